# Optimizing an MI355X kernel written in HIP

```python
import math
import jax
import jax.numpy as jnp
from jax import lax
import numpy as np

D_MODEL = 1024
BATCH = 2
SEQ = 16384
DEPTH = 2

H_A = 8
DK_A = 64
DV_A = 64
CONV_K = 4
CHUNK = 64
H_B = 8
H_B_KV = 2
DH_B = 64
WINDOW = 128
ATT_BLK = 128
NUM_BUCKETS = 32
MAX_DISTANCE = 128
POOL_WINDOWS = (2, 4, 8, 16)
N_POOL_GROUPS = 4
POOL_GROUP_DIM = D_MODEL // N_POOL_GROUPS
N_GROUPS = 4
EXPERTS_PER_GROUP = 8
N_EXPERTS = N_GROUPS * EXPERTS_PER_GROUP
TOP_K_INNER = 2
D_FF_EXPERT = D_MODEL // 2
MOE_BLK = 128
EPS = 1e-6

WA = H_A * DK_A
VA = H_A * DV_A
WB = H_B * DH_B
WKV_B = H_B_KV * DH_B
IN_SIZES = (WA, WA, VA, VA, H_A, H_A, WB, WKV_B, WKV_B)
P_IN = 2 * WA + 2 * VA + 2 * H_A + WB + 2 * WKV_B

kernel_name = 'hybrid_deltanet_swa_pool_hmoe'


def rms_norm(x, w):
    x32 = x.astype(jnp.float32)
    y = x32 * lax.rsqrt(jnp.mean(x32 * x32, axis=-1, keepdims=True) + EPS)
    return (y * w.astype(jnp.float32)).astype(x.dtype)


def l2_normalize(x):
    return x * lax.rsqrt(jnp.sum(x * x, axis=-1, keepdims=True) + EPS)


def causal_depthwise_conv(x, w):
    ch = x.shape[-1]
    return lax.conv_general_dilated(x, w[:, None, :].astype(x.dtype), window_strides=(1,), padding=((CONV_K - 1, 0),), dimension_numbers=('NWC', 'WIO', 'NWC'), feature_group_count=ch)


def t5_causal_bucket(dist):
    n = jnp.maximum(dist, 0)
    max_exact = NUM_BUCKETS // 2
    nf = jnp.maximum(n, 1).astype(jnp.float32)
    large = max_exact + (jnp.log(nf / max_exact) / math.log(MAX_DISTANCE / max_exact) * (NUM_BUCKETS - max_exact)).astype(jnp.int32)
    large = jnp.minimum(large, NUM_BUCKETS - 1)
    return jnp.where(n < max_exact, n, large)


def chunk_gated_delta_rule(q, k, v, g, beta):
    bsz, nh, seq, dk = q.shape
    dv = v.shape[-1]
    n = seq // CHUNK
    q = q.reshape(bsz, nh, n, CHUNK, dk)
    k = k.reshape(bsz, nh, n, CHUNK, dk)
    v = v.reshape(bsz, nh, n, CHUNK, dv)
    g = g.reshape(bsz, nh, n, CHUNK)
    beta = beta.reshape(bsz, nh, n, CHUNK)
    gc = jnp.cumsum(g, axis=-1)
    incl = jnp.tril(jnp.ones((CHUNK, CHUNK), dtype=bool))
    strict = jnp.tril(jnp.ones((CHUNK, CHUNK), dtype=bool), -1)
    decay = jnp.where(incl, jnp.exp(jnp.where(incl, gc[..., :, None] - gc[..., None, :], 0.0)), 0.0)
    kb = k * beta[..., None]
    a_mat = jnp.eye(CHUNK, dtype=jnp.float32) + jnp.where(strict, jnp.einsum('bhnid,bhnjd->bhnij', kb, k) * decay, 0.0)
    rhs = jnp.concatenate([v * beta[..., None], kb * jnp.exp(gc)[..., None]], axis=-1)
    sol = lax.linalg.triangular_solve(a_mat, rhs, left_side=True, lower=True, unit_diagonal=True)
    u, w = sol[..., :dv], sol[..., dv:]
    a_qk = jnp.einsum('bhnid,bhnjd->bhnij', q, k) * decay
    q_dec = q * jnp.exp(gc)[..., None]
    k_dec = k * jnp.exp(gc[..., -1:] - gc)[..., None]
    g_tot = jnp.exp(gc[..., -1])

    def step(state, inp):
        a_n, qd, kd, u_n, w_n, gt = inp
        v_new = u_n - jnp.einsum('bhck,bhkv->bhcv', w_n, state)
        o = jnp.einsum('bhck,bhkv->bhcv', qd, state) + jnp.einsum('bhij,bhjv->bhiv', a_n, v_new)
        state = state * gt[..., None, None] + jnp.einsum('bhck,bhcv->bhkv', kd, v_new)
        return state, o

    xs = (jnp.moveaxis(a_qk, 2, 0), jnp.moveaxis(q_dec, 2, 0), jnp.moveaxis(k_dec, 2, 0), jnp.moveaxis(u, 2, 0), jnp.moveaxis(w, 2, 0), jnp.moveaxis(g_tot, 2, 0))
    s0 = jnp.zeros((bsz, nh, dk, dv), jnp.float32)
    _, o = lax.scan(step, s0, xs)
    return jnp.moveaxis(o, 0, 2).reshape(bsz, nh, seq, dv)


def sliding_window_sink_attention(q, k, v, sinks, rel_bias):
    bsz, seq, _ = q.shape
    nb = seq // ATT_BLK
    grp = H_B // H_B_KV
    qb = q.reshape(bsz, nb, ATT_BLK, H_B_KV, grp, DH_B).astype(jnp.float32) * (DH_B ** -0.5)

    def band(t):
        t = t.reshape(bsz, seq, H_B_KV, DH_B)
        tp = jnp.concatenate([jnp.zeros_like(t[:, :ATT_BLK]), t], axis=1).reshape(bsz, nb + 1, ATT_BLK, H_B_KV, DH_B)
        return jnp.concatenate([tp[:, :-1], tp[:, 1:]], axis=2).astype(jnp.float32)

    kw = band(k)
    vw = band(v)
    s = jnp.einsum('bnqhgd,bnkhd->bhgnqk', qb, kw)
    qi = jnp.arange(ATT_BLK)[:, None]
    ki = jnp.arange(2 * ATT_BLK)[None, :]
    dist = qi + ATT_BLK - ki
    bias = rel_bias.astype(jnp.float32)[t5_causal_bucket(dist)]
    bias = bias.transpose(2, 0, 1).reshape(H_B_KV, grp, 1, ATT_BLK, 2 * ATT_BLK)
    key_pos = jnp.arange(nb)[:, None, None] * ATT_BLK + ki[None] - ATT_BLK
    valid = (dist >= 0) & (dist < WINDOW) & (key_pos >= 0)
    s = jnp.where(valid, s + bias, -1e30)
    sink = sinks.astype(jnp.float32).reshape(H_B_KV, grp, 1, 1, 1)
    m = jnp.maximum(jnp.max(s, axis=-1, keepdims=True), sink)
    p = jnp.exp(s - m)
    denom = jnp.sum(p, axis=-1, keepdims=True) + jnp.exp(sink - m)
    o = jnp.einsum('bhgnqk,bnkhd->bnqhgd', p / denom, vw)
    return o.reshape(bsz, seq, WB).astype(q.dtype)


def deltanet_swa_mixer(h, w_in, conv_w, a_log, dt_bias, onorm_w, sinks, rel_bias, w_out):
    bsz, seq, _ = h.shape
    f32 = jnp.float32
    proj = h @ w_in
    cuts = np.cumsum(IN_SIZES)[:-1].tolist()
    q_a, k_a, v_a, z_a, b_a, a_a, q_b, k_b, v_b = jnp.split(proj, cuts, axis=-1)
    qkv = jax.nn.silu(causal_depthwise_conv(jnp.concatenate([q_a, k_a, v_a], axis=-1), conv_w))
    qa, ka, va = jnp.split(qkv, [WA, 2 * WA], axis=-1)
    qa = l2_normalize(qa.reshape(bsz, seq, H_A, DK_A).transpose(0, 2, 1, 3).astype(f32)) * (DK_A ** -0.5)
    ka = l2_normalize(ka.reshape(bsz, seq, H_A, DK_A).transpose(0, 2, 1, 3).astype(f32))
    va = va.reshape(bsz, seq, H_A, DV_A).transpose(0, 2, 1, 3).astype(f32)
    beta = jax.nn.sigmoid(b_a.astype(f32)).transpose(0, 2, 1)
    g = (-jnp.exp(a_log.astype(f32)) * jax.nn.softplus(a_a.astype(f32) + dt_bias.astype(f32))).transpose(0, 2, 1)
    o_a = chunk_gated_delta_rule(qa, ka, va, g, beta).transpose(0, 2, 1, 3)
    o_a = rms_norm(o_a, onorm_w) * jax.nn.silu(z_a.reshape(bsz, seq, H_A, DV_A).astype(f32))
    out_a = o_a.reshape(bsz, seq, VA).astype(h.dtype)
    out_b = sliding_window_sink_attention(q_b, k_b, v_b, sinks, rel_bias)
    return jnp.concatenate([out_a, out_b], axis=-1) @ w_out


def multiscale_pool_mixer(h, pool_w, pool_scale):
    bsz, seq, d = h.shape
    f32 = jnp.float32
    hg = h.astype(f32).reshape(bsz, seq, N_POOL_GROUPS, POOL_GROUP_DIM)
    cs = jnp.cumsum(hg, axis=1)
    t = jnp.arange(seq)
    pooled = []
    for gi, win in enumerate(POOL_WINDOWS):
        hi = cs[:, :, gi]
        lo = jnp.concatenate([jnp.zeros((bsz, win, POOL_GROUP_DIM), f32), cs[:, :seq - win, gi]], axis=1)
        count = jnp.minimum(t + 1, win).astype(f32)[None, :, None]
        pooled.append((hi - lo) / count - hg[:, :, gi])
    pooled = jnp.stack(pooled, axis=2).astype(h.dtype)
    y = jnp.einsum('blgc,gcd->blgd', pooled, pool_w).reshape(bsz, seq, d)
    return y * pool_scale


def hierarchical_moe(h, r1_w, r1_b, r2_w, r2_b, w_gate, w_up, w_down):
    bsz, seq, d = h.shape
    n_tok = bsz * seq
    xf = h.reshape(n_tok, d)
    p_grp = jax.nn.softmax((xf @ r1_w).astype(jnp.float32) + r1_b.astype(jnp.float32), axis=-1)
    p_top, grp = lax.top_k(p_grp, 1)
    p_top = p_top[:, 0]
    grp = grp[:, 0]
    lg2 = ((xf @ r2_w).astype(jnp.float32) + r2_b.astype(jnp.float32)).reshape(n_tok, N_GROUPS, EXPERTS_PER_GROUP)
    lg2 = lg2[jnp.arange(n_tok), grp]
    top_l, top_e = lax.top_k(lg2, TOP_K_INNER)
    gate = p_top[:, None] * jax.nn.softmax(top_l, axis=-1)
    expert = grp[:, None] * EXPERTS_PER_GROUP + top_e
    n_asg = n_tok * TOP_K_INNER
    e_flat = expert.reshape(n_asg)
    g_flat = gate.reshape(n_asg)
    tok_flat = jnp.arange(n_asg, dtype=jnp.int32) // TOP_K_INNER
    order = jnp.argsort(e_flat)
    e_s = e_flat[order]
    g_s = g_flat[order]
    tok_s = tok_flat[order]
    counts = jnp.zeros((N_EXPERTS,), jnp.int32).at[e_flat].add(1)
    starts = jnp.cumsum(counts) - counts
    padded = (counts + MOE_BLK - 1) // MOE_BLK * MOE_BLK
    pad_end = jnp.cumsum(padded)
    pad_start = pad_end - padded
    dest = pad_start[e_s] + (jnp.arange(n_asg, dtype=jnp.int32) - starts[e_s])
    n_rows = (n_asg + N_EXPERTS * (MOE_BLK - 1) + MOE_BLK - 1) // MOE_BLK * MOE_BLK
    n_blk = n_rows // MOE_BLK
    row_tok = jnp.full((n_rows,), n_tok, jnp.int32).at[dest].set(tok_s)
    row_gate = jnp.zeros((n_rows,), jnp.float32).at[dest].set(g_s)
    blk_expert = jnp.minimum(jnp.searchsorted(pad_end, jnp.arange(n_blk, dtype=jnp.int32) * MOE_BLK, side='right'), N_EXPERTS - 1)
    x_pad = jnp.concatenate([xf, jnp.zeros((1, d), xf.dtype)], axis=0)
    x_rows = x_pad[row_tok].reshape(n_blk, MOE_BLK, d)

    def expert_block(args):
        xb, e = args
        return (jax.nn.silu(xb @ w_gate[e]) * (xb @ w_up[e])) @ w_down[e]

    y_rows = lax.map(expert_block, (x_rows, blk_expert)).reshape(n_rows, d)
    y = jax.ops.segment_sum(y_rows * row_gate[:, None].astype(y_rows.dtype), row_tok, num_segments=n_tok + 1)[:n_tok]
    return y.reshape(bsz, seq, d)


def setup_inputs(seed: int = 0) -> dict:
    key = jax.random.key(seed)
    ks = jax.random.split(key, 24)
    f32 = jnp.float32
    d = D_MODEL
    n_even = (DEPTH + 1) // 2
    n_odd = DEPTH // 2

    def nrm(k, shape, scale):
        return jax.random.normal(k, shape, f32) * scale

    x = nrm(ks[0], (BATCH, SEQ, d), 1.0)
    c = nrm(ks[1], (BATCH, d), 1.0)
    ada_w = nrm(ks[2], (DEPTH, d, 6 * d), 0.5 * d ** -0.5)
    ada_b = nrm(ks[3], (DEPTH, 6 * d), 0.02)
    norm_mix_w = 1.0 + nrm(ks[4], (DEPTH, d), 0.02)
    norm_ffn_w = 1.0 + nrm(ks[5], (DEPTH, d), 0.02)
    ab_w_in = nrm(ks[6], (n_even, d, P_IN), d ** -0.5)
    ab_conv_w = nrm(ks[7], (n_even, CONV_K, 3 * WA), CONV_K ** -0.5)
    ab_a_log = jnp.log(jax.random.uniform(ks[8], (n_even, H_A), f32, 1.0, 16.0))
    dt0 = jnp.exp(jax.random.uniform(ks[9], (n_even, H_A), f32, math.log(1e-3), math.log(1e-1)))
    ab_dt_bias = dt0 + jnp.log(-jnp.expm1(-dt0))
    ab_onorm_w = 1.0 + nrm(ks[10], (n_even, DV_A), 0.02)
    ab_sinks = nrm(ks[11], (n_even, H_B), 0.5)
    rel_bias = nrm(ks[12], (NUM_BUCKETS, H_B), 0.5)
    ab_w_out = nrm(ks[13], (n_even, VA + WB, d), (VA + WB) ** -0.5)
    pool_w = nrm(ks[14], (n_odd, N_POOL_GROUPS, POOL_GROUP_DIM, POOL_GROUP_DIM), POOL_GROUP_DIM ** -0.5)
    pool_scale = 1.0 + nrm(ks[15], (n_odd, d), 0.1)
    r1_w = nrm(ks[16], (DEPTH, d, N_GROUPS), d ** -0.5)
    r1_b = nrm(ks[17], (DEPTH, N_GROUPS), 0.01)
    r2_w = nrm(ks[18], (DEPTH, d, N_EXPERTS), d ** -0.5)
    r2_b = nrm(ks[19], (DEPTH, N_EXPERTS), 0.01)
    moe_w_gate = nrm(ks[20], (DEPTH, N_EXPERTS, d, D_FF_EXPERT), d ** -0.5)
    moe_w_up = nrm(ks[21], (DEPTH, N_EXPERTS, d, D_FF_EXPERT), d ** -0.5)
    moe_w_down = nrm(ks[22], (DEPTH, N_EXPERTS, D_FF_EXPERT, d), D_FF_EXPERT ** -0.5)
    final_norm_w = 1.0 + nrm(ks[23], (d,), 0.02)
    return {'x': x, 'c': c, 'ada_w': ada_w, 'ada_b': ada_b, 'norm_mix_w': norm_mix_w, 'norm_ffn_w': norm_ffn_w, 'ab_w_in': ab_w_in, 'ab_conv_w': ab_conv_w, 'ab_a_log': ab_a_log, 'ab_dt_bias': ab_dt_bias, 'ab_onorm_w': ab_onorm_w, 'ab_sinks': ab_sinks, 'rel_bias': rel_bias, 'ab_w_out': ab_w_out, 'pool_w': pool_w, 'pool_scale': pool_scale, 'r1_w': r1_w, 'r1_b': r1_b, 'r2_w': r2_w, 'r2_b': r2_b, 'moe_w_gate': moe_w_gate, 'moe_w_up': moe_w_up, 'moe_w_down': moe_w_down, 'final_norm_w': final_norm_w}


def reference(x, c, ada_w, ada_b, norm_mix_w, norm_ffn_w, ab_w_in, ab_conv_w, ab_a_log, ab_dt_bias, ab_onorm_w, ab_sinks, rel_bias, ab_w_out, pool_w, pool_scale, r1_w, r1_b, r2_w, r2_b, moe_w_gate, moe_w_up, moe_w_down, final_norm_w):
    cond = jax.nn.silu(c)
    for layer in range(DEPTH):
        mod = cond @ ada_w[layer] + ada_b[layer]
        sh1, sc1, g1, sh2, sc2, g2 = [m[:, None, :] for m in jnp.split(mod, 6, axis=-1)]
        h = rms_norm(x, norm_mix_w[layer]) * (1 + sc1) + sh1
        i = layer // 2
        if layer % 2 == 0:
            y = deltanet_swa_mixer(h, ab_w_in[i], ab_conv_w[i], ab_a_log[i], ab_dt_bias[i], ab_onorm_w[i], ab_sinks[i], rel_bias, ab_w_out[i])
        else:
            y = multiscale_pool_mixer(h, pool_w[i], pool_scale[i])
        x = x + g1 * y
        h = rms_norm(x, norm_ffn_w[layer]) * (1 + sc2) + sh2
        x = x + g2 * hierarchical_moe(h, r1_w[layer], r1_b[layer], r2_w[layer], r2_b[layer], moe_w_gate[layer], moe_w_up[layer], moe_w_down[layer])
    return rms_norm(x, final_norm_w)
```

```cpp
#include <hip/hip_runtime.h>
#include <cstdio>
#include <cstdint>

#ifndef MK_ONE_LAUNCH
#define MK_ONE_LAUNCH 1
#endif

#define GAS __attribute__((address_space(1)))
#define LAS __attribute__((address_space(3)))
typedef unsigned short bf16;
typedef unsigned v4u __attribute__((ext_vector_type(4)));
typedef unsigned v2u __attribute__((ext_vector_type(2)));
typedef float f32x4 __attribute__((ext_vector_type(4)));
typedef float f32x2 __attribute__((ext_vector_type(2)));
typedef float f32x16 __attribute__((ext_vector_type(16)));
typedef short bf16x8 __attribute__((ext_vector_type(8)));
typedef GAS unsigned gu32;
#define RLX_AGENT __ATOMIC_RELAXED, __HIP_MEMORY_SCOPE_AGENT
#define LDS_WAIT() asm volatile("s_waitcnt lgkmcnt(0)" ::: "memory")
#define VM_WAIT() asm volatile("s_waitcnt vmcnt(0)" ::: "memory")

constexpr int BATCH = 2, SEQ = 16384, D = 1024, NTOK = BATCH * SEQ;
constexpr int PIN = 2816;
constexpr int PC_QA = 0, PC_KA = 512, PC_VA = 1024, PC_ZA = 1536, PC_QB = 2048, PC_KB = 2560, PC_VB = 2688;
constexpr int NEXP = 32, DFF = 512;
constexpr int MAXTILES = NTOK * 2 / 256 + NEXP;
constexpr float EPS = 1e-6f;
constexpr int NWAVES = 8;

constexpr size_t MiB = 1u << 20;
constexpr size_t WS_CTL = 0, CTL_ZERO_BYTES = 1 * MiB;
constexpr size_t WS_MOD = 1 * MiB;
constexpr size_t WS_WBA = 1 * MiB + 128 * 1024;
constexpr size_t WS_ROUTE = 2 * MiB;
constexpr size_t WS_RT = 3 * MiB;
constexpr size_t WS_BG = 7 * MiB;
constexpr size_t WS_WIN = 10 * MiB;
constexpr size_t WS_WOUT = 16 * MiB;
constexpr size_t WS_POOLW = 18 * MiB;
constexpr size_t WS_WGU = 20 * MiB;
constexpr size_t WS_WD = 84 * MiB;
constexpr size_t WS_H = 116 * MiB;
constexpr size_t WS_PROJ = 180 * MiB;
constexpr size_t WS_OAB = 356 * MiB;
constexpr size_t WS_YM = 180 * MiB;
constexpr size_t WS_ACT = 180 * MiB;
constexpr size_t WS_Y = 252 * MiB;
constexpr size_t WS_END = 420 * MiB;
constexpr size_t WS_DN_MT = WS_H;
constexpr size_t WS_DN_QPT = WS_H + 32 * MiB;
constexpr size_t WS_DN_BM = 420 * MiB, WS_DN_O0T = 452 * MiB, WS_DN_S = 484 * MiB;
constexpr size_t WS_DN_GT = 9 * MiB;
constexpr size_t WS_END2 = 516 * MiB;
constexpr int CW_CNT = 64;
constexpr int CW_BAR = 4096;
constexpr int CW_BAD = 200;

constexpr int RING_OFF = 0, RING_BYTES = 131072;
constexpr int LDSCTL_OFF = RING_BYTES, MISC_OFF = LDSCTL_OFF + 320;
constexpr int SCHED_OFF = LDSCTL_OFF + 1024;
constexpr int LDS_BYTES = 163840;
constexpr int R1W_OFF = 135168;
constexpr int RT_LDS_OFF = 151552;

typedef __bf16 bf16x2_t __attribute__((ext_vector_type(2)));
__device__ __forceinline__ unsigned pk2(float lo, float hi) { bf16x2_t v; v.x = (__bf16)lo; v.y = (__bf16)hi; return __builtin_bit_cast(unsigned, v); }
__device__ __forceinline__ unsigned f2bf(float f) { return pk2(f, 0.f) & 0xffffu; }
__device__ __forceinline__ float bf2f(unsigned b) { return __builtin_bit_cast(float, b << 16); }
__device__ __forceinline__ float bflo(unsigned w) { return __builtin_bit_cast(float, w << 16); }
__device__ __forceinline__ float bfhi(unsigned w) { return __builtin_bit_cast(float, w & 0xffff0000u); }
template <int CTRL> __device__ __forceinline__ float dpp_f(float v) { return __builtin_bit_cast(float, __builtin_amdgcn_update_dpp(0, __builtin_bit_cast(int, v), CTRL, 0xf, 0xf, false)); }
__device__ __forceinline__ float quad_sum(float v) { v += dpp_f<0xB1>(v); v += dpp_f<0x4E>(v); return v; }
__device__ __forceinline__ float oct_sum(float v) { v = quad_sum(v); v += dpp_f<0x141>(v); return v; }
__device__ __forceinline__ float wave_sum(float v) {
    v = oct_sum(v); v += dpp_f<0x140>(v);
    const float r0 = __builtin_bit_cast(float, __builtin_amdgcn_readlane(__builtin_bit_cast(int, v), 0)), r1 = __builtin_bit_cast(float, __builtin_amdgcn_readlane(__builtin_bit_cast(int, v), 16));
    const float r2 = __builtin_bit_cast(float, __builtin_amdgcn_readlane(__builtin_bit_cast(int, v), 32)), r3 = __builtin_bit_cast(float, __builtin_amdgcn_readlane(__builtin_bit_cast(int, v), 48));
    return (r0 + r1) + (r2 + r3);
}
__device__ __forceinline__ float rl(float x, int l) { return __builtin_bit_cast(float, __builtin_amdgcn_readlane(__builtin_bit_cast(int, x), l)); }
__device__ __forceinline__ float silu_f(float x) { return x / (1.f + __expf(-x)); }
__device__ __forceinline__ float sigmoid_f(float x) { return 1.f / (1.f + __expf(-x)); }
__device__ __forceinline__ float softplus_f(float x) { return x > 20.f ? x : log1pf(__expf(x)); }

namespace pg8 {
#define PG8_LAS __attribute__((address_space(3)))
typedef unsigned short bf16_t;
typedef unsigned u32x4 __attribute__((ext_vector_type(4)));
constexpr int BM = 256, BK = 64, HALF = 128, HTB = HALF * BK * 2, STAGE_BYTES = 8 * HTB;

__host__ __device__ __forceinline__ int lds_byte(int r, int c) { const int st = (r >> 4) * 2 + (c >> 5), rr = r & 15, cc = c & 31, ob = rr * 64 + cc * 2; return st * 1024 + (ob ^ (((ob >> 9) & 1) << 5)); }
__host__ __device__ __forceinline__ void stage_rc(int b, int& R, int& C) { const int st = b / 1024, sb = b % 1024, swz = sb ^ (((sb >> 9) & 1) << 5); R = (st >> 1) * 16 + swz / 64; C = (st & 1) * 32 + (swz % 64) / 2; }
__host__ __device__ __forceinline__ int perm32(int rho) { const int n = rho >> 4, i = rho & 15; return 8 * (i >> 2) + 4 * n + (i & 3); }

struct Unit { int pm, pn, e; };
struct Gemm { const bf16_t* A; int K, ldb; };

template <class Epi, class Sched>
__device__ __forceinline__ void gemm_phase(PG8_LAS unsigned char* lds, const Gemm g, const Sched& S, const Epi& E) {
    const int tid = threadIdx.x, wid = __builtin_amdgcn_readfirstlane(tid >> 6), lane = tid & 63, wr = wid >> 2, wc = wid & 3, fr = lane & 15, fq = lane >> 4;
    const int K = g.K, nt = K / BK;
    int R0, C0, R1, C1; stage_rc(tid * 16, R0, C0); stage_rc(tid * 16 + 8192, R1, C1);
    const int Rb0 = (R0 & ~31) + perm32(R0 & 31), Rb1 = (R1 & ~31) + perm32(R1 & 31);
    const unsigned voffB0 = (unsigned)(Rb0 * g.ldb + C0) * 2u, voffB1 = (unsigned)(Rb1 * g.ldb + C1) * 2u;
    const size_t kstep = (size_t)(BK * 2);
    const size_t hstepB = (size_t)HALF * g.ldb * 2;
    const unsigned ldsw = (unsigned)wid * 1024u;
    const int aoff = lds_byte(wr * 64 + fr, fq * 8), boff = lds_byte(wc * 32 + fr, fq * 8);
    const char* Ab = (const char*)g.A;
#define PG8_SA(b, h) (((b) * 2 + (h)) * HTB)
#define PG8_SB(b, h) ((4 + (b) * 2 + (h)) * HTB)
#define PG8_ST2(bufoff, gbase, v0, v1) do { \
        __builtin_amdgcn_global_load_lds((const unsigned*)((const char*)(gbase) + (v0)), (PG8_LAS unsigned*)(lds + (bufoff) + ldsw), 16, 0, 0); \
        __builtin_amdgcn_global_load_lds((const unsigned*)((const char*)(gbase) + (v1)), (PG8_LAS unsigned*)(lds + (bufoff) + ldsw + 8192), 16, 0, 0); } while (0)
#define PG8_STB(bufoff, gbase) PG8_ST2(bufoff, gbase, voffB0, voffB1)
#define PG8_LDA(dst, b, h) do { _Pragma("unroll") for (int m = 0; m < 4; ++m) _Pragma("unroll") for (int k = 0; k < 2; ++k) dst[m][k] = *(const PG8_LAS bf16x8*)(lds + PG8_SA(b, h) + aoff + m * 2048 + k * 1024); } while (0)
#define PG8_LDB(dst, b, h) do { _Pragma("unroll") for (int n = 0; n < 2; ++n) _Pragma("unroll") for (int k = 0; k < 2; ++k) dst[n][k] = *(const PG8_LAS bf16x8*)(lds + PG8_SB(b, h) + boff + n * 2048 + k * 1024); } while (0)
#define PG8_MMA(ai, bj, At, Bt) do { __builtin_amdgcn_s_setprio(1); _Pragma("unroll") for (int m = 0; m < 4; ++m) _Pragma("unroll") for (int n = 0; n < 2; ++n) _Pragma("unroll") for (int k = 0; k < 2; ++k) \
        acc[ai][bj][m][n] = __builtin_amdgcn_mfma_f32_16x16x32_bf16(Bt[n][k], At[m][k], acc[ai][bj][m][n], 0, 0, 0); __builtin_amdgcn_s_setprio(0); } while (0)
#define PG8_WAIT_V(n) asm volatile("s_waitcnt vmcnt(" #n ")" ::: "memory")
#define PG8_WAIT_L(n) asm volatile("s_waitcnt lgkmcnt(" #n ")" ::: "memory")
#define PG8_BAR __builtin_amdgcn_s_barrier()
#define PG8_SCHED __builtin_amdgcn_sched_barrier(0)
    Unit cur, nxt; int ui = 0;
    if (!S.next(0, cur)) return;
    f32x4 acc[2][2][4][2];
#pragma unroll
    for (int a = 0; a < 2; ++a)
#pragma unroll
        for (int b = 0; b < 2; ++b)
#pragma unroll
            for (int m = 0; m < 4; ++m)
#pragma unroll
                for (int n = 0; n < 2; ++n) acc[a][b][m][n] = (f32x4){0.f, 0.f, 0.f, 0.f};
    bf16x8 At[4][2], B0[2][2], B1[2][2];
    unsigned c00, c01, c10, c11;
#define PG8_AOFF(u, d00, d01, d10, d11) do { \
        d00 = S.a_off(u, R0) + (unsigned)C0 * 2u; d01 = S.a_off(u, R1) + (unsigned)C1 * 2u; \
        d10 = S.a_off(u, HALF + R0) + (unsigned)C0 * 2u; d11 = S.a_off(u, HALF + R1) + (unsigned)C1 * 2u; } while (0)
    PG8_AOFF(cur, c00, c01, c10, c11);
    const char* cB = S.b_ptr(cur);
    PG8_STB(PG8_SB(0, 0), cB); PG8_STB(PG8_SB(0, 1), cB + hstepB); PG8_ST2(PG8_SA(0, 0), Ab, c00, c01); PG8_ST2(PG8_SA(0, 1), Ab, c10, c11);
    if (wr == 1) PG8_BAR;
    PG8_WAIT_V(2); PG8_BAR;
    PG8_STB(PG8_SB(1, 0), cB + kstep); PG8_ST2(PG8_SA(1, 0), Ab + kstep, c00, c01); PG8_STB(PG8_SB(1, 1), cB + hstepB + kstep);
    PG8_WAIT_V(6); PG8_BAR;
    for (;;) {
        const bool has_next = S.next(ui + 1, nxt);
        const char* nB = has_next ? S.b_ptr(nxt) : cB;
#pragma unroll 1
        for (int t = 0; t < nt; t += 2) {
            const bool last = (t == nt - 2);
            const char* a1 = Ab + (size_t)(t + 1) * kstep;
            const char* a2 = last ? Ab : Ab + (size_t)(t + 2) * kstep; const char* b2 = last ? nB : cB + (size_t)(t + 2) * kstep;
            const char* a3 = a2 + kstep; const char* b3 = b2 + kstep;
            PG8_LDB(B0, 0, 0); PG8_LDB(B1, 0, 1); PG8_SCHED; PG8_LDA(At, 0, 0); PG8_ST2(PG8_SA(1, 1), a1, c10, c11);
            PG8_WAIT_V(8); PG8_WAIT_L(0); PG8_BAR; PG8_MMA(0, 0, At, B0); PG8_MMA(0, 1, At, B1); PG8_BAR; PG8_SCHED;
            if (last && has_next) { PG8_AOFF(nxt, c00, c01, c10, c11); }
            PG8_LDA(At, 0, 1); PG8_STB(PG8_SB(0, 0), b2); PG8_STB(PG8_SB(0, 1), b2 + hstepB); PG8_ST2(PG8_SA(0, 0), a2, c00, c01);
            PG8_WAIT_V(8); PG8_WAIT_L(0); PG8_BAR; PG8_MMA(1, 0, At, B0); PG8_MMA(1, 1, At, B1); PG8_BAR; PG8_SCHED;
            PG8_LDB(B0, 1, 0); PG8_LDB(B1, 1, 1); PG8_SCHED; PG8_LDA(At, 1, 0); PG8_ST2(PG8_SA(0, 1), a2, c10, c11);
            PG8_WAIT_V(8); PG8_WAIT_L(0); PG8_BAR; PG8_MMA(0, 0, At, B0); PG8_MMA(0, 1, At, B1); PG8_BAR; PG8_SCHED;
            PG8_LDA(At, 1, 1); PG8_STB(PG8_SB(1, 0), b3); PG8_STB(PG8_SB(1, 1), b3 + hstepB); PG8_ST2(PG8_SA(1, 0), a3, c00, c01);
            PG8_WAIT_V(8); PG8_WAIT_L(0); PG8_BAR; PG8_MMA(1, 0, At, B0); PG8_MMA(1, 1, At, B1); PG8_BAR; PG8_SCHED;
        }
        if (wr == 0) PG8_BAR;
        E(acc, cur, wr, wc, fr, fq);
        if (!has_next) break;
#pragma unroll
        for (int a = 0; a < 2; ++a)
#pragma unroll
            for (int b = 0; b < 2; ++b)
#pragma unroll
                for (int m = 0; m < 4; ++m)
#pragma unroll
                    for (int n = 0; n < 2; ++n) acc[a][b][m][n] = (f32x4){0.f, 0.f, 0.f, 0.f};
        cur = nxt; cB = nB; ++ui;
        if (wr == 1) PG8_BAR;
    }
    PG8_WAIT_V(0);
    PG8_BAR;
#undef PG8_SA
#undef PG8_SB
#undef PG8_ST2
#undef PG8_STB
#undef PG8_LDA
#undef PG8_LDB
#undef PG8_MMA
#undef PG8_WAIT_V
#undef PG8_WAIT_L
#undef PG8_BAR
#undef PG8_SCHED
#undef PG8_AOFF
}
}

#define XB_TMO      128
#define XB_XCNT(j)  (256  + 64 * (j))
#define XB_XSUB(j)  (1280 + 64 * (j))
#define XB_XGEN(j)  (2304 + 64 * (j))
#define XB_TOP      3328
#define XB_TOPGEN   3392
#define XCD_BAR_WORDS 3456
#define XB_SPIN_CAP (1u << 22)

__device__ __forceinline__ unsigned xb_ld(unsigned* p)              { return __hip_atomic_load(p, __ATOMIC_RELAXED, __HIP_MEMORY_SCOPE_AGENT); }
__device__ __forceinline__ unsigned xb_add(unsigned* p, unsigned v) { return __hip_atomic_fetch_add(p, v, __ATOMIC_RELAXED, __HIP_MEMORY_SCOPE_AGENT); }
__device__ __forceinline__ unsigned xb_xcc_id() { return (unsigned)__builtin_amdgcn_s_getreg((3 << 11) | 20) & 0xFu; }
#define XB_SPIN(cond, bar) do { unsigned _sp = 0; while (cond) { __builtin_amdgcn_s_sleep(1); \
    if ((++_sp & 255u) == 0u) { if (xb_ld(&(bar)[XB_TMO])) break; if (_sp > XB_SPIN_CAP) { atomicAdd(&(bar)[XB_TMO], 1u); break; } } } } while (0)

struct XcdBarrier { unsigned* bar; unsigned x; volatile LAS unsigned* st; };

__device__ __forceinline__ XcdBarrier xcd_barrier_post(unsigned* bar, volatile LAS unsigned* st) {
    XcdBarrier b; b.bar = bar; b.x = xb_xcc_id(); b.st = st;
    if (threadIdx.x == 0) (void)xb_add(&bar[XB_XCNT(b.x)], 1u);
    return b;
}
__device__ __forceinline__ void xcd_barrier_complete(unsigned* bar, unsigned x, unsigned& nloc, unsigned& nx) {
    const unsigned G = gridDim.x * gridDim.y * gridDim.z;
    unsigned sum, cnt, mine, sp = 0u;
    for (;;) {
        sum = 0u; cnt = 0u; mine = 0u;
#pragma unroll
        for (unsigned j = 0; j < 16; ++j) { const unsigned c = xb_ld(&bar[XB_XCNT(j)]); sum += c; cnt += (c > 0u) ? 1u : 0u; mine = (j == x) ? c : mine; }
        if (sum == G) break;
        __builtin_amdgcn_s_sleep(1);
        if ((++sp & 255u) == 0u) { if (xb_ld(&bar[XB_TMO])) break; if (sp > XB_SPIN_CAP) { atomicAdd(&bar[XB_TMO], 1u); break; } }
    }
    nloc = mine > 0u ? mine : 1u; nx = cnt > 0u ? cnt : 1u;
}
__device__ __forceinline__ void xcd_barrier(const XcdBarrier& b) {
    asm volatile("s_waitcnt vmcnt(0)" ::: "memory");
    __syncthreads();
    if (threadIdx.x == 0) {
        unsigned* bar = b.bar;
        __builtin_amdgcn_s_waitcnt(0);
        unsigned nloc = b.st[0], nx = b.st[1];
        if (nloc == 0u) { xcd_barrier_complete(bar, b.x, nloc, nx); b.st[0] = nloc; b.st[1] = nx; }
        const unsigned old = xb_add(&bar[XB_XSUB(b.x)], 1u);
        const unsigned gen = old / nloc;
        if (old + 1u == (gen + 1u) * nloc) {
            __builtin_amdgcn_fence(__ATOMIC_RELEASE, "agent");
            asm volatile("s_waitcnt vmcnt(0)" ::: "memory");
            const unsigned og = xb_add(&bar[XB_TOP], 1u);
            const unsigned tg = og / nx;
            if (og + 1u == (tg + 1u) * nx) xb_add(&bar[XB_TOPGEN], 1u);
            else XB_SPIN(xb_ld(&bar[XB_TOPGEN]) == tg, bar);
            __builtin_amdgcn_fence(__ATOMIC_ACQUIRE, "agent");
            xb_add(&bar[XB_XGEN(b.x)], 1u);
            asm volatile("s_waitcnt vmcnt(0)" ::: "memory");
        } else {
            XB_SPIN(xb_ld(&bar[XB_XGEN(b.x)]) == gen, bar);
            __builtin_amdgcn_fence(__ATOMIC_ACQUIRE, "agent");
            asm volatile("s_waitcnt vmcnt(0)" ::: "memory");
        }
    }
    __syncthreads();
}

struct Frame {
    LAS unsigned char* lds;
    volatile LAS unsigned* MISC;
    gu32* ctl;
    int tid, lane, wave, vcu, G;
    const float* in[24];
    float* out;
    unsigned char* ws;
};
enum { I_X = 0, I_C, I_ADAW, I_ADAB, I_NMIX, I_NFFN, I_WIN, I_CONVW, I_ALOG, I_DTB, I_ONORM, I_SINKS, I_RELB, I_WOUT, I_POOLW, I_POOLS, I_R1W, I_R1B, I_R2W, I_R2B, I_WG, I_WU, I_WDN, I_FNW };

__device__ __forceinline__ void p0_transpose_item(const float* W, int ldw, int K, bf16* WT, int dst_row0, LAS float* scr, int k0, int n0, int lane) {
    f32x4 w4[8];
#pragma unroll
    for (int i = 0; i < 8; ++i) { const int f = i * 64 + lane, kk = f >> 3, c4 = f & 7; w4[i] = __builtin_nontemporal_load((const f32x4*)(W + (size_t)(k0 + kk) * ldw + n0 + c4 * 4)); }
#pragma unroll
    for (int i = 0; i < 8; ++i) { const int f = i * 64 + lane, kk = f >> 3, c4 = f & 7; LAS float* d = scr + kk * 33 + c4 * 4; d[0] = w4[i].x; d[1] = w4[i].y; d[2] = w4[i].z; d[3] = w4[i].w; }
    LDS_WAIT(); asm volatile("" ::: "memory");
    const int c = lane & 7;
#pragma unroll
    for (int j = 0; j < 4; ++j) { const int n = (lane >> 3) + 8 * j; const LAS float* s = scr + (8 * c) * 33 + n;
        v4u o; o.x = pk2(s[0 * 33], s[1 * 33]); o.y = pk2(s[2 * 33], s[3 * 33]); o.z = pk2(s[4 * 33], s[5 * 33]); o.w = pk2(s[6 * 33], s[7 * 33]);
        __builtin_nontemporal_store(o, (GAS v4u*)(WT + (size_t)(dst_row0 + n) * K + k0 + 8 * c)); }
    LDS_WAIT(); asm volatile("" ::: "memory");
}
__device__ __forceinline__ void convert_moe_weights(Frame& F, int layer, const int wg_first, const int wg_count) {
    LAS float* scr = (LAS float*)(F.lds + RING_OFF + F.wave * 16384);
    const int gw = wg_first * NWAVES + F.wave, NGW = wg_count * NWAVES;
    bf16* WGU = (bf16*)(F.ws + WS_WGU); bf16* WD = (bf16*)(F.ws + WS_WD);
    for (int it = gw; it < NEXP * 768; it += NGW) {
        const int e = it / 768, r = it % 768;
        if (r < 512) {
            const int up = r >> 8, q = r & 255, kb = q >> 4, nb = q & 15;
            const float* W = (up ? F.in[I_WU] : F.in[I_WG]) + (size_t)(layer * NEXP + e) * 1024 * 512;
            p0_transpose_item(W, 512, 1024, WGU, e * 1024 + (nb >> 2) * 256 + up * 128 + (nb & 3) * 32, scr, kb * 64, nb * 32, F.lane);
        } else {
            const int q = r - 512, kb = q >> 5, nb = q & 31;
            const float* W = F.in[I_WDN] + (size_t)(layer * NEXP + e) * 512 * 1024;
            p0_transpose_item(W, 1024, 512, WD, e * 1024 + nb * 32, scr, kb * 64, nb * 32, F.lane);
        }
    }
}
__device__ __forceinline__ void p0_prologue(Frame& F) {
    LAS float* scr = (LAS float*)(F.lds + RING_OFF + F.wave * 16384);
    const int gw = F.vcu * NWAVES + F.wave, NGW = F.G * NWAVES;
    constexpr int IA = 16 * 64, IB = 16 * 24, IO = 16 * 32, IP = 4 * 32, NIT = IA + IB + IO + IP;
    for (int it = gw; it < NIT; it += NGW) {
        int r = it;
        if (r < IA) { p0_transpose_item(F.in[I_WIN], 2832, 1024, (bf16*)(F.ws + WS_WIN), (r % 64) * 32, scr, (r / 64) * 64, (r % 64) * 32, F.lane); continue; } r -= IA;
        if (r < IB) { p0_transpose_item(F.in[I_WIN] + 2064, 2832, 1024, (bf16*)(F.ws + WS_WIN), 2048 + (r % 24) * 32, scr, (r / 24) * 64, (r % 24) * 32, F.lane); continue; } r -= IB;
        if (r < IO) { p0_transpose_item(F.in[I_WOUT], 1024, 1024, (bf16*)(F.ws + WS_WOUT), (r % 32) * 32, scr, (r / 32) * 64, (r % 32) * 32, F.lane); continue; } r -= IO;
        { const int g = r >> 5, q = r & 31; p0_transpose_item(F.in[I_POOLW] + (size_t)g * 65536, 256, 256, (bf16*)(F.ws + WS_POOLW) + (size_t)g * 65536, (q & 7) * 32, scr, (q >> 3) * 64, (q & 7) * 32, F.lane); }
    }
    { float* WBA = (float*)(F.ws + WS_WBA); const int gt = F.vcu * 512 + F.tid;
      if (gt < 16 * 1024) { const int o = gt >> 10, k = gt & 1023; WBA[o * 1024 + k] = F.in[I_WIN][(size_t)k * 2832 + 2048 + o]; } }
    __syncthreads();
    {
        LAS float* red = (LAS float*)(F.lds + RING_OFF);
        const int ks = F.tid >> 4, cj = F.tid & 15;
        for (int u = F.vcu; u < 192; u += F.G) {
            const int l = u / 96, cb = u % 96;
            const float* W = F.in[I_ADAW] + (size_t)l * 1024 * 6144 + cb * 64 + cj * 4;
            f32x4 a0 = {0.f, 0.f, 0.f, 0.f}, a1 = {0.f, 0.f, 0.f, 0.f};
            for (int k = ks * 32; k < ks * 32 + 32; ++k) {
                const f32x4 w = *(const f32x4*)(W + (size_t)k * 6144);
                const float c0 = silu_f(F.in[I_C][k]), c1 = silu_f(F.in[I_C][1024 + k]);
                a0 += w * c0; a1 += w * c1;
            }
            *(LAS f32x4*)(red + (ks * 2 + 0) * 64 + cj * 4) = a0; *(LAS f32x4*)(red + (ks * 2 + 1) * 64 + cj * 4) = a1;
            __syncthreads();
            if (F.tid < 128) { const int b = F.tid >> 6, c = F.tid & 63; float s = 0.f;
                for (int q = 0; q < 32; ++q) s += red[(q * 2 + b) * 64 + c];
                ((float*)(F.ws + WS_MOD))[(size_t)(l * 2 + b) * 6144 + cb * 64 + c] = s + F.in[I_ADAB][l * 6144 + cb * 64 + c]; }
            __syncthreads();
        }
    }
}

struct RowVec { f32x4 v[4]; };
__device__ __forceinline__ RowVec load_row_f32(const float* row, int lane) { RowVec r; const GAS f32x4* p = (const GAS f32x4*)row + lane;
#pragma unroll
    for (int j = 0; j < 4; ++j) r.v[j] = p[64 * j]; return r; }
__device__ __forceinline__ void store_row_f32(float* row, int lane, const RowVec& r) { GAS f32x4* p = (GAS f32x4*)row + lane;
#pragma unroll
    for (int j = 0; j < 4; ++j) p[64 * j] = r.v[j]; }
__device__ __forceinline__ void store_row_bf16(bf16* row, int lane, const RowVec& r) { GAS v2u* p = (GAS v2u*)row + lane;
#pragma unroll
    for (int j = 0; j < 4; ++j) { v2u o; o.x = pk2(r.v[j].x, r.v[j].y); o.y = pk2(r.v[j].z, r.v[j].w); p[64 * j] = o; } }
__device__ __forceinline__ float row_rstd(const RowVec& r) { float s = 0.f;
#pragma unroll
    for (int j = 0; j < 4; ++j) s += (r.v[j].x * r.v[j].x + r.v[j].y * r.v[j].y) + (r.v[j].z * r.v[j].z + r.v[j].w * r.v[j].w);
    return 1.0f / sqrtf(wave_sum(s) * (1.f / D) + EPS); }
struct ModVec { f32x4 a[4], b[4]; };
__device__ __forceinline__ ModVec load_mod(const float* w, const float* sc, const float* sh, int lane) { ModVec m;
#pragma unroll
    for (int j = 0; j < 4; ++j) { const f32x4 wv = *((const f32x4*)w + lane + 64 * j), s = *((const f32x4*)sc + lane + 64 * j); m.a[j] = wv * (s + 1.0f); m.b[j] = *((const f32x4*)sh + lane + 64 * j); }
    return m; }
__device__ __forceinline__ RowVec apply_mod(const RowVec& x, float rstd, const ModVec& m) { RowVec h;
#pragma unroll
    for (int j = 0; j < 4; ++j) h.v[j] = x.v[j] * rstd * m.a[j] + m.b[j]; return h; }

__device__ __forceinline__ void p1_prenorm0(Frame& F) {
    LAS float* wba = (LAS float*)(F.lds + RING_OFF);
    { const float* WBA = (const float*)(F.ws + WS_WBA); for (int i = F.tid; i < 16 * 256; i += 512) *((LAS f32x4*)wba + i) = *((const f32x4*)WBA + i); }
    __syncthreads();
    const float* mod = (const float*)(F.ws + WS_MOD);
    bf16* H = (bf16*)(F.ws + WS_H); float* BG = (float*)(F.ws + WS_BG);
    const int tok0 = F.vcu * (NTOK / F.G) + F.wave * (NTOK / F.G / NWAVES), ntw = NTOK / F.G / NWAVES;
    const int b = tok0 / SEQ;
    const ModVec m = load_mod(F.in[I_NMIX], mod + (size_t)b * 6144 + 1024, mod + (size_t)b * 6144, F.lane);
    const int hh = F.lane & 7;
    const float nega = -__expf(F.in[I_ALOG][hh]), dtb = F.in[I_DTB][hh];
    RowVec xn = load_row_f32(F.in[I_X] + (size_t)tok0 * D, F.lane);
    for (int i = 0; i < ntw; ++i) {
        const int t = tok0 + i;
        const RowVec x = xn;
        if (i + 1 < ntw) xn = load_row_f32(F.in[I_X] + (size_t)(t + 1) * D, F.lane);
        const RowVec h = apply_mod(x, row_rstd(x), m);
        store_row_bf16(H + (size_t)t * D, F.lane, h);
        float mine = 0.f;
#pragma unroll 2
        for (int o = 0; o < 16; ++o) { float s = 0.f;
#pragma unroll
            for (int j = 0; j < 4; ++j) { const f32x4 w = *((const LAS f32x4*)(wba + o * 1024) + F.lane + 64 * j); s += (h.v[j].x * w.x + h.v[j].y * w.y) + (h.v[j].z * w.z + h.v[j].w * w.w); }
            s = wave_sum(s); if (F.lane == o) mine = s; }
        if (F.lane < 8) BG[(size_t)t * 16 + F.lane] = sigmoid_f(mine);
        else if (F.lane < 16) BG[(size_t)t * 16 + F.lane] = nega * softplus_f(mine + dtb);
    }
}

struct DenseSched {
    int nM, nN, nwg, G, c; unsigned lda2, acol2; const char* B; size_t btile;
    __device__ __forceinline__ void init(int M, int N, int G_, int c_, int lda, int acolstride, const void* B_, int ldb) { nM = M / 256; nN = N / 256; nwg = nM * nN; G = G_; c = c_; lda2 = (unsigned)lda * 2u; acol2 = (unsigned)acolstride * 2u; B = (const char*)B_; btile = (size_t)256 * ldb * 2; }
    __device__ __forceinline__ bool next(int i, pg8::Unit& u) const {
        const long L = (long)i * G + c; if (L >= nwg) return false;
        int wgid = (int)L; { const int q = nwg / 8, r = nwg % 8, xcd = wgid % 8, off = wgid / 8; wgid = (xcd < r ? xcd * (q + 1) : r * (q + 1) + (xcd - r) * q) + off; }
        const int nig = 8 * nN, gid = wgid / nig, fm = gid * 8, gsz = (nM - fm) < 8 ? (nM - fm) : 8;
        u.pm = fm + ((wgid % nig) % gsz); u.pn = (wgid % nig) / gsz; u.e = 0; return true;
    }
    __device__ __forceinline__ unsigned a_off(const pg8::Unit& u, int r) const { return (unsigned)(u.pm * 256 + r) * lda2 + (unsigned)u.pn * acol2; }
    __device__ __forceinline__ const char* b_ptr(const pg8::Unit& u) const { return B + (size_t)u.pn * btile; }
};
struct MoeSched {
    const LAS int* cnt; const LAS int* tbase; const LAS int* tileExp;
    int nunits, chunk, G, c; const int* RT; const char* B; size_t bexp, btile; unsigned arow2;
    __device__ __forceinline__ void init(const LAS int* tables, int G_, int c_, const int* RT_, const void* B_, int ldb, int lda) {
        cnt = tables; tbase = tables + 32; tileExp = tables + 80; G = G_; c = c_; RT = RT_; B = (const char*)B_; bexp = (size_t)1024 * ldb * 2; btile = (size_t)256 * ldb * 2; arow2 = (unsigned)lda * 2u;
        nunits = tbase[32] * 4; chunk = ((nunits + 7) / 8 + 3) & ~3;
    }
    __device__ __forceinline__ bool next(int i, pg8::Unit& u) const {
        const int w = i * (G / 8) + (c >> 3); if (w >= chunk) return false;
        const int L = (c & 7) * chunk + w; if (L >= nunits) return false;
        u.pm = L >> 2; u.pn = L & 3; u.e = tileExp[u.pm]; return true;
    }
    __device__ __forceinline__ unsigned a_off(const pg8::Unit& u, int r) const {
        if (RT) { const int pos = (u.pm - tbase[u.e]) * 256 + r; const int tok = pos < cnt[u.e] ? RT[u.e * NTOK + pos] : 0; return (unsigned)tok * arow2; }
        return (unsigned)(u.pm * 256 + r) * arow2;
    }
    __device__ __forceinline__ const char* b_ptr(const pg8::Unit& u) const { return B + (size_t)u.e * bexp + (size_t)u.pn * btile; }
};
__device__ __forceinline__ void build_moe_tables(Frame& F, int layer) {
    LAS int* T = (LAS int*)(F.lds + SCHED_OFF);
    int tid_ = F.tid; asm volatile("" : "+v"(tid_));
    if (tid_ < 32) T[tid_] = (int)__hip_atomic_load(F.ctl + CW_CNT + 64 * layer + tid_, RLX_AGENT);
    __syncthreads();
    if (F.tid == 0) { int acc = 0; for (int e = 0; e < 32; ++e) { T[32 + e] = acc; const int nt = (T[e] + 255) >> 8; for (int j = 0; j < nt; ++j) T[80 + acc + j] = e; acc += nt; } T[64] = acc; }
    __syncthreads();
}

struct EpiStoreBf16 {
    bf16* O; int ldc;
    __device__ __forceinline__ void operator()(const f32x4 (&acc)[2][2][4][2], const pg8::Unit& u, int wr, int wc, int fr, int fq) const {
        const int row0 = u.pm * 256 + wr * 64 + fr, col0 = u.pn * 256 + wc * 32 + 8 * fq;
#pragma unroll
        for (int ai = 0; ai < 2; ++ai)
#pragma unroll
            for (int m = 0; m < 4; ++m) { bf16* rowp = O + (size_t)(row0 + ai * 128 + m * 16) * ldc + col0;
#pragma unroll
                for (int bj = 0; bj < 2; ++bj) { const f32x4 v0 = acc[ai][bj][m][0], v1 = acc[ai][bj][m][1];
                    v4u w; w.x = pk2(v0[0], v0[1]); w.y = pk2(v0[2], v0[3]); w.z = pk2(v1[0], v1[1]); w.w = pk2(v1[2], v1[3]);
                    *(v4u*)(rowp + bj * 128) = w; } }
    }
};
struct EpiSwiglu {
    bf16* O;
    __device__ __forceinline__ void operator()(const f32x4 (&acc)[2][2][4][2], const pg8::Unit& u, int wr, int wc, int fr, int fq) const {
        const int row0 = u.pm * 256 + wr * 64 + fr, col0 = u.pn * 128 + wc * 32 + 8 * fq;
#pragma unroll
        for (int ai = 0; ai < 2; ++ai)
#pragma unroll
            for (int m = 0; m < 4; ++m) { bf16* rowp = O + (size_t)(row0 + ai * 128 + m * 16) * DFF + col0;
                float r[8];
#pragma unroll
                for (int n = 0; n < 2; ++n)
#pragma unroll
                    for (int j = 0; j < 4; ++j) r[4 * n + j] = silu_f(acc[ai][0][m][n][j]) * acc[ai][1][m][n][j];
                v4u w; w.x = pk2(r[0], r[1]); w.y = pk2(r[2], r[3]); w.z = pk2(r[4], r[5]); w.w = pk2(r[6], r[7]);
                *(v4u*)rowp = w; }
    }
};

__device__ __forceinline__ void moe_route(Frame& F, int layer) {
    LAS int* hist = (LAS int*)(F.lds + RT_LDS_OFF);
    LAS int* base = hist + 32;
    LAS int* tinfo = hist + 64;
    LAS float* tg = (LAS float*)(hist + 64 + 512);
    if (F.tid < 32) hist[F.tid] = 0;
    LAS f32x4* R2 = (LAS f32x4*)(F.lds + RING_OFF);
    LAS f32x4* R1 = (LAS f32x4*)(F.lds + R1W_OFF);
    { const f32x4* g2p = (const f32x4*)(F.in[I_R2W] + (size_t)layer * 1024 * 32); const f32x4* g1p = (const f32x4*)(F.in[I_R1W] + (size_t)layer * 1024 * 4);
      for (int i = F.tid; i < 8192; i += 512) { const int k = i >> 3, c4 = i & 7, ln = (k & 255) >> 2, q = k & 3, j = k >> 8; R2[((j * 4 + q) * 8 + c4) * 64 + ln] = g2p[i]; }
      for (int k = F.tid; k < 1024; k += 512) { const int ln = (k & 255) >> 2, q = k & 3, j = k >> 8; R1[(j * 4 + q) * 64 + ln] = g1p[k]; } }
    __syncthreads();
    const float* mod = (const float*)(F.ws + WS_MOD) + (size_t)layer * 2 * 6144;
    bf16* H = (bf16*)(F.ws + WS_H);
    const int tokw = F.vcu * 128 + F.wave * 16, b = (F.vcu * 128) / SEQ;
    const ModVec m = load_mod(F.in[I_NFFN] + layer * D, mod + (size_t)b * 6144 + 4 * 1024, mod + (size_t)b * 6144 + 3 * 1024, F.lane);
    const float* r1b = F.in[I_R1B] + layer * 4; const float* r2b = F.in[I_R2B] + layer * 32;
    const float* xin = layer == 0 ? F.in[I_X] : F.out; const bf16* YM = (const bf16*)(F.ws + WS_YM);
    f32x4 cf[4];
#pragma unroll
    for (int j = 0; j < 4; ++j) { cf[j] = *((const f32x4*)(mod + (size_t)b * 6144 + 2 * 1024) + F.lane + 64 * j); if (layer == 1) cf[j] *= *((const f32x4*)F.in[I_POOLS] + F.lane + 64 * j); }
    RowVec xn = load_row_f32(xin + (size_t)tokw * D, F.lane); v2u yn[4];
#pragma unroll
    for (int j = 0; j < 4; ++j) yn[j] = *((const GAS v2u*)(YM + (size_t)tokw * D) + F.lane + 64 * j);
    for (int i = 0; i < 16; ++i) {
        const int t = tokw + i;
        RowVec x = xn; v2u yc[4];
#pragma unroll
        for (int j = 0; j < 4; ++j) yc[j] = yn[j];
        if (i + 1 < 16) { xn = load_row_f32(xin + (size_t)(t + 1) * D, F.lane);
#pragma unroll
            for (int j = 0; j < 4; ++j) yn[j] = *((const GAS v2u*)(YM + (size_t)(t + 1) * D) + F.lane + 64 * j); }
#pragma unroll
        for (int j = 0; j < 4; ++j) { f32x4 yv; yv.x = bflo(yc[j].x); yv.y = bfhi(yc[j].x); yv.z = bflo(yc[j].y); yv.w = bfhi(yc[j].y); x.v[j] += cf[j] * yv; }
        store_row_f32(F.out + (size_t)t * D, F.lane, x);
        RowVec h = apply_mod(x, row_rstd(x), m);
        store_row_bf16(H + (size_t)t * D, F.lane, h);
        f32x4 l1 = {0.f, 0.f, 0.f, 0.f};
#pragma unroll
        for (int j = 0; j < 4; ++j)
#pragma unroll
            for (int q = 0; q < 4; ++q) l1 += R1[(j * 4 + q) * 64 + F.lane] * h.v[j][q];
        float lg[4];
#pragma unroll
        for (int g = 0; g < 4; ++g) lg[g] = wave_sum(l1[g]) + r1b[g];
        int grp = 0; float mx = lg[0];
#pragma unroll
        for (int g = 1; g < 4; ++g) if (lg[g] > mx) { mx = lg[g]; grp = g; }
        float se = 0.f;
#pragma unroll
        for (int g = 0; g < 4; ++g) se += __expf(lg[g] - mx);
        const float ptop = 1.0f / se;
        grp = __builtin_amdgcn_readfirstlane(grp);
        f32x4 a0 = {0.f, 0.f, 0.f, 0.f}, a1 = {0.f, 0.f, 0.f, 0.f};
#pragma unroll
        for (int j = 0; j < 4; ++j)
#pragma unroll
            for (int q = 0; q < 4; ++q) { const LAS f32x4* wp = R2 + ((j * 4 + q) * 8 + grp * 2) * 64 + F.lane;
                a0 += wp[0] * h.v[j][q]; a1 += wp[64] * h.v[j][q]; }
        float l2[8];
#pragma unroll
        for (int q = 0; q < 4; ++q) { l2[q] = wave_sum(a0[q]) + r2b[grp * 8 + q]; l2[4 + q] = wave_sum(a1[q]) + r2b[grp * 8 + 4 + q]; }
        int i0 = 0; float v0 = l2[0];
#pragma unroll
        for (int q = 1; q < 8; ++q) if (l2[q] > v0) { v0 = l2[q]; i0 = q; }
        int i1 = (i0 == 0) ? 1 : 0; float v1 = l2[i1 == 1 ? 1 : 0];
#pragma unroll
        for (int q = 0; q < 8; ++q) if (q != i0 && l2[q] > v1) { v1 = l2[q]; i1 = q; }
        const float g0 = ptop / (1.0f + __expf(v1 - v0)), g1 = ptop - g0;
        if (F.lane == 0) { const int e0 = grp * 8 + i0, e1 = grp * 8 + i1, li = F.wave * 16 + i;
            tinfo[li * 4 + 0] = e0; tinfo[li * 4 + 1] = e1; tinfo[li * 4 + 2] = atomicAdd((int*)(hist + e0), 1); tinfo[li * 4 + 3] = atomicAdd((int*)(hist + e1), 1);
            tg[li * 2] = g0; tg[li * 2 + 1] = g1;
            { float* GA = (float*)(F.ws + WS_BG); GA[(size_t)t * 2] = g0; GA[(size_t)t * 2 + 1] = g1; }
        }
    }
    __syncthreads();
    if (F.tid < 32) base[F.tid] = (int)__hip_atomic_fetch_add(F.ctl + CW_CNT + 64 * layer + F.tid, (unsigned)hist[F.tid], RLX_AGENT);
    __syncthreads();
    if (F.tid < 128) { const int t = F.vcu * 128 + F.tid; const int e0 = tinfo[F.tid * 4], e1 = tinfo[F.tid * 4 + 1];
        const int p0 = base[e0] + tinfo[F.tid * 4 + 2], p1 = base[e1] + tinfo[F.tid * 4 + 3];
        int* RT = (int*)(F.ws + WS_RT); RT[e0 * NTOK + p0] = t; RT[e1 * NTOK + p1] = t;
        v4u r0; r0.x = e0; r0.y = e1; r0.z = p0; r0.w = p1; v4u r1; r1.x = __builtin_bit_cast(unsigned, tg[F.tid * 2]); r1.y = __builtin_bit_cast(unsigned, tg[F.tid * 2 + 1]); r1.z = 0; r1.w = 0;
        v4u* RO = (v4u*)(F.ws + WS_ROUTE) + (size_t)t * 2; RO[0] = r0; (void)r1; }
    __syncthreads();
}

struct CombRows { RowVec x; v2u ya[4], yb[4]; };
struct CombRecs { v4u rec; float ga, gb; };
__device__ __forceinline__ CombRecs comb_load_recs(Frame& F, int tokw) { CombRecs c; const int t = tokw + (F.lane & 15);
    c.rec = *((const v4u*)(F.ws + WS_ROUTE) + (size_t)t * 2); const float* GA = (const float*)(F.ws + WS_BG); c.ga = GA[(size_t)t * 2]; c.gb = GA[(size_t)t * 2 + 1]; return c; }
__device__ __forceinline__ int rl_i(int v, int l) { return __builtin_amdgcn_readlane(v, l); }
__device__ __forceinline__ void comb_issue(Frame& F, const CombRecs& c, int i, int t, CombRows& r) {
    const LAS int* T = (const LAS int*)(F.lds + SCHED_OFF);
    const int e0 = rl_i((int)c.rec.x, i), e1 = rl_i((int)c.rec.y, i), p0 = rl_i((int)c.rec.z, i), p1 = rl_i((int)c.rec.w, i);
    const size_t rowa = (size_t)T[32 + e0] * 256 + p0, rowb = (size_t)T[32 + e1] * 256 + p1;
    const bf16* Y = (const bf16*)(F.ws + WS_Y);
    const GAS v2u* ya = (const GAS v2u*)(Y + rowa * D) + F.lane; const GAS v2u* yb = (const GAS v2u*)(Y + rowb * D) + F.lane;
    r.x = load_row_f32(F.out + (size_t)t * D, F.lane);
#pragma unroll
    for (int j = 0; j < 4; ++j) { r.ya[j] = ya[64 * j]; r.yb[j] = yb[64 * j]; }
}
__device__ __forceinline__ RowVec comb_finish(const CombRecs& c, int i, const CombRows& r, const f32x4 (&g2)[4]) {
    const float ga = rl(c.ga, i), gb = rl(c.gb, i); RowVec x = r.x;
#pragma unroll
    for (int j = 0; j < 4; ++j) { const v2u a = r.ya[j], bq = r.yb[j];
        f32x4 s; s.x = ga * bflo(a.x) + gb * bflo(bq.x); s.y = ga * bfhi(a.x) + gb * bfhi(bq.x); s.z = ga * bflo(a.y) + gb * bflo(bq.y); s.w = ga * bfhi(a.y) + gb * bfhi(bq.y);
        x.v[j] += g2[j] * s; }
    return x;
}

__device__ __forceinline__ void attn_phase(Frame& F, const int u_first, const int u_stride) {
    LAS bf16* KS = (LAS bf16*)(F.lds + RING_OFF);
    LAS bf16* VT = (LAS bf16*)(F.lds + RING_OFF + 36864);
    LAS float* BT = (LAS float*)(F.lds + RING_OFF + 36864 + 33280);
    const bf16* PROJ = (const bf16*)(F.ws + WS_PROJ); bf16* OAB = (bf16*)(F.ws + WS_OAB);
    const int lane = F.lane, lc = lane & 31, lh = lane >> 5;
    for (int unit = u_first; unit < 512; unit += u_stride) {
        const int b = unit >> 8, kvh = (unit >> 7) & 1, qb = unit & 127, t0 = qb * 128;
        __syncthreads();
        for (int i = F.tid; i < 4 * 192; i += 512) { const int hq = i / 192, x = i - hq * 192, dist = 159 - x; float v = 0.f;
            if (dist >= 0 && dist < 128) { int bk = dist; if (dist >= 16) { bk = 16 + (int)(logf((float)dist / 16.0f) / 2.0794415416798357f * 16.0f); bk = bk > 31 ? 31 : bk; }
                v = F.in[I_RELB][bk * 8 + kvh * 4 + hq] * 1.4426950408889634f; }
            BT[i] = v; }
#pragma unroll
        for (int cc = 0; cc < 4; ++cc) { const int ch = F.tid + 512 * cc, key = ch >> 3, part = ch & 7, tl = t0 - 128 + key;
            v4u kv = {0u, 0u, 0u, 0u}, vv = {0u, 0u, 0u, 0u};
            if (tl >= 0) { const bf16* rp = PROJ + (size_t)(b * SEQ + tl) * PIN; kv = *(const v4u*)(rp + PC_KB + kvh * 64 + part * 8); vv = *(const v4u*)(rp + PC_VB + kvh * 64 + part * 8); }
            *(LAS v4u*)(KS + key * 72 + part * 8) = kv;
            const unsigned w[4] = {vv.x, vv.y, vv.z, vv.w};
#pragma unroll
            for (int q = 0; q < 4; ++q) { VT[(part * 8 + 2 * q) * 260 + key] = (bf16)(w[q] & 0xffffu); VT[(part * 8 + 2 * q + 1) * 260 + key] = (bf16)(w[q] >> 16); } }
        __syncthreads();
#pragma unroll 1
        for (int tt = 0; tt < 2; ++tt) {
            const int task = F.wave * 2 + tt, hq = task >> 2, qt = task & 3, qh = kvh * 4 + hq;
            const int qi = 32 * qt + lc;
            const bf16* qrow = PROJ + (size_t)(b * SEQ + t0 + qi) * PIN + PC_QB + qh * 64 + 8 * lh;
            bf16x8 qf[4];
#pragma unroll
            for (int s = 0; s < 4; ++s) qf[s] = *(const bf16x8*)(qrow + 16 * s);
            f32x16 sc[5];
#pragma unroll
            for (int kt = 0; kt < 5; ++kt) {
#pragma unroll
                for (int r = 0; r < 16; ++r) sc[kt][r] = 0.f;
                const LAS bf16* kp = KS + (32 * (qt + kt) + lc) * 72 + 8 * lh;
#pragma unroll
                for (int s = 0; s < 4; ++s) { const bf16x8 kf = *(const LAS bf16x8*)(kp + 16 * s); sc[kt] = __builtin_amdgcn_mfma_f32_32x32x16_bf16(kf, qf[s], sc[kt], 0, 0, 0); }
            }
            const float sink2 = F.in[I_SINKS][qh] * 1.4426950408889634f;
            const LAS float* bp = BT + hq * 192 + (4 * lh - lc + 31);
            const int m_lo = lc + 1 - 4 * lh, m_hi = lc - 4 * lh;
            float mx = sink2;
#pragma unroll
            for (int kt = 0; kt < 5; ++kt) {
                const bool dead = (t0 == 0) && (qt + kt < 4);
#pragma unroll
                for (int r = 0; r < 16; ++r) { const int cr = (r & 3) + 8 * (r >> 2);
                    float v = sc[kt][r] * (0.125f * 1.4426950408889634f) + bp[32 * kt + cr];
                    if (kt == 0) v = (cr >= m_lo) ? v : -1e30f;
                    if (kt == 4) v = (cr <= m_hi) ? v : -1e30f;
                    if (dead) v = -1e30f;
                    sc[kt][r] = v; mx = fmaxf(mx, v); } }
            mx = fmaxf(mx, __shfl_xor(mx, 32));
            float den = 0.f;
#pragma unroll
            for (int kt = 0; kt < 5; ++kt)
#pragma unroll
                for (int r = 0; r < 16; ++r) { const float p = __builtin_amdgcn_exp2f(sc[kt][r] - mx); sc[kt][r] = p; den += p; }
            den += __shfl_xor(den, 32);
            den += __builtin_amdgcn_exp2f(sink2 - mx);
            const float inv = 1.0f / den;
            f32x16 oa[2];
#pragma unroll
            for (int dt = 0; dt < 2; ++dt)
#pragma unroll
                for (int r = 0; r < 16; ++r) oa[dt][r] = 0.f;
#pragma unroll
            for (int kt = 0; kt < 5; ++kt)
#pragma unroll
                for (int s2 = 0; s2 < 2; ++s2) {
                    v4u pw; pw.x = pk2(sc[kt][8 * s2 + 0], sc[kt][8 * s2 + 1]); pw.y = pk2(sc[kt][8 * s2 + 2], sc[kt][8 * s2 + 3]); pw.z = pk2(sc[kt][8 * s2 + 4], sc[kt][8 * s2 + 5]); pw.w = pk2(sc[kt][8 * s2 + 6], sc[kt][8 * s2 + 7]);
                    const bf16x8 pf = __builtin_bit_cast(bf16x8, pw);
#pragma unroll
                    for (int dt = 0; dt < 2; ++dt) { const LAS bf16* vp = VT + (32 * dt + lc) * 260 + 32 * (qt + kt) + 16 * s2 + 4 * lh;
                        const v2u va = *(const LAS v2u*)vp, vb = *(const LAS v2u*)(vp + 8);
                        v4u vw; vw.x = va.x; vw.y = va.y; vw.z = vb.x; vw.w = vb.y;
                        oa[dt] = __builtin_amdgcn_mfma_f32_32x32x16_bf16(__builtin_bit_cast(bf16x8, vw), pf, oa[dt], 0, 0, 0); }
                }
            bf16* orow = OAB + (size_t)(b * SEQ + t0 + qi) * D + 512 + qh * 64 + 4 * lh;
#pragma unroll
            for (int dt = 0; dt < 2; ++dt)
#pragma unroll
                for (int rg = 0; rg < 4; ++rg) { v2u o; o.x = pk2(oa[dt][4 * rg] * inv, oa[dt][4 * rg + 1] * inv); o.y = pk2(oa[dt][4 * rg + 2] * inv, oa[dt][4 * rg + 3] * inv);
                    *(v2u*)(orow + 32 * dt + 8 * rg) = o; }
        }
    }
    __syncthreads();
}


constexpr int DN_ST = 72;

__device__ __forceinline__ bf16x8 pack8(const f32x16& x, int s) { v4u p; p.x = pk2(x[8 * s], x[8 * s + 1]); p.y = pk2(x[8 * s + 2], x[8 * s + 3]); p.z = pk2(x[8 * s + 4], x[8 * s + 5]); p.w = pk2(x[8 * s + 6], x[8 * s + 7]); return __builtin_bit_cast(bf16x8, p); }
__device__ __forceinline__ f32x16 dn_tile(const LAS bf16* A, int ra, const LAS bf16* B, int rb, int lc, int lh) {
    f32x16 acc;
#pragma unroll
    for (int r = 0; r < 16; ++r) acc[r] = 0.f;
#pragma unroll
    for (int s = 0; s < 4; ++s) { const bf16x8 a = *(const LAS bf16x8*)(A + (ra + lc) * DN_ST + 16 * s + 8 * lh), b = *(const LAS bf16x8*)(B + (rb + lc) * DN_ST + 16 * s + 8 * lh);
        acc = __builtin_amdgcn_mfma_f32_32x32x16_bf16(a, b, acc, 0, 0, 0); }
    return acc;
}
__device__ __forceinline__ void dn_prep(Frame& F) {
    LAS bf16* Qs = (LAS bf16*)(F.lds + RING_OFF);
    LAS bf16* Ks = Qs + 64 * DN_ST;
    LAS bf16* KBs = Ks + 64 * DN_ST;
    LAS bf16* Vs = KBs + 64 * DN_ST;
    LAS bf16* KDT = Vs + 64 * DN_ST;
    LAS bf16* AQK = KDT + 64 * DN_ST;
    LAS bf16* UT = AQK + 64 * DN_ST;
    LAS bf16* WT = UT + 64 * DN_ST;
    LAS bf16* LNO = WT + 64 * DN_ST;
    LAS float* LD = (LAS float*)(LNO + 64 * DN_ST);
    LAS bf16* TDZ = (LAS bf16*)(LD + 64 * 16);
    LAS float* gcs = (LAS float*)(TDZ + 64 * 24);
    LAS float* bts = gcs + 64;
    const bf16* PROJ = (const bf16*)(F.ws + WS_PROJ); const float* BG = (const float*)(F.ws + WS_BG);
    const int tid = F.tid, lane = F.lane, lc = lane & 31, lh = lane >> 5, wave = F.wave;
    LAS float* CW = bts + 64;
    for (int i = tid; i < 1536; i += 512) *((LAS f32x4*)CW + i) = *((const f32x4*)F.in[I_CONVW] + i);
    for (int unit = F.vcu; unit < 4096; unit += F.G) {
        const int b = unit >> 11, h = (unit >> 8) & 7, n = unit & 255;
        const size_t row0 = (size_t)b * SEQ + (size_t)n * 64;
        __syncthreads();
        if (wave == 0) { const float g = BG[(row0 + lane) * 16 + 8 + h]; float c = g;
#pragma unroll
            for (int o = 1; o < 64; o <<= 1) { const float up = __shfl_up(c, o); if (lane >= o) c += up; }
            gcs[lane] = c; bts[lane] = BG[(row0 + lane) * 16 + h]; }
        __syncthreads();
        { const int t = tid >> 3, cs = tid & 7; const int tl = n * 64 + t;
          float q[8], k[8], v[8];
#pragma unroll
          for (int e = 0; e < 8; ++e) { q[e] = 0.f; k[e] = 0.f; v[e] = 0.f; }
#pragma unroll
          for (int j = 0; j < 4; ++j) { if (tl - 3 + j >= 0) { const bf16* rp = PROJ + (row0 + t - 3 + j) * PIN + h * 64 + cs * 8;
                const v4u wq = *(const v4u*)(rp + PC_QA), wk = *(const v4u*)(rp + PC_KA), wv = *(const v4u*)(rp + PC_VA);
                const LAS float* cw = CW + j * 1536 + h * 64 + cs * 8;
                const unsigned uq[4] = {wq.x, wq.y, wq.z, wq.w}, uk[4] = {wk.x, wk.y, wk.z, wk.w}, uv[4] = {wv.x, wv.y, wv.z, wv.w};
#pragma unroll
                for (int e = 0; e < 4; ++e) { q[2 * e] += cw[2 * e] * bflo(uq[e]); q[2 * e + 1] += cw[2 * e + 1] * bfhi(uq[e]);
                    k[2 * e] += cw[512 + 2 * e] * bflo(uk[e]); k[2 * e + 1] += cw[512 + 2 * e + 1] * bfhi(uk[e]);
                    v[2 * e] += cw[1024 + 2 * e] * bflo(uv[e]); v[2 * e + 1] += cw[1024 + 2 * e + 1] * bfhi(uv[e]); } } }
          float sq = 0.f, sk = 0.f;
#pragma unroll
          for (int e = 0; e < 8; ++e) { q[e] = silu_f(q[e]); k[e] = silu_f(k[e]); v[e] = silu_f(v[e]); sq += q[e] * q[e]; sk += k[e] * k[e]; }
          sq = oct_sum(sq); sk = oct_sum(sk);
          const float rq = 0.125f / sqrtf(sq + EPS), rk = 1.0f / sqrtf(sk + EPS), bt = bts[t], kd = __expf(gcs[63] - gcs[t]);
          v4u oq, ok, ob, ov;
          oq.x = pk2(q[0] * rq, q[1] * rq); oq.y = pk2(q[2] * rq, q[3] * rq); oq.z = pk2(q[4] * rq, q[5] * rq); oq.w = pk2(q[6] * rq, q[7] * rq);
#pragma unroll
          for (int e = 0; e < 8; ++e) k[e] *= rk;
          ok.x = pk2(k[0], k[1]); ok.y = pk2(k[2], k[3]); ok.z = pk2(k[4], k[5]); ok.w = pk2(k[6], k[7]);
          ob.x = pk2(k[0] * bt, k[1] * bt); ob.y = pk2(k[2] * bt, k[3] * bt); ob.z = pk2(k[4] * bt, k[5] * bt); ob.w = pk2(k[6] * bt, k[7] * bt);
          ov.x = pk2(v[0], v[1]); ov.y = pk2(v[2], v[3]); ov.z = pk2(v[4], v[5]); ov.w = pk2(v[6], v[7]);
          *(LAS v4u*)(Qs + t * DN_ST + cs * 8) = oq; *(LAS v4u*)(Ks + t * DN_ST + cs * 8) = ok; *(LAS v4u*)(KBs + t * DN_ST + cs * 8) = ob; *(LAS v4u*)(Vs + t * DN_ST + cs * 8) = ov;
#pragma unroll
          for (int e = 0; e < 8; ++e) KDT[(cs * 8 + e) * DN_ST + t] = (bf16)f2bf(k[e] * kd); }
        __syncthreads();
        { const int it = (wave >> 1) & 1, jt = wave & 1; const bool qk = wave >= 4;
          f32x16 acc;
          if (it >= jt) acc = dn_tile(qk ? Qs : KBs, 32 * it, Ks, 32 * jt, lc, lh);
          const int j = 32 * jt + lc; const float gj = gcs[j];
#pragma unroll
          for (int r = 0; r < 16; ++r) { const int i = 32 * it + (r & 3) + 8 * (r >> 2) + 4 * lh;
              float val = 0.f;
              if (it >= jt) { if (qk ? (i >= j) : (i > j)) val = acc[r] * __expf(gcs[i] - gj); }
              if (qk) AQK[i * DN_ST + j] = (bf16)f2bf(val);
              else { const bool diag = (i >> 4) == (j >> 4); LNO[i * DN_ST + j] = (bf16)f2bf(diag ? 0.f : -val); if (diag) LD[i * 16 + (j & 15)] = val; } } }
        __syncthreads();
        if (wave == 0) { const int bb = lane >> 4, c = lane & 15; float tcol[16];
#pragma unroll
            for (int i = 0; i < 16; ++i) { float v = (i == c) ? 1.f : 0.f;
#pragma unroll
                for (int j4 = 0; j4 < (i + 3) / 4; ++j4) { const f32x4 a = *(const LAS f32x4*)(LD + (16 * bb + i) * 16 + 4 * j4);
#pragma unroll
                    for (int e = 0; e < 4; ++e) if (4 * j4 + e < i) v -= a[e] * tcol[4 * j4 + e]; }
                tcol[i] = v; TDZ[(16 * bb + i) * 24 + c] = (bf16)f2bf(v); } }
        __syncthreads();
        if (wave < 4) {
            const int ct = wave, cc = 32 * (ct & 1) + lc; const bool isw = ct >= 2;
            f32x16 acc[2];
#pragma unroll
            for (int rt = 0; rt < 2; ++rt)
#pragma unroll
                for (int r = 0; r < 16; ++r) { const int t = 32 * rt + (r & 3) + 8 * (r >> 2) + 4 * lh;
                    acc[rt][r] = isw ? bf2f(Ks[t * DN_ST + cc]) * bts[t] * __expf(gcs[t]) : bf2f(Vs[t * DN_ST + cc]) * bts[t]; }
#define DN_AFRAG(arr, stride, row, kb) ({ const LAS bf16* p_ = (arr) + (row) * (stride) + 16 * (kb) + 4 * lh; const v2u lo_ = *(const LAS v2u*)p_, hi_ = *(const LAS v2u*)(p_ + 8); v4u w_; w_.x = lo_.x; w_.y = lo_.y; w_.z = hi_.x; w_.w = hi_.y; __builtin_bit_cast(bf16x8, w_); })
            f32x16 X[4];
#pragma unroll
            for (int bb = 0; bb < 4; ++bb) { const int rt = bb >> 1, odd = bb & 1;
                bf16x8 ta = DN_AFRAG(TDZ, 24, 32 * rt + lc, 0);
                if ((lc >> 4) != odd) ta = (bf16x8){0, 0, 0, 0, 0, 0, 0, 0};
                f32x16 z;
#pragma unroll
                for (int r = 0; r < 16; ++r) z[r] = 0.f;
                z = __builtin_amdgcn_mfma_f32_32x32x16_bf16(ta, pack8(acc[rt], odd), z, 0, 0, 0);
                X[bb] = z;
                const bf16x8 xb = pack8(z, odd);
                if (bb == 0) { acc[0] = __builtin_amdgcn_mfma_f32_32x32x16_bf16(DN_AFRAG(LNO, DN_ST, lc, 0), xb, acc[0], 0, 0, 0); acc[1] = __builtin_amdgcn_mfma_f32_32x32x16_bf16(DN_AFRAG(LNO, DN_ST, 32 + lc, 0), xb, acc[1], 0, 0, 0); }
                if (bb == 1) { acc[1] = __builtin_amdgcn_mfma_f32_32x32x16_bf16(DN_AFRAG(LNO, DN_ST, 32 + lc, 1), xb, acc[1], 0, 0, 0); }
                if (bb == 2) { acc[1] = __builtin_amdgcn_mfma_f32_32x32x16_bf16(DN_AFRAG(LNO, DN_ST, 32 + lc, 2), xb, acc[1], 0, 0, 0); }
            }
#undef DN_AFRAG
            LAS bf16* dst = (isw ? WT : UT) + cc * DN_ST;
#pragma unroll
            for (int bb = 0; bb < 4; ++bb)
#pragma unroll
                for (int g = 0; g < 2; ++g) { const int r0 = 8 * (bb & 1) + 4 * g; v2u o; o.x = pk2(X[bb][r0], X[bb][r0 + 1]); o.y = pk2(X[bb][r0 + 2], X[bb][r0 + 3]);
                    *(LAS v2u*)(dst + 16 * bb + 8 * g + 4 * lh) = o; }
        }
        __syncthreads();
        { bf16* MT = (bf16*)(F.ws + WS_DN_MT) + (size_t)unit * 4096; bf16* QPT = (bf16*)(F.ws + WS_DN_QPT) + (size_t)unit * 4096;
          bf16* BM = (bf16*)(F.ws + WS_DN_BM) + (size_t)unit * 4096; bf16* O0T = (bf16*)(F.ws + WS_DN_O0T) + (size_t)unit * 4096;
#pragma unroll 1
          for (int tt = 0; tt < 2; ++tt) { const int task = wave * 2 + tt, p = task >> 2, ta = (task >> 1) & 1, tb = task & 1;
              if (p == 0) {
                  f32x16 acc = dn_tile(WT, 32 * ta, KDT, 32 * tb, lc, lh);
#pragma unroll
                  for (int r = 0; r < 16; ++r) acc[r] = -acc[r];
#pragma unroll
                  for (int s2 = 0; s2 < 2; ++s2) *(bf16x8*)(MT + ((((tb * 2 + ta) * 2 + s2) * 64 + lane) * 8)) = pack8(acc, s2);
              } else if (p == 1) {
                  const f32x16 acc = dn_tile(KDT, 32 * ta, UT, 32 * tb, lc, lh);
#pragma unroll
                  for (int s2 = 0; s2 < 2; ++s2) *(bf16x8*)(BM + ((((tb * 2 + ta) * 2 + s2) * 64 + lane) * 8)) = pack8(acc, s2);
              } else if (p == 2) {
                  f32x16 acc = dn_tile(WT, 32 * ta, AQK, 32 * tb, lc, lh);
                  const int i = 32 * tb + lc; const float eg = __expf(gcs[i]);
#pragma unroll
                  for (int r = 0; r < 16; ++r) { const int a = 32 * ta + (r & 3) + 8 * (r >> 2) + 4 * lh; acc[r] = bf2f(Qs[i * DN_ST + a]) * eg - acc[r]; }
#pragma unroll
                  for (int s2 = 0; s2 < 2; ++s2) *(bf16x8*)(QPT + ((((tb * 2 + ta) * 2 + s2) * 64 + lane) * 8)) = pack8(acc, s2);
              } else {
                  const f32x16 acc = dn_tile(UT, 32 * ta, AQK, 32 * tb, lc, lh);
#pragma unroll
                  for (int s2 = 0; s2 < 2; ++s2) *(bf16x8*)(O0T + ((((tb * 2 + ta) * 2 + s2) * 64 + lane) * 8)) = pack8(acc, s2);
              } }
          if (tid == 0) ((float*)(F.ws + WS_DN_GT))[unit] = __expf(gcs[63]); }
    }
    __syncthreads();
}
template <int r>
__device__ __forceinline__ void dn_scan_wave(Frame& F) {
    const int w = F.vcu, bh = w >> 1, ct = w & 1, lane = F.lane;
    const bf16x8* MT = (const bf16x8*)(F.ws + WS_DN_MT); const bf16x8* BM = (const bf16x8*)(F.ws + WS_DN_BM); bf16x8* SS = (bf16x8*)(F.ws + WS_DN_S);
    const float* GT = (const float*)(F.ws + WS_DN_GT);
    LAS bf16x8* MB = (LAS bf16x8*)(F.lds + RING_OFF);
    volatile LAS int* FL = (volatile LAS int*)(F.lds + LDSCTL_OFF + 64);
    f32x16 S;
#pragma unroll
    for (int q = 0; q < 16; ++q) S[q] = 0.f;
    bf16x8 mA[4], bA[2], mB[4], bB[2], mC[4], bC[2], mD[4], bD[2], mE[4], bE[2], mG[4], bG[2]; float gA, gB, gC, gD, gE, gG;
#define DN_SLOAD(m, bm, gt, u) do { const size_t ub = (size_t)(u) * 512; _Pragma("unroll") for (int f = 0; f < 4; ++f) m[f] = MT[ub + (r * 4 + f) * 64 + lane]; \
        _Pragma("unroll") for (int f = 0; f < 2; ++f) bm[f] = BM[ub + ((ct * 2 + r) * 2 + f) * 64 + lane]; gt = GT[u]; } while (0)
#define DN_STEP(cm, cb, cg, unit, n) do { \
        bf16x8 own[2]; own[0] = pack8(S, 0); own[1] = pack8(S, 1); \
        LAS bf16x8* mb = MB + ((n) & 1) * 256; \
        mb[(r * 2 + 0) * 64 + lane] = own[0]; mb[(r * 2 + 1) * 64 + lane] = own[1]; \
        asm volatile("s_waitcnt lgkmcnt(0)" ::: "memory"); \
        if (lane == 0) FL[r] = (n) + 1; \
        SS[(size_t)(unit) * 512 + (ct * 4 + r * 2 + 0) * 64 + lane] = own[0]; SS[(size_t)(unit) * 512 + (ct * 4 + r * 2 + 1) * 64 + lane] = own[1]; \
        f32x16 A; \
        { const v4u b0 = __builtin_bit_cast(v4u, cb[0]), b1 = __builtin_bit_cast(v4u, cb[1]); const unsigned u0[8] = {b0.x, b0.y, b0.z, b0.w, b1.x, b1.y, b1.z, b1.w}; \
          _Pragma("unroll") for (int e = 0; e < 8; ++e) { A[2 * e] = cg * S[2 * e] + bflo(u0[e]); A[2 * e + 1] = cg * S[2 * e + 1] + bfhi(u0[e]); } } \
        while (FL[1 - r] < (n) + 1) { } \
        asm volatile("" ::: "memory"); \
        bf16x8 oth[2]; oth[0] = mb[((1 - r) * 2 + 0) * 64 + lane]; oth[1] = mb[((1 - r) * 2 + 1) * 64 + lane]; \
          \
        _Pragma("unroll") for (int s2 = 0; s2 < 2; ++s2) { A = __builtin_amdgcn_mfma_f32_32x32x16_bf16(cm[r * 2 + s2], own[s2], A, 0, 0, 0); A = __builtin_amdgcn_mfma_f32_32x32x16_bf16(cm[(1 - r) * 2 + s2], oth[s2], A, 0, 0, 0); } \
        S = A; } while (0)
    const int u0 = bh * 256;
    DN_SLOAD(mA, bA, gA, u0); DN_SLOAD(mB, bB, gB, u0 + 1); DN_SLOAD(mC, bC, gC, u0 + 2); DN_SLOAD(mD, bD, gD, u0 + 3); DN_SLOAD(mE, bE, gE, u0 + 4); DN_SLOAD(mG, bG, gG, u0 + 5);
    for (int n = 0; n < 252; n += 6) {
        DN_STEP(mA, bA, gA, u0 + n, n);         DN_SLOAD(mA, bA, gA, u0 + n + 6);
        DN_STEP(mB, bB, gB, u0 + n + 1, n + 1); DN_SLOAD(mB, bB, gB, u0 + n + 7);
        DN_STEP(mC, bC, gC, u0 + n + 2, n + 2); DN_SLOAD(mC, bC, gC, u0 + n + 8);
        DN_STEP(mD, bD, gD, u0 + n + 3, n + 3); DN_SLOAD(mD, bD, gD, u0 + n + 9);
        DN_STEP(mE, bE, gE, u0 + n + 4, n + 4); if (n + 10 < 256) DN_SLOAD(mE, bE, gE, u0 + n + 10);
        DN_STEP(mG, bG, gG, u0 + n + 5, n + 5); if (n + 11 < 256) DN_SLOAD(mG, bG, gG, u0 + n + 11);
    }
    DN_STEP(mA, bA, gA, u0 + 252, 252); DN_STEP(mB, bB, gB, u0 + 253, 253); DN_STEP(mC, bC, gC, u0 + 254, 254); DN_STEP(mD, bD, gD, u0 + 255, 255);
#undef DN_SLOAD
#undef DN_STEP
}
__device__ __forceinline__ void dn_scan(Frame& F) {
    if (F.vcu >= 32) return;
    if (F.wave == 0) dn_scan_wave<0>(F); else if (F.wave == 1) dn_scan_wave<1>(F);
}
__device__ __forceinline__ void dn_output(Frame& F) {
    const bf16x8* QPT = (const bf16x8*)(F.ws + WS_DN_QPT); const bf16x8* O0T = (const bf16x8*)(F.ws + WS_DN_O0T); const bf16x8* SS = (const bf16x8*)(F.ws + WS_DN_S);
    const bf16* PROJ = (const bf16*)(F.ws + WS_PROJ); bf16* OAB = (bf16*)(F.ws + WS_OAB);
    const int lane = F.lane, lc = lane & 31, lh = lane >> 5; int nbad = 0; (void)nbad;
    for (int task = F.vcu * NWAVES + F.wave; task < 8192; task += F.G * NWAVES) {
        const int unit = task >> 1, it = task & 1, b = unit >> 11, h = (unit >> 8) & 7, n = unit & 255;
        const size_t ub = (size_t)unit * 512;
        f32x16 o[2];
#pragma unroll
        for (int ct = 0; ct < 2; ++ct) {
            const v4u c0 = __builtin_bit_cast(v4u, O0T[ub + ((it * 2 + ct) * 2 + 0) * 64 + lane]), c1 = __builtin_bit_cast(v4u, O0T[ub + ((it * 2 + ct) * 2 + 1) * 64 + lane]);
            const unsigned u[8] = {c0.x, c0.y, c0.z, c0.w, c1.x, c1.y, c1.z, c1.w};
#pragma unroll
            for (int e = 0; e < 8; ++e) { o[ct][2 * e] = bflo(u[e]); o[ct][2 * e + 1] = bfhi(u[e]); }
#pragma unroll
            for (int at = 0; at < 2; ++at)
#pragma unroll
                for (int s2 = 0; s2 < 2; ++s2) o[ct] = __builtin_amdgcn_mfma_f32_32x32x16_bf16(SS[ub + (ct * 4 + at * 2 + s2) * 64 + lane], QPT[ub + ((it * 2 + at) * 2 + s2) * 64 + lane], o[ct], 0, 0, 0);
        }
        float ss = 0.f;
#pragma unroll
        for (int ct = 0; ct < 2; ++ct)
#pragma unroll
            for (int r = 0; r < 16; ++r) ss += o[ct][r] * o[ct][r];
        ss += __shfl_xor(ss, 32);
        const float rs = 1.0f / sqrtf(ss * (1.0f / 64.0f) + EPS);
        const size_t row = (size_t)b * SEQ + (size_t)n * 64 + it * 32 + lc;
#pragma unroll
        for (int ct = 0; ct < 2; ++ct)
#pragma unroll
            for (int rg = 0; rg < 4; ++rg) { const int c0 = 32 * ct + 8 * rg + 4 * lh;
                const v2u zz = *(const v2u*)(PROJ + row * PIN + PC_ZA + h * 64 + c0); const f32x4 ow = *(const f32x4*)(F.in[I_ONORM] + c0);
                const float z0 = bflo(zz.x), z1 = bfhi(zz.x), z2 = bflo(zz.y), z3 = bfhi(zz.y);
                v2u ov; ov.x = pk2(o[ct][4 * rg] * rs * ow[0] * silu_f(z0), o[ct][4 * rg + 1] * rs * ow[1] * silu_f(z1)); ov.y = pk2(o[ct][4 * rg + 2] * rs * ow[2] * silu_f(z2), o[ct][4 * rg + 3] * rs * ow[3] * silu_f(z3));
                *(v2u*)(OAB + row * D + h * 64 + c0) = ov;
            }
    }
}

template <int WIN>
__device__ __forceinline__ void pooled_block(const bf16* H, bf16* P, const int t0, const int tl0, const int col) {
    v4u r[WIN - 1 + 8];
#pragma unroll
    for (int j = 0; j < WIN - 1 + 8; ++j) { const int dt = j - (WIN - 1); r[j] = (v4u){0u, 0u, 0u, 0u}; if (tl0 + dt >= 0) r[j] = *(const v4u*)(H + (size_t)(t0 + dt) * D + col); }
    float s[8];
#pragma unroll
    for (int q = 0; q < 8; ++q) s[q] = 0.f;
#define POOL_ACC(sgn, VV) do { const v4u q_ = (VV); s[0] += sgn bflo(q_.x); s[1] += sgn bfhi(q_.x); s[2] += sgn bflo(q_.y); s[3] += sgn bfhi(q_.y); s[4] += sgn bflo(q_.z); s[5] += sgn bfhi(q_.z); s[6] += sgn bflo(q_.w); s[7] += sgn bfhi(q_.w); } while (0)
#pragma unroll
    for (int j = 0; j < WIN - 1; ++j) POOL_ACC(+, r[j]);
#pragma unroll
    for (int i = 0; i < 8; ++i) { const v4u self = r[WIN - 1 + i]; POOL_ACC(+, self);
        const int n = (tl0 + i + 1) < WIN ? (tl0 + i + 1) : WIN; const float inv = 1.0f / (float)n;
        v4u o; o.x = pk2(s[0] * inv - bflo(self.x), s[1] * inv - bfhi(self.x)); o.y = pk2(s[2] * inv - bflo(self.y), s[3] * inv - bfhi(self.y));
        o.z = pk2(s[4] * inv - bflo(self.z), s[5] * inv - bfhi(self.z)); o.w = pk2(s[6] * inv - bflo(self.w), s[7] * inv - bfhi(self.w));
        *(v4u*)(P + (size_t)(t0 + i) * D + col) = o;
        POOL_ACC(-, r[i]); }
#undef POOL_ACC
}
__device__ __forceinline__ void pooled_phase(Frame& F) {
    const bf16* H = (const bf16*)(F.ws + WS_H); bf16* P = (bf16*)(F.ws + WS_OAB);
    const int gt = F.vcu * 512 + F.tid, NT = F.G * 512;
    for (int it = gt; it < (NTOK / 8) * 128; it += NT) {
        const int c = it & 31, g = __builtin_amdgcn_readfirstlane((it >> 6) & 3), tb = ((it >> 8) << 1) | ((it >> 5) & 1);
        const int t0 = tb * 8, tl0 = t0 & (SEQ - 1), col = g * 256 + c * 8;
        if (g == 0) pooled_block<2>(H, P, t0, tl0, col); else if (g == 1) pooled_block<4>(H, P, t0, tl0, col); else if (g == 2) pooled_block<8>(H, P, t0, tl0, col); else pooled_block<16>(H, P, t0, tl0, col);
    }
}


#ifndef PH_MASK
#define PH_MASK 0xFFFFFF
#endif
#define IN(k) (((PH_MASK >> (k)) & 1) && lo <= (k) && (k) < hi)
#define BOTH(k) (IN(k) && IN((k) + 1))
#if MK_ONE_LAUNCH
#define GRID_BAR() xcd_barrier(bar)
#else
#define GRID_BAR() do { } while (0)
#endif
template <int LAYER>
__device__ __forceinline__ void moe_phases(Frame& F, const XcdBarrier& bar, const int lo, const int hi) {
    constexpr int pb = LAYER == 0 ? 7 : 13;
    bf16* const H = (bf16*)(F.ws + WS_H);
    const float* const MOD = (const float*)(F.ws + WS_MOD);
    if (IN(pb)) {
        moe_route(F, LAYER); if (BOTH(pb)) GRID_BAR(); }
    if (IN(pb + 1)) {
        build_moe_tables(F, LAYER);
        pg8::Gemm g{(const bf16*)H, 1024, 1024}; MoeSched S; S.init((const LAS int*)(F.lds + SCHED_OFF), F.G, (int)blockIdx.x, (const int*)(F.ws + WS_RT), F.ws + WS_WGU, 1024, 1024);
        EpiSwiglu E{(bf16*)(F.ws + WS_ACT)};
        pg8::gemm_phase<EpiSwiglu, MoeSched>(F.lds + RING_OFF, g, S, E);
        if (BOTH(pb + 1)) GRID_BAR();
    }
    if (IN(pb + 2)) {
        build_moe_tables(F, LAYER);
        pg8::Gemm g{(const bf16*)(F.ws + WS_ACT), 512, 512}; MoeSched S; S.init((const LAS int*)(F.lds + SCHED_OFF), F.G, (int)blockIdx.x, nullptr, F.ws + WS_WD, 512, 512);
        EpiStoreBf16 E{(bf16*)(F.ws + WS_Y), D};
        pg8::gemm_phase<EpiStoreBf16, MoeSched>(F.lds + RING_OFF, g, S, E);
        if (BOTH(pb + 2)) GRID_BAR();
    }
    if (IN(pb + 3)) {
        build_moe_tables(F, LAYER);
        const int tokw = F.vcu * 128 + F.wave * 16, b = (F.vcu * 128) / SEQ;
        f32x4 g2[4];
#pragma unroll
        for (int j = 0; j < 4; ++j) g2[j] = *((const f32x4*)(MOD + (size_t)(LAYER * 2 + b) * 6144 + 5 * 1024) + F.lane + 64 * j);
        if (LAYER == 0) {
            const ModVec m1 = load_mod(F.in[I_NMIX] + D, MOD + (size_t)(2 + b) * 6144 + 1024, MOD + (size_t)(2 + b) * 6144, F.lane);
            { const CombRecs recs = comb_load_recs(F, tokw); CombRows cur, nxt; comb_issue(F, recs, 0, tokw, cur);
              for (int i = 0; i < 16; ++i) { const int t = tokw + i;
                  if (i + 1 < 16) comb_issue(F, recs, i + 1, t + 1, nxt);
                  const RowVec x = comb_finish(recs, i, cur, g2);
                  store_row_f32(F.out + (size_t)t * D, F.lane, x); store_row_bf16(H + (size_t)t * D, F.lane, apply_mod(x, row_rstd(x), m1));
                  cur = nxt; } }
            __syncthreads();
            convert_moe_weights(F, 1, F.vcu, F.G);
        } else {
            f32x4 fw[4];
#pragma unroll
            for (int j = 0; j < 4; ++j) fw[j] = *((const f32x4*)F.in[I_FNW] + F.lane + 64 * j);
            { const CombRecs recs = comb_load_recs(F, tokw); CombRows cur, nxt; comb_issue(F, recs, 0, tokw, cur);
              for (int i = 0; i < 16; ++i) { const int t = tokw + i;
                  if (i + 1 < 16) comb_issue(F, recs, i + 1, t + 1, nxt);
                  RowVec x = comb_finish(recs, i, cur, g2); const float rstd = row_rstd(x);
#pragma unroll
                  for (int j = 0; j < 4; ++j) x.v[j] = x.v[j] * rstd * fw[j];
                  store_row_f32(F.out + (size_t)t * D, F.lane, x);
                  cur = nxt; } }
        }
        if (BOTH(pb + 3)) GRID_BAR();
    }
}

constexpr int PH_P0 = 0, PH_P1 = 1, PH_INPROJ = 2, PH_ATT = 3, PH_SCAN = 4, PH_DNOUT = 5, PH_OUTPROJ = 6, PH_MOE0 = 7, PH_POOLED = 11, PH_POOLG = 12, PH_MOE1 = 13;
constexpr int N_PHASES = 17;
struct Args { const float* in[24]; float* out; unsigned char* ws; int ph_lo, ph_hi; };
__global__ void __launch_bounds__(NWAVES * 64, 2) trunk_fwd(Args args) {
    __shared__ __attribute__((aligned(16))) unsigned char lds[LDS_BYTES];
    Frame F;
    F.lds = (LAS unsigned char*)lds;
    F.MISC = (volatile LAS unsigned*)(F.lds + MISC_OFF);
    F.tid = threadIdx.x; F.lane = F.tid & 63; F.wave = __builtin_amdgcn_readfirstlane(F.tid >> 6);
    F.G = gridDim.x; { const int bx = blockIdx.x; F.vcu = (F.G % 8 == 0) ? (bx % 8) * (F.G / 8) + bx / 8 : bx; }
#pragma unroll
    for (int i = 0; i < 24; ++i) F.in[i] = args.in[i];
    F.out = args.out; F.ws = args.ws; F.ctl = (gu32*)(args.ws + WS_CTL);
    for (int u = F.tid; u < (LDS_BYTES - LDSCTL_OFF) / 4; u += NWAVES * 64) ((LAS unsigned*)(F.lds + LDSCTL_OFF))[u] = 0u;
    __syncthreads();
#if MK_ONE_LAUNCH
    XcdBarrier bar = xcd_barrier_post((unsigned*)(F.ctl + CW_BAR), F.MISC + 8);
#else
    XcdBarrier bar; bar.bar = nullptr; bar.x = 0; bar.st = nullptr;
#endif
    const int lo = args.ph_lo, hi = args.ph_hi;
    bf16* const H = (bf16*)(F.ws + WS_H);
    const float* const MOD = (const float*)(F.ws + WS_MOD);

    if (IN(PH_P0)) { p0_prologue(F); if (BOTH(PH_P0)) GRID_BAR(); }
    if (IN(PH_P1)) { p1_prenorm0(F); if (BOTH(PH_P1)) GRID_BAR(); }
    if (IN(PH_INPROJ)) {
        pg8::Gemm g{(const bf16*)H, 1024, 1024}; DenseSched S; S.init(NTOK, PIN, F.G, (int)blockIdx.x, 1024, 0, F.ws + WS_WIN, 1024);
        EpiStoreBf16 E{(bf16*)(F.ws + WS_PROJ), PIN};
        pg8::gemm_phase<EpiStoreBf16, DenseSched>(F.lds + RING_OFF, g, S, E);
        if (BOTH(PH_INPROJ)) GRID_BAR();
    }
    if (IN(PH_ATT)) { dn_prep(F); if (BOTH(PH_ATT)) GRID_BAR(); }
    if (IN(PH_SCAN)) {
        if (F.vcu < 32) dn_scan(F);
        else { attn_phase(F, F.vcu - 32, F.G - 32); __syncthreads(); convert_moe_weights(F, 0, F.vcu - 32, F.G - 32); }
        if (BOTH(PH_SCAN)) GRID_BAR(); }
    if (IN(PH_DNOUT)) { dn_output(F); if (BOTH(PH_DNOUT)) GRID_BAR(); }
    if (IN(PH_OUTPROJ)) {
        pg8::Gemm g{(const bf16*)(F.ws + WS_OAB), 1024, 1024}; DenseSched S; S.init(NTOK, D, F.G, (int)blockIdx.x, 1024, 0, F.ws + WS_WOUT, 1024);
        EpiStoreBf16 E{(bf16*)(F.ws + WS_YM), D};
        pg8::gemm_phase<EpiStoreBf16, DenseSched>(F.lds + RING_OFF, g, S, E);
        if (BOTH(PH_OUTPROJ)) GRID_BAR();
    }
    moe_phases<0>(F, bar, lo, hi);
    if (IN(PH_POOLED)) { pooled_phase(F); if (BOTH(PH_POOLED)) GRID_BAR(); }
    if (IN(PH_POOLG)) {
        pg8::Gemm g{(const bf16*)(F.ws + WS_OAB), 256, 256}; DenseSched S; S.init(NTOK, D, F.G, (int)blockIdx.x, 1024, 256, F.ws + WS_POOLW, 256);
        EpiStoreBf16 E{(bf16*)(F.ws + WS_YM), D};
        pg8::gemm_phase<EpiStoreBf16, DenseSched>(F.lds + RING_OFF, g, S, E);
        if (BOTH(PH_POOLG)) GRID_BAR();
    }
    moe_phases<1>(F, bar, lo, hi);
#undef IN
#undef BOTH
}

extern "C" void kernel_launch(void* const* d_in, const int* in_sizes, int n_in, void* d_out, int out_size, void* d_ws, size_t ws_size, hipStream_t stream) {
    static int grid = 0;
    if (grid == 0) {
        if (n_in != 24 || in_sizes[0] != NTOK * D || out_size != NTOK * D || ws_size < WS_END2) { fprintf(stderr, "kernel_launch: unexpected shapes (n_in %d, in0 %d, out %d, ws %zu); nothing launched\n", n_in, n_in > 0 ? in_sizes[0] : -1, out_size, ws_size); grid = -1; return; }
        int per_cu = 0;
        if (hipOccupancyMaxActiveBlocksPerMultiprocessor(&per_cu, (const void*)trunk_fwd, NWAVES * 64, 0) != hipSuccess || per_cu < 1) fprintf(stderr, "kernel_launch: occupancy query says %d\n", per_cu);
        (void)hipGetLastError();
        grid = 256;
    }
    if (grid < 0) return;
    if (hipMemsetAsync((char*)d_ws + WS_CTL, 0, CTL_ZERO_BYTES, stream) != hipSuccess) { fprintf(stderr, "kernel_launch: memset failed\n"); return; }
    Args a{};
    for (int i = 0; i < 24; ++i) a.in[i] = (const float*)d_in[i];
    a.out = (float*)d_out; a.ws = (unsigned char*)d_ws;
#if MK_ONE_LAUNCH
    a.ph_lo = 0; a.ph_hi = N_PHASES;
    hipLaunchKernelGGL(trunk_fwd, dim3(grid), dim3(NWAVES * 64), 0, stream, a);
#else
    for (int p = 0; p < N_PHASES; ++p) { a.ph_lo = p; a.ph_hi = p + 1; hipLaunchKernelGGL(trunk_fwd, dim3(grid), dim3(NWAVES * 64), 0, stream, a); }
#endif
}
```

```cpp
#include <hip/hip_runtime.h>
#include <cstdio>
#include <cstdint>

#ifndef MK_ONE_LAUNCH
#define MK_ONE_LAUNCH 1
#endif

#define GAS __attribute__((address_space(1)))
#define LAS __attribute__((address_space(3)))
typedef unsigned short bf16;
typedef unsigned v4u __attribute__((ext_vector_type(4)));
typedef unsigned v2u __attribute__((ext_vector_type(2)));
typedef float f32x4 __attribute__((ext_vector_type(4)));
typedef float f32x2 __attribute__((ext_vector_type(2)));
typedef float f32x16 __attribute__((ext_vector_type(16)));
typedef short bf16x8 __attribute__((ext_vector_type(8)));
typedef GAS unsigned gu32;
#define RLX_AGENT __ATOMIC_RELAXED, __HIP_MEMORY_SCOPE_AGENT
#define LDS_WAIT() asm volatile("s_waitcnt lgkmcnt(0)" ::: "memory")
#define VM_WAIT() asm volatile("s_waitcnt vmcnt(0)" ::: "memory")

constexpr int BATCH = 2, SEQ = 16384, D = 1024, NTOK = BATCH * SEQ;
constexpr int PIN = 2816;
constexpr int PC_QA = 0, PC_KA = 512, PC_VA = 1024, PC_ZA = 1536, PC_QB = 2048, PC_KB = 2560, PC_VB = 2688;
constexpr int NEXP = 32, DFF = 512;
constexpr int MAXTILES = NTOK * 2 / 256 + NEXP;
constexpr float EPS = 1e-6f;
constexpr int NWAVES = 8;

constexpr size_t MiB = 1u << 20;
constexpr size_t WS_CTL = 0, CTL_ZERO_BYTES = 1 * MiB;
constexpr size_t WS_MOD = 1 * MiB;
constexpr size_t WS_WBA = 1 * MiB + 128 * 1024;
constexpr size_t WS_ROUTE = 2 * MiB;
constexpr size_t WS_RT = 3 * MiB;
constexpr size_t WS_BG = 7 * MiB;
constexpr size_t WS_WIN = 10 * MiB;
constexpr size_t WS_WOUT = 16 * MiB;
constexpr size_t WS_POOLW = 18 * MiB;
constexpr size_t WS_WGU = 20 * MiB;
constexpr size_t WS_WD = 84 * MiB;
constexpr size_t WS_H = 116 * MiB;
constexpr size_t WS_PROJ = 180 * MiB;
constexpr size_t WS_OAB = 356 * MiB;
constexpr size_t WS_YM = 180 * MiB;
constexpr size_t WS_ACT = 180 * MiB;
constexpr size_t WS_Y = 252 * MiB;
constexpr size_t WS_END = 420 * MiB;
constexpr size_t WS_DN_MT = WS_H;
constexpr size_t WS_DN_QPT = WS_H + 32 * MiB;
constexpr size_t WS_DN_BM = 420 * MiB, WS_DN_O0T = 452 * MiB, WS_DN_S = 484 * MiB;
constexpr size_t WS_DN_GT = 9 * MiB;
constexpr size_t WS_XRB = 420 * MiB;
constexpr size_t WS_END2 = 516 * MiB;
constexpr int CW_CNT = 64;
constexpr int CW_BAR = 4096;
constexpr int CW_BAD = 200;

constexpr int RING_OFF = 0, RING_BYTES = 131072;
constexpr int LDSCTL_OFF = RING_BYTES, MISC_OFF = LDSCTL_OFF + 320;
constexpr int SCHED_OFF = LDSCTL_OFF + 1024;
constexpr int LDS_BYTES = 163840;
constexpr int R1W_OFF = 135168;
constexpr int RT_LDS_OFF = 151552;

typedef __bf16 bf16x2_t __attribute__((ext_vector_type(2)));
__device__ __forceinline__ unsigned pk2(float lo, float hi) { bf16x2_t v; v.x = (__bf16)lo; v.y = (__bf16)hi; return __builtin_bit_cast(unsigned, v); }
__device__ __forceinline__ unsigned f2bf(float f) { return pk2(f, 0.f) & 0xffffu; }
__device__ __forceinline__ float bf2f(unsigned b) { return __builtin_bit_cast(float, b << 16); }
__device__ __forceinline__ float bflo(unsigned w) { return __builtin_bit_cast(float, w << 16); }
__device__ __forceinline__ float bfhi(unsigned w) { return __builtin_bit_cast(float, w & 0xffff0000u); }
template <int CTRL> __device__ __forceinline__ float dpp_f(float v) { return __builtin_bit_cast(float, __builtin_amdgcn_update_dpp(0, __builtin_bit_cast(int, v), CTRL, 0xf, 0xf, false)); }
__device__ __forceinline__ float quad_sum(float v) { v += dpp_f<0xB1>(v); v += dpp_f<0x4E>(v); return v; }
__device__ __forceinline__ float oct_sum(float v) { v = quad_sum(v); v += dpp_f<0x141>(v); return v; }
__device__ __forceinline__ float wave_sum(float v) {
    v = oct_sum(v); v += dpp_f<0x140>(v);
    const float r0 = __builtin_bit_cast(float, __builtin_amdgcn_readlane(__builtin_bit_cast(int, v), 0)), r1 = __builtin_bit_cast(float, __builtin_amdgcn_readlane(__builtin_bit_cast(int, v), 16));
    const float r2 = __builtin_bit_cast(float, __builtin_amdgcn_readlane(__builtin_bit_cast(int, v), 32)), r3 = __builtin_bit_cast(float, __builtin_amdgcn_readlane(__builtin_bit_cast(int, v), 48));
    return (r0 + r1) + (r2 + r3);
}
__device__ __forceinline__ float rl(float x, int l) { return __builtin_bit_cast(float, __builtin_amdgcn_readlane(__builtin_bit_cast(int, x), l)); }
__device__ __forceinline__ float silu_f(float x) { return x / (1.f + __expf(-x)); }
__device__ __forceinline__ float sigmoid_f(float x) { return 1.f / (1.f + __expf(-x)); }
__device__ __forceinline__ float softplus_f(float x) { return x > 20.f ? x : log1pf(__expf(x)); }

namespace pg8 {
#define PG8_LAS __attribute__((address_space(3)))
typedef unsigned short bf16_t;
typedef unsigned u32x4 __attribute__((ext_vector_type(4)));
constexpr int BM = 256, BK = 64, HALF = 128, HTB = HALF * BK * 2, STAGE_BYTES = 8 * HTB;

__host__ __device__ __forceinline__ int lds_byte(int r, int c) { const int st = (r >> 4) * 2 + (c >> 5), rr = r & 15, cc = c & 31, ob = rr * 64 + cc * 2; return st * 1024 + (ob ^ (((ob >> 9) & 1) << 5)); }
__host__ __device__ __forceinline__ void stage_rc(int b, int& R, int& C) { const int st = b / 1024, sb = b % 1024, swz = sb ^ (((sb >> 9) & 1) << 5); R = (st >> 1) * 16 + swz / 64; C = (st & 1) * 32 + (swz % 64) / 2; }
__host__ __device__ __forceinline__ int perm32(int rho) { const int n = rho >> 4, i = rho & 15; return 8 * (i >> 2) + 4 * n + (i & 3); }

struct Unit { int pm, pn, e; };
struct Gemm { const bf16_t* A; int K, ldb; };

template <class Epi, class Sched>
__device__ __forceinline__ void gemm_phase(PG8_LAS unsigned char* lds, const Gemm g, const Sched& S, const Epi& E) {
    const int tid = threadIdx.x, wid = __builtin_amdgcn_readfirstlane(tid >> 6), lane = tid & 63, wr = wid >> 2, wc = wid & 3, fr = lane & 15, fq = lane >> 4;
    const int K = g.K, nt = K / BK;
    int R0, C0, R1, C1; stage_rc(tid * 16, R0, C0); stage_rc(tid * 16 + 8192, R1, C1);
    const int Rb0 = (R0 & ~31) + perm32(R0 & 31), Rb1 = (R1 & ~31) + perm32(R1 & 31);
    const unsigned voffB0 = (unsigned)(Rb0 * g.ldb + C0) * 2u, voffB1 = (unsigned)(Rb1 * g.ldb + C1) * 2u;
    const size_t kstep = (size_t)(BK * 2);
    const size_t hstepB = (size_t)HALF * g.ldb * 2;
    const unsigned ldsw = (unsigned)wid * 1024u;
    const int aoff = lds_byte(wr * 64 + fr, fq * 8), boff = lds_byte(wc * 32 + fr, fq * 8);
    const char* Ab = (const char*)g.A;
#define PG8_SA(b, h) (((b) * 2 + (h)) * HTB)
#define PG8_SB(b, h) ((4 + (b) * 2 + (h)) * HTB)
#define PG8_ST2(bufoff, gbase, v0, v1) do { \
        __builtin_amdgcn_global_load_lds((const unsigned*)((const char*)(gbase) + (v0)), (PG8_LAS unsigned*)(lds + (bufoff) + ldsw), 16, 0, 0); \
        __builtin_amdgcn_global_load_lds((const unsigned*)((const char*)(gbase) + (v1)), (PG8_LAS unsigned*)(lds + (bufoff) + ldsw + 8192), 16, 0, 0); } while (0)
#define PG8_STB(bufoff, gbase) PG8_ST2(bufoff, gbase, voffB0, voffB1)
#define PG8_LDA(dst, b, h) do { _Pragma("unroll") for (int m = 0; m < 4; ++m) _Pragma("unroll") for (int k = 0; k < 2; ++k) dst[m][k] = *(const PG8_LAS bf16x8*)(lds + PG8_SA(b, h) + aoff + m * 2048 + k * 1024); } while (0)
#define PG8_LDB(dst, b, h) do { _Pragma("unroll") for (int n = 0; n < 2; ++n) _Pragma("unroll") for (int k = 0; k < 2; ++k) dst[n][k] = *(const PG8_LAS bf16x8*)(lds + PG8_SB(b, h) + boff + n * 2048 + k * 1024); } while (0)
#define PG8_MMA(ai, bj, At, Bt) do { __builtin_amdgcn_s_setprio(1); _Pragma("unroll") for (int m = 0; m < 4; ++m) _Pragma("unroll") for (int n = 0; n < 2; ++n) _Pragma("unroll") for (int k = 0; k < 2; ++k) \
        acc[ai][bj][m][n] = __builtin_amdgcn_mfma_f32_16x16x32_bf16(Bt[n][k], At[m][k], acc[ai][bj][m][n], 0, 0, 0); __builtin_amdgcn_s_setprio(0); } while (0)
#define PG8_WAIT_V(n) asm volatile("s_waitcnt vmcnt(" #n ")" ::: "memory")
#define PG8_WAIT_L(n) asm volatile("s_waitcnt lgkmcnt(" #n ")" ::: "memory")
#define PG8_BAR __builtin_amdgcn_s_barrier()
#define PG8_SCHED __builtin_amdgcn_sched_barrier(0)
    Unit cur, nxt; int ui = 0;
    if (!S.next(0, cur)) return;
    f32x4 acc[2][2][4][2];
#pragma unroll
    for (int a = 0; a < 2; ++a)
#pragma unroll
        for (int b = 0; b < 2; ++b)
#pragma unroll
            for (int m = 0; m < 4; ++m)
#pragma unroll
                for (int n = 0; n < 2; ++n) acc[a][b][m][n] = (f32x4){0.f, 0.f, 0.f, 0.f};
    bf16x8 At[4][2], B0[2][2], B1[2][2];
    unsigned c00, c01, c10, c11;
#define PG8_AOFF(u, d00, d01, d10, d11) do { \
        d00 = S.a_off(u, R0) + (unsigned)C0 * 2u; d01 = S.a_off(u, R1) + (unsigned)C1 * 2u; \
        d10 = S.a_off(u, HALF + R0) + (unsigned)C0 * 2u; d11 = S.a_off(u, HALF + R1) + (unsigned)C1 * 2u; } while (0)
    PG8_AOFF(cur, c00, c01, c10, c11);
    const char* cB = S.b_ptr(cur);
    PG8_STB(PG8_SB(0, 0), cB); PG8_STB(PG8_SB(0, 1), cB + hstepB); PG8_ST2(PG8_SA(0, 0), Ab, c00, c01); PG8_ST2(PG8_SA(0, 1), Ab, c10, c11);
    if (wr == 1) PG8_BAR;
    PG8_WAIT_V(2); PG8_BAR;
    PG8_STB(PG8_SB(1, 0), cB + kstep); PG8_ST2(PG8_SA(1, 0), Ab + kstep, c00, c01); PG8_STB(PG8_SB(1, 1), cB + hstepB + kstep);
    PG8_WAIT_V(6); PG8_BAR;
    for (;;) {
        const bool has_next = S.next(ui + 1, nxt);
        const char* nB = has_next ? S.b_ptr(nxt) : cB;
#pragma unroll 1
        for (int t = 0; t < nt; t += 2) {
            const bool last = (t == nt - 2);
            const char* a1 = Ab + (size_t)(t + 1) * kstep;
            const char* a2 = last ? Ab : Ab + (size_t)(t + 2) * kstep; const char* b2 = last ? nB : cB + (size_t)(t + 2) * kstep;
            const char* a3 = a2 + kstep; const char* b3 = b2 + kstep;
            PG8_LDB(B0, 0, 0); PG8_LDB(B1, 0, 1); PG8_SCHED; PG8_LDA(At, 0, 0); PG8_ST2(PG8_SA(1, 1), a1, c10, c11);
            PG8_WAIT_V(8); PG8_WAIT_L(0); PG8_BAR; PG8_MMA(0, 0, At, B0); PG8_MMA(0, 1, At, B1); PG8_BAR; PG8_SCHED;
            if (last && has_next) { PG8_AOFF(nxt, c00, c01, c10, c11); }
            PG8_LDA(At, 0, 1); PG8_STB(PG8_SB(0, 0), b2); PG8_STB(PG8_SB(0, 1), b2 + hstepB); PG8_ST2(PG8_SA(0, 0), a2, c00, c01);
            PG8_WAIT_V(8); PG8_WAIT_L(0); PG8_BAR; PG8_MMA(1, 0, At, B0); PG8_MMA(1, 1, At, B1); PG8_BAR; PG8_SCHED;
            PG8_LDB(B0, 1, 0); PG8_LDB(B1, 1, 1); PG8_SCHED; PG8_LDA(At, 1, 0); PG8_ST2(PG8_SA(0, 1), a2, c10, c11);
            PG8_WAIT_V(8); PG8_WAIT_L(0); PG8_BAR; PG8_MMA(0, 0, At, B0); PG8_MMA(0, 1, At, B1); PG8_BAR; PG8_SCHED;
            PG8_LDA(At, 1, 1); PG8_STB(PG8_SB(1, 0), b3); PG8_STB(PG8_SB(1, 1), b3 + hstepB); PG8_ST2(PG8_SA(1, 0), a3, c00, c01);
            PG8_WAIT_V(8); PG8_WAIT_L(0); PG8_BAR; PG8_MMA(1, 0, At, B0); PG8_MMA(1, 1, At, B1); PG8_BAR; PG8_SCHED;
        }
        if (wr == 0) PG8_BAR;
        E(acc, cur, wr, wc, fr, fq);
        if (!has_next) break;
#pragma unroll
        for (int a = 0; a < 2; ++a)
#pragma unroll
            for (int b = 0; b < 2; ++b)
#pragma unroll
                for (int m = 0; m < 4; ++m)
#pragma unroll
                    for (int n = 0; n < 2; ++n) acc[a][b][m][n] = (f32x4){0.f, 0.f, 0.f, 0.f};
        cur = nxt; cB = nB; ++ui;
        if (wr == 1) PG8_BAR;
    }
    PG8_WAIT_V(0);
    PG8_BAR;
#undef PG8_SA
#undef PG8_SB
#undef PG8_ST2
#undef PG8_STB
#undef PG8_LDA
#undef PG8_LDB
#undef PG8_MMA
#undef PG8_WAIT_V
#undef PG8_WAIT_L
#undef PG8_BAR
#undef PG8_SCHED
#undef PG8_AOFF
}
}

#define XB_TMO      128
#define XB_XCNT(j)  (256  + 64 * (j))
#define XB_XSUB(j)  (1280 + 64 * (j))
#define XB_XGEN(j)  (2304 + 64 * (j))
#define XB_TOP      3328
#define XB_TOPGEN   3392
#define XCD_BAR_WORDS 3456
#define XB_SPIN_CAP (1u << 22)

__device__ __forceinline__ unsigned xb_ld(unsigned* p)              { return __hip_atomic_load(p, __ATOMIC_RELAXED, __HIP_MEMORY_SCOPE_AGENT); }
__device__ __forceinline__ unsigned xb_add(unsigned* p, unsigned v) { return __hip_atomic_fetch_add(p, v, __ATOMIC_RELAXED, __HIP_MEMORY_SCOPE_AGENT); }
__device__ __forceinline__ unsigned xb_xcc_id() { return (unsigned)__builtin_amdgcn_s_getreg((3 << 11) | 20) & 0xFu; }
#define XB_SPIN(cond, bar) do { unsigned _sp = 0; while (cond) { __builtin_amdgcn_s_sleep(1); \
    if ((++_sp & 255u) == 0u) { if (xb_ld(&(bar)[XB_TMO])) break; if (_sp > XB_SPIN_CAP) { atomicAdd(&(bar)[XB_TMO], 1u); break; } } } } while (0)

struct XcdBarrier { unsigned* bar; unsigned x; volatile LAS unsigned* st; };

__device__ __forceinline__ XcdBarrier xcd_barrier_post(unsigned* bar, volatile LAS unsigned* st) {
    XcdBarrier b; b.bar = bar; b.x = xb_xcc_id(); b.st = st;
    if (threadIdx.x == 0) (void)xb_add(&bar[XB_XCNT(b.x)], 1u);
    return b;
}
__device__ __forceinline__ void xcd_barrier_complete(unsigned* bar, unsigned x, unsigned& nloc, unsigned& nx) {
    const unsigned G = gridDim.x * gridDim.y * gridDim.z;
    unsigned sum, cnt, mine, sp = 0u;
    for (;;) {
        sum = 0u; cnt = 0u; mine = 0u;
#pragma unroll
        for (unsigned j = 0; j < 16; ++j) { const unsigned c = xb_ld(&bar[XB_XCNT(j)]); sum += c; cnt += (c > 0u) ? 1u : 0u; mine = (j == x) ? c : mine; }
        if (sum == G) break;
        __builtin_amdgcn_s_sleep(1);
        if ((++sp & 255u) == 0u) { if (xb_ld(&bar[XB_TMO])) break; if (sp > XB_SPIN_CAP) { atomicAdd(&bar[XB_TMO], 1u); break; } }
    }
    nloc = mine > 0u ? mine : 1u; nx = cnt > 0u ? cnt : 1u;
}
__device__ __forceinline__ void xcd_barrier(const XcdBarrier& b) {
    asm volatile("s_waitcnt vmcnt(0)" ::: "memory");
    __syncthreads();
    if (threadIdx.x == 0) {
        unsigned* bar = b.bar;
        __builtin_amdgcn_s_waitcnt(0);
        unsigned nloc = b.st[0], nx = b.st[1];
        if (nloc == 0u) { xcd_barrier_complete(bar, b.x, nloc, nx); b.st[0] = nloc; b.st[1] = nx; }
        const unsigned old = xb_add(&bar[XB_XSUB(b.x)], 1u);
        const unsigned gen = old / nloc;
        if (old + 1u == (gen + 1u) * nloc) {
            __builtin_amdgcn_fence(__ATOMIC_RELEASE, "agent");
            asm volatile("s_waitcnt vmcnt(0)" ::: "memory");
            const unsigned og = xb_add(&bar[XB_TOP], 1u);
            const unsigned tg = og / nx;
            if (og + 1u == (tg + 1u) * nx) xb_add(&bar[XB_TOPGEN], 1u);
            else XB_SPIN(xb_ld(&bar[XB_TOPGEN]) == tg, bar);
            __builtin_amdgcn_fence(__ATOMIC_ACQUIRE, "agent");
            xb_add(&bar[XB_XGEN(b.x)], 1u);
            asm volatile("s_waitcnt vmcnt(0)" ::: "memory");
        } else {
            XB_SPIN(xb_ld(&bar[XB_XGEN(b.x)]) == gen, bar);
            __builtin_amdgcn_fence(__ATOMIC_ACQUIRE, "agent");
            asm volatile("s_waitcnt vmcnt(0)" ::: "memory");
        }
    }
    __syncthreads();
}

struct Frame {
    LAS unsigned char* lds;
    volatile LAS unsigned* MISC;
    gu32* ctl;
    int tid, lane, wave, vcu, G;
    const float* in[24];
    float* out;
    unsigned char* ws;
};
enum { I_X = 0, I_C, I_ADAW, I_ADAB, I_NMIX, I_NFFN, I_WIN, I_CONVW, I_ALOG, I_DTB, I_ONORM, I_SINKS, I_RELB, I_WOUT, I_POOLW, I_POOLS, I_R1W, I_R1B, I_R2W, I_R2B, I_WG, I_WU, I_WDN, I_FNW };

__device__ __forceinline__ void p0_transpose_item(const float* W, int ldw, int K, bf16* WT, int dst_row0, LAS float* scr, int k0, int n0, int lane) {
    f32x4 w4[8];
#pragma unroll
    for (int i = 0; i < 8; ++i) { const int f = i * 64 + lane, kk = f >> 3, c4 = f & 7; w4[i] = __builtin_nontemporal_load((const f32x4*)(W + (size_t)(k0 + kk) * ldw + n0 + c4 * 4)); }
#pragma unroll
    for (int i = 0; i < 8; ++i) { const int f = i * 64 + lane, kk = f >> 3, c4 = f & 7; LAS float* d = scr + kk * 33 + c4 * 4; d[0] = w4[i].x; d[1] = w4[i].y; d[2] = w4[i].z; d[3] = w4[i].w; }
    LDS_WAIT(); asm volatile("" ::: "memory");
    const int c = lane & 7;
#pragma unroll
    for (int j = 0; j < 4; ++j) { const int n = (lane >> 3) + 8 * j; const LAS float* s = scr + (8 * c) * 33 + n;
        v4u o; o.x = pk2(s[0 * 33], s[1 * 33]); o.y = pk2(s[2 * 33], s[3 * 33]); o.z = pk2(s[4 * 33], s[5 * 33]); o.w = pk2(s[6 * 33], s[7 * 33]);
        __builtin_nontemporal_store(o, (GAS v4u*)(WT + (size_t)(dst_row0 + n) * K + k0 + 8 * c)); }
    LDS_WAIT(); asm volatile("" ::: "memory");
}
__device__ __forceinline__ void convert_moe_weights(Frame& F, int layer, const int wg_first, const int wg_count) {
    LAS float* scr = (LAS float*)(F.lds + RING_OFF + F.wave * 16384);
    const int gw = wg_first * NWAVES + F.wave, NGW = wg_count * NWAVES;
    bf16* WGU = (bf16*)(F.ws + WS_WGU); bf16* WD = (bf16*)(F.ws + WS_WD);
    for (int it = gw; it < NEXP * 768; it += NGW) {
        const int e = it / 768, r = it % 768;
        if (r < 512) {
            const int up = r >> 8, q = r & 255, kb = q >> 4, nb = q & 15;
            const float* W = (up ? F.in[I_WU] : F.in[I_WG]) + (size_t)(layer * NEXP + e) * 1024 * 512;
            p0_transpose_item(W, 512, 1024, WGU, e * 1024 + (nb >> 2) * 256 + up * 128 + (nb & 3) * 32, scr, kb * 64, nb * 32, F.lane);
        } else {
            const int q = r - 512, kb = q >> 5, nb = q & 31;
            const float* W = F.in[I_WDN] + (size_t)(layer * NEXP + e) * 512 * 1024;
            p0_transpose_item(W, 1024, 512, WD, e * 1024 + nb * 32, scr, kb * 64, nb * 32, F.lane);
        }
    }
}
__device__ __forceinline__ void p0_prologue(Frame& F) {
    LAS float* scr = (LAS float*)(F.lds + RING_OFF + F.wave * 16384);
    const int gw = F.vcu * NWAVES + F.wave, NGW = F.G * NWAVES;
    constexpr int IA = 16 * 64, IB = 16 * 24, IO = 16 * 32, IP = 4 * 32, NIT = IA + IB + IO + IP;
    for (int it = gw; it < NIT; it += NGW) {
        int r = it;
        if (r < IA) { p0_transpose_item(F.in[I_WIN], 2832, 1024, (bf16*)(F.ws + WS_WIN), (r % 64) * 32, scr, (r / 64) * 64, (r % 64) * 32, F.lane); continue; } r -= IA;
        if (r < IB) { p0_transpose_item(F.in[I_WIN] + 2064, 2832, 1024, (bf16*)(F.ws + WS_WIN), 2048 + (r % 24) * 32, scr, (r / 24) * 64, (r % 24) * 32, F.lane); continue; } r -= IB;
        if (r < IO) { p0_transpose_item(F.in[I_WOUT], 1024, 1024, (bf16*)(F.ws + WS_WOUT), (r % 32) * 32, scr, (r / 32) * 64, (r % 32) * 32, F.lane); continue; } r -= IO;
        { const int g = r >> 5, q = r & 31; p0_transpose_item(F.in[I_POOLW] + (size_t)g * 65536, 256, 256, (bf16*)(F.ws + WS_POOLW) + (size_t)g * 65536, (q & 7) * 32, scr, (q >> 3) * 64, (q & 7) * 32, F.lane); }
    }
    { float* WBA = (float*)(F.ws + WS_WBA); const int gt = F.vcu * 512 + F.tid;
      if (gt < 16 * 1024) { const int o = gt >> 10, k = gt & 1023; WBA[o * 1024 + k] = F.in[I_WIN][(size_t)k * 2832 + 2048 + o]; } }
    __syncthreads();
    {
        LAS float* red = (LAS float*)(F.lds + RING_OFF);
        const int ks = F.tid >> 4, cj = F.tid & 15;
        for (int u = F.vcu; u < 192; u += F.G) {
            const int l = u / 96, cb = u % 96;
            const float* W = F.in[I_ADAW] + (size_t)l * 1024 * 6144 + cb * 64 + cj * 4;
            f32x4 a0 = {0.f, 0.f, 0.f, 0.f}, a1 = {0.f, 0.f, 0.f, 0.f};
            for (int k = ks * 32; k < ks * 32 + 32; ++k) {
                const f32x4 w = *(const f32x4*)(W + (size_t)k * 6144);
                const float c0 = silu_f(F.in[I_C][k]), c1 = silu_f(F.in[I_C][1024 + k]);
                a0 += w * c0; a1 += w * c1;
            }
            *(LAS f32x4*)(red + (ks * 2 + 0) * 64 + cj * 4) = a0; *(LAS f32x4*)(red + (ks * 2 + 1) * 64 + cj * 4) = a1;
            __syncthreads();
            if (F.tid < 128) { const int b = F.tid >> 6, c = F.tid & 63; float s = 0.f;
                for (int q = 0; q < 32; ++q) s += red[(q * 2 + b) * 64 + c];
                ((float*)(F.ws + WS_MOD))[(size_t)(l * 2 + b) * 6144 + cb * 64 + c] = s + F.in[I_ADAB][l * 6144 + cb * 64 + c]; }
            __syncthreads();
        }
    }
}

struct RowVec { f32x4 v[4]; };
__device__ __forceinline__ RowVec load_row_f32(const float* row, int lane) { RowVec r; const GAS f32x4* p = (const GAS f32x4*)row + lane;
#pragma unroll
    for (int j = 0; j < 4; ++j) r.v[j] = p[64 * j]; return r; }
__device__ __forceinline__ void store_row_f32(float* row, int lane, const RowVec& r) { GAS f32x4* p = (GAS f32x4*)row + lane;
#pragma unroll
    for (int j = 0; j < 4; ++j) p[64 * j] = r.v[j]; }
__device__ __forceinline__ void store_row_bf16(bf16* row, int lane, const RowVec& r) { GAS v2u* p = (GAS v2u*)row + lane;
#pragma unroll
    for (int j = 0; j < 4; ++j) { v2u o; o.x = pk2(r.v[j].x, r.v[j].y); o.y = pk2(r.v[j].z, r.v[j].w); p[64 * j] = o; } }
__device__ __forceinline__ void load_row_bf16(const bf16* row, int lane, v2u (&p)[4]) { const GAS v2u* q = (const GAS v2u*)row + lane;
#pragma unroll
    for (int j = 0; j < 4; ++j) p[j] = q[64 * j]; }
__device__ __forceinline__ RowVec unpack_row_bf16(const v2u (&p)[4]) { RowVec r;
#pragma unroll
    for (int j = 0; j < 4; ++j) { r.v[j].x = bflo(p[j].x); r.v[j].y = bfhi(p[j].x); r.v[j].z = bflo(p[j].y); r.v[j].w = bfhi(p[j].y); } return r; }
__device__ __forceinline__ float row_rstd(const RowVec& r) { float s = 0.f;
#pragma unroll
    for (int j = 0; j < 4; ++j) s += (r.v[j].x * r.v[j].x + r.v[j].y * r.v[j].y) + (r.v[j].z * r.v[j].z + r.v[j].w * r.v[j].w);
    return 1.0f / sqrtf(wave_sum(s) * (1.f / D) + EPS); }
struct ModVec { f32x4 a[4], b[4]; };
__device__ __forceinline__ ModVec load_mod(const float* w, const float* sc, const float* sh, int lane) { ModVec m;
#pragma unroll
    for (int j = 0; j < 4; ++j) { const f32x4 wv = *((const f32x4*)w + lane + 64 * j), s = *((const f32x4*)sc + lane + 64 * j); m.a[j] = wv * (s + 1.0f); m.b[j] = *((const f32x4*)sh + lane + 64 * j); }
    return m; }
__device__ __forceinline__ RowVec apply_mod(const RowVec& x, float rstd, const ModVec& m) { RowVec h;
#pragma unroll
    for (int j = 0; j < 4; ++j) h.v[j] = x.v[j] * rstd * m.a[j] + m.b[j]; return h; }

__device__ __forceinline__ void p1_prenorm0(Frame& F) {
    LAS float* wba = (LAS float*)(F.lds + RING_OFF);
    { const float* WBA = (const float*)(F.ws + WS_WBA); for (int i = F.tid; i < 16 * 256; i += 512) *((LAS f32x4*)wba + i) = *((const f32x4*)WBA + i); }
    __syncthreads();
    const float* mod = (const float*)(F.ws + WS_MOD);
    bf16* H = (bf16*)(F.ws + WS_H); float* BG = (float*)(F.ws + WS_BG);
    const int tok0 = F.vcu * (NTOK / F.G) + F.wave * (NTOK / F.G / NWAVES), ntw = NTOK / F.G / NWAVES;
    const int b = tok0 / SEQ;
    const ModVec m = load_mod(F.in[I_NMIX], mod + (size_t)b * 6144 + 1024, mod + (size_t)b * 6144, F.lane);
    const int hh = F.lane & 7;
    const float nega = -__expf(F.in[I_ALOG][hh]), dtb = F.in[I_DTB][hh];
    RowVec xn = load_row_f32(F.in[I_X] + (size_t)tok0 * D, F.lane);
    for (int i = 0; i < ntw; ++i) {
        const int t = tok0 + i;
        const RowVec x = xn;
        if (i + 1 < ntw) xn = load_row_f32(F.in[I_X] + (size_t)(t + 1) * D, F.lane);
        const RowVec h = apply_mod(x, row_rstd(x), m);
        store_row_bf16(H + (size_t)t * D, F.lane, h);
        float mine = 0.f;
#pragma unroll 2
        for (int o = 0; o < 16; ++o) { float s = 0.f;
#pragma unroll
            for (int j = 0; j < 4; ++j) { const f32x4 w = *((const LAS f32x4*)(wba + o * 1024) + F.lane + 64 * j); s += (h.v[j].x * w.x + h.v[j].y * w.y) + (h.v[j].z * w.z + h.v[j].w * w.w); }
            s = wave_sum(s); if (F.lane == o) mine = s; }
        if (F.lane < 8) BG[(size_t)t * 16 + F.lane] = sigmoid_f(mine);
        else if (F.lane < 16) BG[(size_t)t * 16 + F.lane] = nega * softplus_f(mine + dtb);
    }
}

struct DenseSched {
    int nM, nN, nwg, G, c; unsigned lda2, acol2; const char* B; size_t btile;
    __device__ __forceinline__ void init(int M, int N, int G_, int c_, int lda, int acolstride, const void* B_, int ldb) { nM = M / 256; nN = N / 256; nwg = nM * nN; G = G_; c = c_; lda2 = (unsigned)lda * 2u; acol2 = (unsigned)acolstride * 2u; B = (const char*)B_; btile = (size_t)256 * ldb * 2; }
    __device__ __forceinline__ bool next(int i, pg8::Unit& u) const {
        const long L = (long)i * G + c; if (L >= nwg) return false;
        int wgid = (int)L; { const int q = nwg / 8, r = nwg % 8, xcd = wgid % 8, off = wgid / 8; wgid = (xcd < r ? xcd * (q + 1) : r * (q + 1) + (xcd - r) * q) + off; }
        const int nig = 8 * nN, gid = wgid / nig, fm = gid * 8, gsz = (nM - fm) < 8 ? (nM - fm) : 8;
        u.pm = fm + ((wgid % nig) % gsz); u.pn = (wgid % nig) / gsz; u.e = 0; return true;
    }
    __device__ __forceinline__ unsigned a_off(const pg8::Unit& u, int r) const { return (unsigned)(u.pm * 256 + r) * lda2 + (unsigned)u.pn * acol2; }
    __device__ __forceinline__ const char* b_ptr(const pg8::Unit& u) const { return B + (size_t)u.pn * btile; }
};
struct MoeSched {
    const LAS int* cnt; const LAS int* tbase; const LAS int* tileExp;
    int nunits, chunk, G, c; const int* RT; const char* B; size_t bexp, btile; unsigned arow2;
    __device__ __forceinline__ void init(const LAS int* tables, int G_, int c_, const int* RT_, const void* B_, int ldb, int lda) {
        cnt = tables; tbase = tables + 32; tileExp = tables + 80; G = G_; c = c_; RT = RT_; B = (const char*)B_; bexp = (size_t)1024 * ldb * 2; btile = (size_t)256 * ldb * 2; arow2 = (unsigned)lda * 2u;
        nunits = tbase[32] * 4; chunk = ((nunits + 7) / 8 + 3) & ~3;
    }
    __device__ __forceinline__ bool next(int i, pg8::Unit& u) const {
        const int w = i * (G / 8) + (c >> 3); if (w >= chunk) return false;
        const int L = (c & 7) * chunk + w; if (L >= nunits) return false;
        u.pm = L >> 2; u.pn = L & 3; u.e = tileExp[u.pm]; return true;
    }
    __device__ __forceinline__ unsigned a_off(const pg8::Unit& u, int r) const {
        if (RT) { const int pos = (u.pm - tbase[u.e]) * 256 + r; const int tok = pos < cnt[u.e] ? RT[u.e * NTOK + pos] : 0; return (unsigned)tok * arow2; }
        return (unsigned)(u.pm * 256 + r) * arow2;
    }
    __device__ __forceinline__ const char* b_ptr(const pg8::Unit& u) const { return B + (size_t)u.e * bexp + (size_t)u.pn * btile; }
};
__device__ __forceinline__ void build_moe_tables(Frame& F, int layer) {
    LAS int* T = (LAS int*)(F.lds + SCHED_OFF);
    int tid_ = F.tid; asm volatile("" : "+v"(tid_));
    if (tid_ < 32) T[tid_] = (int)__hip_atomic_load(F.ctl + CW_CNT + 64 * layer + tid_, RLX_AGENT);
    __syncthreads();
    if (F.tid == 0) { int acc = 0; for (int e = 0; e < 32; ++e) { T[32 + e] = acc; const int nt = (T[e] + 255) >> 8; for (int j = 0; j < nt; ++j) T[80 + acc + j] = e; acc += nt; } T[64] = acc; }
    __syncthreads();
}

struct EpiStoreBf16 {
    bf16* O; int ldc;
    __device__ __forceinline__ void operator()(const f32x4 (&acc)[2][2][4][2], const pg8::Unit& u, int wr, int wc, int fr, int fq) const {
        const int row0 = u.pm * 256 + wr * 64 + fr, col0 = u.pn * 256 + wc * 32 + 8 * fq;
#pragma unroll
        for (int ai = 0; ai < 2; ++ai)
#pragma unroll
            for (int m = 0; m < 4; ++m) { bf16* rowp = O + (size_t)(row0 + ai * 128 + m * 16) * ldc + col0;
#pragma unroll
                for (int bj = 0; bj < 2; ++bj) { const f32x4 v0 = acc[ai][bj][m][0], v1 = acc[ai][bj][m][1];
                    v4u w; w.x = pk2(v0[0], v0[1]); w.y = pk2(v0[2], v0[3]); w.z = pk2(v1[0], v1[1]); w.w = pk2(v1[2], v1[3]);
                    *(v4u*)(rowp + bj * 128) = w; } }
    }
};
struct EpiSwiglu {
    bf16* O;
    __device__ __forceinline__ void operator()(const f32x4 (&acc)[2][2][4][2], const pg8::Unit& u, int wr, int wc, int fr, int fq) const {
        const int row0 = u.pm * 256 + wr * 64 + fr, col0 = u.pn * 128 + wc * 32 + 8 * fq;
#pragma unroll
        for (int ai = 0; ai < 2; ++ai)
#pragma unroll
            for (int m = 0; m < 4; ++m) { bf16* rowp = O + (size_t)(row0 + ai * 128 + m * 16) * DFF + col0;
                float r[8];
#pragma unroll
                for (int n = 0; n < 2; ++n)
#pragma unroll
                    for (int j = 0; j < 4; ++j) r[4 * n + j] = silu_f(acc[ai][0][m][n][j]) * acc[ai][1][m][n][j];
                v4u w; w.x = pk2(r[0], r[1]); w.y = pk2(r[2], r[3]); w.z = pk2(r[4], r[5]); w.w = pk2(r[6], r[7]);
                *(v4u*)rowp = w; }
    }
};

__device__ __forceinline__ void moe_route(Frame& F, int layer) {
    LAS int* hist = (LAS int*)(F.lds + RT_LDS_OFF);
    LAS int* base = hist + 32;
    LAS int* tinfo = hist + 64;
    LAS float* tg = (LAS float*)(hist + 64 + 512);
    if (F.tid < 32) hist[F.tid] = 0;
    LAS f32x4* R2 = (LAS f32x4*)(F.lds + RING_OFF);
    LAS f32x4* R1 = (LAS f32x4*)(F.lds + R1W_OFF);
    { const f32x4* g2p = (const f32x4*)(F.in[I_R2W] + (size_t)layer * 1024 * 32); const f32x4* g1p = (const f32x4*)(F.in[I_R1W] + (size_t)layer * 1024 * 4);
      for (int i = F.tid; i < 8192; i += 512) { const int k = i >> 3, c4 = i & 7, ln = (k & 255) >> 2, q = k & 3, j = k >> 8; R2[((j * 4 + q) * 8 + c4) * 64 + ln] = g2p[i]; }
      for (int k = F.tid; k < 1024; k += 512) { const int ln = (k & 255) >> 2, q = k & 3, j = k >> 8; R1[(j * 4 + q) * 64 + ln] = g1p[k]; } }
    __syncthreads();
    const float* mod = (const float*)(F.ws + WS_MOD) + (size_t)layer * 2 * 6144;
    bf16* H = (bf16*)(F.ws + WS_H);
    const int tokw = F.vcu * 128 + F.wave * 16, b = (F.vcu * 128) / SEQ;
    const ModVec m = load_mod(F.in[I_NFFN] + layer * D, mod + (size_t)b * 6144 + 4 * 1024, mod + (size_t)b * 6144 + 3 * 1024, F.lane);
    const float* r1b = F.in[I_R1B] + layer * 4; const float* r2b = F.in[I_R2B] + layer * 32;
    const float* xin = F.in[I_X]; bf16* XRB = (bf16*)(F.ws + WS_XRB); const bf16* YM = (const bf16*)(F.ws + WS_YM);
    f32x4 cf[4];
#pragma unroll
    for (int j = 0; j < 4; ++j) { cf[j] = *((const f32x4*)(mod + (size_t)b * 6144 + 2 * 1024) + F.lane + 64 * j); if (layer == 1) cf[j] *= *((const f32x4*)F.in[I_POOLS] + F.lane + 64 * j); }
    RowVec xn; v2u xbn[4], yn[4];
    if (layer == 0) xn = load_row_f32(xin + (size_t)tokw * D, F.lane); else load_row_bf16(XRB + (size_t)tokw * D, F.lane, xbn);
#pragma unroll
    for (int j = 0; j < 4; ++j) yn[j] = *((const GAS v2u*)(YM + (size_t)tokw * D) + F.lane + 64 * j);
    for (int i = 0; i < 16; ++i) {
        const int t = tokw + i;
        RowVec x; v2u yc[4];
        if (layer == 0) x = xn; else x = unpack_row_bf16(xbn);
#pragma unroll
        for (int j = 0; j < 4; ++j) yc[j] = yn[j];
        if (i + 1 < 16) { if (layer == 0) xn = load_row_f32(xin + (size_t)(t + 1) * D, F.lane); else load_row_bf16(XRB + (size_t)(t + 1) * D, F.lane, xbn);
#pragma unroll
            for (int j = 0; j < 4; ++j) yn[j] = *((const GAS v2u*)(YM + (size_t)(t + 1) * D) + F.lane + 64 * j); }
#pragma unroll
        for (int j = 0; j < 4; ++j) { f32x4 yv; yv.x = bflo(yc[j].x); yv.y = bfhi(yc[j].x); yv.z = bflo(yc[j].y); yv.w = bfhi(yc[j].y); x.v[j] += cf[j] * yv; }
        store_row_bf16(XRB + (size_t)t * D, F.lane, x);
        RowVec h = apply_mod(x, row_rstd(x), m);
        store_row_bf16(H + (size_t)t * D, F.lane, h);
        f32x4 l1 = {0.f, 0.f, 0.f, 0.f};
#pragma unroll
        for (int j = 0; j < 4; ++j)
#pragma unroll
            for (int q = 0; q < 4; ++q) l1 += R1[(j * 4 + q) * 64 + F.lane] * h.v[j][q];
        float lg[4];
#pragma unroll
        for (int g = 0; g < 4; ++g) lg[g] = wave_sum(l1[g]) + r1b[g];
        int grp = 0; float mx = lg[0];
#pragma unroll
        for (int g = 1; g < 4; ++g) if (lg[g] > mx) { mx = lg[g]; grp = g; }
        float se = 0.f;
#pragma unroll
        for (int g = 0; g < 4; ++g) se += __expf(lg[g] - mx);
        const float ptop = 1.0f / se;
        grp = __builtin_amdgcn_readfirstlane(grp);
        f32x4 a0 = {0.f, 0.f, 0.f, 0.f}, a1 = {0.f, 0.f, 0.f, 0.f};
#pragma unroll
        for (int j = 0; j < 4; ++j)
#pragma unroll
            for (int q = 0; q < 4; ++q) { const LAS f32x4* wp = R2 + ((j * 4 + q) * 8 + grp * 2) * 64 + F.lane;
                a0 += wp[0] * h.v[j][q]; a1 += wp[64] * h.v[j][q]; }
        float l2[8];
#pragma unroll
        for (int q = 0; q < 4; ++q) { l2[q] = wave_sum(a0[q]) + r2b[grp * 8 + q]; l2[4 + q] = wave_sum(a1[q]) + r2b[grp * 8 + 4 + q]; }
        int i0 = 0; float v0 = l2[0];
#pragma unroll
        for (int q = 1; q < 8; ++q) if (l2[q] > v0) { v0 = l2[q]; i0 = q; }
        int i1 = (i0 == 0) ? 1 : 0; float v1 = l2[i1 == 1 ? 1 : 0];
#pragma unroll
        for (int q = 0; q < 8; ++q) if (q != i0 && l2[q] > v1) { v1 = l2[q]; i1 = q; }
        const float g0 = ptop / (1.0f + __expf(v1 - v0)), g1 = ptop - g0;
        if (F.lane == 0) { const int e0 = grp * 8 + i0, e1 = grp * 8 + i1, li = F.wave * 16 + i;
            tinfo[li * 4 + 0] = e0; tinfo[li * 4 + 1] = e1; tinfo[li * 4 + 2] = atomicAdd((int*)(hist + e0), 1); tinfo[li * 4 + 3] = atomicAdd((int*)(hist + e1), 1);
            tg[li * 2] = g0; tg[li * 2 + 1] = g1;
            { float* GA = (float*)(F.ws + WS_BG); GA[(size_t)t * 2] = g0; GA[(size_t)t * 2 + 1] = g1; }
        }
    }
    __syncthreads();
    if (F.tid < 32) base[F.tid] = (int)__hip_atomic_fetch_add(F.ctl + CW_CNT + 64 * layer + F.tid, (unsigned)hist[F.tid], RLX_AGENT);
    __syncthreads();
    if (F.tid < 128) { const int t = F.vcu * 128 + F.tid; const int e0 = tinfo[F.tid * 4], e1 = tinfo[F.tid * 4 + 1];
        const int p0 = base[e0] + tinfo[F.tid * 4 + 2], p1 = base[e1] + tinfo[F.tid * 4 + 3];
        int* RT = (int*)(F.ws + WS_RT); RT[e0 * NTOK + p0] = t; RT[e1 * NTOK + p1] = t;
        v4u r0; r0.x = e0; r0.y = e1; r0.z = p0; r0.w = p1; v4u r1; r1.x = __builtin_bit_cast(unsigned, tg[F.tid * 2]); r1.y = __builtin_bit_cast(unsigned, tg[F.tid * 2 + 1]); r1.z = 0; r1.w = 0;
        v4u* RO = (v4u*)(F.ws + WS_ROUTE) + (size_t)t * 2; RO[0] = r0; (void)r1; }
    __syncthreads();
}

struct CombRows { v2u xb[4], ya[4], yb[4]; };
struct CombRecs { v4u rec; float ga, gb; };
__device__ __forceinline__ CombRecs comb_load_recs(Frame& F, int tokw) { CombRecs c; const int t = tokw + (F.lane & 15);
    c.rec = *((const v4u*)(F.ws + WS_ROUTE) + (size_t)t * 2); const float* GA = (const float*)(F.ws + WS_BG); c.ga = GA[(size_t)t * 2]; c.gb = GA[(size_t)t * 2 + 1]; return c; }
__device__ __forceinline__ int rl_i(int v, int l) { return __builtin_amdgcn_readlane(v, l); }
__device__ __forceinline__ void comb_issue(Frame& F, const CombRecs& c, int i, int t, CombRows& r) {
    const LAS int* T = (const LAS int*)(F.lds + SCHED_OFF);
    const int e0 = rl_i((int)c.rec.x, i), e1 = rl_i((int)c.rec.y, i), p0 = rl_i((int)c.rec.z, i), p1 = rl_i((int)c.rec.w, i);
    const size_t rowa = (size_t)T[32 + e0] * 256 + p0, rowb = (size_t)T[32 + e1] * 256 + p1;
    const bf16* Y = (const bf16*)(F.ws + WS_Y);
    const GAS v2u* ya = (const GAS v2u*)(Y + rowa * D) + F.lane; const GAS v2u* yb = (const GAS v2u*)(Y + rowb * D) + F.lane;
    load_row_bf16((const bf16*)(F.ws + WS_XRB) + (size_t)t * D, F.lane, r.xb);
#pragma unroll
    for (int j = 0; j < 4; ++j) { r.ya[j] = ya[64 * j]; r.yb[j] = yb[64 * j]; }
}
__device__ __forceinline__ RowVec comb_finish(const CombRecs& c, int i, const CombRows& r, const f32x4 (&g2)[4]) {
    const float ga = rl(c.ga, i), gb = rl(c.gb, i); RowVec x = unpack_row_bf16(r.xb);
#pragma unroll
    for (int j = 0; j < 4; ++j) { const v2u a = r.ya[j], bq = r.yb[j];
        f32x4 s; s.x = ga * bflo(a.x) + gb * bflo(bq.x); s.y = ga * bfhi(a.x) + gb * bfhi(bq.x); s.z = ga * bflo(a.y) + gb * bflo(bq.y); s.w = ga * bfhi(a.y) + gb * bfhi(bq.y);
        x.v[j] += g2[j] * s; }
    return x;
}

__device__ __forceinline__ void attn_phase(Frame& F, const int u_first, const int u_stride) {
    LAS bf16* KS = (LAS bf16*)(F.lds + RING_OFF);
    LAS bf16* VT = (LAS bf16*)(F.lds + RING_OFF + 36864);
    LAS float* BT = (LAS float*)(F.lds + RING_OFF + 36864 + 33280);
    const bf16* PROJ = (const bf16*)(F.ws + WS_PROJ); bf16* OAB = (bf16*)(F.ws + WS_OAB);
    const int lane = F.lane, lc = lane & 31, lh = lane >> 5;
    for (int unit = u_first; unit < 512; unit += u_stride) {
        const int b = unit >> 8, kvh = (unit >> 7) & 1, qb = unit & 127, t0 = qb * 128;
        __syncthreads();
        for (int i = F.tid; i < 4 * 192; i += 512) { const int hq = i / 192, x = i - hq * 192, dist = 159 - x; float v = 0.f;
            if (dist >= 0 && dist < 128) { int bk = dist; if (dist >= 16) { bk = 16 + (int)(logf((float)dist / 16.0f) / 2.0794415416798357f * 16.0f); bk = bk > 31 ? 31 : bk; }
                v = F.in[I_RELB][bk * 8 + kvh * 4 + hq] * 1.4426950408889634f; }
            BT[i] = v; }
#pragma unroll
        for (int cc = 0; cc < 4; ++cc) { const int ch = F.tid + 512 * cc, key = ch >> 3, part = ch & 7, tl = t0 - 128 + key;
            v4u kv = {0u, 0u, 0u, 0u}, vv = {0u, 0u, 0u, 0u};
            if (tl >= 0) { const bf16* rp = PROJ + (size_t)(b * SEQ + tl) * PIN; kv = *(const v4u*)(rp + PC_KB + kvh * 64 + part * 8); vv = *(const v4u*)(rp + PC_VB + kvh * 64 + part * 8); }
            *(LAS v4u*)(KS + key * 72 + part * 8) = kv;
            const unsigned w[4] = {vv.x, vv.y, vv.z, vv.w};
#pragma unroll
            for (int q = 0; q < 4; ++q) { VT[(part * 8 + 2 * q) * 260 + key] = (bf16)(w[q] & 0xffffu); VT[(part * 8 + 2 * q + 1) * 260 + key] = (bf16)(w[q] >> 16); } }
        __syncthreads();
#pragma unroll 1
        for (int tt = 0; tt < 2; ++tt) {
            const int task = F.wave * 2 + tt, hq = task >> 2, qt = task & 3, qh = kvh * 4 + hq;
            const int qi = 32 * qt + lc;
            const bf16* qrow = PROJ + (size_t)(b * SEQ + t0 + qi) * PIN + PC_QB + qh * 64 + 8 * lh;
            bf16x8 qf[4];
#pragma unroll
            for (int s = 0; s < 4; ++s) qf[s] = *(const bf16x8*)(qrow + 16 * s);
            f32x16 sc[5];
#pragma unroll
            for (int kt = 0; kt < 5; ++kt) {
#pragma unroll
                for (int r = 0; r < 16; ++r) sc[kt][r] = 0.f;
                const LAS bf16* kp = KS + (32 * (qt + kt) + lc) * 72 + 8 * lh;
#pragma unroll
                for (int s = 0; s < 4; ++s) { const bf16x8 kf = *(const LAS bf16x8*)(kp + 16 * s); sc[kt] = __builtin_amdgcn_mfma_f32_32x32x16_bf16(kf, qf[s], sc[kt], 0, 0, 0); }
            }
            const float sink2 = F.in[I_SINKS][qh] * 1.4426950408889634f;
            const LAS float* bp = BT + hq * 192 + (4 * lh - lc + 31);
            const int m_lo = lc + 1 - 4 * lh, m_hi = lc - 4 * lh;
            float mx = sink2;
#pragma unroll
            for (int kt = 0; kt < 5; ++kt) {
                const bool dead = (t0 == 0) && (qt + kt < 4);
#pragma unroll
                for (int r = 0; r < 16; ++r) { const int cr = (r & 3) + 8 * (r >> 2);
                    float v = sc[kt][r] * (0.125f * 1.4426950408889634f) + bp[32 * kt + cr];
                    if (kt == 0) v = (cr >= m_lo) ? v : -1e30f;
                    if (kt == 4) v = (cr <= m_hi) ? v : -1e30f;
                    if (dead) v = -1e30f;
                    sc[kt][r] = v; mx = fmaxf(mx, v); } }
            mx = fmaxf(mx, __shfl_xor(mx, 32));
            float den = 0.f;
#pragma unroll
            for (int kt = 0; kt < 5; ++kt)
#pragma unroll
                for (int r = 0; r < 16; ++r) { const float p = __builtin_amdgcn_exp2f(sc[kt][r] - mx); sc[kt][r] = p; den += p; }
            den += __shfl_xor(den, 32);
            den += __builtin_amdgcn_exp2f(sink2 - mx);
            const float inv = 1.0f / den;
            f32x16 oa[2];
#pragma unroll
            for (int dt = 0; dt < 2; ++dt)
#pragma unroll
                for (int r = 0; r < 16; ++r) oa[dt][r] = 0.f;
#pragma unroll
            for (int kt = 0; kt < 5; ++kt)
#pragma unroll
                for (int s2 = 0; s2 < 2; ++s2) {
                    v4u pw; pw.x = pk2(sc[kt][8 * s2 + 0], sc[kt][8 * s2 + 1]); pw.y = pk2(sc[kt][8 * s2 + 2], sc[kt][8 * s2 + 3]); pw.z = pk2(sc[kt][8 * s2 + 4], sc[kt][8 * s2 + 5]); pw.w = pk2(sc[kt][8 * s2 + 6], sc[kt][8 * s2 + 7]);
                    const bf16x8 pf = __builtin_bit_cast(bf16x8, pw);
#pragma unroll
                    for (int dt = 0; dt < 2; ++dt) { const LAS bf16* vp = VT + (32 * dt + lc) * 260 + 32 * (qt + kt) + 16 * s2 + 4 * lh;
                        const v2u va = *(const LAS v2u*)vp, vb = *(const LAS v2u*)(vp + 8);
                        v4u vw; vw.x = va.x; vw.y = va.y; vw.z = vb.x; vw.w = vb.y;
                        oa[dt] = __builtin_amdgcn_mfma_f32_32x32x16_bf16(__builtin_bit_cast(bf16x8, vw), pf, oa[dt], 0, 0, 0); }
                }
            bf16* orow = OAB + (size_t)(b * SEQ + t0 + qi) * D + 512 + qh * 64 + 4 * lh;
#pragma unroll
            for (int dt = 0; dt < 2; ++dt)
#pragma unroll
                for (int rg = 0; rg < 4; ++rg) { v2u o; o.x = pk2(oa[dt][4 * rg] * inv, oa[dt][4 * rg + 1] * inv); o.y = pk2(oa[dt][4 * rg + 2] * inv, oa[dt][4 * rg + 3] * inv);
                    *(v2u*)(orow + 32 * dt + 8 * rg) = o; }
        }
    }
    __syncthreads();
}


constexpr int DN_ST = 72;

__device__ __forceinline__ bf16x8 pack8(const f32x16& x, int s) { v4u p; p.x = pk2(x[8 * s], x[8 * s + 1]); p.y = pk2(x[8 * s + 2], x[8 * s + 3]); p.z = pk2(x[8 * s + 4], x[8 * s + 5]); p.w = pk2(x[8 * s + 6], x[8 * s + 7]); return __builtin_bit_cast(bf16x8, p); }
__device__ __forceinline__ f32x16 dn_tile(const LAS bf16* A, int ra, const LAS bf16* B, int rb, int lc, int lh) {
    f32x16 acc;
#pragma unroll
    for (int r = 0; r < 16; ++r) acc[r] = 0.f;
#pragma unroll
    for (int s = 0; s < 4; ++s) { const bf16x8 a = *(const LAS bf16x8*)(A + (ra + lc) * DN_ST + 16 * s + 8 * lh), b = *(const LAS bf16x8*)(B + (rb + lc) * DN_ST + 16 * s + 8 * lh);
        acc = __builtin_amdgcn_mfma_f32_32x32x16_bf16(a, b, acc, 0, 0, 0); }
    return acc;
}
__device__ __forceinline__ void dn_prep(Frame& F) {
    LAS bf16* Qs = (LAS bf16*)(F.lds + RING_OFF);
    LAS bf16* Ks = Qs + 64 * DN_ST;
    LAS bf16* KBs = Ks + 64 * DN_ST;
    LAS bf16* Vs = KBs + 64 * DN_ST;
    LAS bf16* KDT = Vs + 64 * DN_ST;
    LAS bf16* AQK = KDT + 64 * DN_ST;
    LAS bf16* UT = AQK + 64 * DN_ST;
    LAS bf16* WT = UT + 64 * DN_ST;
    LAS bf16* LNO = WT + 64 * DN_ST;
    LAS float* LD = (LAS float*)(LNO + 64 * DN_ST);
    LAS bf16* TDZ = (LAS bf16*)(LD + 64 * 16);
    LAS float* gcs = (LAS float*)(TDZ + 64 * 24);
    LAS float* bts = gcs + 64;
    const bf16* PROJ = (const bf16*)(F.ws + WS_PROJ); const float* BG = (const float*)(F.ws + WS_BG);
    const int tid = F.tid, lane = F.lane, lc = lane & 31, lh = lane >> 5, wave = F.wave;
    LAS float* CW = bts + 64;
    for (int i = tid; i < 1536; i += 512) *((LAS f32x4*)CW + i) = *((const f32x4*)F.in[I_CONVW] + i);
    for (int unit = F.vcu; unit < 4096; unit += F.G) {
        const int b = unit >> 11, h = (unit >> 8) & 7, n = unit & 255;
        const size_t row0 = (size_t)b * SEQ + (size_t)n * 64;
        __syncthreads();
        if (wave == 0) { const float g = BG[(row0 + lane) * 16 + 8 + h]; float c = g;
#pragma unroll
            for (int o = 1; o < 64; o <<= 1) { const float up = __shfl_up(c, o); if (lane >= o) c += up; }
            gcs[lane] = c; bts[lane] = BG[(row0 + lane) * 16 + h]; }
        __syncthreads();
        { const int t = tid >> 3, cs = tid & 7; const int tl = n * 64 + t;
          float q[8], k[8], v[8];
#pragma unroll
          for (int e = 0; e < 8; ++e) { q[e] = 0.f; k[e] = 0.f; v[e] = 0.f; }
#pragma unroll
          for (int j = 0; j < 4; ++j) { if (tl - 3 + j >= 0) { const bf16* rp = PROJ + (row0 + t - 3 + j) * PIN + h * 64 + cs * 8;
                const v4u wq = *(const v4u*)(rp + PC_QA), wk = *(const v4u*)(rp + PC_KA), wv = *(const v4u*)(rp + PC_VA);
                const LAS float* cw = CW + j * 1536 + h * 64 + cs * 8;
                const unsigned uq[4] = {wq.x, wq.y, wq.z, wq.w}, uk[4] = {wk.x, wk.y, wk.z, wk.w}, uv[4] = {wv.x, wv.y, wv.z, wv.w};
#pragma unroll
                for (int e = 0; e < 4; ++e) { q[2 * e] += cw[2 * e] * bflo(uq[e]); q[2 * e + 1] += cw[2 * e + 1] * bfhi(uq[e]);
                    k[2 * e] += cw[512 + 2 * e] * bflo(uk[e]); k[2 * e + 1] += cw[512 + 2 * e + 1] * bfhi(uk[e]);
                    v[2 * e] += cw[1024 + 2 * e] * bflo(uv[e]); v[2 * e + 1] += cw[1024 + 2 * e + 1] * bfhi(uv[e]); } } }
          float sq = 0.f, sk = 0.f;
#pragma unroll
          for (int e = 0; e < 8; ++e) { q[e] = silu_f(q[e]); k[e] = silu_f(k[e]); v[e] = silu_f(v[e]); sq += q[e] * q[e]; sk += k[e] * k[e]; }
          sq = oct_sum(sq); sk = oct_sum(sk);
          const float rq = 0.125f / sqrtf(sq + EPS), rk = 1.0f / sqrtf(sk + EPS), bt = bts[t], kd = __expf(gcs[63] - gcs[t]);
          v4u oq, ok, ob, ov;
          oq.x = pk2(q[0] * rq, q[1] * rq); oq.y = pk2(q[2] * rq, q[3] * rq); oq.z = pk2(q[4] * rq, q[5] * rq); oq.w = pk2(q[6] * rq, q[7] * rq);
#pragma unroll
          for (int e = 0; e < 8; ++e) k[e] *= rk;
          ok.x = pk2(k[0], k[1]); ok.y = pk2(k[2], k[3]); ok.z = pk2(k[4], k[5]); ok.w = pk2(k[6], k[7]);
          ob.x = pk2(k[0] * bt, k[1] * bt); ob.y = pk2(k[2] * bt, k[3] * bt); ob.z = pk2(k[4] * bt, k[5] * bt); ob.w = pk2(k[6] * bt, k[7] * bt);
          ov.x = pk2(v[0], v[1]); ov.y = pk2(v[2], v[3]); ov.z = pk2(v[4], v[5]); ov.w = pk2(v[6], v[7]);
          *(LAS v4u*)(Qs + t * DN_ST + cs * 8) = oq; *(LAS v4u*)(Ks + t * DN_ST + cs * 8) = ok; *(LAS v4u*)(KBs + t * DN_ST + cs * 8) = ob; *(LAS v4u*)(Vs + t * DN_ST + cs * 8) = ov;
#pragma unroll
          for (int e = 0; e < 8; ++e) KDT[(cs * 8 + e) * DN_ST + t] = (bf16)f2bf(k[e] * kd); }
        __syncthreads();
        { const int it = (wave >> 1) & 1, jt = wave & 1; const bool qk = wave >= 4;
          f32x16 acc;
          if (it >= jt) acc = dn_tile(qk ? Qs : KBs, 32 * it, Ks, 32 * jt, lc, lh);
          const int j = 32 * jt + lc; const float gj = gcs[j];
#pragma unroll
          for (int r = 0; r < 16; ++r) { const int i = 32 * it + (r & 3) + 8 * (r >> 2) + 4 * lh;
              float val = 0.f;
              if (it >= jt) { if (qk ? (i >= j) : (i > j)) val = acc[r] * __expf(gcs[i] - gj); }
              if (qk) AQK[i * DN_ST + j] = (bf16)f2bf(val);
              else { const bool diag = (i >> 4) == (j >> 4); LNO[i * DN_ST + j] = (bf16)f2bf(diag ? 0.f : -val); if (diag) LD[i * 16 + (j & 15)] = val; } } }
        __syncthreads();
        if (wave == 0) { const int bb = lane >> 4, c = lane & 15; float tcol[16];
#pragma unroll
            for (int i = 0; i < 16; ++i) { float v = (i == c) ? 1.f : 0.f;
#pragma unroll
                for (int j4 = 0; j4 < (i + 3) / 4; ++j4) { const f32x4 a = *(const LAS f32x4*)(LD + (16 * bb + i) * 16 + 4 * j4);
#pragma unroll
                    for (int e = 0; e < 4; ++e) if (4 * j4 + e < i) v -= a[e] * tcol[4 * j4 + e]; }
                tcol[i] = v; TDZ[(16 * bb + i) * 24 + c] = (bf16)f2bf(v); } }
        __syncthreads();
        if (wave < 4) {
            const int ct = wave, cc = 32 * (ct & 1) + lc; const bool isw = ct >= 2;
            f32x16 acc[2];
#pragma unroll
            for (int rt = 0; rt < 2; ++rt)
#pragma unroll
                for (int r = 0; r < 16; ++r) { const int t = 32 * rt + (r & 3) + 8 * (r >> 2) + 4 * lh;
                    acc[rt][r] = isw ? bf2f(Ks[t * DN_ST + cc]) * bts[t] * __expf(gcs[t]) : bf2f(Vs[t * DN_ST + cc]) * bts[t]; }
#define DN_AFRAG(arr, stride, row, kb) ({ const LAS bf16* p_ = (arr) + (row) * (stride) + 16 * (kb) + 4 * lh; const v2u lo_ = *(const LAS v2u*)p_, hi_ = *(const LAS v2u*)(p_ + 8); v4u w_; w_.x = lo_.x; w_.y = lo_.y; w_.z = hi_.x; w_.w = hi_.y; __builtin_bit_cast(bf16x8, w_); })
            f32x16 X[4];
#pragma unroll
            for (int bb = 0; bb < 4; ++bb) { const int rt = bb >> 1, odd = bb & 1;
                bf16x8 ta = DN_AFRAG(TDZ, 24, 32 * rt + lc, 0);
                if ((lc >> 4) != odd) ta = (bf16x8){0, 0, 0, 0, 0, 0, 0, 0};
                f32x16 z;
#pragma unroll
                for (int r = 0; r < 16; ++r) z[r] = 0.f;
                z = __builtin_amdgcn_mfma_f32_32x32x16_bf16(ta, pack8(acc[rt], odd), z, 0, 0, 0);
                X[bb] = z;
                const bf16x8 xb = pack8(z, odd);
                if (bb == 0) { acc[0] = __builtin_amdgcn_mfma_f32_32x32x16_bf16(DN_AFRAG(LNO, DN_ST, lc, 0), xb, acc[0], 0, 0, 0); acc[1] = __builtin_amdgcn_mfma_f32_32x32x16_bf16(DN_AFRAG(LNO, DN_ST, 32 + lc, 0), xb, acc[1], 0, 0, 0); }
                if (bb == 1) { acc[1] = __builtin_amdgcn_mfma_f32_32x32x16_bf16(DN_AFRAG(LNO, DN_ST, 32 + lc, 1), xb, acc[1], 0, 0, 0); }
                if (bb == 2) { acc[1] = __builtin_amdgcn_mfma_f32_32x32x16_bf16(DN_AFRAG(LNO, DN_ST, 32 + lc, 2), xb, acc[1], 0, 0, 0); }
            }
#undef DN_AFRAG
            LAS bf16* dst = (isw ? WT : UT) + cc * DN_ST;
#pragma unroll
            for (int bb = 0; bb < 4; ++bb)
#pragma unroll
                for (int g = 0; g < 2; ++g) { const int r0 = 8 * (bb & 1) + 4 * g; v2u o; o.x = pk2(X[bb][r0], X[bb][r0 + 1]); o.y = pk2(X[bb][r0 + 2], X[bb][r0 + 3]);
                    *(LAS v2u*)(dst + 16 * bb + 8 * g + 4 * lh) = o; }
        }
        __syncthreads();
        { bf16* MT = (bf16*)(F.ws + WS_DN_MT) + (size_t)unit * 4096; bf16* QPT = (bf16*)(F.ws + WS_DN_QPT) + (size_t)unit * 4096;
          bf16* BM = (bf16*)(F.ws + WS_DN_BM) + (size_t)unit * 4096; bf16* O0T = (bf16*)(F.ws + WS_DN_O0T) + (size_t)unit * 4096;
#pragma unroll 1
          for (int tt = 0; tt < 2; ++tt) { const int task = wave * 2 + tt, p = task >> 2, ta = (task >> 1) & 1, tb = task & 1;
              if (p == 0) {
                  f32x16 acc = dn_tile(WT, 32 * ta, KDT, 32 * tb, lc, lh);
#pragma unroll
                  for (int r = 0; r < 16; ++r) acc[r] = -acc[r];
#pragma unroll
                  for (int s2 = 0; s2 < 2; ++s2) *(bf16x8*)(MT + ((((tb * 2 + ta) * 2 + s2) * 64 + lane) * 8)) = pack8(acc, s2);
              } else if (p == 1) {
                  const f32x16 acc = dn_tile(KDT, 32 * ta, UT, 32 * tb, lc, lh);
#pragma unroll
                  for (int s2 = 0; s2 < 2; ++s2) *(bf16x8*)(BM + ((((tb * 2 + ta) * 2 + s2) * 64 + lane) * 8)) = pack8(acc, s2);
              } else if (p == 2) {
                  f32x16 acc = dn_tile(WT, 32 * ta, AQK, 32 * tb, lc, lh);
                  const int i = 32 * tb + lc; const float eg = __expf(gcs[i]);
#pragma unroll
                  for (int r = 0; r < 16; ++r) { const int a = 32 * ta + (r & 3) + 8 * (r >> 2) + 4 * lh; acc[r] = bf2f(Qs[i * DN_ST + a]) * eg - acc[r]; }
#pragma unroll
                  for (int s2 = 0; s2 < 2; ++s2) *(bf16x8*)(QPT + ((((tb * 2 + ta) * 2 + s2) * 64 + lane) * 8)) = pack8(acc, s2);
              } else {
                  const f32x16 acc = dn_tile(UT, 32 * ta, AQK, 32 * tb, lc, lh);
#pragma unroll
                  for (int s2 = 0; s2 < 2; ++s2) *(bf16x8*)(O0T + ((((tb * 2 + ta) * 2 + s2) * 64 + lane) * 8)) = pack8(acc, s2);
              } }
          if (tid == 0) ((float*)(F.ws + WS_DN_GT))[unit] = __expf(gcs[63]); }
    }
    __syncthreads();
}
template <int r>
__device__ __forceinline__ void dn_scan_wave(Frame& F) {
    const int w = F.vcu, bh = w >> 1, ct = w & 1, lane = F.lane;
    const bf16x8* MT = (const bf16x8*)(F.ws + WS_DN_MT); const bf16x8* BM = (const bf16x8*)(F.ws + WS_DN_BM); bf16x8* SS = (bf16x8*)(F.ws + WS_DN_S);
    const float* GT = (const float*)(F.ws + WS_DN_GT);
    LAS bf16x8* MB = (LAS bf16x8*)(F.lds + RING_OFF);
    volatile LAS int* FL = (volatile LAS int*)(F.lds + LDSCTL_OFF + 64);
    f32x16 S;
#pragma unroll
    for (int q = 0; q < 16; ++q) S[q] = 0.f;
    bf16x8 mA[4], bA[2], mB[4], bB[2], mC[4], bC[2], mD[4], bD[2], mE[4], bE[2], mG[4], bG[2]; float gA, gB, gC, gD, gE, gG;
#define DN_SLOAD(m, bm, gt, u) do { const size_t ub = (size_t)(u) * 512; _Pragma("unroll") for (int f = 0; f < 4; ++f) m[f] = MT[ub + (r * 4 + f) * 64 + lane]; \
        _Pragma("unroll") for (int f = 0; f < 2; ++f) bm[f] = BM[ub + ((ct * 2 + r) * 2 + f) * 64 + lane]; gt = GT[u]; } while (0)
#define DN_STEP(cm, cb, cg, unit, n) do { \
        bf16x8 own[2]; own[0] = pack8(S, 0); own[1] = pack8(S, 1); \
        LAS bf16x8* mb = MB + ((n) & 1) * 256; \
        mb[(r * 2 + 0) * 64 + lane] = own[0]; mb[(r * 2 + 1) * 64 + lane] = own[1]; \
        asm volatile("s_waitcnt lgkmcnt(0)" ::: "memory"); \
        if (lane == 0) FL[r] = (n) + 1; \
        SS[(size_t)(unit) * 512 + (ct * 4 + r * 2 + 0) * 64 + lane] = own[0]; SS[(size_t)(unit) * 512 + (ct * 4 + r * 2 + 1) * 64 + lane] = own[1]; \
        f32x16 A; \
        { const v4u b0 = __builtin_bit_cast(v4u, cb[0]), b1 = __builtin_bit_cast(v4u, cb[1]); const unsigned u0[8] = {b0.x, b0.y, b0.z, b0.w, b1.x, b1.y, b1.z, b1.w}; \
          _Pragma("unroll") for (int e = 0; e < 8; ++e) { A[2 * e] = cg * S[2 * e] + bflo(u0[e]); A[2 * e + 1] = cg * S[2 * e + 1] + bfhi(u0[e]); } } \
        while (FL[1 - r] < (n) + 1) { } \
        asm volatile("" ::: "memory"); \
        bf16x8 oth[2]; oth[0] = mb[((1 - r) * 2 + 0) * 64 + lane]; oth[1] = mb[((1 - r) * 2 + 1) * 64 + lane]; \
          \
        _Pragma("unroll") for (int s2 = 0; s2 < 2; ++s2) { A = __builtin_amdgcn_mfma_f32_32x32x16_bf16(cm[r * 2 + s2], own[s2], A, 0, 0, 0); A = __builtin_amdgcn_mfma_f32_32x32x16_bf16(cm[(1 - r) * 2 + s2], oth[s2], A, 0, 0, 0); } \
        S = A; } while (0)
    const int u0 = bh * 256;
    DN_SLOAD(mA, bA, gA, u0); DN_SLOAD(mB, bB, gB, u0 + 1); DN_SLOAD(mC, bC, gC, u0 + 2); DN_SLOAD(mD, bD, gD, u0 + 3); DN_SLOAD(mE, bE, gE, u0 + 4); DN_SLOAD(mG, bG, gG, u0 + 5);
    for (int n = 0; n < 252; n += 6) {
        DN_STEP(mA, bA, gA, u0 + n, n);         DN_SLOAD(mA, bA, gA, u0 + n + 6);
        DN_STEP(mB, bB, gB, u0 + n + 1, n + 1); DN_SLOAD(mB, bB, gB, u0 + n + 7);
        DN_STEP(mC, bC, gC, u0 + n + 2, n + 2); DN_SLOAD(mC, bC, gC, u0 + n + 8);
        DN_STEP(mD, bD, gD, u0 + n + 3, n + 3); DN_SLOAD(mD, bD, gD, u0 + n + 9);
        DN_STEP(mE, bE, gE, u0 + n + 4, n + 4); if (n + 10 < 256) DN_SLOAD(mE, bE, gE, u0 + n + 10);
        DN_STEP(mG, bG, gG, u0 + n + 5, n + 5); if (n + 11 < 256) DN_SLOAD(mG, bG, gG, u0 + n + 11);
    }
    DN_STEP(mA, bA, gA, u0 + 252, 252); DN_STEP(mB, bB, gB, u0 + 253, 253); DN_STEP(mC, bC, gC, u0 + 254, 254); DN_STEP(mD, bD, gD, u0 + 255, 255);
#undef DN_SLOAD
#undef DN_STEP
}
__device__ __forceinline__ void dn_scan(Frame& F) {
    if (F.vcu >= 32) return;
    if (F.wave == 0) dn_scan_wave<0>(F); else if (F.wave == 1) dn_scan_wave<1>(F);
}
__device__ __forceinline__ void dn_output(Frame& F) {
    const bf16x8* QPT = (const bf16x8*)(F.ws + WS_DN_QPT); const bf16x8* O0T = (const bf16x8*)(F.ws + WS_DN_O0T); const bf16x8* SS = (const bf16x8*)(F.ws + WS_DN_S);
    const bf16* PROJ = (const bf16*)(F.ws + WS_PROJ); bf16* OAB = (bf16*)(F.ws + WS_OAB);
    const int lane = F.lane, lc = lane & 31, lh = lane >> 5; int nbad = 0; (void)nbad;
    for (int task = F.vcu * NWAVES + F.wave; task < 8192; task += F.G * NWAVES) {
        const int unit = task >> 1, it = task & 1, b = unit >> 11, h = (unit >> 8) & 7, n = unit & 255;
        const size_t ub = (size_t)unit * 512;
        f32x16 o[2];
#pragma unroll
        for (int ct = 0; ct < 2; ++ct) {
            const v4u c0 = __builtin_bit_cast(v4u, O0T[ub + ((it * 2 + ct) * 2 + 0) * 64 + lane]), c1 = __builtin_bit_cast(v4u, O0T[ub + ((it * 2 + ct) * 2 + 1) * 64 + lane]);
            const unsigned u[8] = {c0.x, c0.y, c0.z, c0.w, c1.x, c1.y, c1.z, c1.w};
#pragma unroll
            for (int e = 0; e < 8; ++e) { o[ct][2 * e] = bflo(u[e]); o[ct][2 * e + 1] = bfhi(u[e]); }
#pragma unroll
            for (int at = 0; at < 2; ++at)
#pragma unroll
                for (int s2 = 0; s2 < 2; ++s2) o[ct] = __builtin_amdgcn_mfma_f32_32x32x16_bf16(SS[ub + (ct * 4 + at * 2 + s2) * 64 + lane], QPT[ub + ((it * 2 + at) * 2 + s2) * 64 + lane], o[ct], 0, 0, 0);
        }
        float ss = 0.f;
#pragma unroll
        for (int ct = 0; ct < 2; ++ct)
#pragma unroll
            for (int r = 0; r < 16; ++r) ss += o[ct][r] * o[ct][r];
        ss += __shfl_xor(ss, 32);
        const float rs = 1.0f / sqrtf(ss * (1.0f / 64.0f) + EPS);
        const size_t row = (size_t)b * SEQ + (size_t)n * 64 + it * 32 + lc;
#pragma unroll
        for (int ct = 0; ct < 2; ++ct)
#pragma unroll
            for (int rg = 0; rg < 4; ++rg) { const int c0 = 32 * ct + 8 * rg + 4 * lh;
                const v2u zz = *(const v2u*)(PROJ + row * PIN + PC_ZA + h * 64 + c0); const f32x4 ow = *(const f32x4*)(F.in[I_ONORM] + c0);
                const float z0 = bflo(zz.x), z1 = bfhi(zz.x), z2 = bflo(zz.y), z3 = bfhi(zz.y);
                v2u ov; ov.x = pk2(o[ct][4 * rg] * rs * ow[0] * silu_f(z0), o[ct][4 * rg + 1] * rs * ow[1] * silu_f(z1)); ov.y = pk2(o[ct][4 * rg + 2] * rs * ow[2] * silu_f(z2), o[ct][4 * rg + 3] * rs * ow[3] * silu_f(z3));
                *(v2u*)(OAB + row * D + h * 64 + c0) = ov;
            }
    }
}

template <int WIN>
__device__ __forceinline__ void pooled_block(const bf16* H, bf16* P, const int t0, const int tl0, const int col) {
    v4u r[WIN - 1 + 8];
#pragma unroll
    for (int j = 0; j < WIN - 1 + 8; ++j) { const int dt = j - (WIN - 1); r[j] = (v4u){0u, 0u, 0u, 0u}; if (tl0 + dt >= 0) r[j] = *(const v4u*)(H + (size_t)(t0 + dt) * D + col); }
    float s[8];
#pragma unroll
    for (int q = 0; q < 8; ++q) s[q] = 0.f;
#define POOL_ACC(sgn, VV) do { const v4u q_ = (VV); s[0] += sgn bflo(q_.x); s[1] += sgn bfhi(q_.x); s[2] += sgn bflo(q_.y); s[3] += sgn bfhi(q_.y); s[4] += sgn bflo(q_.z); s[5] += sgn bfhi(q_.z); s[6] += sgn bflo(q_.w); s[7] += sgn bfhi(q_.w); } while (0)
#pragma unroll
    for (int j = 0; j < WIN - 1; ++j) POOL_ACC(+, r[j]);
#pragma unroll
    for (int i = 0; i < 8; ++i) { const v4u self = r[WIN - 1 + i]; POOL_ACC(+, self);
        const int n = (tl0 + i + 1) < WIN ? (tl0 + i + 1) : WIN; const float inv = 1.0f / (float)n;
        v4u o; o.x = pk2(s[0] * inv - bflo(self.x), s[1] * inv - bfhi(self.x)); o.y = pk2(s[2] * inv - bflo(self.y), s[3] * inv - bfhi(self.y));
        o.z = pk2(s[4] * inv - bflo(self.z), s[5] * inv - bfhi(self.z)); o.w = pk2(s[6] * inv - bflo(self.w), s[7] * inv - bfhi(self.w));
        *(v4u*)(P + (size_t)(t0 + i) * D + col) = o;
        POOL_ACC(-, r[i]); }
#undef POOL_ACC
}
__device__ __forceinline__ void pooled_phase(Frame& F) {
    const bf16* H = (const bf16*)(F.ws + WS_H); bf16* P = (bf16*)(F.ws + WS_OAB);
    const int gt = F.vcu * 512 + F.tid, NT = F.G * 512;
    for (int it = gt; it < (NTOK / 8) * 128; it += NT) {
        const int c = it & 31, g = __builtin_amdgcn_readfirstlane((it >> 6) & 3), tb = ((it >> 8) << 1) | ((it >> 5) & 1);
        const int t0 = tb * 8, tl0 = t0 & (SEQ - 1), col = g * 256 + c * 8;
        if (g == 0) pooled_block<2>(H, P, t0, tl0, col); else if (g == 1) pooled_block<4>(H, P, t0, tl0, col); else if (g == 2) pooled_block<8>(H, P, t0, tl0, col); else pooled_block<16>(H, P, t0, tl0, col);
    }
}


#ifndef PH_MASK
#define PH_MASK 0xFFFFFF
#endif
#define IN(k) (((PH_MASK >> (k)) & 1) && lo <= (k) && (k) < hi)
#define BOTH(k) (IN(k) && IN((k) + 1))
#if MK_ONE_LAUNCH
#define GRID_BAR() xcd_barrier(bar)
#else
#define GRID_BAR() do { } while (0)
#endif
template <int LAYER>
__device__ __forceinline__ void moe_phases(Frame& F, const XcdBarrier& bar, const int lo, const int hi) {
    constexpr int pb = LAYER == 0 ? 7 : 13;
    bf16* const H = (bf16*)(F.ws + WS_H);
    const float* const MOD = (const float*)(F.ws + WS_MOD);
    if (IN(pb)) {
        moe_route(F, LAYER); if (BOTH(pb)) GRID_BAR(); }
    if (IN(pb + 1)) {
        build_moe_tables(F, LAYER);
        pg8::Gemm g{(const bf16*)H, 1024, 1024}; MoeSched S; S.init((const LAS int*)(F.lds + SCHED_OFF), F.G, (int)blockIdx.x, (const int*)(F.ws + WS_RT), F.ws + WS_WGU, 1024, 1024);
        EpiSwiglu E{(bf16*)(F.ws + WS_ACT)};
        pg8::gemm_phase<EpiSwiglu, MoeSched>(F.lds + RING_OFF, g, S, E);
        if (BOTH(pb + 1)) GRID_BAR();
    }
    if (IN(pb + 2)) {
        build_moe_tables(F, LAYER);
        pg8::Gemm g{(const bf16*)(F.ws + WS_ACT), 512, 512}; MoeSched S; S.init((const LAS int*)(F.lds + SCHED_OFF), F.G, (int)blockIdx.x, nullptr, F.ws + WS_WD, 512, 512);
        EpiStoreBf16 E{(bf16*)(F.ws + WS_Y), D};
        pg8::gemm_phase<EpiStoreBf16, MoeSched>(F.lds + RING_OFF, g, S, E);
        if (BOTH(pb + 2)) GRID_BAR();
    }
    if (IN(pb + 3)) {
        build_moe_tables(F, LAYER);
        const int tokw = F.vcu * 128 + F.wave * 16, b = (F.vcu * 128) / SEQ;
        f32x4 g2[4];
#pragma unroll
        for (int j = 0; j < 4; ++j) g2[j] = *((const f32x4*)(MOD + (size_t)(LAYER * 2 + b) * 6144 + 5 * 1024) + F.lane + 64 * j);
        if (LAYER == 0) {
            const ModVec m1 = load_mod(F.in[I_NMIX] + D, MOD + (size_t)(2 + b) * 6144 + 1024, MOD + (size_t)(2 + b) * 6144, F.lane);
            { const CombRecs recs = comb_load_recs(F, tokw); CombRows cur, nxt; comb_issue(F, recs, 0, tokw, cur);
              for (int i = 0; i < 16; ++i) { const int t = tokw + i;
                  if (i + 1 < 16) comb_issue(F, recs, i + 1, t + 1, nxt);
                  const RowVec x = comb_finish(recs, i, cur, g2);
                  store_row_bf16((bf16*)(F.ws + WS_XRB) + (size_t)t * D, F.lane, x); store_row_bf16(H + (size_t)t * D, F.lane, apply_mod(x, row_rstd(x), m1));
                  cur = nxt; } }
            __syncthreads();
            convert_moe_weights(F, 1, F.vcu, F.G);
        } else {
            f32x4 fw[4];
#pragma unroll
            for (int j = 0; j < 4; ++j) fw[j] = *((const f32x4*)F.in[I_FNW] + F.lane + 64 * j);
            { const CombRecs recs = comb_load_recs(F, tokw); CombRows cur, nxt; comb_issue(F, recs, 0, tokw, cur);
              for (int i = 0; i < 16; ++i) { const int t = tokw + i;
                  if (i + 1 < 16) comb_issue(F, recs, i + 1, t + 1, nxt);
                  RowVec x = comb_finish(recs, i, cur, g2); const float rstd = row_rstd(x);
#pragma unroll
                  for (int j = 0; j < 4; ++j) x.v[j] = x.v[j] * rstd * fw[j];
                  store_row_f32(F.out + (size_t)t * D, F.lane, x);
                  cur = nxt; } }
        }
        if (BOTH(pb + 3)) GRID_BAR();
    }
}

constexpr int PH_P0 = 0, PH_P1 = 1, PH_INPROJ = 2, PH_ATT = 3, PH_SCAN = 4, PH_DNOUT = 5, PH_OUTPROJ = 6, PH_MOE0 = 7, PH_POOLED = 11, PH_POOLG = 12, PH_MOE1 = 13;
constexpr int N_PHASES = 17;
struct Args { const float* in[24]; float* out; unsigned char* ws; int ph_lo, ph_hi; };
__global__ void __launch_bounds__(NWAVES * 64, 2) trunk_fwd(Args args) {
    __shared__ __attribute__((aligned(16))) unsigned char lds[LDS_BYTES];
    Frame F;
    F.lds = (LAS unsigned char*)lds;
    F.MISC = (volatile LAS unsigned*)(F.lds + MISC_OFF);
    F.tid = threadIdx.x; F.lane = F.tid & 63; F.wave = __builtin_amdgcn_readfirstlane(F.tid >> 6);
    F.G = gridDim.x; { const int bx = blockIdx.x; F.vcu = (F.G % 8 == 0) ? (bx % 8) * (F.G / 8) + bx / 8 : bx; }
#pragma unroll
    for (int i = 0; i < 24; ++i) F.in[i] = args.in[i];
    F.out = args.out; F.ws = args.ws; F.ctl = (gu32*)(args.ws + WS_CTL);
    for (int u = F.tid; u < (LDS_BYTES - LDSCTL_OFF) / 4; u += NWAVES * 64) ((LAS unsigned*)(F.lds + LDSCTL_OFF))[u] = 0u;
    __syncthreads();
#if MK_ONE_LAUNCH
    XcdBarrier bar = xcd_barrier_post((unsigned*)(F.ctl + CW_BAR), F.MISC + 8);
#else
    XcdBarrier bar; bar.bar = nullptr; bar.x = 0; bar.st = nullptr;
#endif
    const int lo = args.ph_lo, hi = args.ph_hi;
    bf16* const H = (bf16*)(F.ws + WS_H);
    const float* const MOD = (const float*)(F.ws + WS_MOD);

    if (IN(PH_P0)) { p0_prologue(F); if (BOTH(PH_P0)) GRID_BAR(); }
    if (IN(PH_P1)) { p1_prenorm0(F); if (BOTH(PH_P1)) GRID_BAR(); }
    if (IN(PH_INPROJ)) {
        pg8::Gemm g{(const bf16*)H, 1024, 1024}; DenseSched S; S.init(NTOK, PIN, F.G, (int)blockIdx.x, 1024, 0, F.ws + WS_WIN, 1024);
        EpiStoreBf16 E{(bf16*)(F.ws + WS_PROJ), PIN};
        pg8::gemm_phase<EpiStoreBf16, DenseSched>(F.lds + RING_OFF, g, S, E);
        if (BOTH(PH_INPROJ)) GRID_BAR();
    }
    if (IN(PH_ATT)) { dn_prep(F); if (BOTH(PH_ATT)) GRID_BAR(); }
    if (IN(PH_SCAN)) {
        if (F.vcu < 32) dn_scan(F);
        else { attn_phase(F, F.vcu - 32, F.G - 32); __syncthreads(); convert_moe_weights(F, 0, F.vcu - 32, F.G - 32); }
        if (BOTH(PH_SCAN)) GRID_BAR(); }
    if (IN(PH_DNOUT)) { dn_output(F); if (BOTH(PH_DNOUT)) GRID_BAR(); }
    if (IN(PH_OUTPROJ)) {
        pg8::Gemm g{(const bf16*)(F.ws + WS_OAB), 1024, 1024}; DenseSched S; S.init(NTOK, D, F.G, (int)blockIdx.x, 1024, 0, F.ws + WS_WOUT, 1024);
        EpiStoreBf16 E{(bf16*)(F.ws + WS_YM), D};
        pg8::gemm_phase<EpiStoreBf16, DenseSched>(F.lds + RING_OFF, g, S, E);
        if (BOTH(PH_OUTPROJ)) GRID_BAR();
    }
    moe_phases<0>(F, bar, lo, hi);
    if (IN(PH_POOLED)) { pooled_phase(F); if (BOTH(PH_POOLED)) GRID_BAR(); }
    if (IN(PH_POOLG)) {
        pg8::Gemm g{(const bf16*)(F.ws + WS_OAB), 256, 256}; DenseSched S; S.init(NTOK, D, F.G, (int)blockIdx.x, 1024, 256, F.ws + WS_POOLW, 256);
        EpiStoreBf16 E{(bf16*)(F.ws + WS_YM), D};
        pg8::gemm_phase<EpiStoreBf16, DenseSched>(F.lds + RING_OFF, g, S, E);
        if (BOTH(PH_POOLG)) GRID_BAR();
    }
    moe_phases<1>(F, bar, lo, hi);
#undef IN
#undef BOTH
}

extern "C" void kernel_launch(void* const* d_in, const int* in_sizes, int n_in, void* d_out, int out_size, void* d_ws, size_t ws_size, hipStream_t stream) {
    static int grid = 0;
    if (grid == 0) {
        if (n_in != 24 || in_sizes[0] != NTOK * D || out_size != NTOK * D || ws_size < WS_END2) { fprintf(stderr, "kernel_launch: unexpected shapes (n_in %d, in0 %d, out %d, ws %zu); nothing launched\n", n_in, n_in > 0 ? in_sizes[0] : -1, out_size, ws_size); grid = -1; return; }
        int per_cu = 0;
        if (hipOccupancyMaxActiveBlocksPerMultiprocessor(&per_cu, (const void*)trunk_fwd, NWAVES * 64, 0) != hipSuccess || per_cu < 1) fprintf(stderr, "kernel_launch: occupancy query says %d\n", per_cu);
        (void)hipGetLastError();
        grid = 256;
    }
    if (grid < 0) return;
    if (hipMemsetAsync((char*)d_ws + WS_CTL, 0, CTL_ZERO_BYTES, stream) != hipSuccess) { fprintf(stderr, "kernel_launch: memset failed\n"); return; }
    Args a{};
    for (int i = 0; i < 24; ++i) a.in[i] = (const float*)d_in[i];
    a.out = (float*)d_out; a.ws = (unsigned char*)d_ws;
#if MK_ONE_LAUNCH
    a.ph_lo = 0; a.ph_hi = N_PHASES;
    hipLaunchKernelGGL(trunk_fwd, dim3(grid), dim3(NWAVES * 64), 0, stream, a);
#else
    for (int p = 0; p < N_PHASES; ++p) { a.ph_lo = p; a.ph_hi = p + 1; hipLaunchKernelGGL(trunk_fwd, dim3(grid), dim3(NWAVES * 64), 0, stream, a); }
#endif
}
```

```cpp
#include <hip/hip_runtime.h>
#include <cstdio>
#include <cstdint>

#ifndef MK_ONE_LAUNCH
#define MK_ONE_LAUNCH 1
#endif

#define GAS __attribute__((address_space(1)))
#define LAS __attribute__((address_space(3)))
typedef unsigned short bf16;
typedef unsigned v4u __attribute__((ext_vector_type(4)));
typedef unsigned v2u __attribute__((ext_vector_type(2)));
typedef float f32x4 __attribute__((ext_vector_type(4)));
typedef float f32x2 __attribute__((ext_vector_type(2)));
typedef float f32x16 __attribute__((ext_vector_type(16)));
typedef short bf16x8 __attribute__((ext_vector_type(8)));
typedef GAS unsigned gu32;
#define RLX_AGENT __ATOMIC_RELAXED, __HIP_MEMORY_SCOPE_AGENT
#define LDS_WAIT() asm volatile("s_waitcnt lgkmcnt(0)" ::: "memory")
#define VM_WAIT() asm volatile("s_waitcnt vmcnt(0)" ::: "memory")

constexpr int BATCH = 2, SEQ = 16384, D = 1024, NTOK = BATCH * SEQ;
constexpr int PIN = 2816;
constexpr int PC_QA = 0, PC_KA = 512, PC_VA = 1024, PC_ZA = 1536, PC_QB = 2048, PC_KB = 2560, PC_VB = 2688;
constexpr int NEXP = 32, DFF = 512;
constexpr int MAXTILES = NTOK * 2 / 256 + NEXP;
constexpr float EPS = 1e-6f;
constexpr int NWAVES = 8;

constexpr size_t MiB = 1u << 20;
constexpr size_t WS_CTL = 0, CTL_ZERO_BYTES = 1 * MiB;
constexpr size_t WS_MOD = 1 * MiB;
constexpr size_t WS_WBA = 1 * MiB + 128 * 1024;
constexpr size_t WS_ROUTE = 2 * MiB;
constexpr size_t WS_RT = 3 * MiB;
constexpr size_t WS_BG = 7 * MiB;
constexpr size_t WS_WIN = 10 * MiB;
constexpr size_t WS_WOUT = 16 * MiB;
constexpr size_t WS_POOLW = 18 * MiB;
constexpr size_t WS_WGU = 20 * MiB;
constexpr size_t WS_WD = 84 * MiB;
constexpr size_t WS_H = 116 * MiB;
constexpr size_t WS_PROJ = 180 * MiB;
constexpr size_t WS_OAB = 356 * MiB;
constexpr size_t WS_YM = 180 * MiB;
constexpr size_t WS_ACT = 180 * MiB;
constexpr size_t WS_Y = 252 * MiB;
constexpr size_t WS_END = 420 * MiB;
constexpr size_t WS_DN_MT = WS_H;
constexpr size_t WS_DN_QPT = WS_H + 32 * MiB;
constexpr size_t WS_DN_BM = 420 * MiB, WS_DN_O0T = 452 * MiB, WS_DN_S = 484 * MiB;
constexpr size_t WS_DN_GT = 9 * MiB;
constexpr size_t WS_XRB = 420 * MiB;
constexpr size_t WS_WD1 = 484 * MiB;
constexpr size_t WS_END2 = 516 * MiB;
constexpr int CW_CNT = 64;
constexpr int CW_BAR = 4096;
constexpr int CW_BAD = 200;

constexpr int RING_OFF = 0, RING_BYTES = 131072;
constexpr int LDSCTL_OFF = RING_BYTES, MISC_OFF = LDSCTL_OFF + 320;
constexpr int SCHED_OFF = LDSCTL_OFF + 1024;
constexpr int LDS_BYTES = 163840;
constexpr int R1W_OFF = 135168;
constexpr int RT_LDS_OFF = 151552;

typedef __bf16 bf16x2_t __attribute__((ext_vector_type(2)));
__device__ __forceinline__ unsigned pk2(float lo, float hi) { bf16x2_t v; v.x = (__bf16)lo; v.y = (__bf16)hi; return __builtin_bit_cast(unsigned, v); }
__device__ __forceinline__ unsigned f2bf(float f) { return pk2(f, 0.f) & 0xffffu; }
__device__ __forceinline__ float bf2f(unsigned b) { return __builtin_bit_cast(float, b << 16); }
__device__ __forceinline__ float bflo(unsigned w) { return __builtin_bit_cast(float, w << 16); }
__device__ __forceinline__ float bfhi(unsigned w) { return __builtin_bit_cast(float, w & 0xffff0000u); }
template <int CTRL> __device__ __forceinline__ float dpp_f(float v) { return __builtin_bit_cast(float, __builtin_amdgcn_update_dpp(0, __builtin_bit_cast(int, v), CTRL, 0xf, 0xf, false)); }
__device__ __forceinline__ float quad_sum(float v) { v += dpp_f<0xB1>(v); v += dpp_f<0x4E>(v); return v; }
__device__ __forceinline__ float oct_sum(float v) { v = quad_sum(v); v += dpp_f<0x141>(v); return v; }
__device__ __forceinline__ float wave_sum(float v) {
    v = oct_sum(v); v += dpp_f<0x140>(v);
    const float r0 = __builtin_bit_cast(float, __builtin_amdgcn_readlane(__builtin_bit_cast(int, v), 0)), r1 = __builtin_bit_cast(float, __builtin_amdgcn_readlane(__builtin_bit_cast(int, v), 16));
    const float r2 = __builtin_bit_cast(float, __builtin_amdgcn_readlane(__builtin_bit_cast(int, v), 32)), r3 = __builtin_bit_cast(float, __builtin_amdgcn_readlane(__builtin_bit_cast(int, v), 48));
    return (r0 + r1) + (r2 + r3);
}
__device__ __forceinline__ float rl(float x, int l) { return __builtin_bit_cast(float, __builtin_amdgcn_readlane(__builtin_bit_cast(int, x), l)); }
__device__ __forceinline__ float silu_f(float x) { return x / (1.f + __expf(-x)); }
__device__ __forceinline__ float sigmoid_f(float x) { return 1.f / (1.f + __expf(-x)); }
__device__ __forceinline__ float softplus_f(float x) { return x > 20.f ? x : log1pf(__expf(x)); }

namespace pg8 {
#define PG8_LAS __attribute__((address_space(3)))
typedef unsigned short bf16_t;
typedef unsigned u32x4 __attribute__((ext_vector_type(4)));
constexpr int BM = 256, BK = 64, HALF = 128, HTB = HALF * BK * 2, STAGE_BYTES = 8 * HTB;

__host__ __device__ __forceinline__ int lds_byte(int r, int c) { const int st = (r >> 4) * 2 + (c >> 5), rr = r & 15, cc = c & 31, ob = rr * 64 + cc * 2; return st * 1024 + (ob ^ (((ob >> 9) & 1) << 5)); }
__host__ __device__ __forceinline__ void stage_rc(int b, int& R, int& C) { const int st = b / 1024, sb = b % 1024, swz = sb ^ (((sb >> 9) & 1) << 5); R = (st >> 1) * 16 + swz / 64; C = (st & 1) * 32 + (swz % 64) / 2; }
__host__ __device__ __forceinline__ int perm32(int rho) { const int n = rho >> 4, i = rho & 15; return 8 * (i >> 2) + 4 * n + (i & 3); }

struct Unit { int pm, pn, e; };
struct Gemm { const bf16_t* A; int K, ldb; };

template <class Epi, class Sched>
__device__ __forceinline__ void gemm_phase(PG8_LAS unsigned char* lds, const Gemm g, const Sched& S, const Epi& E) {
    const int tid = threadIdx.x, wid = __builtin_amdgcn_readfirstlane(tid >> 6), lane = tid & 63, wr = wid >> 2, wc = wid & 3, fr = lane & 15, fq = lane >> 4;
    const int K = g.K, nt = K / BK;
    int R0, C0, R1, C1; stage_rc(tid * 16, R0, C0); stage_rc(tid * 16 + 8192, R1, C1);
    const int Rb0 = (R0 & ~31) + perm32(R0 & 31), Rb1 = (R1 & ~31) + perm32(R1 & 31);
    const unsigned voffB0 = (unsigned)(Rb0 * g.ldb + C0) * 2u, voffB1 = (unsigned)(Rb1 * g.ldb + C1) * 2u;
    const size_t kstep = (size_t)(BK * 2);
    const size_t hstepB = (size_t)HALF * g.ldb * 2;
    const unsigned ldsw = (unsigned)wid * 1024u;
    const int aoff = lds_byte(wr * 64 + fr, fq * 8), boff = lds_byte(wc * 32 + fr, fq * 8);
    const char* Ab = (const char*)g.A;
#define PG8_SA(b, h) (((b) * 2 + (h)) * HTB)
#define PG8_SB(b, h) ((4 + (b) * 2 + (h)) * HTB)
#define PG8_ST2(bufoff, gbase, v0, v1) do { \
        __builtin_amdgcn_global_load_lds((const unsigned*)((const char*)(gbase) + (v0)), (PG8_LAS unsigned*)(lds + (bufoff) + ldsw), 16, 0, 0); \
        __builtin_amdgcn_global_load_lds((const unsigned*)((const char*)(gbase) + (v1)), (PG8_LAS unsigned*)(lds + (bufoff) + ldsw + 8192), 16, 0, 0); } while (0)
#define PG8_STB(bufoff, gbase) PG8_ST2(bufoff, gbase, voffB0, voffB1)
#define PG8_LDA(dst, b, h) do { _Pragma("unroll") for (int m = 0; m < 4; ++m) _Pragma("unroll") for (int k = 0; k < 2; ++k) dst[m][k] = *(const PG8_LAS bf16x8*)(lds + PG8_SA(b, h) + aoff + m * 2048 + k * 1024); } while (0)
#define PG8_LDB(dst, b, h) do { _Pragma("unroll") for (int n = 0; n < 2; ++n) _Pragma("unroll") for (int k = 0; k < 2; ++k) dst[n][k] = *(const PG8_LAS bf16x8*)(lds + PG8_SB(b, h) + boff + n * 2048 + k * 1024); } while (0)
#define PG8_MMA(ai, bj, At, Bt) do { __builtin_amdgcn_s_setprio(1); _Pragma("unroll") for (int m = 0; m < 4; ++m) _Pragma("unroll") for (int n = 0; n < 2; ++n) _Pragma("unroll") for (int k = 0; k < 2; ++k) \
        acc[ai][bj][m][n] = __builtin_amdgcn_mfma_f32_16x16x32_bf16(Bt[n][k], At[m][k], acc[ai][bj][m][n], 0, 0, 0); __builtin_amdgcn_s_setprio(0); } while (0)
#define PG8_WAIT_V(n) asm volatile("s_waitcnt vmcnt(" #n ")" ::: "memory")
#define PG8_WAIT_L(n) asm volatile("s_waitcnt lgkmcnt(" #n ")" ::: "memory")
#define PG8_BAR __builtin_amdgcn_s_barrier()
#define PG8_SCHED __builtin_amdgcn_sched_barrier(0)
    Unit cur, nxt; int ui = 0;
    if (!S.next(0, cur)) return;
    f32x4 acc[2][2][4][2];
#pragma unroll
    for (int a = 0; a < 2; ++a)
#pragma unroll
        for (int b = 0; b < 2; ++b)
#pragma unroll
            for (int m = 0; m < 4; ++m)
#pragma unroll
                for (int n = 0; n < 2; ++n) acc[a][b][m][n] = (f32x4){0.f, 0.f, 0.f, 0.f};
    bf16x8 At[4][2], B0[2][2], B1[2][2];
    unsigned c00, c01, c10, c11;
#define PG8_AOFF(u, d00, d01, d10, d11) do { \
        d00 = S.a_off(u, R0) + (unsigned)C0 * 2u; d01 = S.a_off(u, R1) + (unsigned)C1 * 2u; \
        d10 = S.a_off(u, HALF + R0) + (unsigned)C0 * 2u; d11 = S.a_off(u, HALF + R1) + (unsigned)C1 * 2u; } while (0)
    PG8_AOFF(cur, c00, c01, c10, c11);
    const char* cB = S.b_ptr(cur);
    PG8_STB(PG8_SB(0, 0), cB); PG8_STB(PG8_SB(0, 1), cB + hstepB); PG8_ST2(PG8_SA(0, 0), Ab, c00, c01); PG8_ST2(PG8_SA(0, 1), Ab, c10, c11);
    if (wr == 1) PG8_BAR;
    PG8_WAIT_V(2); PG8_BAR;
    PG8_STB(PG8_SB(1, 0), cB + kstep); PG8_ST2(PG8_SA(1, 0), Ab + kstep, c00, c01); PG8_STB(PG8_SB(1, 1), cB + hstepB + kstep);
    PG8_WAIT_V(6); PG8_BAR;
    for (;;) {
        const bool has_next = S.next(ui + 1, nxt);
        const char* nB = has_next ? S.b_ptr(nxt) : cB;
#pragma unroll 1
        for (int t = 0; t < nt; t += 2) {
            const bool last = (t == nt - 2);
            const char* a1 = Ab + (size_t)(t + 1) * kstep;
            const char* a2 = last ? Ab : Ab + (size_t)(t + 2) * kstep; const char* b2 = last ? nB : cB + (size_t)(t + 2) * kstep;
            const char* a3 = a2 + kstep; const char* b3 = b2 + kstep;
            PG8_LDB(B0, 0, 0); PG8_LDB(B1, 0, 1); PG8_SCHED; PG8_LDA(At, 0, 0); PG8_ST2(PG8_SA(1, 1), a1, c10, c11);
            PG8_WAIT_V(8); PG8_WAIT_L(0); PG8_BAR; PG8_MMA(0, 0, At, B0); PG8_MMA(0, 1, At, B1); PG8_BAR; PG8_SCHED;
            if (last && has_next) { PG8_AOFF(nxt, c00, c01, c10, c11); }
            PG8_LDA(At, 0, 1); PG8_STB(PG8_SB(0, 0), b2); PG8_STB(PG8_SB(0, 1), b2 + hstepB); PG8_ST2(PG8_SA(0, 0), a2, c00, c01);
            PG8_WAIT_V(8); PG8_WAIT_L(0); PG8_BAR; PG8_MMA(1, 0, At, B0); PG8_MMA(1, 1, At, B1); PG8_BAR; PG8_SCHED;
            PG8_LDB(B0, 1, 0); PG8_LDB(B1, 1, 1); PG8_SCHED; PG8_LDA(At, 1, 0); PG8_ST2(PG8_SA(0, 1), a2, c10, c11);
            PG8_WAIT_V(8); PG8_WAIT_L(0); PG8_BAR; PG8_MMA(0, 0, At, B0); PG8_MMA(0, 1, At, B1); PG8_BAR; PG8_SCHED;
            PG8_LDA(At, 1, 1); PG8_STB(PG8_SB(1, 0), b3); PG8_STB(PG8_SB(1, 1), b3 + hstepB); PG8_ST2(PG8_SA(1, 0), a3, c00, c01);
            PG8_WAIT_V(8); PG8_WAIT_L(0); PG8_BAR; PG8_MMA(1, 0, At, B0); PG8_MMA(1, 1, At, B1); PG8_BAR; PG8_SCHED;
        }
        if (wr == 0) PG8_BAR;
        E(acc, cur, wr, wc, fr, fq);
        if (!has_next) break;
#pragma unroll
        for (int a = 0; a < 2; ++a)
#pragma unroll
            for (int b = 0; b < 2; ++b)
#pragma unroll
                for (int m = 0; m < 4; ++m)
#pragma unroll
                    for (int n = 0; n < 2; ++n) acc[a][b][m][n] = (f32x4){0.f, 0.f, 0.f, 0.f};
        cur = nxt; cB = nB; ++ui;
        if (wr == 1) PG8_BAR;
    }
    PG8_WAIT_V(0);
    PG8_BAR;
#undef PG8_SA
#undef PG8_SB
#undef PG8_ST2
#undef PG8_STB
#undef PG8_LDA
#undef PG8_LDB
#undef PG8_MMA
#undef PG8_WAIT_V
#undef PG8_WAIT_L
#undef PG8_BAR
#undef PG8_SCHED
#undef PG8_AOFF
}
}

#define XB_TMO      128
#define XB_XCNT(j)  (256  + 64 * (j))
#define XB_XSUB(j)  (1280 + 64 * (j))
#define XB_XGEN(j)  (2304 + 64 * (j))
#define XB_TOP      3328
#define XB_TOPGEN   3392
#define XCD_BAR_WORDS 3456
#define XB_SPIN_CAP (1u << 22)

__device__ __forceinline__ unsigned xb_ld(unsigned* p)              { return __hip_atomic_load(p, __ATOMIC_RELAXED, __HIP_MEMORY_SCOPE_AGENT); }
__device__ __forceinline__ unsigned xb_add(unsigned* p, unsigned v) { return __hip_atomic_fetch_add(p, v, __ATOMIC_RELAXED, __HIP_MEMORY_SCOPE_AGENT); }
__device__ __forceinline__ unsigned xb_xcc_id() { return (unsigned)__builtin_amdgcn_s_getreg((3 << 11) | 20) & 0xFu; }
#define XB_SPIN(cond, bar) do { unsigned _sp = 0; while (cond) { __builtin_amdgcn_s_sleep(1); \
    if ((++_sp & 255u) == 0u) { if (xb_ld(&(bar)[XB_TMO])) break; if (_sp > XB_SPIN_CAP) { atomicAdd(&(bar)[XB_TMO], 1u); break; } } } } while (0)

struct XcdBarrier { unsigned* bar; unsigned x; volatile LAS unsigned* st; };

__device__ __forceinline__ XcdBarrier xcd_barrier_post(unsigned* bar, volatile LAS unsigned* st) {
    XcdBarrier b; b.bar = bar; b.x = xb_xcc_id(); b.st = st;
    if (threadIdx.x == 0) (void)xb_add(&bar[XB_XCNT(b.x)], 1u);
    return b;
}
__device__ __forceinline__ void xcd_barrier_complete(unsigned* bar, unsigned x, unsigned& nloc, unsigned& nx) {
    const unsigned G = gridDim.x * gridDim.y * gridDim.z;
    unsigned sum, cnt, mine, sp = 0u;
    for (;;) {
        sum = 0u; cnt = 0u; mine = 0u;
#pragma unroll
        for (unsigned j = 0; j < 16; ++j) { const unsigned c = xb_ld(&bar[XB_XCNT(j)]); sum += c; cnt += (c > 0u) ? 1u : 0u; mine = (j == x) ? c : mine; }
        if (sum == G) break;
        __builtin_amdgcn_s_sleep(1);
        if ((++sp & 255u) == 0u) { if (xb_ld(&bar[XB_TMO])) break; if (sp > XB_SPIN_CAP) { atomicAdd(&bar[XB_TMO], 1u); break; } }
    }
    nloc = mine > 0u ? mine : 1u; nx = cnt > 0u ? cnt : 1u;
}
__device__ __forceinline__ void xcd_barrier(const XcdBarrier& b) {
    asm volatile("s_waitcnt vmcnt(0)" ::: "memory");
    __syncthreads();
    if (threadIdx.x == 0) {
        unsigned* bar = b.bar;
        __builtin_amdgcn_s_waitcnt(0);
        unsigned nloc = b.st[0], nx = b.st[1];
        if (nloc == 0u) { xcd_barrier_complete(bar, b.x, nloc, nx); b.st[0] = nloc; b.st[1] = nx; }
        const unsigned old = xb_add(&bar[XB_XSUB(b.x)], 1u);
        const unsigned gen = old / nloc;
        if (old + 1u == (gen + 1u) * nloc) {
            __builtin_amdgcn_fence(__ATOMIC_RELEASE, "agent");
            asm volatile("s_waitcnt vmcnt(0)" ::: "memory");
            const unsigned og = xb_add(&bar[XB_TOP], 1u);
            const unsigned tg = og / nx;
            if (og + 1u == (tg + 1u) * nx) xb_add(&bar[XB_TOPGEN], 1u);
            else XB_SPIN(xb_ld(&bar[XB_TOPGEN]) == tg, bar);
            __builtin_amdgcn_fence(__ATOMIC_ACQUIRE, "agent");
            xb_add(&bar[XB_XGEN(b.x)], 1u);
            asm volatile("s_waitcnt vmcnt(0)" ::: "memory");
        } else {
            XB_SPIN(xb_ld(&bar[XB_XGEN(b.x)]) == gen, bar);
            __builtin_amdgcn_fence(__ATOMIC_ACQUIRE, "agent");
            asm volatile("s_waitcnt vmcnt(0)" ::: "memory");
        }
    }
    __syncthreads();
}

struct Frame {
    LAS unsigned char* lds;
    volatile LAS unsigned* MISC;
    gu32* ctl;
    int tid, lane, wave, vcu, G;
    const float* in[24];
    float* out;
    unsigned char* ws;
};
enum { I_X = 0, I_C, I_ADAW, I_ADAB, I_NMIX, I_NFFN, I_WIN, I_CONVW, I_ALOG, I_DTB, I_ONORM, I_SINKS, I_RELB, I_WOUT, I_POOLW, I_POOLS, I_R1W, I_R1B, I_R2W, I_R2B, I_WG, I_WU, I_WDN, I_FNW };

__device__ __forceinline__ void p0_transpose_item(const float* W, int ldw, int K, bf16* WT, int dst_row0, LAS float* scr, int k0, int n0, int lane) {
    f32x4 w4[8];
#pragma unroll
    for (int i = 0; i < 8; ++i) { const int f = i * 64 + lane, kk = f >> 3, c4 = f & 7; w4[i] = __builtin_nontemporal_load((const f32x4*)(W + (size_t)(k0 + kk) * ldw + n0 + c4 * 4)); }
#pragma unroll
    for (int i = 0; i < 8; ++i) { const int f = i * 64 + lane, kk = f >> 3, c4 = f & 7; LAS float* d = scr + kk * 33 + c4 * 4; d[0] = w4[i].x; d[1] = w4[i].y; d[2] = w4[i].z; d[3] = w4[i].w; }
    LDS_WAIT(); asm volatile("" ::: "memory");
    const int c = lane & 7;
#pragma unroll
    for (int j = 0; j < 4; ++j) { const int n = (lane >> 3) + 8 * j; const LAS float* s = scr + (8 * c) * 33 + n;
        v4u o; o.x = pk2(s[0 * 33], s[1 * 33]); o.y = pk2(s[2 * 33], s[3 * 33]); o.z = pk2(s[4 * 33], s[5 * 33]); o.w = pk2(s[6 * 33], s[7 * 33]);
        __builtin_nontemporal_store(o, (GAS v4u*)(WT + (size_t)(dst_row0 + n) * K + k0 + 8 * c)); }
    LDS_WAIT(); asm volatile("" ::: "memory");
}
constexpr int CQ_ND = NEXP * 256, CQ_N = NEXP * 768;
constexpr int TQ_INPROJ = 6, TQ_GU = 5, TQ_DN = 3;
constexpr int IP_FULL = ((NTOK / 256) * (PIN / 256)) % 256;
constexpr int CQ_T2 = IP_FULL ? (256 - IP_FULL) * 8 * TQ_INPROJ : 0;
__device__ __forceinline__ void convert_item(Frame& F, int layer, int it, LAS float* scr) {
    if (it < CQ_ND) {
        const int e = it >> 8, q = it & 255, kb = q >> 5, nb = q & 31;
        const float* W = F.in[I_WDN] + (size_t)(layer * NEXP + e) * 512 * 1024;
        p0_transpose_item(W, 1024, 512, (bf16*)(F.ws + (layer ? WS_WD1 : WS_WD)), e * 1024 + nb * 32, scr, kb * 64, nb * 32, F.lane);
    } else {
        const int r0 = it - CQ_ND, e = r0 >> 9, r = r0 & 511, up = r >> 8, q = r & 255, kb = q >> 4, nb = q & 15;
        const float* W = (up ? F.in[I_WU] : F.in[I_WG]) + (size_t)(layer * NEXP + e) * 1024 * 512;
        p0_transpose_item(W, 512, 1024, (bf16*)(F.ws + WS_WGU), e * 1024 + (nb >> 2) * 256 + up * 128 + (nb & 3) * 32, scr, kb * 64, nb * 32, F.lane);
    }
}
__device__ __forceinline__ void convert_range(Frame& F, int layer, int first, int end, int start, int stride) {
    LAS float* scr = (LAS float*)(F.lds + RING_OFF + F.wave * 16384);
    for (int it = first + start; it < end; it += stride) convert_item(F, layer, it, scr);
}
__device__ __forceinline__ void p0_prologue(Frame& F) {
    LAS float* scr = (LAS float*)(F.lds + RING_OFF + F.wave * 16384);
    const int gw = F.vcu * NWAVES + F.wave, NGW = F.G * NWAVES;
    constexpr int IA = 16 * 64, IB = 16 * 24, IO = 16 * 32, IP = 4 * 32, NIT = IA + IB + IO + IP;
    for (int it = gw; it < NIT; it += NGW) {
        int r = it;
        if (r < IA) { p0_transpose_item(F.in[I_WIN], 2832, 1024, (bf16*)(F.ws + WS_WIN), (r % 64) * 32, scr, (r / 64) * 64, (r % 64) * 32, F.lane); continue; } r -= IA;
        if (r < IB) { p0_transpose_item(F.in[I_WIN] + 2064, 2832, 1024, (bf16*)(F.ws + WS_WIN), 2048 + (r % 24) * 32, scr, (r / 24) * 64, (r % 24) * 32, F.lane); continue; } r -= IB;
        if (r < IO) { p0_transpose_item(F.in[I_WOUT], 1024, 1024, (bf16*)(F.ws + WS_WOUT), (r % 32) * 32, scr, (r / 32) * 64, (r % 32) * 32, F.lane); continue; } r -= IO;
        { const int g = r >> 5, q = r & 31; p0_transpose_item(F.in[I_POOLW] + (size_t)g * 65536, 256, 256, (bf16*)(F.ws + WS_POOLW) + (size_t)g * 65536, (q & 7) * 32, scr, (q >> 3) * 64, (q & 7) * 32, F.lane); }
    }
    { float* WBA = (float*)(F.ws + WS_WBA); const int gt = F.vcu * 512 + F.tid;
      if (gt < 16 * 1024) { const int o = gt >> 10, k = gt & 1023; WBA[o * 1024 + k] = F.in[I_WIN][(size_t)k * 2832 + 2048 + o]; } }
    __syncthreads();
    {
        LAS float* red = (LAS float*)(F.lds + RING_OFF);
        const int ks = F.tid >> 4, cj = F.tid & 15;
        for (int u = F.vcu; u < 192; u += F.G) {
            const int l = u / 96, cb = u % 96;
            const float* W = F.in[I_ADAW] + (size_t)l * 1024 * 6144 + cb * 64 + cj * 4;
            f32x4 a0 = {0.f, 0.f, 0.f, 0.f}, a1 = {0.f, 0.f, 0.f, 0.f};
            for (int k = ks * 32; k < ks * 32 + 32; ++k) {
                const f32x4 w = *(const f32x4*)(W + (size_t)k * 6144);
                const float c0 = silu_f(F.in[I_C][k]), c1 = silu_f(F.in[I_C][1024 + k]);
                a0 += w * c0; a1 += w * c1;
            }
            *(LAS f32x4*)(red + (ks * 2 + 0) * 64 + cj * 4) = a0; *(LAS f32x4*)(red + (ks * 2 + 1) * 64 + cj * 4) = a1;
            __syncthreads();
            if (F.tid < 128) { const int b = F.tid >> 6, c = F.tid & 63; float s = 0.f;
                for (int q = 0; q < 32; ++q) s += red[(q * 2 + b) * 64 + c];
                ((float*)(F.ws + WS_MOD))[(size_t)(l * 2 + b) * 6144 + cb * 64 + c] = s + F.in[I_ADAB][l * 6144 + cb * 64 + c]; }
            __syncthreads();
        }
    }
}

struct RowVec { f32x4 v[4]; };
__device__ __forceinline__ RowVec load_row_f32(const float* row, int lane) { RowVec r; const GAS f32x4* p = (const GAS f32x4*)row + lane;
#pragma unroll
    for (int j = 0; j < 4; ++j) r.v[j] = p[64 * j]; return r; }
__device__ __forceinline__ void store_row_f32(float* row, int lane, const RowVec& r) { GAS f32x4* p = (GAS f32x4*)row + lane;
#pragma unroll
    for (int j = 0; j < 4; ++j) p[64 * j] = r.v[j]; }
__device__ __forceinline__ void store_row_bf16(bf16* row, int lane, const RowVec& r) { GAS v2u* p = (GAS v2u*)row + lane;
#pragma unroll
    for (int j = 0; j < 4; ++j) { v2u o; o.x = pk2(r.v[j].x, r.v[j].y); o.y = pk2(r.v[j].z, r.v[j].w); p[64 * j] = o; } }
__device__ __forceinline__ void load_row_bf16(const bf16* row, int lane, v2u (&p)[4]) { const GAS v2u* q = (const GAS v2u*)row + lane;
#pragma unroll
    for (int j = 0; j < 4; ++j) p[j] = q[64 * j]; }
__device__ __forceinline__ RowVec unpack_row_bf16(const v2u (&p)[4]) { RowVec r;
#pragma unroll
    for (int j = 0; j < 4; ++j) { r.v[j].x = bflo(p[j].x); r.v[j].y = bfhi(p[j].x); r.v[j].z = bflo(p[j].y); r.v[j].w = bfhi(p[j].y); } return r; }
__device__ __forceinline__ float row_rstd(const RowVec& r) { float s = 0.f;
#pragma unroll
    for (int j = 0; j < 4; ++j) s += (r.v[j].x * r.v[j].x + r.v[j].y * r.v[j].y) + (r.v[j].z * r.v[j].z + r.v[j].w * r.v[j].w);
    return 1.0f / sqrtf(wave_sum(s) * (1.f / D) + EPS); }
struct ModVec { f32x4 a[4], b[4]; };
__device__ __forceinline__ ModVec load_mod(const float* w, const float* sc, const float* sh, int lane) { ModVec m;
#pragma unroll
    for (int j = 0; j < 4; ++j) { const f32x4 wv = *((const f32x4*)w + lane + 64 * j), s = *((const f32x4*)sc + lane + 64 * j); m.a[j] = wv * (s + 1.0f); m.b[j] = *((const f32x4*)sh + lane + 64 * j); }
    return m; }
__device__ __forceinline__ RowVec apply_mod(const RowVec& x, float rstd, const ModVec& m) { RowVec h;
#pragma unroll
    for (int j = 0; j < 4; ++j) h.v[j] = x.v[j] * rstd * m.a[j] + m.b[j]; return h; }

__device__ __forceinline__ void p1_prenorm0(Frame& F) {
    LAS float* wba = (LAS float*)(F.lds + RING_OFF);
    { const float* WBA = (const float*)(F.ws + WS_WBA); for (int i = F.tid; i < 16 * 256; i += 512) *((LAS f32x4*)wba + i) = *((const f32x4*)WBA + i); }
    __syncthreads();
    const float* mod = (const float*)(F.ws + WS_MOD);
    bf16* H = (bf16*)(F.ws + WS_H); float* BG = (float*)(F.ws + WS_BG);
    const int tok0 = F.vcu * (NTOK / F.G) + F.wave * (NTOK / F.G / NWAVES), ntw = NTOK / F.G / NWAVES;
    const int b = tok0 / SEQ;
    const ModVec m = load_mod(F.in[I_NMIX], mod + (size_t)b * 6144 + 1024, mod + (size_t)b * 6144, F.lane);
    const int hh = F.lane & 7;
    const float nega = -__expf(F.in[I_ALOG][hh]), dtb = F.in[I_DTB][hh];
    RowVec xn = load_row_f32(F.in[I_X] + (size_t)tok0 * D, F.lane);
    for (int i = 0; i < ntw; ++i) {
        const int t = tok0 + i;
        const RowVec x = xn;
        if (i + 1 < ntw) xn = load_row_f32(F.in[I_X] + (size_t)(t + 1) * D, F.lane);
        const RowVec h = apply_mod(x, row_rstd(x), m);
        store_row_bf16(H + (size_t)t * D, F.lane, h);
        float mine = 0.f;
#pragma unroll 2
        for (int o = 0; o < 16; ++o) { float s = 0.f;
#pragma unroll
            for (int j = 0; j < 4; ++j) { const f32x4 w = *((const LAS f32x4*)(wba + o * 1024) + F.lane + 64 * j); s += (h.v[j].x * w.x + h.v[j].y * w.y) + (h.v[j].z * w.z + h.v[j].w * w.w); }
            s = wave_sum(s); if (F.lane == o) mine = s; }
        if (F.lane < 8) BG[(size_t)t * 16 + F.lane] = sigmoid_f(mine);
        else if (F.lane < 16) BG[(size_t)t * 16 + F.lane] = nega * softplus_f(mine + dtb);
    }
}

struct DenseSched {
    int nM, nN, nwg, G, c; unsigned lda2, acol2; const char* B; size_t btile;
    __device__ __forceinline__ void init(int M, int N, int G_, int c_, int lda, int acolstride, const void* B_, int ldb) { nM = M / 256; nN = N / 256; nwg = nM * nN; G = G_; c = c_; lda2 = (unsigned)lda * 2u; acol2 = (unsigned)acolstride * 2u; B = (const char*)B_; btile = (size_t)256 * ldb * 2; }
    __device__ __forceinline__ bool next(int i, pg8::Unit& u) const {
        const long L = (long)i * G + c; if (L >= nwg) return false;
        int wgid = (int)L; { const int q = nwg / 8, r = nwg % 8, xcd = wgid % 8, off = wgid / 8; wgid = (xcd < r ? xcd * (q + 1) : r * (q + 1) + (xcd - r) * q) + off; }
        const int nig = 8 * nN, gid = wgid / nig, fm = gid * 8, gsz = (nM - fm) < 8 ? (nM - fm) : 8;
        u.pm = fm + ((wgid % nig) % gsz); u.pn = (wgid % nig) / gsz; u.e = 0; return true;
    }
    __device__ __forceinline__ unsigned a_off(const pg8::Unit& u, int r) const { return (unsigned)(u.pm * 256 + r) * lda2 + (unsigned)u.pn * acol2; }
    __device__ __forceinline__ const char* b_ptr(const pg8::Unit& u) const { return B + (size_t)u.pn * btile; }
};
struct MoeSched {
    const LAS int* cnt; const LAS int* tbase; const LAS int* tileExp;
    int nunits, chunk, G, c; const int* RT; const char* B; size_t bexp, btile; unsigned arow2;
    __device__ __forceinline__ void init(const LAS int* tables, int G_, int c_, const int* RT_, const void* B_, int ldb, int lda) {
        cnt = tables; tbase = tables + 32; tileExp = tables + 80; G = G_; c = c_; RT = RT_; B = (const char*)B_; bexp = (size_t)1024 * ldb * 2; btile = (size_t)256 * ldb * 2; arow2 = (unsigned)lda * 2u;
        nunits = tbase[32] * 4; chunk = ((nunits + 7) / 8 + 3) & ~3;
    }
    __device__ __forceinline__ bool next(int i, pg8::Unit& u) const {
        const int w = i * (G / 8) + (c >> 3); if (w >= chunk) return false;
        const int L = (c & 7) * chunk + w; if (L >= nunits) return false;
        u.pm = L >> 2; u.pn = L & 3; u.e = tileExp[u.pm]; return true;
    }
    __device__ __forceinline__ unsigned a_off(const pg8::Unit& u, int r) const {
        if (RT) { const int pos = (u.pm - tbase[u.e]) * 256 + r; const int tok = pos < cnt[u.e] ? RT[u.e * NTOK + pos] : 0; return (unsigned)tok * arow2; }
        return (unsigned)(u.pm * 256 + r) * arow2;
    }
    __device__ __forceinline__ const char* b_ptr(const pg8::Unit& u) const { return B + (size_t)u.e * bexp + (size_t)u.pn * btile; }
};
__device__ __forceinline__ void build_moe_tables(Frame& F, int layer) {
    LAS int* T = (LAS int*)(F.lds + SCHED_OFF);
    int tid_ = F.tid; asm volatile("" : "+v"(tid_));
    if (tid_ < 32) T[tid_] = (int)__hip_atomic_load(F.ctl + CW_CNT + 64 * layer + tid_, RLX_AGENT);
    __syncthreads();
    if (F.tid == 0) { int acc = 0; for (int e = 0; e < 32; ++e) { T[32 + e] = acc; const int nt = (T[e] + 255) >> 8; for (int j = 0; j < nt; ++j) T[80 + acc + j] = e; acc += nt; } T[64] = acc; }
    __syncthreads();
}

__device__ __forceinline__ int moe_units_of(int c, int G, int nunits, int chunk) {
    const int sl = c >> 3, x = c & 7, per = G / 8; int U = nunits - x * chunk; U = U < 0 ? 0 : (U > chunk ? chunk : U);
    return sl < U ? (U - sl + per - 1) / per : 0;
}
__device__ __forceinline__ void moe_tail_plan(Frame& F) {
    LAS int* T = (LAS int*)(F.lds + SCHED_OFF);
    if (F.tid == 0) { T[65] = 0; T[66] = 0; }
    __syncthreads();
    if (F.tid < 256) {
        const int nunits = T[64] * 4, chunk = ((nunits + 7) / 8 + 3) & ~3, per = F.G / 8, maxu = (chunk + per - 1) / per, c = (int)blockIdx.x;
        const int sp = F.tid < F.G ? maxu - moe_units_of(F.tid, F.G, nunits, chunk) : 0;
        const int lower = (int)wave_sum(F.tid < c ? (float)sp : 0.f), all = (int)wave_sum((float)sp);
        if (F.lane == 0) { atomicAdd((int*)(T + 65), lower); atomicAdd((int*)(T + 66), all); }
        if (F.tid == c) T[67] = sp;
    }
    __syncthreads();
}

struct EpiStoreBf16 {
    bf16* O; int ldc;
    __device__ __forceinline__ void operator()(const f32x4 (&acc)[2][2][4][2], const pg8::Unit& u, int wr, int wc, int fr, int fq) const {
        const int row0 = u.pm * 256 + wr * 64 + fr, col0 = u.pn * 256 + wc * 32 + 8 * fq;
#pragma unroll
        for (int ai = 0; ai < 2; ++ai)
#pragma unroll
            for (int m = 0; m < 4; ++m) { bf16* rowp = O + (size_t)(row0 + ai * 128 + m * 16) * ldc + col0;
#pragma unroll
                for (int bj = 0; bj < 2; ++bj) { const f32x4 v0 = acc[ai][bj][m][0], v1 = acc[ai][bj][m][1];
                    v4u w; w.x = pk2(v0[0], v0[1]); w.y = pk2(v0[2], v0[3]); w.z = pk2(v1[0], v1[1]); w.w = pk2(v1[2], v1[3]);
                    *(v4u*)(rowp + bj * 128) = w; } }
    }
};
struct EpiSwiglu {
    bf16* O;
    __device__ __forceinline__ void operator()(const f32x4 (&acc)[2][2][4][2], const pg8::Unit& u, int wr, int wc, int fr, int fq) const {
        const int row0 = u.pm * 256 + wr * 64 + fr, col0 = u.pn * 128 + wc * 32 + 8 * fq;
#pragma unroll
        for (int ai = 0; ai < 2; ++ai)
#pragma unroll
            for (int m = 0; m < 4; ++m) { bf16* rowp = O + (size_t)(row0 + ai * 128 + m * 16) * DFF + col0;
                float r[8];
#pragma unroll
                for (int n = 0; n < 2; ++n)
#pragma unroll
                    for (int j = 0; j < 4; ++j) r[4 * n + j] = silu_f(acc[ai][0][m][n][j]) * acc[ai][1][m][n][j];
                v4u w; w.x = pk2(r[0], r[1]); w.y = pk2(r[2], r[3]); w.z = pk2(r[4], r[5]); w.w = pk2(r[6], r[7]);
                *(v4u*)rowp = w; }
    }
};

__device__ __forceinline__ void moe_route(Frame& F, int layer) {
    LAS int* hist = (LAS int*)(F.lds + RT_LDS_OFF);
    LAS int* base = hist + 32;
    LAS int* tinfo = hist + 64;
    LAS float* tg = (LAS float*)(hist + 64 + 512);
    if (F.tid < 32) hist[F.tid] = 0;
    LAS f32x4* R2 = (LAS f32x4*)(F.lds + RING_OFF);
    LAS f32x4* R1 = (LAS f32x4*)(F.lds + R1W_OFF);
    { const f32x4* g2p = (const f32x4*)(F.in[I_R2W] + (size_t)layer * 1024 * 32); const f32x4* g1p = (const f32x4*)(F.in[I_R1W] + (size_t)layer * 1024 * 4);
      for (int i = F.tid; i < 8192; i += 512) { const int k = i >> 3, c4 = i & 7, ln = (k & 255) >> 2, q = k & 3, j = k >> 8; R2[((j * 4 + q) * 8 + c4) * 64 + ln] = g2p[i]; }
      for (int k = F.tid; k < 1024; k += 512) { const int ln = (k & 255) >> 2, q = k & 3, j = k >> 8; R1[(j * 4 + q) * 64 + ln] = g1p[k]; } }
    __syncthreads();
    const float* mod = (const float*)(F.ws + WS_MOD) + (size_t)layer * 2 * 6144;
    bf16* H = (bf16*)(F.ws + WS_H);
    const int tokw = F.vcu * 128 + F.wave * 16, b = (F.vcu * 128) / SEQ;
    const ModVec m = load_mod(F.in[I_NFFN] + layer * D, mod + (size_t)b * 6144 + 4 * 1024, mod + (size_t)b * 6144 + 3 * 1024, F.lane);
    const float* r1b = F.in[I_R1B] + layer * 4; const float* r2b = F.in[I_R2B] + layer * 32;
    const float* xin = F.in[I_X]; bf16* XRB = (bf16*)(F.ws + WS_XRB); const bf16* YM = (const bf16*)(F.ws + WS_YM);
    f32x4 cf[4];
#pragma unroll
    for (int j = 0; j < 4; ++j) { cf[j] = *((const f32x4*)(mod + (size_t)b * 6144 + 2 * 1024) + F.lane + 64 * j); if (layer == 1) cf[j] *= *((const f32x4*)F.in[I_POOLS] + F.lane + 64 * j); }
    RowVec xn; v2u xbn[4], yn[4];
    if (layer == 0) xn = load_row_f32(xin + (size_t)tokw * D, F.lane); else load_row_bf16(XRB + (size_t)tokw * D, F.lane, xbn);
#pragma unroll
    for (int j = 0; j < 4; ++j) yn[j] = *((const GAS v2u*)(YM + (size_t)tokw * D) + F.lane + 64 * j);
    for (int i = 0; i < 16; ++i) {
        const int t = tokw + i;
        RowVec x; v2u yc[4];
        if (layer == 0) x = xn; else x = unpack_row_bf16(xbn);
#pragma unroll
        for (int j = 0; j < 4; ++j) yc[j] = yn[j];
        if (i + 1 < 16) { if (layer == 0) xn = load_row_f32(xin + (size_t)(t + 1) * D, F.lane); else load_row_bf16(XRB + (size_t)(t + 1) * D, F.lane, xbn);
#pragma unroll
            for (int j = 0; j < 4; ++j) yn[j] = *((const GAS v2u*)(YM + (size_t)(t + 1) * D) + F.lane + 64 * j); }
#pragma unroll
        for (int j = 0; j < 4; ++j) { f32x4 yv; yv.x = bflo(yc[j].x); yv.y = bfhi(yc[j].x); yv.z = bflo(yc[j].y); yv.w = bfhi(yc[j].y); x.v[j] += cf[j] * yv; }
        store_row_bf16(XRB + (size_t)t * D, F.lane, x);
        RowVec h = apply_mod(x, row_rstd(x), m);
        store_row_bf16(H + (size_t)t * D, F.lane, h);
        f32x4 l1 = {0.f, 0.f, 0.f, 0.f};
#pragma unroll
        for (int j = 0; j < 4; ++j)
#pragma unroll
            for (int q = 0; q < 4; ++q) l1 += R1[(j * 4 + q) * 64 + F.lane] * h.v[j][q];
        float lg[4];
#pragma unroll
        for (int g = 0; g < 4; ++g) lg[g] = wave_sum(l1[g]) + r1b[g];
        int grp = 0; float mx = lg[0];
#pragma unroll
        for (int g = 1; g < 4; ++g) if (lg[g] > mx) { mx = lg[g]; grp = g; }
        float se = 0.f;
#pragma unroll
        for (int g = 0; g < 4; ++g) se += __expf(lg[g] - mx);
        const float ptop = 1.0f / se;
        grp = __builtin_amdgcn_readfirstlane(grp);
        f32x4 a0 = {0.f, 0.f, 0.f, 0.f}, a1 = {0.f, 0.f, 0.f, 0.f};
#pragma unroll
        for (int j = 0; j < 4; ++j)
#pragma unroll
            for (int q = 0; q < 4; ++q) { const LAS f32x4* wp = R2 + ((j * 4 + q) * 8 + grp * 2) * 64 + F.lane;
                a0 += wp[0] * h.v[j][q]; a1 += wp[64] * h.v[j][q]; }
        float l2[8];
#pragma unroll
        for (int q = 0; q < 4; ++q) { l2[q] = wave_sum(a0[q]) + r2b[grp * 8 + q]; l2[4 + q] = wave_sum(a1[q]) + r2b[grp * 8 + 4 + q]; }
        int i0 = 0; float v0 = l2[0];
#pragma unroll
        for (int q = 1; q < 8; ++q) if (l2[q] > v0) { v0 = l2[q]; i0 = q; }
        int i1 = (i0 == 0) ? 1 : 0; float v1 = l2[i1 == 1 ? 1 : 0];
#pragma unroll
        for (int q = 0; q < 8; ++q) if (q != i0 && l2[q] > v1) { v1 = l2[q]; i1 = q; }
        const float g0 = ptop / (1.0f + __expf(v1 - v0)), g1 = ptop - g0;
        if (F.lane == 0) { const int e0 = grp * 8 + i0, e1 = grp * 8 + i1, li = F.wave * 16 + i;
            tinfo[li * 4 + 0] = e0; tinfo[li * 4 + 1] = e1; tinfo[li * 4 + 2] = atomicAdd((int*)(hist + e0), 1); tinfo[li * 4 + 3] = atomicAdd((int*)(hist + e1), 1);
            tg[li * 2] = g0; tg[li * 2 + 1] = g1;
            { float* GA = (float*)(F.ws + WS_BG); GA[(size_t)t * 2] = g0; GA[(size_t)t * 2 + 1] = g1; }
        }
    }
    __syncthreads();
    if (F.tid < 32) base[F.tid] = (int)__hip_atomic_fetch_add(F.ctl + CW_CNT + 64 * layer + F.tid, (unsigned)hist[F.tid], RLX_AGENT);
    __syncthreads();
    if (F.tid < 128) { const int t = F.vcu * 128 + F.tid; const int e0 = tinfo[F.tid * 4], e1 = tinfo[F.tid * 4 + 1];
        const int p0 = base[e0] + tinfo[F.tid * 4 + 2], p1 = base[e1] + tinfo[F.tid * 4 + 3];
        int* RT = (int*)(F.ws + WS_RT); RT[e0 * NTOK + p0] = t; RT[e1 * NTOK + p1] = t;
        v4u r0; r0.x = e0; r0.y = e1; r0.z = p0; r0.w = p1; v4u r1; r1.x = __builtin_bit_cast(unsigned, tg[F.tid * 2]); r1.y = __builtin_bit_cast(unsigned, tg[F.tid * 2 + 1]); r1.z = 0; r1.w = 0;
        v4u* RO = (v4u*)(F.ws + WS_ROUTE) + (size_t)t * 2; RO[0] = r0; (void)r1; }
    __syncthreads();
}

struct CombRows { v2u xb[4], ya[4], yb[4]; };
struct CombRecs { v4u rec; float ga, gb; };
__device__ __forceinline__ CombRecs comb_load_recs(Frame& F, int tokw) { CombRecs c; const int t = tokw + (F.lane & 15);
    c.rec = *((const v4u*)(F.ws + WS_ROUTE) + (size_t)t * 2); const float* GA = (const float*)(F.ws + WS_BG); c.ga = GA[(size_t)t * 2]; c.gb = GA[(size_t)t * 2 + 1]; return c; }
__device__ __forceinline__ int rl_i(int v, int l) { return __builtin_amdgcn_readlane(v, l); }
__device__ __forceinline__ void comb_issue(Frame& F, const CombRecs& c, int i, int t, CombRows& r) {
    const LAS int* T = (const LAS int*)(F.lds + SCHED_OFF);
    const int e0 = rl_i((int)c.rec.x, i), e1 = rl_i((int)c.rec.y, i), p0 = rl_i((int)c.rec.z, i), p1 = rl_i((int)c.rec.w, i);
    const size_t rowa = (size_t)T[32 + e0] * 256 + p0, rowb = (size_t)T[32 + e1] * 256 + p1;
    const bf16* Y = (const bf16*)(F.ws + WS_Y);
    const GAS v2u* ya = (const GAS v2u*)(Y + rowa * D) + F.lane; const GAS v2u* yb = (const GAS v2u*)(Y + rowb * D) + F.lane;
    load_row_bf16((const bf16*)(F.ws + WS_XRB) + (size_t)t * D, F.lane, r.xb);
#pragma unroll
    for (int j = 0; j < 4; ++j) { r.ya[j] = ya[64 * j]; r.yb[j] = yb[64 * j]; }
}
__device__ __forceinline__ RowVec comb_finish(const CombRecs& c, int i, const CombRows& r, const f32x4 (&g2)[4]) {
    const float ga = rl(c.ga, i), gb = rl(c.gb, i); RowVec x = unpack_row_bf16(r.xb);
#pragma unroll
    for (int j = 0; j < 4; ++j) { const v2u a = r.ya[j], bq = r.yb[j];
        f32x4 s; s.x = ga * bflo(a.x) + gb * bflo(bq.x); s.y = ga * bfhi(a.x) + gb * bfhi(bq.x); s.z = ga * bflo(a.y) + gb * bflo(bq.y); s.w = ga * bfhi(a.y) + gb * bfhi(bq.y);
        x.v[j] += g2[j] * s; }
    return x;
}

__device__ __forceinline__ void attn_phase(Frame& F, const int u_first, const int u_stride) {
    LAS bf16* KS = (LAS bf16*)(F.lds + RING_OFF);
    LAS bf16* VT = (LAS bf16*)(F.lds + RING_OFF + 36864);
    LAS float* BT = (LAS float*)(F.lds + RING_OFF + 36864 + 33280);
    const bf16* PROJ = (const bf16*)(F.ws + WS_PROJ); bf16* OAB = (bf16*)(F.ws + WS_OAB);
    const int lane = F.lane, lc = lane & 31, lh = lane >> 5;
    for (int unit = u_first; unit < 512; unit += u_stride) {
        const int b = unit >> 8, kvh = (unit >> 7) & 1, qb = unit & 127, t0 = qb * 128;
        __syncthreads();
        for (int i = F.tid; i < 4 * 192; i += 512) { const int hq = i / 192, x = i - hq * 192, dist = 159 - x; float v = 0.f;
            if (dist >= 0 && dist < 128) { int bk = dist; if (dist >= 16) { bk = 16 + (int)(logf((float)dist / 16.0f) / 2.0794415416798357f * 16.0f); bk = bk > 31 ? 31 : bk; }
                v = F.in[I_RELB][bk * 8 + kvh * 4 + hq] * 1.4426950408889634f; }
            BT[i] = v; }
#pragma unroll
        for (int cc = 0; cc < 4; ++cc) { const int ch = F.tid + 512 * cc, key = ch >> 3, part = ch & 7, tl = t0 - 128 + key;
            v4u kv = {0u, 0u, 0u, 0u}, vv = {0u, 0u, 0u, 0u};
            if (tl >= 0) { const bf16* rp = PROJ + (size_t)(b * SEQ + tl) * PIN; kv = *(const v4u*)(rp + PC_KB + kvh * 64 + part * 8); vv = *(const v4u*)(rp + PC_VB + kvh * 64 + part * 8); }
            *(LAS v4u*)(KS + key * 72 + part * 8) = kv;
            const unsigned w[4] = {vv.x, vv.y, vv.z, vv.w};
#pragma unroll
            for (int q = 0; q < 4; ++q) { VT[(part * 8 + 2 * q) * 260 + key] = (bf16)(w[q] & 0xffffu); VT[(part * 8 + 2 * q + 1) * 260 + key] = (bf16)(w[q] >> 16); } }
        __syncthreads();
#pragma unroll 1
        for (int tt = 0; tt < 2; ++tt) {
            const int task = F.wave * 2 + tt, hq = task >> 2, qt = task & 3, qh = kvh * 4 + hq;
            const int qi = 32 * qt + lc;
            const bf16* qrow = PROJ + (size_t)(b * SEQ + t0 + qi) * PIN + PC_QB + qh * 64 + 8 * lh;
            bf16x8 qf[4];
#pragma unroll
            for (int s = 0; s < 4; ++s) qf[s] = *(const bf16x8*)(qrow + 16 * s);
            f32x16 sc[5];
#pragma unroll
            for (int kt = 0; kt < 5; ++kt) {
#pragma unroll
                for (int r = 0; r < 16; ++r) sc[kt][r] = 0.f;
                const LAS bf16* kp = KS + (32 * (qt + kt) + lc) * 72 + 8 * lh;
#pragma unroll
                for (int s = 0; s < 4; ++s) { const bf16x8 kf = *(const LAS bf16x8*)(kp + 16 * s); sc[kt] = __builtin_amdgcn_mfma_f32_32x32x16_bf16(kf, qf[s], sc[kt], 0, 0, 0); }
            }
            const float sink2 = F.in[I_SINKS][qh] * 1.4426950408889634f;
            const LAS float* bp = BT + hq * 192 + (4 * lh - lc + 31);
            const int m_lo = lc + 1 - 4 * lh, m_hi = lc - 4 * lh;
            float mx = sink2;
#pragma unroll
            for (int kt = 0; kt < 5; ++kt) {
                const bool dead = (t0 == 0) && (qt + kt < 4);
#pragma unroll
                for (int r = 0; r < 16; ++r) { const int cr = (r & 3) + 8 * (r >> 2);
                    float v = sc[kt][r] * (0.125f * 1.4426950408889634f) + bp[32 * kt + cr];
                    if (kt == 0) v = (cr >= m_lo) ? v : -1e30f;
                    if (kt == 4) v = (cr <= m_hi) ? v : -1e30f;
                    if (dead) v = -1e30f;
                    sc[kt][r] = v; mx = fmaxf(mx, v); } }
            mx = fmaxf(mx, __shfl_xor(mx, 32));
            float den = 0.f;
#pragma unroll
            for (int kt = 0; kt < 5; ++kt)
#pragma unroll
                for (int r = 0; r < 16; ++r) { const float p = __builtin_amdgcn_exp2f(sc[kt][r] - mx); sc[kt][r] = p; den += p; }
            den += __shfl_xor(den, 32);
            den += __builtin_amdgcn_exp2f(sink2 - mx);
            const float inv = 1.0f / den;
            f32x16 oa[2];
#pragma unroll
            for (int dt = 0; dt < 2; ++dt)
#pragma unroll
                for (int r = 0; r < 16; ++r) oa[dt][r] = 0.f;
#pragma unroll
            for (int kt = 0; kt < 5; ++kt)
#pragma unroll
                for (int s2 = 0; s2 < 2; ++s2) {
                    v4u pw; pw.x = pk2(sc[kt][8 * s2 + 0], sc[kt][8 * s2 + 1]); pw.y = pk2(sc[kt][8 * s2 + 2], sc[kt][8 * s2 + 3]); pw.z = pk2(sc[kt][8 * s2 + 4], sc[kt][8 * s2 + 5]); pw.w = pk2(sc[kt][8 * s2 + 6], sc[kt][8 * s2 + 7]);
                    const bf16x8 pf = __builtin_bit_cast(bf16x8, pw);
#pragma unroll
                    for (int dt = 0; dt < 2; ++dt) { const LAS bf16* vp = VT + (32 * dt + lc) * 260 + 32 * (qt + kt) + 16 * s2 + 4 * lh;
                        const v2u va = *(const LAS v2u*)vp, vb = *(const LAS v2u*)(vp + 8);
                        v4u vw; vw.x = va.x; vw.y = va.y; vw.z = vb.x; vw.w = vb.y;
                        oa[dt] = __builtin_amdgcn_mfma_f32_32x32x16_bf16(__builtin_bit_cast(bf16x8, vw), pf, oa[dt], 0, 0, 0); }
                }
            bf16* orow = OAB + (size_t)(b * SEQ + t0 + qi) * D + 512 + qh * 64 + 4 * lh;
#pragma unroll
            for (int dt = 0; dt < 2; ++dt)
#pragma unroll
                for (int rg = 0; rg < 4; ++rg) { v2u o; o.x = pk2(oa[dt][4 * rg] * inv, oa[dt][4 * rg + 1] * inv); o.y = pk2(oa[dt][4 * rg + 2] * inv, oa[dt][4 * rg + 3] * inv);
                    *(v2u*)(orow + 32 * dt + 8 * rg) = o; }
        }
    }
    __syncthreads();
}


constexpr int DN_ST = 72;

__device__ __forceinline__ bf16x8 pack8(const f32x16& x, int s) { v4u p; p.x = pk2(x[8 * s], x[8 * s + 1]); p.y = pk2(x[8 * s + 2], x[8 * s + 3]); p.z = pk2(x[8 * s + 4], x[8 * s + 5]); p.w = pk2(x[8 * s + 6], x[8 * s + 7]); return __builtin_bit_cast(bf16x8, p); }
__device__ __forceinline__ f32x16 dn_tile(const LAS bf16* A, int ra, const LAS bf16* B, int rb, int lc, int lh) {
    f32x16 acc;
#pragma unroll
    for (int r = 0; r < 16; ++r) acc[r] = 0.f;
#pragma unroll
    for (int s = 0; s < 4; ++s) { const bf16x8 a = *(const LAS bf16x8*)(A + (ra + lc) * DN_ST + 16 * s + 8 * lh), b = *(const LAS bf16x8*)(B + (rb + lc) * DN_ST + 16 * s + 8 * lh);
        acc = __builtin_amdgcn_mfma_f32_32x32x16_bf16(a, b, acc, 0, 0, 0); }
    return acc;
}
__device__ __forceinline__ void dn_prep(Frame& F) {
    LAS bf16* Qs = (LAS bf16*)(F.lds + RING_OFF);
    LAS bf16* Ks = Qs + 64 * DN_ST;
    LAS bf16* KBs = Ks + 64 * DN_ST;
    LAS bf16* Vs = KBs + 64 * DN_ST;
    LAS bf16* KDT = Vs + 64 * DN_ST;
    LAS bf16* AQK = KDT + 64 * DN_ST;
    LAS bf16* UT = AQK + 64 * DN_ST;
    LAS bf16* WT = UT + 64 * DN_ST;
    LAS bf16* LNO = WT + 64 * DN_ST;
    LAS float* LD = (LAS float*)(LNO + 64 * DN_ST);
    LAS bf16* TDZ = (LAS bf16*)(LD + 64 * 16);
    LAS float* gcs = (LAS float*)(TDZ + 64 * 24);
    LAS float* bts = gcs + 64;
    const bf16* PROJ = (const bf16*)(F.ws + WS_PROJ); const float* BG = (const float*)(F.ws + WS_BG);
    const int tid = F.tid, lane = F.lane, lc = lane & 31, lh = lane >> 5, wave = F.wave;
    LAS float* CW = bts + 64;
    for (int i = tid; i < 1536; i += 512) *((LAS f32x4*)CW + i) = *((const f32x4*)F.in[I_CONVW] + i);
    for (int unit = F.vcu; unit < 4096; unit += F.G) {
        const int b = unit >> 11, h = (unit >> 8) & 7, n = unit & 255;
        const size_t row0 = (size_t)b * SEQ + (size_t)n * 64;
        __syncthreads();
        if (wave == 0) { const float g = BG[(row0 + lane) * 16 + 8 + h]; float c = g;
#pragma unroll
            for (int o = 1; o < 64; o <<= 1) { const float up = __shfl_up(c, o); if (lane >= o) c += up; }
            gcs[lane] = c; bts[lane] = BG[(row0 + lane) * 16 + h]; }
        __syncthreads();
        { const int t = tid >> 3, cs = tid & 7; const int tl = n * 64 + t;
          float q[8], k[8], v[8];
#pragma unroll
          for (int e = 0; e < 8; ++e) { q[e] = 0.f; k[e] = 0.f; v[e] = 0.f; }
#pragma unroll
          for (int j = 0; j < 4; ++j) { if (tl - 3 + j >= 0) { const bf16* rp = PROJ + (row0 + t - 3 + j) * PIN + h * 64 + cs * 8;
                const v4u wq = *(const v4u*)(rp + PC_QA), wk = *(const v4u*)(rp + PC_KA), wv = *(const v4u*)(rp + PC_VA);
                const LAS float* cw = CW + j * 1536 + h * 64 + cs * 8;
                const unsigned uq[4] = {wq.x, wq.y, wq.z, wq.w}, uk[4] = {wk.x, wk.y, wk.z, wk.w}, uv[4] = {wv.x, wv.y, wv.z, wv.w};
#pragma unroll
                for (int e = 0; e < 4; ++e) { q[2 * e] += cw[2 * e] * bflo(uq[e]); q[2 * e + 1] += cw[2 * e + 1] * bfhi(uq[e]);
                    k[2 * e] += cw[512 + 2 * e] * bflo(uk[e]); k[2 * e + 1] += cw[512 + 2 * e + 1] * bfhi(uk[e]);
                    v[2 * e] += cw[1024 + 2 * e] * bflo(uv[e]); v[2 * e + 1] += cw[1024 + 2 * e + 1] * bfhi(uv[e]); } } }
          float sq = 0.f, sk = 0.f;
#pragma unroll
          for (int e = 0; e < 8; ++e) { q[e] = silu_f(q[e]); k[e] = silu_f(k[e]); v[e] = silu_f(v[e]); sq += q[e] * q[e]; sk += k[e] * k[e]; }
          sq = oct_sum(sq); sk = oct_sum(sk);
          const float rq = 0.125f / sqrtf(sq + EPS), rk = 1.0f / sqrtf(sk + EPS), bt = bts[t], kd = __expf(gcs[63] - gcs[t]);
          v4u oq, ok, ob, ov;
          oq.x = pk2(q[0] * rq, q[1] * rq); oq.y = pk2(q[2] * rq, q[3] * rq); oq.z = pk2(q[4] * rq, q[5] * rq); oq.w = pk2(q[6] * rq, q[7] * rq);
#pragma unroll
          for (int e = 0; e < 8; ++e) k[e] *= rk;
          ok.x = pk2(k[0], k[1]); ok.y = pk2(k[2], k[3]); ok.z = pk2(k[4], k[5]); ok.w = pk2(k[6], k[7]);
          ob.x = pk2(k[0] * bt, k[1] * bt); ob.y = pk2(k[2] * bt, k[3] * bt); ob.z = pk2(k[4] * bt, k[5] * bt); ob.w = pk2(k[6] * bt, k[7] * bt);
          ov.x = pk2(v[0], v[1]); ov.y = pk2(v[2], v[3]); ov.z = pk2(v[4], v[5]); ov.w = pk2(v[6], v[7]);
          *(LAS v4u*)(Qs + t * DN_ST + cs * 8) = oq; *(LAS v4u*)(Ks + t * DN_ST + cs * 8) = ok; *(LAS v4u*)(KBs + t * DN_ST + cs * 8) = ob; *(LAS v4u*)(Vs + t * DN_ST + cs * 8) = ov;
#pragma unroll
          for (int e = 0; e < 8; ++e) KDT[(cs * 8 + e) * DN_ST + t] = (bf16)f2bf(k[e] * kd); }
        __syncthreads();
        { const int it = (wave >> 1) & 1, jt = wave & 1; const bool qk = wave >= 4;
          f32x16 acc;
          if (it >= jt) acc = dn_tile(qk ? Qs : KBs, 32 * it, Ks, 32 * jt, lc, lh);
          const int j = 32 * jt + lc; const float gj = gcs[j];
#pragma unroll
          for (int r = 0; r < 16; ++r) { const int i = 32 * it + (r & 3) + 8 * (r >> 2) + 4 * lh;
              float val = 0.f;
              if (it >= jt) { if (qk ? (i >= j) : (i > j)) val = acc[r] * __expf(gcs[i] - gj); }
              if (qk) AQK[i * DN_ST + j] = (bf16)f2bf(val);
              else { const bool diag = (i >> 4) == (j >> 4); LNO[i * DN_ST + j] = (bf16)f2bf(diag ? 0.f : -val); if (diag) LD[i * 16 + (j & 15)] = val; } } }
        __syncthreads();
        if (wave == 0) { const int bb = lane >> 4, c = lane & 15; float tcol[16];
#pragma unroll
            for (int i = 0; i < 16; ++i) { float v = (i == c) ? 1.f : 0.f;
#pragma unroll
                for (int j4 = 0; j4 < (i + 3) / 4; ++j4) { const f32x4 a = *(const LAS f32x4*)(LD + (16 * bb + i) * 16 + 4 * j4);
#pragma unroll
                    for (int e = 0; e < 4; ++e) if (4 * j4 + e < i) v -= a[e] * tcol[4 * j4 + e]; }
                tcol[i] = v; TDZ[(16 * bb + i) * 24 + c] = (bf16)f2bf(v); } }
        __syncthreads();
        if (wave < 4) {
            const int ct = wave, cc = 32 * (ct & 1) + lc; const bool isw = ct >= 2;
            f32x16 acc[2];
#pragma unroll
            for (int rt = 0; rt < 2; ++rt)
#pragma unroll
                for (int r = 0; r < 16; ++r) { const int t = 32 * rt + (r & 3) + 8 * (r >> 2) + 4 * lh;
                    acc[rt][r] = isw ? bf2f(Ks[t * DN_ST + cc]) * bts[t] * __expf(gcs[t]) : bf2f(Vs[t * DN_ST + cc]) * bts[t]; }
#define DN_AFRAG(arr, stride, row, kb) ({ const LAS bf16* p_ = (arr) + (row) * (stride) + 16 * (kb) + 4 * lh; const v2u lo_ = *(const LAS v2u*)p_, hi_ = *(const LAS v2u*)(p_ + 8); v4u w_; w_.x = lo_.x; w_.y = lo_.y; w_.z = hi_.x; w_.w = hi_.y; __builtin_bit_cast(bf16x8, w_); })
            f32x16 X[4];
#pragma unroll
            for (int bb = 0; bb < 4; ++bb) { const int rt = bb >> 1, odd = bb & 1;
                bf16x8 ta = DN_AFRAG(TDZ, 24, 32 * rt + lc, 0);
                if ((lc >> 4) != odd) ta = (bf16x8){0, 0, 0, 0, 0, 0, 0, 0};
                f32x16 z;
#pragma unroll
                for (int r = 0; r < 16; ++r) z[r] = 0.f;
                z = __builtin_amdgcn_mfma_f32_32x32x16_bf16(ta, pack8(acc[rt], odd), z, 0, 0, 0);
                X[bb] = z;
                const bf16x8 xb = pack8(z, odd);
                if (bb == 0) { acc[0] = __builtin_amdgcn_mfma_f32_32x32x16_bf16(DN_AFRAG(LNO, DN_ST, lc, 0), xb, acc[0], 0, 0, 0); acc[1] = __builtin_amdgcn_mfma_f32_32x32x16_bf16(DN_AFRAG(LNO, DN_ST, 32 + lc, 0), xb, acc[1], 0, 0, 0); }
                if (bb == 1) { acc[1] = __builtin_amdgcn_mfma_f32_32x32x16_bf16(DN_AFRAG(LNO, DN_ST, 32 + lc, 1), xb, acc[1], 0, 0, 0); }
                if (bb == 2) { acc[1] = __builtin_amdgcn_mfma_f32_32x32x16_bf16(DN_AFRAG(LNO, DN_ST, 32 + lc, 2), xb, acc[1], 0, 0, 0); }
            }
#undef DN_AFRAG
            LAS bf16* dst = (isw ? WT : UT) + cc * DN_ST;
#pragma unroll
            for (int bb = 0; bb < 4; ++bb)
#pragma unroll
                for (int g = 0; g < 2; ++g) { const int r0 = 8 * (bb & 1) + 4 * g; v2u o; o.x = pk2(X[bb][r0], X[bb][r0 + 1]); o.y = pk2(X[bb][r0 + 2], X[bb][r0 + 3]);
                    *(LAS v2u*)(dst + 16 * bb + 8 * g + 4 * lh) = o; }
        }
        __syncthreads();
        { bf16* MT = (bf16*)(F.ws + WS_DN_MT) + (size_t)unit * 4096; bf16* QPT = (bf16*)(F.ws + WS_DN_QPT) + (size_t)unit * 4096;
          bf16* BM = (bf16*)(F.ws + WS_DN_BM) + (size_t)unit * 4096; bf16* O0T = (bf16*)(F.ws + WS_DN_O0T) + (size_t)unit * 4096;
#pragma unroll 1
          for (int tt = 0; tt < 2; ++tt) { const int task = wave * 2 + tt, p = task >> 2, ta = (task >> 1) & 1, tb = task & 1;
              if (p == 0) {
                  f32x16 acc = dn_tile(WT, 32 * ta, KDT, 32 * tb, lc, lh);
#pragma unroll
                  for (int r = 0; r < 16; ++r) acc[r] = -acc[r];
#pragma unroll
                  for (int s2 = 0; s2 < 2; ++s2) *(bf16x8*)(MT + ((((tb * 2 + ta) * 2 + s2) * 64 + lane) * 8)) = pack8(acc, s2);
              } else if (p == 1) {
                  const f32x16 acc = dn_tile(KDT, 32 * ta, UT, 32 * tb, lc, lh);
#pragma unroll
                  for (int s2 = 0; s2 < 2; ++s2) *(bf16x8*)(BM + ((((tb * 2 + ta) * 2 + s2) * 64 + lane) * 8)) = pack8(acc, s2);
              } else if (p == 2) {
                  f32x16 acc = dn_tile(WT, 32 * ta, AQK, 32 * tb, lc, lh);
                  const int i = 32 * tb + lc; const float eg = __expf(gcs[i]);
#pragma unroll
                  for (int r = 0; r < 16; ++r) { const int a = 32 * ta + (r & 3) + 8 * (r >> 2) + 4 * lh; acc[r] = bf2f(Qs[i * DN_ST + a]) * eg - acc[r]; }
#pragma unroll
                  for (int s2 = 0; s2 < 2; ++s2) *(bf16x8*)(QPT + ((((tb * 2 + ta) * 2 + s2) * 64 + lane) * 8)) = pack8(acc, s2);
              } else {
                  const f32x16 acc = dn_tile(UT, 32 * ta, AQK, 32 * tb, lc, lh);
#pragma unroll
                  for (int s2 = 0; s2 < 2; ++s2) *(bf16x8*)(O0T + ((((tb * 2 + ta) * 2 + s2) * 64 + lane) * 8)) = pack8(acc, s2);
              } }
          if (tid == 0) ((float*)(F.ws + WS_DN_GT))[unit] = __expf(gcs[63]); }
    }
    __syncthreads();
}
template <int r>
__device__ __forceinline__ void dn_scan_wave(Frame& F) {
    const int w = F.vcu, bh = w >> 1, ct = w & 1, lane = F.lane;
    const bf16x8* MT = (const bf16x8*)(F.ws + WS_DN_MT); const bf16x8* BM = (const bf16x8*)(F.ws + WS_DN_BM); bf16x8* SS = (bf16x8*)(F.ws + WS_DN_S);
    const float* GT = (const float*)(F.ws + WS_DN_GT);
    LAS bf16x8* MB = (LAS bf16x8*)(F.lds + RING_OFF);
    volatile LAS int* FL = (volatile LAS int*)(F.lds + LDSCTL_OFF + 64);
    f32x16 S;
#pragma unroll
    for (int q = 0; q < 16; ++q) S[q] = 0.f;
    bf16x8 mA[4], bA[2], mB[4], bB[2], mC[4], bC[2], mD[4], bD[2], mE[4], bE[2], mG[4], bG[2]; float gA, gB, gC, gD, gE, gG;
#define DN_SLOAD(m, bm, gt, u) do { const size_t ub = (size_t)(u) * 512; _Pragma("unroll") for (int f = 0; f < 4; ++f) m[f] = MT[ub + (r * 4 + f) * 64 + lane]; \
        _Pragma("unroll") for (int f = 0; f < 2; ++f) bm[f] = BM[ub + ((ct * 2 + r) * 2 + f) * 64 + lane]; gt = GT[u]; } while (0)
#define DN_STEP(cm, cb, cg, unit, n) do { \
        bf16x8 own[2]; own[0] = pack8(S, 0); own[1] = pack8(S, 1); \
        LAS bf16x8* mb = MB + ((n) & 1) * 256; \
        mb[(r * 2 + 0) * 64 + lane] = own[0]; mb[(r * 2 + 1) * 64 + lane] = own[1]; \
        asm volatile("s_waitcnt lgkmcnt(0)" ::: "memory"); \
        if (lane == 0) FL[r] = (n) + 1; \
        SS[(size_t)(unit) * 512 + (ct * 4 + r * 2 + 0) * 64 + lane] = own[0]; SS[(size_t)(unit) * 512 + (ct * 4 + r * 2 + 1) * 64 + lane] = own[1]; \
        f32x16 A; \
        { const v4u b0 = __builtin_bit_cast(v4u, cb[0]), b1 = __builtin_bit_cast(v4u, cb[1]); const unsigned u0[8] = {b0.x, b0.y, b0.z, b0.w, b1.x, b1.y, b1.z, b1.w}; \
          _Pragma("unroll") for (int e = 0; e < 8; ++e) { A[2 * e] = cg * S[2 * e] + bflo(u0[e]); A[2 * e + 1] = cg * S[2 * e + 1] + bfhi(u0[e]); } } \
        while (FL[1 - r] < (n) + 1) { } \
        asm volatile("" ::: "memory"); \
        bf16x8 oth[2]; oth[0] = mb[((1 - r) * 2 + 0) * 64 + lane]; oth[1] = mb[((1 - r) * 2 + 1) * 64 + lane]; \
          \
        _Pragma("unroll") for (int s2 = 0; s2 < 2; ++s2) { A = __builtin_amdgcn_mfma_f32_32x32x16_bf16(cm[r * 2 + s2], own[s2], A, 0, 0, 0); A = __builtin_amdgcn_mfma_f32_32x32x16_bf16(cm[(1 - r) * 2 + s2], oth[s2], A, 0, 0, 0); } \
        S = A; } while (0)
    const int u0 = bh * 256;
    DN_SLOAD(mA, bA, gA, u0); DN_SLOAD(mB, bB, gB, u0 + 1); DN_SLOAD(mC, bC, gC, u0 + 2); DN_SLOAD(mD, bD, gD, u0 + 3); DN_SLOAD(mE, bE, gE, u0 + 4); DN_SLOAD(mG, bG, gG, u0 + 5);
    for (int n = 0; n < 252; n += 6) {
        DN_STEP(mA, bA, gA, u0 + n, n);         DN_SLOAD(mA, bA, gA, u0 + n + 6);
        DN_STEP(mB, bB, gB, u0 + n + 1, n + 1); DN_SLOAD(mB, bB, gB, u0 + n + 7);
        DN_STEP(mC, bC, gC, u0 + n + 2, n + 2); DN_SLOAD(mC, bC, gC, u0 + n + 8);
        DN_STEP(mD, bD, gD, u0 + n + 3, n + 3); DN_SLOAD(mD, bD, gD, u0 + n + 9);
        DN_STEP(mE, bE, gE, u0 + n + 4, n + 4); if (n + 10 < 256) DN_SLOAD(mE, bE, gE, u0 + n + 10);
        DN_STEP(mG, bG, gG, u0 + n + 5, n + 5); if (n + 11 < 256) DN_SLOAD(mG, bG, gG, u0 + n + 11);
    }
    DN_STEP(mA, bA, gA, u0 + 252, 252); DN_STEP(mB, bB, gB, u0 + 253, 253); DN_STEP(mC, bC, gC, u0 + 254, 254); DN_STEP(mD, bD, gD, u0 + 255, 255);
#undef DN_SLOAD
#undef DN_STEP
}
__device__ __forceinline__ void dn_scan(Frame& F) {
    if (F.vcu >= 32) return;
    if (F.wave == 0) dn_scan_wave<0>(F); else if (F.wave == 1) dn_scan_wave<1>(F);
}
__device__ __forceinline__ void dn_output(Frame& F) {
    const bf16x8* QPT = (const bf16x8*)(F.ws + WS_DN_QPT); const bf16x8* O0T = (const bf16x8*)(F.ws + WS_DN_O0T); const bf16x8* SS = (const bf16x8*)(F.ws + WS_DN_S);
    const bf16* PROJ = (const bf16*)(F.ws + WS_PROJ); bf16* OAB = (bf16*)(F.ws + WS_OAB);
    const int lane = F.lane, lc = lane & 31, lh = lane >> 5; int nbad = 0; (void)nbad;
    for (int task = F.vcu * NWAVES + F.wave; task < 8192; task += F.G * NWAVES) {
        const int unit = task >> 1, it = task & 1, b = unit >> 11, h = (unit >> 8) & 7, n = unit & 255;
        const size_t ub = (size_t)unit * 512;
        f32x16 o[2];
#pragma unroll
        for (int ct = 0; ct < 2; ++ct) {
            const v4u c0 = __builtin_bit_cast(v4u, O0T[ub + ((it * 2 + ct) * 2 + 0) * 64 + lane]), c1 = __builtin_bit_cast(v4u, O0T[ub + ((it * 2 + ct) * 2 + 1) * 64 + lane]);
            const unsigned u[8] = {c0.x, c0.y, c0.z, c0.w, c1.x, c1.y, c1.z, c1.w};
#pragma unroll
            for (int e = 0; e < 8; ++e) { o[ct][2 * e] = bflo(u[e]); o[ct][2 * e + 1] = bfhi(u[e]); }
#pragma unroll
            for (int at = 0; at < 2; ++at)
#pragma unroll
                for (int s2 = 0; s2 < 2; ++s2) o[ct] = __builtin_amdgcn_mfma_f32_32x32x16_bf16(SS[ub + (ct * 4 + at * 2 + s2) * 64 + lane], QPT[ub + ((it * 2 + at) * 2 + s2) * 64 + lane], o[ct], 0, 0, 0);
        }
        float ss = 0.f;
#pragma unroll
        for (int ct = 0; ct < 2; ++ct)
#pragma unroll
            for (int r = 0; r < 16; ++r) ss += o[ct][r] * o[ct][r];
        ss += __shfl_xor(ss, 32);
        const float rs = 1.0f / sqrtf(ss * (1.0f / 64.0f) + EPS);
        const size_t row = (size_t)b * SEQ + (size_t)n * 64 + it * 32 + lc;
#pragma unroll
        for (int ct = 0; ct < 2; ++ct)
#pragma unroll
            for (int rg = 0; rg < 4; ++rg) { const int c0 = 32 * ct + 8 * rg + 4 * lh;
                const v2u zz = *(const v2u*)(PROJ + row * PIN + PC_ZA + h * 64 + c0); const f32x4 ow = *(const f32x4*)(F.in[I_ONORM] + c0);
                const float z0 = bflo(zz.x), z1 = bfhi(zz.x), z2 = bflo(zz.y), z3 = bfhi(zz.y);
                v2u ov; ov.x = pk2(o[ct][4 * rg] * rs * ow[0] * silu_f(z0), o[ct][4 * rg + 1] * rs * ow[1] * silu_f(z1)); ov.y = pk2(o[ct][4 * rg + 2] * rs * ow[2] * silu_f(z2), o[ct][4 * rg + 3] * rs * ow[3] * silu_f(z3));
                *(v2u*)(OAB + row * D + h * 64 + c0) = ov;
            }
    }
}

template <int WIN>
__device__ __forceinline__ void pooled_block(const bf16* H, bf16* P, const int t0, const int tl0, const int col) {
    v4u r[WIN - 1 + 8];
#pragma unroll
    for (int j = 0; j < WIN - 1 + 8; ++j) { const int dt = j - (WIN - 1); r[j] = (v4u){0u, 0u, 0u, 0u}; if (tl0 + dt >= 0) r[j] = *(const v4u*)(H + (size_t)(t0 + dt) * D + col); }
    float s[8];
#pragma unroll
    for (int q = 0; q < 8; ++q) s[q] = 0.f;
#define POOL_ACC(sgn, VV) do { const v4u q_ = (VV); s[0] += sgn bflo(q_.x); s[1] += sgn bfhi(q_.x); s[2] += sgn bflo(q_.y); s[3] += sgn bfhi(q_.y); s[4] += sgn bflo(q_.z); s[5] += sgn bfhi(q_.z); s[6] += sgn bflo(q_.w); s[7] += sgn bfhi(q_.w); } while (0)
#pragma unroll
    for (int j = 0; j < WIN - 1; ++j) POOL_ACC(+, r[j]);
#pragma unroll
    for (int i = 0; i < 8; ++i) { const v4u self = r[WIN - 1 + i]; POOL_ACC(+, self);
        const int n = (tl0 + i + 1) < WIN ? (tl0 + i + 1) : WIN; const float inv = 1.0f / (float)n;
        v4u o; o.x = pk2(s[0] * inv - bflo(self.x), s[1] * inv - bfhi(self.x)); o.y = pk2(s[2] * inv - bflo(self.y), s[3] * inv - bfhi(self.y));
        o.z = pk2(s[4] * inv - bflo(self.z), s[5] * inv - bfhi(self.z)); o.w = pk2(s[6] * inv - bflo(self.w), s[7] * inv - bfhi(self.w));
        *(v4u*)(P + (size_t)(t0 + i) * D + col) = o;
        POOL_ACC(-, r[i]); }
#undef POOL_ACC
}
__device__ __forceinline__ void pooled_phase(Frame& F) {
    const bf16* H = (const bf16*)(F.ws + WS_H); bf16* P = (bf16*)(F.ws + WS_OAB);
    const int gt = F.vcu * 512 + F.tid, NT = F.G * 512;
    for (int it = gt; it < (NTOK / 8) * 128; it += NT) {
        const int c = it & 31, g = __builtin_amdgcn_readfirstlane((it >> 6) & 3), tb = ((it >> 8) << 1) | ((it >> 5) & 1);
        const int t0 = tb * 8, tl0 = t0 & (SEQ - 1), col = g * 256 + c * 8;
        if (g == 0) pooled_block<2>(H, P, t0, tl0, col); else if (g == 1) pooled_block<4>(H, P, t0, tl0, col); else if (g == 2) pooled_block<8>(H, P, t0, tl0, col); else pooled_block<16>(H, P, t0, tl0, col);
    }
}


#ifndef PH_MASK
#define PH_MASK 0xFFFFFF
#endif
#define IN(k) (((PH_MASK >> (k)) & 1) && lo <= (k) && (k) < hi)
#define BOTH(k) (IN(k) && IN((k) + 1))
#if MK_ONE_LAUNCH
#define GRID_BAR() xcd_barrier(bar)
#else
#define GRID_BAR() do { } while (0)
#endif
template <int LAYER>
__device__ __forceinline__ void moe_phases(Frame& F, const XcdBarrier& bar, const int lo, const int hi) {
    constexpr int pb = LAYER == 0 ? 7 : 13;
    bf16* const H = (bf16*)(F.ws + WS_H);
    const float* const MOD = (const float*)(F.ws + WS_MOD);
    if (IN(pb)) {
        moe_route(F, LAYER); if (BOTH(pb)) GRID_BAR(); }
    if (IN(pb + 1)) {
        build_moe_tables(F, LAYER);
        pg8::Gemm g{(const bf16*)H, 1024, 1024}; MoeSched S; S.init((const LAS int*)(F.lds + SCHED_OFF), F.G, (int)blockIdx.x, (const int*)(F.ws + WS_RT), F.ws + WS_WGU, 1024, 1024);
        EpiSwiglu E{(bf16*)(F.ws + WS_ACT)};
        if (LAYER == 0) moe_tail_plan(F);
        pg8::gemm_phase<EpiSwiglu, MoeSched>(F.lds + RING_OFF, g, S, E);
        if (LAYER == 0) {
            const LAS int* T = (const LAS int*)(F.lds + SCHED_OFF); const int sp = T[67];
            if (sp > 0) { __syncthreads(); const int f = T[65] * 8 * TQ_GU; int e = f + sp * 8 * TQ_GU; e = e < CQ_ND ? e : CQ_ND; convert_range(F, 1, f, e, F.wave, 8); } }
        if (BOTH(pb + 1)) GRID_BAR();
    }
    if (IN(pb + 2)) {
        build_moe_tables(F, LAYER);
        pg8::Gemm g{(const bf16*)(F.ws + WS_ACT), 512, 512}; MoeSched S; S.init((const LAS int*)(F.lds + SCHED_OFF), F.G, (int)blockIdx.x, nullptr, F.ws + (LAYER ? WS_WD1 : WS_WD), 512, 512);
        EpiStoreBf16 E{(bf16*)(F.ws + WS_Y), D};
        if (LAYER == 0) moe_tail_plan(F);
        pg8::gemm_phase<EpiStoreBf16, MoeSched>(F.lds + RING_OFF, g, S, E);
        if (LAYER == 0) {
            const LAS int* T = (const LAS int*)(F.lds + SCHED_OFF); const int sp = T[67];
            int t8 = T[66] * 8 * TQ_GU; t8 = t8 < CQ_ND ? t8 : CQ_ND;
            if (sp > 0) { __syncthreads(); const int f = t8 + T[65] * 8 * TQ_DN; int e = f + sp * 8 * TQ_DN; e = e < CQ_N ? e : CQ_N; convert_range(F, 1, f, e, F.wave, 8); } }
        if (BOTH(pb + 2)) GRID_BAR();
    }
    if (IN(pb + 3)) {
        build_moe_tables(F, LAYER);
        if (LAYER == 0) moe_tail_plan(F);
        const int tokw = F.vcu * 128 + F.wave * 16, b = (F.vcu * 128) / SEQ;
        f32x4 g2[4];
#pragma unroll
        for (int j = 0; j < 4; ++j) g2[j] = *((const f32x4*)(MOD + (size_t)(LAYER * 2 + b) * 6144 + 5 * 1024) + F.lane + 64 * j);
        if (LAYER == 0) {
            const ModVec m1 = load_mod(F.in[I_NMIX] + D, MOD + (size_t)(2 + b) * 6144 + 1024, MOD + (size_t)(2 + b) * 6144, F.lane);
            { const CombRecs recs = comb_load_recs(F, tokw); CombRows cur, nxt; comb_issue(F, recs, 0, tokw, cur);
              for (int i = 0; i < 16; ++i) { const int t = tokw + i;
                  if (i + 1 < 16) comb_issue(F, recs, i + 1, t + 1, nxt);
                  const RowVec x = comb_finish(recs, i, cur, g2);
                  store_row_bf16((bf16*)(F.ws + WS_XRB) + (size_t)t * D, F.lane, x); store_row_bf16(H + (size_t)t * D, F.lane, apply_mod(x, row_rstd(x), m1));
                  cur = nxt; } }
            __syncthreads();
            { const LAS int* T = (const LAS int*)(F.lds + SCHED_OFF);
              int t8 = T[66] * 8 * TQ_GU; t8 = t8 < CQ_ND ? t8 : CQ_ND; int t9 = t8 + T[66] * 8 * TQ_DN; t9 = t9 < CQ_N ? t9 : CQ_N;
              convert_range(F, 1, t9, CQ_N, F.vcu * NWAVES + F.wave, F.G * NWAVES); }
        } else {
            f32x4 fw[4];
#pragma unroll
            for (int j = 0; j < 4; ++j) fw[j] = *((const f32x4*)F.in[I_FNW] + F.lane + 64 * j);
            { const CombRecs recs = comb_load_recs(F, tokw); CombRows cur, nxt; comb_issue(F, recs, 0, tokw, cur);
              for (int i = 0; i < 16; ++i) { const int t = tokw + i;
                  if (i + 1 < 16) comb_issue(F, recs, i + 1, t + 1, nxt);
                  RowVec x = comb_finish(recs, i, cur, g2); const float rstd = row_rstd(x);
#pragma unroll
                  for (int j = 0; j < 4; ++j) x.v[j] = x.v[j] * rstd * fw[j];
                  store_row_f32(F.out + (size_t)t * D, F.lane, x);
                  cur = nxt; } }
        }
        if (BOTH(pb + 3)) GRID_BAR();
    }
}

constexpr int PH_P0 = 0, PH_P1 = 1, PH_INPROJ = 2, PH_ATT = 3, PH_SCAN = 4, PH_DNOUT = 5, PH_OUTPROJ = 6, PH_MOE0 = 7, PH_POOLED = 11, PH_POOLG = 12, PH_MOE1 = 13;
constexpr int N_PHASES = 17;
struct Args { const float* in[24]; float* out; unsigned char* ws; int ph_lo, ph_hi; };
__global__ void __launch_bounds__(NWAVES * 64, 2) trunk_fwd(Args args) {
    __shared__ __attribute__((aligned(16))) unsigned char lds[LDS_BYTES];
    Frame F;
    F.lds = (LAS unsigned char*)lds;
    F.MISC = (volatile LAS unsigned*)(F.lds + MISC_OFF);
    F.tid = threadIdx.x; F.lane = F.tid & 63; F.wave = __builtin_amdgcn_readfirstlane(F.tid >> 6);
    F.G = gridDim.x; { const int bx = blockIdx.x; F.vcu = (F.G % 8 == 0) ? (bx % 8) * (F.G / 8) + bx / 8 : bx; }
#pragma unroll
    for (int i = 0; i < 24; ++i) F.in[i] = args.in[i];
    F.out = args.out; F.ws = args.ws; F.ctl = (gu32*)(args.ws + WS_CTL);
    for (int u = F.tid; u < (LDS_BYTES - LDSCTL_OFF) / 4; u += NWAVES * 64) ((LAS unsigned*)(F.lds + LDSCTL_OFF))[u] = 0u;
    __syncthreads();
#if MK_ONE_LAUNCH
    XcdBarrier bar = xcd_barrier_post((unsigned*)(F.ctl + CW_BAR), F.MISC + 8);
#else
    XcdBarrier bar; bar.bar = nullptr; bar.x = 0; bar.st = nullptr;
#endif
    const int lo = args.ph_lo, hi = args.ph_hi;
    bf16* const H = (bf16*)(F.ws + WS_H);
    const float* const MOD = (const float*)(F.ws + WS_MOD);

    if (IN(PH_P0)) { p0_prologue(F); if (BOTH(PH_P0)) GRID_BAR(); }
    if (IN(PH_P1)) { p1_prenorm0(F); if (BOTH(PH_P1)) GRID_BAR(); }
    if (IN(PH_INPROJ)) {
        pg8::Gemm g{(const bf16*)H, 1024, 1024}; DenseSched S; S.init(NTOK, PIN, F.G, (int)blockIdx.x, 1024, 0, F.ws + WS_WIN, 1024);
        EpiStoreBf16 E{(bf16*)(F.ws + WS_PROJ), PIN};
        pg8::gemm_phase<EpiStoreBf16, DenseSched>(F.lds + RING_OFF, g, S, E);
        if (IP_FULL && (int)blockIdx.x >= IP_FULL) {
            __syncthreads(); const int r = (int)blockIdx.x - IP_FULL; convert_range(F, 0, r * 8 * TQ_INPROJ, (r + 1) * 8 * TQ_INPROJ, F.wave, 8); }
        if (BOTH(PH_INPROJ)) GRID_BAR();
    }
    if (IN(PH_ATT)) { dn_prep(F); if (BOTH(PH_ATT)) GRID_BAR(); }
    if (IN(PH_SCAN)) {
        if (F.vcu < 32) dn_scan(F);
        else { attn_phase(F, F.vcu - 32, F.G - 32); __syncthreads(); convert_range(F, 0, CQ_T2, CQ_N, (F.vcu - 32) * NWAVES + F.wave, (F.G - 32) * NWAVES); }
        if (BOTH(PH_SCAN)) GRID_BAR(); }
    if (IN(PH_DNOUT)) { dn_output(F); if (BOTH(PH_DNOUT)) GRID_BAR(); }
    if (IN(PH_OUTPROJ)) {
        pg8::Gemm g{(const bf16*)(F.ws + WS_OAB), 1024, 1024}; DenseSched S; S.init(NTOK, D, F.G, (int)blockIdx.x, 1024, 0, F.ws + WS_WOUT, 1024);
        EpiStoreBf16 E{(bf16*)(F.ws + WS_YM), D};
        pg8::gemm_phase<EpiStoreBf16, DenseSched>(F.lds + RING_OFF, g, S, E);
        if (BOTH(PH_OUTPROJ)) GRID_BAR();
    }
    moe_phases<0>(F, bar, lo, hi);
    if (IN(PH_POOLED)) { pooled_phase(F); if (BOTH(PH_POOLED)) GRID_BAR(); }
    if (IN(PH_POOLG)) {
        pg8::Gemm g{(const bf16*)(F.ws + WS_OAB), 256, 256}; DenseSched S; S.init(NTOK, D, F.G, (int)blockIdx.x, 1024, 256, F.ws + WS_POOLW, 256);
        EpiStoreBf16 E{(bf16*)(F.ws + WS_YM), D};
        pg8::gemm_phase<EpiStoreBf16, DenseSched>(F.lds + RING_OFF, g, S, E);
        if (BOTH(PH_POOLG)) GRID_BAR();
    }
    moe_phases<1>(F, bar, lo, hi);
#undef IN
#undef BOTH
}

extern "C" void kernel_launch(void* const* d_in, const int* in_sizes, int n_in, void* d_out, int out_size, void* d_ws, size_t ws_size, hipStream_t stream) {
    static int grid = 0;
    if (grid == 0) {
        if (n_in != 24 || in_sizes[0] != NTOK * D || out_size != NTOK * D || ws_size < WS_END2) { fprintf(stderr, "kernel_launch: unexpected shapes (n_in %d, in0 %d, out %d, ws %zu); nothing launched\n", n_in, n_in > 0 ? in_sizes[0] : -1, out_size, ws_size); grid = -1; return; }
        int per_cu = 0;
        if (hipOccupancyMaxActiveBlocksPerMultiprocessor(&per_cu, (const void*)trunk_fwd, NWAVES * 64, 0) != hipSuccess || per_cu < 1) fprintf(stderr, "kernel_launch: occupancy query says %d\n", per_cu);
        (void)hipGetLastError();
        grid = 256;
    }
    if (grid < 0) return;
    if (hipMemsetAsync((char*)d_ws + WS_CTL, 0, CTL_ZERO_BYTES, stream) != hipSuccess) { fprintf(stderr, "kernel_launch: memset failed\n"); return; }
    Args a{};
    for (int i = 0; i < 24; ++i) a.in[i] = (const float*)d_in[i];
    a.out = (float*)d_out; a.ws = (unsigned char*)d_ws;
#if MK_ONE_LAUNCH
    a.ph_lo = 0; a.ph_hi = N_PHASES;
    hipLaunchKernelGGL(trunk_fwd, dim3(grid), dim3(NWAVES * 64), 0, stream, a);
#else
    for (int p = 0; p < N_PHASES; ++p) { a.ph_lo = p; a.ph_hi = p + 1; hipLaunchKernelGGL(trunk_fwd, dim3(grid), dim3(NWAVES * 64), 0, stream, a); }
#endif
}
```

```cpp
#include <hip/hip_runtime.h>
#include <cstdio>
#include <cstdint>

#ifndef MK_ONE_LAUNCH
#define MK_ONE_LAUNCH 1
#endif

#define GAS __attribute__((address_space(1)))
#define LAS __attribute__((address_space(3)))
typedef unsigned short bf16;
typedef unsigned v4u __attribute__((ext_vector_type(4)));
typedef unsigned v2u __attribute__((ext_vector_type(2)));
typedef float f32x4 __attribute__((ext_vector_type(4)));
typedef float f32x2 __attribute__((ext_vector_type(2)));
typedef float f32x16 __attribute__((ext_vector_type(16)));
typedef short bf16x8 __attribute__((ext_vector_type(8)));
typedef GAS unsigned gu32;
#define RLX_AGENT __ATOMIC_RELAXED, __HIP_MEMORY_SCOPE_AGENT
#define LDS_WAIT() asm volatile("s_waitcnt lgkmcnt(0)" ::: "memory")
#define VM_WAIT() asm volatile("s_waitcnt vmcnt(0)" ::: "memory")

constexpr int BATCH = 2, SEQ = 16384, D = 1024, NTOK = BATCH * SEQ;
constexpr int PIN = 2816;
constexpr int PC_QA = 0, PC_KA = 512, PC_VA = 1024, PC_ZA = 1536, PC_QB = 2048, PC_KB = 2560, PC_VB = 2688;
constexpr int NEXP = 32, DFF = 512;
constexpr int MAXTILES = NTOK * 2 / 256 + NEXP;
constexpr float EPS = 1e-6f;
constexpr int NWAVES = 8;

constexpr size_t MiB = 1u << 20;
constexpr size_t WS_CTL = 0, CTL_ZERO_BYTES = 1 * MiB;
constexpr size_t WS_MOD = 1 * MiB;
constexpr size_t WS_WBA = 1 * MiB + 128 * 1024;
constexpr size_t WS_ROUTE = 2 * MiB;
constexpr size_t WS_RT = 3 * MiB;
constexpr size_t WS_BG = 7 * MiB;
constexpr size_t WS_WIN = 10 * MiB;
constexpr size_t WS_WOUT = 16 * MiB;
constexpr size_t WS_POOLW = 18 * MiB;
constexpr size_t WS_WGU = 20 * MiB;
constexpr size_t WS_WD = 84 * MiB;
constexpr size_t WS_H = 116 * MiB;
constexpr size_t WS_PROJ = 180 * MiB;
constexpr size_t WS_OAB = 356 * MiB;
constexpr size_t WS_YM = 180 * MiB;
constexpr size_t WS_ACT = 180 * MiB;
constexpr size_t WS_Y = 252 * MiB;
constexpr size_t WS_END = 420 * MiB;
constexpr size_t WS_DN_MT = WS_H;
constexpr size_t WS_DN_QPT = WS_H + 32 * MiB;
constexpr size_t WS_DN_BM = 420 * MiB, WS_DN_O0T = 452 * MiB, WS_DN_S = 484 * MiB;
constexpr size_t WS_DN_GT = 9 * MiB;
constexpr size_t WS_XRB = 420 * MiB;
constexpr size_t WS_WD1 = 484 * MiB;
constexpr size_t WS_END2 = 516 * MiB;
constexpr int CW_CNT = 64;
constexpr int CW_BAR = 4096;
constexpr int CW_BAD = 200;

constexpr int RING_OFF = 0, RING_BYTES = 131072;
constexpr int LDSCTL_OFF = RING_BYTES, MISC_OFF = LDSCTL_OFF + 320;
constexpr int SCHED_OFF = LDSCTL_OFF + 1024;
constexpr int LDS_BYTES = 163840;
constexpr int R1W_OFF = 135168;
constexpr int RT_LDS_OFF = 151552;

typedef __bf16 bf16x2_t __attribute__((ext_vector_type(2)));
__device__ __forceinline__ unsigned pk2(float lo, float hi) { bf16x2_t v; v.x = (__bf16)lo; v.y = (__bf16)hi; return __builtin_bit_cast(unsigned, v); }
__device__ __forceinline__ unsigned f2bf(float f) { return pk2(f, 0.f) & 0xffffu; }
__device__ __forceinline__ float bf2f(unsigned b) { return __builtin_bit_cast(float, b << 16); }
__device__ __forceinline__ float bflo(unsigned w) { return __builtin_bit_cast(float, w << 16); }
__device__ __forceinline__ float bfhi(unsigned w) { return __builtin_bit_cast(float, w & 0xffff0000u); }
template <int CTRL> __device__ __forceinline__ float dpp_f(float v) { return __builtin_bit_cast(float, __builtin_amdgcn_update_dpp(0, __builtin_bit_cast(int, v), CTRL, 0xf, 0xf, false)); }
__device__ __forceinline__ float quad_sum(float v) { v += dpp_f<0xB1>(v); v += dpp_f<0x4E>(v); return v; }
__device__ __forceinline__ float oct_sum(float v) { v = quad_sum(v); v += dpp_f<0x141>(v); return v; }
__device__ __forceinline__ float wave_sum(float v) {
    v = oct_sum(v); v += dpp_f<0x140>(v);
    const float r0 = __builtin_bit_cast(float, __builtin_amdgcn_readlane(__builtin_bit_cast(int, v), 0)), r1 = __builtin_bit_cast(float, __builtin_amdgcn_readlane(__builtin_bit_cast(int, v), 16));
    const float r2 = __builtin_bit_cast(float, __builtin_amdgcn_readlane(__builtin_bit_cast(int, v), 32)), r3 = __builtin_bit_cast(float, __builtin_amdgcn_readlane(__builtin_bit_cast(int, v), 48));
    return (r0 + r1) + (r2 + r3);
}
__device__ __forceinline__ float rl(float x, int l) { return __builtin_bit_cast(float, __builtin_amdgcn_readlane(__builtin_bit_cast(int, x), l)); }
__device__ __forceinline__ float silu_f(float x) { return x / (1.f + __expf(-x)); }
__device__ __forceinline__ float sigmoid_f(float x) { return 1.f / (1.f + __expf(-x)); }
__device__ __forceinline__ float softplus_f(float x) { return x > 20.f ? x : log1pf(__expf(x)); }

namespace pg8 {
#define PG8_LAS __attribute__((address_space(3)))
typedef unsigned short bf16_t;
typedef unsigned u32x4 __attribute__((ext_vector_type(4)));
constexpr int BM = 256, BK = 64, HALF = 128, HTB = HALF * BK * 2, STAGE_BYTES = 8 * HTB;

__host__ __device__ __forceinline__ int lds_byte(int r, int c) { const int st = (r >> 4) * 2 + (c >> 5), rr = r & 15, cc = c & 31, ob = rr * 64 + cc * 2; return st * 1024 + (ob ^ (((ob >> 9) & 1) << 5)); }
__host__ __device__ __forceinline__ void stage_rc(int b, int& R, int& C) { const int st = b / 1024, sb = b % 1024, swz = sb ^ (((sb >> 9) & 1) << 5); R = (st >> 1) * 16 + swz / 64; C = (st & 1) * 32 + (swz % 64) / 2; }
__host__ __device__ __forceinline__ int perm32(int rho) { const int n = rho >> 4, i = rho & 15; return 8 * (i >> 2) + 4 * n + (i & 3); }

struct Unit { int pm, pn, e; };
struct Gemm { const bf16_t* A; int K, ldb; };

template <class Epi, class Sched>
__device__ __forceinline__ void gemm_phase(PG8_LAS unsigned char* lds, const Gemm g, const Sched& S, const Epi& E) {
    const int tid = threadIdx.x, wid = __builtin_amdgcn_readfirstlane(tid >> 6), lane = tid & 63, wr = wid >> 2, wc = wid & 3, fr = lane & 15, fq = lane >> 4;
    const int K = g.K, nt = K / BK;
    int R0, C0, R1, C1; stage_rc(tid * 16, R0, C0); stage_rc(tid * 16 + 8192, R1, C1);
    const int Rb0 = (R0 & ~31) + perm32(R0 & 31), Rb1 = (R1 & ~31) + perm32(R1 & 31);
    const unsigned voffB0 = (unsigned)(Rb0 * g.ldb + C0) * 2u, voffB1 = (unsigned)(Rb1 * g.ldb + C1) * 2u;
    const size_t kstep = (size_t)(BK * 2);
    const size_t hstepB = (size_t)HALF * g.ldb * 2;
    const unsigned ldsw = (unsigned)wid * 1024u;
    const int aoff = lds_byte(wr * 64 + fr, fq * 8), boff = lds_byte(wc * 32 + fr, fq * 8);
    const char* Ab = (const char*)g.A;
#define PG8_SA(b, h) (((b) * 2 + (h)) * HTB)
#define PG8_SB(b, h) ((4 + (b) * 2 + (h)) * HTB)
#define PG8_ST2(bufoff, gbase, v0, v1) do { \
        __builtin_amdgcn_global_load_lds((const unsigned*)((const char*)(gbase) + (v0)), (PG8_LAS unsigned*)(lds + (bufoff) + ldsw), 16, 0, 0); \
        __builtin_amdgcn_global_load_lds((const unsigned*)((const char*)(gbase) + (v1)), (PG8_LAS unsigned*)(lds + (bufoff) + ldsw + 8192), 16, 0, 0); } while (0)
#define PG8_STB(bufoff, gbase) PG8_ST2(bufoff, gbase, voffB0, voffB1)
#define PG8_LDA(dst, b, h) do { _Pragma("unroll") for (int m = 0; m < 4; ++m) _Pragma("unroll") for (int k = 0; k < 2; ++k) dst[m][k] = *(const PG8_LAS bf16x8*)(lds + PG8_SA(b, h) + aoff + m * 2048 + k * 1024); } while (0)
#define PG8_LDB(dst, b, h) do { _Pragma("unroll") for (int n = 0; n < 2; ++n) _Pragma("unroll") for (int k = 0; k < 2; ++k) dst[n][k] = *(const PG8_LAS bf16x8*)(lds + PG8_SB(b, h) + boff + n * 2048 + k * 1024); } while (0)
#define PG8_MMA(ai, bj, At, Bt) do { __builtin_amdgcn_s_setprio(1); _Pragma("unroll") for (int m = 0; m < 4; ++m) _Pragma("unroll") for (int n = 0; n < 2; ++n) _Pragma("unroll") for (int k = 0; k < 2; ++k) \
        acc[ai][bj][m][n] = __builtin_amdgcn_mfma_f32_16x16x32_bf16(Bt[n][k], At[m][k], acc[ai][bj][m][n], 0, 0, 0); __builtin_amdgcn_s_setprio(0); } while (0)
#define PG8_WAIT_V(n) asm volatile("s_waitcnt vmcnt(" #n ")" ::: "memory")
#define PG8_WAIT_L(n) asm volatile("s_waitcnt lgkmcnt(" #n ")" ::: "memory")
#define PG8_BAR __builtin_amdgcn_s_barrier()
#define PG8_SCHED __builtin_amdgcn_sched_barrier(0)
    Unit cur, nxt; int ui = 0;
    if (!S.next(0, cur)) return;
    f32x4 acc[2][2][4][2];
#pragma unroll
    for (int a = 0; a < 2; ++a)
#pragma unroll
        for (int b = 0; b < 2; ++b)
#pragma unroll
            for (int m = 0; m < 4; ++m)
#pragma unroll
                for (int n = 0; n < 2; ++n) acc[a][b][m][n] = (f32x4){0.f, 0.f, 0.f, 0.f};
    bf16x8 At[4][2], B0[2][2], B1[2][2];
    unsigned c00, c01, c10, c11;
#define PG8_AOFF(u, d00, d01, d10, d11) do { \
        d00 = S.a_off(u, R0) + (unsigned)C0 * 2u; d01 = S.a_off(u, R1) + (unsigned)C1 * 2u; \
        d10 = S.a_off(u, HALF + R0) + (unsigned)C0 * 2u; d11 = S.a_off(u, HALF + R1) + (unsigned)C1 * 2u; } while (0)
    PG8_AOFF(cur, c00, c01, c10, c11);
    const char* cB = S.b_ptr(cur);
    PG8_STB(PG8_SB(0, 0), cB); PG8_STB(PG8_SB(0, 1), cB + hstepB); PG8_ST2(PG8_SA(0, 0), Ab, c00, c01); PG8_ST2(PG8_SA(0, 1), Ab, c10, c11);
    if (wr == 1) PG8_BAR;
    PG8_WAIT_V(2); PG8_BAR;
    PG8_STB(PG8_SB(1, 0), cB + kstep); PG8_ST2(PG8_SA(1, 0), Ab + kstep, c00, c01); PG8_STB(PG8_SB(1, 1), cB + hstepB + kstep);
    PG8_WAIT_V(6); PG8_BAR;
    for (;;) {
        const bool has_next = S.next(ui + 1, nxt);
        const char* nB = has_next ? S.b_ptr(nxt) : cB;
#pragma unroll 1
        for (int t = 0; t < nt; t += 2) {
            const bool last = (t == nt - 2);
            const char* a1 = Ab + (size_t)(t + 1) * kstep;
            const char* a2 = last ? Ab : Ab + (size_t)(t + 2) * kstep; const char* b2 = last ? nB : cB + (size_t)(t + 2) * kstep;
            const char* a3 = a2 + kstep; const char* b3 = b2 + kstep;
            PG8_LDB(B0, 0, 0); PG8_LDB(B1, 0, 1); PG8_SCHED; PG8_LDA(At, 0, 0); PG8_ST2(PG8_SA(1, 1), a1, c10, c11);
            PG8_WAIT_V(8); PG8_WAIT_L(0); PG8_BAR; PG8_MMA(0, 0, At, B0); PG8_MMA(0, 1, At, B1); PG8_BAR; PG8_SCHED;
            if (last && has_next) { PG8_AOFF(nxt, c00, c01, c10, c11); }
            PG8_LDA(At, 0, 1); PG8_STB(PG8_SB(0, 0), b2); PG8_STB(PG8_SB(0, 1), b2 + hstepB); PG8_ST2(PG8_SA(0, 0), a2, c00, c01);
            PG8_WAIT_V(8); PG8_WAIT_L(0); PG8_BAR; PG8_MMA(1, 0, At, B0); PG8_MMA(1, 1, At, B1); PG8_BAR; PG8_SCHED;
            PG8_LDB(B0, 1, 0); PG8_LDB(B1, 1, 1); PG8_SCHED; PG8_LDA(At, 1, 0); PG8_ST2(PG8_SA(0, 1), a2, c10, c11);
            PG8_WAIT_V(8); PG8_WAIT_L(0); PG8_BAR; PG8_MMA(0, 0, At, B0); PG8_MMA(0, 1, At, B1); PG8_BAR; PG8_SCHED;
            PG8_LDA(At, 1, 1); PG8_STB(PG8_SB(1, 0), b3); PG8_STB(PG8_SB(1, 1), b3 + hstepB); PG8_ST2(PG8_SA(1, 0), a3, c00, c01);
            PG8_WAIT_V(8); PG8_WAIT_L(0); PG8_BAR; PG8_MMA(1, 0, At, B0); PG8_MMA(1, 1, At, B1); PG8_BAR; PG8_SCHED;
        }
        if (wr == 0) PG8_BAR;
        E(acc, cur, wr, wc, fr, fq);
        if (!has_next) break;
#pragma unroll
        for (int a = 0; a < 2; ++a)
#pragma unroll
            for (int b = 0; b < 2; ++b)
#pragma unroll
                for (int m = 0; m < 4; ++m)
#pragma unroll
                    for (int n = 0; n < 2; ++n) acc[a][b][m][n] = (f32x4){0.f, 0.f, 0.f, 0.f};
        cur = nxt; cB = nB; ++ui;
        if (wr == 1) PG8_BAR;
    }
    PG8_WAIT_V(0);
    PG8_BAR;
#undef PG8_SA
#undef PG8_SB
#undef PG8_ST2
#undef PG8_STB
#undef PG8_LDA
#undef PG8_LDB
#undef PG8_MMA
#undef PG8_WAIT_V
#undef PG8_WAIT_L
#undef PG8_BAR
#undef PG8_SCHED
#undef PG8_AOFF
}
}

#define XB_TMO      128
#define XB_XCNT(j)  (256  + 64 * (j))
#define XB_XSUB(j)  (1280 + 64 * (j))
#define XB_XGEN(j)  (2304 + 64 * (j))
#define XB_TOP      3328
#define XB_TOPGEN   3392
#define XCD_BAR_WORDS 3456
#define XB_SPIN_CAP (1u << 22)

__device__ __forceinline__ unsigned xb_ld(unsigned* p)              { return __hip_atomic_load(p, __ATOMIC_RELAXED, __HIP_MEMORY_SCOPE_AGENT); }
__device__ __forceinline__ unsigned xb_add(unsigned* p, unsigned v) { return __hip_atomic_fetch_add(p, v, __ATOMIC_RELAXED, __HIP_MEMORY_SCOPE_AGENT); }
__device__ __forceinline__ unsigned xb_xcc_id() { return (unsigned)__builtin_amdgcn_s_getreg((3 << 11) | 20) & 0xFu; }
#define XB_SPIN(cond, bar) do { unsigned _sp = 0; while (cond) { __builtin_amdgcn_s_sleep(1); \
    if ((++_sp & 255u) == 0u) { if (xb_ld(&(bar)[XB_TMO])) break; if (_sp > XB_SPIN_CAP) { atomicAdd(&(bar)[XB_TMO], 1u); break; } } } } while (0)

struct XcdBarrier { unsigned* bar; unsigned x; volatile LAS unsigned* st; };

__device__ __forceinline__ XcdBarrier xcd_barrier_post(unsigned* bar, volatile LAS unsigned* st) {
    XcdBarrier b; b.bar = bar; b.x = xb_xcc_id(); b.st = st;
    if (threadIdx.x == 0) (void)xb_add(&bar[XB_XCNT(b.x)], 1u);
    return b;
}
__device__ __forceinline__ void xcd_barrier_complete(unsigned* bar, unsigned x, unsigned& nloc, unsigned& nx) {
    const unsigned G = gridDim.x * gridDim.y * gridDim.z;
    unsigned sum, cnt, mine, sp = 0u;
    for (;;) {
        sum = 0u; cnt = 0u; mine = 0u;
#pragma unroll
        for (unsigned j = 0; j < 16; ++j) { const unsigned c = xb_ld(&bar[XB_XCNT(j)]); sum += c; cnt += (c > 0u) ? 1u : 0u; mine = (j == x) ? c : mine; }
        if (sum == G) break;
        __builtin_amdgcn_s_sleep(1);
        if ((++sp & 255u) == 0u) { if (xb_ld(&bar[XB_TMO])) break; if (sp > XB_SPIN_CAP) { atomicAdd(&bar[XB_TMO], 1u); break; } }
    }
    nloc = mine > 0u ? mine : 1u; nx = cnt > 0u ? cnt : 1u;
}
__device__ __forceinline__ void xcd_barrier(const XcdBarrier& b) {
    asm volatile("s_waitcnt vmcnt(0)" ::: "memory");
    __syncthreads();
    if (threadIdx.x == 0) {
        unsigned* bar = b.bar;
        __builtin_amdgcn_s_waitcnt(0);
        unsigned nloc = b.st[0], nx = b.st[1];
        if (nloc == 0u) { xcd_barrier_complete(bar, b.x, nloc, nx); b.st[0] = nloc; b.st[1] = nx; }
        const unsigned old = xb_add(&bar[XB_XSUB(b.x)], 1u);
        const unsigned gen = old / nloc;
        if (old + 1u == (gen + 1u) * nloc) {
            __builtin_amdgcn_fence(__ATOMIC_RELEASE, "agent");
            asm volatile("s_waitcnt vmcnt(0)" ::: "memory");
            const unsigned og = xb_add(&bar[XB_TOP], 1u);
            const unsigned tg = og / nx;
            if (og + 1u == (tg + 1u) * nx) xb_add(&bar[XB_TOPGEN], 1u);
            else XB_SPIN(xb_ld(&bar[XB_TOPGEN]) == tg, bar);
            __builtin_amdgcn_fence(__ATOMIC_ACQUIRE, "agent");
            xb_add(&bar[XB_XGEN(b.x)], 1u);
            asm volatile("s_waitcnt vmcnt(0)" ::: "memory");
        } else {
            XB_SPIN(xb_ld(&bar[XB_XGEN(b.x)]) == gen, bar);
            __builtin_amdgcn_fence(__ATOMIC_ACQUIRE, "agent");
            asm volatile("s_waitcnt vmcnt(0)" ::: "memory");
        }
    }
    __syncthreads();
}

struct Frame {
    LAS unsigned char* lds;
    volatile LAS unsigned* MISC;
    gu32* ctl;
    int tid, lane, wave, vcu, G;
    const float* in[24];
    float* out;
    unsigned char* ws;
};
enum { I_X = 0, I_C, I_ADAW, I_ADAB, I_NMIX, I_NFFN, I_WIN, I_CONVW, I_ALOG, I_DTB, I_ONORM, I_SINKS, I_RELB, I_WOUT, I_POOLW, I_POOLS, I_R1W, I_R1B, I_R2W, I_R2B, I_WG, I_WU, I_WDN, I_FNW };

__device__ __forceinline__ void p0_transpose_item(const float* W, int ldw, int K, bf16* WT, int dst_row0, LAS float* scr, int k0, int n0, int lane) {
    f32x4 w4[8];
#pragma unroll
    for (int i = 0; i < 8; ++i) { const int f = i * 64 + lane, kk = f >> 3, c4 = f & 7; w4[i] = __builtin_nontemporal_load((const f32x4*)(W + (size_t)(k0 + kk) * ldw + n0 + c4 * 4)); }
#pragma unroll
    for (int i = 0; i < 8; ++i) { const int f = i * 64 + lane, kk = f >> 3, c4 = f & 7; LAS float* d = scr + kk * 33 + c4 * 4; d[0] = w4[i].x; d[1] = w4[i].y; d[2] = w4[i].z; d[3] = w4[i].w; }
    LDS_WAIT(); asm volatile("" ::: "memory");
    const int c = lane & 7;
#pragma unroll
    for (int j = 0; j < 4; ++j) { const int n = (lane >> 3) + 8 * j; const LAS float* s = scr + (8 * c) * 33 + n;
        v4u o; o.x = pk2(s[0 * 33], s[1 * 33]); o.y = pk2(s[2 * 33], s[3 * 33]); o.z = pk2(s[4 * 33], s[5 * 33]); o.w = pk2(s[6 * 33], s[7 * 33]);
        __builtin_nontemporal_store(o, (GAS v4u*)(WT + (size_t)(dst_row0 + n) * K + k0 + 8 * c)); }
    LDS_WAIT(); asm volatile("" ::: "memory");
}
constexpr int CQ_ND = NEXP * 256, CQ_N = NEXP * 768;
constexpr int TQ_INPROJ = 9, TQ_GU = 6, TQ_DN = 4;
constexpr int IP_FULL = ((NTOK / 256) * (PIN / 256)) % 256;
constexpr int CQ_T2 = IP_FULL ? (256 - IP_FULL) * 8 * TQ_INPROJ : 0;
__device__ __forceinline__ void convert_item(Frame& F, int layer, int it, LAS float* scr) {
    if (it < CQ_ND) {
        const int e = it >> 8, q = it & 255, kb = q >> 5, nb = q & 31;
        const float* W = F.in[I_WDN] + (size_t)(layer * NEXP + e) * 512 * 1024;
        p0_transpose_item(W, 1024, 512, (bf16*)(F.ws + (layer ? WS_WD1 : WS_WD)), e * 1024 + nb * 32, scr, kb * 64, nb * 32, F.lane);
    } else {
        const int r0 = it - CQ_ND, e = r0 >> 9, r = r0 & 511, up = r >> 8, q = r & 255, kb = q >> 4, nb = q & 15;
        const float* W = (up ? F.in[I_WU] : F.in[I_WG]) + (size_t)(layer * NEXP + e) * 1024 * 512;
        p0_transpose_item(W, 512, 1024, (bf16*)(F.ws + WS_WGU), e * 1024 + (nb >> 2) * 256 + up * 128 + (nb & 3) * 32, scr, kb * 64, nb * 32, F.lane);
    }
}
__device__ __forceinline__ void convert_range(Frame& F, int layer, int first, int end, int start, int stride) {
    LAS float* scr = (LAS float*)(F.lds + RING_OFF + F.wave * 16384);
    for (int it = first + start; it < end; it += stride) convert_item(F, layer, it, scr);
}
__device__ __forceinline__ void p0_prologue(Frame& F) {
    LAS float* scr = (LAS float*)(F.lds + RING_OFF + F.wave * 16384);
    const int gw = F.vcu * NWAVES + F.wave, NGW = F.G * NWAVES;
    constexpr int IA = 16 * 64, IB = 16 * 24, IO = 16 * 32, IP = 4 * 32, NIT = IA + IB + IO + IP;
    for (int it = gw; it < NIT; it += NGW) {
        int r = it;
        if (r < IA) { p0_transpose_item(F.in[I_WIN], 2832, 1024, (bf16*)(F.ws + WS_WIN), (r % 64) * 32, scr, (r / 64) * 64, (r % 64) * 32, F.lane); continue; } r -= IA;
        if (r < IB) { p0_transpose_item(F.in[I_WIN] + 2064, 2832, 1024, (bf16*)(F.ws + WS_WIN), 2048 + (r % 24) * 32, scr, (r / 24) * 64, (r % 24) * 32, F.lane); continue; } r -= IB;
        if (r < IO) { p0_transpose_item(F.in[I_WOUT], 1024, 1024, (bf16*)(F.ws + WS_WOUT), (r % 32) * 32, scr, (r / 32) * 64, (r % 32) * 32, F.lane); continue; } r -= IO;
        { const int g = r >> 5, q = r & 31; p0_transpose_item(F.in[I_POOLW] + (size_t)g * 65536, 256, 256, (bf16*)(F.ws + WS_POOLW) + (size_t)g * 65536, (q & 7) * 32, scr, (q >> 3) * 64, (q & 7) * 32, F.lane); }
    }
    { float* WBA = (float*)(F.ws + WS_WBA); const int gt = F.vcu * 512 + F.tid;
      if (gt < 16 * 1024) { const int o = gt >> 10, k = gt & 1023; WBA[o * 1024 + k] = F.in[I_WIN][(size_t)k * 2832 + 2048 + o]; } }
    __syncthreads();
    {
        LAS float* red = (LAS float*)(F.lds + RING_OFF);
        const int ks = F.tid >> 4, cj = F.tid & 15;
        for (int u = F.vcu; u < 192; u += F.G) {
            const int l = u / 96, cb = u % 96;
            const float* W = F.in[I_ADAW] + (size_t)l * 1024 * 6144 + cb * 64 + cj * 4;
            f32x4 a0 = {0.f, 0.f, 0.f, 0.f}, a1 = {0.f, 0.f, 0.f, 0.f};
            for (int k = ks * 32; k < ks * 32 + 32; ++k) {
                const f32x4 w = *(const f32x4*)(W + (size_t)k * 6144);
                const float c0 = silu_f(F.in[I_C][k]), c1 = silu_f(F.in[I_C][1024 + k]);
                a0 += w * c0; a1 += w * c1;
            }
            *(LAS f32x4*)(red + (ks * 2 + 0) * 64 + cj * 4) = a0; *(LAS f32x4*)(red + (ks * 2 + 1) * 64 + cj * 4) = a1;
            __syncthreads();
            if (F.tid < 128) { const int b = F.tid >> 6, c = F.tid & 63; float s = 0.f;
                for (int q = 0; q < 32; ++q) s += red[(q * 2 + b) * 64 + c];
                ((float*)(F.ws + WS_MOD))[(size_t)(l * 2 + b) * 6144 + cb * 64 + c] = s + F.in[I_ADAB][l * 6144 + cb * 64 + c]; }
            __syncthreads();
        }
    }
}

struct RowVec { f32x4 v[4]; };
__device__ __forceinline__ RowVec load_row_f32(const float* row, int lane) { RowVec r; const GAS f32x4* p = (const GAS f32x4*)row + lane;
#pragma unroll
    for (int j = 0; j < 4; ++j) r.v[j] = p[64 * j]; return r; }
__device__ __forceinline__ void store_row_f32(float* row, int lane, const RowVec& r) { GAS f32x4* p = (GAS f32x4*)row + lane;
#pragma unroll
    for (int j = 0; j < 4; ++j) p[64 * j] = r.v[j]; }
__device__ __forceinline__ void store_row_bf16(bf16* row, int lane, const RowVec& r) { GAS v2u* p = (GAS v2u*)row + lane;
#pragma unroll
    for (int j = 0; j < 4; ++j) { v2u o; o.x = pk2(r.v[j].x, r.v[j].y); o.y = pk2(r.v[j].z, r.v[j].w); p[64 * j] = o; } }
__device__ __forceinline__ void load_row_bf16(const bf16* row, int lane, v2u (&p)[4]) { const GAS v2u* q = (const GAS v2u*)row + lane;
#pragma unroll
    for (int j = 0; j < 4; ++j) p[j] = q[64 * j]; }
__device__ __forceinline__ RowVec unpack_row_bf16(const v2u (&p)[4]) { RowVec r;
#pragma unroll
    for (int j = 0; j < 4; ++j) { r.v[j].x = bflo(p[j].x); r.v[j].y = bfhi(p[j].x); r.v[j].z = bflo(p[j].y); r.v[j].w = bfhi(p[j].y); } return r; }
__device__ __forceinline__ float row_rstd(const RowVec& r) { float s = 0.f;
#pragma unroll
    for (int j = 0; j < 4; ++j) s += (r.v[j].x * r.v[j].x + r.v[j].y * r.v[j].y) + (r.v[j].z * r.v[j].z + r.v[j].w * r.v[j].w);
    return 1.0f / sqrtf(wave_sum(s) * (1.f / D) + EPS); }
struct ModVec { f32x4 a[4], b[4]; };
__device__ __forceinline__ ModVec load_mod(const float* w, const float* sc, const float* sh, int lane) { ModVec m;
#pragma unroll
    for (int j = 0; j < 4; ++j) { const f32x4 wv = *((const f32x4*)w + lane + 64 * j), s = *((const f32x4*)sc + lane + 64 * j); m.a[j] = wv * (s + 1.0f); m.b[j] = *((const f32x4*)sh + lane + 64 * j); }
    return m; }
__device__ __forceinline__ RowVec apply_mod(const RowVec& x, float rstd, const ModVec& m) { RowVec h;
#pragma unroll
    for (int j = 0; j < 4; ++j) h.v[j] = x.v[j] * rstd * m.a[j] + m.b[j]; return h; }

__device__ __forceinline__ void p1_prenorm0(Frame& F) {
    LAS float* wba = (LAS float*)(F.lds + RING_OFF);
    { const float* WBA = (const float*)(F.ws + WS_WBA); for (int i = F.tid; i < 16 * 256; i += 512) *((LAS f32x4*)wba + i) = *((const f32x4*)WBA + i); }
    __syncthreads();
    const float* mod = (const float*)(F.ws + WS_MOD);
    bf16* H = (bf16*)(F.ws + WS_H); float* BG = (float*)(F.ws + WS_BG);
    const int tok0 = F.vcu * (NTOK / F.G) + F.wave * (NTOK / F.G / NWAVES), ntw = NTOK / F.G / NWAVES;
    const int b = tok0 / SEQ;
    const ModVec m = load_mod(F.in[I_NMIX], mod + (size_t)b * 6144 + 1024, mod + (size_t)b * 6144, F.lane);
    const int hh = F.lane & 7;
    const float nega = -__expf(F.in[I_ALOG][hh]), dtb = F.in[I_DTB][hh];
    RowVec xn = load_row_f32(F.in[I_X] + (size_t)tok0 * D, F.lane);
    for (int i = 0; i < ntw; ++i) {
        const int t = tok0 + i;
        const RowVec x = xn;
        if (i + 1 < ntw) xn = load_row_f32(F.in[I_X] + (size_t)(t + 1) * D, F.lane);
        const RowVec h = apply_mod(x, row_rstd(x), m);
        store_row_bf16(H + (size_t)t * D, F.lane, h);
        float mine = 0.f;
#pragma unroll 2
        for (int o = 0; o < 16; ++o) { float s = 0.f;
#pragma unroll
            for (int j = 0; j < 4; ++j) { const f32x4 w = *((const LAS f32x4*)(wba + o * 1024) + F.lane + 64 * j); s += (h.v[j].x * w.x + h.v[j].y * w.y) + (h.v[j].z * w.z + h.v[j].w * w.w); }
            s = wave_sum(s); if (F.lane == o) mine = s; }
        if (F.lane < 8) BG[(size_t)t * 16 + F.lane] = sigmoid_f(mine);
        else if (F.lane < 16) BG[(size_t)t * 16 + F.lane] = nega * softplus_f(mine + dtb);
    }
}

struct DenseSched {
    int nM, nN, nwg, G, c; unsigned lda2, acol2; const char* B; size_t btile;
    __device__ __forceinline__ void init(int M, int N, int G_, int c_, int lda, int acolstride, const void* B_, int ldb) { nM = M / 256; nN = N / 256; nwg = nM * nN; G = G_; c = c_; lda2 = (unsigned)lda * 2u; acol2 = (unsigned)acolstride * 2u; B = (const char*)B_; btile = (size_t)256 * ldb * 2; }
    __device__ __forceinline__ bool next(int i, pg8::Unit& u) const {
        const long L = (long)i * G + c; if (L >= nwg) return false;
        int wgid = (int)L; { const int q = nwg / 8, r = nwg % 8, xcd = wgid % 8, off = wgid / 8; wgid = (xcd < r ? xcd * (q + 1) : r * (q + 1) + (xcd - r) * q) + off; }
        const int nig = 8 * nN, gid = wgid / nig, fm = gid * 8, gsz = (nM - fm) < 8 ? (nM - fm) : 8;
        u.pm = fm + ((wgid % nig) % gsz); u.pn = (wgid % nig) / gsz; u.e = 0; return true;
    }
    __device__ __forceinline__ unsigned a_off(const pg8::Unit& u, int r) const { return (unsigned)(u.pm * 256 + r) * lda2 + (unsigned)u.pn * acol2; }
    __device__ __forceinline__ const char* b_ptr(const pg8::Unit& u) const { return B + (size_t)u.pn * btile; }
};
struct MoeSched {
    const LAS int* cnt; const LAS int* tbase; const LAS int* tileExp;
    int nunits, chunk, G, c; const int* RT; const char* B; size_t bexp, btile; unsigned arow2;
    __device__ __forceinline__ void init(const LAS int* tables, int G_, int c_, const int* RT_, const void* B_, int ldb, int lda) {
        cnt = tables; tbase = tables + 32; tileExp = tables + 80; G = G_; c = c_; RT = RT_; B = (const char*)B_; bexp = (size_t)1024 * ldb * 2; btile = (size_t)256 * ldb * 2; arow2 = (unsigned)lda * 2u;
        nunits = tbase[32] * 4; chunk = ((nunits + 7) / 8 + 3) & ~3;
    }
    __device__ __forceinline__ bool next(int i, pg8::Unit& u) const {
        const int w = i * (G / 8) + (c >> 3); if (w >= chunk) return false;
        const int L = (c & 7) * chunk + w; if (L >= nunits) return false;
        u.pm = L >> 2; u.pn = L & 3; u.e = tileExp[u.pm]; return true;
    }
    __device__ __forceinline__ unsigned a_off(const pg8::Unit& u, int r) const {
        if (RT) { const int pos = (u.pm - tbase[u.e]) * 256 + r; const int tok = pos < cnt[u.e] ? RT[u.e * NTOK + pos] : 0; return (unsigned)tok * arow2; }
        return (unsigned)(u.pm * 256 + r) * arow2;
    }
    __device__ __forceinline__ const char* b_ptr(const pg8::Unit& u) const { return B + (size_t)u.e * bexp + (size_t)u.pn * btile; }
};
__device__ __forceinline__ void build_moe_tables(Frame& F, int layer) {
    LAS int* T = (LAS int*)(F.lds + SCHED_OFF);
    int tid_ = F.tid; asm volatile("" : "+v"(tid_));
    if (tid_ < 32) T[tid_] = (int)__hip_atomic_load(F.ctl + CW_CNT + 64 * layer + tid_, RLX_AGENT);
    __syncthreads();
    if (F.tid == 0) { int acc = 0; for (int e = 0; e < 32; ++e) { T[32 + e] = acc; const int nt = (T[e] + 255) >> 8; for (int j = 0; j < nt; ++j) T[80 + acc + j] = e; acc += nt; } T[64] = acc; }
    __syncthreads();
}

__device__ __forceinline__ int moe_units_of(int c, int G, int nunits, int chunk) {
    const int sl = c >> 3, x = c & 7, per = G / 8; int U = nunits - x * chunk; U = U < 0 ? 0 : (U > chunk ? chunk : U);
    return sl < U ? (U - sl + per - 1) / per : 0;
}
__device__ __forceinline__ void moe_tail_plan(Frame& F) {
    LAS int* T = (LAS int*)(F.lds + SCHED_OFF);
    if (F.tid == 0) { T[65] = 0; T[66] = 0; }
    __syncthreads();
    if (F.tid < 256) {
        const int nunits = T[64] * 4, chunk = ((nunits + 7) / 8 + 3) & ~3, per = F.G / 8, maxu = (chunk + per - 1) / per, c = (int)blockIdx.x;
        const int sp = F.tid < F.G ? maxu - moe_units_of(F.tid, F.G, nunits, chunk) : 0;
        const int lower = (int)wave_sum(F.tid < c ? (float)sp : 0.f), all = (int)wave_sum((float)sp);
        if (F.lane == 0) { atomicAdd((int*)(T + 65), lower); atomicAdd((int*)(T + 66), all); }
        if (F.tid == c) T[67] = sp;
    }
    __syncthreads();
}

struct EpiStoreBf16 {
    bf16* O; int ldc;
    __device__ __forceinline__ void operator()(const f32x4 (&acc)[2][2][4][2], const pg8::Unit& u, int wr, int wc, int fr, int fq) const {
        const int row0 = u.pm * 256 + wr * 64 + fr, col0 = u.pn * 256 + wc * 32 + 8 * fq;
#pragma unroll
        for (int ai = 0; ai < 2; ++ai)
#pragma unroll
            for (int m = 0; m < 4; ++m) { bf16* rowp = O + (size_t)(row0 + ai * 128 + m * 16) * ldc + col0;
#pragma unroll
                for (int bj = 0; bj < 2; ++bj) { const f32x4 v0 = acc[ai][bj][m][0], v1 = acc[ai][bj][m][1];
                    v4u w; w.x = pk2(v0[0], v0[1]); w.y = pk2(v0[2], v0[3]); w.z = pk2(v1[0], v1[1]); w.w = pk2(v1[2], v1[3]);
                    *(v4u*)(rowp + bj * 128) = w; } }
    }
};
struct EpiSwiglu {
    bf16* O;
    __device__ __forceinline__ void operator()(const f32x4 (&acc)[2][2][4][2], const pg8::Unit& u, int wr, int wc, int fr, int fq) const {
        const int row0 = u.pm * 256 + wr * 64 + fr, col0 = u.pn * 128 + wc * 32 + 8 * fq;
#pragma unroll
        for (int ai = 0; ai < 2; ++ai)
#pragma unroll
            for (int m = 0; m < 4; ++m) { bf16* rowp = O + (size_t)(row0 + ai * 128 + m * 16) * DFF + col0;
                float r[8];
#pragma unroll
                for (int n = 0; n < 2; ++n)
#pragma unroll
                    for (int j = 0; j < 4; ++j) r[4 * n + j] = silu_f(acc[ai][0][m][n][j]) * acc[ai][1][m][n][j];
                v4u w; w.x = pk2(r[0], r[1]); w.y = pk2(r[2], r[3]); w.z = pk2(r[4], r[5]); w.w = pk2(r[6], r[7]);
                *(v4u*)rowp = w; }
    }
};

__device__ __forceinline__ void moe_route(Frame& F, int layer) {
    LAS int* hist = (LAS int*)(F.lds + RT_LDS_OFF);
    LAS int* base = hist + 32;
    LAS int* tinfo = hist + 64;
    LAS float* tg = (LAS float*)(hist + 64 + 512);
    if (F.tid < 32) hist[F.tid] = 0;
    LAS f32x4* R2 = (LAS f32x4*)(F.lds + RING_OFF);
    LAS f32x4* R1 = (LAS f32x4*)(F.lds + R1W_OFF);
    { const f32x4* g2p = (const f32x4*)(F.in[I_R2W] + (size_t)layer * 1024 * 32); const f32x4* g1p = (const f32x4*)(F.in[I_R1W] + (size_t)layer * 1024 * 4);
      for (int i = F.tid; i < 8192; i += 512) { const int k = i >> 3, c4 = i & 7, ln = (k & 255) >> 2, q = k & 3, j = k >> 8; R2[((j * 4 + q) * 8 + c4) * 64 + ln] = g2p[i]; }
      for (int k = F.tid; k < 1024; k += 512) { const int ln = (k & 255) >> 2, q = k & 3, j = k >> 8; R1[(j * 4 + q) * 64 + ln] = g1p[k]; } }
    __syncthreads();
    const float* mod = (const float*)(F.ws + WS_MOD) + (size_t)layer * 2 * 6144;
    bf16* H = (bf16*)(F.ws + WS_H);
    const int tokw = F.vcu * 128 + F.wave * 16, b = (F.vcu * 128) / SEQ;
    const ModVec m = load_mod(F.in[I_NFFN] + layer * D, mod + (size_t)b * 6144 + 4 * 1024, mod + (size_t)b * 6144 + 3 * 1024, F.lane);
    const float* r1b = F.in[I_R1B] + layer * 4; const float* r2b = F.in[I_R2B] + layer * 32;
    const float* xin = F.in[I_X]; bf16* XRB = (bf16*)(F.ws + WS_XRB); const bf16* YM = (const bf16*)(F.ws + WS_YM);
    f32x4 cf[4];
#pragma unroll
    for (int j = 0; j < 4; ++j) { cf[j] = *((const f32x4*)(mod + (size_t)b * 6144 + 2 * 1024) + F.lane + 64 * j); if (layer == 1) cf[j] *= *((const f32x4*)F.in[I_POOLS] + F.lane + 64 * j); }
    RowVec xn; v2u xbn[4], yn[4];
    if (layer == 0) xn = load_row_f32(xin + (size_t)tokw * D, F.lane); else load_row_bf16(XRB + (size_t)tokw * D, F.lane, xbn);
#pragma unroll
    for (int j = 0; j < 4; ++j) yn[j] = *((const GAS v2u*)(YM + (size_t)tokw * D) + F.lane + 64 * j);
    for (int i = 0; i < 16; ++i) {
        const int t = tokw + i;
        RowVec x; v2u yc[4];
        if (layer == 0) x = xn; else x = unpack_row_bf16(xbn);
#pragma unroll
        for (int j = 0; j < 4; ++j) yc[j] = yn[j];
        if (i + 1 < 16) { if (layer == 0) xn = load_row_f32(xin + (size_t)(t + 1) * D, F.lane); else load_row_bf16(XRB + (size_t)(t + 1) * D, F.lane, xbn);
#pragma unroll
            for (int j = 0; j < 4; ++j) yn[j] = *((const GAS v2u*)(YM + (size_t)(t + 1) * D) + F.lane + 64 * j); }
#pragma unroll
        for (int j = 0; j < 4; ++j) { f32x4 yv; yv.x = bflo(yc[j].x); yv.y = bfhi(yc[j].x); yv.z = bflo(yc[j].y); yv.w = bfhi(yc[j].y); x.v[j] += cf[j] * yv; }
        store_row_bf16(XRB + (size_t)t * D, F.lane, x);
        RowVec h = apply_mod(x, row_rstd(x), m);
        store_row_bf16(H + (size_t)t * D, F.lane, h);
        f32x4 l1 = {0.f, 0.f, 0.f, 0.f};
#pragma unroll
        for (int j = 0; j < 4; ++j)
#pragma unroll
            for (int q = 0; q < 4; ++q) l1 += R1[(j * 4 + q) * 64 + F.lane] * h.v[j][q];
        float lg[4];
#pragma unroll
        for (int g = 0; g < 4; ++g) lg[g] = wave_sum(l1[g]) + r1b[g];
        int grp = 0; float mx = lg[0];
#pragma unroll
        for (int g = 1; g < 4; ++g) if (lg[g] > mx) { mx = lg[g]; grp = g; }
        float se = 0.f;
#pragma unroll
        for (int g = 0; g < 4; ++g) se += __expf(lg[g] - mx);
        const float ptop = 1.0f / se;
        grp = __builtin_amdgcn_readfirstlane(grp);
        f32x4 a0 = {0.f, 0.f, 0.f, 0.f}, a1 = {0.f, 0.f, 0.f, 0.f};
#pragma unroll
        for (int j = 0; j < 4; ++j)
#pragma unroll
            for (int q = 0; q < 4; ++q) { const LAS f32x4* wp = R2 + ((j * 4 + q) * 8 + grp * 2) * 64 + F.lane;
                a0 += wp[0] * h.v[j][q]; a1 += wp[64] * h.v[j][q]; }
        float l2[8];
#pragma unroll
        for (int q = 0; q < 4; ++q) { l2[q] = wave_sum(a0[q]) + r2b[grp * 8 + q]; l2[4 + q] = wave_sum(a1[q]) + r2b[grp * 8 + 4 + q]; }
        int i0 = 0; float v0 = l2[0];
#pragma unroll
        for (int q = 1; q < 8; ++q) if (l2[q] > v0) { v0 = l2[q]; i0 = q; }
        int i1 = (i0 == 0) ? 1 : 0; float v1 = l2[i1 == 1 ? 1 : 0];
#pragma unroll
        for (int q = 0; q < 8; ++q) if (q != i0 && l2[q] > v1) { v1 = l2[q]; i1 = q; }
        const float g0 = ptop / (1.0f + __expf(v1 - v0)), g1 = ptop - g0;
        if (F.lane == 0) { const int e0 = grp * 8 + i0, e1 = grp * 8 + i1, li = F.wave * 16 + i;
            tinfo[li * 4 + 0] = e0; tinfo[li * 4 + 1] = e1; tinfo[li * 4 + 2] = atomicAdd((int*)(hist + e0), 1); tinfo[li * 4 + 3] = atomicAdd((int*)(hist + e1), 1);
            tg[li * 2] = g0; tg[li * 2 + 1] = g1;
            { float* GA = (float*)(F.ws + WS_BG); GA[(size_t)t * 2] = g0; GA[(size_t)t * 2 + 1] = g1; }
        }
    }
    __syncthreads();
    if (F.tid < 32) base[F.tid] = (int)__hip_atomic_fetch_add(F.ctl + CW_CNT + 64 * layer + F.tid, (unsigned)hist[F.tid], RLX_AGENT);
    __syncthreads();
    if (F.tid < 128) { const int t = F.vcu * 128 + F.tid; const int e0 = tinfo[F.tid * 4], e1 = tinfo[F.tid * 4 + 1];
        const int p0 = base[e0] + tinfo[F.tid * 4 + 2], p1 = base[e1] + tinfo[F.tid * 4 + 3];
        int* RT = (int*)(F.ws + WS_RT); RT[e0 * NTOK + p0] = t; RT[e1 * NTOK + p1] = t;
        v4u r0; r0.x = e0; r0.y = e1; r0.z = p0; r0.w = p1; v4u r1; r1.x = __builtin_bit_cast(unsigned, tg[F.tid * 2]); r1.y = __builtin_bit_cast(unsigned, tg[F.tid * 2 + 1]); r1.z = 0; r1.w = 0;
        v4u* RO = (v4u*)(F.ws + WS_ROUTE) + (size_t)t * 2; RO[0] = r0; (void)r1; }
    __syncthreads();
}

struct CombRows { v2u xb[4], ya[4], yb[4]; };
struct CombRecs { v4u rec; float ga, gb; };
__device__ __forceinline__ CombRecs comb_load_recs(Frame& F, int tokw) { CombRecs c; const int t = tokw + (F.lane & 15);
    c.rec = *((const v4u*)(F.ws + WS_ROUTE) + (size_t)t * 2); const float* GA = (const float*)(F.ws + WS_BG); c.ga = GA[(size_t)t * 2]; c.gb = GA[(size_t)t * 2 + 1]; return c; }
__device__ __forceinline__ int rl_i(int v, int l) { return __builtin_amdgcn_readlane(v, l); }
__device__ __forceinline__ void comb_issue(Frame& F, const CombRecs& c, int i, int t, CombRows& r) {
    const LAS int* T = (const LAS int*)(F.lds + SCHED_OFF);
    const int e0 = rl_i((int)c.rec.x, i), e1 = rl_i((int)c.rec.y, i), p0 = rl_i((int)c.rec.z, i), p1 = rl_i((int)c.rec.w, i);
    const size_t rowa = (size_t)T[32 + e0] * 256 + p0, rowb = (size_t)T[32 + e1] * 256 + p1;
    const bf16* Y = (const bf16*)(F.ws + WS_Y);
    const GAS v2u* ya = (const GAS v2u*)(Y + rowa * D) + F.lane; const GAS v2u* yb = (const GAS v2u*)(Y + rowb * D) + F.lane;
    load_row_bf16((const bf16*)(F.ws + WS_XRB) + (size_t)t * D, F.lane, r.xb);
#pragma unroll
    for (int j = 0; j < 4; ++j) { r.ya[j] = ya[64 * j]; r.yb[j] = yb[64 * j]; }
}
__device__ __forceinline__ RowVec comb_finish(const CombRecs& c, int i, const CombRows& r, const f32x4 (&g2)[4]) {
    const float ga = rl(c.ga, i), gb = rl(c.gb, i); RowVec x = unpack_row_bf16(r.xb);
#pragma unroll
    for (int j = 0; j < 4; ++j) { const v2u a = r.ya[j], bq = r.yb[j];
        f32x4 s; s.x = ga * bflo(a.x) + gb * bflo(bq.x); s.y = ga * bfhi(a.x) + gb * bfhi(bq.x); s.z = ga * bflo(a.y) + gb * bflo(bq.y); s.w = ga * bfhi(a.y) + gb * bfhi(bq.y);
        x.v[j] += g2[j] * s; }
    return x;
}

__device__ __forceinline__ void attn_phase(Frame& F, const int u_first, const int u_stride) {
    LAS bf16* KS = (LAS bf16*)(F.lds + RING_OFF);
    LAS bf16* VT = (LAS bf16*)(F.lds + RING_OFF + 36864);
    LAS float* BT = (LAS float*)(F.lds + RING_OFF + 36864 + 33280);
    const bf16* PROJ = (const bf16*)(F.ws + WS_PROJ); bf16* OAB = (bf16*)(F.ws + WS_OAB);
    const int lane = F.lane, lc = lane & 31, lh = lane >> 5;
    for (int unit = u_first; unit < 512; unit += u_stride) {
        const int b = unit >> 8, kvh = (unit >> 7) & 1, qb = unit & 127, t0 = qb * 128;
        __syncthreads();
        for (int i = F.tid; i < 4 * 192; i += 512) { const int hq = i / 192, x = i - hq * 192, dist = 159 - x; float v = 0.f;
            if (dist >= 0 && dist < 128) { int bk = dist; if (dist >= 16) { bk = 16 + (int)(logf((float)dist / 16.0f) / 2.0794415416798357f * 16.0f); bk = bk > 31 ? 31 : bk; }
                v = F.in[I_RELB][bk * 8 + kvh * 4 + hq] * 1.4426950408889634f; }
            BT[i] = v; }
#pragma unroll
        for (int cc = 0; cc < 4; ++cc) { const int ch = F.tid + 512 * cc, key = ch >> 3, part = ch & 7, tl = t0 - 128 + key;
            v4u kv = {0u, 0u, 0u, 0u}, vv = {0u, 0u, 0u, 0u};
            if (tl >= 0) { const bf16* rp = PROJ + (size_t)(b * SEQ + tl) * PIN; kv = *(const v4u*)(rp + PC_KB + kvh * 64 + part * 8); vv = *(const v4u*)(rp + PC_VB + kvh * 64 + part * 8); }
            *(LAS v4u*)(KS + key * 72 + part * 8) = kv;
            const unsigned w[4] = {vv.x, vv.y, vv.z, vv.w};
#pragma unroll
            for (int q = 0; q < 4; ++q) { VT[(part * 8 + 2 * q) * 260 + key] = (bf16)(w[q] & 0xffffu); VT[(part * 8 + 2 * q + 1) * 260 + key] = (bf16)(w[q] >> 16); } }
        __syncthreads();
#pragma unroll 1
        for (int tt = 0; tt < 2; ++tt) {
            const int task = F.wave * 2 + tt, hq = task >> 2, qt = task & 3, qh = kvh * 4 + hq;
            const int qi = 32 * qt + lc;
            const bf16* qrow = PROJ + (size_t)(b * SEQ + t0 + qi) * PIN + PC_QB + qh * 64 + 8 * lh;
            bf16x8 qf[4];
#pragma unroll
            for (int s = 0; s < 4; ++s) qf[s] = *(const bf16x8*)(qrow + 16 * s);
            f32x16 sc[5];
#pragma unroll
            for (int kt = 0; kt < 5; ++kt) {
#pragma unroll
                for (int r = 0; r < 16; ++r) sc[kt][r] = 0.f;
                const LAS bf16* kp = KS + (32 * (qt + kt) + lc) * 72 + 8 * lh;
#pragma unroll
                for (int s = 0; s < 4; ++s) { const bf16x8 kf = *(const LAS bf16x8*)(kp + 16 * s); sc[kt] = __builtin_amdgcn_mfma_f32_32x32x16_bf16(kf, qf[s], sc[kt], 0, 0, 0); }
            }
            const float sink2 = F.in[I_SINKS][qh] * 1.4426950408889634f;
            const LAS float* bp = BT + hq * 192 + (4 * lh - lc + 31);
            const int m_lo = lc + 1 - 4 * lh, m_hi = lc - 4 * lh;
            float mx = sink2;
#pragma unroll
            for (int kt = 0; kt < 5; ++kt) {
                const bool dead = (t0 == 0) && (qt + kt < 4);
#pragma unroll
                for (int r = 0; r < 16; ++r) { const int cr = (r & 3) + 8 * (r >> 2);
                    float v = sc[kt][r] * (0.125f * 1.4426950408889634f) + bp[32 * kt + cr];
                    if (kt == 0) v = (cr >= m_lo) ? v : -1e30f;
                    if (kt == 4) v = (cr <= m_hi) ? v : -1e30f;
                    if (dead) v = -1e30f;
                    sc[kt][r] = v; mx = fmaxf(mx, v); } }
            mx = fmaxf(mx, __shfl_xor(mx, 32));
            float den = 0.f;
#pragma unroll
            for (int kt = 0; kt < 5; ++kt)
#pragma unroll
                for (int r = 0; r < 16; ++r) { const float p = __builtin_amdgcn_exp2f(sc[kt][r] - mx); sc[kt][r] = p; den += p; }
            den += __shfl_xor(den, 32);
            den += __builtin_amdgcn_exp2f(sink2 - mx);
            const float inv = 1.0f / den;
            f32x16 oa[2];
#pragma unroll
            for (int dt = 0; dt < 2; ++dt)
#pragma unroll
                for (int r = 0; r < 16; ++r) oa[dt][r] = 0.f;
#pragma unroll
            for (int kt = 0; kt < 5; ++kt)
#pragma unroll
                for (int s2 = 0; s2 < 2; ++s2) {
                    v4u pw; pw.x = pk2(sc[kt][8 * s2 + 0], sc[kt][8 * s2 + 1]); pw.y = pk2(sc[kt][8 * s2 + 2], sc[kt][8 * s2 + 3]); pw.z = pk2(sc[kt][8 * s2 + 4], sc[kt][8 * s2 + 5]); pw.w = pk2(sc[kt][8 * s2 + 6], sc[kt][8 * s2 + 7]);
                    const bf16x8 pf = __builtin_bit_cast(bf16x8, pw);
#pragma unroll
                    for (int dt = 0; dt < 2; ++dt) { const LAS bf16* vp = VT + (32 * dt + lc) * 260 + 32 * (qt + kt) + 16 * s2 + 4 * lh;
                        const v2u va = *(const LAS v2u*)vp, vb = *(const LAS v2u*)(vp + 8);
                        v4u vw; vw.x = va.x; vw.y = va.y; vw.z = vb.x; vw.w = vb.y;
                        oa[dt] = __builtin_amdgcn_mfma_f32_32x32x16_bf16(__builtin_bit_cast(bf16x8, vw), pf, oa[dt], 0, 0, 0); }
                }
            bf16* orow = OAB + (size_t)(b * SEQ + t0 + qi) * D + 512 + qh * 64 + 4 * lh;
#pragma unroll
            for (int dt = 0; dt < 2; ++dt)
#pragma unroll
                for (int rg = 0; rg < 4; ++rg) { v2u o; o.x = pk2(oa[dt][4 * rg] * inv, oa[dt][4 * rg + 1] * inv); o.y = pk2(oa[dt][4 * rg + 2] * inv, oa[dt][4 * rg + 3] * inv);
                    *(v2u*)(orow + 32 * dt + 8 * rg) = o; }
        }
    }
    __syncthreads();
}


constexpr int DN_ST = 72;

__device__ __forceinline__ bf16x8 pack8(const f32x16& x, int s) { v4u p; p.x = pk2(x[8 * s], x[8 * s + 1]); p.y = pk2(x[8 * s + 2], x[8 * s + 3]); p.z = pk2(x[8 * s + 4], x[8 * s + 5]); p.w = pk2(x[8 * s + 6], x[8 * s + 7]); return __builtin_bit_cast(bf16x8, p); }
__device__ __forceinline__ f32x16 dn_tile(const LAS bf16* A, int ra, const LAS bf16* B, int rb, int lc, int lh) {
    f32x16 acc;
#pragma unroll
    for (int r = 0; r < 16; ++r) acc[r] = 0.f;
#pragma unroll
    for (int s = 0; s < 4; ++s) { const bf16x8 a = *(const LAS bf16x8*)(A + (ra + lc) * DN_ST + 16 * s + 8 * lh), b = *(const LAS bf16x8*)(B + (rb + lc) * DN_ST + 16 * s + 8 * lh);
        acc = __builtin_amdgcn_mfma_f32_32x32x16_bf16(a, b, acc, 0, 0, 0); }
    return acc;
}
__device__ __forceinline__ void dn_prep(Frame& F) {
    LAS bf16* Qs = (LAS bf16*)(F.lds + RING_OFF);
    LAS bf16* Ks = Qs + 64 * DN_ST;
    LAS bf16* KBs = Ks + 64 * DN_ST;
    LAS bf16* Vs = KBs + 64 * DN_ST;
    LAS bf16* KDT = Vs + 64 * DN_ST;
    LAS bf16* AQK = KDT + 64 * DN_ST;
    LAS bf16* UT = AQK + 64 * DN_ST;
    LAS bf16* WT = UT + 64 * DN_ST;
    LAS bf16* LNO = WT + 64 * DN_ST;
    LAS float* LD = (LAS float*)(LNO + 64 * DN_ST);
    LAS bf16* TDZ = (LAS bf16*)(LD + 64 * 16);
    LAS float* gcs = (LAS float*)(TDZ + 64 * 24);
    LAS float* bts = gcs + 64;
    const bf16* PROJ = (const bf16*)(F.ws + WS_PROJ); const float* BG = (const float*)(F.ws + WS_BG);
    const int tid = F.tid, lane = F.lane, lc = lane & 31, lh = lane >> 5, wave = F.wave;
    LAS float* CW = bts + 64;
    for (int i = tid; i < 1536; i += 512) *((LAS f32x4*)CW + i) = *((const f32x4*)F.in[I_CONVW] + i);
    for (int unit = F.vcu; unit < 4096; unit += F.G) {
        const int b = unit >> 11, h = (unit >> 8) & 7, n = unit & 255;
        const size_t row0 = (size_t)b * SEQ + (size_t)n * 64;
        __syncthreads();
        if (wave == 0) { const float g = BG[(row0 + lane) * 16 + 8 + h]; float c = g;
#pragma unroll
            for (int o = 1; o < 64; o <<= 1) { const float up = __shfl_up(c, o); if (lane >= o) c += up; }
            gcs[lane] = c; bts[lane] = BG[(row0 + lane) * 16 + h]; }
        __syncthreads();
        { const int t = tid >> 3, cs = tid & 7; const int tl = n * 64 + t;
          float q[8], k[8], v[8];
#pragma unroll
          for (int e = 0; e < 8; ++e) { q[e] = 0.f; k[e] = 0.f; v[e] = 0.f; }
#pragma unroll
          for (int j = 0; j < 4; ++j) { if (tl - 3 + j >= 0) { const bf16* rp = PROJ + (row0 + t - 3 + j) * PIN + h * 64 + cs * 8;
                const v4u wq = *(const v4u*)(rp + PC_QA), wk = *(const v4u*)(rp + PC_KA), wv = *(const v4u*)(rp + PC_VA);
                const LAS float* cw = CW + j * 1536 + h * 64 + cs * 8;
                const unsigned uq[4] = {wq.x, wq.y, wq.z, wq.w}, uk[4] = {wk.x, wk.y, wk.z, wk.w}, uv[4] = {wv.x, wv.y, wv.z, wv.w};
#pragma unroll
                for (int e = 0; e < 4; ++e) { q[2 * e] += cw[2 * e] * bflo(uq[e]); q[2 * e + 1] += cw[2 * e + 1] * bfhi(uq[e]);
                    k[2 * e] += cw[512 + 2 * e] * bflo(uk[e]); k[2 * e + 1] += cw[512 + 2 * e + 1] * bfhi(uk[e]);
                    v[2 * e] += cw[1024 + 2 * e] * bflo(uv[e]); v[2 * e + 1] += cw[1024 + 2 * e + 1] * bfhi(uv[e]); } } }
          float sq = 0.f, sk = 0.f;
#pragma unroll
          for (int e = 0; e < 8; ++e) { q[e] = silu_f(q[e]); k[e] = silu_f(k[e]); v[e] = silu_f(v[e]); sq += q[e] * q[e]; sk += k[e] * k[e]; }
          sq = oct_sum(sq); sk = oct_sum(sk);
          const float rq = 0.125f / sqrtf(sq + EPS), rk = 1.0f / sqrtf(sk + EPS), bt = bts[t], kd = __expf(gcs[63] - gcs[t]);
          v4u oq, ok, ob, ov;
          oq.x = pk2(q[0] * rq, q[1] * rq); oq.y = pk2(q[2] * rq, q[3] * rq); oq.z = pk2(q[4] * rq, q[5] * rq); oq.w = pk2(q[6] * rq, q[7] * rq);
#pragma unroll
          for (int e = 0; e < 8; ++e) k[e] *= rk;
          ok.x = pk2(k[0], k[1]); ok.y = pk2(k[2], k[3]); ok.z = pk2(k[4], k[5]); ok.w = pk2(k[6], k[7]);
          ob.x = pk2(k[0] * bt, k[1] * bt); ob.y = pk2(k[2] * bt, k[3] * bt); ob.z = pk2(k[4] * bt, k[5] * bt); ob.w = pk2(k[6] * bt, k[7] * bt);
          ov.x = pk2(v[0], v[1]); ov.y = pk2(v[2], v[3]); ov.z = pk2(v[4], v[5]); ov.w = pk2(v[6], v[7]);
          *(LAS v4u*)(Qs + t * DN_ST + cs * 8) = oq; *(LAS v4u*)(Ks + t * DN_ST + cs * 8) = ok; *(LAS v4u*)(KBs + t * DN_ST + cs * 8) = ob; *(LAS v4u*)(Vs + t * DN_ST + cs * 8) = ov;
#pragma unroll
          for (int e = 0; e < 8; ++e) KDT[(cs * 8 + e) * DN_ST + t] = (bf16)f2bf(k[e] * kd); }
        __syncthreads();
        { const int it = (wave >> 1) & 1, jt = wave & 1; const bool qk = wave >= 4;
          f32x16 acc;
          if (it >= jt) acc = dn_tile(qk ? Qs : KBs, 32 * it, Ks, 32 * jt, lc, lh);
          const int j = 32 * jt + lc; const float gj = gcs[j];
#pragma unroll
          for (int r = 0; r < 16; ++r) { const int i = 32 * it + (r & 3) + 8 * (r >> 2) + 4 * lh;
              float val = 0.f;
              if (it >= jt) { if (qk ? (i >= j) : (i > j)) val = acc[r] * __expf(gcs[i] - gj); }
              if (qk) AQK[i * DN_ST + j] = (bf16)f2bf(val);
              else { const bool diag = (i >> 4) == (j >> 4); LNO[i * DN_ST + j] = (bf16)f2bf(diag ? 0.f : -val); if (diag) LD[i * 16 + (j & 15)] = val; } } }
        __syncthreads();
        if (wave == 0) { const int bb = lane >> 4, c = lane & 15; float tcol[16];
#pragma unroll
            for (int i = 0; i < 16; ++i) { float v = (i == c) ? 1.f : 0.f;
#pragma unroll
                for (int j4 = 0; j4 < (i + 3) / 4; ++j4) { const f32x4 a = *(const LAS f32x4*)(LD + (16 * bb + i) * 16 + 4 * j4);
#pragma unroll
                    for (int e = 0; e < 4; ++e) if (4 * j4 + e < i) v -= a[e] * tcol[4 * j4 + e]; }
                tcol[i] = v; TDZ[(16 * bb + i) * 24 + c] = (bf16)f2bf(v); } }
        __syncthreads();
        if (wave < 4) {
            const int ct = wave, cc = 32 * (ct & 1) + lc; const bool isw = ct >= 2;
            f32x16 acc[2];
#pragma unroll
            for (int rt = 0; rt < 2; ++rt)
#pragma unroll
                for (int r = 0; r < 16; ++r) { const int t = 32 * rt + (r & 3) + 8 * (r >> 2) + 4 * lh;
                    acc[rt][r] = isw ? bf2f(Ks[t * DN_ST + cc]) * bts[t] * __expf(gcs[t]) : bf2f(Vs[t * DN_ST + cc]) * bts[t]; }
#define DN_AFRAG(arr, stride, row, kb) ({ const LAS bf16* p_ = (arr) + (row) * (stride) + 16 * (kb) + 4 * lh; const v2u lo_ = *(const LAS v2u*)p_, hi_ = *(const LAS v2u*)(p_ + 8); v4u w_; w_.x = lo_.x; w_.y = lo_.y; w_.z = hi_.x; w_.w = hi_.y; __builtin_bit_cast(bf16x8, w_); })
            f32x16 X[4];
#pragma unroll
            for (int bb = 0; bb < 4; ++bb) { const int rt = bb >> 1, odd = bb & 1;
                bf16x8 ta = DN_AFRAG(TDZ, 24, 32 * rt + lc, 0);
                if ((lc >> 4) != odd) ta = (bf16x8){0, 0, 0, 0, 0, 0, 0, 0};
                f32x16 z;
#pragma unroll
                for (int r = 0; r < 16; ++r) z[r] = 0.f;
                z = __builtin_amdgcn_mfma_f32_32x32x16_bf16(ta, pack8(acc[rt], odd), z, 0, 0, 0);
                X[bb] = z;
                const bf16x8 xb = pack8(z, odd);
                if (bb == 0) { acc[0] = __builtin_amdgcn_mfma_f32_32x32x16_bf16(DN_AFRAG(LNO, DN_ST, lc, 0), xb, acc[0], 0, 0, 0); acc[1] = __builtin_amdgcn_mfma_f32_32x32x16_bf16(DN_AFRAG(LNO, DN_ST, 32 + lc, 0), xb, acc[1], 0, 0, 0); }
                if (bb == 1) { acc[1] = __builtin_amdgcn_mfma_f32_32x32x16_bf16(DN_AFRAG(LNO, DN_ST, 32 + lc, 1), xb, acc[1], 0, 0, 0); }
                if (bb == 2) { acc[1] = __builtin_amdgcn_mfma_f32_32x32x16_bf16(DN_AFRAG(LNO, DN_ST, 32 + lc, 2), xb, acc[1], 0, 0, 0); }
            }
#undef DN_AFRAG
            LAS bf16* dst = (isw ? WT : UT) + cc * DN_ST;
#pragma unroll
            for (int bb = 0; bb < 4; ++bb)
#pragma unroll
                for (int g = 0; g < 2; ++g) { const int r0 = 8 * (bb & 1) + 4 * g; v2u o; o.x = pk2(X[bb][r0], X[bb][r0 + 1]); o.y = pk2(X[bb][r0 + 2], X[bb][r0 + 3]);
                    *(LAS v2u*)(dst + 16 * bb + 8 * g + 4 * lh) = o; }
        }
        __syncthreads();
        { bf16* MT = (bf16*)(F.ws + WS_DN_MT) + (size_t)unit * 4096; bf16* QPT = (bf16*)(F.ws + WS_DN_QPT) + (size_t)unit * 4096;
          bf16* BM = (bf16*)(F.ws + WS_DN_BM) + (size_t)unit * 4096; bf16* O0T = (bf16*)(F.ws + WS_DN_O0T) + (size_t)unit * 4096;
#pragma unroll 1
          for (int tt = 0; tt < 2; ++tt) { const int task = wave * 2 + tt, p = task >> 2, ta = (task >> 1) & 1, tb = task & 1;
              if (p == 0) {
                  f32x16 acc = dn_tile(WT, 32 * ta, KDT, 32 * tb, lc, lh);
#pragma unroll
                  for (int r = 0; r < 16; ++r) acc[r] = -acc[r];
#pragma unroll
                  for (int s2 = 0; s2 < 2; ++s2) *(bf16x8*)(MT + ((((tb * 2 + ta) * 2 + s2) * 64 + lane) * 8)) = pack8(acc, s2);
              } else if (p == 1) {
                  const f32x16 acc = dn_tile(KDT, 32 * ta, UT, 32 * tb, lc, lh);
#pragma unroll
                  for (int s2 = 0; s2 < 2; ++s2) *(bf16x8*)(BM + ((((tb * 2 + ta) * 2 + s2) * 64 + lane) * 8)) = pack8(acc, s2);
              } else if (p == 2) {
                  f32x16 acc = dn_tile(WT, 32 * ta, AQK, 32 * tb, lc, lh);
                  const int i = 32 * tb + lc; const float eg = __expf(gcs[i]);
#pragma unroll
                  for (int r = 0; r < 16; ++r) { const int a = 32 * ta + (r & 3) + 8 * (r >> 2) + 4 * lh; acc[r] = bf2f(Qs[i * DN_ST + a]) * eg - acc[r]; }
#pragma unroll
                  for (int s2 = 0; s2 < 2; ++s2) *(bf16x8*)(QPT + ((((tb * 2 + ta) * 2 + s2) * 64 + lane) * 8)) = pack8(acc, s2);
              } else {
                  const f32x16 acc = dn_tile(UT, 32 * ta, AQK, 32 * tb, lc, lh);
#pragma unroll
                  for (int s2 = 0; s2 < 2; ++s2) *(bf16x8*)(O0T + ((((tb * 2 + ta) * 2 + s2) * 64 + lane) * 8)) = pack8(acc, s2);
              } }
          if (tid == 0) ((float*)(F.ws + WS_DN_GT))[unit] = __expf(gcs[63]); }
    }
    __syncthreads();
}
template <int r>
__device__ __forceinline__ void dn_scan_wave(Frame& F) {
    const int w = F.vcu, bh = w >> 1, ct = w & 1, lane = F.lane;
    const bf16x8* MT = (const bf16x8*)(F.ws + WS_DN_MT); const bf16x8* BM = (const bf16x8*)(F.ws + WS_DN_BM); bf16x8* SS = (bf16x8*)(F.ws + WS_DN_S);
    const float* GT = (const float*)(F.ws + WS_DN_GT);
    LAS bf16x8* MB = (LAS bf16x8*)(F.lds + RING_OFF);
    volatile LAS int* FL = (volatile LAS int*)(F.lds + LDSCTL_OFF + 64);
    f32x16 S;
#pragma unroll
    for (int q = 0; q < 16; ++q) S[q] = 0.f;
    bf16x8 mA[4], bA[2], mB[4], bB[2], mC[4], bC[2], mD[4], bD[2], mE[4], bE[2], mG[4], bG[2]; float gA, gB, gC, gD, gE, gG;
#define DN_SLOAD(m, bm, gt, u) do { const size_t ub = (size_t)(u) * 512; _Pragma("unroll") for (int f = 0; f < 4; ++f) m[f] = MT[ub + (r * 4 + f) * 64 + lane]; \
        _Pragma("unroll") for (int f = 0; f < 2; ++f) bm[f] = BM[ub + ((ct * 2 + r) * 2 + f) * 64 + lane]; gt = GT[u]; } while (0)
#define DN_STEP(cm, cb, cg, unit, n) do { \
        bf16x8 own[2]; own[0] = pack8(S, 0); own[1] = pack8(S, 1); \
        LAS bf16x8* mb = MB + ((n) & 1) * 256; \
        mb[(r * 2 + 0) * 64 + lane] = own[0]; mb[(r * 2 + 1) * 64 + lane] = own[1]; \
        asm volatile("s_waitcnt lgkmcnt(0)" ::: "memory"); \
        if (lane == 0) FL[r] = (n) + 1; \
        SS[(size_t)(unit) * 512 + (ct * 4 + r * 2 + 0) * 64 + lane] = own[0]; SS[(size_t)(unit) * 512 + (ct * 4 + r * 2 + 1) * 64 + lane] = own[1]; \
        f32x16 A; \
        { const v4u b0 = __builtin_bit_cast(v4u, cb[0]), b1 = __builtin_bit_cast(v4u, cb[1]); const unsigned u0[8] = {b0.x, b0.y, b0.z, b0.w, b1.x, b1.y, b1.z, b1.w}; \
          _Pragma("unroll") for (int e = 0; e < 8; ++e) { A[2 * e] = cg * S[2 * e] + bflo(u0[e]); A[2 * e + 1] = cg * S[2 * e + 1] + bfhi(u0[e]); } } \
        while (FL[1 - r] < (n) + 1) { } \
        asm volatile("" ::: "memory"); \
        bf16x8 oth[2]; oth[0] = mb[((1 - r) * 2 + 0) * 64 + lane]; oth[1] = mb[((1 - r) * 2 + 1) * 64 + lane]; \
          \
        _Pragma("unroll") for (int s2 = 0; s2 < 2; ++s2) { A = __builtin_amdgcn_mfma_f32_32x32x16_bf16(cm[r * 2 + s2], own[s2], A, 0, 0, 0); A = __builtin_amdgcn_mfma_f32_32x32x16_bf16(cm[(1 - r) * 2 + s2], oth[s2], A, 0, 0, 0); } \
        S = A; } while (0)
    const int u0 = bh * 256;
    DN_SLOAD(mA, bA, gA, u0); DN_SLOAD(mB, bB, gB, u0 + 1); DN_SLOAD(mC, bC, gC, u0 + 2); DN_SLOAD(mD, bD, gD, u0 + 3); DN_SLOAD(mE, bE, gE, u0 + 4); DN_SLOAD(mG, bG, gG, u0 + 5);
    for (int n = 0; n < 252; n += 6) {
        DN_STEP(mA, bA, gA, u0 + n, n);         DN_SLOAD(mA, bA, gA, u0 + n + 6);
        DN_STEP(mB, bB, gB, u0 + n + 1, n + 1); DN_SLOAD(mB, bB, gB, u0 + n + 7);
        DN_STEP(mC, bC, gC, u0 + n + 2, n + 2); DN_SLOAD(mC, bC, gC, u0 + n + 8);
        DN_STEP(mD, bD, gD, u0 + n + 3, n + 3); DN_SLOAD(mD, bD, gD, u0 + n + 9);
        DN_STEP(mE, bE, gE, u0 + n + 4, n + 4); if (n + 10 < 256) DN_SLOAD(mE, bE, gE, u0 + n + 10);
        DN_STEP(mG, bG, gG, u0 + n + 5, n + 5); if (n + 11 < 256) DN_SLOAD(mG, bG, gG, u0 + n + 11);
    }
    DN_STEP(mA, bA, gA, u0 + 252, 252); DN_STEP(mB, bB, gB, u0 + 253, 253); DN_STEP(mC, bC, gC, u0 + 254, 254); DN_STEP(mD, bD, gD, u0 + 255, 255);
#undef DN_SLOAD
#undef DN_STEP
}
__device__ __forceinline__ void dn_scan(Frame& F) {
    if (F.vcu >= 32) return;
    if (F.wave == 0) dn_scan_wave<0>(F); else if (F.wave == 1) dn_scan_wave<1>(F);
}
__device__ __forceinline__ void dn_output(Frame& F) {
    const bf16x8* QPT = (const bf16x8*)(F.ws + WS_DN_QPT); const bf16x8* O0T = (const bf16x8*)(F.ws + WS_DN_O0T); const bf16x8* SS = (const bf16x8*)(F.ws + WS_DN_S);
    const bf16* PROJ = (const bf16*)(F.ws + WS_PROJ); bf16* OAB = (bf16*)(F.ws + WS_OAB);
    const int lane = F.lane, lc = lane & 31, lh = lane >> 5; int nbad = 0; (void)nbad;
    for (int task = F.vcu * NWAVES + F.wave; task < 8192; task += F.G * NWAVES) {
        const int unit = task >> 1, it = task & 1, b = unit >> 11, h = (unit >> 8) & 7, n = unit & 255;
        const size_t ub = (size_t)unit * 512;
        f32x16 o[2];
#pragma unroll
        for (int ct = 0; ct < 2; ++ct) {
            const v4u c0 = __builtin_bit_cast(v4u, O0T[ub + ((it * 2 + ct) * 2 + 0) * 64 + lane]), c1 = __builtin_bit_cast(v4u, O0T[ub + ((it * 2 + ct) * 2 + 1) * 64 + lane]);
            const unsigned u[8] = {c0.x, c0.y, c0.z, c0.w, c1.x, c1.y, c1.z, c1.w};
#pragma unroll
            for (int e = 0; e < 8; ++e) { o[ct][2 * e] = bflo(u[e]); o[ct][2 * e + 1] = bfhi(u[e]); }
#pragma unroll
            for (int at = 0; at < 2; ++at)
#pragma unroll
                for (int s2 = 0; s2 < 2; ++s2) o[ct] = __builtin_amdgcn_mfma_f32_32x32x16_bf16(SS[ub + (ct * 4 + at * 2 + s2) * 64 + lane], QPT[ub + ((it * 2 + at) * 2 + s2) * 64 + lane], o[ct], 0, 0, 0);
        }
        float ss = 0.f;
#pragma unroll
        for (int ct = 0; ct < 2; ++ct)
#pragma unroll
            for (int r = 0; r < 16; ++r) ss += o[ct][r] * o[ct][r];
        ss += __shfl_xor(ss, 32);
        const float rs = 1.0f / sqrtf(ss * (1.0f / 64.0f) + EPS);
        const size_t row = (size_t)b * SEQ + (size_t)n * 64 + it * 32 + lc;
#pragma unroll
        for (int ct = 0; ct < 2; ++ct)
#pragma unroll
            for (int rg = 0; rg < 4; ++rg) { const int c0 = 32 * ct + 8 * rg + 4 * lh;
                const v2u zz = *(const v2u*)(PROJ + row * PIN + PC_ZA + h * 64 + c0); const f32x4 ow = *(const f32x4*)(F.in[I_ONORM] + c0);
                const float z0 = bflo(zz.x), z1 = bfhi(zz.x), z2 = bflo(zz.y), z3 = bfhi(zz.y);
                v2u ov; ov.x = pk2(o[ct][4 * rg] * rs * ow[0] * silu_f(z0), o[ct][4 * rg + 1] * rs * ow[1] * silu_f(z1)); ov.y = pk2(o[ct][4 * rg + 2] * rs * ow[2] * silu_f(z2), o[ct][4 * rg + 3] * rs * ow[3] * silu_f(z3));
                *(v2u*)(OAB + row * D + h * 64 + c0) = ov;
            }
    }
}

template <int WIN>
__device__ __forceinline__ void pooled_block(const bf16* H, bf16* P, const int t0, const int tl0, const int col) {
    v4u r[WIN - 1 + 8];
#pragma unroll
    for (int j = 0; j < WIN - 1 + 8; ++j) { const int dt = j - (WIN - 1); r[j] = (v4u){0u, 0u, 0u, 0u}; if (tl0 + dt >= 0) r[j] = *(const v4u*)(H + (size_t)(t0 + dt) * D + col); }
    float s[8];
#pragma unroll
    for (int q = 0; q < 8; ++q) s[q] = 0.f;
#define POOL_ACC(sgn, VV) do { const v4u q_ = (VV); s[0] += sgn bflo(q_.x); s[1] += sgn bfhi(q_.x); s[2] += sgn bflo(q_.y); s[3] += sgn bfhi(q_.y); s[4] += sgn bflo(q_.z); s[5] += sgn bfhi(q_.z); s[6] += sgn bflo(q_.w); s[7] += sgn bfhi(q_.w); } while (0)
#pragma unroll
    for (int j = 0; j < WIN - 1; ++j) POOL_ACC(+, r[j]);
#pragma unroll
    for (int i = 0; i < 8; ++i) { const v4u self = r[WIN - 1 + i]; POOL_ACC(+, self);
        const int n = (tl0 + i + 1) < WIN ? (tl0 + i + 1) : WIN; const float inv = 1.0f / (float)n;
        v4u o; o.x = pk2(s[0] * inv - bflo(self.x), s[1] * inv - bfhi(self.x)); o.y = pk2(s[2] * inv - bflo(self.y), s[3] * inv - bfhi(self.y));
        o.z = pk2(s[4] * inv - bflo(self.z), s[5] * inv - bfhi(self.z)); o.w = pk2(s[6] * inv - bflo(self.w), s[7] * inv - bfhi(self.w));
        *(v4u*)(P + (size_t)(t0 + i) * D + col) = o;
        POOL_ACC(-, r[i]); }
#undef POOL_ACC
}
__device__ __forceinline__ void pooled_phase(Frame& F) {
    const bf16* H = (const bf16*)(F.ws + WS_H); bf16* P = (bf16*)(F.ws + WS_OAB);
    const int gt = F.vcu * 512 + F.tid, NT = F.G * 512;
    for (int it = gt; it < (NTOK / 8) * 128; it += NT) {
        const int c = it & 31, g = __builtin_amdgcn_readfirstlane((it >> 6) & 3), tb = ((it >> 8) << 1) | ((it >> 5) & 1);
        const int t0 = tb * 8, tl0 = t0 & (SEQ - 1), col = g * 256 + c * 8;
        if (g == 0) pooled_block<2>(H, P, t0, tl0, col); else if (g == 1) pooled_block<4>(H, P, t0, tl0, col); else if (g == 2) pooled_block<8>(H, P, t0, tl0, col); else pooled_block<16>(H, P, t0, tl0, col);
    }
}


#ifndef PH_MASK
#define PH_MASK 0xFFFFFF
#endif
#define IN(k) (((PH_MASK >> (k)) & 1) && lo <= (k) && (k) < hi)
#define BOTH(k) (IN(k) && IN((k) + 1))
#if MK_ONE_LAUNCH
#define GRID_BAR() xcd_barrier(bar)
#else
#define GRID_BAR() do { } while (0)
#endif
template <int LAYER>
__device__ __forceinline__ void moe_phases(Frame& F, const XcdBarrier& bar, const int lo, const int hi) {
    constexpr int pb = LAYER == 0 ? 7 : 13;
    bf16* const H = (bf16*)(F.ws + WS_H);
    const float* const MOD = (const float*)(F.ws + WS_MOD);
    if (IN(pb)) {
        moe_route(F, LAYER); if (BOTH(pb)) GRID_BAR(); }
    if (IN(pb + 1)) {
        build_moe_tables(F, LAYER);
        pg8::Gemm g{(const bf16*)H, 1024, 1024}; MoeSched S; S.init((const LAS int*)(F.lds + SCHED_OFF), F.G, (int)blockIdx.x, (const int*)(F.ws + WS_RT), F.ws + WS_WGU, 1024, 1024);
        EpiSwiglu E{(bf16*)(F.ws + WS_ACT)};
        if (LAYER == 0) moe_tail_plan(F);
        pg8::gemm_phase<EpiSwiglu, MoeSched>(F.lds + RING_OFF, g, S, E);
        if (LAYER == 0) {
            const LAS int* T = (const LAS int*)(F.lds + SCHED_OFF); const int sp = T[67];
            if (sp > 0) { __syncthreads(); const int f = T[65] * 8 * TQ_GU; int e = f + sp * 8 * TQ_GU; e = e < CQ_ND ? e : CQ_ND; convert_range(F, 1, f, e, F.wave, 8); } }
        if (BOTH(pb + 1)) GRID_BAR();
    }
    if (IN(pb + 2)) {
        build_moe_tables(F, LAYER);
        pg8::Gemm g{(const bf16*)(F.ws + WS_ACT), 512, 512}; MoeSched S; S.init((const LAS int*)(F.lds + SCHED_OFF), F.G, (int)blockIdx.x, nullptr, F.ws + (LAYER ? WS_WD1 : WS_WD), 512, 512);
        EpiStoreBf16 E{(bf16*)(F.ws + WS_Y), D};
        if (LAYER == 0) moe_tail_plan(F);
        pg8::gemm_phase<EpiStoreBf16, MoeSched>(F.lds + RING_OFF, g, S, E);
        if (LAYER == 0) {
            const LAS int* T = (const LAS int*)(F.lds + SCHED_OFF); const int sp = T[67];
            int t8 = T[66] * 8 * TQ_GU; t8 = t8 < CQ_ND ? t8 : CQ_ND;
            if (sp > 0) { __syncthreads(); const int f = t8 + T[65] * 8 * TQ_DN; int e = f + sp * 8 * TQ_DN; e = e < CQ_N ? e : CQ_N; convert_range(F, 1, f, e, F.wave, 8); } }
        if (BOTH(pb + 2)) GRID_BAR();
    }
    if (IN(pb + 3)) {
        build_moe_tables(F, LAYER);
        if (LAYER == 0) moe_tail_plan(F);
        const int tokw = F.vcu * 128 + F.wave * 16, b = (F.vcu * 128) / SEQ;
        f32x4 g2[4];
#pragma unroll
        for (int j = 0; j < 4; ++j) g2[j] = *((const f32x4*)(MOD + (size_t)(LAYER * 2 + b) * 6144 + 5 * 1024) + F.lane + 64 * j);
        if (LAYER == 0) {
            const ModVec m1 = load_mod(F.in[I_NMIX] + D, MOD + (size_t)(2 + b) * 6144 + 1024, MOD + (size_t)(2 + b) * 6144, F.lane);
            { const CombRecs recs = comb_load_recs(F, tokw); CombRows cur, nxt; comb_issue(F, recs, 0, tokw, cur);
              for (int i = 0; i < 16; ++i) { const int t = tokw + i;
                  if (i + 1 < 16) comb_issue(F, recs, i + 1, t + 1, nxt);
                  const RowVec x = comb_finish(recs, i, cur, g2);
                  store_row_bf16((bf16*)(F.ws + WS_XRB) + (size_t)t * D, F.lane, x); store_row_bf16(H + (size_t)t * D, F.lane, apply_mod(x, row_rstd(x), m1));
                  cur = nxt; } }
            __syncthreads();
            { const LAS int* T = (const LAS int*)(F.lds + SCHED_OFF);
              int t8 = T[66] * 8 * TQ_GU; t8 = t8 < CQ_ND ? t8 : CQ_ND; int t9 = t8 + T[66] * 8 * TQ_DN; t9 = t9 < CQ_N ? t9 : CQ_N;
              convert_range(F, 1, t9, CQ_N, F.vcu * NWAVES + F.wave, F.G * NWAVES); }
        } else {
            f32x4 fw[4];
#pragma unroll
            for (int j = 0; j < 4; ++j) fw[j] = *((const f32x4*)F.in[I_FNW] + F.lane + 64 * j);
            { const CombRecs recs = comb_load_recs(F, tokw); CombRows cur, nxt; comb_issue(F, recs, 0, tokw, cur);
              for (int i = 0; i < 16; ++i) { const int t = tokw + i;
                  if (i + 1 < 16) comb_issue(F, recs, i + 1, t + 1, nxt);
                  RowVec x = comb_finish(recs, i, cur, g2); const float rstd = row_rstd(x);
#pragma unroll
                  for (int j = 0; j < 4; ++j) x.v[j] = x.v[j] * rstd * fw[j];
                  store_row_f32(F.out + (size_t)t * D, F.lane, x);
                  cur = nxt; } }
        }
        if (BOTH(pb + 3)) GRID_BAR();
    }
}

constexpr int PH_P0 = 0, PH_P1 = 1, PH_INPROJ = 2, PH_ATT = 3, PH_SCAN = 4, PH_DNOUT = 5, PH_OUTPROJ = 6, PH_MOE0 = 7, PH_POOLED = 11, PH_POOLG = 12, PH_MOE1 = 13;
constexpr int N_PHASES = 17;
struct Args { const float* in[24]; float* out; unsigned char* ws; int ph_lo, ph_hi; };
__global__ void __launch_bounds__(NWAVES * 64, 2) trunk_fwd(Args args) {
    __shared__ __attribute__((aligned(16))) unsigned char lds[LDS_BYTES];
    Frame F;
    F.lds = (LAS unsigned char*)lds;
    F.MISC = (volatile LAS unsigned*)(F.lds + MISC_OFF);
    F.tid = threadIdx.x; F.lane = F.tid & 63; F.wave = __builtin_amdgcn_readfirstlane(F.tid >> 6);
    F.G = gridDim.x; { const int bx = blockIdx.x; F.vcu = (F.G % 8 == 0) ? (bx % 8) * (F.G / 8) + bx / 8 : bx; }
#pragma unroll
    for (int i = 0; i < 24; ++i) F.in[i] = args.in[i];
    F.out = args.out; F.ws = args.ws; F.ctl = (gu32*)(args.ws + WS_CTL);
    for (int u = F.tid; u < (LDS_BYTES - LDSCTL_OFF) / 4; u += NWAVES * 64) ((LAS unsigned*)(F.lds + LDSCTL_OFF))[u] = 0u;
    __syncthreads();
#if MK_ONE_LAUNCH
    XcdBarrier bar = xcd_barrier_post((unsigned*)(F.ctl + CW_BAR), F.MISC + 8);
#else
    XcdBarrier bar; bar.bar = nullptr; bar.x = 0; bar.st = nullptr;
#endif
    const int lo = args.ph_lo, hi = args.ph_hi;
    bf16* const H = (bf16*)(F.ws + WS_H);
    const float* const MOD = (const float*)(F.ws + WS_MOD);

    if (IN(PH_P0)) { p0_prologue(F); if (BOTH(PH_P0)) GRID_BAR(); }
    if (IN(PH_P1)) { p1_prenorm0(F); if (BOTH(PH_P1)) GRID_BAR(); }
    if (IN(PH_INPROJ)) {
        pg8::Gemm g{(const bf16*)H, 1024, 1024}; DenseSched S; S.init(NTOK, PIN, F.G, (int)blockIdx.x, 1024, 0, F.ws + WS_WIN, 1024);
        EpiStoreBf16 E{(bf16*)(F.ws + WS_PROJ), PIN};
        pg8::gemm_phase<EpiStoreBf16, DenseSched>(F.lds + RING_OFF, g, S, E);
        if (IP_FULL && (int)blockIdx.x >= IP_FULL) {
            __syncthreads(); const int r = (int)blockIdx.x - IP_FULL; convert_range(F, 0, r * 8 * TQ_INPROJ, (r + 1) * 8 * TQ_INPROJ, F.wave, 8); }
        if (BOTH(PH_INPROJ)) GRID_BAR();
    }
    if (IN(PH_ATT)) { dn_prep(F); if (BOTH(PH_ATT)) GRID_BAR(); }
    if (IN(PH_SCAN)) {
        if (F.vcu < 32) dn_scan(F);
        else { attn_phase(F, F.vcu - 32, F.G - 32); __syncthreads(); convert_range(F, 0, CQ_T2, CQ_N, (F.vcu - 32) * NWAVES + F.wave, (F.G - 32) * NWAVES); }
        if (BOTH(PH_SCAN)) GRID_BAR(); }
    if (IN(PH_DNOUT)) { dn_output(F); if (BOTH(PH_DNOUT)) GRID_BAR(); }
    if (IN(PH_OUTPROJ)) {
        pg8::Gemm g{(const bf16*)(F.ws + WS_OAB), 1024, 1024}; DenseSched S; S.init(NTOK, D, F.G, (int)blockIdx.x, 1024, 0, F.ws + WS_WOUT, 1024);
        EpiStoreBf16 E{(bf16*)(F.ws + WS_YM), D};
        pg8::gemm_phase<EpiStoreBf16, DenseSched>(F.lds + RING_OFF, g, S, E);
        if (BOTH(PH_OUTPROJ)) GRID_BAR();
    }
    moe_phases<0>(F, bar, lo, hi);
    if (IN(PH_POOLED)) { pooled_phase(F); if (BOTH(PH_POOLED)) GRID_BAR(); }
    if (IN(PH_POOLG)) {
        pg8::Gemm g{(const bf16*)(F.ws + WS_OAB), 256, 256}; DenseSched S; S.init(NTOK, D, F.G, (int)blockIdx.x, 1024, 256, F.ws + WS_POOLW, 256);
        EpiStoreBf16 E{(bf16*)(F.ws + WS_YM), D};
        pg8::gemm_phase<EpiStoreBf16, DenseSched>(F.lds + RING_OFF, g, S, E);
        if (BOTH(PH_POOLG)) GRID_BAR();
    }
    moe_phases<1>(F, bar, lo, hi);
#undef IN
#undef BOTH
}

extern "C" void kernel_launch(void* const* d_in, const int* in_sizes, int n_in, void* d_out, int out_size, void* d_ws, size_t ws_size, hipStream_t stream) {
    static int grid = 0;
    if (grid == 0) {
        if (n_in != 24 || in_sizes[0] != NTOK * D || out_size != NTOK * D || ws_size < WS_END2) { fprintf(stderr, "kernel_launch: unexpected shapes (n_in %d, in0 %d, out %d, ws %zu); nothing launched\n", n_in, n_in > 0 ? in_sizes[0] : -1, out_size, ws_size); grid = -1; return; }
        int per_cu = 0;
        if (hipOccupancyMaxActiveBlocksPerMultiprocessor(&per_cu, (const void*)trunk_fwd, NWAVES * 64, 0) != hipSuccess || per_cu < 1) fprintf(stderr, "kernel_launch: occupancy query says %d\n", per_cu);
        (void)hipGetLastError();
        grid = 256;
    }
    if (grid < 0) return;
    if (hipMemsetAsync((char*)d_ws + WS_CTL, 0, CTL_ZERO_BYTES, stream) != hipSuccess) { fprintf(stderr, "kernel_launch: memset failed\n"); return; }
    Args a{};
    for (int i = 0; i < 24; ++i) a.in[i] = (const float*)d_in[i];
    a.out = (float*)d_out; a.ws = (unsigned char*)d_ws;
#if MK_ONE_LAUNCH
    a.ph_lo = 0; a.ph_hi = N_PHASES;
    hipLaunchKernelGGL(trunk_fwd, dim3(grid), dim3(NWAVES * 64), 0, stream, a);
#else
    for (int p = 0; p < N_PHASES; ++p) { a.ph_lo = p; a.ph_hi = p + 1; hipLaunchKernelGGL(trunk_fwd, dim3(grid), dim3(NWAVES * 64), 0, stream, a); }
#endif
}
```

```cpp
#include <hip/hip_runtime.h>
#include <cstdio>
#include <cstdint>

#ifndef MK_ONE_LAUNCH
#define MK_ONE_LAUNCH 1
#endif

#define GAS __attribute__((address_space(1)))
#define LAS __attribute__((address_space(3)))
typedef unsigned short bf16;
typedef unsigned v4u __attribute__((ext_vector_type(4)));
typedef unsigned v2u __attribute__((ext_vector_type(2)));
typedef float f32x4 __attribute__((ext_vector_type(4)));
typedef float f32x2 __attribute__((ext_vector_type(2)));
typedef float f32x16 __attribute__((ext_vector_type(16)));
typedef short bf16x8 __attribute__((ext_vector_type(8)));
typedef GAS unsigned gu32;
#define RLX_AGENT __ATOMIC_RELAXED, __HIP_MEMORY_SCOPE_AGENT
#define LDS_WAIT() asm volatile("s_waitcnt lgkmcnt(0)" ::: "memory")
#define VM_WAIT() asm volatile("s_waitcnt vmcnt(0)" ::: "memory")

constexpr int BATCH = 2, SEQ = 16384, D = 1024, NTOK = BATCH * SEQ;
constexpr int PIN = 2816;
constexpr int PC_QA = 0, PC_KA = 512, PC_VA = 1024, PC_ZA = 1536, PC_QB = 2048, PC_KB = 2560, PC_VB = 2688;
constexpr int NEXP = 32, DFF = 512;
constexpr int MAXTILES = NTOK * 2 / 256 + NEXP;
constexpr float EPS = 1e-6f;
constexpr int NWAVES = 8;

constexpr size_t MiB = 1u << 20;
constexpr size_t WS_CTL = 0, CTL_ZERO_BYTES = 1 * MiB;
constexpr size_t WS_MOD = 1 * MiB;
constexpr size_t WS_WBA = 1 * MiB + 128 * 1024;
constexpr size_t WS_ROUTE = 2 * MiB;
constexpr size_t WS_RT = 3 * MiB;
constexpr size_t WS_BG = 7 * MiB;
constexpr size_t WS_WIN = 10 * MiB;
constexpr size_t WS_WOUT = 16 * MiB;
constexpr size_t WS_POOLW = 18 * MiB;
constexpr size_t WS_WGU = 20 * MiB;
constexpr size_t WS_WD = 84 * MiB;
constexpr size_t WS_H = 116 * MiB;
constexpr size_t WS_PROJ = 180 * MiB;
constexpr size_t WS_OAB = 356 * MiB;
constexpr size_t WS_YM = 180 * MiB;
constexpr size_t WS_ACT = 180 * MiB;
constexpr size_t WS_Y = 252 * MiB;
constexpr size_t WS_END = 420 * MiB;
constexpr size_t WS_DN_MT = WS_H;
constexpr size_t WS_DN_QPT = WS_H + 32 * MiB;
constexpr size_t WS_DN_BM = 420 * MiB, WS_DN_O0T = 452 * MiB, WS_DN_S = 484 * MiB;
constexpr size_t WS_DN_GT = 9 * MiB;
constexpr size_t WS_XRB = 420 * MiB;
constexpr size_t WS_WD1 = 484 * MiB;
constexpr size_t WS_END2 = 516 * MiB;
constexpr int CW_CNT = 64;
constexpr int CW_BAR = 4096;
constexpr int CW_BAD = 200;

constexpr int RING_OFF = 0, RING_BYTES = 131072;
constexpr int LDSCTL_OFF = RING_BYTES, MISC_OFF = LDSCTL_OFF + 320;
constexpr int SCHED_OFF = LDSCTL_OFF + 1024;
constexpr int LDS_BYTES = 163840;
constexpr int R1W_OFF = 135168;
constexpr int RT_LDS_OFF = 151552;

typedef __bf16 bf16x2_t __attribute__((ext_vector_type(2)));
__device__ __forceinline__ unsigned pk2(float lo, float hi) { bf16x2_t v; v.x = (__bf16)lo; v.y = (__bf16)hi; return __builtin_bit_cast(unsigned, v); }
__device__ __forceinline__ unsigned f2bf(float f) { return pk2(f, 0.f) & 0xffffu; }
__device__ __forceinline__ float bf2f(unsigned b) { return __builtin_bit_cast(float, b << 16); }
__device__ __forceinline__ float bflo(unsigned w) { return __builtin_bit_cast(float, w << 16); }
__device__ __forceinline__ float bfhi(unsigned w) { return __builtin_bit_cast(float, w & 0xffff0000u); }
template <int CTRL> __device__ __forceinline__ float dpp_f(float v) { return __builtin_bit_cast(float, __builtin_amdgcn_update_dpp(0, __builtin_bit_cast(int, v), CTRL, 0xf, 0xf, false)); }
__device__ __forceinline__ float quad_sum(float v) { v += dpp_f<0xB1>(v); v += dpp_f<0x4E>(v); return v; }
__device__ __forceinline__ float oct_sum(float v) { v = quad_sum(v); v += dpp_f<0x141>(v); return v; }
__device__ __forceinline__ float wave_sum(float v) {
    v = oct_sum(v); v += dpp_f<0x140>(v);
    const float r0 = __builtin_bit_cast(float, __builtin_amdgcn_readlane(__builtin_bit_cast(int, v), 0)), r1 = __builtin_bit_cast(float, __builtin_amdgcn_readlane(__builtin_bit_cast(int, v), 16));
    const float r2 = __builtin_bit_cast(float, __builtin_amdgcn_readlane(__builtin_bit_cast(int, v), 32)), r3 = __builtin_bit_cast(float, __builtin_amdgcn_readlane(__builtin_bit_cast(int, v), 48));
    return (r0 + r1) + (r2 + r3);
}
__device__ __forceinline__ float rl(float x, int l) { return __builtin_bit_cast(float, __builtin_amdgcn_readlane(__builtin_bit_cast(int, x), l)); }
__device__ __forceinline__ float silu_f(float x) { return x / (1.f + __expf(-x)); }
__device__ __forceinline__ float sigmoid_f(float x) { return 1.f / (1.f + __expf(-x)); }
__device__ __forceinline__ float softplus_f(float x) { return x > 20.f ? x : log1pf(__expf(x)); }

namespace pg8 {
#define PG8_LAS __attribute__((address_space(3)))
typedef unsigned short bf16_t;
typedef unsigned u32x4 __attribute__((ext_vector_type(4)));
constexpr int BM = 256, BK = 64, HALF = 128, HTB = HALF * BK * 2, STAGE_BYTES = 8 * HTB;

__host__ __device__ __forceinline__ int lds_byte(int r, int c) { const int st = (r >> 4) * 2 + (c >> 5), rr = r & 15, cc = c & 31, ob = rr * 64 + cc * 2; return st * 1024 + (ob ^ (((ob >> 9) & 1) << 5)); }
__host__ __device__ __forceinline__ void stage_rc(int b, int& R, int& C) { const int st = b / 1024, sb = b % 1024, swz = sb ^ (((sb >> 9) & 1) << 5); R = (st >> 1) * 16 + swz / 64; C = (st & 1) * 32 + (swz % 64) / 2; }
__host__ __device__ __forceinline__ int perm32(int rho) { const int n = rho >> 4, i = rho & 15; return 8 * (i >> 2) + 4 * n + (i & 3); }

struct Unit { int pm, pn, e; };
struct Gemm { const bf16_t* A; int K, ldb; };

template <class Epi, class Sched>
__device__ __forceinline__ void gemm_phase(PG8_LAS unsigned char* lds, const Gemm g, const Sched& S, const Epi& E) {
    const int tid = threadIdx.x, wid = __builtin_amdgcn_readfirstlane(tid >> 6), lane = tid & 63, wr = wid >> 2, wc = wid & 3, fr = lane & 15, fq = lane >> 4;
    const int K = g.K, nt = K / BK;
    int R0, C0, R1, C1; stage_rc(tid * 16, R0, C0); stage_rc(tid * 16 + 8192, R1, C1);
    const int Rb0 = (R0 & ~31) + perm32(R0 & 31), Rb1 = (R1 & ~31) + perm32(R1 & 31);
    const unsigned voffB0 = (unsigned)(Rb0 * g.ldb + C0) * 2u, voffB1 = (unsigned)(Rb1 * g.ldb + C1) * 2u;
    const size_t kstep = (size_t)(BK * 2);
    const size_t hstepB = (size_t)HALF * g.ldb * 2;
    const unsigned ldsw = (unsigned)wid * 1024u;
    const int aoff = lds_byte(wr * 64 + fr, fq * 8), boff = lds_byte(wc * 32 + fr, fq * 8);
    const char* Ab = (const char*)g.A;
#define PG8_SA(b, h) (((b) * 2 + (h)) * HTB)
#define PG8_SB(b, h) ((4 + (b) * 2 + (h)) * HTB)
#define PG8_ST2(bufoff, gbase, v0, v1) do { \
        __builtin_amdgcn_global_load_lds((const unsigned*)((const char*)(gbase) + (v0)), (PG8_LAS unsigned*)(lds + (bufoff) + ldsw), 16, 0, 0); \
        __builtin_amdgcn_global_load_lds((const unsigned*)((const char*)(gbase) + (v1)), (PG8_LAS unsigned*)(lds + (bufoff) + ldsw + 8192), 16, 0, 0); } while (0)
#define PG8_STB(bufoff, gbase) PG8_ST2(bufoff, gbase, voffB0, voffB1)
#define PG8_LDA(dst, b, h) do { _Pragma("unroll") for (int m = 0; m < 4; ++m) _Pragma("unroll") for (int k = 0; k < 2; ++k) dst[m][k] = *(const PG8_LAS bf16x8*)(lds + PG8_SA(b, h) + aoff + m * 2048 + k * 1024); } while (0)
#define PG8_LDB(dst, b, h) do { _Pragma("unroll") for (int n = 0; n < 2; ++n) _Pragma("unroll") for (int k = 0; k < 2; ++k) dst[n][k] = *(const PG8_LAS bf16x8*)(lds + PG8_SB(b, h) + boff + n * 2048 + k * 1024); } while (0)
#define PG8_MMA(ai, bj, At, Bt) do { __builtin_amdgcn_s_setprio(1); _Pragma("unroll") for (int m = 0; m < 4; ++m) _Pragma("unroll") for (int n = 0; n < 2; ++n) _Pragma("unroll") for (int k = 0; k < 2; ++k) \
        acc[ai][bj][m][n] = __builtin_amdgcn_mfma_f32_16x16x32_bf16(Bt[n][k], At[m][k], acc[ai][bj][m][n], 0, 0, 0); __builtin_amdgcn_s_setprio(0); } while (0)
#define PG8_WAIT_V(n) asm volatile("s_waitcnt vmcnt(" #n ")" ::: "memory")
#define PG8_WAIT_L(n) asm volatile("s_waitcnt lgkmcnt(" #n ")" ::: "memory")
#define PG8_BAR __builtin_amdgcn_s_barrier()
#define PG8_SCHED __builtin_amdgcn_sched_barrier(0)
    Unit cur, nxt; int ui = 0;
    if (!S.next(0, cur)) return;
    f32x4 acc[2][2][4][2];
#pragma unroll
    for (int a = 0; a < 2; ++a)
#pragma unroll
        for (int b = 0; b < 2; ++b)
#pragma unroll
            for (int m = 0; m < 4; ++m)
#pragma unroll
                for (int n = 0; n < 2; ++n) acc[a][b][m][n] = (f32x4){0.f, 0.f, 0.f, 0.f};
    bf16x8 At[4][2], B0[2][2], B1[2][2];
    unsigned c00, c01, c10, c11;
#define PG8_AOFF(u, d00, d01, d10, d11) do { \
        d00 = S.a_off(u, R0) + (unsigned)C0 * 2u; d01 = S.a_off(u, R1) + (unsigned)C1 * 2u; \
        d10 = S.a_off(u, HALF + R0) + (unsigned)C0 * 2u; d11 = S.a_off(u, HALF + R1) + (unsigned)C1 * 2u; } while (0)
    PG8_AOFF(cur, c00, c01, c10, c11);
    const char* cB = S.b_ptr(cur);
    PG8_STB(PG8_SB(0, 0), cB); PG8_STB(PG8_SB(0, 1), cB + hstepB); PG8_ST2(PG8_SA(0, 0), Ab, c00, c01); PG8_ST2(PG8_SA(0, 1), Ab, c10, c11);
    if (wr == 1) PG8_BAR;
    PG8_WAIT_V(2); PG8_BAR;
    PG8_STB(PG8_SB(1, 0), cB + kstep); PG8_ST2(PG8_SA(1, 0), Ab + kstep, c00, c01); PG8_STB(PG8_SB(1, 1), cB + hstepB + kstep);
    PG8_WAIT_V(6); PG8_BAR;
    for (;;) {
        const bool has_next = S.next(ui + 1, nxt);
        const char* nB = has_next ? S.b_ptr(nxt) : cB;
#pragma unroll 1
        for (int t = 0; t < nt; t += 2) {
            const bool last = (t == nt - 2);
            const char* a1 = Ab + (size_t)(t + 1) * kstep;
            const char* a2 = last ? Ab : Ab + (size_t)(t + 2) * kstep; const char* b2 = last ? nB : cB + (size_t)(t + 2) * kstep;
            const char* a3 = a2 + kstep; const char* b3 = b2 + kstep;
            PG8_LDB(B0, 0, 0); PG8_LDB(B1, 0, 1); PG8_SCHED; PG8_LDA(At, 0, 0); PG8_ST2(PG8_SA(1, 1), a1, c10, c11);
            PG8_WAIT_V(8); PG8_WAIT_L(0); PG8_BAR; PG8_MMA(0, 0, At, B0); PG8_MMA(0, 1, At, B1); PG8_BAR; PG8_SCHED;
            if (last && has_next) { PG8_AOFF(nxt, c00, c01, c10, c11); }
            PG8_LDA(At, 0, 1); PG8_STB(PG8_SB(0, 0), b2); PG8_STB(PG8_SB(0, 1), b2 + hstepB); PG8_ST2(PG8_SA(0, 0), a2, c00, c01);
            PG8_WAIT_V(8); PG8_WAIT_L(0); PG8_BAR; PG8_MMA(1, 0, At, B0); PG8_MMA(1, 1, At, B1); PG8_BAR; PG8_SCHED;
            PG8_LDB(B0, 1, 0); PG8_LDB(B1, 1, 1); PG8_SCHED; PG8_LDA(At, 1, 0); PG8_ST2(PG8_SA(0, 1), a2, c10, c11);
            PG8_WAIT_V(8); PG8_WAIT_L(0); PG8_BAR; PG8_MMA(0, 0, At, B0); PG8_MMA(0, 1, At, B1); PG8_BAR; PG8_SCHED;
            PG8_LDA(At, 1, 1); PG8_STB(PG8_SB(1, 0), b3); PG8_STB(PG8_SB(1, 1), b3 + hstepB); PG8_ST2(PG8_SA(1, 0), a3, c00, c01);
            PG8_WAIT_V(8); PG8_WAIT_L(0); PG8_BAR; PG8_MMA(1, 0, At, B0); PG8_MMA(1, 1, At, B1); PG8_BAR; PG8_SCHED;
        }
        if (wr == 0) PG8_BAR;
        E(acc, cur, wr, wc, fr, fq);
        if (!has_next) break;
#pragma unroll
        for (int a = 0; a < 2; ++a)
#pragma unroll
            for (int b = 0; b < 2; ++b)
#pragma unroll
                for (int m = 0; m < 4; ++m)
#pragma unroll
                    for (int n = 0; n < 2; ++n) acc[a][b][m][n] = (f32x4){0.f, 0.f, 0.f, 0.f};
        cur = nxt; cB = nB; ++ui;
        if (wr == 1) PG8_BAR;
    }
    PG8_WAIT_V(0);
    PG8_BAR;
#undef PG8_SA
#undef PG8_SB
#undef PG8_ST2
#undef PG8_STB
#undef PG8_LDA
#undef PG8_LDB
#undef PG8_MMA
#undef PG8_WAIT_V
#undef PG8_WAIT_L
#undef PG8_BAR
#undef PG8_SCHED
#undef PG8_AOFF
}
}

#define XB_TMO      128
#define XB_XCNT(j)  (256  + 64 * (j))
#define XB_XSUB(j)  (1280 + 64 * (j))
#define XB_XGEN(j)  (2304 + 64 * (j))
#define XB_TOP      3328
#define XB_TOPGEN   3392
#define XCD_BAR_WORDS 3456
#define XB_SPIN_CAP (1u << 22)

__device__ __forceinline__ unsigned xb_ld(unsigned* p)              { return __hip_atomic_load(p, __ATOMIC_RELAXED, __HIP_MEMORY_SCOPE_AGENT); }
__device__ __forceinline__ unsigned xb_add(unsigned* p, unsigned v) { return __hip_atomic_fetch_add(p, v, __ATOMIC_RELAXED, __HIP_MEMORY_SCOPE_AGENT); }
__device__ __forceinline__ unsigned xb_xcc_id() { return (unsigned)__builtin_amdgcn_s_getreg((3 << 11) | 20) & 0xFu; }
#define XB_SPIN(cond, bar) do { unsigned _sp = 0; while (cond) { __builtin_amdgcn_s_sleep(1); \
    if ((++_sp & 255u) == 0u) { if (xb_ld(&(bar)[XB_TMO])) break; if (_sp > XB_SPIN_CAP) { atomicAdd(&(bar)[XB_TMO], 1u); break; } } } } while (0)

struct XcdBarrier { unsigned* bar; unsigned x; volatile LAS unsigned* st; };

__device__ __forceinline__ XcdBarrier xcd_barrier_post(unsigned* bar, volatile LAS unsigned* st) {
    XcdBarrier b; b.bar = bar; b.x = xb_xcc_id(); b.st = st;
    if (threadIdx.x == 0) (void)xb_add(&bar[XB_XCNT(b.x)], 1u);
    return b;
}
__device__ __forceinline__ void xcd_barrier_complete(unsigned* bar, unsigned x, unsigned& nloc, unsigned& nx) {
    const unsigned G = gridDim.x * gridDim.y * gridDim.z;
    unsigned sum, cnt, mine, sp = 0u;
    for (;;) {
        sum = 0u; cnt = 0u; mine = 0u;
#pragma unroll
        for (unsigned j = 0; j < 16; ++j) { const unsigned c = xb_ld(&bar[XB_XCNT(j)]); sum += c; cnt += (c > 0u) ? 1u : 0u; mine = (j == x) ? c : mine; }
        if (sum == G) break;
        __builtin_amdgcn_s_sleep(1);
        if ((++sp & 255u) == 0u) { if (xb_ld(&bar[XB_TMO])) break; if (sp > XB_SPIN_CAP) { atomicAdd(&bar[XB_TMO], 1u); break; } }
    }
    nloc = mine > 0u ? mine : 1u; nx = cnt > 0u ? cnt : 1u;
}
__device__ __forceinline__ void xcd_barrier(const XcdBarrier& b) {
    asm volatile("s_waitcnt vmcnt(0)" ::: "memory");
    __syncthreads();
    if (threadIdx.x == 0) {
        unsigned* bar = b.bar;
        __builtin_amdgcn_s_waitcnt(0);
        unsigned nloc = b.st[0], nx = b.st[1];
        if (nloc == 0u) { xcd_barrier_complete(bar, b.x, nloc, nx); b.st[0] = nloc; b.st[1] = nx; }
        const unsigned old = xb_add(&bar[XB_XSUB(b.x)], 1u);
        const unsigned gen = old / nloc;
        if (old + 1u == (gen + 1u) * nloc) {
            __builtin_amdgcn_fence(__ATOMIC_RELEASE, "agent");
            asm volatile("s_waitcnt vmcnt(0)" ::: "memory");
            const unsigned og = xb_add(&bar[XB_TOP], 1u);
            const unsigned tg = og / nx;
            if (og + 1u == (tg + 1u) * nx) xb_add(&bar[XB_TOPGEN], 1u);
            else XB_SPIN(xb_ld(&bar[XB_TOPGEN]) == tg, bar);
            __builtin_amdgcn_fence(__ATOMIC_ACQUIRE, "agent");
            xb_add(&bar[XB_XGEN(b.x)], 1u);
            asm volatile("s_waitcnt vmcnt(0)" ::: "memory");
        } else {
            XB_SPIN(xb_ld(&bar[XB_XGEN(b.x)]) == gen, bar);
            __builtin_amdgcn_fence(__ATOMIC_ACQUIRE, "agent");
            asm volatile("s_waitcnt vmcnt(0)" ::: "memory");
        }
    }
    __syncthreads();
}

struct Frame {
    LAS unsigned char* lds;
    volatile LAS unsigned* MISC;
    gu32* ctl;
    int tid, lane, wave, vcu, G;
    const float* in[24];
    float* out;
    unsigned char* ws;
};
enum { I_X = 0, I_C, I_ADAW, I_ADAB, I_NMIX, I_NFFN, I_WIN, I_CONVW, I_ALOG, I_DTB, I_ONORM, I_SINKS, I_RELB, I_WOUT, I_POOLW, I_POOLS, I_R1W, I_R1B, I_R2W, I_R2B, I_WG, I_WU, I_WDN, I_FNW };

__device__ __forceinline__ void p0_transpose_item(const float* W, int ldw, int K, bf16* WT, int dst_row0, LAS float* scr, int k0, int n0, int lane) {
    f32x4 w4[8];
#pragma unroll
    for (int i = 0; i < 8; ++i) { const int f = i * 64 + lane, kk = f >> 3, c4 = f & 7; w4[i] = __builtin_nontemporal_load((const f32x4*)(W + (size_t)(k0 + kk) * ldw + n0 + c4 * 4)); }
#pragma unroll
    for (int i = 0; i < 8; ++i) { const int f = i * 64 + lane, kk = f >> 3, c4 = f & 7; LAS float* d = scr + kk * 33 + c4 * 4; d[0] = w4[i].x; d[1] = w4[i].y; d[2] = w4[i].z; d[3] = w4[i].w; }
    LDS_WAIT(); asm volatile("" ::: "memory");
    const int c = lane & 7;
#pragma unroll
    for (int j = 0; j < 4; ++j) { const int n = (lane >> 3) + 8 * j; const LAS float* s = scr + (8 * c) * 33 + n;
        v4u o; o.x = pk2(s[0 * 33], s[1 * 33]); o.y = pk2(s[2 * 33], s[3 * 33]); o.z = pk2(s[4 * 33], s[5 * 33]); o.w = pk2(s[6 * 33], s[7 * 33]);
        __builtin_nontemporal_store(o, (GAS v4u*)(WT + (size_t)(dst_row0 + n) * K + k0 + 8 * c)); }
    LDS_WAIT(); asm volatile("" ::: "memory");
}
constexpr int CQ_ND = NEXP * 256, CQ_N = NEXP * 768;
constexpr int TQ_INPROJ = 9, TQ_GU = 6, TQ_DN = 4;
constexpr int IP_FULL = ((NTOK / 256) * (PIN / 256)) % 256;
constexpr int CQ_T2 = IP_FULL ? (256 - IP_FULL) * 8 * TQ_INPROJ : 0;
__device__ __forceinline__ void convert_item(Frame& F, int layer, int it, LAS float* scr) {
    if (it < CQ_ND) {
        const int e = it >> 8, q = it & 255, kb = q >> 5, nb = q & 31;
        const float* W = F.in[I_WDN] + (size_t)(layer * NEXP + e) * 512 * 1024;
        p0_transpose_item(W, 1024, 512, (bf16*)(F.ws + (layer ? WS_WD1 : WS_WD)), e * 1024 + nb * 32, scr, kb * 64, nb * 32, F.lane);
    } else {
        const int r0 = it - CQ_ND, e = r0 >> 9, r = r0 & 511, up = r >> 8, q = r & 255, kb = q >> 4, nb = q & 15;
        const float* W = (up ? F.in[I_WU] : F.in[I_WG]) + (size_t)(layer * NEXP + e) * 1024 * 512;
        p0_transpose_item(W, 512, 1024, (bf16*)(F.ws + WS_WGU), e * 1024 + (nb >> 2) * 256 + up * 128 + (nb & 3) * 32, scr, kb * 64, nb * 32, F.lane);
    }
}
__device__ __forceinline__ void convert_range(Frame& F, int layer, int first, int end, int start, int stride) {
    LAS float* scr = (LAS float*)(F.lds + RING_OFF + F.wave * 16384);
    for (int it = first + start; it < end; it += stride) convert_item(F, layer, it, scr);
}
__device__ __forceinline__ void p0_prologue(Frame& F) {
    LAS float* scr = (LAS float*)(F.lds + RING_OFF + F.wave * 16384);
    const int gw = F.vcu * NWAVES + F.wave, NGW = F.G * NWAVES;
    constexpr int IA = 16 * 64, IB = 16 * 24, IO = 16 * 32, IP = 4 * 32, NIT = IA + IB + IO + IP;
    for (int it = gw; it < NIT; it += NGW) {
        int r = it;
        if (r < IA) { p0_transpose_item(F.in[I_WIN], 2832, 1024, (bf16*)(F.ws + WS_WIN), (r % 64) * 32, scr, (r / 64) * 64, (r % 64) * 32, F.lane); continue; } r -= IA;
        if (r < IB) { p0_transpose_item(F.in[I_WIN] + 2064, 2832, 1024, (bf16*)(F.ws + WS_WIN), 2048 + (r % 24) * 32, scr, (r / 24) * 64, (r % 24) * 32, F.lane); continue; } r -= IB;
        if (r < IO) { p0_transpose_item(F.in[I_WOUT], 1024, 1024, (bf16*)(F.ws + WS_WOUT), (r % 32) * 32, scr, (r / 32) * 64, (r % 32) * 32, F.lane); continue; } r -= IO;
        { const int g = r >> 5, q = r & 31; p0_transpose_item(F.in[I_POOLW] + (size_t)g * 65536, 256, 256, (bf16*)(F.ws + WS_POOLW) + (size_t)g * 65536, (q & 7) * 32, scr, (q >> 3) * 64, (q & 7) * 32, F.lane); }
    }
    { float* WBA = (float*)(F.ws + WS_WBA); const int gt = F.vcu * 512 + F.tid;
      if (gt < 16 * 1024) { const int o = gt >> 10, k = gt & 1023; WBA[o * 1024 + k] = F.in[I_WIN][(size_t)k * 2832 + 2048 + o]; } }
    __syncthreads();
    {
        LAS float* red = (LAS float*)(F.lds + RING_OFF);
        const int ks = F.tid >> 4, cj = F.tid & 15;
        for (int u = F.vcu; u < 192; u += F.G) {
            const int l = u / 96, cb = u % 96;
            const float* W = F.in[I_ADAW] + (size_t)l * 1024 * 6144 + cb * 64 + cj * 4;
            f32x4 a0 = {0.f, 0.f, 0.f, 0.f}, a1 = {0.f, 0.f, 0.f, 0.f};
            for (int k = ks * 32; k < ks * 32 + 32; ++k) {
                const f32x4 w = *(const f32x4*)(W + (size_t)k * 6144);
                const float c0 = silu_f(F.in[I_C][k]), c1 = silu_f(F.in[I_C][1024 + k]);
                a0 += w * c0; a1 += w * c1;
            }
            *(LAS f32x4*)(red + (ks * 2 + 0) * 64 + cj * 4) = a0; *(LAS f32x4*)(red + (ks * 2 + 1) * 64 + cj * 4) = a1;
            __syncthreads();
            if (F.tid < 128) { const int b = F.tid >> 6, c = F.tid & 63; float s = 0.f;
                for (int q = 0; q < 32; ++q) s += red[(q * 2 + b) * 64 + c];
                ((float*)(F.ws + WS_MOD))[(size_t)(l * 2 + b) * 6144 + cb * 64 + c] = s + F.in[I_ADAB][l * 6144 + cb * 64 + c]; }
            __syncthreads();
        }
    }
}

struct RowVec { f32x4 v[4]; };
__device__ __forceinline__ RowVec load_row_f32(const float* row, int lane) { RowVec r; const GAS f32x4* p = (const GAS f32x4*)row + lane;
#pragma unroll
    for (int j = 0; j < 4; ++j) r.v[j] = p[64 * j]; return r; }
__device__ __forceinline__ void store_row_f32(float* row, int lane, const RowVec& r) { GAS f32x4* p = (GAS f32x4*)row + lane;
#pragma unroll
    for (int j = 0; j < 4; ++j) p[64 * j] = r.v[j]; }
__device__ __forceinline__ void store_row_bf16(bf16* row, int lane, const RowVec& r) { GAS v2u* p = (GAS v2u*)row + lane;
#pragma unroll
    for (int j = 0; j < 4; ++j) { v2u o; o.x = pk2(r.v[j].x, r.v[j].y); o.y = pk2(r.v[j].z, r.v[j].w); p[64 * j] = o; } }
__device__ __forceinline__ void load_row_bf16(const bf16* row, int lane, v2u (&p)[4]) { const GAS v2u* q = (const GAS v2u*)row + lane;
#pragma unroll
    for (int j = 0; j < 4; ++j) p[j] = q[64 * j]; }
__device__ __forceinline__ RowVec unpack_row_bf16(const v2u (&p)[4]) { RowVec r;
#pragma unroll
    for (int j = 0; j < 4; ++j) { r.v[j].x = bflo(p[j].x); r.v[j].y = bfhi(p[j].x); r.v[j].z = bflo(p[j].y); r.v[j].w = bfhi(p[j].y); } return r; }
__device__ __forceinline__ float row_rstd(const RowVec& r) { float s = 0.f;
#pragma unroll
    for (int j = 0; j < 4; ++j) s += (r.v[j].x * r.v[j].x + r.v[j].y * r.v[j].y) + (r.v[j].z * r.v[j].z + r.v[j].w * r.v[j].w);
    return 1.0f / sqrtf(wave_sum(s) * (1.f / D) + EPS); }
struct ModVec { f32x4 a[4], b[4]; };
__device__ __forceinline__ ModVec load_mod(const float* w, const float* sc, const float* sh, int lane) { ModVec m;
#pragma unroll
    for (int j = 0; j < 4; ++j) { const f32x4 wv = *((const f32x4*)w + lane + 64 * j), s = *((const f32x4*)sc + lane + 64 * j); m.a[j] = wv * (s + 1.0f); m.b[j] = *((const f32x4*)sh + lane + 64 * j); }
    return m; }
__device__ __forceinline__ RowVec apply_mod(const RowVec& x, float rstd, const ModVec& m) { RowVec h;
#pragma unroll
    for (int j = 0; j < 4; ++j) h.v[j] = x.v[j] * rstd * m.a[j] + m.b[j]; return h; }

__device__ __forceinline__ void p1_prenorm0(Frame& F) {
    LAS float* wba = (LAS float*)(F.lds + RING_OFF);
    { const float* WBA = (const float*)(F.ws + WS_WBA); for (int i = F.tid; i < 16 * 256; i += 512) *((LAS f32x4*)wba + i) = *((const f32x4*)WBA + i); }
    __syncthreads();
    const float* mod = (const float*)(F.ws + WS_MOD);
    bf16* H = (bf16*)(F.ws + WS_H); float* BG = (float*)(F.ws + WS_BG);
    const int tok0 = F.vcu * (NTOK / F.G) + F.wave * (NTOK / F.G / NWAVES), ntw = NTOK / F.G / NWAVES;
    const int b = tok0 / SEQ;
    const ModVec m = load_mod(F.in[I_NMIX], mod + (size_t)b * 6144 + 1024, mod + (size_t)b * 6144, F.lane);
    const int hh = F.lane & 7;
    const float nega = -__expf(F.in[I_ALOG][hh]), dtb = F.in[I_DTB][hh];
    RowVec xn = load_row_f32(F.in[I_X] + (size_t)tok0 * D, F.lane);
    for (int i = 0; i < ntw; ++i) {
        const int t = tok0 + i;
        const RowVec x = xn;
        if (i + 1 < ntw) xn = load_row_f32(F.in[I_X] + (size_t)(t + 1) * D, F.lane);
        const RowVec h = apply_mod(x, row_rstd(x), m);
        store_row_bf16(H + (size_t)t * D, F.lane, h);
        float mine = 0.f;
#pragma unroll 2
        for (int o = 0; o < 16; ++o) { float s = 0.f;
#pragma unroll
            for (int j = 0; j < 4; ++j) { const f32x4 w = *((const LAS f32x4*)(wba + o * 1024) + F.lane + 64 * j); s += (h.v[j].x * w.x + h.v[j].y * w.y) + (h.v[j].z * w.z + h.v[j].w * w.w); }
            s = wave_sum(s); if (F.lane == o) mine = s; }
        if (F.lane < 8) BG[(size_t)t * 16 + F.lane] = sigmoid_f(mine);
        else if (F.lane < 16) BG[(size_t)t * 16 + F.lane] = nega * softplus_f(mine + dtb);
    }
}

struct DenseSched {
    int nM, nN, nwg, G, c; unsigned lda2, acol2; const char* B; size_t btile;
    __device__ __forceinline__ void init(int M, int N, int G_, int c_, int lda, int acolstride, const void* B_, int ldb) { nM = M / 256; nN = N / 256; nwg = nM * nN; G = G_; c = c_; lda2 = (unsigned)lda * 2u; acol2 = (unsigned)acolstride * 2u; B = (const char*)B_; btile = (size_t)256 * ldb * 2; }
    __device__ __forceinline__ bool next(int i, pg8::Unit& u) const {
        const long L = (long)i * G + c; if (L >= nwg) return false;
        int wgid = (int)L; { const int q = nwg / 8, r = nwg % 8, xcd = wgid % 8, off = wgid / 8; wgid = (xcd < r ? xcd * (q + 1) : r * (q + 1) + (xcd - r) * q) + off; }
        const int nig = 8 * nN, gid = wgid / nig, fm = gid * 8, gsz = (nM - fm) < 8 ? (nM - fm) : 8;
        u.pm = fm + ((wgid % nig) % gsz); u.pn = (wgid % nig) / gsz; u.e = 0; return true;
    }
    __device__ __forceinline__ unsigned a_off(const pg8::Unit& u, int r) const { return (unsigned)(u.pm * 256 + r) * lda2 + (unsigned)u.pn * acol2; }
    __device__ __forceinline__ const char* b_ptr(const pg8::Unit& u) const { return B + (size_t)u.pn * btile; }
};
struct MoeSched {
    const LAS int* cnt; const LAS int* tbase; const LAS int* tileExp;
    int nunits, chunk, G, c; const int* RT; const char* B; size_t bexp, btile; unsigned arow2;
    __device__ __forceinline__ void init(const LAS int* tables, int G_, int c_, const int* RT_, const void* B_, int ldb, int lda) {
        cnt = tables; tbase = tables + 32; tileExp = tables + 80; G = G_; c = c_; RT = RT_; B = (const char*)B_; bexp = (size_t)1024 * ldb * 2; btile = (size_t)256 * ldb * 2; arow2 = (unsigned)lda * 2u;
        nunits = tbase[32] * 4; chunk = ((nunits + 7) / 8 + 3) & ~3;
    }
    __device__ __forceinline__ bool next(int i, pg8::Unit& u) const {
        const int w = i * (G / 8) + (c >> 3); if (w >= chunk) return false;
        const int L = (c & 7) * chunk + w; if (L >= nunits) return false;
        u.pm = L >> 2; u.pn = L & 3; u.e = tileExp[u.pm]; return true;
    }
    __device__ __forceinline__ unsigned a_off(const pg8::Unit& u, int r) const {
        if (RT) { const int pos = (u.pm - tbase[u.e]) * 256 + r; const int tok = pos < cnt[u.e] ? RT[u.e * NTOK + pos] : 0; return (unsigned)tok * arow2; }
        return (unsigned)(u.pm * 256 + r) * arow2;
    }
    __device__ __forceinline__ const char* b_ptr(const pg8::Unit& u) const { return B + (size_t)u.e * bexp + (size_t)u.pn * btile; }
};
__device__ __forceinline__ void build_moe_tables(Frame& F, int layer) {
    LAS int* T = (LAS int*)(F.lds + SCHED_OFF);
    int tid_ = F.tid; asm volatile("" : "+v"(tid_));
    if (tid_ < 32) T[tid_] = (int)__hip_atomic_load(F.ctl + CW_CNT + 64 * layer + tid_, RLX_AGENT);
    __syncthreads();
    if (F.tid == 0) { int acc = 0; for (int e = 0; e < 32; ++e) { T[32 + e] = acc; const int nt = (T[e] + 255) >> 8; for (int j = 0; j < nt; ++j) T[80 + acc + j] = e; acc += nt; } T[64] = acc; }
    __syncthreads();
}

__device__ __forceinline__ int moe_units_of(int c, int G, int nunits, int chunk) {
    const int sl = c >> 3, x = c & 7, per = G / 8; int U = nunits - x * chunk; U = U < 0 ? 0 : (U > chunk ? chunk : U);
    return sl < U ? (U - sl + per - 1) / per : 0;
}
__device__ __forceinline__ void moe_tail_plan(Frame& F) {
    LAS int* T = (LAS int*)(F.lds + SCHED_OFF);
    if (F.tid == 0) { T[65] = 0; T[66] = 0; }
    __syncthreads();
    if (F.tid < 256) {
        const int nunits = T[64] * 4, chunk = ((nunits + 7) / 8 + 3) & ~3, per = F.G / 8, maxu = (chunk + per - 1) / per, c = (int)blockIdx.x;
        const int sp = F.tid < F.G ? maxu - moe_units_of(F.tid, F.G, nunits, chunk) : 0;
        const int lower = (int)wave_sum(F.tid < c ? (float)sp : 0.f), all = (int)wave_sum((float)sp);
        if (F.lane == 0) { atomicAdd((int*)(T + 65), lower); atomicAdd((int*)(T + 66), all); }
        if (F.tid == c) T[67] = sp;
    }
    __syncthreads();
}

struct EpiStoreBf16 {
    bf16* O; int ldc;
    __device__ __forceinline__ void operator()(const f32x4 (&acc)[2][2][4][2], const pg8::Unit& u, int wr, int wc, int fr, int fq) const {
        const int row0 = u.pm * 256 + wr * 64 + fr, col0 = u.pn * 256 + wc * 32 + 8 * fq;
#pragma unroll
        for (int ai = 0; ai < 2; ++ai)
#pragma unroll
            for (int m = 0; m < 4; ++m) { bf16* rowp = O + (size_t)(row0 + ai * 128 + m * 16) * ldc + col0;
#pragma unroll
                for (int bj = 0; bj < 2; ++bj) { const f32x4 v0 = acc[ai][bj][m][0], v1 = acc[ai][bj][m][1];
                    v4u w; w.x = pk2(v0[0], v0[1]); w.y = pk2(v0[2], v0[3]); w.z = pk2(v1[0], v1[1]); w.w = pk2(v1[2], v1[3]);
                    *(v4u*)(rowp + bj * 128) = w; } }
    }
};
template <bool F32SRC> struct EpiResid {
    const float* X; bf16* O; const float* cf; const float* mul;
    __device__ __forceinline__ void operator()(const f32x4 (&acc)[2][2][4][2], const pg8::Unit& u, int wr, int wc, int fr, int fq) const {
        const int row0 = u.pm * 256 + wr * 64 + fr, col0 = u.pn * 256 + wc * 32 + 8 * fq, b = (u.pm * 256) / SEQ;
        f32x4 c[2][2];
#pragma unroll
        for (int bj = 0; bj < 2; ++bj)
#pragma unroll
            for (int n = 0; n < 2; ++n) { c[bj][n] = *(const f32x4*)(cf + (size_t)b * 6144 + col0 + bj * 128 + 4 * n); if (mul) c[bj][n] *= *(const f32x4*)(mul + col0 + bj * 128 + 4 * n); }
#pragma unroll
        for (int ai = 0; ai < 2; ++ai)
#pragma unroll
            for (int m = 0; m < 4; ++m) { const size_t ro = (size_t)(row0 + ai * 128 + m * 16) * D + col0;
                f32x4 s[2][2];
                if (F32SRC) {
#pragma unroll
                    for (int bj = 0; bj < 2; ++bj) { s[bj][0] = *(const GAS f32x4*)(X + ro + bj * 128); s[bj][1] = *(const GAS f32x4*)(X + ro + bj * 128 + 4); }
                } else {
#pragma unroll
                    for (int bj = 0; bj < 2; ++bj) { const v4u q = *(const GAS v4u*)(O + ro + bj * 128);
                        s[bj][0].x = bflo(q.x); s[bj][0].y = bfhi(q.x); s[bj][0].z = bflo(q.y); s[bj][0].w = bfhi(q.y); s[bj][1].x = bflo(q.z); s[bj][1].y = bfhi(q.z); s[bj][1].z = bflo(q.w); s[bj][1].w = bfhi(q.w); }
                }
#pragma unroll
                for (int bj = 0; bj < 2; ++bj) { const f32x4 v0 = s[bj][0] + c[bj][0] * acc[ai][bj][m][0], v1 = s[bj][1] + c[bj][1] * acc[ai][bj][m][1];
                    v4u w; w.x = pk2(v0[0], v0[1]); w.y = pk2(v0[2], v0[3]); w.z = pk2(v1[0], v1[1]); w.w = pk2(v1[2], v1[3]);
                    *(v4u*)(O + ro + bj * 128) = w; } }
    }
};
struct EpiSwiglu {
    bf16* O;
    __device__ __forceinline__ void operator()(const f32x4 (&acc)[2][2][4][2], const pg8::Unit& u, int wr, int wc, int fr, int fq) const {
        const int row0 = u.pm * 256 + wr * 64 + fr, col0 = u.pn * 128 + wc * 32 + 8 * fq;
#pragma unroll
        for (int ai = 0; ai < 2; ++ai)
#pragma unroll
            for (int m = 0; m < 4; ++m) { bf16* rowp = O + (size_t)(row0 + ai * 128 + m * 16) * DFF + col0;
                float r[8];
#pragma unroll
                for (int n = 0; n < 2; ++n)
#pragma unroll
                    for (int j = 0; j < 4; ++j) r[4 * n + j] = silu_f(acc[ai][0][m][n][j]) * acc[ai][1][m][n][j];
                v4u w; w.x = pk2(r[0], r[1]); w.y = pk2(r[2], r[3]); w.z = pk2(r[4], r[5]); w.w = pk2(r[6], r[7]);
                *(v4u*)rowp = w; }
    }
};

__device__ __forceinline__ void moe_route(Frame& F, int layer) {
    LAS int* hist = (LAS int*)(F.lds + RT_LDS_OFF);
    LAS int* base = hist + 32;
    LAS int* tinfo = hist + 64;
    LAS float* tg = (LAS float*)(hist + 64 + 512);
    if (F.tid < 32) hist[F.tid] = 0;
    LAS f32x4* R2 = (LAS f32x4*)(F.lds + RING_OFF);
    LAS f32x4* R1 = (LAS f32x4*)(F.lds + R1W_OFF);
    { const f32x4* g2p = (const f32x4*)(F.in[I_R2W] + (size_t)layer * 1024 * 32); const f32x4* g1p = (const f32x4*)(F.in[I_R1W] + (size_t)layer * 1024 * 4);
      for (int i = F.tid; i < 8192; i += 512) { const int k = i >> 3, c4 = i & 7, ln = (k & 255) >> 2, q = k & 3, j = k >> 8; R2[((j * 4 + q) * 8 + c4) * 64 + ln] = g2p[i]; }
      for (int k = F.tid; k < 1024; k += 512) { const int ln = (k & 255) >> 2, q = k & 3, j = k >> 8; R1[(j * 4 + q) * 64 + ln] = g1p[k]; } }
    __syncthreads();
    const float* mod = (const float*)(F.ws + WS_MOD) + (size_t)layer * 2 * 6144;
    bf16* H = (bf16*)(F.ws + WS_H);
    const int tokw = F.vcu * 128 + F.wave * 16, b = (F.vcu * 128) / SEQ;
    const ModVec m = load_mod(F.in[I_NFFN] + layer * D, mod + (size_t)b * 6144 + 4 * 1024, mod + (size_t)b * 6144 + 3 * 1024, F.lane);
    const float* r1b = F.in[I_R1B] + layer * 4; const float* r2b = F.in[I_R2B] + layer * 32;
    const bf16* XRB = (const bf16*)(F.ws + WS_XRB);
    v2u xbn[4], xb2[4];
    load_row_bf16(XRB + (size_t)tokw * D, F.lane, xbn); load_row_bf16(XRB + (size_t)(tokw + 1) * D, F.lane, xb2);
    for (int i = 0; i < 16; ++i) {
        const int t = tokw + i;
        const RowVec x = unpack_row_bf16(xbn);
#pragma unroll
        for (int j = 0; j < 4; ++j) xbn[j] = xb2[j];
        if (i + 2 < 16) load_row_bf16(XRB + (size_t)(t + 2) * D, F.lane, xb2);
        RowVec h = apply_mod(x, row_rstd(x), m);
        store_row_bf16(H + (size_t)t * D, F.lane, h);
        f32x4 l1 = {0.f, 0.f, 0.f, 0.f};
#pragma unroll
        for (int j = 0; j < 4; ++j)
#pragma unroll
            for (int q = 0; q < 4; ++q) l1 += R1[(j * 4 + q) * 64 + F.lane] * h.v[j][q];
        float lg[4];
#pragma unroll
        for (int g = 0; g < 4; ++g) lg[g] = wave_sum(l1[g]) + r1b[g];
        int grp = 0; float mx = lg[0];
#pragma unroll
        for (int g = 1; g < 4; ++g) if (lg[g] > mx) { mx = lg[g]; grp = g; }
        float se = 0.f;
#pragma unroll
        for (int g = 0; g < 4; ++g) se += __expf(lg[g] - mx);
        const float ptop = 1.0f / se;
        grp = __builtin_amdgcn_readfirstlane(grp);
        f32x4 a0 = {0.f, 0.f, 0.f, 0.f}, a1 = {0.f, 0.f, 0.f, 0.f};
#pragma unroll
        for (int j = 0; j < 4; ++j)
#pragma unroll
            for (int q = 0; q < 4; ++q) { const LAS f32x4* wp = R2 + ((j * 4 + q) * 8 + grp * 2) * 64 + F.lane;
                a0 += wp[0] * h.v[j][q]; a1 += wp[64] * h.v[j][q]; }
        float l2[8];
#pragma unroll
        for (int q = 0; q < 4; ++q) { l2[q] = wave_sum(a0[q]) + r2b[grp * 8 + q]; l2[4 + q] = wave_sum(a1[q]) + r2b[grp * 8 + 4 + q]; }
        int i0 = 0; float v0 = l2[0];
#pragma unroll
        for (int q = 1; q < 8; ++q) if (l2[q] > v0) { v0 = l2[q]; i0 = q; }
        int i1 = (i0 == 0) ? 1 : 0; float v1 = l2[i1 == 1 ? 1 : 0];
#pragma unroll
        for (int q = 0; q < 8; ++q) if (q != i0 && l2[q] > v1) { v1 = l2[q]; i1 = q; }
        const float g0 = ptop / (1.0f + __expf(v1 - v0)), g1 = ptop - g0;
        if (F.lane == 0) { const int e0 = grp * 8 + i0, e1 = grp * 8 + i1, li = F.wave * 16 + i;
            tinfo[li * 4 + 0] = e0; tinfo[li * 4 + 1] = e1; tinfo[li * 4 + 2] = atomicAdd((int*)(hist + e0), 1); tinfo[li * 4 + 3] = atomicAdd((int*)(hist + e1), 1);
            tg[li * 2] = g0; tg[li * 2 + 1] = g1;
            { float* GA = (float*)(F.ws + WS_BG); GA[(size_t)t * 2] = g0; GA[(size_t)t * 2 + 1] = g1; }
        }
    }
    __syncthreads();
    if (F.tid < 32) base[F.tid] = (int)__hip_atomic_fetch_add(F.ctl + CW_CNT + 64 * layer + F.tid, (unsigned)hist[F.tid], RLX_AGENT);
    __syncthreads();
    if (F.tid < 128) { const int t = F.vcu * 128 + F.tid; const int e0 = tinfo[F.tid * 4], e1 = tinfo[F.tid * 4 + 1];
        const int p0 = base[e0] + tinfo[F.tid * 4 + 2], p1 = base[e1] + tinfo[F.tid * 4 + 3];
        int* RT = (int*)(F.ws + WS_RT); RT[e0 * NTOK + p0] = t; RT[e1 * NTOK + p1] = t;
        v4u r0; r0.x = e0; r0.y = e1; r0.z = p0; r0.w = p1; v4u r1; r1.x = __builtin_bit_cast(unsigned, tg[F.tid * 2]); r1.y = __builtin_bit_cast(unsigned, tg[F.tid * 2 + 1]); r1.z = 0; r1.w = 0;
        v4u* RO = (v4u*)(F.ws + WS_ROUTE) + (size_t)t * 2; RO[0] = r0; (void)r1; }
    __syncthreads();
}

struct CombRows { v2u xb[4], ya[4], yb[4]; };
struct CombRecs { v4u rec; float ga, gb; };
__device__ __forceinline__ CombRecs comb_load_recs(Frame& F, int tokw) { CombRecs c; const int t = tokw + (F.lane & 15);
    c.rec = *((const v4u*)(F.ws + WS_ROUTE) + (size_t)t * 2); const float* GA = (const float*)(F.ws + WS_BG); c.ga = GA[(size_t)t * 2]; c.gb = GA[(size_t)t * 2 + 1]; return c; }
__device__ __forceinline__ int rl_i(int v, int l) { return __builtin_amdgcn_readlane(v, l); }
__device__ __forceinline__ void comb_issue(Frame& F, const CombRecs& c, int i, int t, CombRows& r) {
    const LAS int* T = (const LAS int*)(F.lds + SCHED_OFF);
    const int e0 = rl_i((int)c.rec.x, i), e1 = rl_i((int)c.rec.y, i), p0 = rl_i((int)c.rec.z, i), p1 = rl_i((int)c.rec.w, i);
    const size_t rowa = (size_t)T[32 + e0] * 256 + p0, rowb = (size_t)T[32 + e1] * 256 + p1;
    const bf16* Y = (const bf16*)(F.ws + WS_Y);
    const GAS v2u* ya = (const GAS v2u*)(Y + rowa * D) + F.lane; const GAS v2u* yb = (const GAS v2u*)(Y + rowb * D) + F.lane;
    load_row_bf16((const bf16*)(F.ws + WS_XRB) + (size_t)t * D, F.lane, r.xb);
#pragma unroll
    for (int j = 0; j < 4; ++j) { r.ya[j] = ya[64 * j]; r.yb[j] = yb[64 * j]; }
}
__device__ __forceinline__ RowVec comb_finish(const CombRecs& c, int i, const CombRows& r, const f32x4 (&g2)[4]) {
    const float ga = rl(c.ga, i), gb = rl(c.gb, i); RowVec x = unpack_row_bf16(r.xb);
#pragma unroll
    for (int j = 0; j < 4; ++j) { const v2u a = r.ya[j], bq = r.yb[j];
        f32x4 s; s.x = ga * bflo(a.x) + gb * bflo(bq.x); s.y = ga * bfhi(a.x) + gb * bfhi(bq.x); s.z = ga * bflo(a.y) + gb * bflo(bq.y); s.w = ga * bfhi(a.y) + gb * bfhi(bq.y);
        x.v[j] += g2[j] * s; }
    return x;
}

__device__ __forceinline__ void attn_phase(Frame& F, const int u_first, const int u_stride) {
    LAS bf16* KS = (LAS bf16*)(F.lds + RING_OFF);
    LAS bf16* VT = (LAS bf16*)(F.lds + RING_OFF + 36864);
    LAS float* BT = (LAS float*)(F.lds + RING_OFF + 36864 + 33280);
    const bf16* PROJ = (const bf16*)(F.ws + WS_PROJ); bf16* OAB = (bf16*)(F.ws + WS_OAB);
    const int lane = F.lane, lc = lane & 31, lh = lane >> 5;
    for (int unit = u_first; unit < 512; unit += u_stride) {
        const int b = unit >> 8, kvh = (unit >> 7) & 1, qb = unit & 127, t0 = qb * 128;
        __syncthreads();
        for (int i = F.tid; i < 4 * 192; i += 512) { const int hq = i / 192, x = i - hq * 192, dist = 159 - x; float v = 0.f;
            if (dist >= 0 && dist < 128) { int bk = dist; if (dist >= 16) { bk = 16 + (int)(logf((float)dist / 16.0f) / 2.0794415416798357f * 16.0f); bk = bk > 31 ? 31 : bk; }
                v = F.in[I_RELB][bk * 8 + kvh * 4 + hq] * 1.4426950408889634f; }
            BT[i] = v; }
#pragma unroll
        for (int cc = 0; cc < 4; ++cc) { const int ch = F.tid + 512 * cc, key = ch >> 3, part = ch & 7, tl = t0 - 128 + key;
            v4u kv = {0u, 0u, 0u, 0u}, vv = {0u, 0u, 0u, 0u};
            if (tl >= 0) { const bf16* rp = PROJ + (size_t)(b * SEQ + tl) * PIN; kv = *(const v4u*)(rp + PC_KB + kvh * 64 + part * 8); vv = *(const v4u*)(rp + PC_VB + kvh * 64 + part * 8); }
            *(LAS v4u*)(KS + key * 72 + part * 8) = kv;
            const unsigned w[4] = {vv.x, vv.y, vv.z, vv.w};
#pragma unroll
            for (int q = 0; q < 4; ++q) { VT[(part * 8 + 2 * q) * 260 + key] = (bf16)(w[q] & 0xffffu); VT[(part * 8 + 2 * q + 1) * 260 + key] = (bf16)(w[q] >> 16); } }
        __syncthreads();
#pragma unroll 1
        for (int tt = 0; tt < 2; ++tt) {
            const int task = F.wave * 2 + tt, hq = task >> 2, qt = task & 3, qh = kvh * 4 + hq;
            const int qi = 32 * qt + lc;
            const bf16* qrow = PROJ + (size_t)(b * SEQ + t0 + qi) * PIN + PC_QB + qh * 64 + 8 * lh;
            bf16x8 qf[4];
#pragma unroll
            for (int s = 0; s < 4; ++s) qf[s] = *(const bf16x8*)(qrow + 16 * s);
            f32x16 sc[5];
#pragma unroll
            for (int kt = 0; kt < 5; ++kt) {
#pragma unroll
                for (int r = 0; r < 16; ++r) sc[kt][r] = 0.f;
                const LAS bf16* kp = KS + (32 * (qt + kt) + lc) * 72 + 8 * lh;
#pragma unroll
                for (int s = 0; s < 4; ++s) { const bf16x8 kf = *(const LAS bf16x8*)(kp + 16 * s); sc[kt] = __builtin_amdgcn_mfma_f32_32x32x16_bf16(kf, qf[s], sc[kt], 0, 0, 0); }
            }
            const float sink2 = F.in[I_SINKS][qh] * 1.4426950408889634f;
            const LAS float* bp = BT + hq * 192 + (4 * lh - lc + 31);
            const int m_lo = lc + 1 - 4 * lh, m_hi = lc - 4 * lh;
            float mx = sink2;
#pragma unroll
            for (int kt = 0; kt < 5; ++kt) {
                const bool dead = (t0 == 0) && (qt + kt < 4);
#pragma unroll
                for (int r = 0; r < 16; ++r) { const int cr = (r & 3) + 8 * (r >> 2);
                    float v = sc[kt][r] * (0.125f * 1.4426950408889634f) + bp[32 * kt + cr];
                    if (kt == 0) v = (cr >= m_lo) ? v : -1e30f;
                    if (kt == 4) v = (cr <= m_hi) ? v : -1e30f;
                    if (dead) v = -1e30f;
                    sc[kt][r] = v; mx = fmaxf(mx, v); } }
            mx = fmaxf(mx, __shfl_xor(mx, 32));
            float den = 0.f;
#pragma unroll
            for (int kt = 0; kt < 5; ++kt)
#pragma unroll
                for (int r = 0; r < 16; ++r) { const float p = __builtin_amdgcn_exp2f(sc[kt][r] - mx); sc[kt][r] = p; den += p; }
            den += __shfl_xor(den, 32);
            den += __builtin_amdgcn_exp2f(sink2 - mx);
            const float inv = 1.0f / den;
            f32x16 oa[2];
#pragma unroll
            for (int dt = 0; dt < 2; ++dt)
#pragma unroll
                for (int r = 0; r < 16; ++r) oa[dt][r] = 0.f;
#pragma unroll
            for (int kt = 0; kt < 5; ++kt)
#pragma unroll
                for (int s2 = 0; s2 < 2; ++s2) {
                    v4u pw; pw.x = pk2(sc[kt][8 * s2 + 0], sc[kt][8 * s2 + 1]); pw.y = pk2(sc[kt][8 * s2 + 2], sc[kt][8 * s2 + 3]); pw.z = pk2(sc[kt][8 * s2 + 4], sc[kt][8 * s2 + 5]); pw.w = pk2(sc[kt][8 * s2 + 6], sc[kt][8 * s2 + 7]);
                    const bf16x8 pf = __builtin_bit_cast(bf16x8, pw);
#pragma unroll
                    for (int dt = 0; dt < 2; ++dt) { const LAS bf16* vp = VT + (32 * dt + lc) * 260 + 32 * (qt + kt) + 16 * s2 + 4 * lh;
                        const v2u va = *(const LAS v2u*)vp, vb = *(const LAS v2u*)(vp + 8);
                        v4u vw; vw.x = va.x; vw.y = va.y; vw.z = vb.x; vw.w = vb.y;
                        oa[dt] = __builtin_amdgcn_mfma_f32_32x32x16_bf16(__builtin_bit_cast(bf16x8, vw), pf, oa[dt], 0, 0, 0); }
                }
            bf16* orow = OAB + (size_t)(b * SEQ + t0 + qi) * D + 512 + qh * 64 + 4 * lh;
#pragma unroll
            for (int dt = 0; dt < 2; ++dt)
#pragma unroll
                for (int rg = 0; rg < 4; ++rg) { v2u o; o.x = pk2(oa[dt][4 * rg] * inv, oa[dt][4 * rg + 1] * inv); o.y = pk2(oa[dt][4 * rg + 2] * inv, oa[dt][4 * rg + 3] * inv);
                    *(v2u*)(orow + 32 * dt + 8 * rg) = o; }
        }
    }
    __syncthreads();
}


constexpr int DN_ST = 72;

__device__ __forceinline__ bf16x8 pack8(const f32x16& x, int s) { v4u p; p.x = pk2(x[8 * s], x[8 * s + 1]); p.y = pk2(x[8 * s + 2], x[8 * s + 3]); p.z = pk2(x[8 * s + 4], x[8 * s + 5]); p.w = pk2(x[8 * s + 6], x[8 * s + 7]); return __builtin_bit_cast(bf16x8, p); }
__device__ __forceinline__ f32x16 dn_tile(const LAS bf16* A, int ra, const LAS bf16* B, int rb, int lc, int lh) {
    f32x16 acc;
#pragma unroll
    for (int r = 0; r < 16; ++r) acc[r] = 0.f;
#pragma unroll
    for (int s = 0; s < 4; ++s) { const bf16x8 a = *(const LAS bf16x8*)(A + (ra + lc) * DN_ST + 16 * s + 8 * lh), b = *(const LAS bf16x8*)(B + (rb + lc) * DN_ST + 16 * s + 8 * lh);
        acc = __builtin_amdgcn_mfma_f32_32x32x16_bf16(a, b, acc, 0, 0, 0); }
    return acc;
}
__device__ __forceinline__ void dn_prep(Frame& F) {
    LAS bf16* Qs = (LAS bf16*)(F.lds + RING_OFF);
    LAS bf16* Ks = Qs + 64 * DN_ST;
    LAS bf16* KBs = Ks + 64 * DN_ST;
    LAS bf16* Vs = KBs + 64 * DN_ST;
    LAS bf16* KDT = Vs + 64 * DN_ST;
    LAS bf16* AQK = KDT + 64 * DN_ST;
    LAS bf16* UT = AQK + 64 * DN_ST;
    LAS bf16* WT = UT + 64 * DN_ST;
    LAS bf16* LNO = WT + 64 * DN_ST;
    LAS float* LD = (LAS float*)(LNO + 64 * DN_ST);
    LAS bf16* TDZ = (LAS bf16*)(LD + 64 * 16);
    LAS float* gcs = (LAS float*)(TDZ + 64 * 24);
    LAS float* bts = gcs + 64;
    const bf16* PROJ = (const bf16*)(F.ws + WS_PROJ); const float* BG = (const float*)(F.ws + WS_BG);
    const int tid = F.tid, lane = F.lane, lc = lane & 31, lh = lane >> 5, wave = F.wave;
    LAS float* CW = bts + 64;
    for (int i = tid; i < 1536; i += 512) *((LAS f32x4*)CW + i) = *((const f32x4*)F.in[I_CONVW] + i);
    for (int unit = F.vcu; unit < 4096; unit += F.G) {
        const int b = unit >> 11, h = (unit >> 8) & 7, n = unit & 255;
        const size_t row0 = (size_t)b * SEQ + (size_t)n * 64;
        __syncthreads();
        if (wave == 0) { const float g = BG[(row0 + lane) * 16 + 8 + h]; float c = g;
#pragma unroll
            for (int o = 1; o < 64; o <<= 1) { const float up = __shfl_up(c, o); if (lane >= o) c += up; }
            gcs[lane] = c; bts[lane] = BG[(row0 + lane) * 16 + h]; }
        __syncthreads();
        { const int t = tid >> 3, cs = tid & 7; const int tl = n * 64 + t;
          float q[8], k[8], v[8];
#pragma unroll
          for (int e = 0; e < 8; ++e) { q[e] = 0.f; k[e] = 0.f; v[e] = 0.f; }
#pragma unroll
          for (int j = 0; j < 4; ++j) { if (tl - 3 + j >= 0) { const bf16* rp = PROJ + (row0 + t - 3 + j) * PIN + h * 64 + cs * 8;
                const v4u wq = *(const v4u*)(rp + PC_QA), wk = *(const v4u*)(rp + PC_KA), wv = *(const v4u*)(rp + PC_VA);
                const LAS float* cw = CW + j * 1536 + h * 64 + cs * 8;
                const unsigned uq[4] = {wq.x, wq.y, wq.z, wq.w}, uk[4] = {wk.x, wk.y, wk.z, wk.w}, uv[4] = {wv.x, wv.y, wv.z, wv.w};
#pragma unroll
                for (int e = 0; e < 4; ++e) { q[2 * e] += cw[2 * e] * bflo(uq[e]); q[2 * e + 1] += cw[2 * e + 1] * bfhi(uq[e]);
                    k[2 * e] += cw[512 + 2 * e] * bflo(uk[e]); k[2 * e + 1] += cw[512 + 2 * e + 1] * bfhi(uk[e]);
                    v[2 * e] += cw[1024 + 2 * e] * bflo(uv[e]); v[2 * e + 1] += cw[1024 + 2 * e + 1] * bfhi(uv[e]); } } }
          float sq = 0.f, sk = 0.f;
#pragma unroll
          for (int e = 0; e < 8; ++e) { q[e] = silu_f(q[e]); k[e] = silu_f(k[e]); v[e] = silu_f(v[e]); sq += q[e] * q[e]; sk += k[e] * k[e]; }
          sq = oct_sum(sq); sk = oct_sum(sk);
          const float rq = 0.125f / sqrtf(sq + EPS), rk = 1.0f / sqrtf(sk + EPS), bt = bts[t], kd = __expf(gcs[63] - gcs[t]);
          v4u oq, ok, ob, ov;
          oq.x = pk2(q[0] * rq, q[1] * rq); oq.y = pk2(q[2] * rq, q[3] * rq); oq.z = pk2(q[4] * rq, q[5] * rq); oq.w = pk2(q[6] * rq, q[7] * rq);
#pragma unroll
          for (int e = 0; e < 8; ++e) k[e] *= rk;
          ok.x = pk2(k[0], k[1]); ok.y = pk2(k[2], k[3]); ok.z = pk2(k[4], k[5]); ok.w = pk2(k[6], k[7]);
          ob.x = pk2(k[0] * bt, k[1] * bt); ob.y = pk2(k[2] * bt, k[3] * bt); ob.z = pk2(k[4] * bt, k[5] * bt); ob.w = pk2(k[6] * bt, k[7] * bt);
          ov.x = pk2(v[0], v[1]); ov.y = pk2(v[2], v[3]); ov.z = pk2(v[4], v[5]); ov.w = pk2(v[6], v[7]);
          *(LAS v4u*)(Qs + t * DN_ST + cs * 8) = oq; *(LAS v4u*)(Ks + t * DN_ST + cs * 8) = ok; *(LAS v4u*)(KBs + t * DN_ST + cs * 8) = ob; *(LAS v4u*)(Vs + t * DN_ST + cs * 8) = ov;
#pragma unroll
          for (int e = 0; e < 8; ++e) KDT[(cs * 8 + e) * DN_ST + t] = (bf16)f2bf(k[e] * kd); }
        __syncthreads();
        { const int it = (wave >> 1) & 1, jt = wave & 1; const bool qk = wave >= 4;
          f32x16 acc;
          if (it >= jt) acc = dn_tile(qk ? Qs : KBs, 32 * it, Ks, 32 * jt, lc, lh);
          const int j = 32 * jt + lc; const float gj = gcs[j];
#pragma unroll
          for (int r = 0; r < 16; ++r) { const int i = 32 * it + (r & 3) + 8 * (r >> 2) + 4 * lh;
              float val = 0.f;
              if (it >= jt) { if (qk ? (i >= j) : (i > j)) val = acc[r] * __expf(gcs[i] - gj); }
              if (qk) AQK[i * DN_ST + j] = (bf16)f2bf(val);
              else { const bool diag = (i >> 4) == (j >> 4); LNO[i * DN_ST + j] = (bf16)f2bf(diag ? 0.f : -val); if (diag) LD[i * 16 + (j & 15)] = val; } } }
        __syncthreads();
        if (wave == 0) { const int bb = lane >> 4, c = lane & 15; float tcol[16];
#pragma unroll
            for (int i = 0; i < 16; ++i) { float v = (i == c) ? 1.f : 0.f;
#pragma unroll
                for (int j4 = 0; j4 < (i + 3) / 4; ++j4) { const f32x4 a = *(const LAS f32x4*)(LD + (16 * bb + i) * 16 + 4 * j4);
#pragma unroll
                    for (int e = 0; e < 4; ++e) if (4 * j4 + e < i) v -= a[e] * tcol[4 * j4 + e]; }
                tcol[i] = v; TDZ[(16 * bb + i) * 24 + c] = (bf16)f2bf(v); } }
        __syncthreads();
        if (wave < 4) {
            const int ct = wave, cc = 32 * (ct & 1) + lc; const bool isw = ct >= 2;
            f32x16 acc[2];
#pragma unroll
            for (int rt = 0; rt < 2; ++rt)
#pragma unroll
                for (int r = 0; r < 16; ++r) { const int t = 32 * rt + (r & 3) + 8 * (r >> 2) + 4 * lh;
                    acc[rt][r] = isw ? bf2f(Ks[t * DN_ST + cc]) * bts[t] * __expf(gcs[t]) : bf2f(Vs[t * DN_ST + cc]) * bts[t]; }
#define DN_AFRAG(arr, stride, row, kb) ({ const LAS bf16* p_ = (arr) + (row) * (stride) + 16 * (kb) + 4 * lh; const v2u lo_ = *(const LAS v2u*)p_, hi_ = *(const LAS v2u*)(p_ + 8); v4u w_; w_.x = lo_.x; w_.y = lo_.y; w_.z = hi_.x; w_.w = hi_.y; __builtin_bit_cast(bf16x8, w_); })
            f32x16 X[4];
#pragma unroll
            for (int bb = 0; bb < 4; ++bb) { const int rt = bb >> 1, odd = bb & 1;
                bf16x8 ta = DN_AFRAG(TDZ, 24, 32 * rt + lc, 0);
                if ((lc >> 4) != odd) ta = (bf16x8){0, 0, 0, 0, 0, 0, 0, 0};
                f32x16 z;
#pragma unroll
                for (int r = 0; r < 16; ++r) z[r] = 0.f;
                z = __builtin_amdgcn_mfma_f32_32x32x16_bf16(ta, pack8(acc[rt], odd), z, 0, 0, 0);
                X[bb] = z;
                const bf16x8 xb = pack8(z, odd);
                if (bb == 0) { acc[0] = __builtin_amdgcn_mfma_f32_32x32x16_bf16(DN_AFRAG(LNO, DN_ST, lc, 0), xb, acc[0], 0, 0, 0); acc[1] = __builtin_amdgcn_mfma_f32_32x32x16_bf16(DN_AFRAG(LNO, DN_ST, 32 + lc, 0), xb, acc[1], 0, 0, 0); }
                if (bb == 1) { acc[1] = __builtin_amdgcn_mfma_f32_32x32x16_bf16(DN_AFRAG(LNO, DN_ST, 32 + lc, 1), xb, acc[1], 0, 0, 0); }
                if (bb == 2) { acc[1] = __builtin_amdgcn_mfma_f32_32x32x16_bf16(DN_AFRAG(LNO, DN_ST, 32 + lc, 2), xb, acc[1], 0, 0, 0); }
            }
#undef DN_AFRAG
            LAS bf16* dst = (isw ? WT : UT) + cc * DN_ST;
#pragma unroll
            for (int bb = 0; bb < 4; ++bb)
#pragma unroll
                for (int g = 0; g < 2; ++g) { const int r0 = 8 * (bb & 1) + 4 * g; v2u o; o.x = pk2(X[bb][r0], X[bb][r0 + 1]); o.y = pk2(X[bb][r0 + 2], X[bb][r0 + 3]);
                    *(LAS v2u*)(dst + 16 * bb + 8 * g + 4 * lh) = o; }
        }
        __syncthreads();
        { bf16* MT = (bf16*)(F.ws + WS_DN_MT) + (size_t)unit * 4096; bf16* QPT = (bf16*)(F.ws + WS_DN_QPT) + (size_t)unit * 4096;
          bf16* BM = (bf16*)(F.ws + WS_DN_BM) + (size_t)unit * 4096; bf16* O0T = (bf16*)(F.ws + WS_DN_O0T) + (size_t)unit * 4096;
#pragma unroll 1
          for (int tt = 0; tt < 2; ++tt) { const int task = wave * 2 + tt, p = task >> 2, ta = (task >> 1) & 1, tb = task & 1;
              if (p == 0) {
                  f32x16 acc = dn_tile(WT, 32 * ta, KDT, 32 * tb, lc, lh);
#pragma unroll
                  for (int r = 0; r < 16; ++r) acc[r] = -acc[r];
#pragma unroll
                  for (int s2 = 0; s2 < 2; ++s2) *(bf16x8*)(MT + ((((tb * 2 + ta) * 2 + s2) * 64 + lane) * 8)) = pack8(acc, s2);
              } else if (p == 1) {
                  const f32x16 acc = dn_tile(KDT, 32 * ta, UT, 32 * tb, lc, lh);
#pragma unroll
                  for (int s2 = 0; s2 < 2; ++s2) *(bf16x8*)(BM + ((((tb * 2 + ta) * 2 + s2) * 64 + lane) * 8)) = pack8(acc, s2);
              } else if (p == 2) {
                  f32x16 acc = dn_tile(WT, 32 * ta, AQK, 32 * tb, lc, lh);
                  const int i = 32 * tb + lc; const float eg = __expf(gcs[i]);
#pragma unroll
                  for (int r = 0; r < 16; ++r) { const int a = 32 * ta + (r & 3) + 8 * (r >> 2) + 4 * lh; acc[r] = bf2f(Qs[i * DN_ST + a]) * eg - acc[r]; }
#pragma unroll
                  for (int s2 = 0; s2 < 2; ++s2) *(bf16x8*)(QPT + ((((tb * 2 + ta) * 2 + s2) * 64 + lane) * 8)) = pack8(acc, s2);
              } else {
                  const f32x16 acc = dn_tile(UT, 32 * ta, AQK, 32 * tb, lc, lh);
#pragma unroll
                  for (int s2 = 0; s2 < 2; ++s2) *(bf16x8*)(O0T + ((((tb * 2 + ta) * 2 + s2) * 64 + lane) * 8)) = pack8(acc, s2);
              } }
          if (tid == 0) ((float*)(F.ws + WS_DN_GT))[unit] = __expf(gcs[63]); }
    }
    __syncthreads();
}
template <int r>
__device__ __forceinline__ void dn_scan_wave(Frame& F) {
    const int w = F.vcu, bh = w >> 1, ct = w & 1, lane = F.lane;
    const bf16x8* MT = (const bf16x8*)(F.ws + WS_DN_MT); const bf16x8* BM = (const bf16x8*)(F.ws + WS_DN_BM); bf16x8* SS = (bf16x8*)(F.ws + WS_DN_S);
    const float* GT = (const float*)(F.ws + WS_DN_GT);
    LAS bf16x8* MB = (LAS bf16x8*)(F.lds + RING_OFF);
    volatile LAS int* FL = (volatile LAS int*)(F.lds + LDSCTL_OFF + 64);
    f32x16 S;
#pragma unroll
    for (int q = 0; q < 16; ++q) S[q] = 0.f;
    bf16x8 mA[4], bA[2], mB[4], bB[2], mC[4], bC[2], mD[4], bD[2], mE[4], bE[2], mG[4], bG[2]; float gA, gB, gC, gD, gE, gG;
#define DN_SLOAD(m, bm, gt, u) do { const size_t ub = (size_t)(u) * 512; _Pragma("unroll") for (int f = 0; f < 4; ++f) m[f] = MT[ub + (r * 4 + f) * 64 + lane]; \
        _Pragma("unroll") for (int f = 0; f < 2; ++f) bm[f] = BM[ub + ((ct * 2 + r) * 2 + f) * 64 + lane]; gt = GT[u]; } while (0)
#define DN_STEP(cm, cb, cg, unit, n) do { \
        bf16x8 own[2]; own[0] = pack8(S, 0); own[1] = pack8(S, 1); \
        LAS bf16x8* mb = MB + ((n) & 1) * 256; \
        mb[(r * 2 + 0) * 64 + lane] = own[0]; mb[(r * 2 + 1) * 64 + lane] = own[1]; \
        asm volatile("s_waitcnt lgkmcnt(0)" ::: "memory"); \
        if (lane == 0) FL[r] = (n) + 1; \
        SS[(size_t)(unit) * 512 + (ct * 4 + r * 2 + 0) * 64 + lane] = own[0]; SS[(size_t)(unit) * 512 + (ct * 4 + r * 2 + 1) * 64 + lane] = own[1]; \
        f32x16 A; \
        { const v4u b0 = __builtin_bit_cast(v4u, cb[0]), b1 = __builtin_bit_cast(v4u, cb[1]); const unsigned u0[8] = {b0.x, b0.y, b0.z, b0.w, b1.x, b1.y, b1.z, b1.w}; \
          _Pragma("unroll") for (int e = 0; e < 8; ++e) { A[2 * e] = cg * S[2 * e] + bflo(u0[e]); A[2 * e + 1] = cg * S[2 * e + 1] + bfhi(u0[e]); } } \
        while (FL[1 - r] < (n) + 1) { } \
        asm volatile("" ::: "memory"); \
        bf16x8 oth[2]; oth[0] = mb[((1 - r) * 2 + 0) * 64 + lane]; oth[1] = mb[((1 - r) * 2 + 1) * 64 + lane]; \
          \
        _Pragma("unroll") for (int s2 = 0; s2 < 2; ++s2) { A = __builtin_amdgcn_mfma_f32_32x32x16_bf16(cm[r * 2 + s2], own[s2], A, 0, 0, 0); A = __builtin_amdgcn_mfma_f32_32x32x16_bf16(cm[(1 - r) * 2 + s2], oth[s2], A, 0, 0, 0); } \
        S = A; } while (0)
    const int u0 = bh * 256;
    DN_SLOAD(mA, bA, gA, u0); DN_SLOAD(mB, bB, gB, u0 + 1); DN_SLOAD(mC, bC, gC, u0 + 2); DN_SLOAD(mD, bD, gD, u0 + 3); DN_SLOAD(mE, bE, gE, u0 + 4); DN_SLOAD(mG, bG, gG, u0 + 5);
    for (int n = 0; n < 252; n += 6) {
        DN_STEP(mA, bA, gA, u0 + n, n);         DN_SLOAD(mA, bA, gA, u0 + n + 6);
        DN_STEP(mB, bB, gB, u0 + n + 1, n + 1); DN_SLOAD(mB, bB, gB, u0 + n + 7);
        DN_STEP(mC, bC, gC, u0 + n + 2, n + 2); DN_SLOAD(mC, bC, gC, u0 + n + 8);
        DN_STEP(mD, bD, gD, u0 + n + 3, n + 3); DN_SLOAD(mD, bD, gD, u0 + n + 9);
        DN_STEP(mE, bE, gE, u0 + n + 4, n + 4); if (n + 10 < 256) DN_SLOAD(mE, bE, gE, u0 + n + 10);
        DN_STEP(mG, bG, gG, u0 + n + 5, n + 5); if (n + 11 < 256) DN_SLOAD(mG, bG, gG, u0 + n + 11);
    }
    DN_STEP(mA, bA, gA, u0 + 252, 252); DN_STEP(mB, bB, gB, u0 + 253, 253); DN_STEP(mC, bC, gC, u0 + 254, 254); DN_STEP(mD, bD, gD, u0 + 255, 255);
#undef DN_SLOAD
#undef DN_STEP
}
__device__ __forceinline__ void dn_scan(Frame& F) {
    if (F.vcu >= 32) return;
    if (F.wave == 0) dn_scan_wave<0>(F); else if (F.wave == 1) dn_scan_wave<1>(F);
}
__device__ __forceinline__ void dn_output(Frame& F) {
    const bf16x8* QPT = (const bf16x8*)(F.ws + WS_DN_QPT); const bf16x8* O0T = (const bf16x8*)(F.ws + WS_DN_O0T); const bf16x8* SS = (const bf16x8*)(F.ws + WS_DN_S);
    const bf16* PROJ = (const bf16*)(F.ws + WS_PROJ); bf16* OAB = (bf16*)(F.ws + WS_OAB);
    const int lane = F.lane, lc = lane & 31, lh = lane >> 5; int nbad = 0; (void)nbad;
    for (int task = F.vcu * NWAVES + F.wave; task < 8192; task += F.G * NWAVES) {
        const int unit = task >> 1, it = task & 1, b = unit >> 11, h = (unit >> 8) & 7, n = unit & 255;
        const size_t ub = (size_t)unit * 512;
        f32x16 o[2];
#pragma unroll
        for (int ct = 0; ct < 2; ++ct) {
            const v4u c0 = __builtin_bit_cast(v4u, O0T[ub + ((it * 2 + ct) * 2 + 0) * 64 + lane]), c1 = __builtin_bit_cast(v4u, O0T[ub + ((it * 2 + ct) * 2 + 1) * 64 + lane]);
            const unsigned u[8] = {c0.x, c0.y, c0.z, c0.w, c1.x, c1.y, c1.z, c1.w};
#pragma unroll
            for (int e = 0; e < 8; ++e) { o[ct][2 * e] = bflo(u[e]); o[ct][2 * e + 1] = bfhi(u[e]); }
#pragma unroll
            for (int at = 0; at < 2; ++at)
#pragma unroll
                for (int s2 = 0; s2 < 2; ++s2) o[ct] = __builtin_amdgcn_mfma_f32_32x32x16_bf16(SS[ub + (ct * 4 + at * 2 + s2) * 64 + lane], QPT[ub + ((it * 2 + at) * 2 + s2) * 64 + lane], o[ct], 0, 0, 0);
        }
        float ss = 0.f;
#pragma unroll
        for (int ct = 0; ct < 2; ++ct)
#pragma unroll
            for (int r = 0; r < 16; ++r) ss += o[ct][r] * o[ct][r];
        ss += __shfl_xor(ss, 32);
        const float rs = 1.0f / sqrtf(ss * (1.0f / 64.0f) + EPS);
        const size_t row = (size_t)b * SEQ + (size_t)n * 64 + it * 32 + lc;
#pragma unroll
        for (int ct = 0; ct < 2; ++ct)
#pragma unroll
            for (int rg = 0; rg < 4; ++rg) { const int c0 = 32 * ct + 8 * rg + 4 * lh;
                const v2u zz = *(const v2u*)(PROJ + row * PIN + PC_ZA + h * 64 + c0); const f32x4 ow = *(const f32x4*)(F.in[I_ONORM] + c0);
                const float z0 = bflo(zz.x), z1 = bfhi(zz.x), z2 = bflo(zz.y), z3 = bfhi(zz.y);
                v2u ov; ov.x = pk2(o[ct][4 * rg] * rs * ow[0] * silu_f(z0), o[ct][4 * rg + 1] * rs * ow[1] * silu_f(z1)); ov.y = pk2(o[ct][4 * rg + 2] * rs * ow[2] * silu_f(z2), o[ct][4 * rg + 3] * rs * ow[3] * silu_f(z3));
                *(v2u*)(OAB + row * D + h * 64 + c0) = ov;
            }
    }
}

template <int WIN>
__device__ __forceinline__ void pooled_block(const bf16* H, bf16* P, const int t0, const int tl0, const int col) {
    v4u r[WIN - 1 + 8];
#pragma unroll
    for (int j = 0; j < WIN - 1 + 8; ++j) { const int dt = j - (WIN - 1); r[j] = (v4u){0u, 0u, 0u, 0u}; if (tl0 + dt >= 0) r[j] = *(const v4u*)(H + (size_t)(t0 + dt) * D + col); }
    float s[8];
#pragma unroll
    for (int q = 0; q < 8; ++q) s[q] = 0.f;
#define POOL_ACC(sgn, VV) do { const v4u q_ = (VV); s[0] += sgn bflo(q_.x); s[1] += sgn bfhi(q_.x); s[2] += sgn bflo(q_.y); s[3] += sgn bfhi(q_.y); s[4] += sgn bflo(q_.z); s[5] += sgn bfhi(q_.z); s[6] += sgn bflo(q_.w); s[7] += sgn bfhi(q_.w); } while (0)
#pragma unroll
    for (int j = 0; j < WIN - 1; ++j) POOL_ACC(+, r[j]);
#pragma unroll
    for (int i = 0; i < 8; ++i) { const v4u self = r[WIN - 1 + i]; POOL_ACC(+, self);
        const int n = (tl0 + i + 1) < WIN ? (tl0 + i + 1) : WIN; const float inv = 1.0f / (float)n;
        v4u o; o.x = pk2(s[0] * inv - bflo(self.x), s[1] * inv - bfhi(self.x)); o.y = pk2(s[2] * inv - bflo(self.y), s[3] * inv - bfhi(self.y));
        o.z = pk2(s[4] * inv - bflo(self.z), s[5] * inv - bfhi(self.z)); o.w = pk2(s[6] * inv - bflo(self.w), s[7] * inv - bfhi(self.w));
        *(v4u*)(P + (size_t)(t0 + i) * D + col) = o;
        POOL_ACC(-, r[i]); }
#undef POOL_ACC
}
__device__ __forceinline__ void pooled_phase(Frame& F) {
    const bf16* H = (const bf16*)(F.ws + WS_H); bf16* P = (bf16*)(F.ws + WS_OAB);
    const int gt = F.vcu * 512 + F.tid, NT = F.G * 512;
    for (int it = gt; it < (NTOK / 8) * 128; it += NT) {
        const int c = it & 31, g = __builtin_amdgcn_readfirstlane((it >> 6) & 3), tb = ((it >> 8) << 1) | ((it >> 5) & 1);
        const int t0 = tb * 8, tl0 = t0 & (SEQ - 1), col = g * 256 + c * 8;
        if (g == 0) pooled_block<2>(H, P, t0, tl0, col); else if (g == 1) pooled_block<4>(H, P, t0, tl0, col); else if (g == 2) pooled_block<8>(H, P, t0, tl0, col); else pooled_block<16>(H, P, t0, tl0, col);
    }
}


#ifndef PH_MASK
#define PH_MASK 0xFFFFFF
#endif
#define IN(k) (((PH_MASK >> (k)) & 1) && lo <= (k) && (k) < hi)
#define BOTH(k) (IN(k) && IN((k) + 1))
#if MK_ONE_LAUNCH
#define GRID_BAR() xcd_barrier(bar)
#else
#define GRID_BAR() do { } while (0)
#endif
template <int LAYER>
__device__ __forceinline__ void moe_phases(Frame& F, const XcdBarrier& bar, const int lo, const int hi) {
    constexpr int pb = LAYER == 0 ? 7 : 13;
    bf16* const H = (bf16*)(F.ws + WS_H);
    const float* const MOD = (const float*)(F.ws + WS_MOD);
    if (IN(pb)) {
        moe_route(F, LAYER); if (BOTH(pb)) GRID_BAR(); }
    if (IN(pb + 1)) {
        build_moe_tables(F, LAYER);
        pg8::Gemm g{(const bf16*)H, 1024, 1024}; MoeSched S; S.init((const LAS int*)(F.lds + SCHED_OFF), F.G, (int)blockIdx.x, (const int*)(F.ws + WS_RT), F.ws + WS_WGU, 1024, 1024);
        EpiSwiglu E{(bf16*)(F.ws + WS_ACT)};
        if (LAYER == 0) moe_tail_plan(F);
        pg8::gemm_phase<EpiSwiglu, MoeSched>(F.lds + RING_OFF, g, S, E);
        if (LAYER == 0) {
            const LAS int* T = (const LAS int*)(F.lds + SCHED_OFF); const int sp = T[67];
            if (sp > 0) { __syncthreads(); const int f = T[65] * 8 * TQ_GU; int e = f + sp * 8 * TQ_GU; e = e < CQ_ND ? e : CQ_ND; convert_range(F, 1, f, e, F.wave, 8); } }
        if (BOTH(pb + 1)) GRID_BAR();
    }
    if (IN(pb + 2)) {
        build_moe_tables(F, LAYER);
        pg8::Gemm g{(const bf16*)(F.ws + WS_ACT), 512, 512}; MoeSched S; S.init((const LAS int*)(F.lds + SCHED_OFF), F.G, (int)blockIdx.x, nullptr, F.ws + (LAYER ? WS_WD1 : WS_WD), 512, 512);
        EpiStoreBf16 E{(bf16*)(F.ws + WS_Y), D};
        if (LAYER == 0) moe_tail_plan(F);
        pg8::gemm_phase<EpiStoreBf16, MoeSched>(F.lds + RING_OFF, g, S, E);
        if (LAYER == 0) {
            const LAS int* T = (const LAS int*)(F.lds + SCHED_OFF); const int sp = T[67];
            int t8 = T[66] * 8 * TQ_GU; t8 = t8 < CQ_ND ? t8 : CQ_ND;
            if (sp > 0) { __syncthreads(); const int f = t8 + T[65] * 8 * TQ_DN; int e = f + sp * 8 * TQ_DN; e = e < CQ_N ? e : CQ_N; convert_range(F, 1, f, e, F.wave, 8); } }
        if (BOTH(pb + 2)) GRID_BAR();
    }
    if (IN(pb + 3)) {
        build_moe_tables(F, LAYER);
        if (LAYER == 0) moe_tail_plan(F);
        const int tokw = F.vcu * 128 + F.wave * 16, b = (F.vcu * 128) / SEQ;
        f32x4 g2[4];
#pragma unroll
        for (int j = 0; j < 4; ++j) g2[j] = *((const f32x4*)(MOD + (size_t)(LAYER * 2 + b) * 6144 + 5 * 1024) + F.lane + 64 * j);
        if (LAYER == 0) {
            const ModVec m1 = load_mod(F.in[I_NMIX] + D, MOD + (size_t)(2 + b) * 6144 + 1024, MOD + (size_t)(2 + b) * 6144, F.lane);
            { const CombRecs recs = comb_load_recs(F, tokw); CombRows cur, nxt; comb_issue(F, recs, 0, tokw, cur);
              for (int i = 0; i < 16; ++i) { const int t = tokw + i;
                  if (i + 1 < 16) comb_issue(F, recs, i + 1, t + 1, nxt);
                  const RowVec x = comb_finish(recs, i, cur, g2);
                  store_row_bf16((bf16*)(F.ws + WS_XRB) + (size_t)t * D, F.lane, x); store_row_bf16(H + (size_t)t * D, F.lane, apply_mod(x, row_rstd(x), m1));
                  cur = nxt; } }
            __syncthreads();
            { const LAS int* T = (const LAS int*)(F.lds + SCHED_OFF);
              int t8 = T[66] * 8 * TQ_GU; t8 = t8 < CQ_ND ? t8 : CQ_ND; int t9 = t8 + T[66] * 8 * TQ_DN; t9 = t9 < CQ_N ? t9 : CQ_N;
              convert_range(F, 1, t9, CQ_N, F.vcu * NWAVES + F.wave, F.G * NWAVES); }
        } else {
            f32x4 fw[4];
#pragma unroll
            for (int j = 0; j < 4; ++j) fw[j] = *((const f32x4*)F.in[I_FNW] + F.lane + 64 * j);
            { const CombRecs recs = comb_load_recs(F, tokw); CombRows cur, nxt; comb_issue(F, recs, 0, tokw, cur);
              for (int i = 0; i < 16; ++i) { const int t = tokw + i;
                  if (i + 1 < 16) comb_issue(F, recs, i + 1, t + 1, nxt);
                  RowVec x = comb_finish(recs, i, cur, g2); const float rstd = row_rstd(x);
#pragma unroll
                  for (int j = 0; j < 4; ++j) x.v[j] = x.v[j] * rstd * fw[j];
                  store_row_f32(F.out + (size_t)t * D, F.lane, x);
                  cur = nxt; } }
        }
        if (BOTH(pb + 3)) GRID_BAR();
    }
}

constexpr int PH_P0 = 0, PH_P1 = 1, PH_INPROJ = 2, PH_ATT = 3, PH_SCAN = 4, PH_DNOUT = 5, PH_OUTPROJ = 6, PH_MOE0 = 7, PH_POOLED = 11, PH_POOLG = 12, PH_MOE1 = 13;
constexpr int N_PHASES = 17;
struct Args { const float* in[24]; float* out; unsigned char* ws; int ph_lo, ph_hi; };
__global__ void __launch_bounds__(NWAVES * 64, 2) trunk_fwd(Args args) {
    __shared__ __attribute__((aligned(16))) unsigned char lds[LDS_BYTES];
    Frame F;
    F.lds = (LAS unsigned char*)lds;
    F.MISC = (volatile LAS unsigned*)(F.lds + MISC_OFF);
    F.tid = threadIdx.x; F.lane = F.tid & 63; F.wave = __builtin_amdgcn_readfirstlane(F.tid >> 6);
    F.G = gridDim.x; { const int bx = blockIdx.x; F.vcu = (F.G % 8 == 0) ? (bx % 8) * (F.G / 8) + bx / 8 : bx; }
#pragma unroll
    for (int i = 0; i < 24; ++i) F.in[i] = args.in[i];
    F.out = args.out; F.ws = args.ws; F.ctl = (gu32*)(args.ws + WS_CTL);
    for (int u = F.tid; u < (LDS_BYTES - LDSCTL_OFF) / 4; u += NWAVES * 64) ((LAS unsigned*)(F.lds + LDSCTL_OFF))[u] = 0u;
    __syncthreads();
#if MK_ONE_LAUNCH
    XcdBarrier bar = xcd_barrier_post((unsigned*)(F.ctl + CW_BAR), F.MISC + 8);
#else
    XcdBarrier bar; bar.bar = nullptr; bar.x = 0; bar.st = nullptr;
#endif
    const int lo = args.ph_lo, hi = args.ph_hi;
    bf16* const H = (bf16*)(F.ws + WS_H);
    const float* const MOD = (const float*)(F.ws + WS_MOD);

    if (IN(PH_P0)) { p0_prologue(F); if (BOTH(PH_P0)) GRID_BAR(); }
    if (IN(PH_P1)) { p1_prenorm0(F); if (BOTH(PH_P1)) GRID_BAR(); }
    if (IN(PH_INPROJ)) {
        pg8::Gemm g{(const bf16*)H, 1024, 1024}; DenseSched S; S.init(NTOK, PIN, F.G, (int)blockIdx.x, 1024, 0, F.ws + WS_WIN, 1024);
        EpiStoreBf16 E{(bf16*)(F.ws + WS_PROJ), PIN};
        pg8::gemm_phase<EpiStoreBf16, DenseSched>(F.lds + RING_OFF, g, S, E);
        if (IP_FULL && (int)blockIdx.x >= IP_FULL) {
            __syncthreads(); const int r = (int)blockIdx.x - IP_FULL; convert_range(F, 0, r * 8 * TQ_INPROJ, (r + 1) * 8 * TQ_INPROJ, F.wave, 8); }
        if (BOTH(PH_INPROJ)) GRID_BAR();
    }
    if (IN(PH_ATT)) { dn_prep(F); if (BOTH(PH_ATT)) GRID_BAR(); }
    if (IN(PH_SCAN)) {
        if (F.vcu < 32) dn_scan(F);
        else { attn_phase(F, F.vcu - 32, F.G - 32); __syncthreads(); convert_range(F, 0, CQ_T2, CQ_N, (F.vcu - 32) * NWAVES + F.wave, (F.G - 32) * NWAVES); }
        if (BOTH(PH_SCAN)) GRID_BAR(); }
    if (IN(PH_DNOUT)) { dn_output(F); if (BOTH(PH_DNOUT)) GRID_BAR(); }
    if (IN(PH_OUTPROJ)) {
        pg8::Gemm g{(const bf16*)(F.ws + WS_OAB), 1024, 1024}; DenseSched S; S.init(NTOK, D, F.G, (int)blockIdx.x, 1024, 0, F.ws + WS_WOUT, 1024);
        EpiResid<true> E{F.in[I_X], (bf16*)(F.ws + WS_XRB), MOD + 2 * 1024, nullptr};
        pg8::gemm_phase<EpiResid<true>, DenseSched>(F.lds + RING_OFF, g, S, E);
        if (BOTH(PH_OUTPROJ)) GRID_BAR();
    }
    moe_phases<0>(F, bar, lo, hi);
    if (IN(PH_POOLED)) { pooled_phase(F); if (BOTH(PH_POOLED)) GRID_BAR(); }
    if (IN(PH_POOLG)) {
        pg8::Gemm g{(const bf16*)(F.ws + WS_OAB), 256, 256}; DenseSched S; S.init(NTOK, D, F.G, (int)blockIdx.x, 1024, 256, F.ws + WS_POOLW, 256);
        EpiResid<false> E{nullptr, (bf16*)(F.ws + WS_XRB), MOD + (size_t)2 * 6144 + 2 * 1024, F.in[I_POOLS]};
        pg8::gemm_phase<EpiResid<false>, DenseSched>(F.lds + RING_OFF, g, S, E);
        if (BOTH(PH_POOLG)) GRID_BAR();
    }
    moe_phases<1>(F, bar, lo, hi);
#undef IN
#undef BOTH
}

extern "C" void kernel_launch(void* const* d_in, const int* in_sizes, int n_in, void* d_out, int out_size, void* d_ws, size_t ws_size, hipStream_t stream) {
    static int grid = 0;
    if (grid == 0) {
        if (n_in != 24 || in_sizes[0] != NTOK * D || out_size != NTOK * D || ws_size < WS_END2) { fprintf(stderr, "kernel_launch: unexpected shapes (n_in %d, in0 %d, out %d, ws %zu); nothing launched\n", n_in, n_in > 0 ? in_sizes[0] : -1, out_size, ws_size); grid = -1; return; }
        int per_cu = 0;
        if (hipOccupancyMaxActiveBlocksPerMultiprocessor(&per_cu, (const void*)trunk_fwd, NWAVES * 64, 0) != hipSuccess || per_cu < 1) fprintf(stderr, "kernel_launch: occupancy query says %d\n", per_cu);
        (void)hipGetLastError();
        grid = 256;
    }
    if (grid < 0) return;
    if (hipMemsetAsync((char*)d_ws + WS_CTL, 0, CTL_ZERO_BYTES, stream) != hipSuccess) { fprintf(stderr, "kernel_launch: memset failed\n"); return; }
    Args a{};
    for (int i = 0; i < 24; ++i) a.in[i] = (const float*)d_in[i];
    a.out = (float*)d_out; a.ws = (unsigned char*)d_ws;
#if MK_ONE_LAUNCH
    a.ph_lo = 0; a.ph_hi = N_PHASES;
    hipLaunchKernelGGL(trunk_fwd, dim3(grid), dim3(NWAVES * 64), 0, stream, a);
#else
    for (int p = 0; p < N_PHASES; ++p) { a.ph_lo = p; a.ph_hi = p + 1; hipLaunchKernelGGL(trunk_fwd, dim3(grid), dim3(NWAVES * 64), 0, stream, a); }
#endif
}
```

```cpp
#include <hip/hip_runtime.h>
#include <cstdio>
#include <cstdint>

#ifndef MK_ONE_LAUNCH
#define MK_ONE_LAUNCH 1
#endif

#define GAS __attribute__((address_space(1)))
#define LAS __attribute__((address_space(3)))
typedef unsigned short bf16;
typedef unsigned v4u __attribute__((ext_vector_type(4)));
typedef unsigned v2u __attribute__((ext_vector_type(2)));
typedef float f32x4 __attribute__((ext_vector_type(4)));
typedef float f32x2 __attribute__((ext_vector_type(2)));
typedef float f32x16 __attribute__((ext_vector_type(16)));
typedef short bf16x8 __attribute__((ext_vector_type(8)));
typedef GAS unsigned gu32;
#define RLX_AGENT __ATOMIC_RELAXED, __HIP_MEMORY_SCOPE_AGENT
#define LDS_WAIT() asm volatile("s_waitcnt lgkmcnt(0)" ::: "memory")
#define VM_WAIT() asm volatile("s_waitcnt vmcnt(0)" ::: "memory")

constexpr int BATCH = 2, SEQ = 16384, D = 1024, NTOK = BATCH * SEQ;
constexpr int PIN = 2816;
constexpr int PC_QA = 0, PC_KA = 512, PC_VA = 1024, PC_ZA = 1536, PC_QB = 2048, PC_KB = 2560, PC_VB = 2688;
constexpr int NEXP = 32, DFF = 512;
constexpr int MAXTILES = NTOK * 2 / 256 + NEXP;
constexpr float EPS = 1e-6f;
constexpr int NWAVES = 8;

constexpr size_t MiB = 1u << 20;
constexpr size_t WS_CTL = 0, CTL_ZERO_BYTES = 1 * MiB;
constexpr size_t WS_MOD = 1 * MiB;
constexpr size_t WS_WBA = 1 * MiB + 128 * 1024;
constexpr size_t WS_ROUTE = 2 * MiB;
constexpr size_t WS_RT = 3 * MiB;
constexpr size_t WS_BG = 7 * MiB;
constexpr size_t WS_WIN = 10 * MiB;
constexpr size_t WS_WOUT = 16 * MiB;
constexpr size_t WS_POOLW = 18 * MiB;
constexpr size_t WS_WGU = 20 * MiB;
constexpr size_t WS_WD = 84 * MiB;
constexpr size_t WS_H = 116 * MiB;
constexpr size_t WS_PROJ = 180 * MiB;
constexpr size_t WS_OAB = 356 * MiB;
constexpr size_t WS_YM = 180 * MiB;
constexpr size_t WS_ACT = 180 * MiB;
constexpr size_t WS_Y = 252 * MiB;
constexpr size_t WS_END = 420 * MiB;
constexpr size_t WS_DN_MT = WS_H;
constexpr size_t WS_DN_QPT = WS_H + 32 * MiB;
constexpr size_t WS_DN_BM = 420 * MiB, WS_DN_O0T = 452 * MiB, WS_DN_S = 484 * MiB;
constexpr size_t WS_DN_GT = 9 * MiB;
constexpr size_t WS_XRB = 420 * MiB;
constexpr size_t WS_WD1 = 484 * MiB;
constexpr size_t WS_END2 = 516 * MiB;
constexpr int CW_CNT = 64;
constexpr int CW_BAR = 4096;
constexpr int CW_BAD = 200;

constexpr int RING_OFF = 0, RING_BYTES = 131072;
constexpr int LDSCTL_OFF = RING_BYTES, MISC_OFF = LDSCTL_OFF + 320;
constexpr int SCHED_OFF = LDSCTL_OFF + 1024;
constexpr int LDS_BYTES = 163840;
constexpr int R1W_OFF = 135168;
constexpr int RT_LDS_OFF = 151552;

typedef __bf16 bf16x2_t __attribute__((ext_vector_type(2)));
__device__ __forceinline__ unsigned pk2(float lo, float hi) { bf16x2_t v; v.x = (__bf16)lo; v.y = (__bf16)hi; return __builtin_bit_cast(unsigned, v); }
__device__ __forceinline__ unsigned f2bf(float f) { return pk2(f, 0.f) & 0xffffu; }
__device__ __forceinline__ float bf2f(unsigned b) { return __builtin_bit_cast(float, b << 16); }
__device__ __forceinline__ float bflo(unsigned w) { return __builtin_bit_cast(float, w << 16); }
__device__ __forceinline__ float bfhi(unsigned w) { return __builtin_bit_cast(float, w & 0xffff0000u); }
template <int CTRL> __device__ __forceinline__ float dpp_f(float v) { return __builtin_bit_cast(float, __builtin_amdgcn_update_dpp(0, __builtin_bit_cast(int, v), CTRL, 0xf, 0xf, false)); }
__device__ __forceinline__ float quad_sum(float v) { v += dpp_f<0xB1>(v); v += dpp_f<0x4E>(v); return v; }
__device__ __forceinline__ float oct_sum(float v) { v = quad_sum(v); v += dpp_f<0x141>(v); return v; }
__device__ __forceinline__ float wave_sum(float v) {
    v = oct_sum(v); v += dpp_f<0x140>(v);
    const float r0 = __builtin_bit_cast(float, __builtin_amdgcn_readlane(__builtin_bit_cast(int, v), 0)), r1 = __builtin_bit_cast(float, __builtin_amdgcn_readlane(__builtin_bit_cast(int, v), 16));
    const float r2 = __builtin_bit_cast(float, __builtin_amdgcn_readlane(__builtin_bit_cast(int, v), 32)), r3 = __builtin_bit_cast(float, __builtin_amdgcn_readlane(__builtin_bit_cast(int, v), 48));
    return (r0 + r1) + (r2 + r3);
}
__device__ __forceinline__ float rl(float x, int l) { return __builtin_bit_cast(float, __builtin_amdgcn_readlane(__builtin_bit_cast(int, x), l)); }
__device__ __forceinline__ float silu_f(float x) { return x / (1.f + __expf(-x)); }
__device__ __forceinline__ float sigmoid_f(float x) { return 1.f / (1.f + __expf(-x)); }
__device__ __forceinline__ float softplus_f(float x) { return x > 20.f ? x : log1pf(__expf(x)); }

namespace pg8 {
#define PG8_LAS __attribute__((address_space(3)))
typedef unsigned short bf16_t;
typedef unsigned u32x4 __attribute__((ext_vector_type(4)));
constexpr int BM = 256, BK = 64, HALF = 128, HTB = HALF * BK * 2, STAGE_BYTES = 8 * HTB;

__host__ __device__ __forceinline__ int lds_byte(int r, int c) { const int st = (r >> 4) * 2 + (c >> 5), rr = r & 15, cc = c & 31, ob = rr * 64 + cc * 2; return st * 1024 + (ob ^ (((ob >> 9) & 1) << 5)); }
__host__ __device__ __forceinline__ void stage_rc(int b, int& R, int& C) { const int st = b / 1024, sb = b % 1024, swz = sb ^ (((sb >> 9) & 1) << 5); R = (st >> 1) * 16 + swz / 64; C = (st & 1) * 32 + (swz % 64) / 2; }
__host__ __device__ __forceinline__ int perm32(int rho) { const int n = rho >> 4, i = rho & 15; return 8 * (i >> 2) + 4 * n + (i & 3); }

struct Unit { int pm, pn, e; };
struct Gemm { const bf16_t* A; int K, ldb; };

template <class Epi, class Sched>
__device__ __forceinline__ void gemm_phase(PG8_LAS unsigned char* lds, const Gemm g, const Sched& S, const Epi& E) {
    const int tid = threadIdx.x, wid = __builtin_amdgcn_readfirstlane(tid >> 6), lane = tid & 63, wr = wid >> 2, wc = wid & 3, fr = lane & 15, fq = lane >> 4;
    const int K = g.K, nt = K / BK;
    int R0, C0, R1, C1; stage_rc(tid * 16, R0, C0); stage_rc(tid * 16 + 8192, R1, C1);
    const int Rb0 = (R0 & ~31) + perm32(R0 & 31), Rb1 = (R1 & ~31) + perm32(R1 & 31);
    const unsigned voffB0 = (unsigned)(Rb0 * g.ldb + C0) * 2u, voffB1 = (unsigned)(Rb1 * g.ldb + C1) * 2u;
    const size_t kstep = (size_t)(BK * 2);
    const size_t hstepB = (size_t)HALF * g.ldb * 2;
    const unsigned ldsw = (unsigned)wid * 1024u;
    const int aoff = lds_byte(wr * 64 + fr, fq * 8), boff = lds_byte(wc * 32 + fr, fq * 8);
    const char* Ab = (const char*)g.A;
#define PG8_SA(b, h) (((b) * 2 + (h)) * HTB)
#define PG8_SB(b, h) ((4 + (b) * 2 + (h)) * HTB)
#define PG8_ST2(bufoff, gbase, v0, v1) do { \
        __builtin_amdgcn_global_load_lds((const unsigned*)((const char*)(gbase) + (v0)), (PG8_LAS unsigned*)(lds + (bufoff) + ldsw), 16, 0, 0); \
        __builtin_amdgcn_global_load_lds((const unsigned*)((const char*)(gbase) + (v1)), (PG8_LAS unsigned*)(lds + (bufoff) + ldsw + 8192), 16, 0, 0); } while (0)
#define PG8_STB(bufoff, gbase) PG8_ST2(bufoff, gbase, voffB0, voffB1)
#define PG8_LDA(dst, b, h) do { _Pragma("unroll") for (int m = 0; m < 4; ++m) _Pragma("unroll") for (int k = 0; k < 2; ++k) dst[m][k] = *(const PG8_LAS bf16x8*)(lds + PG8_SA(b, h) + aoff + m * 2048 + k * 1024); } while (0)
#define PG8_LDB(dst, b, h) do { _Pragma("unroll") for (int n = 0; n < 2; ++n) _Pragma("unroll") for (int k = 0; k < 2; ++k) dst[n][k] = *(const PG8_LAS bf16x8*)(lds + PG8_SB(b, h) + boff + n * 2048 + k * 1024); } while (0)
#define PG8_MMA(ai, bj, At, Bt) do { __builtin_amdgcn_s_setprio(1); _Pragma("unroll") for (int m = 0; m < 4; ++m) _Pragma("unroll") for (int n = 0; n < 2; ++n) _Pragma("unroll") for (int k = 0; k < 2; ++k) \
        acc[ai][bj][m][n] = __builtin_amdgcn_mfma_f32_16x16x32_bf16(Bt[n][k], At[m][k], acc[ai][bj][m][n], 0, 0, 0); __builtin_amdgcn_s_setprio(0); } while (0)
#define PG8_WAIT_V(n) asm volatile("s_waitcnt vmcnt(" #n ")" ::: "memory")
#define PG8_WAIT_L(n) asm volatile("s_waitcnt lgkmcnt(" #n ")" ::: "memory")
#define PG8_BAR __builtin_amdgcn_s_barrier()
#define PG8_SCHED __builtin_amdgcn_sched_barrier(0)
    Unit cur, nxt; int ui = 0;
    if (!S.next(0, cur)) return;
    f32x4 acc[2][2][4][2];
#pragma unroll
    for (int a = 0; a < 2; ++a)
#pragma unroll
        for (int b = 0; b < 2; ++b)
#pragma unroll
            for (int m = 0; m < 4; ++m)
#pragma unroll
                for (int n = 0; n < 2; ++n) acc[a][b][m][n] = (f32x4){0.f, 0.f, 0.f, 0.f};
    bf16x8 At[4][2], B0[2][2], B1[2][2];
    unsigned c00, c01, c10, c11;
#define PG8_AOFF(u, d00, d01, d10, d11) do { \
        d00 = S.a_off(u, R0) + (unsigned)C0 * 2u; d01 = S.a_off(u, R1) + (unsigned)C1 * 2u; \
        d10 = S.a_off(u, HALF + R0) + (unsigned)C0 * 2u; d11 = S.a_off(u, HALF + R1) + (unsigned)C1 * 2u; } while (0)
    PG8_AOFF(cur, c00, c01, c10, c11);
    const char* cB = S.b_ptr(cur);
    PG8_STB(PG8_SB(0, 0), cB); PG8_STB(PG8_SB(0, 1), cB + hstepB); PG8_ST2(PG8_SA(0, 0), Ab, c00, c01); PG8_ST2(PG8_SA(0, 1), Ab, c10, c11);
    if (wr == 1) PG8_BAR;
    PG8_WAIT_V(2); PG8_BAR;
    PG8_STB(PG8_SB(1, 0), cB + kstep); PG8_ST2(PG8_SA(1, 0), Ab + kstep, c00, c01); PG8_STB(PG8_SB(1, 1), cB + hstepB + kstep);
    PG8_WAIT_V(6); PG8_BAR;
    for (;;) {
        const bool has_next = S.next(ui + 1, nxt);
        const char* nB = has_next ? S.b_ptr(nxt) : cB;
#pragma unroll 1
        for (int t = 0; t < nt; t += 2) {
            const bool last = (t == nt - 2);
            const char* a1 = Ab + (size_t)(t + 1) * kstep;
            const char* a2 = last ? Ab : Ab + (size_t)(t + 2) * kstep; const char* b2 = last ? nB : cB + (size_t)(t + 2) * kstep;
            const char* a3 = a2 + kstep; const char* b3 = b2 + kstep;
            PG8_LDB(B0, 0, 0); PG8_LDB(B1, 0, 1); PG8_SCHED; PG8_LDA(At, 0, 0); PG8_ST2(PG8_SA(1, 1), a1, c10, c11);
            PG8_WAIT_V(8); PG8_WAIT_L(0); PG8_BAR; PG8_MMA(0, 0, At, B0); PG8_MMA(0, 1, At, B1); PG8_BAR; PG8_SCHED;
            if (last && has_next) { PG8_AOFF(nxt, c00, c01, c10, c11); }
            PG8_LDA(At, 0, 1); PG8_STB(PG8_SB(0, 0), b2); PG8_STB(PG8_SB(0, 1), b2 + hstepB); PG8_ST2(PG8_SA(0, 0), a2, c00, c01);
            PG8_WAIT_V(8); PG8_WAIT_L(0); PG8_BAR; PG8_MMA(1, 0, At, B0); PG8_MMA(1, 1, At, B1); PG8_BAR; PG8_SCHED;
            PG8_LDB(B0, 1, 0); PG8_LDB(B1, 1, 1); PG8_SCHED; PG8_LDA(At, 1, 0); PG8_ST2(PG8_SA(0, 1), a2, c10, c11);
            PG8_WAIT_V(8); PG8_WAIT_L(0); PG8_BAR; PG8_MMA(0, 0, At, B0); PG8_MMA(0, 1, At, B1); PG8_BAR; PG8_SCHED;
            PG8_LDA(At, 1, 1); PG8_STB(PG8_SB(1, 0), b3); PG8_STB(PG8_SB(1, 1), b3 + hstepB); PG8_ST2(PG8_SA(1, 0), a3, c00, c01);
            PG8_WAIT_V(8); PG8_WAIT_L(0); PG8_BAR; PG8_MMA(1, 0, At, B0); PG8_MMA(1, 1, At, B1); PG8_BAR; PG8_SCHED;
        }
        if (wr == 0) PG8_BAR;
        E(acc, cur, wr, wc, fr, fq);
        if (!has_next) break;
#pragma unroll
        for (int a = 0; a < 2; ++a)
#pragma unroll
            for (int b = 0; b < 2; ++b)
#pragma unroll
                for (int m = 0; m < 4; ++m)
#pragma unroll
                    for (int n = 0; n < 2; ++n) acc[a][b][m][n] = (f32x4){0.f, 0.f, 0.f, 0.f};
        cur = nxt; cB = nB; ++ui;
        if (wr == 1) PG8_BAR;
    }
    PG8_WAIT_V(0);
    PG8_BAR;
#undef PG8_SA
#undef PG8_SB
#undef PG8_ST2
#undef PG8_STB
#undef PG8_LDA
#undef PG8_LDB
#undef PG8_MMA
#undef PG8_WAIT_V
#undef PG8_WAIT_L
#undef PG8_BAR
#undef PG8_SCHED
#undef PG8_AOFF
}
}

#define XB_TMO      128
#define XB_XCNT(j)  (256  + 64 * (j))
#define XB_XSUB(j)  (1280 + 64 * (j))
#define XB_XGEN(j)  (2304 + 64 * (j))
#define XB_TOP      3328
#define XB_TOPGEN   3392
#define XCD_BAR_WORDS 3456
#define XB_SPIN_CAP (1u << 22)

__device__ __forceinline__ unsigned xb_ld(unsigned* p)              { return __hip_atomic_load(p, __ATOMIC_RELAXED, __HIP_MEMORY_SCOPE_AGENT); }
__device__ __forceinline__ unsigned xb_add(unsigned* p, unsigned v) { return __hip_atomic_fetch_add(p, v, __ATOMIC_RELAXED, __HIP_MEMORY_SCOPE_AGENT); }
__device__ __forceinline__ unsigned xb_xcc_id() { return (unsigned)__builtin_amdgcn_s_getreg((3 << 11) | 20) & 0xFu; }
#define XB_SPIN(cond, bar) do { unsigned _sp = 0; while (cond) { __builtin_amdgcn_s_sleep(1); \
    if ((++_sp & 255u) == 0u) { if (xb_ld(&(bar)[XB_TMO])) break; if (_sp > XB_SPIN_CAP) { atomicAdd(&(bar)[XB_TMO], 1u); break; } } } } while (0)

struct XcdBarrier { unsigned* bar; unsigned x; volatile LAS unsigned* st; };

__device__ __forceinline__ XcdBarrier xcd_barrier_post(unsigned* bar, volatile LAS unsigned* st) {
    XcdBarrier b; b.bar = bar; b.x = xb_xcc_id(); b.st = st;
    if (threadIdx.x == 0) (void)xb_add(&bar[XB_XCNT(b.x)], 1u);
    return b;
}
__device__ __forceinline__ void xcd_barrier_complete(unsigned* bar, unsigned x, unsigned& nloc, unsigned& nx) {
    const unsigned G = gridDim.x * gridDim.y * gridDim.z;
    unsigned sum, cnt, mine, sp = 0u;
    for (;;) {
        sum = 0u; cnt = 0u; mine = 0u;
#pragma unroll
        for (unsigned j = 0; j < 16; ++j) { const unsigned c = xb_ld(&bar[XB_XCNT(j)]); sum += c; cnt += (c > 0u) ? 1u : 0u; mine = (j == x) ? c : mine; }
        if (sum == G) break;
        __builtin_amdgcn_s_sleep(1);
        if ((++sp & 255u) == 0u) { if (xb_ld(&bar[XB_TMO])) break; if (sp > XB_SPIN_CAP) { atomicAdd(&bar[XB_TMO], 1u); break; } }
    }
    nloc = mine > 0u ? mine : 1u; nx = cnt > 0u ? cnt : 1u;
}
__device__ __forceinline__ void xcd_barrier(const XcdBarrier& b) {
    asm volatile("s_waitcnt vmcnt(0)" ::: "memory");
    __syncthreads();
    if (threadIdx.x == 0) {
        unsigned* bar = b.bar;
        __builtin_amdgcn_s_waitcnt(0);
        unsigned nloc = b.st[0], nx = b.st[1];
        if (nloc == 0u) { xcd_barrier_complete(bar, b.x, nloc, nx); b.st[0] = nloc; b.st[1] = nx; }
        const unsigned old = xb_add(&bar[XB_XSUB(b.x)], 1u);
        const unsigned gen = old / nloc;
        if (old + 1u == (gen + 1u) * nloc) {
            __builtin_amdgcn_fence(__ATOMIC_RELEASE, "agent");
            asm volatile("s_waitcnt vmcnt(0)" ::: "memory");
            const unsigned og = xb_add(&bar[XB_TOP], 1u);
            const unsigned tg = og / nx;
            if (og + 1u == (tg + 1u) * nx) xb_add(&bar[XB_TOPGEN], 1u);
            else XB_SPIN(xb_ld(&bar[XB_TOPGEN]) == tg, bar);
            __builtin_amdgcn_fence(__ATOMIC_ACQUIRE, "agent");
            xb_add(&bar[XB_XGEN(b.x)], 1u);
            asm volatile("s_waitcnt vmcnt(0)" ::: "memory");
        } else {
            XB_SPIN(xb_ld(&bar[XB_XGEN(b.x)]) == gen, bar);
            __builtin_amdgcn_fence(__ATOMIC_ACQUIRE, "agent");
            asm volatile("s_waitcnt vmcnt(0)" ::: "memory");
        }
    }
    __syncthreads();
}

struct Frame {
    LAS unsigned char* lds;
    volatile LAS unsigned* MISC;
    gu32* ctl;
    int tid, lane, wave, vcu, G;
    const float* in[24];
    float* out;
    unsigned char* ws;
};
enum { I_X = 0, I_C, I_ADAW, I_ADAB, I_NMIX, I_NFFN, I_WIN, I_CONVW, I_ALOG, I_DTB, I_ONORM, I_SINKS, I_RELB, I_WOUT, I_POOLW, I_POOLS, I_R1W, I_R1B, I_R2W, I_R2B, I_WG, I_WU, I_WDN, I_FNW };

__device__ __forceinline__ void p0_transpose_item(const float* W, int ldw, int K, bf16* WT, int dst_row0, LAS float* scr, int k0, int n0, int lane) {
    f32x4 w4[8];
#pragma unroll
    for (int i = 0; i < 8; ++i) { const int f = i * 64 + lane, kk = f >> 3, c4 = f & 7; w4[i] = __builtin_nontemporal_load((const f32x4*)(W + (size_t)(k0 + kk) * ldw + n0 + c4 * 4)); }
#pragma unroll
    for (int i = 0; i < 8; ++i) { const int f = i * 64 + lane, kk = f >> 3, c4 = f & 7; LAS float* d = scr + kk * 33 + c4 * 4; d[0] = w4[i].x; d[1] = w4[i].y; d[2] = w4[i].z; d[3] = w4[i].w; }
    LDS_WAIT(); asm volatile("" ::: "memory");
    const int c = lane & 7;
#pragma unroll
    for (int j = 0; j < 4; ++j) { const int n = (lane >> 3) + 8 * j; const LAS float* s = scr + (8 * c) * 33 + n;
        v4u o; o.x = pk2(s[0 * 33], s[1 * 33]); o.y = pk2(s[2 * 33], s[3 * 33]); o.z = pk2(s[4 * 33], s[5 * 33]); o.w = pk2(s[6 * 33], s[7 * 33]);
        __builtin_nontemporal_store(o, (GAS v4u*)(WT + (size_t)(dst_row0 + n) * K + k0 + 8 * c)); }
    LDS_WAIT(); asm volatile("" ::: "memory");
}
constexpr int CQ_ND = NEXP * 256, CQ_N = NEXP * 768;
constexpr int TQ_INPROJ = 9, TQ_GU = 6, TQ_DN = 4;
constexpr int IP_FULL = ((NTOK / 256) * (PIN / 256)) % 256;
constexpr int CQ_T2 = IP_FULL ? (256 - IP_FULL) * 8 * TQ_INPROJ : 0;
__device__ __forceinline__ void convert_item(Frame& F, int layer, int it, LAS float* scr) {
    if (it < CQ_ND) {
        const int e = it >> 8, q = it & 255, kb = q >> 5, nb = q & 31;
        const float* W = F.in[I_WDN] + (size_t)(layer * NEXP + e) * 512 * 1024;
        p0_transpose_item(W, 1024, 512, (bf16*)(F.ws + (layer ? WS_WD1 : WS_WD)), e * 1024 + nb * 32, scr, kb * 64, nb * 32, F.lane);
    } else {
        const int r0 = it - CQ_ND, e = r0 >> 9, r = r0 & 511, up = r >> 8, q = r & 255, kb = q >> 4, nb = q & 15;
        const float* W = (up ? F.in[I_WU] : F.in[I_WG]) + (size_t)(layer * NEXP + e) * 1024 * 512;
        p0_transpose_item(W, 512, 1024, (bf16*)(F.ws + WS_WGU), e * 1024 + (nb >> 2) * 256 + up * 128 + (nb & 3) * 32, scr, kb * 64, nb * 32, F.lane);
    }
}
__device__ __forceinline__ void convert_range(Frame& F, int layer, int first, int end, int start, int stride) {
    LAS float* scr = (LAS float*)(F.lds + RING_OFF + F.wave * 16384);
    for (int it = first + start; it < end; it += stride) convert_item(F, layer, it, scr);
}
__device__ __forceinline__ void p0_prologue(Frame& F) {
    LAS float* scr = (LAS float*)(F.lds + RING_OFF + F.wave * 16384);
    const int gw = F.vcu * NWAVES + F.wave, NGW = F.G * NWAVES;
    constexpr int IA = 16 * 64, IB = 16 * 24, IO = 16 * 32, IP = 4 * 32, NIT = IA + IB + IO + IP;
    for (int it = gw; it < NIT; it += NGW) {
        int r = it;
        if (r < IA) { p0_transpose_item(F.in[I_WIN], 2832, 1024, (bf16*)(F.ws + WS_WIN), (r % 64) * 32, scr, (r / 64) * 64, (r % 64) * 32, F.lane); continue; } r -= IA;
        if (r < IB) { p0_transpose_item(F.in[I_WIN] + 2064, 2832, 1024, (bf16*)(F.ws + WS_WIN), 2048 + (r % 24) * 32, scr, (r / 24) * 64, (r % 24) * 32, F.lane); continue; } r -= IB;
        if (r < IO) { p0_transpose_item(F.in[I_WOUT], 1024, 1024, (bf16*)(F.ws + WS_WOUT), (r % 32) * 32, scr, (r / 32) * 64, (r % 32) * 32, F.lane); continue; } r -= IO;
        { const int g = r >> 5, q = r & 31; p0_transpose_item(F.in[I_POOLW] + (size_t)g * 65536, 256, 256, (bf16*)(F.ws + WS_POOLW) + (size_t)g * 65536, (q & 7) * 32, scr, (q >> 3) * 64, (q & 7) * 32, F.lane); }
    }
    { float* WBA = (float*)(F.ws + WS_WBA); const int gt = F.vcu * 512 + F.tid;
      if (gt < 16 * 1024) { const int o = gt >> 10, k = gt & 1023; WBA[o * 1024 + k] = F.in[I_WIN][(size_t)k * 2832 + 2048 + o]; } }
    __syncthreads();
    {
        LAS float* red = (LAS float*)(F.lds + RING_OFF);
        const int ks = F.tid >> 4, cj = F.tid & 15;
        for (int u = F.vcu; u < 192; u += F.G) {
            const int l = u / 96, cb = u % 96;
            const float* W = F.in[I_ADAW] + (size_t)l * 1024 * 6144 + cb * 64 + cj * 4;
            f32x4 a0 = {0.f, 0.f, 0.f, 0.f}, a1 = {0.f, 0.f, 0.f, 0.f};
            for (int k = ks * 32; k < ks * 32 + 32; ++k) {
                const f32x4 w = *(const f32x4*)(W + (size_t)k * 6144);
                const float c0 = silu_f(F.in[I_C][k]), c1 = silu_f(F.in[I_C][1024 + k]);
                a0 += w * c0; a1 += w * c1;
            }
            *(LAS f32x4*)(red + (ks * 2 + 0) * 64 + cj * 4) = a0; *(LAS f32x4*)(red + (ks * 2 + 1) * 64 + cj * 4) = a1;
            __syncthreads();
            if (F.tid < 128) { const int b = F.tid >> 6, c = F.tid & 63; float s = 0.f;
                for (int q = 0; q < 32; ++q) s += red[(q * 2 + b) * 64 + c];
                ((float*)(F.ws + WS_MOD))[(size_t)(l * 2 + b) * 6144 + cb * 64 + c] = s + F.in[I_ADAB][l * 6144 + cb * 64 + c]; }
            __syncthreads();
        }
    }
}

struct RowVec { f32x4 v[4]; };
__device__ __forceinline__ RowVec load_row_f32(const float* row, int lane) { RowVec r; const GAS f32x4* p = (const GAS f32x4*)row + lane;
#pragma unroll
    for (int j = 0; j < 4; ++j) r.v[j] = p[64 * j]; return r; }
__device__ __forceinline__ void store_row_f32(float* row, int lane, const RowVec& r) { GAS f32x4* p = (GAS f32x4*)row + lane;
#pragma unroll
    for (int j = 0; j < 4; ++j) p[64 * j] = r.v[j]; }
__device__ __forceinline__ void store_row_bf16(bf16* row, int lane, const RowVec& r) { GAS v2u* p = (GAS v2u*)row + lane;
#pragma unroll
    for (int j = 0; j < 4; ++j) { v2u o; o.x = pk2(r.v[j].x, r.v[j].y); o.y = pk2(r.v[j].z, r.v[j].w); p[64 * j] = o; } }
__device__ __forceinline__ void load_row_bf16(const bf16* row, int lane, v2u (&p)[4]) { const GAS v2u* q = (const GAS v2u*)row + lane;
#pragma unroll
    for (int j = 0; j < 4; ++j) p[j] = q[64 * j]; }
__device__ __forceinline__ RowVec unpack_row_bf16(const v2u (&p)[4]) { RowVec r;
#pragma unroll
    for (int j = 0; j < 4; ++j) { r.v[j].x = bflo(p[j].x); r.v[j].y = bfhi(p[j].x); r.v[j].z = bflo(p[j].y); r.v[j].w = bfhi(p[j].y); } return r; }
__device__ __forceinline__ float row_rstd(const RowVec& r) { float s = 0.f;
#pragma unroll
    for (int j = 0; j < 4; ++j) s += (r.v[j].x * r.v[j].x + r.v[j].y * r.v[j].y) + (r.v[j].z * r.v[j].z + r.v[j].w * r.v[j].w);
    return 1.0f / sqrtf(wave_sum(s) * (1.f / D) + EPS); }
struct ModVec { f32x4 a[4], b[4]; };
__device__ __forceinline__ ModVec load_mod(const float* w, const float* sc, const float* sh, int lane) { ModVec m;
#pragma unroll
    for (int j = 0; j < 4; ++j) { const f32x4 wv = *((const f32x4*)w + lane + 64 * j), s = *((const f32x4*)sc + lane + 64 * j); m.a[j] = wv * (s + 1.0f); m.b[j] = *((const f32x4*)sh + lane + 64 * j); }
    return m; }
__device__ __forceinline__ RowVec apply_mod(const RowVec& x, float rstd, const ModVec& m) { RowVec h;
#pragma unroll
    for (int j = 0; j < 4; ++j) h.v[j] = x.v[j] * rstd * m.a[j] + m.b[j]; return h; }

__device__ __forceinline__ void p1_prenorm0(Frame& F) {
    LAS float* wba = (LAS float*)(F.lds + RING_OFF);
    { const float* WBA = (const float*)(F.ws + WS_WBA); for (int i = F.tid; i < 16 * 256; i += 512) *((LAS f32x4*)wba + i) = *((const f32x4*)WBA + i); }
    __syncthreads();
    const float* mod = (const float*)(F.ws + WS_MOD);
    bf16* H = (bf16*)(F.ws + WS_H); float* BG = (float*)(F.ws + WS_BG);
    const int tok0 = F.vcu * (NTOK / F.G) + F.wave * (NTOK / F.G / NWAVES), ntw = NTOK / F.G / NWAVES;
    const int b = tok0 / SEQ;
    const ModVec m = load_mod(F.in[I_NMIX], mod + (size_t)b * 6144 + 1024, mod + (size_t)b * 6144, F.lane);
    const int hh = F.lane & 7;
    const float nega = -__expf(F.in[I_ALOG][hh]), dtb = F.in[I_DTB][hh];
    RowVec xn = load_row_f32(F.in[I_X] + (size_t)tok0 * D, F.lane);
    for (int i = 0; i < ntw; ++i) {
        const int t = tok0 + i;
        const RowVec x = xn;
        if (i + 1 < ntw) xn = load_row_f32(F.in[I_X] + (size_t)(t + 1) * D, F.lane);
        const RowVec h = apply_mod(x, row_rstd(x), m);
        store_row_bf16(H + (size_t)t * D, F.lane, h);
        float mine = 0.f;
#pragma unroll 2
        for (int o = 0; o < 16; ++o) { float s = 0.f;
#pragma unroll
            for (int j = 0; j < 4; ++j) { const f32x4 w = *((const LAS f32x4*)(wba + o * 1024) + F.lane + 64 * j); s += (h.v[j].x * w.x + h.v[j].y * w.y) + (h.v[j].z * w.z + h.v[j].w * w.w); }
            s = wave_sum(s); if (F.lane == o) mine = s; }
        if (F.lane < 8) BG[(size_t)t * 16 + F.lane] = sigmoid_f(mine);
        else if (F.lane < 16) BG[(size_t)t * 16 + F.lane] = nega * softplus_f(mine + dtb);
    }
}

struct DenseSched {
    int nM, nN, nwg, G, c; unsigned lda2, acol2; const char* B; size_t btile;
    __device__ __forceinline__ void init(int M, int N, int G_, int c_, int lda, int acolstride, const void* B_, int ldb) { nM = M / 256; nN = N / 256; nwg = nM * nN; G = G_; c = c_; lda2 = (unsigned)lda * 2u; acol2 = (unsigned)acolstride * 2u; B = (const char*)B_; btile = (size_t)256 * ldb * 2; }
    __device__ __forceinline__ bool next(int i, pg8::Unit& u) const {
        const long L = (long)i * G + c; if (L >= nwg) return false;
        int wgid = (int)L; { const int q = nwg / 8, r = nwg % 8, xcd = wgid % 8, off = wgid / 8; wgid = (xcd < r ? xcd * (q + 1) : r * (q + 1) + (xcd - r) * q) + off; }
        const int nig = 8 * nN, gid = wgid / nig, fm = gid * 8, gsz = (nM - fm) < 8 ? (nM - fm) : 8;
        u.pm = fm + ((wgid % nig) % gsz); u.pn = (wgid % nig) / gsz; u.e = 0; return true;
    }
    __device__ __forceinline__ unsigned a_off(const pg8::Unit& u, int r) const { return (unsigned)(u.pm * 256 + r) * lda2 + (unsigned)u.pn * acol2; }
    __device__ __forceinline__ const char* b_ptr(const pg8::Unit& u) const { return B + (size_t)u.pn * btile; }
};
struct MoeSched {
    const LAS int* cnt; const LAS int* tbase; const LAS int* tileExp;
    int nunits, chunk, G, c; const int* RT; const char* B; size_t bexp, btile; unsigned arow2;
    __device__ __forceinline__ void init(const LAS int* tables, int G_, int c_, const int* RT_, const void* B_, int ldb, int lda) {
        cnt = tables; tbase = tables + 32; tileExp = tables + 80; G = G_; c = c_; RT = RT_; B = (const char*)B_; bexp = (size_t)1024 * ldb * 2; btile = (size_t)256 * ldb * 2; arow2 = (unsigned)lda * 2u;
        nunits = tbase[32] * 4; chunk = ((nunits + 7) / 8 + 3) & ~3;
    }
    __device__ __forceinline__ bool next(int i, pg8::Unit& u) const {
        const int w = i * (G / 8) + (c >> 3); if (w >= chunk) return false;
        const int L = (c & 7) * chunk + w; if (L >= nunits) return false;
        u.pm = L >> 2; u.pn = L & 3; u.e = tileExp[u.pm]; return true;
    }
    __device__ __forceinline__ unsigned a_off(const pg8::Unit& u, int r) const {
        if (RT) { const int pos = (u.pm - tbase[u.e]) * 256 + r; const int tok = pos < cnt[u.e] ? RT[u.e * NTOK + pos] : 0; return (unsigned)tok * arow2; }
        return (unsigned)(u.pm * 256 + r) * arow2;
    }
    __device__ __forceinline__ const char* b_ptr(const pg8::Unit& u) const { return B + (size_t)u.e * bexp + (size_t)u.pn * btile; }
};
__device__ __forceinline__ void build_moe_tables(Frame& F, int layer) {
    LAS int* T = (LAS int*)(F.lds + SCHED_OFF);
    int tid_ = F.tid; asm volatile("" : "+v"(tid_));
    if (tid_ < 32) T[tid_] = (int)__hip_atomic_load(F.ctl + CW_CNT + 64 * layer + tid_, RLX_AGENT);
    __syncthreads();
    if (F.tid == 0) { int acc = 0; for (int e = 0; e < 32; ++e) { T[32 + e] = acc; const int nt = (T[e] + 255) >> 8; for (int j = 0; j < nt; ++j) T[80 + acc + j] = e; acc += nt; } T[64] = acc; }
    __syncthreads();
}

__device__ __forceinline__ int moe_units_of(int c, int G, int nunits, int chunk) {
    const int sl = c >> 3, x = c & 7, per = G / 8; int U = nunits - x * chunk; U = U < 0 ? 0 : (U > chunk ? chunk : U);
    return sl < U ? (U - sl + per - 1) / per : 0;
}
__device__ __forceinline__ void moe_tail_plan(Frame& F) {
    LAS int* T = (LAS int*)(F.lds + SCHED_OFF);
    if (F.tid == 0) { T[65] = 0; T[66] = 0; }
    __syncthreads();
    if (F.tid < 256) {
        const int nunits = T[64] * 4, chunk = ((nunits + 7) / 8 + 3) & ~3, per = F.G / 8, maxu = (chunk + per - 1) / per, c = (int)blockIdx.x;
        const int sp = F.tid < F.G ? maxu - moe_units_of(F.tid, F.G, nunits, chunk) : 0;
        const int lower = (int)wave_sum(F.tid < c ? (float)sp : 0.f), all = (int)wave_sum((float)sp);
        if (F.lane == 0) { atomicAdd((int*)(T + 65), lower); atomicAdd((int*)(T + 66), all); }
        if (F.tid == c) T[67] = sp;
    }
    __syncthreads();
}

struct EpiStoreBf16 {
    bf16* O; int ldc;
    __device__ __forceinline__ void operator()(const f32x4 (&acc)[2][2][4][2], const pg8::Unit& u, int wr, int wc, int fr, int fq) const {
        const int row0 = u.pm * 256 + wr * 64 + fr, col0 = u.pn * 256 + wc * 32 + 8 * fq;
#pragma unroll
        for (int ai = 0; ai < 2; ++ai)
#pragma unroll
            for (int m = 0; m < 4; ++m) { bf16* rowp = O + (size_t)(row0 + ai * 128 + m * 16) * ldc + col0;
#pragma unroll
                for (int bj = 0; bj < 2; ++bj) { const f32x4 v0 = acc[ai][bj][m][0], v1 = acc[ai][bj][m][1];
                    v4u w; w.x = pk2(v0[0], v0[1]); w.y = pk2(v0[2], v0[3]); w.z = pk2(v1[0], v1[1]); w.w = pk2(v1[2], v1[3]);
                    *(v4u*)(rowp + bj * 128) = w; } }
    }
};
template <bool F32SRC> struct EpiResid {
    const float* X; bf16* O; const float* cf; const float* mul;
    __device__ __forceinline__ void operator()(const f32x4 (&acc)[2][2][4][2], const pg8::Unit& u, int wr, int wc, int fr, int fq) const {
        const int row0 = u.pm * 256 + wr * 64 + fr, col0 = u.pn * 256 + wc * 32 + 8 * fq, b = (u.pm * 256) / SEQ;
        f32x4 c[2][2];
#pragma unroll
        for (int bj = 0; bj < 2; ++bj)
#pragma unroll
            for (int n = 0; n < 2; ++n) { c[bj][n] = *(const f32x4*)(cf + (size_t)b * 6144 + col0 + bj * 128 + 4 * n); if (mul) c[bj][n] *= *(const f32x4*)(mul + col0 + bj * 128 + 4 * n); }
#pragma unroll
        for (int ai = 0; ai < 2; ++ai)
#pragma unroll
            for (int m = 0; m < 4; ++m) { const size_t ro = (size_t)(row0 + ai * 128 + m * 16) * D + col0;
                f32x4 s[2][2];
                if (F32SRC) {
#pragma unroll
                    for (int bj = 0; bj < 2; ++bj) { s[bj][0] = *(const GAS f32x4*)(X + ro + bj * 128); s[bj][1] = *(const GAS f32x4*)(X + ro + bj * 128 + 4); }
                } else {
#pragma unroll
                    for (int bj = 0; bj < 2; ++bj) { const v4u q = *(const GAS v4u*)(O + ro + bj * 128);
                        s[bj][0].x = bflo(q.x); s[bj][0].y = bfhi(q.x); s[bj][0].z = bflo(q.y); s[bj][0].w = bfhi(q.y); s[bj][1].x = bflo(q.z); s[bj][1].y = bfhi(q.z); s[bj][1].z = bflo(q.w); s[bj][1].w = bfhi(q.w); }
                }
#pragma unroll
                for (int bj = 0; bj < 2; ++bj) { const f32x4 v0 = s[bj][0] + c[bj][0] * acc[ai][bj][m][0], v1 = s[bj][1] + c[bj][1] * acc[ai][bj][m][1];
                    v4u w; w.x = pk2(v0[0], v0[1]); w.y = pk2(v0[2], v0[3]); w.z = pk2(v1[0], v1[1]); w.w = pk2(v1[2], v1[3]);
                    *(v4u*)(O + ro + bj * 128) = w; } }
    }
};
struct EpiSwiglu {
    bf16* O;
    __device__ __forceinline__ void operator()(const f32x4 (&acc)[2][2][4][2], const pg8::Unit& u, int wr, int wc, int fr, int fq) const {
        const int row0 = u.pm * 256 + wr * 64 + fr, col0 = u.pn * 128 + wc * 32 + 8 * fq;
#pragma unroll
        for (int ai = 0; ai < 2; ++ai)
#pragma unroll
            for (int m = 0; m < 4; ++m) { bf16* rowp = O + (size_t)(row0 + ai * 128 + m * 16) * DFF + col0;
                float r[8];
#pragma unroll
                for (int n = 0; n < 2; ++n)
#pragma unroll
                    for (int j = 0; j < 4; ++j) r[4 * n + j] = silu_f(acc[ai][0][m][n][j]) * acc[ai][1][m][n][j];
                v4u w; w.x = pk2(r[0], r[1]); w.y = pk2(r[2], r[3]); w.z = pk2(r[4], r[5]); w.w = pk2(r[6], r[7]);
                *(v4u*)rowp = w; }
    }
};

__device__ __forceinline__ void moe_route(Frame& F, int layer) {
    LAS int* hist = (LAS int*)(F.lds + RT_LDS_OFF);
    LAS int* base = hist + 32;
    LAS int* tinfo = hist + 64;
    LAS float* tg = (LAS float*)(hist + 64 + 512);
    if (F.tid < 32) hist[F.tid] = 0;
    LAS f32x4* R2 = (LAS f32x4*)(F.lds + RING_OFF);
    LAS f32x4* R1 = (LAS f32x4*)(F.lds + R1W_OFF);
    { const f32x4* g2p = (const f32x4*)(F.in[I_R2W] + (size_t)layer * 1024 * 32); const f32x4* g1p = (const f32x4*)(F.in[I_R1W] + (size_t)layer * 1024 * 4);
      for (int i = F.tid; i < 8192; i += 512) { const int k = i >> 3, c4 = i & 7, ln = (k & 255) >> 2, q = k & 3, j = k >> 8; R2[((j * 4 + q) * 8 + c4) * 64 + ln] = g2p[i]; }
      for (int k = F.tid; k < 1024; k += 512) { const int ln = (k & 255) >> 2, q = k & 3, j = k >> 8; R1[(j * 4 + q) * 64 + ln] = g1p[k]; } }
    __syncthreads();
    const float* mod = (const float*)(F.ws + WS_MOD) + (size_t)layer * 2 * 6144;
    bf16* H = (bf16*)(F.ws + WS_H);
    const int tokw = F.vcu * 128 + F.wave * 16, b = (F.vcu * 128) / SEQ;
    const ModVec m = load_mod(F.in[I_NFFN] + layer * D, mod + (size_t)b * 6144 + 4 * 1024, mod + (size_t)b * 6144 + 3 * 1024, F.lane);
    const float* r1b = F.in[I_R1B] + layer * 4; const float* r2b = F.in[I_R2B] + layer * 32;
    const bf16* XRB = (const bf16*)(F.ws + WS_XRB);
    v2u xbn[4], xb2[4];
    load_row_bf16(XRB + (size_t)tokw * D, F.lane, xbn); load_row_bf16(XRB + (size_t)(tokw + 1) * D, F.lane, xb2);
    for (int i = 0; i < 16; ++i) {
        const int t = tokw + i;
        const RowVec x = unpack_row_bf16(xbn);
#pragma unroll
        for (int j = 0; j < 4; ++j) xbn[j] = xb2[j];
        if (i + 2 < 16) load_row_bf16(XRB + (size_t)(t + 2) * D, F.lane, xb2);
        RowVec h = apply_mod(x, row_rstd(x), m);
        store_row_bf16(H + (size_t)t * D, F.lane, h);
        f32x4 l1 = {0.f, 0.f, 0.f, 0.f};
#pragma unroll
        for (int j = 0; j < 4; ++j)
#pragma unroll
            for (int q = 0; q < 4; ++q) l1 += R1[(j * 4 + q) * 64 + F.lane] * h.v[j][q];
        float lg[4];
#pragma unroll
        for (int g = 0; g < 4; ++g) lg[g] = wave_sum(l1[g]) + r1b[g];
        int grp = 0; float mx = lg[0];
#pragma unroll
        for (int g = 1; g < 4; ++g) if (lg[g] > mx) { mx = lg[g]; grp = g; }
        float se = 0.f;
#pragma unroll
        for (int g = 0; g < 4; ++g) se += __expf(lg[g] - mx);
        const float ptop = 1.0f / se;
        grp = __builtin_amdgcn_readfirstlane(grp);
        f32x4 a0 = {0.f, 0.f, 0.f, 0.f}, a1 = {0.f, 0.f, 0.f, 0.f};
#pragma unroll
        for (int j = 0; j < 4; ++j)
#pragma unroll
            for (int q = 0; q < 4; ++q) { const LAS f32x4* wp = R2 + ((j * 4 + q) * 8 + grp * 2) * 64 + F.lane;
                a0 += wp[0] * h.v[j][q]; a1 += wp[64] * h.v[j][q]; }
        float l2[8];
#pragma unroll
        for (int q = 0; q < 4; ++q) { l2[q] = wave_sum(a0[q]) + r2b[grp * 8 + q]; l2[4 + q] = wave_sum(a1[q]) + r2b[grp * 8 + 4 + q]; }
        int i0 = 0; float v0 = l2[0];
#pragma unroll
        for (int q = 1; q < 8; ++q) if (l2[q] > v0) { v0 = l2[q]; i0 = q; }
        int i1 = (i0 == 0) ? 1 : 0; float v1 = l2[i1 == 1 ? 1 : 0];
#pragma unroll
        for (int q = 0; q < 8; ++q) if (q != i0 && l2[q] > v1) { v1 = l2[q]; i1 = q; }
        const float g0 = ptop / (1.0f + __expf(v1 - v0)), g1 = ptop - g0;
        if (F.lane == 0) { const int e0 = grp * 8 + i0, e1 = grp * 8 + i1, li = F.wave * 16 + i;
            tinfo[li * 4 + 0] = e0; tinfo[li * 4 + 1] = e1; tinfo[li * 4 + 2] = atomicAdd((int*)(hist + e0), 1); tinfo[li * 4 + 3] = atomicAdd((int*)(hist + e1), 1);
            tg[li * 2] = g0; tg[li * 2 + 1] = g1;
            { float* GA = (float*)(F.ws + WS_BG); GA[(size_t)t * 2] = g0; GA[(size_t)t * 2 + 1] = g1; }
        }
    }
    __syncthreads();
    if (F.tid < 32) base[F.tid] = (int)__hip_atomic_fetch_add(F.ctl + CW_CNT + 64 * layer + F.tid, (unsigned)hist[F.tid], RLX_AGENT);
    __syncthreads();
    if (F.tid < 128) { const int t = F.vcu * 128 + F.tid; const int e0 = tinfo[F.tid * 4], e1 = tinfo[F.tid * 4 + 1];
        const int p0 = base[e0] + tinfo[F.tid * 4 + 2], p1 = base[e1] + tinfo[F.tid * 4 + 3];
        int* RT = (int*)(F.ws + WS_RT); RT[e0 * NTOK + p0] = t; RT[e1 * NTOK + p1] = t;
        v4u r0; r0.x = e0; r0.y = e1; r0.z = p0; r0.w = p1; v4u r1; r1.x = __builtin_bit_cast(unsigned, tg[F.tid * 2]); r1.y = __builtin_bit_cast(unsigned, tg[F.tid * 2 + 1]); r1.z = 0; r1.w = 0;
        v4u* RO = (v4u*)(F.ws + WS_ROUTE) + (size_t)t * 2; RO[0] = r0; (void)r1; }
    __syncthreads();
}

struct CombRows { v2u xb[4], ya[4], yb[4]; };
struct CombRecs { v4u rec; float ga, gb; };
__device__ __forceinline__ CombRecs comb_load_recs(Frame& F, int tokw) { CombRecs c; const int t = tokw + (F.lane & 15);
    c.rec = *((const v4u*)(F.ws + WS_ROUTE) + (size_t)t * 2); const float* GA = (const float*)(F.ws + WS_BG); c.ga = GA[(size_t)t * 2]; c.gb = GA[(size_t)t * 2 + 1]; return c; }
__device__ __forceinline__ int rl_i(int v, int l) { return __builtin_amdgcn_readlane(v, l); }
__device__ __forceinline__ void comb_issue(Frame& F, const CombRecs& c, int i, int t, CombRows& r) {
    const LAS int* T = (const LAS int*)(F.lds + SCHED_OFF);
    const int e0 = rl_i((int)c.rec.x, i), e1 = rl_i((int)c.rec.y, i), p0 = rl_i((int)c.rec.z, i), p1 = rl_i((int)c.rec.w, i);
    const size_t rowa = (size_t)T[32 + e0] * 256 + p0, rowb = (size_t)T[32 + e1] * 256 + p1;
    const bf16* Y = (const bf16*)(F.ws + WS_Y);
    const GAS v2u* ya = (const GAS v2u*)(Y + rowa * D) + F.lane; const GAS v2u* yb = (const GAS v2u*)(Y + rowb * D) + F.lane;
    load_row_bf16((const bf16*)(F.ws + WS_XRB) + (size_t)t * D, F.lane, r.xb);
#pragma unroll
    for (int j = 0; j < 4; ++j) { r.ya[j] = ya[64 * j]; r.yb[j] = yb[64 * j]; }
}
__device__ __forceinline__ RowVec comb_finish(const CombRecs& c, int i, const CombRows& r, const f32x4 (&g2)[4]) {
    const float ga = rl(c.ga, i), gb = rl(c.gb, i); RowVec x = unpack_row_bf16(r.xb);
#pragma unroll
    for (int j = 0; j < 4; ++j) { const v2u a = r.ya[j], bq = r.yb[j];
        f32x4 s; s.x = ga * bflo(a.x) + gb * bflo(bq.x); s.y = ga * bfhi(a.x) + gb * bfhi(bq.x); s.z = ga * bflo(a.y) + gb * bflo(bq.y); s.w = ga * bfhi(a.y) + gb * bfhi(bq.y);
        x.v[j] += g2[j] * s; }
    return x;
}

__device__ __forceinline__ void attn_phase(Frame& F, const int u_first, const int u_stride) {
    LAS bf16* KS = (LAS bf16*)(F.lds + RING_OFF);
    LAS bf16* VT = (LAS bf16*)(F.lds + RING_OFF + 36864);
    LAS float* BT = (LAS float*)(F.lds + RING_OFF + 36864 + 33280);
    const bf16* PROJ = (const bf16*)(F.ws + WS_PROJ); bf16* OAB = (bf16*)(F.ws + WS_OAB);
    const int lane = F.lane, lc = lane & 31, lh = lane >> 5;
    for (int unit = u_first; unit < 512; unit += u_stride) {
        const int b = unit >> 8, kvh = (unit >> 7) & 1, qb = unit & 127, t0 = qb * 128;
        __syncthreads();
        for (int i = F.tid; i < 4 * 192; i += 512) { const int hq = i / 192, x = i - hq * 192, dist = 159 - x; float v = 0.f;
            if (dist >= 0 && dist < 128) { int bk = dist; if (dist >= 16) { bk = 16 + (int)(logf((float)dist / 16.0f) / 2.0794415416798357f * 16.0f); bk = bk > 31 ? 31 : bk; }
                v = F.in[I_RELB][bk * 8 + kvh * 4 + hq] * 1.4426950408889634f; }
            BT[i] = v; }
#pragma unroll
        for (int cc = 0; cc < 4; ++cc) { const int ch = F.tid + 512 * cc, key = ch >> 3, part = ch & 7, tl = t0 - 128 + key;
            v4u kv = {0u, 0u, 0u, 0u}, vv = {0u, 0u, 0u, 0u};
            if (tl >= 0) { const bf16* rp = PROJ + (size_t)(b * SEQ + tl) * PIN; kv = *(const v4u*)(rp + PC_KB + kvh * 64 + part * 8); vv = *(const v4u*)(rp + PC_VB + kvh * 64 + part * 8); }
            *(LAS v4u*)(KS + key * 72 + part * 8) = kv;
            const unsigned w[4] = {vv.x, vv.y, vv.z, vv.w};
#pragma unroll
            for (int q = 0; q < 4; ++q) { VT[(part * 8 + 2 * q) * 260 + key] = (bf16)(w[q] & 0xffffu); VT[(part * 8 + 2 * q + 1) * 260 + key] = (bf16)(w[q] >> 16); } }
        __syncthreads();
#pragma unroll 1
        for (int tt = 0; tt < 2; ++tt) {
            const int task = F.wave * 2 + tt, hq = task >> 2, qt = task & 3, qh = kvh * 4 + hq;
            const int qi = 32 * qt + lc;
            const bf16* qrow = PROJ + (size_t)(b * SEQ + t0 + qi) * PIN + PC_QB + qh * 64 + 8 * lh;
            bf16x8 qf[4];
#pragma unroll
            for (int s = 0; s < 4; ++s) qf[s] = *(const bf16x8*)(qrow + 16 * s);
            f32x16 sc[5];
#pragma unroll
            for (int kt = 0; kt < 5; ++kt) {
#pragma unroll
                for (int r = 0; r < 16; ++r) sc[kt][r] = 0.f;
                const LAS bf16* kp = KS + (32 * (qt + kt) + lc) * 72 + 8 * lh;
#pragma unroll
                for (int s = 0; s < 4; ++s) { const bf16x8 kf = *(const LAS bf16x8*)(kp + 16 * s); sc[kt] = __builtin_amdgcn_mfma_f32_32x32x16_bf16(kf, qf[s], sc[kt], 0, 0, 0); }
            }
            const float sink2 = F.in[I_SINKS][qh] * 1.4426950408889634f;
            const LAS float* bp = BT + hq * 192 + (4 * lh - lc + 31);
            const int m_lo = lc + 1 - 4 * lh, m_hi = lc - 4 * lh;
            float mx = sink2;
#pragma unroll
            for (int kt = 0; kt < 5; ++kt) {
                const bool dead = (t0 == 0) && (qt + kt < 4);
#pragma unroll
                for (int r = 0; r < 16; ++r) { const int cr = (r & 3) + 8 * (r >> 2);
                    float v = sc[kt][r] * (0.125f * 1.4426950408889634f) + bp[32 * kt + cr];
                    if (kt == 0) v = (cr >= m_lo) ? v : -1e30f;
                    if (kt == 4) v = (cr <= m_hi) ? v : -1e30f;
                    if (dead) v = -1e30f;
                    sc[kt][r] = v; mx = fmaxf(mx, v); } }
            mx = fmaxf(mx, __shfl_xor(mx, 32));
            float den = 0.f;
#pragma unroll
            for (int kt = 0; kt < 5; ++kt)
#pragma unroll
                for (int r = 0; r < 16; ++r) { const float p = __builtin_amdgcn_exp2f(sc[kt][r] - mx); sc[kt][r] = p; den += p; }
            den += __shfl_xor(den, 32);
            den += __builtin_amdgcn_exp2f(sink2 - mx);
            const float inv = 1.0f / den;
            f32x16 oa[2];
#pragma unroll
            for (int dt = 0; dt < 2; ++dt)
#pragma unroll
                for (int r = 0; r < 16; ++r) oa[dt][r] = 0.f;
#pragma unroll
            for (int kt = 0; kt < 5; ++kt)
#pragma unroll
                for (int s2 = 0; s2 < 2; ++s2) {
                    v4u pw; pw.x = pk2(sc[kt][8 * s2 + 0], sc[kt][8 * s2 + 1]); pw.y = pk2(sc[kt][8 * s2 + 2], sc[kt][8 * s2 + 3]); pw.z = pk2(sc[kt][8 * s2 + 4], sc[kt][8 * s2 + 5]); pw.w = pk2(sc[kt][8 * s2 + 6], sc[kt][8 * s2 + 7]);
                    const bf16x8 pf = __builtin_bit_cast(bf16x8, pw);
#pragma unroll
                    for (int dt = 0; dt < 2; ++dt) { const LAS bf16* vp = VT + (32 * dt + lc) * 260 + 32 * (qt + kt) + 16 * s2 + 4 * lh;
                        const v2u va = *(const LAS v2u*)vp, vb = *(const LAS v2u*)(vp + 8);
                        v4u vw; vw.x = va.x; vw.y = va.y; vw.z = vb.x; vw.w = vb.y;
                        oa[dt] = __builtin_amdgcn_mfma_f32_32x32x16_bf16(__builtin_bit_cast(bf16x8, vw), pf, oa[dt], 0, 0, 0); }
                }
            bf16* orow = OAB + (size_t)(b * SEQ + t0 + qi) * D + 512 + qh * 64 + 4 * lh;
#pragma unroll
            for (int dt = 0; dt < 2; ++dt)
#pragma unroll
                for (int rg = 0; rg < 4; ++rg) { v2u o; o.x = pk2(oa[dt][4 * rg] * inv, oa[dt][4 * rg + 1] * inv); o.y = pk2(oa[dt][4 * rg + 2] * inv, oa[dt][4 * rg + 3] * inv);
                    *(v2u*)(orow + 32 * dt + 8 * rg) = o; }
        }
    }
    __syncthreads();
}


constexpr int DN_ST = 72;

__device__ __forceinline__ bf16x8 pack8(const f32x16& x, int s) { v4u p; p.x = pk2(x[8 * s], x[8 * s + 1]); p.y = pk2(x[8 * s + 2], x[8 * s + 3]); p.z = pk2(x[8 * s + 4], x[8 * s + 5]); p.w = pk2(x[8 * s + 6], x[8 * s + 7]); return __builtin_bit_cast(bf16x8, p); }
__device__ __forceinline__ f32x16 dn_tile(const LAS bf16* A, int ra, const LAS bf16* B, int rb, int lc, int lh) {
    f32x16 acc;
#pragma unroll
    for (int r = 0; r < 16; ++r) acc[r] = 0.f;
#pragma unroll
    for (int s = 0; s < 4; ++s) { const bf16x8 a = *(const LAS bf16x8*)(A + (ra + lc) * DN_ST + 16 * s + 8 * lh), b = *(const LAS bf16x8*)(B + (rb + lc) * DN_ST + 16 * s + 8 * lh);
        acc = __builtin_amdgcn_mfma_f32_32x32x16_bf16(a, b, acc, 0, 0, 0); }
    return acc;
}
__device__ __forceinline__ void dn_prep(Frame& F) {
    LAS bf16* Qs = (LAS bf16*)(F.lds + RING_OFF);
    LAS bf16* Ks = Qs + 64 * DN_ST;
    LAS bf16* KBs = Ks + 64 * DN_ST;
    LAS bf16* Vs = KBs + 64 * DN_ST;
    LAS bf16* KDT = Vs + 64 * DN_ST;
    LAS bf16* AQK = KDT + 64 * DN_ST;
    LAS bf16* UT = AQK + 64 * DN_ST;
    LAS bf16* WT = UT + 64 * DN_ST;
    LAS bf16* LNO = WT + 64 * DN_ST;
    LAS float* LD = (LAS float*)(LNO + 64 * DN_ST);
    LAS bf16* TDZ = (LAS bf16*)(LD + 64 * 16);
    LAS float* GB = (LAS float*)(TDZ + 64 * 24);
    const bf16* PROJ = (const bf16*)(F.ws + WS_PROJ); const float* BG = (const float*)(F.ws + WS_BG);
    const int tid = F.tid, lane = F.lane, lc = lane & 31, lh = lane >> 5, wave = F.wave;
    LAS float* CW = GB + 256;
    for (int i = tid; i < 1536; i += 512) *((LAS f32x4*)CW + i) = *((const f32x4*)F.in[I_CONVW] + i);
    LAS v4u* RAW = (LAS v4u*)(F.lds + R1W_OFF);
    constexpr int RAW_CH = 67 * 24;
#define DN_RAW_SRC(i_, b_, h_, n_) ({ const int r_ = (i_) / 24, c_ = (i_) - r_ * 24; const int tl_ = (n_) * 64 - 3 + r_; \
        tl_ >= 0 ? (const v4u*)(PROJ + ((size_t)(b_) * SEQ + tl_) * PIN + (c_ < 8 ? PC_QA : c_ < 16 ? PC_KA : PC_VA) + (h_) * 64 + (c_ & 7) * 8) : (const v4u*)nullptr; })
    { const int u0 = F.vcu, b = u0 >> 11, h = (u0 >> 8) & 7, n = u0 & 255;
      for (int i = tid; i < RAW_CH; i += 512) { const v4u* sp = DN_RAW_SRC(i, b, h, n); v4u z = {0u, 0u, 0u, 0u}; if (sp) z = *sp; RAW[i] = z; }
      if (wave == 0) { const size_t row0 = (size_t)b * SEQ + (size_t)n * 64; float c = BG[(row0 + lane) * 16 + 8 + h];
#pragma unroll
          for (int o = 1; o < 64; o <<= 1) { const float up = __shfl_up(c, o); if (lane >= o) c += up; }
          GB[lane] = c; GB[64 + lane] = BG[(row0 + lane) * 16 + h]; } }
    int par = 0;
    for (int unit = F.vcu; unit < 4096; unit += F.G, par ^= 1) {
        const int b = unit >> 11, h = (unit >> 8) & 7, n = unit & 255;
        LAS float* gcs = GB + par * 128; LAS float* bts = gcs + 64;
        const int un = unit + F.G; const bool more = un < 4096; const int bn = un >> 11, hn = (un >> 8) & 7, nn = un & 255;
        __syncthreads();
        { const int t = tid >> 3, cs = tid & 7;
          float q[8], k[8], v[8];
#pragma unroll
          for (int e = 0; e < 8; ++e) { q[e] = 0.f; k[e] = 0.f; v[e] = 0.f; }
#pragma unroll
          for (int j = 0; j < 4; ++j) { { const LAS v4u* rp = RAW + (t + j) * 24 + cs;
                const v4u wq = rp[0], wk = rp[8], wv = rp[16];
                const LAS float* cw = CW + j * 1536 + h * 64 + cs * 8;
                const unsigned uq[4] = {wq.x, wq.y, wq.z, wq.w}, uk[4] = {wk.x, wk.y, wk.z, wk.w}, uv[4] = {wv.x, wv.y, wv.z, wv.w};
#pragma unroll
                for (int e = 0; e < 4; ++e) { q[2 * e] += cw[2 * e] * bflo(uq[e]); q[2 * e + 1] += cw[2 * e + 1] * bfhi(uq[e]);
                    k[2 * e] += cw[512 + 2 * e] * bflo(uk[e]); k[2 * e + 1] += cw[512 + 2 * e + 1] * bfhi(uk[e]);
                    v[2 * e] += cw[1024 + 2 * e] * bflo(uv[e]); v[2 * e + 1] += cw[1024 + 2 * e + 1] * bfhi(uv[e]); } } }
          float sq = 0.f, sk = 0.f;
#pragma unroll
          for (int e = 0; e < 8; ++e) { q[e] = silu_f(q[e]); k[e] = silu_f(k[e]); v[e] = silu_f(v[e]); sq += q[e] * q[e]; sk += k[e] * k[e]; }
          sq = oct_sum(sq); sk = oct_sum(sk);
          const float rq = 0.125f / sqrtf(sq + EPS), rk = 1.0f / sqrtf(sk + EPS), bt = bts[t], kd = __expf(gcs[63] - gcs[t]);
          v4u oq, ok, ob, ov;
          oq.x = pk2(q[0] * rq, q[1] * rq); oq.y = pk2(q[2] * rq, q[3] * rq); oq.z = pk2(q[4] * rq, q[5] * rq); oq.w = pk2(q[6] * rq, q[7] * rq);
#pragma unroll
          for (int e = 0; e < 8; ++e) k[e] *= rk;
          ok.x = pk2(k[0], k[1]); ok.y = pk2(k[2], k[3]); ok.z = pk2(k[4], k[5]); ok.w = pk2(k[6], k[7]);
          ob.x = pk2(k[0] * bt, k[1] * bt); ob.y = pk2(k[2] * bt, k[3] * bt); ob.z = pk2(k[4] * bt, k[5] * bt); ob.w = pk2(k[6] * bt, k[7] * bt);
          ov.x = pk2(v[0], v[1]); ov.y = pk2(v[2], v[3]); ov.z = pk2(v[4], v[5]); ov.w = pk2(v[6], v[7]);
          *(LAS v4u*)(Qs + t * DN_ST + cs * 8) = oq; *(LAS v4u*)(Ks + t * DN_ST + cs * 8) = ok; *(LAS v4u*)(KBs + t * DN_ST + cs * 8) = ob; *(LAS v4u*)(Vs + t * DN_ST + cs * 8) = ov;
#pragma unroll
          for (int e = 0; e < 8; ++e) KDT[(cs * 8 + e) * DN_ST + t] = (bf16)f2bf(k[e] * kd); }
        __syncthreads();
        v4u pf[7]; float pg = 0.f, pb = 0.f;
        if (wave >= 4 && more) {
#pragma unroll
            for (int k7 = 0; k7 < 7; ++k7) { const int i = (tid - 256) + 256 * k7; pf[k7] = (v4u){0u, 0u, 0u, 0u}; if (i < RAW_CH) { const v4u* sp = DN_RAW_SRC(i, bn, hn, nn); if (sp) pf[k7] = *sp; } }
            if (wave == 4) { const size_t rn = (size_t)bn * SEQ + (size_t)nn * 64; pg = BG[(rn + lane) * 16 + 8 + hn]; pb = BG[(rn + lane) * 16 + hn]; }
        }
        { const int it = (wave >> 1) & 1, jt = wave & 1; const bool qk = wave >= 4;
          f32x16 acc;
          if (it >= jt) acc = dn_tile(qk ? Qs : KBs, 32 * it, Ks, 32 * jt, lc, lh);
          const int j = 32 * jt + lc; const float gj = gcs[j];
#pragma unroll
          for (int r = 0; r < 16; ++r) { const int i = 32 * it + (r & 3) + 8 * (r >> 2) + 4 * lh;
              float val = 0.f;
              if (it >= jt) { if (qk ? (i >= j) : (i > j)) val = acc[r] * __expf(gcs[i] - gj); }
              if (qk) AQK[i * DN_ST + j] = (bf16)f2bf(val);
              else { const bool diag = (i >> 4) == (j >> 4); LNO[i * DN_ST + j] = (bf16)f2bf(diag ? 0.f : -val); if (diag) LD[i * 16 + (j & 15)] = val; } } }
        __syncthreads();
        if (wave == 0) { const int bb = lane >> 4, c = lane & 15; float tcol[16];
#pragma unroll
            for (int i = 0; i < 16; ++i) { float v = (i == c) ? 1.f : 0.f;
#pragma unroll
                for (int j4 = 0; j4 < (i + 3) / 4; ++j4) { const f32x4 a = *(const LAS f32x4*)(LD + (16 * bb + i) * 16 + 4 * j4);
#pragma unroll
                    for (int e = 0; e < 4; ++e) if (4 * j4 + e < i) v -= a[e] * tcol[4 * j4 + e]; }
                tcol[i] = v; TDZ[(16 * bb + i) * 24 + c] = (bf16)f2bf(v); } }
        __syncthreads();
        if (wave < 4) {
            const int ct = wave, cc = 32 * (ct & 1) + lc; const bool isw = ct >= 2;
            f32x16 acc[2];
#pragma unroll
            for (int rt = 0; rt < 2; ++rt)
#pragma unroll
                for (int r = 0; r < 16; ++r) { const int t = 32 * rt + (r & 3) + 8 * (r >> 2) + 4 * lh;
                    acc[rt][r] = isw ? bf2f(Ks[t * DN_ST + cc]) * bts[t] * __expf(gcs[t]) : bf2f(Vs[t * DN_ST + cc]) * bts[t]; }
#define DN_AFRAG(arr, stride, row, kb) ({ const LAS bf16* p_ = (arr) + (row) * (stride) + 16 * (kb) + 4 * lh; const v2u lo_ = *(const LAS v2u*)p_, hi_ = *(const LAS v2u*)(p_ + 8); v4u w_; w_.x = lo_.x; w_.y = lo_.y; w_.z = hi_.x; w_.w = hi_.y; __builtin_bit_cast(bf16x8, w_); })
            f32x16 X[4];
#pragma unroll
            for (int bb = 0; bb < 4; ++bb) { const int rt = bb >> 1, odd = bb & 1;
                bf16x8 ta = DN_AFRAG(TDZ, 24, 32 * rt + lc, 0);
                if ((lc >> 4) != odd) ta = (bf16x8){0, 0, 0, 0, 0, 0, 0, 0};
                f32x16 z;
#pragma unroll
                for (int r = 0; r < 16; ++r) z[r] = 0.f;
                z = __builtin_amdgcn_mfma_f32_32x32x16_bf16(ta, pack8(acc[rt], odd), z, 0, 0, 0);
                X[bb] = z;
                const bf16x8 xb = pack8(z, odd);
                if (bb == 0) { acc[0] = __builtin_amdgcn_mfma_f32_32x32x16_bf16(DN_AFRAG(LNO, DN_ST, lc, 0), xb, acc[0], 0, 0, 0); acc[1] = __builtin_amdgcn_mfma_f32_32x32x16_bf16(DN_AFRAG(LNO, DN_ST, 32 + lc, 0), xb, acc[1], 0, 0, 0); }
                if (bb == 1) { acc[1] = __builtin_amdgcn_mfma_f32_32x32x16_bf16(DN_AFRAG(LNO, DN_ST, 32 + lc, 1), xb, acc[1], 0, 0, 0); }
                if (bb == 2) { acc[1] = __builtin_amdgcn_mfma_f32_32x32x16_bf16(DN_AFRAG(LNO, DN_ST, 32 + lc, 2), xb, acc[1], 0, 0, 0); }
            }
#undef DN_AFRAG
            LAS bf16* dst = (isw ? WT : UT) + cc * DN_ST;
#pragma unroll
            for (int bb = 0; bb < 4; ++bb)
#pragma unroll
                for (int g = 0; g < 2; ++g) { const int r0 = 8 * (bb & 1) + 4 * g; v2u o; o.x = pk2(X[bb][r0], X[bb][r0 + 1]); o.y = pk2(X[bb][r0 + 2], X[bb][r0 + 3]);
                    *(LAS v2u*)(dst + 16 * bb + 8 * g + 4 * lh) = o; }
        } else if (more) {
#pragma unroll
            for (int k7 = 0; k7 < 7; ++k7) { const int i = (tid - 256) + 256 * k7; if (i < RAW_CH) RAW[i] = pf[k7]; }
            if (wave == 4) { float c = pg;
#pragma unroll
                for (int o = 1; o < 64; o <<= 1) { const float up = __shfl_up(c, o); if (lane >= o) c += up; }
                GB[(par ^ 1) * 128 + lane] = c; GB[(par ^ 1) * 128 + 64 + lane] = pb; }
        }
        __syncthreads();
        { bf16* MT = (bf16*)(F.ws + WS_DN_MT) + (size_t)unit * 4096; bf16* QPT = (bf16*)(F.ws + WS_DN_QPT) + (size_t)unit * 4096;
          bf16* BM = (bf16*)(F.ws + WS_DN_BM) + (size_t)unit * 4096; bf16* O0T = (bf16*)(F.ws + WS_DN_O0T) + (size_t)unit * 4096;
#pragma unroll 1
          for (int tt = 0; tt < 2; ++tt) { const int task = wave * 2 + tt, p = task >> 2, ta = (task >> 1) & 1, tb = task & 1;
              if (p == 0) {
                  f32x16 acc = dn_tile(WT, 32 * ta, KDT, 32 * tb, lc, lh);
#pragma unroll
                  for (int r = 0; r < 16; ++r) acc[r] = -acc[r];
#pragma unroll
                  for (int s2 = 0; s2 < 2; ++s2) *(bf16x8*)(MT + ((((tb * 2 + ta) * 2 + s2) * 64 + lane) * 8)) = pack8(acc, s2);
              } else if (p == 1) {
                  const f32x16 acc = dn_tile(KDT, 32 * ta, UT, 32 * tb, lc, lh);
#pragma unroll
                  for (int s2 = 0; s2 < 2; ++s2) *(bf16x8*)(BM + ((((tb * 2 + ta) * 2 + s2) * 64 + lane) * 8)) = pack8(acc, s2);
              } else if (p == 2) {
                  f32x16 acc = dn_tile(WT, 32 * ta, AQK, 32 * tb, lc, lh);
                  const int i = 32 * tb + lc; const float eg = __expf(gcs[i]);
#pragma unroll
                  for (int r = 0; r < 16; ++r) { const int a = 32 * ta + (r & 3) + 8 * (r >> 2) + 4 * lh; acc[r] = bf2f(Qs[i * DN_ST + a]) * eg - acc[r]; }
#pragma unroll
                  for (int s2 = 0; s2 < 2; ++s2) *(bf16x8*)(QPT + ((((tb * 2 + ta) * 2 + s2) * 64 + lane) * 8)) = pack8(acc, s2);
              } else {
                  const f32x16 acc = dn_tile(UT, 32 * ta, AQK, 32 * tb, lc, lh);
#pragma unroll
                  for (int s2 = 0; s2 < 2; ++s2) *(bf16x8*)(O0T + ((((tb * 2 + ta) * 2 + s2) * 64 + lane) * 8)) = pack8(acc, s2);
              } }
          if (tid == 0) ((float*)(F.ws + WS_DN_GT))[unit] = __expf(gcs[63]); }
    }
#undef DN_RAW_SRC
    __syncthreads();
}
template <int r>
__device__ __forceinline__ void dn_scan_wave(Frame& F) {
    const int w = F.vcu, bh = w >> 1, ct = w & 1, lane = F.lane;
    const bf16x8* MT = (const bf16x8*)(F.ws + WS_DN_MT); const bf16x8* BM = (const bf16x8*)(F.ws + WS_DN_BM); bf16x8* SS = (bf16x8*)(F.ws + WS_DN_S);
    const float* GT = (const float*)(F.ws + WS_DN_GT);
    LAS bf16x8* MB = (LAS bf16x8*)(F.lds + RING_OFF);
    volatile LAS int* FL = (volatile LAS int*)(F.lds + LDSCTL_OFF + 64);
    f32x16 S;
#pragma unroll
    for (int q = 0; q < 16; ++q) S[q] = 0.f;
    bf16x8 mA[4], bA[2], mB[4], bB[2], mC[4], bC[2], mD[4], bD[2], mE[4], bE[2], mG[4], bG[2]; float gA, gB, gC, gD, gE, gG;
#define DN_SLOAD(m, bm, gt, u) do { const size_t ub = (size_t)(u) * 512; _Pragma("unroll") for (int f = 0; f < 4; ++f) m[f] = MT[ub + (r * 4 + f) * 64 + lane]; \
        _Pragma("unroll") for (int f = 0; f < 2; ++f) bm[f] = BM[ub + ((ct * 2 + r) * 2 + f) * 64 + lane]; gt = GT[u]; } while (0)
#define DN_STEP(cm, cb, cg, unit, n) do { \
        bf16x8 own[2]; own[0] = pack8(S, 0); own[1] = pack8(S, 1); \
        LAS bf16x8* mb = MB + ((n) & 1) * 256; \
        mb[(r * 2 + 0) * 64 + lane] = own[0]; mb[(r * 2 + 1) * 64 + lane] = own[1]; \
        asm volatile("s_waitcnt lgkmcnt(0)" ::: "memory"); \
        if (lane == 0) FL[r] = (n) + 1; \
        SS[(size_t)(unit) * 512 + (ct * 4 + r * 2 + 0) * 64 + lane] = own[0]; SS[(size_t)(unit) * 512 + (ct * 4 + r * 2 + 1) * 64 + lane] = own[1]; \
        f32x16 A; \
        { const v4u b0 = __builtin_bit_cast(v4u, cb[0]), b1 = __builtin_bit_cast(v4u, cb[1]); const unsigned u0[8] = {b0.x, b0.y, b0.z, b0.w, b1.x, b1.y, b1.z, b1.w}; \
          _Pragma("unroll") for (int e = 0; e < 8; ++e) { A[2 * e] = cg * S[2 * e] + bflo(u0[e]); A[2 * e + 1] = cg * S[2 * e + 1] + bfhi(u0[e]); } } \
        while (FL[1 - r] < (n) + 1) { } \
        asm volatile("" ::: "memory"); \
        bf16x8 oth[2]; oth[0] = mb[((1 - r) * 2 + 0) * 64 + lane]; oth[1] = mb[((1 - r) * 2 + 1) * 64 + lane]; \
          \
        _Pragma("unroll") for (int s2 = 0; s2 < 2; ++s2) { A = __builtin_amdgcn_mfma_f32_32x32x16_bf16(cm[r * 2 + s2], own[s2], A, 0, 0, 0); A = __builtin_amdgcn_mfma_f32_32x32x16_bf16(cm[(1 - r) * 2 + s2], oth[s2], A, 0, 0, 0); } \
        S = A; } while (0)
    const int u0 = bh * 256;
    DN_SLOAD(mA, bA, gA, u0); DN_SLOAD(mB, bB, gB, u0 + 1); DN_SLOAD(mC, bC, gC, u0 + 2); DN_SLOAD(mD, bD, gD, u0 + 3); DN_SLOAD(mE, bE, gE, u0 + 4); DN_SLOAD(mG, bG, gG, u0 + 5);
    for (int n = 0; n < 252; n += 6) {
        DN_STEP(mA, bA, gA, u0 + n, n);         DN_SLOAD(mA, bA, gA, u0 + n + 6);
        DN_STEP(mB, bB, gB, u0 + n + 1, n + 1); DN_SLOAD(mB, bB, gB, u0 + n + 7);
        DN_STEP(mC, bC, gC, u0 + n + 2, n + 2); DN_SLOAD(mC, bC, gC, u0 + n + 8);
        DN_STEP(mD, bD, gD, u0 + n + 3, n + 3); DN_SLOAD(mD, bD, gD, u0 + n + 9);
        DN_STEP(mE, bE, gE, u0 + n + 4, n + 4); if (n + 10 < 256) DN_SLOAD(mE, bE, gE, u0 + n + 10);
        DN_STEP(mG, bG, gG, u0 + n + 5, n + 5); if (n + 11 < 256) DN_SLOAD(mG, bG, gG, u0 + n + 11);
    }
    DN_STEP(mA, bA, gA, u0 + 252, 252); DN_STEP(mB, bB, gB, u0 + 253, 253); DN_STEP(mC, bC, gC, u0 + 254, 254); DN_STEP(mD, bD, gD, u0 + 255, 255);
#undef DN_SLOAD
#undef DN_STEP
}
__device__ __forceinline__ void dn_scan(Frame& F) {
    if (F.vcu >= 32) return;
    if (F.wave == 0) dn_scan_wave<0>(F); else if (F.wave == 1) dn_scan_wave<1>(F);
}
__device__ __forceinline__ void dn_output(Frame& F) {
    const bf16x8* QPT = (const bf16x8*)(F.ws + WS_DN_QPT); const bf16x8* O0T = (const bf16x8*)(F.ws + WS_DN_O0T); const bf16x8* SS = (const bf16x8*)(F.ws + WS_DN_S);
    const bf16* PROJ = (const bf16*)(F.ws + WS_PROJ); bf16* OAB = (bf16*)(F.ws + WS_OAB);
    const int lane = F.lane, lc = lane & 31, lh = lane >> 5; int nbad = 0; (void)nbad;
    for (int task = F.vcu * NWAVES + F.wave; task < 8192; task += F.G * NWAVES) {
        const int unit = task >> 1, it = task & 1, b = unit >> 11, h = (unit >> 8) & 7, n = unit & 255;
        const size_t ub = (size_t)unit * 512;
        f32x16 o[2];
#pragma unroll
        for (int ct = 0; ct < 2; ++ct) {
            const v4u c0 = __builtin_bit_cast(v4u, O0T[ub + ((it * 2 + ct) * 2 + 0) * 64 + lane]), c1 = __builtin_bit_cast(v4u, O0T[ub + ((it * 2 + ct) * 2 + 1) * 64 + lane]);
            const unsigned u[8] = {c0.x, c0.y, c0.z, c0.w, c1.x, c1.y, c1.z, c1.w};
#pragma unroll
            for (int e = 0; e < 8; ++e) { o[ct][2 * e] = bflo(u[e]); o[ct][2 * e + 1] = bfhi(u[e]); }
#pragma unroll
            for (int at = 0; at < 2; ++at)
#pragma unroll
                for (int s2 = 0; s2 < 2; ++s2) o[ct] = __builtin_amdgcn_mfma_f32_32x32x16_bf16(SS[ub + (ct * 4 + at * 2 + s2) * 64 + lane], QPT[ub + ((it * 2 + at) * 2 + s2) * 64 + lane], o[ct], 0, 0, 0);
        }
        float ss = 0.f;
#pragma unroll
        for (int ct = 0; ct < 2; ++ct)
#pragma unroll
            for (int r = 0; r < 16; ++r) ss += o[ct][r] * o[ct][r];
        ss += __shfl_xor(ss, 32);
        const float rs = 1.0f / sqrtf(ss * (1.0f / 64.0f) + EPS);
        const size_t row = (size_t)b * SEQ + (size_t)n * 64 + it * 32 + lc;
#pragma unroll
        for (int ct = 0; ct < 2; ++ct)
#pragma unroll
            for (int rg = 0; rg < 4; ++rg) { const int c0 = 32 * ct + 8 * rg + 4 * lh;
                const v2u zz = *(const v2u*)(PROJ + row * PIN + PC_ZA + h * 64 + c0); const f32x4 ow = *(const f32x4*)(F.in[I_ONORM] + c0);
                const float z0 = bflo(zz.x), z1 = bfhi(zz.x), z2 = bflo(zz.y), z3 = bfhi(zz.y);
                v2u ov; ov.x = pk2(o[ct][4 * rg] * rs * ow[0] * silu_f(z0), o[ct][4 * rg + 1] * rs * ow[1] * silu_f(z1)); ov.y = pk2(o[ct][4 * rg + 2] * rs * ow[2] * silu_f(z2), o[ct][4 * rg + 3] * rs * ow[3] * silu_f(z3));
                *(v2u*)(OAB + row * D + h * 64 + c0) = ov;
            }
    }
}

template <int WIN>
__device__ __forceinline__ void pooled_block(const bf16* H, bf16* P, const int t0, const int tl0, const int col) {
    v4u r[WIN - 1 + 8];
#pragma unroll
    for (int j = 0; j < WIN - 1 + 8; ++j) { const int dt = j - (WIN - 1); r[j] = (v4u){0u, 0u, 0u, 0u}; if (tl0 + dt >= 0) r[j] = *(const v4u*)(H + (size_t)(t0 + dt) * D + col); }
    float s[8];
#pragma unroll
    for (int q = 0; q < 8; ++q) s[q] = 0.f;
#define POOL_ACC(sgn, VV) do { const v4u q_ = (VV); s[0] += sgn bflo(q_.x); s[1] += sgn bfhi(q_.x); s[2] += sgn bflo(q_.y); s[3] += sgn bfhi(q_.y); s[4] += sgn bflo(q_.z); s[5] += sgn bfhi(q_.z); s[6] += sgn bflo(q_.w); s[7] += sgn bfhi(q_.w); } while (0)
#pragma unroll
    for (int j = 0; j < WIN - 1; ++j) POOL_ACC(+, r[j]);
#pragma unroll
    for (int i = 0; i < 8; ++i) { const v4u self = r[WIN - 1 + i]; POOL_ACC(+, self);
        const int n = (tl0 + i + 1) < WIN ? (tl0 + i + 1) : WIN; const float inv = 1.0f / (float)n;
        v4u o; o.x = pk2(s[0] * inv - bflo(self.x), s[1] * inv - bfhi(self.x)); o.y = pk2(s[2] * inv - bflo(self.y), s[3] * inv - bfhi(self.y));
        o.z = pk2(s[4] * inv - bflo(self.z), s[5] * inv - bfhi(self.z)); o.w = pk2(s[6] * inv - bflo(self.w), s[7] * inv - bfhi(self.w));
        *(v4u*)(P + (size_t)(t0 + i) * D + col) = o;
        POOL_ACC(-, r[i]); }
#undef POOL_ACC
}
__device__ __forceinline__ void pooled_phase(Frame& F) {
    const bf16* H = (const bf16*)(F.ws + WS_H); bf16* P = (bf16*)(F.ws + WS_OAB);
    const int gt = F.vcu * 512 + F.tid, NT = F.G * 512;
    for (int it = gt; it < (NTOK / 8) * 128; it += NT) {
        const int c = it & 31, g = __builtin_amdgcn_readfirstlane((it >> 6) & 3), tb = ((it >> 8) << 1) | ((it >> 5) & 1);
        const int t0 = tb * 8, tl0 = t0 & (SEQ - 1), col = g * 256 + c * 8;
        if (g == 0) pooled_block<2>(H, P, t0, tl0, col); else if (g == 1) pooled_block<4>(H, P, t0, tl0, col); else if (g == 2) pooled_block<8>(H, P, t0, tl0, col); else pooled_block<16>(H, P, t0, tl0, col);
    }
}


#ifndef PH_MASK
#define PH_MASK 0xFFFFFF
#endif
#define IN(k) (((PH_MASK >> (k)) & 1) && lo <= (k) && (k) < hi)
#define BOTH(k) (IN(k) && IN((k) + 1))
#if MK_ONE_LAUNCH
#define GRID_BAR() xcd_barrier(bar)
#else
#define GRID_BAR() do { } while (0)
#endif
template <int LAYER>
__device__ __forceinline__ void moe_phases(Frame& F, const XcdBarrier& bar, const int lo, const int hi) {
    constexpr int pb = LAYER == 0 ? 7 : 13;
    bf16* const H = (bf16*)(F.ws + WS_H);
    const float* const MOD = (const float*)(F.ws + WS_MOD);
    if (IN(pb)) {
        moe_route(F, LAYER); if (BOTH(pb)) GRID_BAR(); }
    if (IN(pb + 1)) {
        build_moe_tables(F, LAYER);
        pg8::Gemm g{(const bf16*)H, 1024, 1024}; MoeSched S; S.init((const LAS int*)(F.lds + SCHED_OFF), F.G, (int)blockIdx.x, (const int*)(F.ws + WS_RT), F.ws + WS_WGU, 1024, 1024);
        EpiSwiglu E{(bf16*)(F.ws + WS_ACT)};
        if (LAYER == 0) moe_tail_plan(F);
        pg8::gemm_phase<EpiSwiglu, MoeSched>(F.lds + RING_OFF, g, S, E);
        if (LAYER == 0) {
            const LAS int* T = (const LAS int*)(F.lds + SCHED_OFF); const int sp = T[67];
            if (sp > 0) { __syncthreads(); const int f = T[65] * 8 * TQ_GU; int e = f + sp * 8 * TQ_GU; e = e < CQ_ND ? e : CQ_ND; convert_range(F, 1, f, e, F.wave, 8); } }
        if (BOTH(pb + 1)) GRID_BAR();
    }
    if (IN(pb + 2)) {
        build_moe_tables(F, LAYER);
        pg8::Gemm g{(const bf16*)(F.ws + WS_ACT), 512, 512}; MoeSched S; S.init((const LAS int*)(F.lds + SCHED_OFF), F.G, (int)blockIdx.x, nullptr, F.ws + (LAYER ? WS_WD1 : WS_WD), 512, 512);
        EpiStoreBf16 E{(bf16*)(F.ws + WS_Y), D};
        if (LAYER == 0) moe_tail_plan(F);
        pg8::gemm_phase<EpiStoreBf16, MoeSched>(F.lds + RING_OFF, g, S, E);
        if (LAYER == 0) {
            const LAS int* T = (const LAS int*)(F.lds + SCHED_OFF); const int sp = T[67];
            int t8 = T[66] * 8 * TQ_GU; t8 = t8 < CQ_ND ? t8 : CQ_ND;
            if (sp > 0) { __syncthreads(); const int f = t8 + T[65] * 8 * TQ_DN; int e = f + sp * 8 * TQ_DN; e = e < CQ_N ? e : CQ_N; convert_range(F, 1, f, e, F.wave, 8); } }
        if (BOTH(pb + 2)) GRID_BAR();
    }
    if (IN(pb + 3)) {
        build_moe_tables(F, LAYER);
        if (LAYER == 0) moe_tail_plan(F);
        const int tokw = F.vcu * 128 + F.wave * 16, b = (F.vcu * 128) / SEQ;
        f32x4 g2[4];
#pragma unroll
        for (int j = 0; j < 4; ++j) g2[j] = *((const f32x4*)(MOD + (size_t)(LAYER * 2 + b) * 6144 + 5 * 1024) + F.lane + 64 * j);
        if (LAYER == 0) {
            const ModVec m1 = load_mod(F.in[I_NMIX] + D, MOD + (size_t)(2 + b) * 6144 + 1024, MOD + (size_t)(2 + b) * 6144, F.lane);
            { const CombRecs recs = comb_load_recs(F, tokw); CombRows cur, nxt; comb_issue(F, recs, 0, tokw, cur);
              for (int i = 0; i < 16; ++i) { const int t = tokw + i;
                  if (i + 1 < 16) comb_issue(F, recs, i + 1, t + 1, nxt);
                  const RowVec x = comb_finish(recs, i, cur, g2);
                  store_row_bf16((bf16*)(F.ws + WS_XRB) + (size_t)t * D, F.lane, x); store_row_bf16(H + (size_t)t * D, F.lane, apply_mod(x, row_rstd(x), m1));
                  cur = nxt; } }
            __syncthreads();
            { const LAS int* T = (const LAS int*)(F.lds + SCHED_OFF);
              int t8 = T[66] * 8 * TQ_GU; t8 = t8 < CQ_ND ? t8 : CQ_ND; int t9 = t8 + T[66] * 8 * TQ_DN; t9 = t9 < CQ_N ? t9 : CQ_N;
              convert_range(F, 1, t9, CQ_N, F.vcu * NWAVES + F.wave, F.G * NWAVES); }
        } else {
            f32x4 fw[4];
#pragma unroll
            for (int j = 0; j < 4; ++j) fw[j] = *((const f32x4*)F.in[I_FNW] + F.lane + 64 * j);
            { const CombRecs recs = comb_load_recs(F, tokw); CombRows cur, nxt; comb_issue(F, recs, 0, tokw, cur);
              for (int i = 0; i < 16; ++i) { const int t = tokw + i;
                  if (i + 1 < 16) comb_issue(F, recs, i + 1, t + 1, nxt);
                  RowVec x = comb_finish(recs, i, cur, g2); const float rstd = row_rstd(x);
#pragma unroll
                  for (int j = 0; j < 4; ++j) x.v[j] = x.v[j] * rstd * fw[j];
                  store_row_f32(F.out + (size_t)t * D, F.lane, x);
                  cur = nxt; } }
        }
        if (BOTH(pb + 3)) GRID_BAR();
    }
}

constexpr int PH_P0 = 0, PH_P1 = 1, PH_INPROJ = 2, PH_ATT = 3, PH_SCAN = 4, PH_DNOUT = 5, PH_OUTPROJ = 6, PH_MOE0 = 7, PH_POOLED = 11, PH_POOLG = 12, PH_MOE1 = 13;
constexpr int N_PHASES = 17;
struct Args { const float* in[24]; float* out; unsigned char* ws; int ph_lo, ph_hi; };
__global__ void __launch_bounds__(NWAVES * 64, 2) trunk_fwd(Args args) {
    __shared__ __attribute__((aligned(16))) unsigned char lds[LDS_BYTES];
    Frame F;
    F.lds = (LAS unsigned char*)lds;
    F.MISC = (volatile LAS unsigned*)(F.lds + MISC_OFF);
    F.tid = threadIdx.x; F.lane = F.tid & 63; F.wave = __builtin_amdgcn_readfirstlane(F.tid >> 6);
    F.G = gridDim.x; { const int bx = blockIdx.x; F.vcu = (F.G % 8 == 0) ? (bx % 8) * (F.G / 8) + bx / 8 : bx; }
#pragma unroll
    for (int i = 0; i < 24; ++i) F.in[i] = args.in[i];
    F.out = args.out; F.ws = args.ws; F.ctl = (gu32*)(args.ws + WS_CTL);
    for (int u = F.tid; u < (LDS_BYTES - LDSCTL_OFF) / 4; u += NWAVES * 64) ((LAS unsigned*)(F.lds + LDSCTL_OFF))[u] = 0u;
    __syncthreads();
#if MK_ONE_LAUNCH
    XcdBarrier bar = xcd_barrier_post((unsigned*)(F.ctl + CW_BAR), F.MISC + 8);
#else
    XcdBarrier bar; bar.bar = nullptr; bar.x = 0; bar.st = nullptr;
#endif
    const int lo = args.ph_lo, hi = args.ph_hi;
    bf16* const H = (bf16*)(F.ws + WS_H);
    const float* const MOD = (const float*)(F.ws + WS_MOD);

    if (IN(PH_P0)) { p0_prologue(F); if (BOTH(PH_P0)) GRID_BAR(); }
    if (IN(PH_P1)) { p1_prenorm0(F); if (BOTH(PH_P1)) GRID_BAR(); }
    if (IN(PH_INPROJ)) {
        pg8::Gemm g{(const bf16*)H, 1024, 1024}; DenseSched S; S.init(NTOK, PIN, F.G, (int)blockIdx.x, 1024, 0, F.ws + WS_WIN, 1024);
        EpiStoreBf16 E{(bf16*)(F.ws + WS_PROJ), PIN};
        pg8::gemm_phase<EpiStoreBf16, DenseSched>(F.lds + RING_OFF, g, S, E);
        if (IP_FULL && (int)blockIdx.x >= IP_FULL) {
            __syncthreads(); const int r = (int)blockIdx.x - IP_FULL; convert_range(F, 0, r * 8 * TQ_INPROJ, (r + 1) * 8 * TQ_INPROJ, F.wave, 8); }
        if (BOTH(PH_INPROJ)) GRID_BAR();
    }
    if (IN(PH_ATT)) { dn_prep(F); if (BOTH(PH_ATT)) GRID_BAR(); }
    if (IN(PH_SCAN)) {
        if (F.vcu < 32) dn_scan(F);
        else { attn_phase(F, F.vcu - 32, F.G - 32); __syncthreads(); convert_range(F, 0, CQ_T2, CQ_N, (F.vcu - 32) * NWAVES + F.wave, (F.G - 32) * NWAVES); }
        if (BOTH(PH_SCAN)) GRID_BAR(); }
    if (IN(PH_DNOUT)) { dn_output(F); if (BOTH(PH_DNOUT)) GRID_BAR(); }
    if (IN(PH_OUTPROJ)) {
        pg8::Gemm g{(const bf16*)(F.ws + WS_OAB), 1024, 1024}; DenseSched S; S.init(NTOK, D, F.G, (int)blockIdx.x, 1024, 0, F.ws + WS_WOUT, 1024);
        EpiResid<true> E{F.in[I_X], (bf16*)(F.ws + WS_XRB), MOD + 2 * 1024, nullptr};
        pg8::gemm_phase<EpiResid<true>, DenseSched>(F.lds + RING_OFF, g, S, E);
        if (BOTH(PH_OUTPROJ)) GRID_BAR();
    }
    moe_phases<0>(F, bar, lo, hi);
    if (IN(PH_POOLED)) { pooled_phase(F); if (BOTH(PH_POOLED)) GRID_BAR(); }
    if (IN(PH_POOLG)) {
        pg8::Gemm g{(const bf16*)(F.ws + WS_OAB), 256, 256}; DenseSched S; S.init(NTOK, D, F.G, (int)blockIdx.x, 1024, 256, F.ws + WS_POOLW, 256);
        EpiResid<false> E{nullptr, (bf16*)(F.ws + WS_XRB), MOD + (size_t)2 * 6144 + 2 * 1024, F.in[I_POOLS]};
        pg8::gemm_phase<EpiResid<false>, DenseSched>(F.lds + RING_OFF, g, S, E);
        if (BOTH(PH_POOLG)) GRID_BAR();
    }
    moe_phases<1>(F, bar, lo, hi);
#undef IN
#undef BOTH
}

extern "C" void kernel_launch(void* const* d_in, const int* in_sizes, int n_in, void* d_out, int out_size, void* d_ws, size_t ws_size, hipStream_t stream) {
    static int grid = 0;
    if (grid == 0) {
        if (n_in != 24 || in_sizes[0] != NTOK * D || out_size != NTOK * D || ws_size < WS_END2) { fprintf(stderr, "kernel_launch: unexpected shapes (n_in %d, in0 %d, out %d, ws %zu); nothing launched\n", n_in, n_in > 0 ? in_sizes[0] : -1, out_size, ws_size); grid = -1; return; }
        int per_cu = 0;
        if (hipOccupancyMaxActiveBlocksPerMultiprocessor(&per_cu, (const void*)trunk_fwd, NWAVES * 64, 0) != hipSuccess || per_cu < 1) fprintf(stderr, "kernel_launch: occupancy query says %d\n", per_cu);
        (void)hipGetLastError();
        grid = 256;
    }
    if (grid < 0) return;
    if (hipMemsetAsync((char*)d_ws + WS_CTL, 0, CTL_ZERO_BYTES, stream) != hipSuccess) { fprintf(stderr, "kernel_launch: memset failed\n"); return; }
    Args a{};
    for (int i = 0; i < 24; ++i) a.in[i] = (const float*)d_in[i];
    a.out = (float*)d_out; a.ws = (unsigned char*)d_ws;
#if MK_ONE_LAUNCH
    a.ph_lo = 0; a.ph_hi = N_PHASES;
    hipLaunchKernelGGL(trunk_fwd, dim3(grid), dim3(NWAVES * 64), 0, stream, a);
#else
    for (int p = 0; p < N_PHASES; ++p) { a.ph_lo = p; a.ph_hi = p + 1; hipLaunchKernelGGL(trunk_fwd, dim3(grid), dim3(NWAVES * 64), 0, stream, a); }
#endif
}
```

```cpp
#include <hip/hip_runtime.h>
#include <cstdio>
#include <cstdint>

#ifndef MK_ONE_LAUNCH
#define MK_ONE_LAUNCH 1
#endif

#define GAS __attribute__((address_space(1)))
#define LAS __attribute__((address_space(3)))
typedef unsigned short bf16;
typedef unsigned v4u __attribute__((ext_vector_type(4)));
typedef unsigned v2u __attribute__((ext_vector_type(2)));
typedef float f32x4 __attribute__((ext_vector_type(4)));
typedef float f32x2 __attribute__((ext_vector_type(2)));
typedef float f32x16 __attribute__((ext_vector_type(16)));
typedef short bf16x8 __attribute__((ext_vector_type(8)));
typedef GAS unsigned gu32;
#define RLX_AGENT __ATOMIC_RELAXED, __HIP_MEMORY_SCOPE_AGENT
#define LDS_WAIT() asm volatile("s_waitcnt lgkmcnt(0)" ::: "memory")
#define VM_WAIT() asm volatile("s_waitcnt vmcnt(0)" ::: "memory")

constexpr int BATCH = 2, SEQ = 16384, D = 1024, NTOK = BATCH * SEQ;
constexpr int PIN = 2816;
constexpr int PC_QA = 0, PC_KA = 512, PC_VA = 1024, PC_ZA = 1536, PC_QB = 2048, PC_KB = 2560, PC_VB = 2688;
constexpr int NEXP = 32, DFF = 512;
constexpr int MAXTILES = NTOK * 2 / 256 + NEXP;
constexpr float EPS = 1e-6f;
constexpr int NWAVES = 8;

constexpr size_t MiB = 1u << 20;
constexpr size_t WS_CTL = 0, CTL_ZERO_BYTES = 1 * MiB;
constexpr size_t WS_MOD = 1 * MiB;
constexpr size_t WS_WBA = 1 * MiB + 128 * 1024;
constexpr size_t WS_ROUTE = 2 * MiB;
constexpr size_t WS_RT = 3 * MiB;
constexpr size_t WS_BG = 7 * MiB;
constexpr size_t WS_WIN = 10 * MiB;
constexpr size_t WS_WOUT = 16 * MiB;
constexpr size_t WS_POOLW = 18 * MiB;
constexpr size_t WS_WGU = 20 * MiB;
constexpr size_t WS_WD = 84 * MiB;
constexpr size_t WS_H = 116 * MiB;
constexpr size_t WS_PROJ = 180 * MiB;
constexpr size_t WS_OAB = 356 * MiB;
constexpr size_t WS_YM = 180 * MiB;
constexpr size_t WS_ACT = 180 * MiB;
constexpr size_t WS_Y = 252 * MiB;
constexpr size_t WS_END = 420 * MiB;
constexpr size_t WS_DN_MT = WS_H;
constexpr size_t WS_DN_QPT = WS_H + 32 * MiB;
constexpr size_t WS_DN_BM = 420 * MiB, WS_DN_O0T = 452 * MiB, WS_DN_S = 484 * MiB;
constexpr size_t WS_DN_GT = 9 * MiB;
constexpr size_t WS_XRB = 420 * MiB;
constexpr size_t WS_WGT = 484 * MiB;
constexpr size_t WS_END2 = 516 * MiB;
constexpr int CW_CNT = 64;
constexpr int CW_BAR = 4096;
constexpr int CW_BAD = 200;

constexpr int RING_OFF = 0, RING_BYTES = 131072;
constexpr int LDSCTL_OFF = RING_BYTES, MISC_OFF = LDSCTL_OFF + 320;
constexpr int SCHED_OFF = LDSCTL_OFF + 1024;
constexpr int LDS_BYTES = 163840;
constexpr int R1W_OFF = 135168;
constexpr int RT_LDS_OFF = 151552;

typedef __bf16 bf16x2_t __attribute__((ext_vector_type(2)));
__device__ __forceinline__ unsigned pk2(float lo, float hi) { bf16x2_t v; v.x = (__bf16)lo; v.y = (__bf16)hi; return __builtin_bit_cast(unsigned, v); }
__device__ __forceinline__ unsigned f2bf(float f) { return pk2(f, 0.f) & 0xffffu; }
__device__ __forceinline__ float bf2f(unsigned b) { return __builtin_bit_cast(float, b << 16); }
__device__ __forceinline__ float bflo(unsigned w) { return __builtin_bit_cast(float, w << 16); }
__device__ __forceinline__ float bfhi(unsigned w) { return __builtin_bit_cast(float, w & 0xffff0000u); }
template <int CTRL> __device__ __forceinline__ float dpp_f(float v) { return __builtin_bit_cast(float, __builtin_amdgcn_update_dpp(0, __builtin_bit_cast(int, v), CTRL, 0xf, 0xf, false)); }
__device__ __forceinline__ float quad_sum(float v) { v += dpp_f<0xB1>(v); v += dpp_f<0x4E>(v); return v; }
__device__ __forceinline__ float oct_sum(float v) { v = quad_sum(v); v += dpp_f<0x141>(v); return v; }
__device__ __forceinline__ float wave_sum(float v) {
    v = oct_sum(v); v += dpp_f<0x140>(v);
    const float r0 = __builtin_bit_cast(float, __builtin_amdgcn_readlane(__builtin_bit_cast(int, v), 0)), r1 = __builtin_bit_cast(float, __builtin_amdgcn_readlane(__builtin_bit_cast(int, v), 16));
    const float r2 = __builtin_bit_cast(float, __builtin_amdgcn_readlane(__builtin_bit_cast(int, v), 32)), r3 = __builtin_bit_cast(float, __builtin_amdgcn_readlane(__builtin_bit_cast(int, v), 48));
    return (r0 + r1) + (r2 + r3);
}
__device__ __forceinline__ float rl(float x, int l) { return __builtin_bit_cast(float, __builtin_amdgcn_readlane(__builtin_bit_cast(int, x), l)); }
__device__ __forceinline__ float silu_f(float x) { return x / (1.f + __expf(-x)); }
__device__ __forceinline__ float sigmoid_f(float x) { return 1.f / (1.f + __expf(-x)); }
__device__ __forceinline__ float softplus_f(float x) { return x > 20.f ? x : log1pf(__expf(x)); }

namespace pg8 {
#define PG8_LAS __attribute__((address_space(3)))
typedef unsigned short bf16_t;
typedef unsigned u32x4 __attribute__((ext_vector_type(4)));
constexpr int BM = 256, BK = 64, HALF = 128, HTB = HALF * BK * 2, STAGE_BYTES = 8 * HTB;

__host__ __device__ __forceinline__ int lds_byte(int r, int c) { const int st = (r >> 4) * 2 + (c >> 5), rr = r & 15, cc = c & 31, ob = rr * 64 + cc * 2; return st * 1024 + (ob ^ (((ob >> 9) & 1) << 5)); }
__host__ __device__ __forceinline__ void stage_rc(int b, int& R, int& C) { const int st = b / 1024, sb = b % 1024, swz = sb ^ (((sb >> 9) & 1) << 5); R = (st >> 1) * 16 + swz / 64; C = (st & 1) * 32 + (swz % 64) / 2; }
__host__ __device__ __forceinline__ int perm32(int rho) { const int n = rho >> 4, i = rho & 15; return 8 * (i >> 2) + 4 * n + (i & 3); }

struct Unit { int pm, pn, e; };
struct Gemm { const bf16_t* A; int K, ldb; };

template <class Epi, class Sched>
__device__ __forceinline__ void gemm_phase(PG8_LAS unsigned char* lds, const Gemm g, const Sched& S, const Epi& E) {
    const int tid = threadIdx.x, wid = __builtin_amdgcn_readfirstlane(tid >> 6), lane = tid & 63, wr = wid >> 2, wc = wid & 3, fr = lane & 15, fq = lane >> 4;
    const int K = g.K, nt = K / BK;
    int R0, C0, R1, C1; stage_rc(tid * 16, R0, C0); stage_rc(tid * 16 + 8192, R1, C1);
    const int Rb0 = (R0 & ~31) + perm32(R0 & 31), Rb1 = (R1 & ~31) + perm32(R1 & 31);
    const unsigned voffB0 = (unsigned)(Rb0 * g.ldb + C0) * 2u, voffB1 = (unsigned)(Rb1 * g.ldb + C1) * 2u;
    const size_t kstep = (size_t)(BK * 2);
    const size_t hstepB = (size_t)HALF * g.ldb * 2;
    const unsigned ldsw = (unsigned)wid * 1024u;
    const int aoff = lds_byte(wr * 64 + fr, fq * 8), boff = lds_byte(wc * 32 + fr, fq * 8);
    const char* Ab = (const char*)g.A;
#define PG8_SA(b, h) (((b) * 2 + (h)) * HTB)
#define PG8_SB(b, h) ((4 + (b) * 2 + (h)) * HTB)
#define PG8_ST2(bufoff, gbase, v0, v1) do { \
        __builtin_amdgcn_global_load_lds((const unsigned*)((const char*)(gbase) + (v0)), (PG8_LAS unsigned*)(lds + (bufoff) + ldsw), 16, 0, 0); \
        __builtin_amdgcn_global_load_lds((const unsigned*)((const char*)(gbase) + (v1)), (PG8_LAS unsigned*)(lds + (bufoff) + ldsw + 8192), 16, 0, 0); } while (0)
#define PG8_STB(bufoff, gbase) PG8_ST2(bufoff, gbase, voffB0, voffB1)
#define PG8_LDA(dst, b, h) do { _Pragma("unroll") for (int m = 0; m < 4; ++m) _Pragma("unroll") for (int k = 0; k < 2; ++k) dst[m][k] = *(const PG8_LAS bf16x8*)(lds + PG8_SA(b, h) + aoff + m * 2048 + k * 1024); } while (0)
#define PG8_LDB(dst, b, h) do { _Pragma("unroll") for (int n = 0; n < 2; ++n) _Pragma("unroll") for (int k = 0; k < 2; ++k) dst[n][k] = *(const PG8_LAS bf16x8*)(lds + PG8_SB(b, h) + boff + n * 2048 + k * 1024); } while (0)
#define PG8_MMA(ai, bj, At, Bt) do { __builtin_amdgcn_s_setprio(1); _Pragma("unroll") for (int m = 0; m < 4; ++m) _Pragma("unroll") for (int n = 0; n < 2; ++n) _Pragma("unroll") for (int k = 0; k < 2; ++k) \
        acc[ai][bj][m][n] = __builtin_amdgcn_mfma_f32_16x16x32_bf16(Bt[n][k], At[m][k], acc[ai][bj][m][n], 0, 0, 0); __builtin_amdgcn_s_setprio(0); } while (0)
#define PG8_WAIT_V(n) asm volatile("s_waitcnt vmcnt(" #n ")" ::: "memory")
#define PG8_WAIT_L(n) asm volatile("s_waitcnt lgkmcnt(" #n ")" ::: "memory")
#define PG8_BAR __builtin_amdgcn_s_barrier()
#define PG8_SCHED __builtin_amdgcn_sched_barrier(0)
    Unit cur, nxt; int ui = 0;
    if (!S.next(0, cur)) return;
    f32x4 acc[2][2][4][2];
#pragma unroll
    for (int a = 0; a < 2; ++a)
#pragma unroll
        for (int b = 0; b < 2; ++b)
#pragma unroll
            for (int m = 0; m < 4; ++m)
#pragma unroll
                for (int n = 0; n < 2; ++n) acc[a][b][m][n] = (f32x4){0.f, 0.f, 0.f, 0.f};
    bf16x8 At[4][2], B0[2][2], B1[2][2];
    unsigned c00, c01, c10, c11;
#define PG8_AOFF(u, d00, d01, d10, d11) do { \
        d00 = S.a_off(u, R0) + (unsigned)C0 * 2u; d01 = S.a_off(u, R1) + (unsigned)C1 * 2u; \
        d10 = S.a_off(u, HALF + R0) + (unsigned)C0 * 2u; d11 = S.a_off(u, HALF + R1) + (unsigned)C1 * 2u; } while (0)
    PG8_AOFF(cur, c00, c01, c10, c11);
    const char* cB = S.b_ptr(cur);
    PG8_STB(PG8_SB(0, 0), cB); PG8_STB(PG8_SB(0, 1), cB + hstepB); PG8_ST2(PG8_SA(0, 0), Ab, c00, c01); PG8_ST2(PG8_SA(0, 1), Ab, c10, c11);
    if (wr == 1) PG8_BAR;
    PG8_WAIT_V(2); PG8_BAR;
    PG8_STB(PG8_SB(1, 0), cB + kstep); PG8_ST2(PG8_SA(1, 0), Ab + kstep, c00, c01); PG8_STB(PG8_SB(1, 1), cB + hstepB + kstep);
    PG8_WAIT_V(6); PG8_BAR;
    for (;;) {
        const bool has_next = S.next(ui + 1, nxt);
        const char* nB = has_next ? S.b_ptr(nxt) : cB;
#pragma unroll 1
        for (int t = 0; t < nt; t += 2) {
            const bool last = (t == nt - 2);
            const char* a1 = Ab + (size_t)(t + 1) * kstep;
            const char* a2 = last ? Ab : Ab + (size_t)(t + 2) * kstep; const char* b2 = last ? nB : cB + (size_t)(t + 2) * kstep;
            const char* a3 = a2 + kstep; const char* b3 = b2 + kstep;
            PG8_LDB(B0, 0, 0); PG8_LDB(B1, 0, 1); PG8_SCHED; PG8_LDA(At, 0, 0); PG8_ST2(PG8_SA(1, 1), a1, c10, c11);
            PG8_WAIT_V(8); PG8_WAIT_L(0); PG8_BAR; PG8_MMA(0, 0, At, B0); PG8_MMA(0, 1, At, B1); PG8_BAR; PG8_SCHED;
            if (last && has_next) { PG8_AOFF(nxt, c00, c01, c10, c11); }
            PG8_LDA(At, 0, 1); PG8_STB(PG8_SB(0, 0), b2); PG8_STB(PG8_SB(0, 1), b2 + hstepB); PG8_ST2(PG8_SA(0, 0), a2, c00, c01);
            PG8_WAIT_V(8); PG8_WAIT_L(0); PG8_BAR; PG8_MMA(1, 0, At, B0); PG8_MMA(1, 1, At, B1); PG8_BAR; PG8_SCHED;
            PG8_LDB(B0, 1, 0); PG8_LDB(B1, 1, 1); PG8_SCHED; PG8_LDA(At, 1, 0); PG8_ST2(PG8_SA(0, 1), a2, c10, c11);
            PG8_WAIT_V(8); PG8_WAIT_L(0); PG8_BAR; PG8_MMA(0, 0, At, B0); PG8_MMA(0, 1, At, B1); PG8_BAR; PG8_SCHED;
            PG8_LDA(At, 1, 1); PG8_STB(PG8_SB(1, 0), b3); PG8_STB(PG8_SB(1, 1), b3 + hstepB); PG8_ST2(PG8_SA(1, 0), a3, c00, c01);
            PG8_WAIT_V(8); PG8_WAIT_L(0); PG8_BAR; PG8_MMA(1, 0, At, B0); PG8_MMA(1, 1, At, B1); PG8_BAR; PG8_SCHED;
        }
        if (wr == 0) PG8_BAR;
        E(acc, cur, wr, wc, fr, fq);
        if (!has_next) break;
#pragma unroll
        for (int a = 0; a < 2; ++a)
#pragma unroll
            for (int b = 0; b < 2; ++b)
#pragma unroll
                for (int m = 0; m < 4; ++m)
#pragma unroll
                    for (int n = 0; n < 2; ++n) acc[a][b][m][n] = (f32x4){0.f, 0.f, 0.f, 0.f};
        cur = nxt; cB = nB; ++ui;
        if (wr == 1) PG8_BAR;
    }
    PG8_WAIT_V(0);
    PG8_BAR;
#undef PG8_SA
#undef PG8_SB
#undef PG8_ST2
#undef PG8_STB
#undef PG8_LDA
#undef PG8_LDB
#undef PG8_MMA
#undef PG8_WAIT_V
#undef PG8_WAIT_L
#undef PG8_BAR
#undef PG8_SCHED
#undef PG8_AOFF
}
}

#define XB_TMO      128
#define XB_XCNT(j)  (256  + 64 * (j))
#define XB_XSUB(j)  (1280 + 64 * (j))
#define XB_XGEN(j)  (2304 + 64 * (j))
#define XB_TOP      3328
#define XB_TOPGEN   3392
#define XCD_BAR_WORDS 3456
#define XB_SPIN_CAP (1u << 22)

__device__ __forceinline__ unsigned xb_ld(unsigned* p)              { return __hip_atomic_load(p, __ATOMIC_RELAXED, __HIP_MEMORY_SCOPE_AGENT); }
__device__ __forceinline__ unsigned xb_add(unsigned* p, unsigned v) { return __hip_atomic_fetch_add(p, v, __ATOMIC_RELAXED, __HIP_MEMORY_SCOPE_AGENT); }
__device__ __forceinline__ unsigned xb_xcc_id() { return (unsigned)__builtin_amdgcn_s_getreg((3 << 11) | 20) & 0xFu; }
#define XB_SPIN(cond, bar) do { unsigned _sp = 0; while (cond) { __builtin_amdgcn_s_sleep(1); \
    if ((++_sp & 255u) == 0u) { if (xb_ld(&(bar)[XB_TMO])) break; if (_sp > XB_SPIN_CAP) { atomicAdd(&(bar)[XB_TMO], 1u); break; } } } } while (0)

struct XcdBarrier { unsigned* bar; unsigned x; volatile LAS unsigned* st; };

__device__ __forceinline__ XcdBarrier xcd_barrier_post(unsigned* bar, volatile LAS unsigned* st) {
    XcdBarrier b; b.bar = bar; b.x = xb_xcc_id(); b.st = st;
    if (threadIdx.x == 0) (void)xb_add(&bar[XB_XCNT(b.x)], 1u);
    return b;
}
__device__ __forceinline__ void xcd_barrier_complete(unsigned* bar, unsigned x, unsigned& nloc, unsigned& nx) {
    const unsigned G = gridDim.x * gridDim.y * gridDim.z;
    unsigned sum, cnt, mine, sp = 0u;
    for (;;) {
        sum = 0u; cnt = 0u; mine = 0u;
#pragma unroll
        for (unsigned j = 0; j < 16; ++j) { const unsigned c = xb_ld(&bar[XB_XCNT(j)]); sum += c; cnt += (c > 0u) ? 1u : 0u; mine = (j == x) ? c : mine; }
        if (sum == G) break;
        __builtin_amdgcn_s_sleep(1);
        if ((++sp & 255u) == 0u) { if (xb_ld(&bar[XB_TMO])) break; if (sp > XB_SPIN_CAP) { atomicAdd(&bar[XB_TMO], 1u); break; } }
    }
    nloc = mine > 0u ? mine : 1u; nx = cnt > 0u ? cnt : 1u;
}
__device__ __forceinline__ void xcd_barrier(const XcdBarrier& b) {
    asm volatile("s_waitcnt vmcnt(0)" ::: "memory");
    __syncthreads();
    if (threadIdx.x == 0) {
        unsigned* bar = b.bar;
        __builtin_amdgcn_s_waitcnt(0);
        unsigned nloc = b.st[0], nx = b.st[1];
        if (nloc == 0u) { xcd_barrier_complete(bar, b.x, nloc, nx); b.st[0] = nloc; b.st[1] = nx; }
        const unsigned old = xb_add(&bar[XB_XSUB(b.x)], 1u);
        const unsigned gen = old / nloc;
        if (old + 1u == (gen + 1u) * nloc) {
            __builtin_amdgcn_fence(__ATOMIC_RELEASE, "agent");
            asm volatile("s_waitcnt vmcnt(0)" ::: "memory");
            const unsigned og = xb_add(&bar[XB_TOP], 1u);
            const unsigned tg = og / nx;
            if (og + 1u == (tg + 1u) * nx) xb_add(&bar[XB_TOPGEN], 1u);
            else XB_SPIN(xb_ld(&bar[XB_TOPGEN]) == tg, bar);
            __builtin_amdgcn_fence(__ATOMIC_ACQUIRE, "agent");
            xb_add(&bar[XB_XGEN(b.x)], 1u);
            asm volatile("s_waitcnt vmcnt(0)" ::: "memory");
        } else {
            XB_SPIN(xb_ld(&bar[XB_XGEN(b.x)]) == gen, bar);
            __builtin_amdgcn_fence(__ATOMIC_ACQUIRE, "agent");
            asm volatile("s_waitcnt vmcnt(0)" ::: "memory");
        }
    }
    __syncthreads();
}

struct Frame {
    LAS unsigned char* lds;
    volatile LAS unsigned* MISC;
    gu32* ctl;
    int tid, lane, wave, vcu, G;
    const float* in[24];
    float* out;
    unsigned char* ws;
};
enum { I_X = 0, I_C, I_ADAW, I_ADAB, I_NMIX, I_NFFN, I_WIN, I_CONVW, I_ALOG, I_DTB, I_ONORM, I_SINKS, I_RELB, I_WOUT, I_POOLW, I_POOLS, I_R1W, I_R1B, I_R2W, I_R2B, I_WG, I_WU, I_WDN, I_FNW };

__device__ __forceinline__ void p0_transpose_item(const float* W, int ldw, int K, bf16* WT, int dst_row0, LAS float* scr, int k0, int n0, int lane) {
    f32x4 w4[8];
#pragma unroll
    for (int i = 0; i < 8; ++i) { const int f = i * 64 + lane, kk = f >> 3, c4 = f & 7; w4[i] = __builtin_nontemporal_load((const f32x4*)(W + (size_t)(k0 + kk) * ldw + n0 + c4 * 4)); }
#pragma unroll
    for (int i = 0; i < 8; ++i) { const int f = i * 64 + lane, kk = f >> 3, c4 = f & 7; LAS float* d = scr + kk * 33 + c4 * 4; d[0] = w4[i].x; d[1] = w4[i].y; d[2] = w4[i].z; d[3] = w4[i].w; }
    LDS_WAIT(); asm volatile("" ::: "memory");
    const int c = lane & 7;
#pragma unroll
    for (int j = 0; j < 4; ++j) { const int n = (lane >> 3) + 8 * j; const LAS float* s = scr + (8 * c) * 33 + n;
        v4u o; o.x = pk2(s[0 * 33], s[1 * 33]); o.y = pk2(s[2 * 33], s[3 * 33]); o.z = pk2(s[4 * 33], s[5 * 33]); o.w = pk2(s[6 * 33], s[7 * 33]);
        __builtin_nontemporal_store(o, (GAS v4u*)(WT + (size_t)(dst_row0 + n) * K + k0 + 8 * c)); }
    LDS_WAIT(); asm volatile("" ::: "memory");
}
constexpr int CQ_NG = NEXP * 512, CQ_NGT = 16 * 512, CQ_N = NEXP * 768;
constexpr int TQ_INPROJ = 9, TQ_GU = 6, TQ_DN = 4;
constexpr int IP_FULL = ((NTOK / 256) * (PIN / 256)) % 256;
constexpr int CQ_T2 = IP_FULL ? (256 - IP_FULL) * 8 * TQ_INPROJ : 0;
__device__ __forceinline__ void convert_item(Frame& F, int layer, int it, LAS float* scr) {
    if (it < CQ_NG) {
        const int e = it >> 9, r = it & 511, up = r >> 8, q = r & 255, kb = q >> 4, nb = q & 15;
        const float* W = (up ? F.in[I_WU] : F.in[I_WG]) + (size_t)(layer * NEXP + e) * 1024 * 512;
        p0_transpose_item(W, 512, 1024, (bf16*)(F.ws + ((layer && e < 16) ? WS_WGT : WS_WGU)), e * 1024 + (nb >> 2) * 256 + up * 128 + (nb & 3) * 32, scr, kb * 64, nb * 32, F.lane);
    } else {
        const int r0 = it - CQ_NG, e = r0 >> 8, q = r0 & 255, kb = q >> 5, nb = q & 31;
        const float* W = F.in[I_WDN] + (size_t)(layer * NEXP + e) * 512 * 1024;
        p0_transpose_item(W, 1024, 512, (bf16*)(F.ws + WS_WD), e * 1024 + nb * 32, scr, kb * 64, nb * 32, F.lane);
    }
}
__device__ __forceinline__ void convert_range(Frame& F, int layer, int first, int end, int start, int stride) {
    LAS float* scr = (LAS float*)(F.lds + RING_OFF + F.wave * 16384);
    for (int it = first + start; it < end; it += stride) convert_item(F, layer, it, scr);
}
__device__ __forceinline__ void p0_prologue(Frame& F) {
    LAS float* scr = (LAS float*)(F.lds + RING_OFF + F.wave * 16384);
    const int gw = F.vcu * NWAVES + F.wave, NGW = F.G * NWAVES;
    constexpr int IA = 16 * 64, IB = 16 * 24, IO = 16 * 32, IP = 4 * 32, NIT = IA + IB + IO + IP;
    for (int it = gw; it < NIT; it += NGW) {
        int r = it;
        if (r < IA) { p0_transpose_item(F.in[I_WIN], 2832, 1024, (bf16*)(F.ws + WS_WIN), (r % 64) * 32, scr, (r / 64) * 64, (r % 64) * 32, F.lane); continue; } r -= IA;
        if (r < IB) { p0_transpose_item(F.in[I_WIN] + 2064, 2832, 1024, (bf16*)(F.ws + WS_WIN), 2048 + (r % 24) * 32, scr, (r / 24) * 64, (r % 24) * 32, F.lane); continue; } r -= IB;
        if (r < IO) { p0_transpose_item(F.in[I_WOUT], 1024, 1024, (bf16*)(F.ws + WS_WOUT), (r % 32) * 32, scr, (r / 32) * 64, (r % 32) * 32, F.lane); continue; } r -= IO;
        { const int g = r >> 5, q = r & 31; p0_transpose_item(F.in[I_POOLW] + (size_t)g * 65536, 256, 256, (bf16*)(F.ws + WS_POOLW) + (size_t)g * 65536, (q & 7) * 32, scr, (q >> 3) * 64, (q & 7) * 32, F.lane); }
    }
    { float* WBA = (float*)(F.ws + WS_WBA); const int gt = F.vcu * 512 + F.tid;
      if (gt < 16 * 1024) { const int o = gt >> 10, k = gt & 1023; WBA[o * 1024 + k] = F.in[I_WIN][(size_t)k * 2832 + 2048 + o]; } }
    __syncthreads();
    {
        LAS float* red = (LAS float*)(F.lds + RING_OFF);
        const int ks = F.tid >> 4, cj = F.tid & 15;
        for (int u = F.vcu; u < 192; u += F.G) {
            const int l = u / 96, cb = u % 96;
            const float* W = F.in[I_ADAW] + (size_t)l * 1024 * 6144 + cb * 64 + cj * 4;
            f32x4 a0 = {0.f, 0.f, 0.f, 0.f}, a1 = {0.f, 0.f, 0.f, 0.f};
            for (int k = ks * 32; k < ks * 32 + 32; ++k) {
                const f32x4 w = *(const f32x4*)(W + (size_t)k * 6144);
                const float c0 = silu_f(F.in[I_C][k]), c1 = silu_f(F.in[I_C][1024 + k]);
                a0 += w * c0; a1 += w * c1;
            }
            *(LAS f32x4*)(red + (ks * 2 + 0) * 64 + cj * 4) = a0; *(LAS f32x4*)(red + (ks * 2 + 1) * 64 + cj * 4) = a1;
            __syncthreads();
            if (F.tid < 128) { const int b = F.tid >> 6, c = F.tid & 63; float s = 0.f;
                for (int q = 0; q < 32; ++q) s += red[(q * 2 + b) * 64 + c];
                ((float*)(F.ws + WS_MOD))[(size_t)(l * 2 + b) * 6144 + cb * 64 + c] = s + F.in[I_ADAB][l * 6144 + cb * 64 + c]; }
            __syncthreads();
        }
    }
}

struct RowVec { f32x4 v[4]; };
__device__ __forceinline__ RowVec load_row_f32(const float* row, int lane) { RowVec r; const GAS f32x4* p = (const GAS f32x4*)row + lane;
#pragma unroll
    for (int j = 0; j < 4; ++j) r.v[j] = p[64 * j]; return r; }
__device__ __forceinline__ void store_row_f32(float* row, int lane, const RowVec& r) { GAS f32x4* p = (GAS f32x4*)row + lane;
#pragma unroll
    for (int j = 0; j < 4; ++j) p[64 * j] = r.v[j]; }
__device__ __forceinline__ void store_row_bf16(bf16* row, int lane, const RowVec& r) { GAS v2u* p = (GAS v2u*)row + lane;
#pragma unroll
    for (int j = 0; j < 4; ++j) { v2u o; o.x = pk2(r.v[j].x, r.v[j].y); o.y = pk2(r.v[j].z, r.v[j].w); p[64 * j] = o; } }
__device__ __forceinline__ void load_row_bf16(const bf16* row, int lane, v2u (&p)[4]) { const GAS v2u* q = (const GAS v2u*)row + lane;
#pragma unroll
    for (int j = 0; j < 4; ++j) p[j] = q[64 * j]; }
__device__ __forceinline__ RowVec unpack_row_bf16(const v2u (&p)[4]) { RowVec r;
#pragma unroll
    for (int j = 0; j < 4; ++j) { r.v[j].x = bflo(p[j].x); r.v[j].y = bfhi(p[j].x); r.v[j].z = bflo(p[j].y); r.v[j].w = bfhi(p[j].y); } return r; }
__device__ __forceinline__ float row_rstd(const RowVec& r) { float s = 0.f;
#pragma unroll
    for (int j = 0; j < 4; ++j) s += (r.v[j].x * r.v[j].x + r.v[j].y * r.v[j].y) + (r.v[j].z * r.v[j].z + r.v[j].w * r.v[j].w);
    return 1.0f / sqrtf(wave_sum(s) * (1.f / D) + EPS); }
struct ModVec { f32x4 a[4], b[4]; };
__device__ __forceinline__ ModVec load_mod(const float* w, const float* sc, const float* sh, int lane) { ModVec m;
#pragma unroll
    for (int j = 0; j < 4; ++j) { const f32x4 wv = *((const f32x4*)w + lane + 64 * j), s = *((const f32x4*)sc + lane + 64 * j); m.a[j] = wv * (s + 1.0f); m.b[j] = *((const f32x4*)sh + lane + 64 * j); }
    return m; }
__device__ __forceinline__ RowVec apply_mod(const RowVec& x, float rstd, const ModVec& m) { RowVec h;
#pragma unroll
    for (int j = 0; j < 4; ++j) h.v[j] = x.v[j] * rstd * m.a[j] + m.b[j]; return h; }

__device__ __forceinline__ void p1_prenorm0(Frame& F) {
    LAS float* wba = (LAS float*)(F.lds + RING_OFF);
    { const float* WBA = (const float*)(F.ws + WS_WBA); for (int i = F.tid; i < 16 * 256; i += 512) *((LAS f32x4*)wba + i) = *((const f32x4*)WBA + i); }
    __syncthreads();
    const float* mod = (const float*)(F.ws + WS_MOD);
    bf16* H = (bf16*)(F.ws + WS_H); float* BG = (float*)(F.ws + WS_BG);
    const int tok0 = F.vcu * (NTOK / F.G) + F.wave * (NTOK / F.G / NWAVES), ntw = NTOK / F.G / NWAVES;
    const int b = tok0 / SEQ;
    const ModVec m = load_mod(F.in[I_NMIX], mod + (size_t)b * 6144 + 1024, mod + (size_t)b * 6144, F.lane);
    const int hh = F.lane & 7;
    const float nega = -__expf(F.in[I_ALOG][hh]), dtb = F.in[I_DTB][hh];
    RowVec xn = load_row_f32(F.in[I_X] + (size_t)tok0 * D, F.lane);
    for (int i = 0; i < ntw; ++i) {
        const int t = tok0 + i;
        const RowVec x = xn;
        if (i + 1 < ntw) xn = load_row_f32(F.in[I_X] + (size_t)(t + 1) * D, F.lane);
        const RowVec h = apply_mod(x, row_rstd(x), m);
        store_row_bf16(H + (size_t)t * D, F.lane, h);
        float mine = 0.f;
#pragma unroll 2
        for (int o = 0; o < 16; ++o) { float s = 0.f;
#pragma unroll
            for (int j = 0; j < 4; ++j) { const f32x4 w = *((const LAS f32x4*)(wba + o * 1024) + F.lane + 64 * j); s += (h.v[j].x * w.x + h.v[j].y * w.y) + (h.v[j].z * w.z + h.v[j].w * w.w); }
            s = wave_sum(s); if (F.lane == o) mine = s; }
        if (F.lane < 8) BG[(size_t)t * 16 + F.lane] = sigmoid_f(mine);
        else if (F.lane < 16) BG[(size_t)t * 16 + F.lane] = nega * softplus_f(mine + dtb);
    }
}

struct DenseSched {
    int nM, nN, nwg, G, c; unsigned lda2, acol2; const char* B; size_t btile;
    __device__ __forceinline__ void init(int M, int N, int G_, int c_, int lda, int acolstride, const void* B_, int ldb) { nM = M / 256; nN = N / 256; nwg = nM * nN; G = G_; c = c_; lda2 = (unsigned)lda * 2u; acol2 = (unsigned)acolstride * 2u; B = (const char*)B_; btile = (size_t)256 * ldb * 2; }
    __device__ __forceinline__ bool next(int i, pg8::Unit& u) const {
        const long L = (long)i * G + c; if (L >= nwg) return false;
        int wgid = (int)L; { const int q = nwg / 8, r = nwg % 8, xcd = wgid % 8, off = wgid / 8; wgid = (xcd < r ? xcd * (q + 1) : r * (q + 1) + (xcd - r) * q) + off; }
        const int nig = 8 * nN, gid = wgid / nig, fm = gid * 8, gsz = (nM - fm) < 8 ? (nM - fm) : 8;
        u.pm = fm + ((wgid % nig) % gsz); u.pn = (wgid % nig) / gsz; u.e = 0; return true;
    }
    __device__ __forceinline__ unsigned a_off(const pg8::Unit& u, int r) const { return (unsigned)(u.pm * 256 + r) * lda2 + (unsigned)u.pn * acol2; }
    __device__ __forceinline__ const char* b_ptr(const pg8::Unit& u) const { return B + (size_t)u.pn * btile; }
};
struct MoeSched {
    const LAS int* cnt; const LAS int* tbase; const LAS int* tileExp;
    int nunits, chunk, G, c, esplit; const int* RT; const char* B; const char* Blo; size_t bexp, btile; unsigned arow2;
    __device__ __forceinline__ void init(const LAS int* tables, int G_, int c_, const int* RT_, const void* B_, int ldb, int lda) {
        cnt = tables; tbase = tables + 32; tileExp = tables + 80; G = G_; c = c_; RT = RT_; B = (const char*)B_; Blo = B; esplit = 0; bexp = (size_t)1024 * ldb * 2; btile = (size_t)256 * ldb * 2; arow2 = (unsigned)lda * 2u;
        nunits = tbase[32] * 4; chunk = ((nunits + 7) / 8 + 3) & ~3;
    }
    __device__ __forceinline__ bool next(int i, pg8::Unit& u) const {
        const int w = i * (G / 8) + (c >> 3); if (w >= chunk) return false;
        const int L = (c & 7) * chunk + w; if (L >= nunits) return false;
        u.pm = L >> 2; u.pn = L & 3; u.e = tileExp[u.pm]; return true;
    }
    __device__ __forceinline__ unsigned a_off(const pg8::Unit& u, int r) const {
        if (RT) { const int pos = (u.pm - tbase[u.e]) * 256 + r; const int tok = pos < cnt[u.e] ? RT[u.e * NTOK + pos] : 0; return (unsigned)tok * arow2; }
        return (unsigned)(u.pm * 256 + r) * arow2;
    }
    __device__ __forceinline__ const char* b_ptr(const pg8::Unit& u) const { return (u.e < esplit ? Blo : B) + (size_t)u.e * bexp + (size_t)u.pn * btile; }
};
__device__ __forceinline__ void build_moe_tables(Frame& F, int layer) {
    LAS int* T = (LAS int*)(F.lds + SCHED_OFF);
    int tid_ = F.tid; asm volatile("" : "+v"(tid_));
    if (tid_ < 32) T[tid_] = (int)__hip_atomic_load(F.ctl + CW_CNT + 64 * layer + tid_, RLX_AGENT);
    __syncthreads();
    if (F.tid == 0) { int acc = 0; for (int e = 0; e < 32; ++e) { T[32 + e] = acc; const int nt = (T[e] + 255) >> 8; for (int j = 0; j < nt; ++j) T[80 + acc + j] = e; acc += nt; } T[64] = acc; }
    __syncthreads();
}

__device__ __forceinline__ int moe_units_of(int c, int G, int nunits, int chunk) {
    const int sl = c >> 3, x = c & 7, per = G / 8; int U = nunits - x * chunk; U = U < 0 ? 0 : (U > chunk ? chunk : U);
    return sl < U ? (U - sl + per - 1) / per : 0;
}
__device__ __forceinline__ void moe_tail_plan(Frame& F) {
    LAS int* T = (LAS int*)(F.lds + SCHED_OFF);
    if (F.tid == 0) { T[65] = 0; T[66] = 0; }
    __syncthreads();
    if (F.tid < 256) {
        const int nunits = T[64] * 4, chunk = ((nunits + 7) / 8 + 3) & ~3, per = F.G / 8, maxu = (chunk + per - 1) / per, c = (int)blockIdx.x;
        const int sp = F.tid < F.G ? maxu - moe_units_of(F.tid, F.G, nunits, chunk) : 0;
        const int lower = (int)wave_sum(F.tid < c ? (float)sp : 0.f), all = (int)wave_sum((float)sp);
        if (F.lane == 0) { atomicAdd((int*)(T + 65), lower); atomicAdd((int*)(T + 66), all); }
        if (F.tid == c) T[67] = sp;
    }
    __syncthreads();
}

struct EpiStoreBf16 {
    bf16* O; int ldc;
    __device__ __forceinline__ void operator()(const f32x4 (&acc)[2][2][4][2], const pg8::Unit& u, int wr, int wc, int fr, int fq) const {
        const int row0 = u.pm * 256 + wr * 64 + fr, col0 = u.pn * 256 + wc * 32 + 8 * fq;
#pragma unroll
        for (int ai = 0; ai < 2; ++ai)
#pragma unroll
            for (int m = 0; m < 4; ++m) { bf16* rowp = O + (size_t)(row0 + ai * 128 + m * 16) * ldc + col0;
#pragma unroll
                for (int bj = 0; bj < 2; ++bj) { const f32x4 v0 = acc[ai][bj][m][0], v1 = acc[ai][bj][m][1];
                    v4u w; w.x = pk2(v0[0], v0[1]); w.y = pk2(v0[2], v0[3]); w.z = pk2(v1[0], v1[1]); w.w = pk2(v1[2], v1[3]);
                    *(v4u*)(rowp + bj * 128) = w; } }
    }
};
template <bool F32SRC> struct EpiResid {
    const float* X; bf16* O; const float* cf; const float* mul;
    __device__ __forceinline__ void operator()(const f32x4 (&acc)[2][2][4][2], const pg8::Unit& u, int wr, int wc, int fr, int fq) const {
        const int row0 = u.pm * 256 + wr * 64 + fr, col0 = u.pn * 256 + wc * 32 + 8 * fq, b = (u.pm * 256) / SEQ;
        f32x4 c[2][2];
#pragma unroll
        for (int bj = 0; bj < 2; ++bj)
#pragma unroll
            for (int n = 0; n < 2; ++n) { c[bj][n] = *(const f32x4*)(cf + (size_t)b * 6144 + col0 + bj * 128 + 4 * n); if (mul) c[bj][n] *= *(const f32x4*)(mul + col0 + bj * 128 + 4 * n); }
#pragma unroll
        for (int ai = 0; ai < 2; ++ai)
#pragma unroll
            for (int m = 0; m < 4; ++m) { const size_t ro = (size_t)(row0 + ai * 128 + m * 16) * D + col0;
                f32x4 s[2][2];
                if (F32SRC) {
#pragma unroll
                    for (int bj = 0; bj < 2; ++bj) { s[bj][0] = *(const GAS f32x4*)(X + ro + bj * 128); s[bj][1] = *(const GAS f32x4*)(X + ro + bj * 128 + 4); }
                } else {
#pragma unroll
                    for (int bj = 0; bj < 2; ++bj) { const v4u q = *(const GAS v4u*)(O + ro + bj * 128);
                        s[bj][0].x = bflo(q.x); s[bj][0].y = bfhi(q.x); s[bj][0].z = bflo(q.y); s[bj][0].w = bfhi(q.y); s[bj][1].x = bflo(q.z); s[bj][1].y = bfhi(q.z); s[bj][1].z = bflo(q.w); s[bj][1].w = bfhi(q.w); }
                }
#pragma unroll
                for (int bj = 0; bj < 2; ++bj) { const f32x4 v0 = s[bj][0] + c[bj][0] * acc[ai][bj][m][0], v1 = s[bj][1] + c[bj][1] * acc[ai][bj][m][1];
                    v4u w; w.x = pk2(v0[0], v0[1]); w.y = pk2(v0[2], v0[3]); w.z = pk2(v1[0], v1[1]); w.w = pk2(v1[2], v1[3]);
                    *(v4u*)(O + ro + bj * 128) = w; } }
    }
};
struct EpiSwiglu {
    bf16* O;
    __device__ __forceinline__ void operator()(const f32x4 (&acc)[2][2][4][2], const pg8::Unit& u, int wr, int wc, int fr, int fq) const {
        const int row0 = u.pm * 256 + wr * 64 + fr, col0 = u.pn * 128 + wc * 32 + 8 * fq;
#pragma unroll
        for (int ai = 0; ai < 2; ++ai)
#pragma unroll
            for (int m = 0; m < 4; ++m) { bf16* rowp = O + (size_t)(row0 + ai * 128 + m * 16) * DFF + col0;
                float r[8];
#pragma unroll
                for (int n = 0; n < 2; ++n)
#pragma unroll
                    for (int j = 0; j < 4; ++j) r[4 * n + j] = silu_f(acc[ai][0][m][n][j]) * acc[ai][1][m][n][j];
                v4u w; w.x = pk2(r[0], r[1]); w.y = pk2(r[2], r[3]); w.z = pk2(r[4], r[5]); w.w = pk2(r[6], r[7]);
                *(v4u*)rowp = w; }
    }
};

__device__ __forceinline__ void moe_route(Frame& F, int layer) {
    LAS int* hist = (LAS int*)(F.lds + RT_LDS_OFF);
    LAS int* base = hist + 32;
    LAS int* tinfo = hist + 64;
    LAS float* tg = (LAS float*)(hist + 64 + 512);
    if (F.tid < 32) hist[F.tid] = 0;
    LAS f32x4* R2 = (LAS f32x4*)(F.lds + RING_OFF);
    LAS f32x4* R1 = (LAS f32x4*)(F.lds + R1W_OFF);
    { const f32x4* g2p = (const f32x4*)(F.in[I_R2W] + (size_t)layer * 1024 * 32); const f32x4* g1p = (const f32x4*)(F.in[I_R1W] + (size_t)layer * 1024 * 4);
      for (int i = F.tid; i < 8192; i += 512) { const int k = i >> 3, c4 = i & 7, ln = (k & 255) >> 2, q = k & 3, j = k >> 8; R2[((j * 4 + q) * 8 + c4) * 64 + ln] = g2p[i]; }
      for (int k = F.tid; k < 1024; k += 512) { const int ln = (k & 255) >> 2, q = k & 3, j = k >> 8; R1[(j * 4 + q) * 64 + ln] = g1p[k]; } }
    __syncthreads();
    const float* mod = (const float*)(F.ws + WS_MOD) + (size_t)layer * 2 * 6144;
    bf16* H = (bf16*)(F.ws + WS_H);
    const int tokw = F.vcu * 128 + F.wave * 16, b = (F.vcu * 128) / SEQ;
    const ModVec m = load_mod(F.in[I_NFFN] + layer * D, mod + (size_t)b * 6144 + 4 * 1024, mod + (size_t)b * 6144 + 3 * 1024, F.lane);
    const float* r1b = F.in[I_R1B] + layer * 4; const float* r2b = F.in[I_R2B] + layer * 32;
    const bf16* XRB = (const bf16*)(F.ws + WS_XRB);
    v2u xbn[4], xb2[4];
    load_row_bf16(XRB + (size_t)tokw * D, F.lane, xbn); load_row_bf16(XRB + (size_t)(tokw + 1) * D, F.lane, xb2);
    for (int i = 0; i < 16; ++i) {
        const int t = tokw + i;
        const RowVec x = unpack_row_bf16(xbn);
#pragma unroll
        for (int j = 0; j < 4; ++j) xbn[j] = xb2[j];
        if (i + 2 < 16) load_row_bf16(XRB + (size_t)(t + 2) * D, F.lane, xb2);
        RowVec h = apply_mod(x, row_rstd(x), m);
        store_row_bf16(H + (size_t)t * D, F.lane, h);
        f32x4 l1 = {0.f, 0.f, 0.f, 0.f};
#pragma unroll
        for (int j = 0; j < 4; ++j)
#pragma unroll
            for (int q = 0; q < 4; ++q) l1 += R1[(j * 4 + q) * 64 + F.lane] * h.v[j][q];
        float lg[4];
#pragma unroll
        for (int g = 0; g < 4; ++g) lg[g] = wave_sum(l1[g]) + r1b[g];
        int grp = 0; float mx = lg[0];
#pragma unroll
        for (int g = 1; g < 4; ++g) if (lg[g] > mx) { mx = lg[g]; grp = g; }
        float se = 0.f;
#pragma unroll
        for (int g = 0; g < 4; ++g) se += __expf(lg[g] - mx);
        const float ptop = 1.0f / se;
        grp = __builtin_amdgcn_readfirstlane(grp);
        f32x4 a0 = {0.f, 0.f, 0.f, 0.f}, a1 = {0.f, 0.f, 0.f, 0.f};
#pragma unroll
        for (int j = 0; j < 4; ++j)
#pragma unroll
            for (int q = 0; q < 4; ++q) { const LAS f32x4* wp = R2 + ((j * 4 + q) * 8 + grp * 2) * 64 + F.lane;
                a0 += wp[0] * h.v[j][q]; a1 += wp[64] * h.v[j][q]; }
        float l2[8];
#pragma unroll
        for (int q = 0; q < 4; ++q) { l2[q] = wave_sum(a0[q]) + r2b[grp * 8 + q]; l2[4 + q] = wave_sum(a1[q]) + r2b[grp * 8 + 4 + q]; }
        int i0 = 0; float v0 = l2[0];
#pragma unroll
        for (int q = 1; q < 8; ++q) if (l2[q] > v0) { v0 = l2[q]; i0 = q; }
        int i1 = (i0 == 0) ? 1 : 0; float v1 = l2[i1 == 1 ? 1 : 0];
#pragma unroll
        for (int q = 0; q < 8; ++q) if (q != i0 && l2[q] > v1) { v1 = l2[q]; i1 = q; }
        const float g0 = ptop / (1.0f + __expf(v1 - v0)), g1 = ptop - g0;
        if (F.lane == 0) { const int e0 = grp * 8 + i0, e1 = grp * 8 + i1, li = F.wave * 16 + i;
            tinfo[li * 4 + 0] = e0; tinfo[li * 4 + 1] = e1; tinfo[li * 4 + 2] = atomicAdd((int*)(hist + e0), 1); tinfo[li * 4 + 3] = atomicAdd((int*)(hist + e1), 1);
            tg[li * 2] = g0; tg[li * 2 + 1] = g1;
            { float* GA = (float*)(F.ws + WS_BG); GA[(size_t)t * 2] = g0; GA[(size_t)t * 2 + 1] = g1; }
        }
    }
    __syncthreads();
    if (F.tid < 32) base[F.tid] = (int)__hip_atomic_fetch_add(F.ctl + CW_CNT + 64 * layer + F.tid, (unsigned)hist[F.tid], RLX_AGENT);
    __syncthreads();
    if (F.tid < 128) { const int t = F.vcu * 128 + F.tid; const int e0 = tinfo[F.tid * 4], e1 = tinfo[F.tid * 4 + 1];
        const int p0 = base[e0] + tinfo[F.tid * 4 + 2], p1 = base[e1] + tinfo[F.tid * 4 + 3];
        int* RT = (int*)(F.ws + WS_RT); RT[e0 * NTOK + p0] = t; RT[e1 * NTOK + p1] = t;
        v4u r0; r0.x = e0; r0.y = e1; r0.z = p0; r0.w = p1; v4u r1; r1.x = __builtin_bit_cast(unsigned, tg[F.tid * 2]); r1.y = __builtin_bit_cast(unsigned, tg[F.tid * 2 + 1]); r1.z = 0; r1.w = 0;
        v4u* RO = (v4u*)(F.ws + WS_ROUTE) + (size_t)t * 2; RO[0] = r0; (void)r1; }
    __syncthreads();
}

struct CombRows { v2u xb[4], ya[4], yb[4]; };
struct CombRecs { v4u rec; float ga, gb; };
__device__ __forceinline__ CombRecs comb_load_recs(Frame& F, int tokw) { CombRecs c; const int t = tokw + (F.lane & 15);
    c.rec = *((const v4u*)(F.ws + WS_ROUTE) + (size_t)t * 2); const float* GA = (const float*)(F.ws + WS_BG); c.ga = GA[(size_t)t * 2]; c.gb = GA[(size_t)t * 2 + 1]; return c; }
__device__ __forceinline__ int rl_i(int v, int l) { return __builtin_amdgcn_readlane(v, l); }
__device__ __forceinline__ void comb_issue(Frame& F, const CombRecs& c, int i, int t, CombRows& r) {
    const LAS int* T = (const LAS int*)(F.lds + SCHED_OFF);
    const int e0 = rl_i((int)c.rec.x, i), e1 = rl_i((int)c.rec.y, i), p0 = rl_i((int)c.rec.z, i), p1 = rl_i((int)c.rec.w, i);
    const size_t rowa = (size_t)T[32 + e0] * 256 + p0, rowb = (size_t)T[32 + e1] * 256 + p1;
    const bf16* Y = (const bf16*)(F.ws + WS_Y);
    const GAS v2u* ya = (const GAS v2u*)(Y + rowa * D) + F.lane; const GAS v2u* yb = (const GAS v2u*)(Y + rowb * D) + F.lane;
    load_row_bf16((const bf16*)(F.ws + WS_XRB) + (size_t)t * D, F.lane, r.xb);
#pragma unroll
    for (int j = 0; j < 4; ++j) { r.ya[j] = ya[64 * j]; r.yb[j] = yb[64 * j]; }
}
__device__ __forceinline__ RowVec comb_finish(const CombRecs& c, int i, const CombRows& r, const f32x4 (&g2)[4]) {
    const float ga = rl(c.ga, i), gb = rl(c.gb, i); RowVec x = unpack_row_bf16(r.xb);
#pragma unroll
    for (int j = 0; j < 4; ++j) { const v2u a = r.ya[j], bq = r.yb[j];
        f32x4 s; s.x = ga * bflo(a.x) + gb * bflo(bq.x); s.y = ga * bfhi(a.x) + gb * bfhi(bq.x); s.z = ga * bflo(a.y) + gb * bflo(bq.y); s.w = ga * bfhi(a.y) + gb * bfhi(bq.y);
        x.v[j] += g2[j] * s; }
    return x;
}

__device__ __forceinline__ void attn_phase(Frame& F, const int u_first, const int u_stride) {
    LAS bf16* KS = (LAS bf16*)(F.lds + RING_OFF);
    LAS bf16* VT = (LAS bf16*)(F.lds + RING_OFF + 36864);
    LAS float* BT = (LAS float*)(F.lds + RING_OFF + 36864 + 33280);
    const bf16* PROJ = (const bf16*)(F.ws + WS_PROJ); bf16* OAB = (bf16*)(F.ws + WS_OAB);
    const int lane = F.lane, lc = lane & 31, lh = lane >> 5;
    for (int unit = u_first; unit < 512; unit += u_stride) {
        const int b = unit >> 8, kvh = (unit >> 7) & 1, qb = unit & 127, t0 = qb * 128;
        __syncthreads();
        for (int i = F.tid; i < 4 * 192; i += 512) { const int hq = i / 192, x = i - hq * 192, dist = 159 - x; float v = 0.f;
            if (dist >= 0 && dist < 128) { int bk = dist; if (dist >= 16) { bk = 16 + (int)(logf((float)dist / 16.0f) / 2.0794415416798357f * 16.0f); bk = bk > 31 ? 31 : bk; }
                v = F.in[I_RELB][bk * 8 + kvh * 4 + hq] * 1.4426950408889634f; }
            BT[i] = v; }
#pragma unroll
        for (int cc = 0; cc < 4; ++cc) { const int ch = F.tid + 512 * cc, key = ch >> 3, part = ch & 7, tl = t0 - 128 + key;
            v4u kv = {0u, 0u, 0u, 0u}, vv = {0u, 0u, 0u, 0u};
            if (tl >= 0) { const bf16* rp = PROJ + (size_t)(b * SEQ + tl) * PIN; kv = *(const v4u*)(rp + PC_KB + kvh * 64 + part * 8); vv = *(const v4u*)(rp + PC_VB + kvh * 64 + part * 8); }
            *(LAS v4u*)(KS + key * 72 + part * 8) = kv;
            const unsigned w[4] = {vv.x, vv.y, vv.z, vv.w};
#pragma unroll
            for (int q = 0; q < 4; ++q) { VT[(part * 8 + 2 * q) * 260 + key] = (bf16)(w[q] & 0xffffu); VT[(part * 8 + 2 * q + 1) * 260 + key] = (bf16)(w[q] >> 16); } }
        __syncthreads();
#pragma unroll 1
        for (int tt = 0; tt < 2; ++tt) {
            const int task = F.wave * 2 + tt, hq = task >> 2, qt = task & 3, qh = kvh * 4 + hq;
            const int qi = 32 * qt + lc;
            const bf16* qrow = PROJ + (size_t)(b * SEQ + t0 + qi) * PIN + PC_QB + qh * 64 + 8 * lh;
            bf16x8 qf[4];
#pragma unroll
            for (int s = 0; s < 4; ++s) qf[s] = *(const bf16x8*)(qrow + 16 * s);
            f32x16 sc[5];
#pragma unroll
            for (int kt = 0; kt < 5; ++kt) {
#pragma unroll
                for (int r = 0; r < 16; ++r) sc[kt][r] = 0.f;
                const LAS bf16* kp = KS + (32 * (qt + kt) + lc) * 72 + 8 * lh;
#pragma unroll
                for (int s = 0; s < 4; ++s) { const bf16x8 kf = *(const LAS bf16x8*)(kp + 16 * s); sc[kt] = __builtin_amdgcn_mfma_f32_32x32x16_bf16(kf, qf[s], sc[kt], 0, 0, 0); }
            }
            const float sink2 = F.in[I_SINKS][qh] * 1.4426950408889634f;
            const LAS float* bp = BT + hq * 192 + (4 * lh - lc + 31);
            const int m_lo = lc + 1 - 4 * lh, m_hi = lc - 4 * lh;
            float mx = sink2;
#pragma unroll
            for (int kt = 0; kt < 5; ++kt) {
                const bool dead = (t0 == 0) && (qt + kt < 4);
#pragma unroll
                for (int r = 0; r < 16; ++r) { const int cr = (r & 3) + 8 * (r >> 2);
                    float v = sc[kt][r] * (0.125f * 1.4426950408889634f) + bp[32 * kt + cr];
                    if (kt == 0) v = (cr >= m_lo) ? v : -1e30f;
                    if (kt == 4) v = (cr <= m_hi) ? v : -1e30f;
                    if (dead) v = -1e30f;
                    sc[kt][r] = v; mx = fmaxf(mx, v); } }
            mx = fmaxf(mx, __shfl_xor(mx, 32));
            float den = 0.f;
#pragma unroll
            for (int kt = 0; kt < 5; ++kt)
#pragma unroll
                for (int r = 0; r < 16; ++r) { const float p = __builtin_amdgcn_exp2f(sc[kt][r] - mx); sc[kt][r] = p; den += p; }
            den += __shfl_xor(den, 32);
            den += __builtin_amdgcn_exp2f(sink2 - mx);
            const float inv = 1.0f / den;
            f32x16 oa[2];
#pragma unroll
            for (int dt = 0; dt < 2; ++dt)
#pragma unroll
                for (int r = 0; r < 16; ++r) oa[dt][r] = 0.f;
#pragma unroll
            for (int kt = 0; kt < 5; ++kt)
#pragma unroll
                for (int s2 = 0; s2 < 2; ++s2) {
                    v4u pw; pw.x = pk2(sc[kt][8 * s2 + 0], sc[kt][8 * s2 + 1]); pw.y = pk2(sc[kt][8 * s2 + 2], sc[kt][8 * s2 + 3]); pw.z = pk2(sc[kt][8 * s2 + 4], sc[kt][8 * s2 + 5]); pw.w = pk2(sc[kt][8 * s2 + 6], sc[kt][8 * s2 + 7]);
                    const bf16x8 pf = __builtin_bit_cast(bf16x8, pw);
#pragma unroll
                    for (int dt = 0; dt < 2; ++dt) { const LAS bf16* vp = VT + (32 * dt + lc) * 260 + 32 * (qt + kt) + 16 * s2 + 4 * lh;
                        const v2u va = *(const LAS v2u*)vp, vb = *(const LAS v2u*)(vp + 8);
                        v4u vw; vw.x = va.x; vw.y = va.y; vw.z = vb.x; vw.w = vb.y;
                        oa[dt] = __builtin_amdgcn_mfma_f32_32x32x16_bf16(__builtin_bit_cast(bf16x8, vw), pf, oa[dt], 0, 0, 0); }
                }
            bf16* orow = OAB + (size_t)(b * SEQ + t0 + qi) * D + 512 + qh * 64 + 4 * lh;
#pragma unroll
            for (int dt = 0; dt < 2; ++dt)
#pragma unroll
                for (int rg = 0; rg < 4; ++rg) { v2u o; o.x = pk2(oa[dt][4 * rg] * inv, oa[dt][4 * rg + 1] * inv); o.y = pk2(oa[dt][4 * rg + 2] * inv, oa[dt][4 * rg + 3] * inv);
                    *(v2u*)(orow + 32 * dt + 8 * rg) = o; }
        }
    }
    __syncthreads();
}


constexpr int DN_ST = 72;

__device__ __forceinline__ bf16x8 pack8(const f32x16& x, int s) { v4u p; p.x = pk2(x[8 * s], x[8 * s + 1]); p.y = pk2(x[8 * s + 2], x[8 * s + 3]); p.z = pk2(x[8 * s + 4], x[8 * s + 5]); p.w = pk2(x[8 * s + 6], x[8 * s + 7]); return __builtin_bit_cast(bf16x8, p); }
__device__ __forceinline__ f32x16 dn_tile(const LAS bf16* A, int ra, const LAS bf16* B, int rb, int lc, int lh) {
    f32x16 acc;
#pragma unroll
    for (int r = 0; r < 16; ++r) acc[r] = 0.f;
#pragma unroll
    for (int s = 0; s < 4; ++s) { const bf16x8 a = *(const LAS bf16x8*)(A + (ra + lc) * DN_ST + 16 * s + 8 * lh), b = *(const LAS bf16x8*)(B + (rb + lc) * DN_ST + 16 * s + 8 * lh);
        acc = __builtin_amdgcn_mfma_f32_32x32x16_bf16(a, b, acc, 0, 0, 0); }
    return acc;
}
__device__ __forceinline__ void dn_prep(Frame& F) {
    LAS bf16* Qs = (LAS bf16*)(F.lds + RING_OFF);
    LAS bf16* Ks = Qs + 64 * DN_ST;
    LAS bf16* KBs = Ks + 64 * DN_ST;
    LAS bf16* Vs = KBs + 64 * DN_ST;
    LAS bf16* KDT = Vs + 64 * DN_ST;
    LAS bf16* AQK = KDT + 64 * DN_ST;
    LAS bf16* UT = AQK + 64 * DN_ST;
    LAS bf16* WT = UT + 64 * DN_ST;
    LAS bf16* LNO = WT + 64 * DN_ST;
    LAS float* LD = (LAS float*)(LNO + 64 * DN_ST);
    LAS bf16* TDZ = (LAS bf16*)(LD + 64 * 16);
    LAS float* GB = (LAS float*)(TDZ + 64 * 24);
    const bf16* PROJ = (const bf16*)(F.ws + WS_PROJ); const float* BG = (const float*)(F.ws + WS_BG);
    const int tid = F.tid, lane = F.lane, lc = lane & 31, lh = lane >> 5, wave = F.wave;
    LAS float* CW = GB + 256;
    for (int i = tid; i < 1536; i += 512) *((LAS f32x4*)CW + i) = *((const f32x4*)F.in[I_CONVW] + i);
    LAS v4u* RAW = (LAS v4u*)(F.lds + R1W_OFF);
    constexpr int RAW_CH = 67 * 24;
#define DN_RAW_SRC(i_, b_, h_, n_) ({ const int r_ = (i_) / 24, c_ = (i_) - r_ * 24; const int tl_ = (n_) * 64 - 3 + r_; \
        tl_ >= 0 ? (const v4u*)(PROJ + ((size_t)(b_) * SEQ + tl_) * PIN + (c_ < 8 ? PC_QA : c_ < 16 ? PC_KA : PC_VA) + (h_) * 64 + (c_ & 7) * 8) : (const v4u*)nullptr; })
    { const int u0 = F.vcu, b = u0 >> 11, h = (u0 >> 8) & 7, n = u0 & 255;
      for (int i = tid; i < RAW_CH; i += 512) { const v4u* sp = DN_RAW_SRC(i, b, h, n); v4u z = {0u, 0u, 0u, 0u}; if (sp) z = *sp; RAW[i] = z; }
      if (wave == 0) { const size_t row0 = (size_t)b * SEQ + (size_t)n * 64; float c = BG[(row0 + lane) * 16 + 8 + h];
#pragma unroll
          for (int o = 1; o < 64; o <<= 1) { const float up = __shfl_up(c, o); if (lane >= o) c += up; }
          GB[lane] = c; GB[64 + lane] = BG[(row0 + lane) * 16 + h]; } }
    int par = 0;
    for (int unit = F.vcu; unit < 4096; unit += F.G, par ^= 1) {
        const int b = unit >> 11, h = (unit >> 8) & 7, n = unit & 255;
        LAS float* gcs = GB + par * 128; LAS float* bts = gcs + 64;
        const int un = unit + F.G; const bool more = un < 4096; const int bn = un >> 11, hn = (un >> 8) & 7, nn = un & 255;
        __syncthreads();
        { const int t = tid >> 3, cs = tid & 7;
          float q[8], k[8], v[8];
#pragma unroll
          for (int e = 0; e < 8; ++e) { q[e] = 0.f; k[e] = 0.f; v[e] = 0.f; }
#pragma unroll
          for (int j = 0; j < 4; ++j) { { const LAS v4u* rp = RAW + (t + j) * 24 + cs;
                const v4u wq = rp[0], wk = rp[8], wv = rp[16];
                const LAS float* cw = CW + j * 1536 + h * 64 + cs * 8;
                const unsigned uq[4] = {wq.x, wq.y, wq.z, wq.w}, uk[4] = {wk.x, wk.y, wk.z, wk.w}, uv[4] = {wv.x, wv.y, wv.z, wv.w};
#pragma unroll
                for (int e = 0; e < 4; ++e) { q[2 * e] += cw[2 * e] * bflo(uq[e]); q[2 * e + 1] += cw[2 * e + 1] * bfhi(uq[e]);
                    k[2 * e] += cw[512 + 2 * e] * bflo(uk[e]); k[2 * e + 1] += cw[512 + 2 * e + 1] * bfhi(uk[e]);
                    v[2 * e] += cw[1024 + 2 * e] * bflo(uv[e]); v[2 * e + 1] += cw[1024 + 2 * e + 1] * bfhi(uv[e]); } } }
          float sq = 0.f, sk = 0.f;
#pragma unroll
          for (int e = 0; e < 8; ++e) { q[e] = silu_f(q[e]); k[e] = silu_f(k[e]); v[e] = silu_f(v[e]); sq += q[e] * q[e]; sk += k[e] * k[e]; }
          sq = oct_sum(sq); sk = oct_sum(sk);
          const float rq = 0.125f / sqrtf(sq + EPS), rk = 1.0f / sqrtf(sk + EPS), bt = bts[t], kd = __expf(gcs[63] - gcs[t]);
          v4u oq, ok, ob, ov;
          oq.x = pk2(q[0] * rq, q[1] * rq); oq.y = pk2(q[2] * rq, q[3] * rq); oq.z = pk2(q[4] * rq, q[5] * rq); oq.w = pk2(q[6] * rq, q[7] * rq);
#pragma unroll
          for (int e = 0; e < 8; ++e) k[e] *= rk;
          ok.x = pk2(k[0], k[1]); ok.y = pk2(k[2], k[3]); ok.z = pk2(k[4], k[5]); ok.w = pk2(k[6], k[7]);
          ob.x = pk2(k[0] * bt, k[1] * bt); ob.y = pk2(k[2] * bt, k[3] * bt); ob.z = pk2(k[4] * bt, k[5] * bt); ob.w = pk2(k[6] * bt, k[7] * bt);
          ov.x = pk2(v[0], v[1]); ov.y = pk2(v[2], v[3]); ov.z = pk2(v[4], v[5]); ov.w = pk2(v[6], v[7]);
          *(LAS v4u*)(Qs + t * DN_ST + cs * 8) = oq; *(LAS v4u*)(Ks + t * DN_ST + cs * 8) = ok; *(LAS v4u*)(KBs + t * DN_ST + cs * 8) = ob; *(LAS v4u*)(Vs + t * DN_ST + cs * 8) = ov;
#pragma unroll
          for (int e = 0; e < 8; ++e) KDT[(cs * 8 + e) * DN_ST + t] = (bf16)f2bf(k[e] * kd); }
        __syncthreads();
        v4u pf[7]; float pg = 0.f, pb = 0.f;
        if (wave >= 4 && more) {
#pragma unroll
            for (int k7 = 0; k7 < 7; ++k7) { const int i = (tid - 256) + 256 * k7; pf[k7] = (v4u){0u, 0u, 0u, 0u}; if (i < RAW_CH) { const v4u* sp = DN_RAW_SRC(i, bn, hn, nn); if (sp) pf[k7] = *sp; } }
            if (wave == 4) { const size_t rn = (size_t)bn * SEQ + (size_t)nn * 64; pg = BG[(rn + lane) * 16 + 8 + hn]; pb = BG[(rn + lane) * 16 + hn]; }
        }
        { const int it = (wave >> 1) & 1, jt = wave & 1; const bool qk = wave >= 4;
          f32x16 acc;
          if (it >= jt) acc = dn_tile(qk ? Qs : KBs, 32 * it, Ks, 32 * jt, lc, lh);
          const int j = 32 * jt + lc; const float gj = gcs[j];
#pragma unroll
          for (int r = 0; r < 16; ++r) { const int i = 32 * it + (r & 3) + 8 * (r >> 2) + 4 * lh;
              float val = 0.f;
              if (it >= jt) { if (qk ? (i >= j) : (i > j)) val = acc[r] * __expf(gcs[i] - gj); }
              if (qk) AQK[i * DN_ST + j] = (bf16)f2bf(val);
              else { const bool diag = (i >> 4) == (j >> 4); LNO[i * DN_ST + j] = (bf16)f2bf(diag ? 0.f : -val); if (diag) LD[i * 16 + (j & 15)] = val; } } }
        __syncthreads();
        if (wave == 0) { const int bb = lane >> 4, c = lane & 15; float tcol[16];
#pragma unroll
            for (int i = 0; i < 16; ++i) { float v = (i == c) ? 1.f : 0.f;
#pragma unroll
                for (int j4 = 0; j4 < (i + 3) / 4; ++j4) { const f32x4 a = *(const LAS f32x4*)(LD + (16 * bb + i) * 16 + 4 * j4);
#pragma unroll
                    for (int e = 0; e < 4; ++e) if (4 * j4 + e < i) v -= a[e] * tcol[4 * j4 + e]; }
                tcol[i] = v; TDZ[(16 * bb + i) * 24 + c] = (bf16)f2bf(v); } }
        __syncthreads();
        if (wave < 4) {
            const int ct = wave, cc = 32 * (ct & 1) + lc; const bool isw = ct >= 2;
            f32x16 acc[2];
#pragma unroll
            for (int rt = 0; rt < 2; ++rt)
#pragma unroll
                for (int r = 0; r < 16; ++r) { const int t = 32 * rt + (r & 3) + 8 * (r >> 2) + 4 * lh;
                    acc[rt][r] = isw ? bf2f(Ks[t * DN_ST + cc]) * bts[t] * __expf(gcs[t]) : bf2f(Vs[t * DN_ST + cc]) * bts[t]; }
#define DN_AFRAG(arr, stride, row, kb) ({ const LAS bf16* p_ = (arr) + (row) * (stride) + 16 * (kb) + 4 * lh; const v2u lo_ = *(const LAS v2u*)p_, hi_ = *(const LAS v2u*)(p_ + 8); v4u w_; w_.x = lo_.x; w_.y = lo_.y; w_.z = hi_.x; w_.w = hi_.y; __builtin_bit_cast(bf16x8, w_); })
            f32x16 X[4];
#pragma unroll
            for (int bb = 0; bb < 4; ++bb) { const int rt = bb >> 1, odd = bb & 1;
                bf16x8 ta = DN_AFRAG(TDZ, 24, 32 * rt + lc, 0);
                if ((lc >> 4) != odd) ta = (bf16x8){0, 0, 0, 0, 0, 0, 0, 0};
                f32x16 z;
#pragma unroll
                for (int r = 0; r < 16; ++r) z[r] = 0.f;
                z = __builtin_amdgcn_mfma_f32_32x32x16_bf16(ta, pack8(acc[rt], odd), z, 0, 0, 0);
                X[bb] = z;
                const bf16x8 xb = pack8(z, odd);
                if (bb == 0) { acc[0] = __builtin_amdgcn_mfma_f32_32x32x16_bf16(DN_AFRAG(LNO, DN_ST, lc, 0), xb, acc[0], 0, 0, 0); acc[1] = __builtin_amdgcn_mfma_f32_32x32x16_bf16(DN_AFRAG(LNO, DN_ST, 32 + lc, 0), xb, acc[1], 0, 0, 0); }
                if (bb == 1) { acc[1] = __builtin_amdgcn_mfma_f32_32x32x16_bf16(DN_AFRAG(LNO, DN_ST, 32 + lc, 1), xb, acc[1], 0, 0, 0); }
                if (bb == 2) { acc[1] = __builtin_amdgcn_mfma_f32_32x32x16_bf16(DN_AFRAG(LNO, DN_ST, 32 + lc, 2), xb, acc[1], 0, 0, 0); }
            }
#undef DN_AFRAG
            LAS bf16* dst = (isw ? WT : UT) + cc * DN_ST;
#pragma unroll
            for (int bb = 0; bb < 4; ++bb)
#pragma unroll
                for (int g = 0; g < 2; ++g) { const int r0 = 8 * (bb & 1) + 4 * g; v2u o; o.x = pk2(X[bb][r0], X[bb][r0 + 1]); o.y = pk2(X[bb][r0 + 2], X[bb][r0 + 3]);
                    *(LAS v2u*)(dst + 16 * bb + 8 * g + 4 * lh) = o; }
        } else if (more) {
#pragma unroll
            for (int k7 = 0; k7 < 7; ++k7) { const int i = (tid - 256) + 256 * k7; if (i < RAW_CH) RAW[i] = pf[k7]; }
            if (wave == 4) { float c = pg;
#pragma unroll
                for (int o = 1; o < 64; o <<= 1) { const float up = __shfl_up(c, o); if (lane >= o) c += up; }
                GB[(par ^ 1) * 128 + lane] = c; GB[(par ^ 1) * 128 + 64 + lane] = pb; }
        }
        __syncthreads();
        { bf16* MT = (bf16*)(F.ws + WS_DN_MT) + (size_t)unit * 4096; bf16* QPT = (bf16*)(F.ws + WS_DN_QPT) + (size_t)unit * 4096;
          bf16* BM = (bf16*)(F.ws + WS_DN_BM) + (size_t)unit * 4096; bf16* O0T = (bf16*)(F.ws + WS_DN_O0T) + (size_t)unit * 4096;
#pragma unroll 1
          for (int tt = 0; tt < 2; ++tt) { const int task = wave * 2 + tt, p = task >> 2, ta = (task >> 1) & 1, tb = task & 1;
              if (p == 0) {
                  f32x16 acc = dn_tile(WT, 32 * ta, KDT, 32 * tb, lc, lh);
#pragma unroll
                  for (int r = 0; r < 16; ++r) acc[r] = -acc[r];
#pragma unroll
                  for (int s2 = 0; s2 < 2; ++s2) *(bf16x8*)(MT + ((((tb * 2 + ta) * 2 + s2) * 64 + lane) * 8)) = pack8(acc, s2);
              } else if (p == 1) {
                  const f32x16 acc = dn_tile(KDT, 32 * ta, UT, 32 * tb, lc, lh);
#pragma unroll
                  for (int s2 = 0; s2 < 2; ++s2) *(bf16x8*)(BM + ((((tb * 2 + ta) * 2 + s2) * 64 + lane) * 8)) = pack8(acc, s2);
              } else if (p == 2) {
                  f32x16 acc = dn_tile(WT, 32 * ta, AQK, 32 * tb, lc, lh);
                  const int i = 32 * tb + lc; const float eg = __expf(gcs[i]);
#pragma unroll
                  for (int r = 0; r < 16; ++r) { const int a = 32 * ta + (r & 3) + 8 * (r >> 2) + 4 * lh; acc[r] = bf2f(Qs[i * DN_ST + a]) * eg - acc[r]; }
#pragma unroll
                  for (int s2 = 0; s2 < 2; ++s2) *(bf16x8*)(QPT + ((((tb * 2 + ta) * 2 + s2) * 64 + lane) * 8)) = pack8(acc, s2);
              } else {
                  const f32x16 acc = dn_tile(UT, 32 * ta, AQK, 32 * tb, lc, lh);
#pragma unroll
                  for (int s2 = 0; s2 < 2; ++s2) *(bf16x8*)(O0T + ((((tb * 2 + ta) * 2 + s2) * 64 + lane) * 8)) = pack8(acc, s2);
              } }
          if (tid == 0) ((float*)(F.ws + WS_DN_GT))[unit] = __expf(gcs[63]); }
    }
#undef DN_RAW_SRC
    __syncthreads();
}
template <int r>
__device__ __forceinline__ void dn_scan_wave(Frame& F) {
    const int w = F.vcu, bh = w >> 1, ct = w & 1, lane = F.lane;
    const bf16x8* MT = (const bf16x8*)(F.ws + WS_DN_MT); const bf16x8* BM = (const bf16x8*)(F.ws + WS_DN_BM); bf16x8* SS = (bf16x8*)(F.ws + WS_DN_S);
    const float* GT = (const float*)(F.ws + WS_DN_GT);
    LAS bf16x8* MB = (LAS bf16x8*)(F.lds + RING_OFF);
    volatile LAS int* FL = (volatile LAS int*)(F.lds + LDSCTL_OFF + 64);
    f32x16 S;
#pragma unroll
    for (int q = 0; q < 16; ++q) S[q] = 0.f;
    bf16x8 mA[4], bA[2], mB[4], bB[2], mC[4], bC[2], mD[4], bD[2], mE[4], bE[2], mG[4], bG[2]; float gA, gB, gC, gD, gE, gG;
#define DN_SLOAD(m, bm, gt, u) do { const size_t ub = (size_t)(u) * 512; _Pragma("unroll") for (int f = 0; f < 4; ++f) m[f] = MT[ub + (r * 4 + f) * 64 + lane]; \
        _Pragma("unroll") for (int f = 0; f < 2; ++f) bm[f] = BM[ub + ((ct * 2 + r) * 2 + f) * 64 + lane]; gt = GT[u]; } while (0)
#define DN_STEP(cm, cb, cg, unit, n) do { \
        bf16x8 own[2]; own[0] = pack8(S, 0); own[1] = pack8(S, 1); \
        LAS bf16x8* mb = MB + ((n) & 1) * 256; \
        mb[(r * 2 + 0) * 64 + lane] = own[0]; mb[(r * 2 + 1) * 64 + lane] = own[1]; \
        asm volatile("s_waitcnt lgkmcnt(0)" ::: "memory"); \
        if (lane == 0) FL[r] = (n) + 1; \
        SS[(size_t)(unit) * 512 + (ct * 4 + r * 2 + 0) * 64 + lane] = own[0]; SS[(size_t)(unit) * 512 + (ct * 4 + r * 2 + 1) * 64 + lane] = own[1]; \
        f32x16 A; \
        { const v4u b0 = __builtin_bit_cast(v4u, cb[0]), b1 = __builtin_bit_cast(v4u, cb[1]); const unsigned u0[8] = {b0.x, b0.y, b0.z, b0.w, b1.x, b1.y, b1.z, b1.w}; \
          _Pragma("unroll") for (int e = 0; e < 8; ++e) { A[2 * e] = cg * S[2 * e] + bflo(u0[e]); A[2 * e + 1] = cg * S[2 * e + 1] + bfhi(u0[e]); } } \
        while (FL[1 - r] < (n) + 1) { } \
        asm volatile("" ::: "memory"); \
        bf16x8 oth[2]; oth[0] = mb[((1 - r) * 2 + 0) * 64 + lane]; oth[1] = mb[((1 - r) * 2 + 1) * 64 + lane]; \
          \
        _Pragma("unroll") for (int s2 = 0; s2 < 2; ++s2) { A = __builtin_amdgcn_mfma_f32_32x32x16_bf16(cm[r * 2 + s2], own[s2], A, 0, 0, 0); A = __builtin_amdgcn_mfma_f32_32x32x16_bf16(cm[(1 - r) * 2 + s2], oth[s2], A, 0, 0, 0); } \
        S = A; } while (0)
    const int u0 = bh * 256;
    DN_SLOAD(mA, bA, gA, u0); DN_SLOAD(mB, bB, gB, u0 + 1); DN_SLOAD(mC, bC, gC, u0 + 2); DN_SLOAD(mD, bD, gD, u0 + 3); DN_SLOAD(mE, bE, gE, u0 + 4); DN_SLOAD(mG, bG, gG, u0 + 5);
    for (int n = 0; n < 252; n += 6) {
        DN_STEP(mA, bA, gA, u0 + n, n);         DN_SLOAD(mA, bA, gA, u0 + n + 6);
        DN_STEP(mB, bB, gB, u0 + n + 1, n + 1); DN_SLOAD(mB, bB, gB, u0 + n + 7);
        DN_STEP(mC, bC, gC, u0 + n + 2, n + 2); DN_SLOAD(mC, bC, gC, u0 + n + 8);
        DN_STEP(mD, bD, gD, u0 + n + 3, n + 3); DN_SLOAD(mD, bD, gD, u0 + n + 9);
        DN_STEP(mE, bE, gE, u0 + n + 4, n + 4); if (n + 10 < 256) DN_SLOAD(mE, bE, gE, u0 + n + 10);
        DN_STEP(mG, bG, gG, u0 + n + 5, n + 5); if (n + 11 < 256) DN_SLOAD(mG, bG, gG, u0 + n + 11);
    }
    DN_STEP(mA, bA, gA, u0 + 252, 252); DN_STEP(mB, bB, gB, u0 + 253, 253); DN_STEP(mC, bC, gC, u0 + 254, 254); DN_STEP(mD, bD, gD, u0 + 255, 255);
#undef DN_SLOAD
#undef DN_STEP
}
__device__ __forceinline__ void dn_scan(Frame& F) {
    if (F.vcu >= 32) return;
    if (F.wave == 0) dn_scan_wave<0>(F); else if (F.wave == 1) dn_scan_wave<1>(F);
}
__device__ __forceinline__ void dn_output(Frame& F) {
    const bf16x8* QPT = (const bf16x8*)(F.ws + WS_DN_QPT); const bf16x8* O0T = (const bf16x8*)(F.ws + WS_DN_O0T); const bf16x8* SS = (const bf16x8*)(F.ws + WS_DN_S);
    const bf16* PROJ = (const bf16*)(F.ws + WS_PROJ); bf16* OAB = (bf16*)(F.ws + WS_OAB);
    const int lane = F.lane, lc = lane & 31, lh = lane >> 5; int nbad = 0; (void)nbad;
    for (int task = F.vcu * NWAVES + F.wave; task < 8192; task += F.G * NWAVES) {
        const int unit = task >> 1, it = task & 1, b = unit >> 11, h = (unit >> 8) & 7, n = unit & 255;
        const size_t ub = (size_t)unit * 512;
        f32x16 o[2];
#pragma unroll
        for (int ct = 0; ct < 2; ++ct) {
            const v4u c0 = __builtin_bit_cast(v4u, O0T[ub + ((it * 2 + ct) * 2 + 0) * 64 + lane]), c1 = __builtin_bit_cast(v4u, O0T[ub + ((it * 2 + ct) * 2 + 1) * 64 + lane]);
            const unsigned u[8] = {c0.x, c0.y, c0.z, c0.w, c1.x, c1.y, c1.z, c1.w};
#pragma unroll
            for (int e = 0; e < 8; ++e) { o[ct][2 * e] = bflo(u[e]); o[ct][2 * e + 1] = bfhi(u[e]); }
#pragma unroll
            for (int at = 0; at < 2; ++at)
#pragma unroll
                for (int s2 = 0; s2 < 2; ++s2) o[ct] = __builtin_amdgcn_mfma_f32_32x32x16_bf16(SS[ub + (ct * 4 + at * 2 + s2) * 64 + lane], QPT[ub + ((it * 2 + at) * 2 + s2) * 64 + lane], o[ct], 0, 0, 0);
        }
        float ss = 0.f;
#pragma unroll
        for (int ct = 0; ct < 2; ++ct)
#pragma unroll
            for (int r = 0; r < 16; ++r) ss += o[ct][r] * o[ct][r];
        ss += __shfl_xor(ss, 32);
        const float rs = 1.0f / sqrtf(ss * (1.0f / 64.0f) + EPS);
        const size_t row = (size_t)b * SEQ + (size_t)n * 64 + it * 32 + lc;
#pragma unroll
        for (int ct = 0; ct < 2; ++ct)
#pragma unroll
            for (int rg = 0; rg < 4; ++rg) { const int c0 = 32 * ct + 8 * rg + 4 * lh;
                const v2u zz = *(const v2u*)(PROJ + row * PIN + PC_ZA + h * 64 + c0); const f32x4 ow = *(const f32x4*)(F.in[I_ONORM] + c0);
                const float z0 = bflo(zz.x), z1 = bfhi(zz.x), z2 = bflo(zz.y), z3 = bfhi(zz.y);
                v2u ov; ov.x = pk2(o[ct][4 * rg] * rs * ow[0] * silu_f(z0), o[ct][4 * rg + 1] * rs * ow[1] * silu_f(z1)); ov.y = pk2(o[ct][4 * rg + 2] * rs * ow[2] * silu_f(z2), o[ct][4 * rg + 3] * rs * ow[3] * silu_f(z3));
                *(v2u*)(OAB + row * D + h * 64 + c0) = ov;
            }
    }
}

template <int WIN>
__device__ __forceinline__ void pooled_block(const bf16* H, bf16* P, const int t0, const int tl0, const int col) {
    v4u r[WIN - 1 + 8];
#pragma unroll
    for (int j = 0; j < WIN - 1 + 8; ++j) { const int dt = j - (WIN - 1); r[j] = (v4u){0u, 0u, 0u, 0u}; if (tl0 + dt >= 0) r[j] = *(const v4u*)(H + (size_t)(t0 + dt) * D + col); }
    float s[8];
#pragma unroll
    for (int q = 0; q < 8; ++q) s[q] = 0.f;
#define POOL_ACC(sgn, VV) do { const v4u q_ = (VV); s[0] += sgn bflo(q_.x); s[1] += sgn bfhi(q_.x); s[2] += sgn bflo(q_.y); s[3] += sgn bfhi(q_.y); s[4] += sgn bflo(q_.z); s[5] += sgn bfhi(q_.z); s[6] += sgn bflo(q_.w); s[7] += sgn bfhi(q_.w); } while (0)
#pragma unroll
    for (int j = 0; j < WIN - 1; ++j) POOL_ACC(+, r[j]);
#pragma unroll
    for (int i = 0; i < 8; ++i) { const v4u self = r[WIN - 1 + i]; POOL_ACC(+, self);
        const int n = (tl0 + i + 1) < WIN ? (tl0 + i + 1) : WIN; const float inv = 1.0f / (float)n;
        v4u o; o.x = pk2(s[0] * inv - bflo(self.x), s[1] * inv - bfhi(self.x)); o.y = pk2(s[2] * inv - bflo(self.y), s[3] * inv - bfhi(self.y));
        o.z = pk2(s[4] * inv - bflo(self.z), s[5] * inv - bfhi(self.z)); o.w = pk2(s[6] * inv - bflo(self.w), s[7] * inv - bfhi(self.w));
        *(v4u*)(P + (size_t)(t0 + i) * D + col) = o;
        POOL_ACC(-, r[i]); }
#undef POOL_ACC
}
__device__ __forceinline__ void pooled_phase(Frame& F) {
    const bf16* H = (const bf16*)(F.ws + WS_H); bf16* P = (bf16*)(F.ws + WS_OAB);
    const int gt = F.vcu * 512 + F.tid, NT = F.G * 512;
    for (int it = gt; it < (NTOK / 8) * 128; it += NT) {
        const int c = it & 31, g = __builtin_amdgcn_readfirstlane((it >> 6) & 3), tb = ((it >> 8) << 1) | ((it >> 5) & 1);
        const int t0 = tb * 8, tl0 = t0 & (SEQ - 1), col = g * 256 + c * 8;
        if (g == 0) pooled_block<2>(H, P, t0, tl0, col); else if (g == 1) pooled_block<4>(H, P, t0, tl0, col); else if (g == 2) pooled_block<8>(H, P, t0, tl0, col); else pooled_block<16>(H, P, t0, tl0, col);
    }
}


#ifndef PH_MASK
#define PH_MASK 0xFFFFFF
#endif
#define IN(k) (((PH_MASK >> (k)) & 1) && lo <= (k) && (k) < hi)
#define BOTH(k) (IN(k) && IN((k) + 1))
#if MK_ONE_LAUNCH
#define GRID_BAR() xcd_barrier(bar)
#else
#define GRID_BAR() do { } while (0)
#endif
template <int LAYER>
__device__ __forceinline__ void moe_phases(Frame& F, const XcdBarrier& bar, const int lo, const int hi) {
    constexpr int pb = LAYER == 0 ? 7 : 13;
    bf16* const H = (bf16*)(F.ws + WS_H);
    const float* const MOD = (const float*)(F.ws + WS_MOD);
    if (IN(pb)) {
        moe_route(F, LAYER); if (BOTH(pb)) GRID_BAR(); }
    if (IN(pb + 1)) {
        build_moe_tables(F, LAYER);
        pg8::Gemm g{(const bf16*)H, 1024, 1024}; MoeSched S; S.init((const LAS int*)(F.lds + SCHED_OFF), F.G, (int)blockIdx.x, (const int*)(F.ws + WS_RT), F.ws + WS_WGU, 1024, 1024);
        EpiSwiglu E{(bf16*)(F.ws + WS_ACT)};
        if (LAYER == 1) { S.Blo = (const char*)(F.ws + WS_WGT); S.esplit = 16; }
        moe_tail_plan(F);
        pg8::gemm_phase<EpiSwiglu, MoeSched>(F.lds + RING_OFF, g, S, E);
        {
            const LAS int* T = (const LAS int*)(F.lds + SCHED_OFF); const int sp = T[67];
            const int q0 = LAYER == 0 ? 0 : CQ_NG, q1 = LAYER == 0 ? CQ_NGT : CQ_N;
            if (sp > 0) { __syncthreads(); const int f = q0 + T[65] * 8 * TQ_GU; int e = f + sp * 8 * TQ_GU; e = e < q1 ? e : q1; convert_range(F, 1, f, e, F.wave, 8); }
            if (LAYER == 1) { int t = q0 + T[66] * 8 * TQ_GU;
                if (t < q1) { __syncthreads(); convert_range(F, 1, t, q1, F.vcu * NWAVES + F.wave, F.G * NWAVES); } } }
        if (BOTH(pb + 1)) GRID_BAR();
    }
    if (IN(pb + 2)) {
        build_moe_tables(F, LAYER);
        pg8::Gemm g{(const bf16*)(F.ws + WS_ACT), 512, 512}; MoeSched S; S.init((const LAS int*)(F.lds + SCHED_OFF), F.G, (int)blockIdx.x, nullptr, F.ws + WS_WD, 512, 512);
        EpiStoreBf16 E{(bf16*)(F.ws + WS_Y), D};
        if (LAYER == 0) moe_tail_plan(F);
        pg8::gemm_phase<EpiStoreBf16, MoeSched>(F.lds + RING_OFF, g, S, E);
        if (LAYER == 0) {
            const LAS int* T = (const LAS int*)(F.lds + SCHED_OFF); const int sp = T[67];
            int t8 = T[66] * 8 * TQ_GU; t8 = t8 < CQ_NGT ? t8 : CQ_NGT;
            if (sp > 0) { __syncthreads(); const int f = t8 + T[65] * 8 * TQ_DN; int e = f + sp * 8 * TQ_DN; e = e < CQ_NG ? e : CQ_NG; convert_range(F, 1, f, e, F.wave, 8); } }
        if (BOTH(pb + 2)) GRID_BAR();
    }
    if (IN(pb + 3)) {
        build_moe_tables(F, LAYER);
        if (LAYER == 0) moe_tail_plan(F);
        const int tokw = F.vcu * 128 + F.wave * 16, b = (F.vcu * 128) / SEQ;
        f32x4 g2[4];
#pragma unroll
        for (int j = 0; j < 4; ++j) g2[j] = *((const f32x4*)(MOD + (size_t)(LAYER * 2 + b) * 6144 + 5 * 1024) + F.lane + 64 * j);
        if (LAYER == 0) {
            const ModVec m1 = load_mod(F.in[I_NMIX] + D, MOD + (size_t)(2 + b) * 6144 + 1024, MOD + (size_t)(2 + b) * 6144, F.lane);
            { const CombRecs recs = comb_load_recs(F, tokw); CombRows cur, nxt; comb_issue(F, recs, 0, tokw, cur);
              for (int i = 0; i < 16; ++i) { const int t = tokw + i;
                  if (i + 1 < 16) comb_issue(F, recs, i + 1, t + 1, nxt);
                  const RowVec x = comb_finish(recs, i, cur, g2);
                  store_row_bf16((bf16*)(F.ws + WS_XRB) + (size_t)t * D, F.lane, x); store_row_bf16(H + (size_t)t * D, F.lane, apply_mod(x, row_rstd(x), m1));
                  cur = nxt; } }
            __syncthreads();
            { const LAS int* T = (const LAS int*)(F.lds + SCHED_OFF);
              int t8 = T[66] * 8 * TQ_GU; t8 = t8 < CQ_NGT ? t8 : CQ_NGT; int t9 = t8 + T[66] * 8 * TQ_DN; t9 = t9 < CQ_NG ? t9 : CQ_NG;
              convert_range(F, 1, t9, CQ_NG, F.vcu * NWAVES + F.wave, F.G * NWAVES); }
        } else {
            f32x4 fw[4];
#pragma unroll
            for (int j = 0; j < 4; ++j) fw[j] = *((const f32x4*)F.in[I_FNW] + F.lane + 64 * j);
            { const CombRecs recs = comb_load_recs(F, tokw); CombRows cur, nxt; comb_issue(F, recs, 0, tokw, cur);
              for (int i = 0; i < 16; ++i) { const int t = tokw + i;
                  if (i + 1 < 16) comb_issue(F, recs, i + 1, t + 1, nxt);
                  RowVec x = comb_finish(recs, i, cur, g2); const float rstd = row_rstd(x);
#pragma unroll
                  for (int j = 0; j < 4; ++j) x.v[j] = x.v[j] * rstd * fw[j];
                  store_row_f32(F.out + (size_t)t * D, F.lane, x);
                  cur = nxt; } }
        }
        if (BOTH(pb + 3)) GRID_BAR();
    }
}

constexpr int PH_P0 = 0, PH_P1 = 1, PH_INPROJ = 2, PH_ATT = 3, PH_SCAN = 4, PH_DNOUT = 5, PH_OUTPROJ = 6, PH_MOE0 = 7, PH_POOLED = 11, PH_POOLG = 12, PH_MOE1 = 13;
constexpr int N_PHASES = 17;
struct Args { const float* in[24]; float* out; unsigned char* ws; int ph_lo, ph_hi; };
__global__ void __launch_bounds__(NWAVES * 64, 2) trunk_fwd(Args args) {
    __shared__ __attribute__((aligned(16))) unsigned char lds[LDS_BYTES];
    Frame F;
    F.lds = (LAS unsigned char*)lds;
    F.MISC = (volatile LAS unsigned*)(F.lds + MISC_OFF);
    F.tid = threadIdx.x; F.lane = F.tid & 63; F.wave = __builtin_amdgcn_readfirstlane(F.tid >> 6);
    F.G = gridDim.x; { const int bx = blockIdx.x; F.vcu = (F.G % 8 == 0) ? (bx % 8) * (F.G / 8) + bx / 8 : bx; }
#pragma unroll
    for (int i = 0; i < 24; ++i) F.in[i] = args.in[i];
    F.out = args.out; F.ws = args.ws; F.ctl = (gu32*)(args.ws + WS_CTL);
    for (int u = F.tid; u < (LDS_BYTES - LDSCTL_OFF) / 4; u += NWAVES * 64) ((LAS unsigned*)(F.lds + LDSCTL_OFF))[u] = 0u;
    __syncthreads();
#if MK_ONE_LAUNCH
    XcdBarrier bar = xcd_barrier_post((unsigned*)(F.ctl + CW_BAR), F.MISC + 8);
#else
    XcdBarrier bar; bar.bar = nullptr; bar.x = 0; bar.st = nullptr;
#endif
    const int lo = args.ph_lo, hi = args.ph_hi;
    bf16* const H = (bf16*)(F.ws + WS_H);
    const float* const MOD = (const float*)(F.ws + WS_MOD);

    if (IN(PH_P0)) { p0_prologue(F); if (BOTH(PH_P0)) GRID_BAR(); }
    if (IN(PH_P1)) { p1_prenorm0(F); if (BOTH(PH_P1)) GRID_BAR(); }
    if (IN(PH_INPROJ)) {
        pg8::Gemm g{(const bf16*)H, 1024, 1024}; DenseSched S; S.init(NTOK, PIN, F.G, (int)blockIdx.x, 1024, 0, F.ws + WS_WIN, 1024);
        EpiStoreBf16 E{(bf16*)(F.ws + WS_PROJ), PIN};
        pg8::gemm_phase<EpiStoreBf16, DenseSched>(F.lds + RING_OFF, g, S, E);
        if (IP_FULL && (int)blockIdx.x >= IP_FULL) {
            __syncthreads(); const int r = (int)blockIdx.x - IP_FULL; convert_range(F, 0, r * 8 * TQ_INPROJ, (r + 1) * 8 * TQ_INPROJ, F.wave, 8); }
        if (BOTH(PH_INPROJ)) GRID_BAR();
    }
    if (IN(PH_ATT)) { dn_prep(F); if (BOTH(PH_ATT)) GRID_BAR(); }
    if (IN(PH_SCAN)) {
        if (F.vcu < 32) dn_scan(F);
        else { attn_phase(F, F.vcu - 32, F.G - 32); __syncthreads(); convert_range(F, 0, CQ_T2, CQ_N, (F.vcu - 32) * NWAVES + F.wave, (F.G - 32) * NWAVES); }
        if (BOTH(PH_SCAN)) GRID_BAR(); }
    if (IN(PH_DNOUT)) { dn_output(F); if (BOTH(PH_DNOUT)) GRID_BAR(); }
    if (IN(PH_OUTPROJ)) {
        pg8::Gemm g{(const bf16*)(F.ws + WS_OAB), 1024, 1024}; DenseSched S; S.init(NTOK, D, F.G, (int)blockIdx.x, 1024, 0, F.ws + WS_WOUT, 1024);
        EpiResid<true> E{F.in[I_X], (bf16*)(F.ws + WS_XRB), MOD + 2 * 1024, nullptr};
        pg8::gemm_phase<EpiResid<true>, DenseSched>(F.lds + RING_OFF, g, S, E);
        if (BOTH(PH_OUTPROJ)) GRID_BAR();
    }
    moe_phases<0>(F, bar, lo, hi);
    if (IN(PH_POOLED)) { pooled_phase(F); if (BOTH(PH_POOLED)) GRID_BAR(); }
    if (IN(PH_POOLG)) {
        pg8::Gemm g{(const bf16*)(F.ws + WS_OAB), 256, 256}; DenseSched S; S.init(NTOK, D, F.G, (int)blockIdx.x, 1024, 256, F.ws + WS_POOLW, 256);
        EpiResid<false> E{nullptr, (bf16*)(F.ws + WS_XRB), MOD + (size_t)2 * 6144 + 2 * 1024, F.in[I_POOLS]};
        pg8::gemm_phase<EpiResid<false>, DenseSched>(F.lds + RING_OFF, g, S, E);
        if (BOTH(PH_POOLG)) GRID_BAR();
    }
    moe_phases<1>(F, bar, lo, hi);
#undef IN
#undef BOTH
}

extern "C" void kernel_launch(void* const* d_in, const int* in_sizes, int n_in, void* d_out, int out_size, void* d_ws, size_t ws_size, hipStream_t stream) {
    static int grid = 0;
    if (grid == 0) {
        if (n_in != 24 || in_sizes[0] != NTOK * D || out_size != NTOK * D || ws_size < WS_END2) { fprintf(stderr, "kernel_launch: unexpected shapes (n_in %d, in0 %d, out %d, ws %zu); nothing launched\n", n_in, n_in > 0 ? in_sizes[0] : -1, out_size, ws_size); grid = -1; return; }
        int per_cu = 0;
        if (hipOccupancyMaxActiveBlocksPerMultiprocessor(&per_cu, (const void*)trunk_fwd, NWAVES * 64, 0) != hipSuccess || per_cu < 1) fprintf(stderr, "kernel_launch: occupancy query says %d\n", per_cu);
        (void)hipGetLastError();
        grid = 256;
    }
    if (grid < 0) return;
    if (hipMemsetAsync((char*)d_ws + WS_CTL, 0, CTL_ZERO_BYTES, stream) != hipSuccess) { fprintf(stderr, "kernel_launch: memset failed\n"); return; }
    Args a{};
    for (int i = 0; i < 24; ++i) a.in[i] = (const float*)d_in[i];
    a.out = (float*)d_out; a.ws = (unsigned char*)d_ws;
#if MK_ONE_LAUNCH
    a.ph_lo = 0; a.ph_hi = N_PHASES;
    hipLaunchKernelGGL(trunk_fwd, dim3(grid), dim3(NWAVES * 64), 0, stream, a);
#else
    for (int p = 0; p < N_PHASES; ++p) { a.ph_lo = p; a.ph_hi = p + 1; hipLaunchKernelGGL(trunk_fwd, dim3(grid), dim3(NWAVES * 64), 0, stream, a); }
#endif
}
```

```cpp
#include <hip/hip_runtime.h>
#include <cstdio>
#include <cstdint>

#ifndef MK_ONE_LAUNCH
#define MK_ONE_LAUNCH 1
#endif

#define GAS __attribute__((address_space(1)))
#define LAS __attribute__((address_space(3)))
typedef unsigned short bf16;
typedef unsigned v4u __attribute__((ext_vector_type(4)));
typedef unsigned v2u __attribute__((ext_vector_type(2)));
typedef float f32x4 __attribute__((ext_vector_type(4)));
typedef float f32x2 __attribute__((ext_vector_type(2)));
typedef float f32x16 __attribute__((ext_vector_type(16)));
typedef short bf16x8 __attribute__((ext_vector_type(8)));
typedef GAS unsigned gu32;
#define RLX_AGENT __ATOMIC_RELAXED, __HIP_MEMORY_SCOPE_AGENT
#define LDS_WAIT() asm volatile("s_waitcnt lgkmcnt(0)" ::: "memory")
#define VM_WAIT() asm volatile("s_waitcnt vmcnt(0)" ::: "memory")

constexpr int BATCH = 2, SEQ = 16384, D = 1024, NTOK = BATCH * SEQ;
constexpr int PIN = 2816;
constexpr int PC_QA = 0, PC_KA = 512, PC_VA = 1024, PC_ZA = 1536, PC_QB = 2048, PC_KB = 2560, PC_VB = 2688;
constexpr int NEXP = 32, DFF = 512;
constexpr int MAXTILES = NTOK * 2 / 256 + NEXP;
constexpr float EPS = 1e-6f;
constexpr int NWAVES = 8;

constexpr size_t MiB = 1u << 20;
constexpr size_t WS_CTL = 0, CTL_ZERO_BYTES = 1 * MiB;
constexpr size_t WS_MOD = 1 * MiB;
constexpr size_t WS_WBA = 1 * MiB + 128 * 1024;
constexpr size_t WS_ROUTE = 2 * MiB;
constexpr size_t WS_RT = 3 * MiB;
constexpr size_t WS_BG = 7 * MiB;
constexpr size_t WS_WIN = 10 * MiB;
constexpr size_t WS_WOUT = 16 * MiB;
constexpr size_t WS_POOLW = 18 * MiB;
constexpr size_t WS_WGU = 20 * MiB;
constexpr size_t WS_WD = 84 * MiB;
constexpr size_t WS_H = 116 * MiB;
constexpr size_t WS_PROJ = 180 * MiB;
constexpr size_t WS_OAB = 356 * MiB;
constexpr size_t WS_YM = 180 * MiB;
constexpr size_t WS_ACT = 180 * MiB;
constexpr size_t WS_Y = 252 * MiB;
constexpr size_t WS_END = 420 * MiB;
constexpr size_t OUT_DN_MT = 0, OUT_DN_QPT = 32 * MiB;
constexpr size_t WS_DN_BM = 420 * MiB, WS_DN_O0T = 452 * MiB, WS_DN_S = 484 * MiB;
constexpr size_t WS_DN_GT = 9 * MiB;
constexpr size_t WS_XRB = 420 * MiB;
constexpr size_t WS_WGT = 484 * MiB;
constexpr size_t WS_END2 = 516 * MiB;
constexpr int CW_CNT = 64;
constexpr int CW_BAR = 4096;
constexpr int CW_BAD = 200;

constexpr int RING_OFF = 0, RING_BYTES = 131072;
constexpr int LDSCTL_OFF = RING_BYTES, MISC_OFF = LDSCTL_OFF + 320;
constexpr int SCHED_OFF = LDSCTL_OFF + 1024;
constexpr int LDS_BYTES = 163840;
constexpr int R1W_OFF = 135168;
constexpr int RT_LDS_OFF = 151552;

typedef __bf16 bf16x2_t __attribute__((ext_vector_type(2)));
__device__ __forceinline__ unsigned pk2(float lo, float hi) { bf16x2_t v; v.x = (__bf16)lo; v.y = (__bf16)hi; return __builtin_bit_cast(unsigned, v); }
__device__ __forceinline__ unsigned f2bf(float f) { return pk2(f, 0.f) & 0xffffu; }
__device__ __forceinline__ float bf2f(unsigned b) { return __builtin_bit_cast(float, b << 16); }
__device__ __forceinline__ float bflo(unsigned w) { return __builtin_bit_cast(float, w << 16); }
__device__ __forceinline__ float bfhi(unsigned w) { return __builtin_bit_cast(float, w & 0xffff0000u); }
template <int CTRL> __device__ __forceinline__ float dpp_f(float v) { return __builtin_bit_cast(float, __builtin_amdgcn_update_dpp(0, __builtin_bit_cast(int, v), CTRL, 0xf, 0xf, false)); }
__device__ __forceinline__ float quad_sum(float v) { v += dpp_f<0xB1>(v); v += dpp_f<0x4E>(v); return v; }
__device__ __forceinline__ float oct_sum(float v) { v = quad_sum(v); v += dpp_f<0x141>(v); return v; }
__device__ __forceinline__ float wave_sum(float v) {
    v = oct_sum(v); v += dpp_f<0x140>(v);
    const float r0 = __builtin_bit_cast(float, __builtin_amdgcn_readlane(__builtin_bit_cast(int, v), 0)), r1 = __builtin_bit_cast(float, __builtin_amdgcn_readlane(__builtin_bit_cast(int, v), 16));
    const float r2 = __builtin_bit_cast(float, __builtin_amdgcn_readlane(__builtin_bit_cast(int, v), 32)), r3 = __builtin_bit_cast(float, __builtin_amdgcn_readlane(__builtin_bit_cast(int, v), 48));
    return (r0 + r1) + (r2 + r3);
}
__device__ __forceinline__ float rl(float x, int l) { return __builtin_bit_cast(float, __builtin_amdgcn_readlane(__builtin_bit_cast(int, x), l)); }
__device__ __forceinline__ float silu_f(float x) { return x / (1.f + __expf(-x)); }
__device__ __forceinline__ float sigmoid_f(float x) { return 1.f / (1.f + __expf(-x)); }
__device__ __forceinline__ float softplus_f(float x) { return x > 20.f ? x : log1pf(__expf(x)); }

namespace pg8 {
#define PG8_LAS __attribute__((address_space(3)))
typedef unsigned short bf16_t;
typedef unsigned u32x4 __attribute__((ext_vector_type(4)));
constexpr int BM = 256, BK = 64, HALF = 128, HTB = HALF * BK * 2, STAGE_BYTES = 8 * HTB;

__host__ __device__ __forceinline__ int lds_byte(int r, int c) { const int st = (r >> 4) * 2 + (c >> 5), rr = r & 15, cc = c & 31, ob = rr * 64 + cc * 2; return st * 1024 + (ob ^ (((ob >> 9) & 1) << 5)); }
__host__ __device__ __forceinline__ void stage_rc(int b, int& R, int& C) { const int st = b / 1024, sb = b % 1024, swz = sb ^ (((sb >> 9) & 1) << 5); R = (st >> 1) * 16 + swz / 64; C = (st & 1) * 32 + (swz % 64) / 2; }
__host__ __device__ __forceinline__ int perm32(int rho) { const int n = rho >> 4, i = rho & 15; return 8 * (i >> 2) + 4 * n + (i & 3); }

struct Unit { int pm, pn, e; };
struct Gemm { const bf16_t* A; int K, ldb; };

template <class Epi, class Sched>
__device__ __forceinline__ void gemm_phase(PG8_LAS unsigned char* lds, const Gemm g, const Sched& S, const Epi& E) {
    const int tid = threadIdx.x, wid = __builtin_amdgcn_readfirstlane(tid >> 6), lane = tid & 63, wr = wid >> 2, wc = wid & 3, fr = lane & 15, fq = lane >> 4;
    const int K = g.K, nt = K / BK;
    int R0, C0, R1, C1; stage_rc(tid * 16, R0, C0); stage_rc(tid * 16 + 8192, R1, C1);
    const int Rb0 = (R0 & ~31) + perm32(R0 & 31), Rb1 = (R1 & ~31) + perm32(R1 & 31);
    const unsigned voffB0 = (unsigned)(Rb0 * g.ldb + C0) * 2u, voffB1 = (unsigned)(Rb1 * g.ldb + C1) * 2u;
    const size_t kstep = (size_t)(BK * 2);
    const size_t hstepB = (size_t)HALF * g.ldb * 2;
    const unsigned ldsw = (unsigned)wid * 1024u;
    const int aoff = lds_byte(wr * 64 + fr, fq * 8), boff = lds_byte(wc * 32 + fr, fq * 8);
    const char* Ab = (const char*)g.A;
#define PG8_SA(b, h) (((b) * 2 + (h)) * HTB)
#define PG8_SB(b, h) ((4 + (b) * 2 + (h)) * HTB)
#define PG8_ST2(bufoff, gbase, v0, v1) do { \
        __builtin_amdgcn_global_load_lds((const unsigned*)((const char*)(gbase) + (v0)), (PG8_LAS unsigned*)(lds + (bufoff) + ldsw), 16, 0, 0); \
        __builtin_amdgcn_global_load_lds((const unsigned*)((const char*)(gbase) + (v1)), (PG8_LAS unsigned*)(lds + (bufoff) + ldsw + 8192), 16, 0, 0); } while (0)
#define PG8_STB(bufoff, gbase) PG8_ST2(bufoff, gbase, voffB0, voffB1)
#define PG8_LDA(dst, b, h) do { _Pragma("unroll") for (int m = 0; m < 4; ++m) _Pragma("unroll") for (int k = 0; k < 2; ++k) dst[m][k] = *(const PG8_LAS bf16x8*)(lds + PG8_SA(b, h) + aoff + m * 2048 + k * 1024); } while (0)
#define PG8_LDB(dst, b, h) do { _Pragma("unroll") for (int n = 0; n < 2; ++n) _Pragma("unroll") for (int k = 0; k < 2; ++k) dst[n][k] = *(const PG8_LAS bf16x8*)(lds + PG8_SB(b, h) + boff + n * 2048 + k * 1024); } while (0)
#define PG8_MMA(ai, bj, At, Bt) do { __builtin_amdgcn_s_setprio(1); _Pragma("unroll") for (int m = 0; m < 4; ++m) _Pragma("unroll") for (int n = 0; n < 2; ++n) _Pragma("unroll") for (int k = 0; k < 2; ++k) \
        acc[ai][bj][m][n] = __builtin_amdgcn_mfma_f32_16x16x32_bf16(Bt[n][k], At[m][k], acc[ai][bj][m][n], 0, 0, 0); __builtin_amdgcn_s_setprio(0); } while (0)
#define PG8_WAIT_V(n) asm volatile("s_waitcnt vmcnt(" #n ")" ::: "memory")
#define PG8_WAIT_L(n) asm volatile("s_waitcnt lgkmcnt(" #n ")" ::: "memory")
#define PG8_BAR __builtin_amdgcn_s_barrier()
#define PG8_SCHED __builtin_amdgcn_sched_barrier(0)
    Unit cur, nxt; int ui = 0;
    if (!S.next(0, cur)) return;
    f32x4 acc[2][2][4][2];
#pragma unroll
    for (int a = 0; a < 2; ++a)
#pragma unroll
        for (int b = 0; b < 2; ++b)
#pragma unroll
            for (int m = 0; m < 4; ++m)
#pragma unroll
                for (int n = 0; n < 2; ++n) acc[a][b][m][n] = (f32x4){0.f, 0.f, 0.f, 0.f};
    bf16x8 At[4][2], B0[2][2], B1[2][2];
    unsigned c00, c01, c10, c11;
#define PG8_AOFF(u, d00, d01, d10, d11) do { \
        d00 = S.a_off(u, R0) + (unsigned)C0 * 2u; d01 = S.a_off(u, R1) + (unsigned)C1 * 2u; \
        d10 = S.a_off(u, HALF + R0) + (unsigned)C0 * 2u; d11 = S.a_off(u, HALF + R1) + (unsigned)C1 * 2u; } while (0)
    PG8_AOFF(cur, c00, c01, c10, c11);
    const char* cB = S.b_ptr(cur);
    PG8_STB(PG8_SB(0, 0), cB); PG8_STB(PG8_SB(0, 1), cB + hstepB); PG8_ST2(PG8_SA(0, 0), Ab, c00, c01); PG8_ST2(PG8_SA(0, 1), Ab, c10, c11);
    if (wr == 1) PG8_BAR;
    PG8_WAIT_V(2); PG8_BAR;
    PG8_STB(PG8_SB(1, 0), cB + kstep); PG8_ST2(PG8_SA(1, 0), Ab + kstep, c00, c01); PG8_STB(PG8_SB(1, 1), cB + hstepB + kstep);
    PG8_WAIT_V(6); PG8_BAR;
    for (;;) {
        const bool has_next = S.next(ui + 1, nxt);
        const char* nB = has_next ? S.b_ptr(nxt) : cB;
#pragma unroll 1
        for (int t = 0; t < nt; t += 2) {
            const bool last = (t == nt - 2);
            const char* a1 = Ab + (size_t)(t + 1) * kstep;
            const char* a2 = last ? Ab : Ab + (size_t)(t + 2) * kstep; const char* b2 = last ? nB : cB + (size_t)(t + 2) * kstep;
            const char* a3 = a2 + kstep; const char* b3 = b2 + kstep;
            PG8_LDB(B0, 0, 0); PG8_LDB(B1, 0, 1); PG8_SCHED; PG8_LDA(At, 0, 0); PG8_ST2(PG8_SA(1, 1), a1, c10, c11);
            PG8_WAIT_V(8); PG8_WAIT_L(0); PG8_BAR; PG8_MMA(0, 0, At, B0); PG8_MMA(0, 1, At, B1); PG8_BAR; PG8_SCHED;
            if (last && has_next) { PG8_AOFF(nxt, c00, c01, c10, c11); }
            PG8_LDA(At, 0, 1); PG8_STB(PG8_SB(0, 0), b2); PG8_STB(PG8_SB(0, 1), b2 + hstepB); PG8_ST2(PG8_SA(0, 0), a2, c00, c01);
            PG8_WAIT_V(8); PG8_WAIT_L(0); PG8_BAR; PG8_MMA(1, 0, At, B0); PG8_MMA(1, 1, At, B1); PG8_BAR; PG8_SCHED;
            PG8_LDB(B0, 1, 0); PG8_LDB(B1, 1, 1); PG8_SCHED; PG8_LDA(At, 1, 0); PG8_ST2(PG8_SA(0, 1), a2, c10, c11);
            PG8_WAIT_V(8); PG8_WAIT_L(0); PG8_BAR; PG8_MMA(0, 0, At, B0); PG8_MMA(0, 1, At, B1); PG8_BAR; PG8_SCHED;
            PG8_LDA(At, 1, 1); PG8_STB(PG8_SB(1, 0), b3); PG8_STB(PG8_SB(1, 1), b3 + hstepB); PG8_ST2(PG8_SA(1, 0), a3, c00, c01);
            PG8_WAIT_V(8); PG8_WAIT_L(0); PG8_BAR; PG8_MMA(1, 0, At, B0); PG8_MMA(1, 1, At, B1); PG8_BAR; PG8_SCHED;
        }
        if (wr == 0) PG8_BAR;
        E(acc, cur, wr, wc, fr, fq);
        if (!has_next) break;
#pragma unroll
        for (int a = 0; a < 2; ++a)
#pragma unroll
            for (int b = 0; b < 2; ++b)
#pragma unroll
                for (int m = 0; m < 4; ++m)
#pragma unroll
                    for (int n = 0; n < 2; ++n) acc[a][b][m][n] = (f32x4){0.f, 0.f, 0.f, 0.f};
        cur = nxt; cB = nB; ++ui;
        if (wr == 1) PG8_BAR;
    }
    PG8_WAIT_V(0);
    PG8_BAR;
#undef PG8_SA
#undef PG8_SB
#undef PG8_ST2
#undef PG8_STB
#undef PG8_LDA
#undef PG8_LDB
#undef PG8_MMA
#undef PG8_WAIT_V
#undef PG8_WAIT_L
#undef PG8_BAR
#undef PG8_SCHED
#undef PG8_AOFF
}
}

#define XB_TMO      128
#define XB_XCNT(j)  (256  + 64 * (j))
#define XB_XSUB(j)  (1280 + 64 * (j))
#define XB_XGEN(j)  (2304 + 64 * (j))
#define XB_TOP      3328
#define XB_TOPGEN   3392
#define XCD_BAR_WORDS 3456
#define XB_SPIN_CAP (1u << 22)

__device__ __forceinline__ unsigned xb_ld(unsigned* p)              { return __hip_atomic_load(p, __ATOMIC_RELAXED, __HIP_MEMORY_SCOPE_AGENT); }
__device__ __forceinline__ unsigned xb_add(unsigned* p, unsigned v) { return __hip_atomic_fetch_add(p, v, __ATOMIC_RELAXED, __HIP_MEMORY_SCOPE_AGENT); }
__device__ __forceinline__ unsigned xb_xcc_id() { return (unsigned)__builtin_amdgcn_s_getreg((3 << 11) | 20) & 0xFu; }
#define XB_SPIN(cond, bar) do { unsigned _sp = 0; while (cond) { __builtin_amdgcn_s_sleep(1); \
    if ((++_sp & 255u) == 0u) { if (xb_ld(&(bar)[XB_TMO])) break; if (_sp > XB_SPIN_CAP) { atomicAdd(&(bar)[XB_TMO], 1u); break; } } } } while (0)

struct XcdBarrier { unsigned* bar; unsigned x; volatile LAS unsigned* st; };

__device__ __forceinline__ XcdBarrier xcd_barrier_post(unsigned* bar, volatile LAS unsigned* st) {
    XcdBarrier b; b.bar = bar; b.x = xb_xcc_id(); b.st = st;
    if (threadIdx.x == 0) (void)xb_add(&bar[XB_XCNT(b.x)], 1u);
    return b;
}
__device__ __forceinline__ void xcd_barrier_complete(unsigned* bar, unsigned x, unsigned& nloc, unsigned& nx) {
    const unsigned G = gridDim.x * gridDim.y * gridDim.z;
    unsigned sum, cnt, mine, sp = 0u;
    for (;;) {
        sum = 0u; cnt = 0u; mine = 0u;
#pragma unroll
        for (unsigned j = 0; j < 16; ++j) { const unsigned c = xb_ld(&bar[XB_XCNT(j)]); sum += c; cnt += (c > 0u) ? 1u : 0u; mine = (j == x) ? c : mine; }
        if (sum == G) break;
        __builtin_amdgcn_s_sleep(1);
        if ((++sp & 255u) == 0u) { if (xb_ld(&bar[XB_TMO])) break; if (sp > XB_SPIN_CAP) { atomicAdd(&bar[XB_TMO], 1u); break; } }
    }
    nloc = mine > 0u ? mine : 1u; nx = cnt > 0u ? cnt : 1u;
}
__device__ __forceinline__ void xcd_barrier(const XcdBarrier& b) {
    asm volatile("s_waitcnt vmcnt(0)" ::: "memory");
    __syncthreads();
    if (threadIdx.x == 0) {
        unsigned* bar = b.bar;
        __builtin_amdgcn_s_waitcnt(0);
        unsigned nloc = b.st[0], nx = b.st[1];
        if (nloc == 0u) { xcd_barrier_complete(bar, b.x, nloc, nx); b.st[0] = nloc; b.st[1] = nx; }
        const unsigned old = xb_add(&bar[XB_XSUB(b.x)], 1u);
        const unsigned gen = old / nloc;
        if (old + 1u == (gen + 1u) * nloc) {
            __builtin_amdgcn_fence(__ATOMIC_RELEASE, "agent");
            asm volatile("s_waitcnt vmcnt(0)" ::: "memory");
            const unsigned og = xb_add(&bar[XB_TOP], 1u);
            const unsigned tg = og / nx;
            if (og + 1u == (tg + 1u) * nx) xb_add(&bar[XB_TOPGEN], 1u);
            else XB_SPIN(xb_ld(&bar[XB_TOPGEN]) == tg, bar);
            __builtin_amdgcn_fence(__ATOMIC_ACQUIRE, "agent");
            xb_add(&bar[XB_XGEN(b.x)], 1u);
            asm volatile("s_waitcnt vmcnt(0)" ::: "memory");
        } else {
            XB_SPIN(xb_ld(&bar[XB_XGEN(b.x)]) == gen, bar);
            __builtin_amdgcn_fence(__ATOMIC_ACQUIRE, "agent");
            asm volatile("s_waitcnt vmcnt(0)" ::: "memory");
        }
    }
    __syncthreads();
}

struct Frame {
    LAS unsigned char* lds;
    volatile LAS unsigned* MISC;
    gu32* ctl;
    int tid, lane, wave, vcu, G;
    const float* in[24];
    float* out;
    unsigned char* ws;
};
enum { I_X = 0, I_C, I_ADAW, I_ADAB, I_NMIX, I_NFFN, I_WIN, I_CONVW, I_ALOG, I_DTB, I_ONORM, I_SINKS, I_RELB, I_WOUT, I_POOLW, I_POOLS, I_R1W, I_R1B, I_R2W, I_R2B, I_WG, I_WU, I_WDN, I_FNW };

__device__ __forceinline__ void p0_transpose_item(const float* W, int ldw, int K, bf16* WT, int dst_row0, LAS float* scr, int k0, int n0, int lane) {
    f32x4 w4[8];
#pragma unroll
    for (int i = 0; i < 8; ++i) { const int f = i * 64 + lane, kk = f >> 3, c4 = f & 7; w4[i] = __builtin_nontemporal_load((const f32x4*)(W + (size_t)(k0 + kk) * ldw + n0 + c4 * 4)); }
#pragma unroll
    for (int i = 0; i < 8; ++i) { const int f = i * 64 + lane, kk = f >> 3, c4 = f & 7; LAS float* d = scr + kk * 33 + c4 * 4; d[0] = w4[i].x; d[1] = w4[i].y; d[2] = w4[i].z; d[3] = w4[i].w; }
    LDS_WAIT(); asm volatile("" ::: "memory");
    const int c = lane & 7;
#pragma unroll
    for (int j = 0; j < 4; ++j) { const int n = (lane >> 3) + 8 * j; const LAS float* s = scr + (8 * c) * 33 + n;
        v4u o; o.x = pk2(s[0 * 33], s[1 * 33]); o.y = pk2(s[2 * 33], s[3 * 33]); o.z = pk2(s[4 * 33], s[5 * 33]); o.w = pk2(s[6 * 33], s[7 * 33]);
        __builtin_nontemporal_store(o, (GAS v4u*)(WT + (size_t)(dst_row0 + n) * K + k0 + 8 * c)); }
    LDS_WAIT(); asm volatile("" ::: "memory");
}
constexpr int CQ_NG = NEXP * 512, CQ_NGT = 16 * 512, CQ_N = NEXP * 768;
constexpr int TQ_INPROJ = 9, TQ_GU = 6, TQ_DN = 4;
constexpr int IP_TILES = PIN / 256 - 2;
constexpr int IP_FULL = ((NTOK / 256) * IP_TILES) % 256;
constexpr int CQ_T2 = IP_FULL ? (256 - IP_FULL) * 8 * TQ_INPROJ : 0;
__device__ __forceinline__ void convert_item(Frame& F, int layer, int it, LAS float* scr) {
    if (it < CQ_NG) {
        const int e = it >> 9, r = it & 511, up = r >> 8, q = r & 255, kb = q >> 4, nb = q & 15;
        const float* W = (up ? F.in[I_WU] : F.in[I_WG]) + (size_t)(layer * NEXP + e) * 1024 * 512;
        p0_transpose_item(W, 512, 1024, (bf16*)(F.ws + ((layer && e < 16) ? WS_WGT : WS_WGU)), e * 1024 + (nb >> 2) * 256 + up * 128 + (nb & 3) * 32, scr, kb * 64, nb * 32, F.lane);
    } else {
        const int r0 = it - CQ_NG, e = r0 >> 8, q = r0 & 255, kb = q >> 5, nb = q & 31;
        const float* W = F.in[I_WDN] + (size_t)(layer * NEXP + e) * 512 * 1024;
        p0_transpose_item(W, 1024, 512, (bf16*)(F.ws + WS_WD), e * 1024 + nb * 32, scr, kb * 64, nb * 32, F.lane);
    }
}
__device__ __forceinline__ void convert_range(Frame& F, int layer, int first, int end, int start, int stride) {
    LAS float* scr = (LAS float*)(F.lds + RING_OFF + F.wave * 16384);
    for (int it = first + start; it < end; it += stride) convert_item(F, layer, it, scr);
}
__device__ __forceinline__ void p0_prologue(Frame& F) {
    LAS float* scr = (LAS float*)(F.lds + RING_OFF + F.wave * 16384);
    const int gw = F.vcu * NWAVES + F.wave, NGW = F.G * NWAVES;
    constexpr int IA = 16 * 64, IB = 16 * 24, IO = 16 * 32, IP = 4 * 32, NIT = IA + IB + IO + IP;
    for (int it = gw; it < NIT; it += NGW) {
        int r = it;
        if (r < IA) { p0_transpose_item(F.in[I_WIN], 2832, 1024, (bf16*)(F.ws + WS_WIN), (r % 64) * 32, scr, (r / 64) * 64, (r % 64) * 32, F.lane); continue; } r -= IA;
        if (r < IB) { p0_transpose_item(F.in[I_WIN] + 2064, 2832, 1024, (bf16*)(F.ws + WS_WIN), 2048 + (r % 24) * 32, scr, (r / 24) * 64, (r % 24) * 32, F.lane); continue; } r -= IB;
        if (r < IO) { p0_transpose_item(F.in[I_WOUT], 1024, 1024, (bf16*)(F.ws + WS_WOUT), (r % 32) * 32, scr, (r / 32) * 64, (r % 32) * 32, F.lane); continue; } r -= IO;
        { const int g = r >> 5, q = r & 31; p0_transpose_item(F.in[I_POOLW] + (size_t)g * 65536, 256, 256, (bf16*)(F.ws + WS_POOLW) + (size_t)g * 65536, (q & 7) * 32, scr, (q >> 3) * 64, (q & 7) * 32, F.lane); }
    }
    { float* WBA = (float*)(F.ws + WS_WBA); const int gt = F.vcu * 512 + F.tid;
      if (gt < 16 * 1024) { const int o = gt >> 10, k = gt & 1023; WBA[o * 1024 + k] = F.in[I_WIN][(size_t)k * 2832 + 2048 + o]; } }
    __syncthreads();
    {
        LAS float* red = (LAS float*)(F.lds + RING_OFF);
        const int ks = F.tid >> 4, cj = F.tid & 15;
        for (int u = F.vcu; u < 192; u += F.G) {
            const int l = u / 96, cb = u % 96;
            const float* W = F.in[I_ADAW] + (size_t)l * 1024 * 6144 + cb * 64 + cj * 4;
            f32x4 a0 = {0.f, 0.f, 0.f, 0.f}, a1 = {0.f, 0.f, 0.f, 0.f};
            for (int k = ks * 32; k < ks * 32 + 32; ++k) {
                const f32x4 w = *(const f32x4*)(W + (size_t)k * 6144);
                const float c0 = silu_f(F.in[I_C][k]), c1 = silu_f(F.in[I_C][1024 + k]);
                a0 += w * c0; a1 += w * c1;
            }
            *(LAS f32x4*)(red + (ks * 2 + 0) * 64 + cj * 4) = a0; *(LAS f32x4*)(red + (ks * 2 + 1) * 64 + cj * 4) = a1;
            __syncthreads();
            if (F.tid < 128) { const int b = F.tid >> 6, c = F.tid & 63; float s = 0.f;
                for (int q = 0; q < 32; ++q) s += red[(q * 2 + b) * 64 + c];
                ((float*)(F.ws + WS_MOD))[(size_t)(l * 2 + b) * 6144 + cb * 64 + c] = s + F.in[I_ADAB][l * 6144 + cb * 64 + c]; }
            __syncthreads();
        }
    }
}

struct RowVec { f32x4 v[4]; };
__device__ __forceinline__ RowVec load_row_f32(const float* row, int lane) { RowVec r; const GAS f32x4* p = (const GAS f32x4*)row + lane;
#pragma unroll
    for (int j = 0; j < 4; ++j) r.v[j] = p[64 * j]; return r; }
__device__ __forceinline__ void store_row_f32(float* row, int lane, const RowVec& r) { GAS f32x4* p = (GAS f32x4*)row + lane;
#pragma unroll
    for (int j = 0; j < 4; ++j) p[64 * j] = r.v[j]; }
__device__ __forceinline__ void store_row_bf16(bf16* row, int lane, const RowVec& r) { GAS v2u* p = (GAS v2u*)row + lane;
#pragma unroll
    for (int j = 0; j < 4; ++j) { v2u o; o.x = pk2(r.v[j].x, r.v[j].y); o.y = pk2(r.v[j].z, r.v[j].w); p[64 * j] = o; } }
__device__ __forceinline__ void load_row_bf16(const bf16* row, int lane, v2u (&p)[4]) { const GAS v2u* q = (const GAS v2u*)row + lane;
#pragma unroll
    for (int j = 0; j < 4; ++j) p[j] = q[64 * j]; }
__device__ __forceinline__ RowVec unpack_row_bf16(const v2u (&p)[4]) { RowVec r;
#pragma unroll
    for (int j = 0; j < 4; ++j) { r.v[j].x = bflo(p[j].x); r.v[j].y = bfhi(p[j].x); r.v[j].z = bflo(p[j].y); r.v[j].w = bfhi(p[j].y); } return r; }
__device__ __forceinline__ float row_rstd(const RowVec& r) { float s = 0.f;
#pragma unroll
    for (int j = 0; j < 4; ++j) s += (r.v[j].x * r.v[j].x + r.v[j].y * r.v[j].y) + (r.v[j].z * r.v[j].z + r.v[j].w * r.v[j].w);
    return 1.0f / sqrtf(wave_sum(s) * (1.f / D) + EPS); }
struct ModVec { f32x4 a[4], b[4]; };
__device__ __forceinline__ ModVec load_mod(const float* w, const float* sc, const float* sh, int lane) { ModVec m;
#pragma unroll
    for (int j = 0; j < 4; ++j) { const f32x4 wv = *((const f32x4*)w + lane + 64 * j), s = *((const f32x4*)sc + lane + 64 * j); m.a[j] = wv * (s + 1.0f); m.b[j] = *((const f32x4*)sh + lane + 64 * j); }
    return m; }
__device__ __forceinline__ RowVec apply_mod(const RowVec& x, float rstd, const ModVec& m) { RowVec h;
#pragma unroll
    for (int j = 0; j < 4; ++j) h.v[j] = x.v[j] * rstd * m.a[j] + m.b[j]; return h; }

__device__ __forceinline__ void p1_prenorm0(Frame& F) {
    LAS float* wba = (LAS float*)(F.lds + RING_OFF);
    { const float* WBA = (const float*)(F.ws + WS_WBA); for (int i = F.tid; i < 16 * 256; i += 512) *((LAS f32x4*)wba + i) = *((const f32x4*)WBA + i); }
    __syncthreads();
    const float* mod = (const float*)(F.ws + WS_MOD);
    bf16* H = (bf16*)(F.ws + WS_H); float* BG = (float*)(F.ws + WS_BG);
    const int tok0 = F.vcu * (NTOK / F.G) + F.wave * (NTOK / F.G / NWAVES), ntw = NTOK / F.G / NWAVES;
    const int b = tok0 / SEQ;
    const ModVec m = load_mod(F.in[I_NMIX], mod + (size_t)b * 6144 + 1024, mod + (size_t)b * 6144, F.lane);
    const int hh = F.lane & 7;
    const float nega = -__expf(F.in[I_ALOG][hh]), dtb = F.in[I_DTB][hh];
    RowVec xn = load_row_f32(F.in[I_X] + (size_t)tok0 * D, F.lane);
    for (int i = 0; i < ntw; ++i) {
        const int t = tok0 + i;
        const RowVec x = xn;
        if (i + 1 < ntw) xn = load_row_f32(F.in[I_X] + (size_t)(t + 1) * D, F.lane);
        const RowVec h = apply_mod(x, row_rstd(x), m);
        store_row_bf16(H + (size_t)t * D, F.lane, h);
        float mine = 0.f;
#pragma unroll 2
        for (int o = 0; o < 16; ++o) { float s = 0.f;
#pragma unroll
            for (int j = 0; j < 4; ++j) { const f32x4 w = *((const LAS f32x4*)(wba + o * 1024) + F.lane + 64 * j); s += (h.v[j].x * w.x + h.v[j].y * w.y) + (h.v[j].z * w.z + h.v[j].w * w.w); }
            s = wave_sum(s); if (F.lane == o) mine = s; }
        if (F.lane < 8) BG[(size_t)t * 16 + F.lane] = sigmoid_f(mine);
        else if (F.lane < 16) BG[(size_t)t * 16 + F.lane] = nega * softplus_f(mine + dtb);
    }
}

struct DenseSched {
    int nM, nN, nwg, G, c, gap_from, gap, L0, Lend; unsigned lda2, acol2; const char* B; size_t btile;
    __device__ __forceinline__ void init(int M, int N, int G_, int c_, int lda, int acolstride, const void* B_, int ldb) { nM = M / 256; nN = N / 256; nwg = nM * nN; G = G_; c = c_; gap_from = 1 << 30; gap = 0; L0 = 0; Lend = nwg; lda2 = (unsigned)lda * 2u; acol2 = (unsigned)acolstride * 2u; B = (const char*)B_; btile = (size_t)256 * ldb * 2; }
    __device__ __forceinline__ bool next(int i, pg8::Unit& u) const {
        const long L = (long)L0 + (long)i * G + c; if (L >= Lend) return false;
        int wgid = (int)L; { const int q = nwg / 8, r = nwg % 8, xcd = wgid % 8, off = wgid / 8; wgid = (xcd < r ? xcd * (q + 1) : r * (q + 1) + (xcd - r) * q) + off; }
        const int nig = 8 * nN, gid = wgid / nig, fm = gid * 8, gsz = (nM - fm) < 8 ? (nM - fm) : 8;
        u.pm = fm + ((wgid % nig) % gsz); u.pn = (wgid % nig) / gsz; u.pn += (u.pn >= gap_from) ? gap : 0; u.e = 0; return true;
    }
    __device__ __forceinline__ unsigned a_off(const pg8::Unit& u, int r) const { return (unsigned)(u.pm * 256 + r) * lda2 + (unsigned)u.pn * acol2; }
    __device__ __forceinline__ const char* b_ptr(const pg8::Unit& u) const { return B + (size_t)u.pn * btile; }
};
struct MoeSched {
    const LAS int* cnt; const LAS int* tbase; const LAS int* tileExp;
    int nunits, chunk, G, c, esplit; const int* RT; const char* B; const char* Blo; size_t bexp, btile; unsigned arow2;
    __device__ __forceinline__ void init(const LAS int* tables, int G_, int c_, const int* RT_, const void* B_, int ldb, int lda) {
        cnt = tables; tbase = tables + 32; tileExp = tables + 80; G = G_; c = c_; RT = RT_; B = (const char*)B_; Blo = B; esplit = 0; bexp = (size_t)1024 * ldb * 2; btile = (size_t)256 * ldb * 2; arow2 = (unsigned)lda * 2u;
        nunits = tbase[32] * 4; chunk = ((nunits + 7) / 8 + 3) & ~3;
    }
    __device__ __forceinline__ bool next(int i, pg8::Unit& u) const {
        const int w = i * (G / 8) + (c >> 3); if (w >= chunk) return false;
        const int L = (c & 7) * chunk + w; if (L >= nunits) return false;
        u.pm = L >> 2; u.pn = L & 3; u.e = tileExp[u.pm]; return true;
    }
    __device__ __forceinline__ unsigned a_off(const pg8::Unit& u, int r) const {
        if (RT) { const int pos = (u.pm - tbase[u.e]) * 256 + r; const int tok = pos < cnt[u.e] ? RT[u.e * NTOK + pos] : 0; return (unsigned)tok * arow2; }
        return (unsigned)(u.pm * 256 + r) * arow2;
    }
    __device__ __forceinline__ const char* b_ptr(const pg8::Unit& u) const { return (u.e < esplit ? Blo : B) + (size_t)u.e * bexp + (size_t)u.pn * btile; }
};
__device__ __forceinline__ void build_moe_tables(Frame& F, int layer) {
    LAS int* T = (LAS int*)(F.lds + SCHED_OFF);
    int tid_ = F.tid; asm volatile("" : "+v"(tid_));
    if (tid_ < 32) T[tid_] = (int)__hip_atomic_load(F.ctl + CW_CNT + 64 * layer + tid_, RLX_AGENT);
    __syncthreads();
    if (F.tid == 0) { int acc = 0; for (int e = 0; e < 32; ++e) { T[32 + e] = acc; const int nt = (T[e] + 255) >> 8; for (int j = 0; j < nt; ++j) T[80 + acc + j] = e; acc += nt; } T[64] = acc; }
    __syncthreads();
}

__device__ __forceinline__ int moe_units_of(int c, int G, int nunits, int chunk) {
    const int sl = c >> 3, x = c & 7, per = G / 8; int U = nunits - x * chunk; U = U < 0 ? 0 : (U > chunk ? chunk : U);
    return sl < U ? (U - sl + per - 1) / per : 0;
}
__device__ __forceinline__ void moe_tail_plan(Frame& F) {
    LAS int* T = (LAS int*)(F.lds + SCHED_OFF);
    if (F.tid == 0) { T[65] = 0; T[66] = 0; }
    __syncthreads();
    if (F.tid < 256) {
        const int nunits = T[64] * 4, chunk = ((nunits + 7) / 8 + 3) & ~3, per = F.G / 8, maxu = (chunk + per - 1) / per, c = (int)blockIdx.x;
        const int sp = F.tid < F.G ? maxu - moe_units_of(F.tid, F.G, nunits, chunk) : 0;
        const int lower = (int)wave_sum(F.tid < c ? (float)sp : 0.f), all = (int)wave_sum((float)sp);
        if (F.lane == 0) { atomicAdd((int*)(T + 65), lower); atomicAdd((int*)(T + 66), all); }
        if (F.tid == c) T[67] = sp;
    }
    __syncthreads();
}

struct EpiStoreBf16 {
    bf16* O; int ldc;
    __device__ __forceinline__ void operator()(const f32x4 (&acc)[2][2][4][2], const pg8::Unit& u, int wr, int wc, int fr, int fq) const {
        const int row0 = u.pm * 256 + wr * 64 + fr, col0 = u.pn * 256 + wc * 32 + 8 * fq;
#pragma unroll
        for (int ai = 0; ai < 2; ++ai)
#pragma unroll
            for (int m = 0; m < 4; ++m) { bf16* rowp = O + (size_t)(row0 + ai * 128 + m * 16) * ldc + col0;
#pragma unroll
                for (int bj = 0; bj < 2; ++bj) { const f32x4 v0 = acc[ai][bj][m][0], v1 = acc[ai][bj][m][1];
                    v4u w; w.x = pk2(v0[0], v0[1]); w.y = pk2(v0[2], v0[3]); w.z = pk2(v1[0], v1[1]); w.w = pk2(v1[2], v1[3]);
                    *(v4u*)(rowp + bj * 128) = w; } }
    }
};
template <bool F32SRC> struct EpiResid {
    const float* X; bf16* O; const float* cf; const float* mul;
    __device__ __forceinline__ void operator()(const f32x4 (&acc)[2][2][4][2], const pg8::Unit& u, int wr, int wc, int fr, int fq) const {
        const int row0 = u.pm * 256 + wr * 64 + fr, col0 = u.pn * 256 + wc * 32 + 8 * fq, b = (u.pm * 256) / SEQ;
        f32x4 c[2][2];
#pragma unroll
        for (int bj = 0; bj < 2; ++bj)
#pragma unroll
            for (int n = 0; n < 2; ++n) { c[bj][n] = *(const f32x4*)(cf + (size_t)b * 6144 + col0 + bj * 128 + 4 * n); if (mul) c[bj][n] *= *(const f32x4*)(mul + col0 + bj * 128 + 4 * n); }
#pragma unroll
        for (int ai = 0; ai < 2; ++ai)
#pragma unroll
            for (int m = 0; m < 4; ++m) { const size_t ro = (size_t)(row0 + ai * 128 + m * 16) * D + col0;
                f32x4 s[2][2];
                if (F32SRC) {
#pragma unroll
                    for (int bj = 0; bj < 2; ++bj) { s[bj][0] = *(const GAS f32x4*)(X + ro + bj * 128); s[bj][1] = *(const GAS f32x4*)(X + ro + bj * 128 + 4); }
                } else {
#pragma unroll
                    for (int bj = 0; bj < 2; ++bj) { const v4u q = *(const GAS v4u*)(O + ro + bj * 128);
                        s[bj][0].x = bflo(q.x); s[bj][0].y = bfhi(q.x); s[bj][0].z = bflo(q.y); s[bj][0].w = bfhi(q.y); s[bj][1].x = bflo(q.z); s[bj][1].y = bfhi(q.z); s[bj][1].z = bflo(q.w); s[bj][1].w = bfhi(q.w); }
                }
#pragma unroll
                for (int bj = 0; bj < 2; ++bj) { const f32x4 v0 = s[bj][0] + c[bj][0] * acc[ai][bj][m][0], v1 = s[bj][1] + c[bj][1] * acc[ai][bj][m][1];
                    v4u w; w.x = pk2(v0[0], v0[1]); w.y = pk2(v0[2], v0[3]); w.z = pk2(v1[0], v1[1]); w.w = pk2(v1[2], v1[3]);
                    *(v4u*)(O + ro + bj * 128) = w; } }
    }
};
struct EpiSwiglu {
    bf16* O;
    __device__ __forceinline__ void operator()(const f32x4 (&acc)[2][2][4][2], const pg8::Unit& u, int wr, int wc, int fr, int fq) const {
        const int row0 = u.pm * 256 + wr * 64 + fr, col0 = u.pn * 128 + wc * 32 + 8 * fq;
#pragma unroll
        for (int ai = 0; ai < 2; ++ai)
#pragma unroll
            for (int m = 0; m < 4; ++m) { bf16* rowp = O + (size_t)(row0 + ai * 128 + m * 16) * DFF + col0;
                float r[8];
#pragma unroll
                for (int n = 0; n < 2; ++n)
#pragma unroll
                    for (int j = 0; j < 4; ++j) r[4 * n + j] = silu_f(acc[ai][0][m][n][j]) * acc[ai][1][m][n][j];
                v4u w; w.x = pk2(r[0], r[1]); w.y = pk2(r[2], r[3]); w.z = pk2(r[4], r[5]); w.w = pk2(r[6], r[7]);
                *(v4u*)rowp = w; }
    }
};

__device__ __forceinline__ void moe_route(Frame& F, int layer) {
    LAS int* hist = (LAS int*)(F.lds + RT_LDS_OFF);
    LAS int* base = hist + 32;
    LAS int* tinfo = hist + 64;
    LAS float* tg = (LAS float*)(hist + 64 + 512);
    if (F.tid < 32) hist[F.tid] = 0;
    LAS f32x4* R2 = (LAS f32x4*)(F.lds + RING_OFF);
    LAS f32x4* R1 = (LAS f32x4*)(F.lds + R1W_OFF);
    { const f32x4* g2p = (const f32x4*)(F.in[I_R2W] + (size_t)layer * 1024 * 32); const f32x4* g1p = (const f32x4*)(F.in[I_R1W] + (size_t)layer * 1024 * 4);
      for (int i = F.tid; i < 8192; i += 512) { const int k = i >> 3, c4 = i & 7, ln = (k & 255) >> 2, q = k & 3, j = k >> 8; R2[((j * 4 + q) * 8 + c4) * 64 + ln] = g2p[i]; }
      for (int k = F.tid; k < 1024; k += 512) { const int ln = (k & 255) >> 2, q = k & 3, j = k >> 8; R1[(j * 4 + q) * 64 + ln] = g1p[k]; } }
    __syncthreads();
    const float* mod = (const float*)(F.ws + WS_MOD) + (size_t)layer * 2 * 6144;
    bf16* H = (bf16*)(F.ws + WS_H);
    const int tokw = F.vcu * 128 + F.wave * 16, b = (F.vcu * 128) / SEQ;
    const ModVec m = load_mod(F.in[I_NFFN] + layer * D, mod + (size_t)b * 6144 + 4 * 1024, mod + (size_t)b * 6144 + 3 * 1024, F.lane);
    const float* r1b = F.in[I_R1B] + layer * 4; const float* r2b = F.in[I_R2B] + layer * 32;
    const bf16* XRB = (const bf16*)(F.ws + WS_XRB);
    v2u xbn[4], xb2[4];
    load_row_bf16(XRB + (size_t)tokw * D, F.lane, xbn); load_row_bf16(XRB + (size_t)(tokw + 1) * D, F.lane, xb2);
    for (int i = 0; i < 16; ++i) {
        const int t = tokw + i;
        const RowVec x = unpack_row_bf16(xbn);
#pragma unroll
        for (int j = 0; j < 4; ++j) xbn[j] = xb2[j];
        if (i + 2 < 16) load_row_bf16(XRB + (size_t)(t + 2) * D, F.lane, xb2);
        RowVec h = apply_mod(x, row_rstd(x), m);
        store_row_bf16(H + (size_t)t * D, F.lane, h);
        f32x4 l1 = {0.f, 0.f, 0.f, 0.f};
#pragma unroll
        for (int j = 0; j < 4; ++j)
#pragma unroll
            for (int q = 0; q < 4; ++q) l1 += R1[(j * 4 + q) * 64 + F.lane] * h.v[j][q];
        float lg[4];
#pragma unroll
        for (int g = 0; g < 4; ++g) lg[g] = wave_sum(l1[g]) + r1b[g];
        int grp = 0; float mx = lg[0];
#pragma unroll
        for (int g = 1; g < 4; ++g) if (lg[g] > mx) { mx = lg[g]; grp = g; }
        float se = 0.f;
#pragma unroll
        for (int g = 0; g < 4; ++g) se += __expf(lg[g] - mx);
        const float ptop = 1.0f / se;
        grp = __builtin_amdgcn_readfirstlane(grp);
        f32x4 a0 = {0.f, 0.f, 0.f, 0.f}, a1 = {0.f, 0.f, 0.f, 0.f};
#pragma unroll
        for (int j = 0; j < 4; ++j)
#pragma unroll
            for (int q = 0; q < 4; ++q) { const LAS f32x4* wp = R2 + ((j * 4 + q) * 8 + grp * 2) * 64 + F.lane;
                a0 += wp[0] * h.v[j][q]; a1 += wp[64] * h.v[j][q]; }
        float l2[8];
#pragma unroll
        for (int q = 0; q < 4; ++q) { l2[q] = wave_sum(a0[q]) + r2b[grp * 8 + q]; l2[4 + q] = wave_sum(a1[q]) + r2b[grp * 8 + 4 + q]; }
        int i0 = 0; float v0 = l2[0];
#pragma unroll
        for (int q = 1; q < 8; ++q) if (l2[q] > v0) { v0 = l2[q]; i0 = q; }
        int i1 = (i0 == 0) ? 1 : 0; float v1 = l2[i1 == 1 ? 1 : 0];
#pragma unroll
        for (int q = 0; q < 8; ++q) if (q != i0 && l2[q] > v1) { v1 = l2[q]; i1 = q; }
        const float g0 = ptop / (1.0f + __expf(v1 - v0)), g1 = ptop - g0;
        if (F.lane == 0) { const int e0 = grp * 8 + i0, e1 = grp * 8 + i1, li = F.wave * 16 + i;
            tinfo[li * 4 + 0] = e0; tinfo[li * 4 + 1] = e1; tinfo[li * 4 + 2] = atomicAdd((int*)(hist + e0), 1); tinfo[li * 4 + 3] = atomicAdd((int*)(hist + e1), 1);
            tg[li * 2] = g0; tg[li * 2 + 1] = g1;
            { float* GA = (float*)(F.ws + WS_BG); GA[(size_t)t * 2] = g0; GA[(size_t)t * 2 + 1] = g1; }
        }
    }
    __syncthreads();
    if (F.tid < 32) base[F.tid] = (int)__hip_atomic_fetch_add(F.ctl + CW_CNT + 64 * layer + F.tid, (unsigned)hist[F.tid], RLX_AGENT);
    __syncthreads();
    if (F.tid < 128) { const int t = F.vcu * 128 + F.tid; const int e0 = tinfo[F.tid * 4], e1 = tinfo[F.tid * 4 + 1];
        const int p0 = base[e0] + tinfo[F.tid * 4 + 2], p1 = base[e1] + tinfo[F.tid * 4 + 3];
        int* RT = (int*)(F.ws + WS_RT); RT[e0 * NTOK + p0] = t; RT[e1 * NTOK + p1] = t;
        v4u r0; r0.x = e0; r0.y = e1; r0.z = p0; r0.w = p1; v4u r1; r1.x = __builtin_bit_cast(unsigned, tg[F.tid * 2]); r1.y = __builtin_bit_cast(unsigned, tg[F.tid * 2 + 1]); r1.z = 0; r1.w = 0;
        v4u* RO = (v4u*)(F.ws + WS_ROUTE) + (size_t)t * 2; RO[0] = r0; (void)r1; }
    __syncthreads();
}

struct CombRows { v2u xb[4], ya[4], yb[4]; };
struct CombRecs { v4u rec; float ga, gb; };
__device__ __forceinline__ CombRecs comb_load_recs(Frame& F, int tokw) { CombRecs c; const int t = tokw + (F.lane & 15);
    c.rec = *((const v4u*)(F.ws + WS_ROUTE) + (size_t)t * 2); const float* GA = (const float*)(F.ws + WS_BG); c.ga = GA[(size_t)t * 2]; c.gb = GA[(size_t)t * 2 + 1]; return c; }
__device__ __forceinline__ int rl_i(int v, int l) { return __builtin_amdgcn_readlane(v, l); }
__device__ __forceinline__ void comb_issue(Frame& F, const CombRecs& c, int i, int t, CombRows& r) {
    const LAS int* T = (const LAS int*)(F.lds + SCHED_OFF);
    const int e0 = rl_i((int)c.rec.x, i), e1 = rl_i((int)c.rec.y, i), p0 = rl_i((int)c.rec.z, i), p1 = rl_i((int)c.rec.w, i);
    const size_t rowa = (size_t)T[32 + e0] * 256 + p0, rowb = (size_t)T[32 + e1] * 256 + p1;
    const bf16* Y = (const bf16*)(F.ws + WS_Y);
    const GAS v2u* ya = (const GAS v2u*)(Y + rowa * D) + F.lane; const GAS v2u* yb = (const GAS v2u*)(Y + rowb * D) + F.lane;
    load_row_bf16((const bf16*)(F.ws + WS_XRB) + (size_t)t * D, F.lane, r.xb);
#pragma unroll
    for (int j = 0; j < 4; ++j) { r.ya[j] = ya[64 * j]; r.yb[j] = yb[64 * j]; }
}
__device__ __forceinline__ RowVec comb_finish(const CombRecs& c, int i, const CombRows& r, const f32x4 (&g2)[4]) {
    const float ga = rl(c.ga, i), gb = rl(c.gb, i); RowVec x = unpack_row_bf16(r.xb);
#pragma unroll
    for (int j = 0; j < 4; ++j) { const v2u a = r.ya[j], bq = r.yb[j];
        f32x4 s; s.x = ga * bflo(a.x) + gb * bflo(bq.x); s.y = ga * bfhi(a.x) + gb * bfhi(bq.x); s.z = ga * bflo(a.y) + gb * bflo(bq.y); s.w = ga * bfhi(a.y) + gb * bfhi(bq.y);
        x.v[j] += g2[j] * s; }
    return x;
}

__device__ __forceinline__ void attn_phase(Frame& F, const int u_first, const int u_stride) {
    LAS bf16* KS = (LAS bf16*)(F.lds + RING_OFF);
    LAS bf16* VT = (LAS bf16*)(F.lds + RING_OFF + 36864);
    LAS float* BT = (LAS float*)(F.lds + RING_OFF + 36864 + 33280);
    const bf16* PROJ = (const bf16*)(F.ws + WS_PROJ); bf16* OAB = (bf16*)(F.ws + WS_OAB);
    const int lane = F.lane, lc = lane & 31, lh = lane >> 5;
    for (int unit = u_first; unit < 512; unit += u_stride) {
        const int b = unit >> 8, kvh = (unit >> 7) & 1, qb = unit & 127, t0 = qb * 128;
        __syncthreads();
        for (int i = F.tid; i < 4 * 192; i += 512) { const int hq = i / 192, x = i - hq * 192, dist = 159 - x; float v = 0.f;
            if (dist >= 0 && dist < 128) { int bk = dist; if (dist >= 16) { bk = 16 + (int)(logf((float)dist / 16.0f) / 2.0794415416798357f * 16.0f); bk = bk > 31 ? 31 : bk; }
                v = F.in[I_RELB][bk * 8 + kvh * 4 + hq] * 1.4426950408889634f; }
            BT[i] = v; }
#pragma unroll
        for (int cc = 0; cc < 4; ++cc) { const int ch = F.tid + 512 * cc, key = ch >> 3, part = ch & 7, tl = t0 - 128 + key;
            v4u kv = {0u, 0u, 0u, 0u}, vv = {0u, 0u, 0u, 0u};
            if (tl >= 0) { const bf16* rp = PROJ + (size_t)(b * SEQ + tl) * PIN; kv = *(const v4u*)(rp + PC_KB + kvh * 64 + part * 8); vv = *(const v4u*)(rp + PC_VB + kvh * 64 + part * 8); }
            *(LAS v4u*)(KS + key * 72 + part * 8) = kv;
            const unsigned w[4] = {vv.x, vv.y, vv.z, vv.w};
#pragma unroll
            for (int q = 0; q < 4; ++q) { VT[(part * 8 + 2 * q) * 260 + key] = (bf16)(w[q] & 0xffffu); VT[(part * 8 + 2 * q + 1) * 260 + key] = (bf16)(w[q] >> 16); } }
        __syncthreads();
#pragma unroll 1
        for (int tt = 0; tt < 2; ++tt) {
            const int task = F.wave * 2 + tt, hq = task >> 2, qt = task & 3, qh = kvh * 4 + hq;
            const int qi = 32 * qt + lc;
            const bf16* qrow = PROJ + (size_t)(b * SEQ + t0 + qi) * PIN + PC_QB + qh * 64 + 8 * lh;
            bf16x8 qf[4];
#pragma unroll
            for (int s = 0; s < 4; ++s) qf[s] = *(const bf16x8*)(qrow + 16 * s);
            f32x16 sc[5];
#pragma unroll
            for (int kt = 0; kt < 5; ++kt) {
#pragma unroll
                for (int r = 0; r < 16; ++r) sc[kt][r] = 0.f;
                const LAS bf16* kp = KS + (32 * (qt + kt) + lc) * 72 + 8 * lh;
#pragma unroll
                for (int s = 0; s < 4; ++s) { const bf16x8 kf = *(const LAS bf16x8*)(kp + 16 * s); sc[kt] = __builtin_amdgcn_mfma_f32_32x32x16_bf16(kf, qf[s], sc[kt], 0, 0, 0); }
            }
            const float sink2 = F.in[I_SINKS][qh] * 1.4426950408889634f;
            const LAS float* bp = BT + hq * 192 + (4 * lh - lc + 31);
            const int m_lo = lc + 1 - 4 * lh, m_hi = lc - 4 * lh;
            float mx = sink2;
#pragma unroll
            for (int kt = 0; kt < 5; ++kt) {
                const bool dead = (t0 == 0) && (qt + kt < 4);
#pragma unroll
                for (int r = 0; r < 16; ++r) { const int cr = (r & 3) + 8 * (r >> 2);
                    float v = sc[kt][r] * (0.125f * 1.4426950408889634f) + bp[32 * kt + cr];
                    if (kt == 0) v = (cr >= m_lo) ? v : -1e30f;
                    if (kt == 4) v = (cr <= m_hi) ? v : -1e30f;
                    if (dead) v = -1e30f;
                    sc[kt][r] = v; mx = fmaxf(mx, v); } }
            mx = fmaxf(mx, __shfl_xor(mx, 32));
            float den = 0.f;
#pragma unroll
            for (int kt = 0; kt < 5; ++kt)
#pragma unroll
                for (int r = 0; r < 16; ++r) { const float p = __builtin_amdgcn_exp2f(sc[kt][r] - mx); sc[kt][r] = p; den += p; }
            den += __shfl_xor(den, 32);
            den += __builtin_amdgcn_exp2f(sink2 - mx);
            const float inv = 1.0f / den;
            f32x16 oa[2];
#pragma unroll
            for (int dt = 0; dt < 2; ++dt)
#pragma unroll
                for (int r = 0; r < 16; ++r) oa[dt][r] = 0.f;
#pragma unroll
            for (int kt = 0; kt < 5; ++kt)
#pragma unroll
                for (int s2 = 0; s2 < 2; ++s2) {
                    v4u pw; pw.x = pk2(sc[kt][8 * s2 + 0], sc[kt][8 * s2 + 1]); pw.y = pk2(sc[kt][8 * s2 + 2], sc[kt][8 * s2 + 3]); pw.z = pk2(sc[kt][8 * s2 + 4], sc[kt][8 * s2 + 5]); pw.w = pk2(sc[kt][8 * s2 + 6], sc[kt][8 * s2 + 7]);
                    const bf16x8 pf = __builtin_bit_cast(bf16x8, pw);
#pragma unroll
                    for (int dt = 0; dt < 2; ++dt) { const LAS bf16* vp = VT + (32 * dt + lc) * 260 + 32 * (qt + kt) + 16 * s2 + 4 * lh;
                        const v2u va = *(const LAS v2u*)vp, vb = *(const LAS v2u*)(vp + 8);
                        v4u vw; vw.x = va.x; vw.y = va.y; vw.z = vb.x; vw.w = vb.y;
                        oa[dt] = __builtin_amdgcn_mfma_f32_32x32x16_bf16(__builtin_bit_cast(bf16x8, vw), pf, oa[dt], 0, 0, 0); }
                }
            bf16* orow = OAB + (size_t)(b * SEQ + t0 + qi) * D + 512 + qh * 64 + 4 * lh;
#pragma unroll
            for (int dt = 0; dt < 2; ++dt)
#pragma unroll
                for (int rg = 0; rg < 4; ++rg) { v2u o; o.x = pk2(oa[dt][4 * rg] * inv, oa[dt][4 * rg + 1] * inv); o.y = pk2(oa[dt][4 * rg + 2] * inv, oa[dt][4 * rg + 3] * inv);
                    *(v2u*)(orow + 32 * dt + 8 * rg) = o; }
        }
    }
    __syncthreads();
}


constexpr int DN_ST = 72;

__device__ __forceinline__ bf16x8 pack8(const f32x16& x, int s) { v4u p; p.x = pk2(x[8 * s], x[8 * s + 1]); p.y = pk2(x[8 * s + 2], x[8 * s + 3]); p.z = pk2(x[8 * s + 4], x[8 * s + 5]); p.w = pk2(x[8 * s + 6], x[8 * s + 7]); return __builtin_bit_cast(bf16x8, p); }
__device__ __forceinline__ f32x16 dn_tile(const LAS bf16* A, int ra, const LAS bf16* B, int rb, int lc, int lh) {
    f32x16 acc;
#pragma unroll
    for (int r = 0; r < 16; ++r) acc[r] = 0.f;
#pragma unroll
    for (int s = 0; s < 4; ++s) { const bf16x8 a = *(const LAS bf16x8*)(A + (ra + lc) * DN_ST + 16 * s + 8 * lh), b = *(const LAS bf16x8*)(B + (rb + lc) * DN_ST + 16 * s + 8 * lh);
        acc = __builtin_amdgcn_mfma_f32_32x32x16_bf16(a, b, acc, 0, 0, 0); }
    return acc;
}
__device__ __forceinline__ void dn_prep(Frame& F) {
    LAS bf16* Qs = (LAS bf16*)(F.lds + RING_OFF);
    LAS bf16* Ks = Qs + 64 * DN_ST;
    LAS bf16* KBs = Ks + 64 * DN_ST;
    LAS bf16* Vs = KBs + 64 * DN_ST;
    LAS bf16* KDT = Vs + 64 * DN_ST;
    LAS bf16* AQK = KDT + 64 * DN_ST;
    LAS bf16* UT = AQK + 64 * DN_ST;
    LAS bf16* WT = UT + 64 * DN_ST;
    LAS bf16* LNO = WT + 64 * DN_ST;
    LAS float* LD = (LAS float*)(LNO + 64 * DN_ST);
    LAS bf16* TDZ = (LAS bf16*)(LD + 64 * 16);
    LAS float* GB = (LAS float*)(TDZ + 64 * 24);
    const bf16* PROJ = (const bf16*)(F.ws + WS_PROJ); const float* BG = (const float*)(F.ws + WS_BG);
    const int tid = F.tid, lane = F.lane, lc = lane & 31, lh = lane >> 5, wave = F.wave;
    LAS float* CW = GB + 256;
    for (int i = tid; i < 1536; i += 512) *((LAS f32x4*)CW + i) = *((const f32x4*)F.in[I_CONVW] + i);
    LAS v4u* RAW = (LAS v4u*)(F.lds + R1W_OFF);
    constexpr int RAW_CH = 67 * 24;
#define DN_RAW_SRC(i_, b_, h_, n_) ({ const int r_ = (i_) / 24, c_ = (i_) - r_ * 24; const int tl_ = (n_) * 64 - 3 + r_; \
        tl_ >= 0 ? (const v4u*)(PROJ + ((size_t)(b_) * SEQ + tl_) * PIN + (c_ < 8 ? PC_QA : c_ < 16 ? PC_KA : PC_VA) + (h_) * 64 + (c_ & 7) * 8) : (const v4u*)nullptr; })
    { const int u0 = F.vcu, b = u0 >> 11, h = (u0 >> 8) & 7, n = u0 & 255;
      for (int i = tid; i < RAW_CH; i += 512) { const v4u* sp = DN_RAW_SRC(i, b, h, n); v4u z = {0u, 0u, 0u, 0u}; if (sp) z = *sp; RAW[i] = z; }
      if (wave == 0) { const size_t row0 = (size_t)b * SEQ + (size_t)n * 64; float c = BG[(row0 + lane) * 16 + 8 + h];
#pragma unroll
          for (int o = 1; o < 64; o <<= 1) { const float up = __shfl_up(c, o); if (lane >= o) c += up; }
          GB[lane] = c; GB[64 + lane] = BG[(row0 + lane) * 16 + h]; } }
    int par = 0;
    for (int unit = F.vcu; unit < 4096; unit += F.G, par ^= 1) {
        const int b = unit >> 11, h = (unit >> 8) & 7, n = unit & 255;
        LAS float* gcs = GB + par * 128; LAS float* bts = gcs + 64;
        const int un = unit + F.G; const bool more = un < 4096; const int bn = un >> 11, hn = (un >> 8) & 7, nn = un & 255;
        __syncthreads();
        { const int t = tid >> 3, cs = tid & 7;
          float q[8], k[8], v[8];
#pragma unroll
          for (int e = 0; e < 8; ++e) { q[e] = 0.f; k[e] = 0.f; v[e] = 0.f; }
#pragma unroll
          for (int j = 0; j < 4; ++j) { { const LAS v4u* rp = RAW + (t + j) * 24 + cs;
                const v4u wq = rp[0], wk = rp[8], wv = rp[16];
                const LAS float* cw = CW + j * 1536 + h * 64 + cs * 8;
                const unsigned uq[4] = {wq.x, wq.y, wq.z, wq.w}, uk[4] = {wk.x, wk.y, wk.z, wk.w}, uv[4] = {wv.x, wv.y, wv.z, wv.w};
#pragma unroll
                for (int e = 0; e < 4; ++e) { q[2 * e] += cw[2 * e] * bflo(uq[e]); q[2 * e + 1] += cw[2 * e + 1] * bfhi(uq[e]);
                    k[2 * e] += cw[512 + 2 * e] * bflo(uk[e]); k[2 * e + 1] += cw[512 + 2 * e + 1] * bfhi(uk[e]);
                    v[2 * e] += cw[1024 + 2 * e] * bflo(uv[e]); v[2 * e + 1] += cw[1024 + 2 * e + 1] * bfhi(uv[e]); } } }
          float sq = 0.f, sk = 0.f;
#pragma unroll
          for (int e = 0; e < 8; ++e) { q[e] = silu_f(q[e]); k[e] = silu_f(k[e]); v[e] = silu_f(v[e]); sq += q[e] * q[e]; sk += k[e] * k[e]; }
          sq = oct_sum(sq); sk = oct_sum(sk);
          const float rq = 0.125f / sqrtf(sq + EPS), rk = 1.0f / sqrtf(sk + EPS), bt = bts[t], kd = __expf(gcs[63] - gcs[t]);
          v4u oq, ok, ob, ov;
          oq.x = pk2(q[0] * rq, q[1] * rq); oq.y = pk2(q[2] * rq, q[3] * rq); oq.z = pk2(q[4] * rq, q[5] * rq); oq.w = pk2(q[6] * rq, q[7] * rq);
#pragma unroll
          for (int e = 0; e < 8; ++e) k[e] *= rk;
          ok.x = pk2(k[0], k[1]); ok.y = pk2(k[2], k[3]); ok.z = pk2(k[4], k[5]); ok.w = pk2(k[6], k[7]);
          ob.x = pk2(k[0] * bt, k[1] * bt); ob.y = pk2(k[2] * bt, k[3] * bt); ob.z = pk2(k[4] * bt, k[5] * bt); ob.w = pk2(k[6] * bt, k[7] * bt);
          ov.x = pk2(v[0], v[1]); ov.y = pk2(v[2], v[3]); ov.z = pk2(v[4], v[5]); ov.w = pk2(v[6], v[7]);
          *(LAS v4u*)(Qs + t * DN_ST + cs * 8) = oq; *(LAS v4u*)(Ks + t * DN_ST + cs * 8) = ok; *(LAS v4u*)(KBs + t * DN_ST + cs * 8) = ob; *(LAS v4u*)(Vs + t * DN_ST + cs * 8) = ov;
#pragma unroll
          for (int e = 0; e < 8; ++e) KDT[(cs * 8 + e) * DN_ST + t] = (bf16)f2bf(k[e] * kd); }
        __syncthreads();
        v4u pf[7]; float pg = 0.f, pb = 0.f;
        if (wave >= 4 && more) {
#pragma unroll
            for (int k7 = 0; k7 < 7; ++k7) { const int i = (tid - 256) + 256 * k7; pf[k7] = (v4u){0u, 0u, 0u, 0u}; if (i < RAW_CH) { const v4u* sp = DN_RAW_SRC(i, bn, hn, nn); if (sp) pf[k7] = *sp; } }
            if (wave == 4) { const size_t rn = (size_t)bn * SEQ + (size_t)nn * 64; pg = BG[(rn + lane) * 16 + 8 + hn]; pb = BG[(rn + lane) * 16 + hn]; }
        }
        { const int it = (wave >> 1) & 1, jt = wave & 1; const bool qk = wave >= 4;
          f32x16 acc;
          if (it >= jt) acc = dn_tile(qk ? Qs : KBs, 32 * it, Ks, 32 * jt, lc, lh);
          const int j = 32 * jt + lc; const float gj = gcs[j];
#pragma unroll
          for (int r = 0; r < 16; ++r) { const int i = 32 * it + (r & 3) + 8 * (r >> 2) + 4 * lh;
              float val = 0.f;
              if (it >= jt) { if (qk ? (i >= j) : (i > j)) val = acc[r] * __expf(gcs[i] - gj); }
              if (qk) AQK[i * DN_ST + j] = (bf16)f2bf(val);
              else { const bool diag = (i >> 4) == (j >> 4); LNO[i * DN_ST + j] = (bf16)f2bf(diag ? 0.f : -val); if (diag) LD[i * 16 + (j & 15)] = val; } } }
        __syncthreads();
        if (wave == 0) { const int bb = lane >> 4, c = lane & 15; float tcol[16];
#pragma unroll
            for (int i = 0; i < 16; ++i) { float v = (i == c) ? 1.f : 0.f;
#pragma unroll
                for (int j4 = 0; j4 < (i + 3) / 4; ++j4) { const f32x4 a = *(const LAS f32x4*)(LD + (16 * bb + i) * 16 + 4 * j4);
#pragma unroll
                    for (int e = 0; e < 4; ++e) if (4 * j4 + e < i) v -= a[e] * tcol[4 * j4 + e]; }
                tcol[i] = v; TDZ[(16 * bb + i) * 24 + c] = (bf16)f2bf(v); } }
        __syncthreads();
        if (wave < 4) {
            const int ct = wave, cc = 32 * (ct & 1) + lc; const bool isw = ct >= 2;
            f32x16 acc[2];
#pragma unroll
            for (int rt = 0; rt < 2; ++rt)
#pragma unroll
                for (int r = 0; r < 16; ++r) { const int t = 32 * rt + (r & 3) + 8 * (r >> 2) + 4 * lh;
                    acc[rt][r] = isw ? bf2f(Ks[t * DN_ST + cc]) * bts[t] * __expf(gcs[t]) : bf2f(Vs[t * DN_ST + cc]) * bts[t]; }
#define DN_AFRAG(arr, stride, row, kb) ({ const LAS bf16* p_ = (arr) + (row) * (stride) + 16 * (kb) + 4 * lh; const v2u lo_ = *(const LAS v2u*)p_, hi_ = *(const LAS v2u*)(p_ + 8); v4u w_; w_.x = lo_.x; w_.y = lo_.y; w_.z = hi_.x; w_.w = hi_.y; __builtin_bit_cast(bf16x8, w_); })
            f32x16 X[4];
#pragma unroll
            for (int bb = 0; bb < 4; ++bb) { const int rt = bb >> 1, odd = bb & 1;
                bf16x8 ta = DN_AFRAG(TDZ, 24, 32 * rt + lc, 0);
                if ((lc >> 4) != odd) ta = (bf16x8){0, 0, 0, 0, 0, 0, 0, 0};
                f32x16 z;
#pragma unroll
                for (int r = 0; r < 16; ++r) z[r] = 0.f;
                z = __builtin_amdgcn_mfma_f32_32x32x16_bf16(ta, pack8(acc[rt], odd), z, 0, 0, 0);
                X[bb] = z;
                const bf16x8 xb = pack8(z, odd);
                if (bb == 0) { acc[0] = __builtin_amdgcn_mfma_f32_32x32x16_bf16(DN_AFRAG(LNO, DN_ST, lc, 0), xb, acc[0], 0, 0, 0); acc[1] = __builtin_amdgcn_mfma_f32_32x32x16_bf16(DN_AFRAG(LNO, DN_ST, 32 + lc, 0), xb, acc[1], 0, 0, 0); }
                if (bb == 1) { acc[1] = __builtin_amdgcn_mfma_f32_32x32x16_bf16(DN_AFRAG(LNO, DN_ST, 32 + lc, 1), xb, acc[1], 0, 0, 0); }
                if (bb == 2) { acc[1] = __builtin_amdgcn_mfma_f32_32x32x16_bf16(DN_AFRAG(LNO, DN_ST, 32 + lc, 2), xb, acc[1], 0, 0, 0); }
            }
#undef DN_AFRAG
            LAS bf16* dst = (isw ? WT : UT) + cc * DN_ST;
#pragma unroll
            for (int bb = 0; bb < 4; ++bb)
#pragma unroll
                for (int g = 0; g < 2; ++g) { const int r0 = 8 * (bb & 1) + 4 * g; v2u o; o.x = pk2(X[bb][r0], X[bb][r0 + 1]); o.y = pk2(X[bb][r0 + 2], X[bb][r0 + 3]);
                    *(LAS v2u*)(dst + 16 * bb + 8 * g + 4 * lh) = o; }
        } else if (more) {
#pragma unroll
            for (int k7 = 0; k7 < 7; ++k7) { const int i = (tid - 256) + 256 * k7; if (i < RAW_CH) RAW[i] = pf[k7]; }
            if (wave == 4) { float c = pg;
#pragma unroll
                for (int o = 1; o < 64; o <<= 1) { const float up = __shfl_up(c, o); if (lane >= o) c += up; }
                GB[(par ^ 1) * 128 + lane] = c; GB[(par ^ 1) * 128 + 64 + lane] = pb; }
        }
        __syncthreads();
        { bf16* MT = (bf16*)((unsigned char*)F.out + OUT_DN_MT) + (size_t)unit * 4096; bf16* QPT = (bf16*)((unsigned char*)F.out + OUT_DN_QPT) + (size_t)unit * 4096;
          bf16* BM = (bf16*)(F.ws + WS_DN_BM) + (size_t)unit * 4096; bf16* O0T = (bf16*)(F.ws + WS_DN_O0T) + (size_t)unit * 4096;
#pragma unroll 1
          for (int tt = 0; tt < 2; ++tt) { const int task = wave * 2 + tt, p = task >> 2, ta = (task >> 1) & 1, tb = task & 1;
              if (p == 0) {
                  f32x16 acc = dn_tile(WT, 32 * ta, KDT, 32 * tb, lc, lh);
#pragma unroll
                  for (int r = 0; r < 16; ++r) acc[r] = -acc[r];
#pragma unroll
                  for (int s2 = 0; s2 < 2; ++s2) *(bf16x8*)(MT + ((((tb * 2 + ta) * 2 + s2) * 64 + lane) * 8)) = pack8(acc, s2);
              } else if (p == 1) {
                  const f32x16 acc = dn_tile(KDT, 32 * ta, UT, 32 * tb, lc, lh);
#pragma unroll
                  for (int s2 = 0; s2 < 2; ++s2) *(bf16x8*)(BM + ((((tb * 2 + ta) * 2 + s2) * 64 + lane) * 8)) = pack8(acc, s2);
              } else if (p == 2) {
                  f32x16 acc = dn_tile(WT, 32 * ta, AQK, 32 * tb, lc, lh);
                  const int i = 32 * tb + lc; const float eg = __expf(gcs[i]);
#pragma unroll
                  for (int r = 0; r < 16; ++r) { const int a = 32 * ta + (r & 3) + 8 * (r >> 2) + 4 * lh; acc[r] = bf2f(Qs[i * DN_ST + a]) * eg - acc[r]; }
#pragma unroll
                  for (int s2 = 0; s2 < 2; ++s2) *(bf16x8*)(QPT + ((((tb * 2 + ta) * 2 + s2) * 64 + lane) * 8)) = pack8(acc, s2);
              } else {
                  const f32x16 acc = dn_tile(UT, 32 * ta, AQK, 32 * tb, lc, lh);
#pragma unroll
                  for (int s2 = 0; s2 < 2; ++s2) *(bf16x8*)(O0T + ((((tb * 2 + ta) * 2 + s2) * 64 + lane) * 8)) = pack8(acc, s2);
              } }
          if (tid == 0) ((float*)(F.ws + WS_DN_GT))[unit] = __expf(gcs[63]); }
    }
#undef DN_RAW_SRC
    __syncthreads();
}
template <int r>
__device__ __forceinline__ void dn_scan_wave(Frame& F) {
    const int bx = (int)blockIdx.x, w = (bx & 7) * 4 + (bx >> 3), bh = w >> 1, ct = w & 1, lane = F.lane;
    const bf16x8* MT = (const bf16x8*)((const unsigned char*)F.out + OUT_DN_MT); const bf16x8* BM = (const bf16x8*)(F.ws + WS_DN_BM); bf16x8* SS = (bf16x8*)(F.ws + WS_DN_S);
    const float* GT = (const float*)(F.ws + WS_DN_GT);
    LAS bf16x8* MB = (LAS bf16x8*)(F.lds + RING_OFF);
    volatile LAS int* FL = (volatile LAS int*)(F.lds + LDSCTL_OFF + 64);
    f32x16 S;
#pragma unroll
    for (int q = 0; q < 16; ++q) S[q] = 0.f;
    bf16x8 mA[4], bA[2], mB[4], bB[2], mC[4], bC[2], mD[4], bD[2], mE[4], bE[2], mG[4], bG[2]; float gA, gB, gC, gD, gE, gG;
#define DN_SLOAD(m, bm, gt, u) do { const size_t ub = (size_t)(u) * 512; _Pragma("unroll") for (int f = 0; f < 4; ++f) m[f] = MT[ub + (r * 4 + f) * 64 + lane]; \
        _Pragma("unroll") for (int f = 0; f < 2; ++f) bm[f] = BM[ub + ((ct * 2 + r) * 2 + f) * 64 + lane]; gt = GT[u]; } while (0)
#define DN_STEP(cm, cb, cg, unit, n) do { \
        bf16x8 own[2]; own[0] = pack8(S, 0); own[1] = pack8(S, 1); \
        LAS bf16x8* mb = MB + ((n) & 1) * 256; \
        mb[(r * 2 + 0) * 64 + lane] = own[0]; mb[(r * 2 + 1) * 64 + lane] = own[1]; \
        asm volatile("s_waitcnt lgkmcnt(0)" ::: "memory"); \
        if (lane == 0) FL[r] = (n) + 1; \
        SS[(size_t)(unit) * 512 + (ct * 4 + r * 2 + 0) * 64 + lane] = own[0]; SS[(size_t)(unit) * 512 + (ct * 4 + r * 2 + 1) * 64 + lane] = own[1]; \
        f32x16 A; \
        { const v4u b0 = __builtin_bit_cast(v4u, cb[0]), b1 = __builtin_bit_cast(v4u, cb[1]); const unsigned u0[8] = {b0.x, b0.y, b0.z, b0.w, b1.x, b1.y, b1.z, b1.w}; \
          _Pragma("unroll") for (int e = 0; e < 8; ++e) { A[2 * e] = cg * S[2 * e] + bflo(u0[e]); A[2 * e + 1] = cg * S[2 * e + 1] + bfhi(u0[e]); } } \
        while (FL[1 - r] < (n) + 1) { } \
        asm volatile("" ::: "memory"); \
        bf16x8 oth[2]; oth[0] = mb[((1 - r) * 2 + 0) * 64 + lane]; oth[1] = mb[((1 - r) * 2 + 1) * 64 + lane]; \
          \
        _Pragma("unroll") for (int s2 = 0; s2 < 2; ++s2) { A = __builtin_amdgcn_mfma_f32_32x32x16_bf16(cm[r * 2 + s2], own[s2], A, 0, 0, 0); A = __builtin_amdgcn_mfma_f32_32x32x16_bf16(cm[(1 - r) * 2 + s2], oth[s2], A, 0, 0, 0); } \
        S = A; } while (0)
    const int u0 = bh * 256;
    DN_SLOAD(mA, bA, gA, u0); DN_SLOAD(mB, bB, gB, u0 + 1); DN_SLOAD(mC, bC, gC, u0 + 2); DN_SLOAD(mD, bD, gD, u0 + 3); DN_SLOAD(mE, bE, gE, u0 + 4); DN_SLOAD(mG, bG, gG, u0 + 5);
    for (int n = 0; n < 252; n += 6) {
        DN_STEP(mA, bA, gA, u0 + n, n);         DN_SLOAD(mA, bA, gA, u0 + n + 6);
        DN_STEP(mB, bB, gB, u0 + n + 1, n + 1); DN_SLOAD(mB, bB, gB, u0 + n + 7);
        DN_STEP(mC, bC, gC, u0 + n + 2, n + 2); DN_SLOAD(mC, bC, gC, u0 + n + 8);
        DN_STEP(mD, bD, gD, u0 + n + 3, n + 3); DN_SLOAD(mD, bD, gD, u0 + n + 9);
        DN_STEP(mE, bE, gE, u0 + n + 4, n + 4); if (n + 10 < 256) DN_SLOAD(mE, bE, gE, u0 + n + 10);
        DN_STEP(mG, bG, gG, u0 + n + 5, n + 5); if (n + 11 < 256) DN_SLOAD(mG, bG, gG, u0 + n + 11);
    }
    DN_STEP(mA, bA, gA, u0 + 252, 252); DN_STEP(mB, bB, gB, u0 + 253, 253); DN_STEP(mC, bC, gC, u0 + 254, 254); DN_STEP(mD, bD, gD, u0 + 255, 255);
#undef DN_SLOAD
#undef DN_STEP
}
__device__ __forceinline__ void dn_scan(Frame& F) {
    if ((int)blockIdx.x >= 32) return;
    if (F.wave == 0) dn_scan_wave<0>(F); else if (F.wave == 1) dn_scan_wave<1>(F);
}
__device__ __forceinline__ void dn_output(Frame& F) {
    const bf16x8* QPT = (const bf16x8*)((const unsigned char*)F.out + OUT_DN_QPT); const bf16x8* O0T = (const bf16x8*)(F.ws + WS_DN_O0T); const bf16x8* SS = (const bf16x8*)(F.ws + WS_DN_S);
    const bf16* PROJ = (const bf16*)(F.ws + WS_PROJ); bf16* OAB = (bf16*)(F.ws + WS_OAB);
    const int lane = F.lane, lc = lane & 31, lh = lane >> 5; int nbad = 0; (void)nbad;
    for (int task = F.vcu * NWAVES + F.wave; task < 8192; task += F.G * NWAVES) {
        const int unit = task >> 1, it = task & 1, b = unit >> 11, h = (unit >> 8) & 7, n = unit & 255;
        const size_t ub = (size_t)unit * 512;
        f32x16 o[2];
#pragma unroll
        for (int ct = 0; ct < 2; ++ct) {
            const v4u c0 = __builtin_bit_cast(v4u, O0T[ub + ((it * 2 + ct) * 2 + 0) * 64 + lane]), c1 = __builtin_bit_cast(v4u, O0T[ub + ((it * 2 + ct) * 2 + 1) * 64 + lane]);
            const unsigned u[8] = {c0.x, c0.y, c0.z, c0.w, c1.x, c1.y, c1.z, c1.w};
#pragma unroll
            for (int e = 0; e < 8; ++e) { o[ct][2 * e] = bflo(u[e]); o[ct][2 * e + 1] = bfhi(u[e]); }
#pragma unroll
            for (int at = 0; at < 2; ++at)
#pragma unroll
                for (int s2 = 0; s2 < 2; ++s2) o[ct] = __builtin_amdgcn_mfma_f32_32x32x16_bf16(SS[ub + (ct * 4 + at * 2 + s2) * 64 + lane], QPT[ub + ((it * 2 + at) * 2 + s2) * 64 + lane], o[ct], 0, 0, 0);
        }
        float ss = 0.f;
#pragma unroll
        for (int ct = 0; ct < 2; ++ct)
#pragma unroll
            for (int r = 0; r < 16; ++r) ss += o[ct][r] * o[ct][r];
        ss += __shfl_xor(ss, 32);
        const float rs = 1.0f / sqrtf(ss * (1.0f / 64.0f) + EPS);
        const size_t row = (size_t)b * SEQ + (size_t)n * 64 + it * 32 + lc;
#pragma unroll
        for (int ct = 0; ct < 2; ++ct)
#pragma unroll
            for (int rg = 0; rg < 4; ++rg) { const int c0 = 32 * ct + 8 * rg + 4 * lh;
                const v2u zz = *(const v2u*)(PROJ + row * PIN + PC_ZA + h * 64 + c0); const f32x4 ow = *(const f32x4*)(F.in[I_ONORM] + c0);
                const float z0 = bflo(zz.x), z1 = bfhi(zz.x), z2 = bflo(zz.y), z3 = bfhi(zz.y);
                v2u ov; ov.x = pk2(o[ct][4 * rg] * rs * ow[0] * silu_f(z0), o[ct][4 * rg + 1] * rs * ow[1] * silu_f(z1)); ov.y = pk2(o[ct][4 * rg + 2] * rs * ow[2] * silu_f(z2), o[ct][4 * rg + 3] * rs * ow[3] * silu_f(z3));
                *(v2u*)(OAB + row * D + h * 64 + c0) = ov;
            }
    }
}

template <int WIN>
__device__ __forceinline__ void pooled_block(const bf16* H, bf16* P, const int t0, const int tl0, const int col) {
    v4u r[WIN - 1 + 8];
#pragma unroll
    for (int j = 0; j < WIN - 1 + 8; ++j) { const int dt = j - (WIN - 1); r[j] = (v4u){0u, 0u, 0u, 0u}; if (tl0 + dt >= 0) r[j] = *(const v4u*)(H + (size_t)(t0 + dt) * D + col); }
    float s[8];
#pragma unroll
    for (int q = 0; q < 8; ++q) s[q] = 0.f;
#define POOL_ACC(sgn, VV) do { const v4u q_ = (VV); s[0] += sgn bflo(q_.x); s[1] += sgn bfhi(q_.x); s[2] += sgn bflo(q_.y); s[3] += sgn bfhi(q_.y); s[4] += sgn bflo(q_.z); s[5] += sgn bfhi(q_.z); s[6] += sgn bflo(q_.w); s[7] += sgn bfhi(q_.w); } while (0)
#pragma unroll
    for (int j = 0; j < WIN - 1; ++j) POOL_ACC(+, r[j]);
#pragma unroll
    for (int i = 0; i < 8; ++i) { const v4u self = r[WIN - 1 + i]; POOL_ACC(+, self);
        const int n = (tl0 + i + 1) < WIN ? (tl0 + i + 1) : WIN; const float inv = 1.0f / (float)n;
        v4u o; o.x = pk2(s[0] * inv - bflo(self.x), s[1] * inv - bfhi(self.x)); o.y = pk2(s[2] * inv - bflo(self.y), s[3] * inv - bfhi(self.y));
        o.z = pk2(s[4] * inv - bflo(self.z), s[5] * inv - bfhi(self.z)); o.w = pk2(s[6] * inv - bflo(self.w), s[7] * inv - bfhi(self.w));
        *(v4u*)(P + (size_t)(t0 + i) * D + col) = o;
        POOL_ACC(-, r[i]); }
#undef POOL_ACC
}
__device__ __forceinline__ void pooled_phase(Frame& F) {
    const bf16* H = (const bf16*)(F.ws + WS_H); bf16* P = (bf16*)(F.ws + WS_OAB);
    const int gt = F.vcu * 512 + F.tid, NT = F.G * 512;
    for (int it = gt; it < (NTOK / 8) * 128; it += NT) {
        const int c = it & 31, g = __builtin_amdgcn_readfirstlane((it >> 6) & 3), tb = ((it >> 8) << 1) | ((it >> 5) & 1);
        const int t0 = tb * 8, tl0 = t0 & (SEQ - 1), col = g * 256 + c * 8;
        if (g == 0) pooled_block<2>(H, P, t0, tl0, col); else if (g == 1) pooled_block<4>(H, P, t0, tl0, col); else if (g == 2) pooled_block<8>(H, P, t0, tl0, col); else pooled_block<16>(H, P, t0, tl0, col);
    }
}


#ifndef PH_MASK
#define PH_MASK 0xFFFFFF
#endif
#define IN(k) (((PH_MASK >> (k)) & 1) && lo <= (k) && (k) < hi)
#define BOTH(k) (IN(k) && IN((k) + 1))
#if MK_ONE_LAUNCH
#define GRID_BAR() xcd_barrier(bar)
#else
#define GRID_BAR() do { } while (0)
#endif
template <int LAYER>
__device__ __forceinline__ void moe_phases(Frame& F, const XcdBarrier& bar, const int lo, const int hi) {
    constexpr int pb = LAYER == 0 ? 7 : 13;
    bf16* const H = (bf16*)(F.ws + WS_H);
    const float* const MOD = (const float*)(F.ws + WS_MOD);
    if (IN(pb)) {
        moe_route(F, LAYER); if (BOTH(pb)) GRID_BAR(); }
    if (IN(pb + 1)) {
        build_moe_tables(F, LAYER);
        pg8::Gemm g{(const bf16*)H, 1024, 1024}; MoeSched S; S.init((const LAS int*)(F.lds + SCHED_OFF), F.G, (int)blockIdx.x, (const int*)(F.ws + WS_RT), F.ws + WS_WGU, 1024, 1024);
        EpiSwiglu E{(bf16*)(F.ws + WS_ACT)};
        if (LAYER == 1) { S.Blo = (const char*)(F.ws + WS_WGT); S.esplit = 16; }
        moe_tail_plan(F);
        pg8::gemm_phase<EpiSwiglu, MoeSched>(F.lds + RING_OFF, g, S, E);
        {
            const LAS int* T = (const LAS int*)(F.lds + SCHED_OFF); const int sp = T[67];
            const int q0 = LAYER == 0 ? 0 : CQ_NG, q1 = LAYER == 0 ? CQ_NGT : CQ_N;
            if (sp > 0) { __syncthreads(); const int f = q0 + T[65] * 8 * TQ_GU; int e = f + sp * 8 * TQ_GU; e = e < q1 ? e : q1; convert_range(F, 1, f, e, F.wave, 8); }
            if (LAYER == 1) { int t = q0 + T[66] * 8 * TQ_GU;
                if (t < q1) { __syncthreads(); convert_range(F, 1, t, q1, F.vcu * NWAVES + F.wave, F.G * NWAVES); } } }
        if (BOTH(pb + 1)) GRID_BAR();
    }
    if (IN(pb + 2)) {
        build_moe_tables(F, LAYER);
        pg8::Gemm g{(const bf16*)(F.ws + WS_ACT), 512, 512}; MoeSched S; S.init((const LAS int*)(F.lds + SCHED_OFF), F.G, (int)blockIdx.x, nullptr, F.ws + WS_WD, 512, 512);
        EpiStoreBf16 E{(bf16*)(F.ws + WS_Y), D};
        if (LAYER == 0) moe_tail_plan(F);
        pg8::gemm_phase<EpiStoreBf16, MoeSched>(F.lds + RING_OFF, g, S, E);
        if (LAYER == 0) {
            const LAS int* T = (const LAS int*)(F.lds + SCHED_OFF); const int sp = T[67];
            int t8 = T[66] * 8 * TQ_GU; t8 = t8 < CQ_NGT ? t8 : CQ_NGT;
            if (sp > 0) { __syncthreads(); const int f = t8 + T[65] * 8 * TQ_DN; int e = f + sp * 8 * TQ_DN; e = e < CQ_NG ? e : CQ_NG; convert_range(F, 1, f, e, F.wave, 8); } }
        if (BOTH(pb + 2)) GRID_BAR();
    }
    if (IN(pb + 3)) {
        build_moe_tables(F, LAYER);
        if (LAYER == 0) moe_tail_plan(F);
        const int tokw = F.vcu * 128 + F.wave * 16, b = (F.vcu * 128) / SEQ;
        f32x4 g2[4];
#pragma unroll
        for (int j = 0; j < 4; ++j) g2[j] = *((const f32x4*)(MOD + (size_t)(LAYER * 2 + b) * 6144 + 5 * 1024) + F.lane + 64 * j);
        if (LAYER == 0) {
            const ModVec m1 = load_mod(F.in[I_NMIX] + D, MOD + (size_t)(2 + b) * 6144 + 1024, MOD + (size_t)(2 + b) * 6144, F.lane);
            { const CombRecs recs = comb_load_recs(F, tokw); CombRows cur, nxt; comb_issue(F, recs, 0, tokw, cur);
              for (int i = 0; i < 16; ++i) { const int t = tokw + i;
                  if (i + 1 < 16) comb_issue(F, recs, i + 1, t + 1, nxt);
                  const RowVec x = comb_finish(recs, i, cur, g2);
                  store_row_bf16((bf16*)(F.ws + WS_XRB) + (size_t)t * D, F.lane, x); store_row_bf16(H + (size_t)t * D, F.lane, apply_mod(x, row_rstd(x), m1));
                  cur = nxt; } }
            __syncthreads();
            { const LAS int* T = (const LAS int*)(F.lds + SCHED_OFF);
              int t8 = T[66] * 8 * TQ_GU; t8 = t8 < CQ_NGT ? t8 : CQ_NGT; int t9 = t8 + T[66] * 8 * TQ_DN; t9 = t9 < CQ_NG ? t9 : CQ_NG;
              convert_range(F, 1, t9, CQ_NG, F.vcu * NWAVES + F.wave, F.G * NWAVES); }
        } else {
            f32x4 fw[4];
#pragma unroll
            for (int j = 0; j < 4; ++j) fw[j] = *((const f32x4*)F.in[I_FNW] + F.lane + 64 * j);
            { const CombRecs recs = comb_load_recs(F, tokw); CombRows cur, nxt; comb_issue(F, recs, 0, tokw, cur);
              for (int i = 0; i < 16; ++i) { const int t = tokw + i;
                  if (i + 1 < 16) comb_issue(F, recs, i + 1, t + 1, nxt);
                  RowVec x = comb_finish(recs, i, cur, g2); const float rstd = row_rstd(x);
#pragma unroll
                  for (int j = 0; j < 4; ++j) x.v[j] = x.v[j] * rstd * fw[j];
                  store_row_f32(F.out + (size_t)t * D, F.lane, x);
                  cur = nxt; } }
        }
        if (BOTH(pb + 3)) GRID_BAR();
    }
}

constexpr int PH_P0 = 0, PH_P1 = 1, PH_INPROJ = 2, PH_ATT = 3, PH_SCAN = 4, PH_DNOUT = 5, PH_OUTPROJ = 6, PH_MOE0 = 7, PH_POOLED = 11, PH_POOLG = 12, PH_MOE1 = 13;
constexpr int N_PHASES = 17;
struct Args { const float* in[24]; float* out; unsigned char* ws; int ph_lo, ph_hi; };
__global__ void __launch_bounds__(NWAVES * 64, 2) trunk_fwd(Args args) {
    __shared__ __attribute__((aligned(16))) unsigned char lds[LDS_BYTES];
    Frame F;
    F.lds = (LAS unsigned char*)lds;
    F.MISC = (volatile LAS unsigned*)(F.lds + MISC_OFF);
    F.tid = threadIdx.x; F.lane = F.tid & 63; F.wave = __builtin_amdgcn_readfirstlane(F.tid >> 6);
    F.G = gridDim.x; { const int bx = blockIdx.x; F.vcu = (F.G % 8 == 0) ? (bx % 8) * (F.G / 8) + bx / 8 : bx; }
#pragma unroll
    for (int i = 0; i < 24; ++i) F.in[i] = args.in[i];
    F.out = args.out; F.ws = args.ws; F.ctl = (gu32*)(args.ws + WS_CTL);
    for (int u = F.tid; u < (LDS_BYTES - LDSCTL_OFF) / 4; u += NWAVES * 64) ((LAS unsigned*)(F.lds + LDSCTL_OFF))[u] = 0u;
    __syncthreads();
#if MK_ONE_LAUNCH
    XcdBarrier bar = xcd_barrier_post((unsigned*)(F.ctl + CW_BAR), F.MISC + 8);
#else
    XcdBarrier bar; bar.bar = nullptr; bar.x = 0; bar.st = nullptr;
#endif
    const int lo = args.ph_lo, hi = args.ph_hi;
    bf16* const H = (bf16*)(F.ws + WS_H);
    const float* const MOD = (const float*)(F.ws + WS_MOD);

    if (IN(PH_P0)) { p0_prologue(F); if (BOTH(PH_P0)) GRID_BAR(); }
    if (IN(PH_P1)) { p1_prenorm0(F); if (BOTH(PH_P1)) GRID_BAR(); }
    if (IN(PH_INPROJ)) {
        pg8::Gemm g{(const bf16*)H, 1024, 1024}; DenseSched S; S.init(NTOK, IP_TILES * 256, F.G, (int)blockIdx.x, 1024, 0, F.ws + WS_WIN, 1024); S.gap_from = PC_ZA / 256; S.gap = 2;
        EpiStoreBf16 E{(bf16*)(F.ws + WS_PROJ), PIN};
        pg8::gemm_phase<EpiStoreBf16, DenseSched>(F.lds + RING_OFF, g, S, E);
        if (IP_FULL && (int)blockIdx.x >= IP_FULL) {
            __syncthreads(); const int r = (int)blockIdx.x - IP_FULL; convert_range(F, 0, r * 8 * TQ_INPROJ, (r + 1) * 8 * TQ_INPROJ, F.wave, 8); }
        if (BOTH(PH_INPROJ)) GRID_BAR();
    }
    if (IN(PH_ATT)) { dn_prep(F); if (BOTH(PH_ATT)) GRID_BAR(); }
    if (IN(PH_SCAN)) {
        if ((int)blockIdx.x < 32) dn_scan(F);
        else { const int o = (int)blockIdx.x - 32, NO = F.G - 32;
            attn_phase(F, o, NO); __syncthreads();
            { pg8::Gemm g{(const bf16*)H, 1024, 1024}; EpiStoreBf16 E{(bf16*)(F.ws + WS_PROJ), PIN};
              DenseSched S; S.init(NTOK, 512, NO, o, 1024, 0, F.ws + WS_WIN, 1024); S.gap_from = 0; S.gap = PC_ZA / 256; S.Lend = NO;
              pg8::gemm_phase<EpiStoreBf16, DenseSched>(F.lds + RING_OFF, g, S, E);
              if (o >= 64 && o < 64 + (S.nwg - NO)) { __syncthreads(); S.L0 = NO; S.G = S.nwg - NO; S.c = o - 64; S.Lend = S.nwg;
                  pg8::gemm_phase<EpiStoreBf16, DenseSched>(F.lds + RING_OFF, g, S, E); } }
            __syncthreads();
            { const int q = o < 64 ? 7 : o < 96 ? 5 : 10, off = o < 64 ? 56 * o : o < 96 ? 3584 + 40 * (o - 64) : 4864 + 80 * (o - 96);
              convert_range(F, 0, CQ_T2 + off, CQ_T2 + off + 8 * q, F.wave, 8);
              convert_range(F, 0, CQ_T2 + 4864 + 80 * 128, CQ_N, o * NWAVES + F.wave, NO * NWAVES); } }
        if (BOTH(PH_SCAN)) GRID_BAR(); }
    if (IN(PH_DNOUT)) { dn_output(F); if (BOTH(PH_DNOUT)) GRID_BAR(); }
    if (IN(PH_OUTPROJ)) {
        pg8::Gemm g{(const bf16*)(F.ws + WS_OAB), 1024, 1024}; DenseSched S; S.init(NTOK, D, F.G, (int)blockIdx.x, 1024, 0, F.ws + WS_WOUT, 1024);
        EpiResid<true> E{F.in[I_X], (bf16*)(F.ws + WS_XRB), MOD + 2 * 1024, nullptr};
        pg8::gemm_phase<EpiResid<true>, DenseSched>(F.lds + RING_OFF, g, S, E);
        if (BOTH(PH_OUTPROJ)) GRID_BAR();
    }
    moe_phases<0>(F, bar, lo, hi);
    if (IN(PH_POOLED)) { pooled_phase(F); if (BOTH(PH_POOLED)) GRID_BAR(); }
    if (IN(PH_POOLG)) {
        pg8::Gemm g{(const bf16*)(F.ws + WS_OAB), 256, 256}; DenseSched S; S.init(NTOK, D, F.G, (int)blockIdx.x, 1024, 256, F.ws + WS_POOLW, 256);
        EpiResid<false> E{nullptr, (bf16*)(F.ws + WS_XRB), MOD + (size_t)2 * 6144 + 2 * 1024, F.in[I_POOLS]};
        pg8::gemm_phase<EpiResid<false>, DenseSched>(F.lds + RING_OFF, g, S, E);
        if (BOTH(PH_POOLG)) GRID_BAR();
    }
    moe_phases<1>(F, bar, lo, hi);
#undef IN
#undef BOTH
}

extern "C" void kernel_launch(void* const* d_in, const int* in_sizes, int n_in, void* d_out, int out_size, void* d_ws, size_t ws_size, hipStream_t stream) {
    static int grid = 0;
    if (grid == 0) {
        if (n_in != 24 || in_sizes[0] != NTOK * D || out_size != NTOK * D || ws_size < WS_END2) { fprintf(stderr, "kernel_launch: unexpected shapes (n_in %d, in0 %d, out %d, ws %zu); nothing launched\n", n_in, n_in > 0 ? in_sizes[0] : -1, out_size, ws_size); grid = -1; return; }
        int per_cu = 0;
        if (hipOccupancyMaxActiveBlocksPerMultiprocessor(&per_cu, (const void*)trunk_fwd, NWAVES * 64, 0) != hipSuccess || per_cu < 1) fprintf(stderr, "kernel_launch: occupancy query says %d\n", per_cu);
        (void)hipGetLastError();
        grid = 256;
    }
    if (grid < 0) return;
    if (hipMemsetAsync((char*)d_ws + WS_CTL, 0, CTL_ZERO_BYTES, stream) != hipSuccess) { fprintf(stderr, "kernel_launch: memset failed\n"); return; }
    Args a{};
    for (int i = 0; i < 24; ++i) a.in[i] = (const float*)d_in[i];
    a.out = (float*)d_out; a.ws = (unsigned char*)d_ws;
#if MK_ONE_LAUNCH
    a.ph_lo = 0; a.ph_hi = N_PHASES;
    hipLaunchKernelGGL(trunk_fwd, dim3(grid), dim3(NWAVES * 64), 0, stream, a);
#else
    for (int p = 0; p < N_PHASES; ++p) { a.ph_lo = p; a.ph_hi = p + 1; hipLaunchKernelGGL(trunk_fwd, dim3(grid), dim3(NWAVES * 64), 0, stream, a); }
#endif
}
```

```cpp
#include <hip/hip_runtime.h>
#include <cstdio>
#include <cstdint>

#ifndef MK_ONE_LAUNCH
#define MK_ONE_LAUNCH 1
#endif

#define GAS __attribute__((address_space(1)))
#define LAS __attribute__((address_space(3)))
typedef unsigned short bf16;
typedef unsigned v4u __attribute__((ext_vector_type(4)));
typedef unsigned v2u __attribute__((ext_vector_type(2)));
typedef float f32x4 __attribute__((ext_vector_type(4)));
typedef float f32x2 __attribute__((ext_vector_type(2)));
typedef float f32x16 __attribute__((ext_vector_type(16)));
typedef short bf16x8 __attribute__((ext_vector_type(8)));
typedef GAS unsigned gu32;
#define RLX_AGENT __ATOMIC_RELAXED, __HIP_MEMORY_SCOPE_AGENT
#define LDS_WAIT() asm volatile("s_waitcnt lgkmcnt(0)" ::: "memory")
#define VM_WAIT() asm volatile("s_waitcnt vmcnt(0)" ::: "memory")

constexpr int BATCH = 2, SEQ = 16384, D = 1024, NTOK = BATCH * SEQ;
constexpr int PIN = 2816;
constexpr int PC_QA = 0, PC_KA = 512, PC_VA = 1024, PC_ZA = 1536, PC_QB = 2048, PC_KB = 2560, PC_VB = 2688;
constexpr int NEXP = 32, DFF = 512;
constexpr int MAXTILES = NTOK * 2 / 256 + NEXP;
constexpr float EPS = 1e-6f;
constexpr int NWAVES = 8;

constexpr size_t MiB = 1u << 20;
constexpr size_t WS_CTL = 0, CTL_ZERO_BYTES = 1 * MiB;
constexpr size_t WS_MOD = 1 * MiB;
constexpr size_t WS_WBA = 1 * MiB + 128 * 1024;
constexpr size_t WS_ROUTE = 2 * MiB;
constexpr size_t WS_RT = 3 * MiB;
constexpr size_t WS_BG = 7 * MiB;
constexpr size_t WS_WIN = 10 * MiB;
constexpr size_t WS_WOUT = 16 * MiB;
constexpr size_t WS_POOLW = 18 * MiB;
constexpr size_t WS_WGU = 20 * MiB;
constexpr size_t WS_WD = 84 * MiB;
constexpr size_t WS_H = 116 * MiB;
constexpr size_t WS_PROJ = 180 * MiB;
constexpr size_t WS_OAB = 356 * MiB;
constexpr size_t WS_YM = 180 * MiB;
constexpr size_t WS_ACT = 180 * MiB;
constexpr size_t WS_Y = 252 * MiB;
constexpr size_t WS_END = 420 * MiB;
constexpr size_t OUT_DN_MT = 0, OUT_DN_QPT = 32 * MiB;
constexpr size_t WS_DN_BM = 420 * MiB, WS_DN_O0T = 452 * MiB, WS_DN_S = 484 * MiB;
constexpr size_t WS_DN_GT = 9 * MiB;
constexpr size_t WS_XRB = 420 * MiB;
constexpr size_t WS_WGT = 484 * MiB;
constexpr size_t WS_END2 = 516 * MiB;
constexpr int CW_CNT = 64;
constexpr int CW_BAR = 4096;
constexpr int CW_BAD = 200;

constexpr int RING_OFF = 0, RING_BYTES = 131072;
constexpr int LDSCTL_OFF = RING_BYTES, MISC_OFF = LDSCTL_OFF + 320;
constexpr int SCHED_OFF = LDSCTL_OFF + 1024;
constexpr int LDS_BYTES = 163840;
constexpr int R1W_OFF = 135168;
constexpr int RT_LDS_OFF = 151552;

typedef __bf16 bf16x2_t __attribute__((ext_vector_type(2)));
__device__ __forceinline__ unsigned pk2(float lo, float hi) { bf16x2_t v; v.x = (__bf16)lo; v.y = (__bf16)hi; return __builtin_bit_cast(unsigned, v); }
__device__ __forceinline__ unsigned f2bf(float f) { return pk2(f, 0.f) & 0xffffu; }
__device__ __forceinline__ float bf2f(unsigned b) { return __builtin_bit_cast(float, b << 16); }
__device__ __forceinline__ float bflo(unsigned w) { return __builtin_bit_cast(float, w << 16); }
__device__ __forceinline__ float bfhi(unsigned w) { return __builtin_bit_cast(float, w & 0xffff0000u); }
template <int CTRL> __device__ __forceinline__ float dpp_f(float v) { return __builtin_bit_cast(float, __builtin_amdgcn_update_dpp(0, __builtin_bit_cast(int, v), CTRL, 0xf, 0xf, false)); }
__device__ __forceinline__ float quad_sum(float v) { v += dpp_f<0xB1>(v); v += dpp_f<0x4E>(v); return v; }
__device__ __forceinline__ float oct_sum(float v) { v = quad_sum(v); v += dpp_f<0x141>(v); return v; }
__device__ __forceinline__ float wave_sum(float v) {
    v = oct_sum(v); v += dpp_f<0x140>(v);
    const float r0 = __builtin_bit_cast(float, __builtin_amdgcn_readlane(__builtin_bit_cast(int, v), 0)), r1 = __builtin_bit_cast(float, __builtin_amdgcn_readlane(__builtin_bit_cast(int, v), 16));
    const float r2 = __builtin_bit_cast(float, __builtin_amdgcn_readlane(__builtin_bit_cast(int, v), 32)), r3 = __builtin_bit_cast(float, __builtin_amdgcn_readlane(__builtin_bit_cast(int, v), 48));
    return (r0 + r1) + (r2 + r3);
}
__device__ __forceinline__ float rl(float x, int l) { return __builtin_bit_cast(float, __builtin_amdgcn_readlane(__builtin_bit_cast(int, x), l)); }
__device__ __forceinline__ float silu_f(float x) { return x / (1.f + __expf(-x)); }
__device__ __forceinline__ float sigmoid_f(float x) { return 1.f / (1.f + __expf(-x)); }
__device__ __forceinline__ float softplus_f(float x) { return x > 20.f ? x : log1pf(__expf(x)); }

namespace pg8 {
#define PG8_LAS __attribute__((address_space(3)))
typedef unsigned short bf16_t;
typedef unsigned u32x4 __attribute__((ext_vector_type(4)));
constexpr int BM = 256, BK = 64, HALF = 128, HTB = HALF * BK * 2, STAGE_BYTES = 8 * HTB;

__host__ __device__ __forceinline__ int lds_byte(int r, int c) { const int st = (r >> 4) * 2 + (c >> 5), rr = r & 15, cc = c & 31, ob = rr * 64 + cc * 2; return st * 1024 + (ob ^ (((ob >> 9) & 1) << 5)); }
__host__ __device__ __forceinline__ void stage_rc(int b, int& R, int& C) { const int st = b / 1024, sb = b % 1024, swz = sb ^ (((sb >> 9) & 1) << 5); R = (st >> 1) * 16 + swz / 64; C = (st & 1) * 32 + (swz % 64) / 2; }
__host__ __device__ __forceinline__ int perm32(int rho) { const int n = rho >> 4, i = rho & 15; return 8 * (i >> 2) + 4 * n + (i & 3); }

struct Unit { int pm, pn, e; };
struct Gemm { const bf16_t* A; int K, ldb; };

template <class Epi, class Sched>
__device__ __forceinline__ void gemm_phase(PG8_LAS unsigned char* lds, const Gemm g, const Sched& S, const Epi& E) {
    const int tid = threadIdx.x, wid = __builtin_amdgcn_readfirstlane(tid >> 6), lane = tid & 63, wr = wid >> 2, wc = wid & 3, fr = lane & 15, fq = lane >> 4;
    const int K = g.K, nt = K / BK;
    int R0, C0, R1, C1; stage_rc(tid * 16, R0, C0); stage_rc(tid * 16 + 8192, R1, C1);
    const int Rb0 = (R0 & ~31) + perm32(R0 & 31), Rb1 = (R1 & ~31) + perm32(R1 & 31);
    const unsigned voffB0 = (unsigned)(Rb0 * g.ldb + C0) * 2u, voffB1 = (unsigned)(Rb1 * g.ldb + C1) * 2u;
    const size_t kstep = (size_t)(BK * 2);
    const size_t hstepB = (size_t)HALF * g.ldb * 2;
    const unsigned ldsw = (unsigned)wid * 1024u;
    const int aoff = lds_byte(wr * 64 + fr, fq * 8), boff = lds_byte(wc * 32 + fr, fq * 8);
    const char* Ab = (const char*)g.A;
#define PG8_SA(b, h) (((b) * 2 + (h)) * HTB)
#define PG8_SB(b, h) ((4 + (b) * 2 + (h)) * HTB)
#define PG8_ST2(bufoff, gbase, v0, v1) do { \
        __builtin_amdgcn_global_load_lds((const unsigned*)((const char*)(gbase) + (v0)), (PG8_LAS unsigned*)(lds + (bufoff) + ldsw), 16, 0, 0); \
        __builtin_amdgcn_global_load_lds((const unsigned*)((const char*)(gbase) + (v1)), (PG8_LAS unsigned*)(lds + (bufoff) + ldsw + 8192), 16, 0, 0); } while (0)
#define PG8_STB(bufoff, gbase) PG8_ST2(bufoff, gbase, voffB0, voffB1)
#define PG8_LDA(dst, b, h) do { _Pragma("unroll") for (int m = 0; m < 4; ++m) _Pragma("unroll") for (int k = 0; k < 2; ++k) dst[m][k] = *(const PG8_LAS bf16x8*)(lds + PG8_SA(b, h) + aoff + m * 2048 + k * 1024); } while (0)
#define PG8_LDB(dst, b, h) do { _Pragma("unroll") for (int n = 0; n < 2; ++n) _Pragma("unroll") for (int k = 0; k < 2; ++k) dst[n][k] = *(const PG8_LAS bf16x8*)(lds + PG8_SB(b, h) + boff + n * 2048 + k * 1024); } while (0)
#define PG8_MMA(ai, bj, At, Bt) do { __builtin_amdgcn_s_setprio(1); _Pragma("unroll") for (int m = 0; m < 4; ++m) _Pragma("unroll") for (int n = 0; n < 2; ++n) _Pragma("unroll") for (int k = 0; k < 2; ++k) \
        acc[ai][bj][m][n] = __builtin_amdgcn_mfma_f32_16x16x32_bf16(Bt[n][k], At[m][k], acc[ai][bj][m][n], 0, 0, 0); __builtin_amdgcn_s_setprio(0); } while (0)
#define PG8_WAIT_V(n) asm volatile("s_waitcnt vmcnt(" #n ")" ::: "memory")
#define PG8_WAIT_L(n) asm volatile("s_waitcnt lgkmcnt(" #n ")" ::: "memory")
#define PG8_BAR __builtin_amdgcn_s_barrier()
#define PG8_SCHED __builtin_amdgcn_sched_barrier(0)
    Unit cur, nxt; int ui = 0;
    if (!S.next(0, cur)) return;
    f32x4 acc[2][2][4][2];
#pragma unroll
    for (int a = 0; a < 2; ++a)
#pragma unroll
        for (int b = 0; b < 2; ++b)
#pragma unroll
            for (int m = 0; m < 4; ++m)
#pragma unroll
                for (int n = 0; n < 2; ++n) acc[a][b][m][n] = (f32x4){0.f, 0.f, 0.f, 0.f};
    bf16x8 At[4][2], B0[2][2], B1[2][2];
    unsigned c00, c01, c10, c11;
#define PG8_AOFF(u, d00, d01, d10, d11) do { \
        d00 = S.a_off(u, R0) + (unsigned)C0 * 2u; d01 = S.a_off(u, R1) + (unsigned)C1 * 2u; \
        d10 = S.a_off(u, HALF + R0) + (unsigned)C0 * 2u; d11 = S.a_off(u, HALF + R1) + (unsigned)C1 * 2u; } while (0)
    PG8_AOFF(cur, c00, c01, c10, c11);
    const char* cB = S.b_ptr(cur);
    PG8_STB(PG8_SB(0, 0), cB); PG8_STB(PG8_SB(0, 1), cB + hstepB); PG8_ST2(PG8_SA(0, 0), Ab, c00, c01); PG8_ST2(PG8_SA(0, 1), Ab, c10, c11);
    if (wr == 1) PG8_BAR;
    PG8_WAIT_V(2); PG8_BAR;
    PG8_STB(PG8_SB(1, 0), cB + kstep); PG8_ST2(PG8_SA(1, 0), Ab + kstep, c00, c01); PG8_STB(PG8_SB(1, 1), cB + hstepB + kstep);
    PG8_WAIT_V(6); PG8_BAR;
    for (;;) {
        const bool has_next = S.next(ui + 1, nxt);
        const char* nB = has_next ? S.b_ptr(nxt) : cB;
#pragma unroll 1
        for (int t = 0; t < nt; t += 2) {
            const bool last = (t == nt - 2);
            const char* a1 = Ab + (size_t)(t + 1) * kstep;
            const char* a2 = last ? Ab : Ab + (size_t)(t + 2) * kstep; const char* b2 = last ? nB : cB + (size_t)(t + 2) * kstep;
            const char* a3 = a2 + kstep; const char* b3 = b2 + kstep;
            PG8_LDB(B0, 0, 0); PG8_LDB(B1, 0, 1); PG8_SCHED; PG8_LDA(At, 0, 0); PG8_ST2(PG8_SA(1, 1), a1, c10, c11);
            PG8_WAIT_V(8); PG8_WAIT_L(0); PG8_BAR; PG8_MMA(0, 0, At, B0); PG8_MMA(0, 1, At, B1); PG8_BAR; PG8_SCHED;
            if (last && has_next) { PG8_AOFF(nxt, c00, c01, c10, c11); }
            PG8_LDA(At, 0, 1); PG8_STB(PG8_SB(0, 0), b2); PG8_STB(PG8_SB(0, 1), b2 + hstepB); PG8_ST2(PG8_SA(0, 0), a2, c00, c01);
            PG8_WAIT_V(8); PG8_WAIT_L(0); PG8_BAR; PG8_MMA(1, 0, At, B0); PG8_MMA(1, 1, At, B1); PG8_BAR; PG8_SCHED;
            PG8_LDB(B0, 1, 0); PG8_LDB(B1, 1, 1); PG8_SCHED; PG8_LDA(At, 1, 0); PG8_ST2(PG8_SA(0, 1), a2, c10, c11);
            PG8_WAIT_V(8); PG8_WAIT_L(0); PG8_BAR; PG8_MMA(0, 0, At, B0); PG8_MMA(0, 1, At, B1); PG8_BAR; PG8_SCHED;
            PG8_LDA(At, 1, 1); PG8_STB(PG8_SB(1, 0), b3); PG8_STB(PG8_SB(1, 1), b3 + hstepB); PG8_ST2(PG8_SA(1, 0), a3, c00, c01);
            PG8_WAIT_V(8); PG8_WAIT_L(0); PG8_BAR; PG8_MMA(1, 0, At, B0); PG8_MMA(1, 1, At, B1); PG8_BAR; PG8_SCHED;
        }
        if (wr == 0) PG8_BAR;
        E(acc, cur, wr, wc, fr, fq);
        if (!has_next) break;
#pragma unroll
        for (int a = 0; a < 2; ++a)
#pragma unroll
            for (int b = 0; b < 2; ++b)
#pragma unroll
                for (int m = 0; m < 4; ++m)
#pragma unroll
                    for (int n = 0; n < 2; ++n) acc[a][b][m][n] = (f32x4){0.f, 0.f, 0.f, 0.f};
        cur = nxt; cB = nB; ++ui;
        if (wr == 1) PG8_BAR;
    }
    PG8_WAIT_V(0);
    PG8_BAR;
#undef PG8_SA
#undef PG8_SB
#undef PG8_ST2
#undef PG8_STB
#undef PG8_LDA
#undef PG8_LDB
#undef PG8_MMA
#undef PG8_WAIT_V
#undef PG8_WAIT_L
#undef PG8_BAR
#undef PG8_SCHED
#undef PG8_AOFF
}
}

#define XB_TMO      128
#define XB_XCNT(j)  (256  + 64 * (j))
#define XB_XSUB(j)  (1280 + 64 * (j))
#define XB_XGEN(j)  (2304 + 64 * (j))
#define XB_TOP      3328
#define XB_TOPGEN   3392
#define XCD_BAR_WORDS 3456
#define XB_SPIN_CAP (1u << 22)

__device__ __forceinline__ unsigned xb_ld(unsigned* p)              { return __hip_atomic_load(p, __ATOMIC_RELAXED, __HIP_MEMORY_SCOPE_AGENT); }
__device__ __forceinline__ unsigned xb_add(unsigned* p, unsigned v) { return __hip_atomic_fetch_add(p, v, __ATOMIC_RELAXED, __HIP_MEMORY_SCOPE_AGENT); }
__device__ __forceinline__ unsigned xb_xcc_id() { return (unsigned)__builtin_amdgcn_s_getreg((3 << 11) | 20) & 0xFu; }
#define XB_SPIN(cond, bar) do { unsigned _sp = 0; while (cond) { __builtin_amdgcn_s_sleep(1); \
    if ((++_sp & 255u) == 0u) { if (xb_ld(&(bar)[XB_TMO])) break; if (_sp > XB_SPIN_CAP) { atomicAdd(&(bar)[XB_TMO], 1u); break; } } } } while (0)

struct XcdBarrier { unsigned* bar; unsigned x; volatile LAS unsigned* st; };

__device__ __forceinline__ XcdBarrier xcd_barrier_post(unsigned* bar, volatile LAS unsigned* st) {
    XcdBarrier b; b.bar = bar; b.x = xb_xcc_id(); b.st = st;
    if (threadIdx.x == 0) (void)xb_add(&bar[XB_XCNT(b.x)], 1u);
    return b;
}
__device__ __forceinline__ void xcd_barrier_complete(unsigned* bar, unsigned x, unsigned& nloc, unsigned& nx) {
    const unsigned G = gridDim.x * gridDim.y * gridDim.z;
    unsigned sum, cnt, mine, sp = 0u;
    for (;;) {
        sum = 0u; cnt = 0u; mine = 0u;
#pragma unroll
        for (unsigned j = 0; j < 16; ++j) { const unsigned c = xb_ld(&bar[XB_XCNT(j)]); sum += c; cnt += (c > 0u) ? 1u : 0u; mine = (j == x) ? c : mine; }
        if (sum == G) break;
        __builtin_amdgcn_s_sleep(1);
        if ((++sp & 255u) == 0u) { if (xb_ld(&bar[XB_TMO])) break; if (sp > XB_SPIN_CAP) { atomicAdd(&bar[XB_TMO], 1u); break; } }
    }
    nloc = mine > 0u ? mine : 1u; nx = cnt > 0u ? cnt : 1u;
}
__device__ __forceinline__ void xcd_barrier(const XcdBarrier& b) {
    asm volatile("s_waitcnt vmcnt(0)" ::: "memory");
    __syncthreads();
    if (threadIdx.x == 0) {
        unsigned* bar = b.bar;
        __builtin_amdgcn_s_waitcnt(0);
        unsigned nloc = b.st[0], nx = b.st[1];
        if (nloc == 0u) { xcd_barrier_complete(bar, b.x, nloc, nx); b.st[0] = nloc; b.st[1] = nx; }
        const unsigned old = xb_add(&bar[XB_XSUB(b.x)], 1u);
        const unsigned gen = old / nloc;
        if (old + 1u == (gen + 1u) * nloc) {
            __builtin_amdgcn_fence(__ATOMIC_RELEASE, "agent");
            asm volatile("s_waitcnt vmcnt(0)" ::: "memory");
            const unsigned og = xb_add(&bar[XB_TOP], 1u);
            const unsigned tg = og / nx;
            if (og + 1u == (tg + 1u) * nx) xb_add(&bar[XB_TOPGEN], 1u);
            else XB_SPIN(xb_ld(&bar[XB_TOPGEN]) == tg, bar);
            __builtin_amdgcn_fence(__ATOMIC_ACQUIRE, "agent");
            xb_add(&bar[XB_XGEN(b.x)], 1u);
            asm volatile("s_waitcnt vmcnt(0)" ::: "memory");
        } else {
            XB_SPIN(xb_ld(&bar[XB_XGEN(b.x)]) == gen, bar);
            __builtin_amdgcn_fence(__ATOMIC_ACQUIRE, "agent");
            asm volatile("s_waitcnt vmcnt(0)" ::: "memory");
        }
    }
    __syncthreads();
}

struct Frame {
    LAS unsigned char* lds;
    volatile LAS unsigned* MISC;
    gu32* ctl;
    int tid, lane, wave, vcu, G;
    const float* in[24];
    float* out;
    unsigned char* ws;
};
enum { I_X = 0, I_C, I_ADAW, I_ADAB, I_NMIX, I_NFFN, I_WIN, I_CONVW, I_ALOG, I_DTB, I_ONORM, I_SINKS, I_RELB, I_WOUT, I_POOLW, I_POOLS, I_R1W, I_R1B, I_R2W, I_R2B, I_WG, I_WU, I_WDN, I_FNW };

__device__ __forceinline__ void p0_transpose_item(const float* W, int ldw, int K, bf16* WT, int dst_row0, LAS float* scr, int k0, int n0, int lane) {
    f32x4 w4[8];
#pragma unroll
    for (int i = 0; i < 8; ++i) { const int f = i * 64 + lane, kk = f >> 3, c4 = f & 7; w4[i] = __builtin_nontemporal_load((const f32x4*)(W + (size_t)(k0 + kk) * ldw + n0 + c4 * 4)); }
#pragma unroll
    for (int i = 0; i < 8; ++i) { const int f = i * 64 + lane, kk = f >> 3, c4 = f & 7; LAS float* d = scr + kk * 33 + c4 * 4; d[0] = w4[i].x; d[1] = w4[i].y; d[2] = w4[i].z; d[3] = w4[i].w; }
    LDS_WAIT(); asm volatile("" ::: "memory");
    const int c = lane & 7;
#pragma unroll
    for (int j = 0; j < 4; ++j) { const int n = (lane >> 3) + 8 * j; const LAS float* s = scr + (8 * c) * 33 + n;
        v4u o; o.x = pk2(s[0 * 33], s[1 * 33]); o.y = pk2(s[2 * 33], s[3 * 33]); o.z = pk2(s[4 * 33], s[5 * 33]); o.w = pk2(s[6 * 33], s[7 * 33]);
        __builtin_nontemporal_store(o, (GAS v4u*)(WT + (size_t)(dst_row0 + n) * K + k0 + 8 * c)); }
    LDS_WAIT(); asm volatile("" ::: "memory");
}
constexpr int CQ_NG = NEXP * 512, CQ_NGT = 16 * 512, CQ_N = NEXP * 768;
constexpr int TQ_INPROJ = 11, TQ_GU = 6, TQ_DN = 4;
constexpr int IP_TILES = PIN / 256 - 2;
constexpr int IP_FULL = ((NTOK / 256) * IP_TILES) % 256;
constexpr int CQ_T2 = IP_FULL ? (256 - IP_FULL) * 8 * TQ_INPROJ : 0;
__device__ __forceinline__ void convert_item(Frame& F, int layer, int it, LAS float* scr) {
    if (it < CQ_NG) {
        const int e = it >> 9, r = it & 511, up = r >> 8, q = r & 255, kb = q >> 4, nb = q & 15;
        const float* W = (up ? F.in[I_WU] : F.in[I_WG]) + (size_t)(layer * NEXP + e) * 1024 * 512;
        p0_transpose_item(W, 512, 1024, (bf16*)(F.ws + ((layer && e < 16) ? WS_WGT : WS_WGU)), e * 1024 + (nb >> 2) * 256 + up * 128 + (nb & 3) * 32, scr, kb * 64, nb * 32, F.lane);
    } else {
        const int r0 = it - CQ_NG, e = r0 >> 8, q = r0 & 255, kb = q >> 5, nb = q & 31;
        const float* W = F.in[I_WDN] + (size_t)(layer * NEXP + e) * 512 * 1024;
        p0_transpose_item(W, 1024, 512, (bf16*)(F.ws + WS_WD), e * 1024 + nb * 32, scr, kb * 64, nb * 32, F.lane);
    }
}
__device__ __forceinline__ void convert_range(Frame& F, int layer, int first, int end, int start, int stride) {
    LAS float* scr = (LAS float*)(F.lds + RING_OFF + F.wave * 16384);
    for (int it = first + start; it < end; it += stride) convert_item(F, layer, it, scr);
}
__device__ __forceinline__ void p0_prologue(Frame& F) {
    LAS float* scr = (LAS float*)(F.lds + RING_OFF + F.wave * 16384);
    const int gw = F.vcu * NWAVES + F.wave, NGW = F.G * NWAVES;
    constexpr int IA = 16 * 64, IB = 16 * 24, IO = 16 * 32, IP = 4 * 32, NIT = IA + IB + IO + IP;
    for (int it = gw; it < NIT; it += NGW) {
        int r = it;
        if (r < IA) { p0_transpose_item(F.in[I_WIN], 2832, 1024, (bf16*)(F.ws + WS_WIN), (r % 64) * 32, scr, (r / 64) * 64, (r % 64) * 32, F.lane); continue; } r -= IA;
        if (r < IB) { p0_transpose_item(F.in[I_WIN] + 2064, 2832, 1024, (bf16*)(F.ws + WS_WIN), 2048 + (r % 24) * 32, scr, (r / 24) * 64, (r % 24) * 32, F.lane); continue; } r -= IB;
        if (r < IO) { p0_transpose_item(F.in[I_WOUT], 1024, 1024, (bf16*)(F.ws + WS_WOUT), (r % 32) * 32, scr, (r / 32) * 64, (r % 32) * 32, F.lane); continue; } r -= IO;
        { const int g = r >> 5, q = r & 31; p0_transpose_item(F.in[I_POOLW] + (size_t)g * 65536, 256, 256, (bf16*)(F.ws + WS_POOLW) + (size_t)g * 65536, (q & 7) * 32, scr, (q >> 3) * 64, (q & 7) * 32, F.lane); }
    }
    { float* WBA = (float*)(F.ws + WS_WBA); const int gt = F.vcu * 512 + F.tid;
      if (gt < 16 * 1024) { const int o = gt >> 10, k = gt & 1023; WBA[o * 1024 + k] = F.in[I_WIN][(size_t)k * 2832 + 2048 + o]; } }
    __syncthreads();
    {
        LAS float* red = (LAS float*)(F.lds + RING_OFF);
        const int ks = F.tid >> 4, cj = F.tid & 15;
        for (int u = F.vcu; u < 192; u += F.G) {
            const int l = u / 96, cb = u % 96;
            const float* W = F.in[I_ADAW] + (size_t)l * 1024 * 6144 + cb * 64 + cj * 4;
            f32x4 a0 = {0.f, 0.f, 0.f, 0.f}, a1 = {0.f, 0.f, 0.f, 0.f};
            for (int k = ks * 32; k < ks * 32 + 32; ++k) {
                const f32x4 w = *(const f32x4*)(W + (size_t)k * 6144);
                const float c0 = silu_f(F.in[I_C][k]), c1 = silu_f(F.in[I_C][1024 + k]);
                a0 += w * c0; a1 += w * c1;
            }
            *(LAS f32x4*)(red + (ks * 2 + 0) * 64 + cj * 4) = a0; *(LAS f32x4*)(red + (ks * 2 + 1) * 64 + cj * 4) = a1;
            __syncthreads();
            if (F.tid < 128) { const int b = F.tid >> 6, c = F.tid & 63; float s = 0.f;
                for (int q = 0; q < 32; ++q) s += red[(q * 2 + b) * 64 + c];
                ((float*)(F.ws + WS_MOD))[(size_t)(l * 2 + b) * 6144 + cb * 64 + c] = s + F.in[I_ADAB][l * 6144 + cb * 64 + c]; }
            __syncthreads();
        }
    }
}

struct RowVec { f32x4 v[4]; };
__device__ __forceinline__ RowVec load_row_f32(const float* row, int lane) { RowVec r; const GAS f32x4* p = (const GAS f32x4*)row + lane;
#pragma unroll
    for (int j = 0; j < 4; ++j) r.v[j] = p[64 * j]; return r; }
__device__ __forceinline__ void store_row_f32(float* row, int lane, const RowVec& r) { GAS f32x4* p = (GAS f32x4*)row + lane;
#pragma unroll
    for (int j = 0; j < 4; ++j) p[64 * j] = r.v[j]; }
__device__ __forceinline__ void store_row_bf16(bf16* row, int lane, const RowVec& r) { GAS v2u* p = (GAS v2u*)row + lane;
#pragma unroll
    for (int j = 0; j < 4; ++j) { v2u o; o.x = pk2(r.v[j].x, r.v[j].y); o.y = pk2(r.v[j].z, r.v[j].w); p[64 * j] = o; } }
__device__ __forceinline__ void load_row_bf16(const bf16* row, int lane, v2u (&p)[4]) { const GAS v2u* q = (const GAS v2u*)row + lane;
#pragma unroll
    for (int j = 0; j < 4; ++j) p[j] = q[64 * j]; }
__device__ __forceinline__ RowVec unpack_row_bf16(const v2u (&p)[4]) { RowVec r;
#pragma unroll
    for (int j = 0; j < 4; ++j) { r.v[j].x = bflo(p[j].x); r.v[j].y = bfhi(p[j].x); r.v[j].z = bflo(p[j].y); r.v[j].w = bfhi(p[j].y); } return r; }
__device__ __forceinline__ float row_rstd(const RowVec& r) { float s = 0.f;
#pragma unroll
    for (int j = 0; j < 4; ++j) s += (r.v[j].x * r.v[j].x + r.v[j].y * r.v[j].y) + (r.v[j].z * r.v[j].z + r.v[j].w * r.v[j].w);
    return 1.0f / sqrtf(wave_sum(s) * (1.f / D) + EPS); }
struct ModVec { f32x4 a[4], b[4]; };
__device__ __forceinline__ ModVec load_mod(const float* w, const float* sc, const float* sh, int lane) { ModVec m;
#pragma unroll
    for (int j = 0; j < 4; ++j) { const f32x4 wv = *((const f32x4*)w + lane + 64 * j), s = *((const f32x4*)sc + lane + 64 * j); m.a[j] = wv * (s + 1.0f); m.b[j] = *((const f32x4*)sh + lane + 64 * j); }
    return m; }
__device__ __forceinline__ RowVec apply_mod(const RowVec& x, float rstd, const ModVec& m) { RowVec h;
#pragma unroll
    for (int j = 0; j < 4; ++j) h.v[j] = x.v[j] * rstd * m.a[j] + m.b[j]; return h; }

__device__ __forceinline__ void p1_prenorm0(Frame& F) {
    LAS float* wba = (LAS float*)(F.lds + RING_OFF);
    { const float* WBA = (const float*)(F.ws + WS_WBA); for (int i = F.tid; i < 16 * 256; i += 512) *((LAS f32x4*)wba + i) = *((const f32x4*)WBA + i); }
    __syncthreads();
    const float* mod = (const float*)(F.ws + WS_MOD);
    bf16* H = (bf16*)(F.ws + WS_H); float* BG = (float*)(F.ws + WS_BG);
    const int tok0 = F.vcu * (NTOK / F.G) + F.wave * (NTOK / F.G / NWAVES), ntw = NTOK / F.G / NWAVES;
    const int b = tok0 / SEQ;
    const ModVec m = load_mod(F.in[I_NMIX], mod + (size_t)b * 6144 + 1024, mod + (size_t)b * 6144, F.lane);
    const int hh = F.lane & 7;
    const float nega = -__expf(F.in[I_ALOG][hh]), dtb = F.in[I_DTB][hh];
    RowVec xn = load_row_f32(F.in[I_X] + (size_t)tok0 * D, F.lane);
    for (int i = 0; i < ntw; ++i) {
        const int t = tok0 + i;
        const RowVec x = xn;
        if (i + 1 < ntw) xn = load_row_f32(F.in[I_X] + (size_t)(t + 1) * D, F.lane);
        const RowVec h = apply_mod(x, row_rstd(x), m);
        store_row_bf16(H + (size_t)t * D, F.lane, h);
        float mine = 0.f;
#pragma unroll 2
        for (int o = 0; o < 16; ++o) { float s = 0.f;
#pragma unroll
            for (int j = 0; j < 4; ++j) { const f32x4 w = *((const LAS f32x4*)(wba + o * 1024) + F.lane + 64 * j); s += (h.v[j].x * w.x + h.v[j].y * w.y) + (h.v[j].z * w.z + h.v[j].w * w.w); }
            s = wave_sum(s); if (F.lane == o) mine = s; }
        if (F.lane < 8) BG[(size_t)t * 16 + F.lane] = sigmoid_f(mine);
        else if (F.lane < 16) BG[(size_t)t * 16 + F.lane] = nega * softplus_f(mine + dtb);
    }
}

struct DenseSched {
    int nM, nN, nwg, G, c, gap_from, gap, L0, Lend; unsigned lda2, acol2; const char* B; size_t btile;
    __device__ __forceinline__ void init(int M, int N, int G_, int c_, int lda, int acolstride, const void* B_, int ldb) { nM = M / 256; nN = N / 256; nwg = nM * nN; G = G_; c = c_; gap_from = 1 << 30; gap = 0; L0 = 0; Lend = nwg; lda2 = (unsigned)lda * 2u; acol2 = (unsigned)acolstride * 2u; B = (const char*)B_; btile = (size_t)256 * ldb * 2; }
    __device__ __forceinline__ bool next(int i, pg8::Unit& u) const {
        const long L = (long)L0 + (long)i * G + c; if (L >= Lend) return false;
        int wgid = (int)L; { const int q = nwg / 8, r = nwg % 8, xcd = wgid % 8, off = wgid / 8; wgid = (xcd < r ? xcd * (q + 1) : r * (q + 1) + (xcd - r) * q) + off; }
        const int nig = 8 * nN, gid = wgid / nig, fm = gid * 8, gsz = (nM - fm) < 8 ? (nM - fm) : 8;
        u.pm = fm + ((wgid % nig) % gsz); u.pn = (wgid % nig) / gsz; u.pn += (u.pn >= gap_from) ? gap : 0; u.e = 0; return true;
    }
    __device__ __forceinline__ unsigned a_off(const pg8::Unit& u, int r) const { return (unsigned)(u.pm * 256 + r) * lda2 + (unsigned)u.pn * acol2; }
    __device__ __forceinline__ const char* b_ptr(const pg8::Unit& u) const { return B + (size_t)u.pn * btile; }
};
struct MoeSched {
    const LAS int* cnt; const LAS int* tbase; const LAS int* tileExp;
    int nunits, chunk, G, c, esplit; const int* RT; const char* B; const char* Blo; size_t bexp, btile; unsigned arow2;
    __device__ __forceinline__ void init(const LAS int* tables, int G_, int c_, const int* RT_, const void* B_, int ldb, int lda) {
        cnt = tables; tbase = tables + 32; tileExp = tables + 80; G = G_; c = c_; RT = RT_; B = (const char*)B_; Blo = B; esplit = 0; bexp = (size_t)1024 * ldb * 2; btile = (size_t)256 * ldb * 2; arow2 = (unsigned)lda * 2u;
        nunits = tbase[32] * 4; chunk = ((nunits + 7) / 8 + 3) & ~3;
    }
    __device__ __forceinline__ bool next(int i, pg8::Unit& u) const {
        const int w = i * (G / 8) + (c >> 3); if (w >= chunk) return false;
        const int L = (c & 7) * chunk + w; if (L >= nunits) return false;
        u.pm = L >> 2; u.pn = L & 3; u.e = tileExp[u.pm]; return true;
    }
    __device__ __forceinline__ unsigned a_off(const pg8::Unit& u, int r) const {
        if (RT) { const int pos = (u.pm - tbase[u.e]) * 256 + r; const int tok = pos < cnt[u.e] ? RT[u.e * NTOK + pos] : 0; return (unsigned)tok * arow2; }
        return (unsigned)(u.pm * 256 + r) * arow2;
    }
    __device__ __forceinline__ const char* b_ptr(const pg8::Unit& u) const { return (u.e < esplit ? Blo : B) + (size_t)u.e * bexp + (size_t)u.pn * btile; }
};
__device__ __forceinline__ void build_moe_tables(Frame& F, int layer) {
    LAS int* T = (LAS int*)(F.lds + SCHED_OFF);
    int tid_ = F.tid; asm volatile("" : "+v"(tid_));
    if (tid_ < 32) T[tid_] = (int)__hip_atomic_load(F.ctl + CW_CNT + 64 * layer + tid_, RLX_AGENT);
    __syncthreads();
    if (F.tid == 0) { int acc = 0; for (int e = 0; e < 32; ++e) { T[32 + e] = acc; const int nt = (T[e] + 255) >> 8; for (int j = 0; j < nt; ++j) T[80 + acc + j] = e; acc += nt; } T[64] = acc; }
    __syncthreads();
}

__device__ __forceinline__ int moe_units_of(int c, int G, int nunits, int chunk) {
    const int sl = c >> 3, x = c & 7, per = G / 8; int U = nunits - x * chunk; U = U < 0 ? 0 : (U > chunk ? chunk : U);
    return sl < U ? (U - sl + per - 1) / per : 0;
}
__device__ __forceinline__ void moe_tail_plan(Frame& F) {
    LAS int* T = (LAS int*)(F.lds + SCHED_OFF);
    if (F.tid == 0) { T[65] = 0; T[66] = 0; }
    __syncthreads();
    if (F.tid < 256) {
        const int nunits = T[64] * 4, chunk = ((nunits + 7) / 8 + 3) & ~3, per = F.G / 8, maxu = (chunk + per - 1) / per, c = (int)blockIdx.x;
        const int sp = F.tid < F.G ? maxu - moe_units_of(F.tid, F.G, nunits, chunk) : 0;
        const int lower = (int)wave_sum(F.tid < c ? (float)sp : 0.f), all = (int)wave_sum((float)sp);
        if (F.lane == 0) { atomicAdd((int*)(T + 65), lower); atomicAdd((int*)(T + 66), all); }
        if (F.tid == c) T[67] = sp;
    }
    __syncthreads();
}

struct EpiStoreBf16 {
    bf16* O; int ldc;
    __device__ __forceinline__ void operator()(const f32x4 (&acc)[2][2][4][2], const pg8::Unit& u, int wr, int wc, int fr, int fq) const {
        const int row0 = u.pm * 256 + wr * 64 + fr, col0 = u.pn * 256 + wc * 32 + 8 * fq;
#pragma unroll
        for (int ai = 0; ai < 2; ++ai)
#pragma unroll
            for (int m = 0; m < 4; ++m) { bf16* rowp = O + (size_t)(row0 + ai * 128 + m * 16) * ldc + col0;
#pragma unroll
                for (int bj = 0; bj < 2; ++bj) { const f32x4 v0 = acc[ai][bj][m][0], v1 = acc[ai][bj][m][1];
                    v4u w; w.x = pk2(v0[0], v0[1]); w.y = pk2(v0[2], v0[3]); w.z = pk2(v1[0], v1[1]); w.w = pk2(v1[2], v1[3]);
                    *(v4u*)(rowp + bj * 128) = w; } }
    }
};
template <bool F32SRC> struct EpiResid {
    const float* X; bf16* O; const float* cf; const float* mul;
    __device__ __forceinline__ void operator()(const f32x4 (&acc)[2][2][4][2], const pg8::Unit& u, int wr, int wc, int fr, int fq) const {
        const int row0 = u.pm * 256 + wr * 64 + fr, col0 = u.pn * 256 + wc * 32 + 8 * fq, b = (u.pm * 256) / SEQ;
        f32x4 c[2][2];
#pragma unroll
        for (int bj = 0; bj < 2; ++bj)
#pragma unroll
            for (int n = 0; n < 2; ++n) { c[bj][n] = *(const f32x4*)(cf + (size_t)b * 6144 + col0 + bj * 128 + 4 * n); if (mul) c[bj][n] *= *(const f32x4*)(mul + col0 + bj * 128 + 4 * n); }
#pragma unroll
        for (int ai = 0; ai < 2; ++ai)
#pragma unroll
            for (int m = 0; m < 4; ++m) { const size_t ro = (size_t)(row0 + ai * 128 + m * 16) * D + col0;
                f32x4 s[2][2];
                if (F32SRC) {
#pragma unroll
                    for (int bj = 0; bj < 2; ++bj) { s[bj][0] = *(const GAS f32x4*)(X + ro + bj * 128); s[bj][1] = *(const GAS f32x4*)(X + ro + bj * 128 + 4); }
                } else {
#pragma unroll
                    for (int bj = 0; bj < 2; ++bj) { const v4u q = *(const GAS v4u*)(O + ro + bj * 128);
                        s[bj][0].x = bflo(q.x); s[bj][0].y = bfhi(q.x); s[bj][0].z = bflo(q.y); s[bj][0].w = bfhi(q.y); s[bj][1].x = bflo(q.z); s[bj][1].y = bfhi(q.z); s[bj][1].z = bflo(q.w); s[bj][1].w = bfhi(q.w); }
                }
#pragma unroll
                for (int bj = 0; bj < 2; ++bj) { const f32x4 v0 = s[bj][0] + c[bj][0] * acc[ai][bj][m][0], v1 = s[bj][1] + c[bj][1] * acc[ai][bj][m][1];
                    v4u w; w.x = pk2(v0[0], v0[1]); w.y = pk2(v0[2], v0[3]); w.z = pk2(v1[0], v1[1]); w.w = pk2(v1[2], v1[3]);
                    *(v4u*)(O + ro + bj * 128) = w; } }
    }
};
struct EpiSwiglu {
    bf16* O;
    __device__ __forceinline__ void operator()(const f32x4 (&acc)[2][2][4][2], const pg8::Unit& u, int wr, int wc, int fr, int fq) const {
        const int row0 = u.pm * 256 + wr * 64 + fr, col0 = u.pn * 128 + wc * 32 + 8 * fq;
#pragma unroll
        for (int ai = 0; ai < 2; ++ai)
#pragma unroll
            for (int m = 0; m < 4; ++m) { bf16* rowp = O + (size_t)(row0 + ai * 128 + m * 16) * DFF + col0;
                float r[8];
#pragma unroll
                for (int n = 0; n < 2; ++n)
#pragma unroll
                    for (int j = 0; j < 4; ++j) r[4 * n + j] = silu_f(acc[ai][0][m][n][j]) * acc[ai][1][m][n][j];
                v4u w; w.x = pk2(r[0], r[1]); w.y = pk2(r[2], r[3]); w.z = pk2(r[4], r[5]); w.w = pk2(r[6], r[7]);
                *(v4u*)rowp = w; }
    }
};

__device__ __forceinline__ void moe_route(Frame& F, int layer) {
    LAS int* hist = (LAS int*)(F.lds + RT_LDS_OFF);
    LAS int* base = hist + 32;
    LAS int* tinfo = hist + 64;
    LAS float* tg = (LAS float*)(hist + 64 + 512);
    if (F.tid < 32) hist[F.tid] = 0;
    LAS f32x4* R2 = (LAS f32x4*)(F.lds + RING_OFF);
    LAS f32x4* R1 = (LAS f32x4*)(F.lds + R1W_OFF);
    { const f32x4* g2p = (const f32x4*)(F.in[I_R2W] + (size_t)layer * 1024 * 32); const f32x4* g1p = (const f32x4*)(F.in[I_R1W] + (size_t)layer * 1024 * 4);
      for (int i = F.tid; i < 8192; i += 512) { const int k = i >> 3, c4 = i & 7, ln = (k & 255) >> 2, q = k & 3, j = k >> 8; R2[((j * 4 + q) * 8 + c4) * 64 + ln] = g2p[i]; }
      for (int k = F.tid; k < 1024; k += 512) { const int ln = (k & 255) >> 2, q = k & 3, j = k >> 8; R1[(j * 4 + q) * 64 + ln] = g1p[k]; } }
    __syncthreads();
    const float* mod = (const float*)(F.ws + WS_MOD) + (size_t)layer * 2 * 6144;
    bf16* H = (bf16*)(F.ws + WS_H);
    const int tokw = F.vcu * 128 + F.wave * 16, b = (F.vcu * 128) / SEQ;
    const ModVec m = load_mod(F.in[I_NFFN] + layer * D, mod + (size_t)b * 6144 + 4 * 1024, mod + (size_t)b * 6144 + 3 * 1024, F.lane);
    const float* r1b = F.in[I_R1B] + layer * 4; const float* r2b = F.in[I_R2B] + layer * 32;
    const bf16* XRB = (const bf16*)(F.ws + WS_XRB);
    v2u xbn[4], xb2[4];
    load_row_bf16(XRB + (size_t)tokw * D, F.lane, xbn); load_row_bf16(XRB + (size_t)(tokw + 1) * D, F.lane, xb2);
    for (int i = 0; i < 16; ++i) {
        const int t = tokw + i;
        const RowVec x = unpack_row_bf16(xbn);
#pragma unroll
        for (int j = 0; j < 4; ++j) xbn[j] = xb2[j];
        if (i + 2 < 16) load_row_bf16(XRB + (size_t)(t + 2) * D, F.lane, xb2);
        RowVec h = apply_mod(x, row_rstd(x), m);
        store_row_bf16(H + (size_t)t * D, F.lane, h);
        f32x4 l1 = {0.f, 0.f, 0.f, 0.f};
#pragma unroll
        for (int j = 0; j < 4; ++j)
#pragma unroll
            for (int q = 0; q < 4; ++q) l1 += R1[(j * 4 + q) * 64 + F.lane] * h.v[j][q];
        float lg[4];
#pragma unroll
        for (int g = 0; g < 4; ++g) lg[g] = wave_sum(l1[g]) + r1b[g];
        int grp = 0; float mx = lg[0];
#pragma unroll
        for (int g = 1; g < 4; ++g) if (lg[g] > mx) { mx = lg[g]; grp = g; }
        float se = 0.f;
#pragma unroll
        for (int g = 0; g < 4; ++g) se += __expf(lg[g] - mx);
        const float ptop = 1.0f / se;
        grp = __builtin_amdgcn_readfirstlane(grp);
        f32x4 a0 = {0.f, 0.f, 0.f, 0.f}, a1 = {0.f, 0.f, 0.f, 0.f};
#pragma unroll
        for (int j = 0; j < 4; ++j)
#pragma unroll
            for (int q = 0; q < 4; ++q) { const LAS f32x4* wp = R2 + ((j * 4 + q) * 8 + grp * 2) * 64 + F.lane;
                a0 += wp[0] * h.v[j][q]; a1 += wp[64] * h.v[j][q]; }
        float l2[8];
#pragma unroll
        for (int q = 0; q < 4; ++q) { l2[q] = wave_sum(a0[q]) + r2b[grp * 8 + q]; l2[4 + q] = wave_sum(a1[q]) + r2b[grp * 8 + 4 + q]; }
        int i0 = 0; float v0 = l2[0];
#pragma unroll
        for (int q = 1; q < 8; ++q) if (l2[q] > v0) { v0 = l2[q]; i0 = q; }
        int i1 = (i0 == 0) ? 1 : 0; float v1 = l2[i1 == 1 ? 1 : 0];
#pragma unroll
        for (int q = 0; q < 8; ++q) if (q != i0 && l2[q] > v1) { v1 = l2[q]; i1 = q; }
        const float g0 = ptop / (1.0f + __expf(v1 - v0)), g1 = ptop - g0;
        if (F.lane == 0) { const int e0 = grp * 8 + i0, e1 = grp * 8 + i1, li = F.wave * 16 + i;
            tinfo[li * 4 + 0] = e0; tinfo[li * 4 + 1] = e1; tinfo[li * 4 + 2] = atomicAdd((int*)(hist + e0), 1); tinfo[li * 4 + 3] = atomicAdd((int*)(hist + e1), 1);
            tg[li * 2] = g0; tg[li * 2 + 1] = g1;
            { float* GA = (float*)(F.ws + WS_BG); GA[(size_t)t * 2] = g0; GA[(size_t)t * 2 + 1] = g1; }
        }
    }
    __syncthreads();
    if (F.tid < 32) base[F.tid] = (int)__hip_atomic_fetch_add(F.ctl + CW_CNT + 64 * layer + F.tid, (unsigned)hist[F.tid], RLX_AGENT);
    __syncthreads();
    if (F.tid < 128) { const int t = F.vcu * 128 + F.tid; const int e0 = tinfo[F.tid * 4], e1 = tinfo[F.tid * 4 + 1];
        const int p0 = base[e0] + tinfo[F.tid * 4 + 2], p1 = base[e1] + tinfo[F.tid * 4 + 3];
        int* RT = (int*)(F.ws + WS_RT); RT[e0 * NTOK + p0] = t; RT[e1 * NTOK + p1] = t;
        v4u r0; r0.x = e0; r0.y = e1; r0.z = p0; r0.w = p1; v4u r1; r1.x = __builtin_bit_cast(unsigned, tg[F.tid * 2]); r1.y = __builtin_bit_cast(unsigned, tg[F.tid * 2 + 1]); r1.z = 0; r1.w = 0;
        v4u* RO = (v4u*)(F.ws + WS_ROUTE) + (size_t)t * 2; RO[0] = r0; (void)r1; }
    __syncthreads();
}

struct CombRows { v2u xb[4], ya[4], yb[4]; };
struct CombRecs { v4u rec; float ga, gb; };
__device__ __forceinline__ CombRecs comb_load_recs(Frame& F, int tokw) { CombRecs c; const int t = tokw + (F.lane & 15);
    c.rec = *((const v4u*)(F.ws + WS_ROUTE) + (size_t)t * 2); const float* GA = (const float*)(F.ws + WS_BG); c.ga = GA[(size_t)t * 2]; c.gb = GA[(size_t)t * 2 + 1]; return c; }
__device__ __forceinline__ int rl_i(int v, int l) { return __builtin_amdgcn_readlane(v, l); }
__device__ __forceinline__ void comb_issue(Frame& F, const CombRecs& c, int i, int t, CombRows& r) {
    const LAS int* T = (const LAS int*)(F.lds + SCHED_OFF);
    const int e0 = rl_i((int)c.rec.x, i), e1 = rl_i((int)c.rec.y, i), p0 = rl_i((int)c.rec.z, i), p1 = rl_i((int)c.rec.w, i);
    const size_t rowa = (size_t)T[32 + e0] * 256 + p0, rowb = (size_t)T[32 + e1] * 256 + p1;
    const bf16* Y = (const bf16*)(F.ws + WS_Y);
    const GAS v2u* ya = (const GAS v2u*)(Y + rowa * D) + F.lane; const GAS v2u* yb = (const GAS v2u*)(Y + rowb * D) + F.lane;
    load_row_bf16((const bf16*)(F.ws + WS_XRB) + (size_t)t * D, F.lane, r.xb);
#pragma unroll
    for (int j = 0; j < 4; ++j) { r.ya[j] = ya[64 * j]; r.yb[j] = yb[64 * j]; }
}
__device__ __forceinline__ RowVec comb_finish(const CombRecs& c, int i, const CombRows& r, const f32x4 (&g2)[4]) {
    const float ga = rl(c.ga, i), gb = rl(c.gb, i); RowVec x = unpack_row_bf16(r.xb);
#pragma unroll
    for (int j = 0; j < 4; ++j) { const v2u a = r.ya[j], bq = r.yb[j];
        f32x4 s; s.x = ga * bflo(a.x) + gb * bflo(bq.x); s.y = ga * bfhi(a.x) + gb * bfhi(bq.x); s.z = ga * bflo(a.y) + gb * bflo(bq.y); s.w = ga * bfhi(a.y) + gb * bfhi(bq.y);
        x.v[j] += g2[j] * s; }
    return x;
}

__device__ __forceinline__ void attn_phase(Frame& F, const int u_first, const int u_stride) {
    LAS bf16* KS = (LAS bf16*)(F.lds + RING_OFF);
    LAS bf16* VT = (LAS bf16*)(F.lds + RING_OFF + 36864);
    LAS float* BT = (LAS float*)(F.lds + RING_OFF + 36864 + 33280);
    const bf16* PROJ = (const bf16*)(F.ws + WS_PROJ); bf16* OAB = (bf16*)(F.ws + WS_OAB);
    const int lane = F.lane, lc = lane & 31, lh = lane >> 5;
    for (int unit = u_first; unit < 512; unit += u_stride) {
        const int b = unit >> 8, kvh = (unit >> 7) & 1, qb = unit & 127, t0 = qb * 128;
        __syncthreads();
        for (int i = F.tid; i < 4 * 192; i += 512) { const int hq = i / 192, x = i - hq * 192, dist = 159 - x; float v = 0.f;
            if (dist >= 0 && dist < 128) { int bk = dist; if (dist >= 16) { bk = 16 + (int)(logf((float)dist / 16.0f) / 2.0794415416798357f * 16.0f); bk = bk > 31 ? 31 : bk; }
                v = F.in[I_RELB][bk * 8 + kvh * 4 + hq] * 1.4426950408889634f; }
            BT[i] = v; }
#pragma unroll
        for (int cc = 0; cc < 4; ++cc) { const int ch = F.tid + 512 * cc, key = ch >> 3, part = ch & 7, tl = t0 - 128 + key;
            v4u kv = {0u, 0u, 0u, 0u}, vv = {0u, 0u, 0u, 0u};
            if (tl >= 0) { const bf16* rp = PROJ + (size_t)(b * SEQ + tl) * PIN; kv = *(const v4u*)(rp + PC_KB + kvh * 64 + part * 8); vv = *(const v4u*)(rp + PC_VB + kvh * 64 + part * 8); }
            *(LAS v4u*)(KS + key * 72 + part * 8) = kv;
            const unsigned w[4] = {vv.x, vv.y, vv.z, vv.w};
#pragma unroll
            for (int q = 0; q < 4; ++q) { VT[(part * 8 + 2 * q) * 260 + key] = (bf16)(w[q] & 0xffffu); VT[(part * 8 + 2 * q + 1) * 260 + key] = (bf16)(w[q] >> 16); } }
        __syncthreads();
#pragma unroll 1
        for (int tt = 0; tt < 2; ++tt) {
            const int task = F.wave * 2 + tt, hq = task >> 2, qt = task & 3, qh = kvh * 4 + hq;
            const int qi = 32 * qt + lc;
            const bf16* qrow = PROJ + (size_t)(b * SEQ + t0 + qi) * PIN + PC_QB + qh * 64 + 8 * lh;
            bf16x8 qf[4];
#pragma unroll
            for (int s = 0; s < 4; ++s) qf[s] = *(const bf16x8*)(qrow + 16 * s);
            f32x16 sc[5];
#pragma unroll
            for (int kt = 0; kt < 5; ++kt) {
#pragma unroll
                for (int r = 0; r < 16; ++r) sc[kt][r] = 0.f;
                const LAS bf16* kp = KS + (32 * (qt + kt) + lc) * 72 + 8 * lh;
#pragma unroll
                for (int s = 0; s < 4; ++s) { const bf16x8 kf = *(const LAS bf16x8*)(kp + 16 * s); sc[kt] = __builtin_amdgcn_mfma_f32_32x32x16_bf16(kf, qf[s], sc[kt], 0, 0, 0); }
            }
            const float sink2 = F.in[I_SINKS][qh] * 1.4426950408889634f;
            const LAS float* bp = BT + hq * 192 + (4 * lh - lc + 31);
            const int m_lo = lc + 1 - 4 * lh, m_hi = lc - 4 * lh;
            float mx = sink2;
#pragma unroll
            for (int kt = 0; kt < 5; ++kt) {
                const bool dead = (t0 == 0) && (qt + kt < 4);
#pragma unroll
                for (int r = 0; r < 16; ++r) { const int cr = (r & 3) + 8 * (r >> 2);
                    float v = sc[kt][r] * (0.125f * 1.4426950408889634f) + bp[32 * kt + cr];
                    if (kt == 0) v = (cr >= m_lo) ? v : -1e30f;
                    if (kt == 4) v = (cr <= m_hi) ? v : -1e30f;
                    if (dead) v = -1e30f;
                    sc[kt][r] = v; mx = fmaxf(mx, v); } }
            mx = fmaxf(mx, __shfl_xor(mx, 32));
            float den = 0.f;
#pragma unroll
            for (int kt = 0; kt < 5; ++kt)
#pragma unroll
                for (int r = 0; r < 16; ++r) { const float p = __builtin_amdgcn_exp2f(sc[kt][r] - mx); sc[kt][r] = p; den += p; }
            den += __shfl_xor(den, 32);
            den += __builtin_amdgcn_exp2f(sink2 - mx);
            const float inv = 1.0f / den;
            f32x16 oa[2];
#pragma unroll
            for (int dt = 0; dt < 2; ++dt)
#pragma unroll
                for (int r = 0; r < 16; ++r) oa[dt][r] = 0.f;
#pragma unroll
            for (int kt = 0; kt < 5; ++kt)
#pragma unroll
                for (int s2 = 0; s2 < 2; ++s2) {
                    v4u pw; pw.x = pk2(sc[kt][8 * s2 + 0], sc[kt][8 * s2 + 1]); pw.y = pk2(sc[kt][8 * s2 + 2], sc[kt][8 * s2 + 3]); pw.z = pk2(sc[kt][8 * s2 + 4], sc[kt][8 * s2 + 5]); pw.w = pk2(sc[kt][8 * s2 + 6], sc[kt][8 * s2 + 7]);
                    const bf16x8 pf = __builtin_bit_cast(bf16x8, pw);
#pragma unroll
                    for (int dt = 0; dt < 2; ++dt) { const LAS bf16* vp = VT + (32 * dt + lc) * 260 + 32 * (qt + kt) + 16 * s2 + 4 * lh;
                        const v2u va = *(const LAS v2u*)vp, vb = *(const LAS v2u*)(vp + 8);
                        v4u vw; vw.x = va.x; vw.y = va.y; vw.z = vb.x; vw.w = vb.y;
                        oa[dt] = __builtin_amdgcn_mfma_f32_32x32x16_bf16(__builtin_bit_cast(bf16x8, vw), pf, oa[dt], 0, 0, 0); }
                }
            bf16* orow = OAB + (size_t)(b * SEQ + t0 + qi) * D + 512 + qh * 64 + 4 * lh;
#pragma unroll
            for (int dt = 0; dt < 2; ++dt)
#pragma unroll
                for (int rg = 0; rg < 4; ++rg) { v2u o; o.x = pk2(oa[dt][4 * rg] * inv, oa[dt][4 * rg + 1] * inv); o.y = pk2(oa[dt][4 * rg + 2] * inv, oa[dt][4 * rg + 3] * inv);
                    *(v2u*)(orow + 32 * dt + 8 * rg) = o; }
        }
    }
    __syncthreads();
}


constexpr int DN_ST = 72;

__device__ __forceinline__ bf16x8 pack8(const f32x16& x, int s) { v4u p; p.x = pk2(x[8 * s], x[8 * s + 1]); p.y = pk2(x[8 * s + 2], x[8 * s + 3]); p.z = pk2(x[8 * s + 4], x[8 * s + 5]); p.w = pk2(x[8 * s + 6], x[8 * s + 7]); return __builtin_bit_cast(bf16x8, p); }
__device__ __forceinline__ f32x16 dn_tile(const LAS bf16* A, int ra, const LAS bf16* B, int rb, int lc, int lh) {
    f32x16 acc;
#pragma unroll
    for (int r = 0; r < 16; ++r) acc[r] = 0.f;
#pragma unroll
    for (int s = 0; s < 4; ++s) { const bf16x8 a = *(const LAS bf16x8*)(A + (ra + lc) * DN_ST + 16 * s + 8 * lh), b = *(const LAS bf16x8*)(B + (rb + lc) * DN_ST + 16 * s + 8 * lh);
        acc = __builtin_amdgcn_mfma_f32_32x32x16_bf16(a, b, acc, 0, 0, 0); }
    return acc;
}
__device__ __forceinline__ void dn_prep(Frame& F) {
    LAS bf16* Qs = (LAS bf16*)(F.lds + RING_OFF);
    LAS bf16* Ks = Qs + 64 * DN_ST;
    LAS bf16* KBs = Ks + 64 * DN_ST;
    LAS bf16* Vs = KBs + 64 * DN_ST;
    LAS bf16* KDT = Vs + 64 * DN_ST;
    LAS bf16* AQK = KDT + 64 * DN_ST;
    LAS bf16* UT = AQK + 64 * DN_ST;
    LAS bf16* WT = UT + 64 * DN_ST;
    LAS bf16* LNO = WT + 64 * DN_ST;
    LAS float* LD = (LAS float*)(LNO + 64 * DN_ST);
    LAS bf16* TDZ = (LAS bf16*)(LD + 64 * 16);
    LAS float* GB = (LAS float*)(TDZ + 64 * 24);
    const bf16* PROJ = (const bf16*)(F.ws + WS_PROJ); const float* BG = (const float*)(F.ws + WS_BG);
    const int tid = F.tid, lane = F.lane, lc = lane & 31, lh = lane >> 5, wave = F.wave;
    LAS float* CW = GB + 256;
    for (int i = tid; i < 1536; i += 512) *((LAS f32x4*)CW + i) = *((const f32x4*)F.in[I_CONVW] + i);
    LAS v4u* RAW = (LAS v4u*)(F.lds + R1W_OFF);
    constexpr int RAW_CH = 67 * 24;
#define DN_RAW_SRC(i_, b_, h_, n_) ({ const int r_ = (i_) / 24, c_ = (i_) - r_ * 24; const int tl_ = (n_) * 64 - 3 + r_; \
        tl_ >= 0 ? (const v4u*)(PROJ + ((size_t)(b_) * SEQ + tl_) * PIN + (c_ < 8 ? PC_QA : c_ < 16 ? PC_KA : PC_VA) + (h_) * 64 + (c_ & 7) * 8) : (const v4u*)nullptr; })
    { const int u0 = F.vcu, b = u0 >> 11, h = (u0 >> 8) & 7, n = u0 & 255;
      for (int i = tid; i < RAW_CH; i += 512) { const v4u* sp = DN_RAW_SRC(i, b, h, n); v4u z = {0u, 0u, 0u, 0u}; if (sp) z = *sp; RAW[i] = z; }
      if (wave == 0) { const size_t row0 = (size_t)b * SEQ + (size_t)n * 64; float c = BG[(row0 + lane) * 16 + 8 + h];
#pragma unroll
          for (int o = 1; o < 64; o <<= 1) { const float up = __shfl_up(c, o); if (lane >= o) c += up; }
          GB[lane] = c; GB[64 + lane] = BG[(row0 + lane) * 16 + h]; } }
    int par = 0;
    for (int unit = F.vcu; unit < 4096; unit += F.G, par ^= 1) {
        const int b = unit >> 11, h = (unit >> 8) & 7, n = unit & 255;
        LAS float* gcs = GB + par * 128; LAS float* bts = gcs + 64;
        const int un = unit + F.G; const bool more = un < 4096; const int bn = un >> 11, hn = (un >> 8) & 7, nn = un & 255;
        __syncthreads();
        { const int t = tid >> 3, cs = tid & 7;
          float q[8], k[8], v[8];
#pragma unroll
          for (int e = 0; e < 8; ++e) { q[e] = 0.f; k[e] = 0.f; v[e] = 0.f; }
#pragma unroll
          for (int j = 0; j < 4; ++j) { { const LAS v4u* rp = RAW + (t + j) * 24 + cs;
                const v4u wq = rp[0], wk = rp[8], wv = rp[16];
                const LAS float* cw = CW + j * 1536 + h * 64 + cs * 8;
                const unsigned uq[4] = {wq.x, wq.y, wq.z, wq.w}, uk[4] = {wk.x, wk.y, wk.z, wk.w}, uv[4] = {wv.x, wv.y, wv.z, wv.w};
#pragma unroll
                for (int e = 0; e < 4; ++e) { q[2 * e] += cw[2 * e] * bflo(uq[e]); q[2 * e + 1] += cw[2 * e + 1] * bfhi(uq[e]);
                    k[2 * e] += cw[512 + 2 * e] * bflo(uk[e]); k[2 * e + 1] += cw[512 + 2 * e + 1] * bfhi(uk[e]);
                    v[2 * e] += cw[1024 + 2 * e] * bflo(uv[e]); v[2 * e + 1] += cw[1024 + 2 * e + 1] * bfhi(uv[e]); } } }
          float sq = 0.f, sk = 0.f;
#pragma unroll
          for (int e = 0; e < 8; ++e) { q[e] = silu_f(q[e]); k[e] = silu_f(k[e]); v[e] = silu_f(v[e]); sq += q[e] * q[e]; sk += k[e] * k[e]; }
          sq = oct_sum(sq); sk = oct_sum(sk);
          const float rq = 0.125f / sqrtf(sq + EPS), rk = 1.0f / sqrtf(sk + EPS), bt = bts[t], kd = __expf(gcs[63] - gcs[t]);
          v4u oq, ok, ob, ov;
          oq.x = pk2(q[0] * rq, q[1] * rq); oq.y = pk2(q[2] * rq, q[3] * rq); oq.z = pk2(q[4] * rq, q[5] * rq); oq.w = pk2(q[6] * rq, q[7] * rq);
#pragma unroll
          for (int e = 0; e < 8; ++e) k[e] *= rk;
          ok.x = pk2(k[0], k[1]); ok.y = pk2(k[2], k[3]); ok.z = pk2(k[4], k[5]); ok.w = pk2(k[6], k[7]);
          ob.x = pk2(k[0] * bt, k[1] * bt); ob.y = pk2(k[2] * bt, k[3] * bt); ob.z = pk2(k[4] * bt, k[5] * bt); ob.w = pk2(k[6] * bt, k[7] * bt);
          ov.x = pk2(v[0], v[1]); ov.y = pk2(v[2], v[3]); ov.z = pk2(v[4], v[5]); ov.w = pk2(v[6], v[7]);
          *(LAS v4u*)(Qs + t * DN_ST + cs * 8) = oq; *(LAS v4u*)(Ks + t * DN_ST + cs * 8) = ok; *(LAS v4u*)(KBs + t * DN_ST + cs * 8) = ob; *(LAS v4u*)(Vs + t * DN_ST + cs * 8) = ov;
#pragma unroll
          for (int e = 0; e < 8; ++e) KDT[(cs * 8 + e) * DN_ST + t] = (bf16)f2bf(k[e] * kd); }
        __syncthreads();
        v4u pf[7]; float pg = 0.f, pb = 0.f;
        if (wave >= 4 && more) {
#pragma unroll
            for (int k7 = 0; k7 < 7; ++k7) { const int i = (tid - 256) + 256 * k7; pf[k7] = (v4u){0u, 0u, 0u, 0u}; if (i < RAW_CH) { const v4u* sp = DN_RAW_SRC(i, bn, hn, nn); if (sp) pf[k7] = *sp; } }
            if (wave == 4) { const size_t rn = (size_t)bn * SEQ + (size_t)nn * 64; pg = BG[(rn + lane) * 16 + 8 + hn]; pb = BG[(rn + lane) * 16 + hn]; }
        }
        { const int it = (wave >> 1) & 1, jt = wave & 1; const bool qk = wave >= 4;
          f32x16 acc;
          if (it >= jt) acc = dn_tile(qk ? Qs : KBs, 32 * it, Ks, 32 * jt, lc, lh);
          const int j = 32 * jt + lc; const float gj = gcs[j];
#pragma unroll
          for (int r = 0; r < 16; ++r) { const int i = 32 * it + (r & 3) + 8 * (r >> 2) + 4 * lh;
              float val = 0.f;
              if (it >= jt) { if (qk ? (i >= j) : (i > j)) val = acc[r] * __expf(gcs[i] - gj); }
              if (qk) AQK[i * DN_ST + j] = (bf16)f2bf(val);
              else { const bool diag = (i >> 4) == (j >> 4); LNO[i * DN_ST + j] = (bf16)f2bf(diag ? 0.f : -val); if (diag) LD[i * 16 + (j & 15)] = val; } } }
        __syncthreads();
        if (wave == 0) { const int bb = lane >> 4, c = lane & 15; float tcol[16];
#pragma unroll
            for (int i = 0; i < 16; ++i) { float v = (i == c) ? 1.f : 0.f;
#pragma unroll
                for (int j4 = 0; j4 < (i + 3) / 4; ++j4) { const f32x4 a = *(const LAS f32x4*)(LD + (16 * bb + i) * 16 + 4 * j4);
#pragma unroll
                    for (int e = 0; e < 4; ++e) if (4 * j4 + e < i) v -= a[e] * tcol[4 * j4 + e]; }
                tcol[i] = v; TDZ[(16 * bb + i) * 24 + c] = (bf16)f2bf(v); } }
        __syncthreads();
        if (wave < 4) {
            const int ct = wave, cc = 32 * (ct & 1) + lc; const bool isw = ct >= 2;
            f32x16 acc[2];
#pragma unroll
            for (int rt = 0; rt < 2; ++rt)
#pragma unroll
                for (int r = 0; r < 16; ++r) { const int t = 32 * rt + (r & 3) + 8 * (r >> 2) + 4 * lh;
                    acc[rt][r] = isw ? bf2f(Ks[t * DN_ST + cc]) * bts[t] * __expf(gcs[t]) : bf2f(Vs[t * DN_ST + cc]) * bts[t]; }
#define DN_AFRAG(arr, stride, row, kb) ({ const LAS bf16* p_ = (arr) + (row) * (stride) + 16 * (kb) + 4 * lh; const v2u lo_ = *(const LAS v2u*)p_, hi_ = *(const LAS v2u*)(p_ + 8); v4u w_; w_.x = lo_.x; w_.y = lo_.y; w_.z = hi_.x; w_.w = hi_.y; __builtin_bit_cast(bf16x8, w_); })
            f32x16 X[4];
#pragma unroll
            for (int bb = 0; bb < 4; ++bb) { const int rt = bb >> 1, odd = bb & 1;
                bf16x8 ta = DN_AFRAG(TDZ, 24, 32 * rt + lc, 0);
                if ((lc >> 4) != odd) ta = (bf16x8){0, 0, 0, 0, 0, 0, 0, 0};
                f32x16 z;
#pragma unroll
                for (int r = 0; r < 16; ++r) z[r] = 0.f;
                z = __builtin_amdgcn_mfma_f32_32x32x16_bf16(ta, pack8(acc[rt], odd), z, 0, 0, 0);
                X[bb] = z;
                const bf16x8 xb = pack8(z, odd);
                if (bb == 0) { acc[0] = __builtin_amdgcn_mfma_f32_32x32x16_bf16(DN_AFRAG(LNO, DN_ST, lc, 0), xb, acc[0], 0, 0, 0); acc[1] = __builtin_amdgcn_mfma_f32_32x32x16_bf16(DN_AFRAG(LNO, DN_ST, 32 + lc, 0), xb, acc[1], 0, 0, 0); }
                if (bb == 1) { acc[1] = __builtin_amdgcn_mfma_f32_32x32x16_bf16(DN_AFRAG(LNO, DN_ST, 32 + lc, 1), xb, acc[1], 0, 0, 0); }
                if (bb == 2) { acc[1] = __builtin_amdgcn_mfma_f32_32x32x16_bf16(DN_AFRAG(LNO, DN_ST, 32 + lc, 2), xb, acc[1], 0, 0, 0); }
            }
#undef DN_AFRAG
            LAS bf16* dst = (isw ? WT : UT) + cc * DN_ST;
#pragma unroll
            for (int bb = 0; bb < 4; ++bb)
#pragma unroll
                for (int g = 0; g < 2; ++g) { const int r0 = 8 * (bb & 1) + 4 * g; v2u o; o.x = pk2(X[bb][r0], X[bb][r0 + 1]); o.y = pk2(X[bb][r0 + 2], X[bb][r0 + 3]);
                    *(LAS v2u*)(dst + 16 * bb + 8 * g + 4 * lh) = o; }
        } else if (more) {
#pragma unroll
            for (int k7 = 0; k7 < 7; ++k7) { const int i = (tid - 256) + 256 * k7; if (i < RAW_CH) RAW[i] = pf[k7]; }
            if (wave == 4) { float c = pg;
#pragma unroll
                for (int o = 1; o < 64; o <<= 1) { const float up = __shfl_up(c, o); if (lane >= o) c += up; }
                GB[(par ^ 1) * 128 + lane] = c; GB[(par ^ 1) * 128 + 64 + lane] = pb; }
        }
        __syncthreads();
        { bf16* MT = (bf16*)((unsigned char*)F.out + OUT_DN_MT) + (size_t)unit * 4096; bf16* QPT = (bf16*)((unsigned char*)F.out + OUT_DN_QPT) + (size_t)unit * 4096;
          bf16* BM = (bf16*)(F.ws + WS_DN_BM) + (size_t)unit * 4096; bf16* O0T = (bf16*)(F.ws + WS_DN_O0T) + (size_t)unit * 4096;
#pragma unroll 1
          for (int tt = 0; tt < 2; ++tt) { const int task = wave * 2 + tt, p = task >> 2, ta = (task >> 1) & 1, tb = task & 1;
              if (p == 0) {
                  f32x16 acc = dn_tile(WT, 32 * ta, KDT, 32 * tb, lc, lh);
#pragma unroll
                  for (int r = 0; r < 16; ++r) acc[r] = -acc[r];
#pragma unroll
                  for (int s2 = 0; s2 < 2; ++s2) *(bf16x8*)(MT + ((((tb * 2 + ta) * 2 + s2) * 64 + lane) * 8)) = pack8(acc, s2);
              } else if (p == 1) {
                  const f32x16 acc = dn_tile(KDT, 32 * ta, UT, 32 * tb, lc, lh);
#pragma unroll
                  for (int s2 = 0; s2 < 2; ++s2) *(bf16x8*)(BM + ((((tb * 2 + ta) * 2 + s2) * 64 + lane) * 8)) = pack8(acc, s2);
              } else if (p == 2) {
                  f32x16 acc = dn_tile(WT, 32 * ta, AQK, 32 * tb, lc, lh);
                  const int i = 32 * tb + lc; const float eg = __expf(gcs[i]);
#pragma unroll
                  for (int r = 0; r < 16; ++r) { const int a = 32 * ta + (r & 3) + 8 * (r >> 2) + 4 * lh; acc[r] = bf2f(Qs[i * DN_ST + a]) * eg - acc[r]; }
#pragma unroll
                  for (int s2 = 0; s2 < 2; ++s2) *(bf16x8*)(QPT + ((((tb * 2 + ta) * 2 + s2) * 64 + lane) * 8)) = pack8(acc, s2);
              } else {
                  const f32x16 acc = dn_tile(UT, 32 * ta, AQK, 32 * tb, lc, lh);
#pragma unroll
                  for (int s2 = 0; s2 < 2; ++s2) *(bf16x8*)(O0T + ((((tb * 2 + ta) * 2 + s2) * 64 + lane) * 8)) = pack8(acc, s2);
              } }
          if (tid == 0) ((float*)(F.ws + WS_DN_GT))[unit] = __expf(gcs[63]); }
    }
#undef DN_RAW_SRC
    __syncthreads();
}
template <int r>
__device__ __forceinline__ void dn_scan_wave(Frame& F) {
    const int bx = (int)blockIdx.x, w = (bx & 7) * 4 + (bx >> 3), bh = w >> 1, ct = w & 1, lane = F.lane;
    const bf16x8* MT = (const bf16x8*)((const unsigned char*)F.out + OUT_DN_MT); const bf16x8* BM = (const bf16x8*)(F.ws + WS_DN_BM); bf16x8* SS = (bf16x8*)(F.ws + WS_DN_S);
    const float* GT = (const float*)(F.ws + WS_DN_GT);
    LAS bf16x8* MB = (LAS bf16x8*)(F.lds + RING_OFF);
    volatile LAS int* FL = (volatile LAS int*)(F.lds + LDSCTL_OFF + 64);
    f32x16 S;
#pragma unroll
    for (int q = 0; q < 16; ++q) S[q] = 0.f;
    bf16x8 mA[4], bA[2], mB[4], bB[2], mC[4], bC[2], mD[4], bD[2], mE[4], bE[2], mG[4], bG[2]; float gA, gB, gC, gD, gE, gG;
#define DN_SLOAD(m, bm, gt, u) do { const size_t ub = (size_t)(u) * 512; _Pragma("unroll") for (int f = 0; f < 4; ++f) m[f] = MT[ub + (r * 4 + f) * 64 + lane]; \
        _Pragma("unroll") for (int f = 0; f < 2; ++f) bm[f] = BM[ub + ((ct * 2 + r) * 2 + f) * 64 + lane]; gt = GT[u]; } while (0)
#define DN_STEP(cm, cb, cg, unit, n) do { \
        bf16x8 own[2]; own[0] = pack8(S, 0); own[1] = pack8(S, 1); \
        LAS bf16x8* mb = MB + ((n) & 1) * 256; \
        mb[(r * 2 + 0) * 64 + lane] = own[0]; mb[(r * 2 + 1) * 64 + lane] = own[1]; \
        asm volatile("s_waitcnt lgkmcnt(0)" ::: "memory"); \
        if (lane == 0) FL[r] = (n) + 1; \
        SS[(size_t)(unit) * 512 + (ct * 4 + r * 2 + 0) * 64 + lane] = own[0]; SS[(size_t)(unit) * 512 + (ct * 4 + r * 2 + 1) * 64 + lane] = own[1]; \
        f32x16 A; \
        { const v4u b0 = __builtin_bit_cast(v4u, cb[0]), b1 = __builtin_bit_cast(v4u, cb[1]); const unsigned u0[8] = {b0.x, b0.y, b0.z, b0.w, b1.x, b1.y, b1.z, b1.w}; \
          _Pragma("unroll") for (int e = 0; e < 8; ++e) { A[2 * e] = cg * S[2 * e] + bflo(u0[e]); A[2 * e + 1] = cg * S[2 * e + 1] + bfhi(u0[e]); } } \
        while (FL[1 - r] < (n) + 1) { } \
        asm volatile("" ::: "memory"); \
        bf16x8 oth[2]; oth[0] = mb[((1 - r) * 2 + 0) * 64 + lane]; oth[1] = mb[((1 - r) * 2 + 1) * 64 + lane]; \
          \
        _Pragma("unroll") for (int s2 = 0; s2 < 2; ++s2) { A = __builtin_amdgcn_mfma_f32_32x32x16_bf16(cm[r * 2 + s2], own[s2], A, 0, 0, 0); A = __builtin_amdgcn_mfma_f32_32x32x16_bf16(cm[(1 - r) * 2 + s2], oth[s2], A, 0, 0, 0); } \
        S = A; } while (0)
    const int u0 = bh * 256;
    DN_SLOAD(mA, bA, gA, u0); DN_SLOAD(mB, bB, gB, u0 + 1); DN_SLOAD(mC, bC, gC, u0 + 2); DN_SLOAD(mD, bD, gD, u0 + 3); DN_SLOAD(mE, bE, gE, u0 + 4); DN_SLOAD(mG, bG, gG, u0 + 5);
    for (int n = 0; n < 252; n += 6) {
        DN_STEP(mA, bA, gA, u0 + n, n);         DN_SLOAD(mA, bA, gA, u0 + n + 6);
        DN_STEP(mB, bB, gB, u0 + n + 1, n + 1); DN_SLOAD(mB, bB, gB, u0 + n + 7);
        DN_STEP(mC, bC, gC, u0 + n + 2, n + 2); DN_SLOAD(mC, bC, gC, u0 + n + 8);
        DN_STEP(mD, bD, gD, u0 + n + 3, n + 3); DN_SLOAD(mD, bD, gD, u0 + n + 9);
        DN_STEP(mE, bE, gE, u0 + n + 4, n + 4); if (n + 10 < 256) DN_SLOAD(mE, bE, gE, u0 + n + 10);
        DN_STEP(mG, bG, gG, u0 + n + 5, n + 5); if (n + 11 < 256) DN_SLOAD(mG, bG, gG, u0 + n + 11);
    }
    DN_STEP(mA, bA, gA, u0 + 252, 252); DN_STEP(mB, bB, gB, u0 + 253, 253); DN_STEP(mC, bC, gC, u0 + 254, 254); DN_STEP(mD, bD, gD, u0 + 255, 255);
#undef DN_SLOAD
#undef DN_STEP
}
__device__ __forceinline__ void dn_scan(Frame& F) {
    if ((int)blockIdx.x >= 32) return;
    if (F.wave == 0) dn_scan_wave<0>(F); else if (F.wave == 1) dn_scan_wave<1>(F);
}
__device__ __forceinline__ void dn_output(Frame& F) {
    const bf16x8* QPT = (const bf16x8*)((const unsigned char*)F.out + OUT_DN_QPT); const bf16x8* O0T = (const bf16x8*)(F.ws + WS_DN_O0T); const bf16x8* SS = (const bf16x8*)(F.ws + WS_DN_S);
    const bf16* PROJ = (const bf16*)(F.ws + WS_PROJ); bf16* OAB = (bf16*)(F.ws + WS_OAB);
    const int lane = F.lane, lc = lane & 31, lh = lane >> 5; int nbad = 0; (void)nbad;
    for (int task = F.vcu * NWAVES + F.wave; task < 8192; task += F.G * NWAVES) {
        const int unit = task >> 1, it = task & 1, b = unit >> 11, h = (unit >> 8) & 7, n = unit & 255;
        const size_t ub = (size_t)unit * 512;
        f32x16 o[2];
#pragma unroll
        for (int ct = 0; ct < 2; ++ct) {
            const v4u c0 = __builtin_bit_cast(v4u, O0T[ub + ((it * 2 + ct) * 2 + 0) * 64 + lane]), c1 = __builtin_bit_cast(v4u, O0T[ub + ((it * 2 + ct) * 2 + 1) * 64 + lane]);
            const unsigned u[8] = {c0.x, c0.y, c0.z, c0.w, c1.x, c1.y, c1.z, c1.w};
#pragma unroll
            for (int e = 0; e < 8; ++e) { o[ct][2 * e] = bflo(u[e]); o[ct][2 * e + 1] = bfhi(u[e]); }
#pragma unroll
            for (int at = 0; at < 2; ++at)
#pragma unroll
                for (int s2 = 0; s2 < 2; ++s2) o[ct] = __builtin_amdgcn_mfma_f32_32x32x16_bf16(SS[ub + (ct * 4 + at * 2 + s2) * 64 + lane], QPT[ub + ((it * 2 + at) * 2 + s2) * 64 + lane], o[ct], 0, 0, 0);
        }
        float ss = 0.f;
#pragma unroll
        for (int ct = 0; ct < 2; ++ct)
#pragma unroll
            for (int r = 0; r < 16; ++r) ss += o[ct][r] * o[ct][r];
        ss += __shfl_xor(ss, 32);
        const float rs = 1.0f / sqrtf(ss * (1.0f / 64.0f) + EPS);
        const size_t row = (size_t)b * SEQ + (size_t)n * 64 + it * 32 + lc;
#pragma unroll
        for (int ct = 0; ct < 2; ++ct)
#pragma unroll
            for (int rg = 0; rg < 4; ++rg) { const int c0 = 32 * ct + 8 * rg + 4 * lh;
                const v2u zz = *(const v2u*)(PROJ + row * PIN + PC_ZA + h * 64 + c0); const f32x4 ow = *(const f32x4*)(F.in[I_ONORM] + c0);
                const float z0 = bflo(zz.x), z1 = bfhi(zz.x), z2 = bflo(zz.y), z3 = bfhi(zz.y);
                v2u ov; ov.x = pk2(o[ct][4 * rg] * rs * ow[0] * silu_f(z0), o[ct][4 * rg + 1] * rs * ow[1] * silu_f(z1)); ov.y = pk2(o[ct][4 * rg + 2] * rs * ow[2] * silu_f(z2), o[ct][4 * rg + 3] * rs * ow[3] * silu_f(z3));
                *(v2u*)(OAB + row * D + h * 64 + c0) = ov;
            }
    }
}

template <int WIN>
__device__ __forceinline__ void pooled_block(const bf16* H, bf16* P, const int t0, const int tl0, const int col) {
    v4u r[WIN - 1 + 8];
#pragma unroll
    for (int j = 0; j < WIN - 1 + 8; ++j) { const int dt = j - (WIN - 1); r[j] = (v4u){0u, 0u, 0u, 0u}; if (tl0 + dt >= 0) r[j] = *(const v4u*)(H + (size_t)(t0 + dt) * D + col); }
    float s[8];
#pragma unroll
    for (int q = 0; q < 8; ++q) s[q] = 0.f;
#define POOL_ACC(sgn, VV) do { const v4u q_ = (VV); s[0] += sgn bflo(q_.x); s[1] += sgn bfhi(q_.x); s[2] += sgn bflo(q_.y); s[3] += sgn bfhi(q_.y); s[4] += sgn bflo(q_.z); s[5] += sgn bfhi(q_.z); s[6] += sgn bflo(q_.w); s[7] += sgn bfhi(q_.w); } while (0)
#pragma unroll
    for (int j = 0; j < WIN - 1; ++j) POOL_ACC(+, r[j]);
#pragma unroll
    for (int i = 0; i < 8; ++i) { const v4u self = r[WIN - 1 + i]; POOL_ACC(+, self);
        const int n = (tl0 + i + 1) < WIN ? (tl0 + i + 1) : WIN; const float inv = 1.0f / (float)n;
        v4u o; o.x = pk2(s[0] * inv - bflo(self.x), s[1] * inv - bfhi(self.x)); o.y = pk2(s[2] * inv - bflo(self.y), s[3] * inv - bfhi(self.y));
        o.z = pk2(s[4] * inv - bflo(self.z), s[5] * inv - bfhi(self.z)); o.w = pk2(s[6] * inv - bflo(self.w), s[7] * inv - bfhi(self.w));
        *(v4u*)(P + (size_t)(t0 + i) * D + col) = o;
        POOL_ACC(-, r[i]); }
#undef POOL_ACC
}
__device__ __forceinline__ void pooled_phase(Frame& F) {
    const bf16* H = (const bf16*)(F.ws + WS_H); bf16* P = (bf16*)(F.ws + WS_OAB);
    const int gt = F.vcu * 512 + F.tid, NT = F.G * 512;
    for (int it = gt; it < (NTOK / 8) * 128; it += NT) {
        const int c = it & 31, g = __builtin_amdgcn_readfirstlane((it >> 6) & 3), tb = ((it >> 8) << 1) | ((it >> 5) & 1);
        const int t0 = tb * 8, tl0 = t0 & (SEQ - 1), col = g * 256 + c * 8;
        if (g == 0) pooled_block<2>(H, P, t0, tl0, col); else if (g == 1) pooled_block<4>(H, P, t0, tl0, col); else if (g == 2) pooled_block<8>(H, P, t0, tl0, col); else pooled_block<16>(H, P, t0, tl0, col);
    }
}


#ifndef PH_MASK
#define PH_MASK 0xFFFFFF
#endif
#define IN(k) (((PH_MASK >> (k)) & 1) && lo <= (k) && (k) < hi)
#define BOTH(k) (IN(k) && IN((k) + 1))
#if MK_ONE_LAUNCH
#define GRID_BAR() xcd_barrier(bar)
#else
#define GRID_BAR() do { } while (0)
#endif
template <int LAYER>
__device__ __forceinline__ void moe_phases(Frame& F, const XcdBarrier& bar, const int lo, const int hi) {
    constexpr int pb = LAYER == 0 ? 7 : 13;
    bf16* const H = (bf16*)(F.ws + WS_H);
    const float* const MOD = (const float*)(F.ws + WS_MOD);
    if (IN(pb)) {
        moe_route(F, LAYER); if (BOTH(pb)) GRID_BAR(); }
    if (IN(pb + 1)) {
        build_moe_tables(F, LAYER);
        pg8::Gemm g{(const bf16*)H, 1024, 1024}; MoeSched S; S.init((const LAS int*)(F.lds + SCHED_OFF), F.G, (int)blockIdx.x, (const int*)(F.ws + WS_RT), F.ws + WS_WGU, 1024, 1024);
        EpiSwiglu E{(bf16*)(F.ws + WS_ACT)};
        if (LAYER == 1) { S.Blo = (const char*)(F.ws + WS_WGT); S.esplit = 16; }
        moe_tail_plan(F);
        pg8::gemm_phase<EpiSwiglu, MoeSched>(F.lds + RING_OFF, g, S, E);
        {
            const LAS int* T = (const LAS int*)(F.lds + SCHED_OFF); const int sp = T[67];
            const int q0 = LAYER == 0 ? 0 : CQ_NG, q1 = LAYER == 0 ? CQ_NGT : CQ_N;
            if (sp > 0) { __syncthreads(); const int f = q0 + T[65] * 8 * TQ_GU; int e = f + sp * 8 * TQ_GU; e = e < q1 ? e : q1; convert_range(F, 1, f, e, F.wave, 8); }
            if (LAYER == 1) { int t = q0 + T[66] * 8 * TQ_GU;
                if (t < q1) { __syncthreads(); convert_range(F, 1, t, q1, F.vcu * NWAVES + F.wave, F.G * NWAVES); } } }
        if (BOTH(pb + 1)) GRID_BAR();
    }
    if (IN(pb + 2)) {
        build_moe_tables(F, LAYER);
        pg8::Gemm g{(const bf16*)(F.ws + WS_ACT), 512, 512}; MoeSched S; S.init((const LAS int*)(F.lds + SCHED_OFF), F.G, (int)blockIdx.x, nullptr, F.ws + WS_WD, 512, 512);
        EpiStoreBf16 E{(bf16*)(F.ws + WS_Y), D};
        if (LAYER == 0) moe_tail_plan(F);
        pg8::gemm_phase<EpiStoreBf16, MoeSched>(F.lds + RING_OFF, g, S, E);
        if (LAYER == 0) {
            const LAS int* T = (const LAS int*)(F.lds + SCHED_OFF); const int sp = T[67];
            int t8 = T[66] * 8 * TQ_GU; t8 = t8 < CQ_NGT ? t8 : CQ_NGT;
            if (sp > 0) { __syncthreads(); const int f = t8 + T[65] * 8 * TQ_DN; int e = f + sp * 8 * TQ_DN; e = e < CQ_NG ? e : CQ_NG; convert_range(F, 1, f, e, F.wave, 8); } }
        if (BOTH(pb + 2)) GRID_BAR();
    }
    if (IN(pb + 3)) {
        build_moe_tables(F, LAYER);
        if (LAYER == 0) moe_tail_plan(F);
        const int tokw = F.vcu * 128 + F.wave * 16, b = (F.vcu * 128) / SEQ;
        f32x4 g2[4];
#pragma unroll
        for (int j = 0; j < 4; ++j) g2[j] = *((const f32x4*)(MOD + (size_t)(LAYER * 2 + b) * 6144 + 5 * 1024) + F.lane + 64 * j);
        if (LAYER == 0) {
            const ModVec m1 = load_mod(F.in[I_NMIX] + D, MOD + (size_t)(2 + b) * 6144 + 1024, MOD + (size_t)(2 + b) * 6144, F.lane);
            { const CombRecs recs = comb_load_recs(F, tokw); CombRows cur, nxt; comb_issue(F, recs, 0, tokw, cur);
              for (int i = 0; i < 16; ++i) { const int t = tokw + i;
                  if (i + 1 < 16) comb_issue(F, recs, i + 1, t + 1, nxt);
                  const RowVec x = comb_finish(recs, i, cur, g2);
                  store_row_bf16((bf16*)(F.ws + WS_XRB) + (size_t)t * D, F.lane, x); store_row_bf16(H + (size_t)t * D, F.lane, apply_mod(x, row_rstd(x), m1));
                  cur = nxt; } }
            __syncthreads();
            { const LAS int* T = (const LAS int*)(F.lds + SCHED_OFF);
              int t8 = T[66] * 8 * TQ_GU; t8 = t8 < CQ_NGT ? t8 : CQ_NGT; int t9 = t8 + T[66] * 8 * TQ_DN; t9 = t9 < CQ_NG ? t9 : CQ_NG;
              convert_range(F, 1, t9, CQ_NG, F.vcu * NWAVES + F.wave, F.G * NWAVES); }
        } else {
            f32x4 fw[4];
#pragma unroll
            for (int j = 0; j < 4; ++j) fw[j] = *((const f32x4*)F.in[I_FNW] + F.lane + 64 * j);
            { const CombRecs recs = comb_load_recs(F, tokw); CombRows cur, nxt; comb_issue(F, recs, 0, tokw, cur);
              for (int i = 0; i < 16; ++i) { const int t = tokw + i;
                  if (i + 1 < 16) comb_issue(F, recs, i + 1, t + 1, nxt);
                  RowVec x = comb_finish(recs, i, cur, g2); const float rstd = row_rstd(x);
#pragma unroll
                  for (int j = 0; j < 4; ++j) x.v[j] = x.v[j] * rstd * fw[j];
                  store_row_f32(F.out + (size_t)t * D, F.lane, x);
                  cur = nxt; } }
        }
        if (BOTH(pb + 3)) GRID_BAR();
    }
}

constexpr int PH_P0 = 0, PH_P1 = 1, PH_INPROJ = 2, PH_ATT = 3, PH_SCAN = 4, PH_DNOUT = 5, PH_OUTPROJ = 6, PH_MOE0 = 7, PH_POOLED = 11, PH_POOLG = 12, PH_MOE1 = 13;
constexpr int N_PHASES = 17;
struct Args { const float* in[24]; float* out; unsigned char* ws; int ph_lo, ph_hi; };
__global__ void __launch_bounds__(NWAVES * 64, 2) trunk_fwd(Args args) {
    __shared__ __attribute__((aligned(16))) unsigned char lds[LDS_BYTES];
    Frame F;
    F.lds = (LAS unsigned char*)lds;
    F.MISC = (volatile LAS unsigned*)(F.lds + MISC_OFF);
    F.tid = threadIdx.x; F.lane = F.tid & 63; F.wave = __builtin_amdgcn_readfirstlane(F.tid >> 6);
    F.G = gridDim.x; { const int bx = blockIdx.x; F.vcu = (F.G % 8 == 0) ? (bx % 8) * (F.G / 8) + bx / 8 : bx; }
#pragma unroll
    for (int i = 0; i < 24; ++i) F.in[i] = args.in[i];
    F.out = args.out; F.ws = args.ws; F.ctl = (gu32*)(args.ws + WS_CTL);
    for (int u = F.tid; u < (LDS_BYTES - LDSCTL_OFF) / 4; u += NWAVES * 64) ((LAS unsigned*)(F.lds + LDSCTL_OFF))[u] = 0u;
    __syncthreads();
#if MK_ONE_LAUNCH
    XcdBarrier bar = xcd_barrier_post((unsigned*)(F.ctl + CW_BAR), F.MISC + 8);
#else
    XcdBarrier bar; bar.bar = nullptr; bar.x = 0; bar.st = nullptr;
#endif
    const int lo = args.ph_lo, hi = args.ph_hi;
    bf16* const H = (bf16*)(F.ws + WS_H);
    const float* const MOD = (const float*)(F.ws + WS_MOD);

    if (IN(PH_P0)) { p0_prologue(F); if (BOTH(PH_P0)) GRID_BAR(); }
    if (IN(PH_P1)) { p1_prenorm0(F); if (BOTH(PH_P1)) GRID_BAR(); }
    if (IN(PH_INPROJ)) {
        pg8::Gemm g{(const bf16*)H, 1024, 1024}; DenseSched S; S.init(NTOK, IP_TILES * 256, F.G, (int)blockIdx.x, 1024, 0, F.ws + WS_WIN, 1024); S.gap_from = PC_ZA / 256; S.gap = 2;
        EpiStoreBf16 E{(bf16*)(F.ws + WS_PROJ), PIN};
        pg8::gemm_phase<EpiStoreBf16, DenseSched>(F.lds + RING_OFF, g, S, E);
        if (IP_FULL && (int)blockIdx.x >= IP_FULL) {
            __syncthreads(); const int r = (int)blockIdx.x - IP_FULL; convert_range(F, 0, r * 8 * TQ_INPROJ, (r + 1) * 8 * TQ_INPROJ, F.wave, 8); }
        if (BOTH(PH_INPROJ)) GRID_BAR();
    }
    if (IN(PH_ATT)) { dn_prep(F); if (BOTH(PH_ATT)) GRID_BAR(); }
    if (IN(PH_SCAN)) {
        if ((int)blockIdx.x < 32) dn_scan(F);
        else { const int o = (int)blockIdx.x - 32, NO = F.G - 32;
            attn_phase(F, o, NO); __syncthreads();
            { pg8::Gemm g{(const bf16*)H, 1024, 1024}; EpiStoreBf16 E{(bf16*)(F.ws + WS_PROJ), PIN};
              DenseSched S; S.init(NTOK, 512, NO, o, 1024, 0, F.ws + WS_WIN, 1024); S.gap_from = 0; S.gap = PC_ZA / 256; S.Lend = NO;
              pg8::gemm_phase<EpiStoreBf16, DenseSched>(F.lds + RING_OFF, g, S, E);
              if (o >= 64 && o < 64 + (S.nwg - NO)) { __syncthreads(); S.L0 = NO; S.G = S.nwg - NO; S.c = o - 64; S.Lend = S.nwg;
                  pg8::gemm_phase<EpiStoreBf16, DenseSched>(F.lds + RING_OFF, g, S, E); } }
            __syncthreads();
            { const int q = o < 64 ? 6 : o < 96 ? 4 : 9, off = o < 64 ? 48 * o : o < 96 ? 3072 + 32 * (o - 64) : 4096 + 72 * (o - 96);
              convert_range(F, 0, CQ_T2 + off, CQ_T2 + off + 8 * q, F.wave, 8);
              convert_range(F, 0, CQ_T2 + 4096 + 72 * 128, CQ_N, o * NWAVES + F.wave, NO * NWAVES); } }
        if (BOTH(PH_SCAN)) GRID_BAR(); }
    if (IN(PH_DNOUT)) { dn_output(F); if (BOTH(PH_DNOUT)) GRID_BAR(); }
    if (IN(PH_OUTPROJ)) {
        pg8::Gemm g{(const bf16*)(F.ws + WS_OAB), 1024, 1024}; DenseSched S; S.init(NTOK, D, F.G, (int)blockIdx.x, 1024, 0, F.ws + WS_WOUT, 1024);
        EpiResid<true> E{F.in[I_X], (bf16*)(F.ws + WS_XRB), MOD + 2 * 1024, nullptr};
        pg8::gemm_phase<EpiResid<true>, DenseSched>(F.lds + RING_OFF, g, S, E);
        if (BOTH(PH_OUTPROJ)) GRID_BAR();
    }
    moe_phases<0>(F, bar, lo, hi);
    if (IN(PH_POOLED)) { pooled_phase(F); if (BOTH(PH_POOLED)) GRID_BAR(); }
    if (IN(PH_POOLG)) {
        pg8::Gemm g{(const bf16*)(F.ws + WS_OAB), 256, 256}; DenseSched S; S.init(NTOK, D, F.G, (int)blockIdx.x, 1024, 256, F.ws + WS_POOLW, 256);
        EpiResid<false> E{nullptr, (bf16*)(F.ws + WS_XRB), MOD + (size_t)2 * 6144 + 2 * 1024, F.in[I_POOLS]};
        pg8::gemm_phase<EpiResid<false>, DenseSched>(F.lds + RING_OFF, g, S, E);
        if (BOTH(PH_POOLG)) GRID_BAR();
    }
    moe_phases<1>(F, bar, lo, hi);
#undef IN
#undef BOTH
}

extern "C" void kernel_launch(void* const* d_in, const int* in_sizes, int n_in, void* d_out, int out_size, void* d_ws, size_t ws_size, hipStream_t stream) {
    static int grid = 0;
    if (grid == 0) {
        if (n_in != 24 || in_sizes[0] != NTOK * D || out_size != NTOK * D || ws_size < WS_END2) { fprintf(stderr, "kernel_launch: unexpected shapes (n_in %d, in0 %d, out %d, ws %zu); nothing launched\n", n_in, n_in > 0 ? in_sizes[0] : -1, out_size, ws_size); grid = -1; return; }
        int per_cu = 0;
        if (hipOccupancyMaxActiveBlocksPerMultiprocessor(&per_cu, (const void*)trunk_fwd, NWAVES * 64, 0) != hipSuccess || per_cu < 1) fprintf(stderr, "kernel_launch: occupancy query says %d\n", per_cu);
        (void)hipGetLastError();
        grid = 256;
    }
    if (grid < 0) return;
    if (hipMemsetAsync((char*)d_ws + WS_CTL, 0, CTL_ZERO_BYTES, stream) != hipSuccess) { fprintf(stderr, "kernel_launch: memset failed\n"); return; }
    Args a{};
    for (int i = 0; i < 24; ++i) a.in[i] = (const float*)d_in[i];
    a.out = (float*)d_out; a.ws = (unsigned char*)d_ws;
#if MK_ONE_LAUNCH
    a.ph_lo = 0; a.ph_hi = N_PHASES;
    hipLaunchKernelGGL(trunk_fwd, dim3(grid), dim3(NWAVES * 64), 0, stream, a);
#else
    for (int p = 0; p < N_PHASES; ++p) { a.ph_lo = p; a.ph_hi = p + 1; hipLaunchKernelGGL(trunk_fwd, dim3(grid), dim3(NWAVES * 64), 0, stream, a); }
#endif
}
```

```cpp
#include <hip/hip_runtime.h>
#include <cstdio>
#include <cstdint>

#ifndef MK_ONE_LAUNCH
#define MK_ONE_LAUNCH 1
#endif

#define GAS __attribute__((address_space(1)))
#define LAS __attribute__((address_space(3)))
typedef unsigned short bf16;
typedef unsigned v4u __attribute__((ext_vector_type(4)));
typedef unsigned v2u __attribute__((ext_vector_type(2)));
typedef float f32x4 __attribute__((ext_vector_type(4)));
typedef float f32x2 __attribute__((ext_vector_type(2)));
typedef float f32x16 __attribute__((ext_vector_type(16)));
typedef short bf16x8 __attribute__((ext_vector_type(8)));
typedef GAS unsigned gu32;
#define RLX_AGENT __ATOMIC_RELAXED, __HIP_MEMORY_SCOPE_AGENT
#define LDS_WAIT() asm volatile("s_waitcnt lgkmcnt(0)" ::: "memory")
#define VM_WAIT() asm volatile("s_waitcnt vmcnt(0)" ::: "memory")

constexpr int BATCH = 2, SEQ = 16384, D = 1024, NTOK = BATCH * SEQ;
constexpr int PIN = 2816;
constexpr int PC_QA = 0, PC_KA = 512, PC_VA = 1024, PC_ZA = 1536, PC_QB = 2048, PC_KB = 2560, PC_VB = 2688;
constexpr int NEXP = 32, DFF = 512;
constexpr int MAXTILES = NTOK * 2 / 256 + NEXP;
constexpr float EPS = 1e-6f;
constexpr int NWAVES = 8;

constexpr size_t MiB = 1u << 20;
constexpr size_t WS_CTL = 0, CTL_ZERO_BYTES = 1 * MiB;
constexpr size_t WS_MOD = 1 * MiB;
constexpr size_t WS_WBA = 1 * MiB + 128 * 1024;
constexpr size_t WS_ROUTE = 2 * MiB;
constexpr size_t WS_RT = 3 * MiB;
constexpr size_t WS_BG = 7 * MiB;
constexpr size_t WS_WIN = 10 * MiB;
constexpr size_t WS_WOUT = 16 * MiB;
constexpr size_t WS_POOLW = 18 * MiB;
constexpr size_t WS_WGU = 20 * MiB;
constexpr size_t WS_WD = 84 * MiB;
constexpr size_t WS_H = 116 * MiB;
constexpr size_t WS_PROJ = 180 * MiB;
constexpr size_t WS_OAB = 356 * MiB;
constexpr size_t WS_YM = 180 * MiB;
constexpr size_t WS_ACT = 180 * MiB;
constexpr size_t WS_Y = 252 * MiB;
constexpr size_t WS_END = 420 * MiB;
constexpr size_t OUT_DN_MT = 0, OUT_DN_QPT = 32 * MiB;
constexpr size_t WS_DN_BM = 420 * MiB, WS_DN_O0T = 452 * MiB, WS_DN_S = 484 * MiB;
constexpr size_t WS_DN_GT = 9 * MiB;
constexpr size_t WS_XRB = 420 * MiB;
constexpr size_t WS_WGT = 484 * MiB;
constexpr size_t WS_END2 = 516 * MiB;
constexpr int CW_CNT = 64;
constexpr int CW_BAR = 4096;
constexpr int CW_BAD = 200;

constexpr int RING_OFF = 0, RING_BYTES = 131072;
constexpr int LDSCTL_OFF = RING_BYTES, MISC_OFF = LDSCTL_OFF + 320;
constexpr int SCHED_OFF = LDSCTL_OFF + 1024;
constexpr int LDS_BYTES = 163840;
constexpr int R1W_OFF = 135168;
constexpr int RT_LDS_OFF = 151552;

typedef __bf16 bf16x2_t __attribute__((ext_vector_type(2)));
__device__ __forceinline__ unsigned pk2(float lo, float hi) { bf16x2_t v; v.x = (__bf16)lo; v.y = (__bf16)hi; return __builtin_bit_cast(unsigned, v); }
__device__ __forceinline__ unsigned f2bf(float f) { return pk2(f, 0.f) & 0xffffu; }
__device__ __forceinline__ float bf2f(unsigned b) { return __builtin_bit_cast(float, b << 16); }
__device__ __forceinline__ float bflo(unsigned w) { return __builtin_bit_cast(float, w << 16); }
__device__ __forceinline__ float bfhi(unsigned w) { return __builtin_bit_cast(float, w & 0xffff0000u); }
template <int CTRL> __device__ __forceinline__ float dpp_f(float v) { return __builtin_bit_cast(float, __builtin_amdgcn_update_dpp(0, __builtin_bit_cast(int, v), CTRL, 0xf, 0xf, false)); }
__device__ __forceinline__ float quad_sum(float v) { v += dpp_f<0xB1>(v); v += dpp_f<0x4E>(v); return v; }
__device__ __forceinline__ float oct_sum(float v) { v = quad_sum(v); v += dpp_f<0x141>(v); return v; }
__device__ __forceinline__ float wave_sum(float v) {
    v = oct_sum(v); v += dpp_f<0x140>(v);
    const float r0 = __builtin_bit_cast(float, __builtin_amdgcn_readlane(__builtin_bit_cast(int, v), 0)), r1 = __builtin_bit_cast(float, __builtin_amdgcn_readlane(__builtin_bit_cast(int, v), 16));
    const float r2 = __builtin_bit_cast(float, __builtin_amdgcn_readlane(__builtin_bit_cast(int, v), 32)), r3 = __builtin_bit_cast(float, __builtin_amdgcn_readlane(__builtin_bit_cast(int, v), 48));
    return (r0 + r1) + (r2 + r3);
}
__device__ __forceinline__ float rl(float x, int l) { return __builtin_bit_cast(float, __builtin_amdgcn_readlane(__builtin_bit_cast(int, x), l)); }
template <int CTRL, int M> __device__ __forceinline__ void ms_halve(const float (&in)[2 * M], float (&out)[M], bool s) {
#pragma unroll
    for (int k = 0; k < M; ++k) { const float keep = s ? in[k + M] : in[k], send = s ? in[k] : in[k + M]; out[k] = keep + dpp_f<CTRL>(send); }
}
__device__ __forceinline__ float ms_rows(float v) {
    { unsigned a = __builtin_bit_cast(unsigned, v), b = a; asm volatile("s_nop 1\n\tv_permlane16_swap_b32 %0, %1" : "+v"(a), "+v"(b)); v = __builtin_bit_cast(float, a) + __builtin_bit_cast(float, b); }
    { unsigned a = __builtin_bit_cast(unsigned, v), b = a; asm volatile("s_nop 1\n\tv_permlane32_swap_b32 %0, %1" : "+v"(a), "+v"(b)); v = __builtin_bit_cast(float, a) + __builtin_bit_cast(float, b); }
    return v;
}
__device__ __forceinline__ float multi_sum16(const float (&v)[16], int lane) {
    float a[8], b[4], c[2], d[1];
    ms_halve<0x140, 8>(v, a, (lane & 8) != 0); ms_halve<0x141, 4>(a, b, (lane & 4) != 0); ms_halve<0x4E, 2>(b, c, (lane & 2) != 0); ms_halve<0xB1, 1>(c, d, (lane & 1) != 0);
    return ms_rows(d[0]);
}
__device__ __forceinline__ float multi_sum8(const float (&v)[8], int lane) {
    float a[4], b[2], c[1];
    ms_halve<0x140, 4>(v, a, (lane & 8) != 0); ms_halve<0x141, 2>(a, b, (lane & 4) != 0); ms_halve<0x4E, 1>(b, c, (lane & 2) != 0);
    float r = c[0]; r += dpp_f<0xB1>(r); return ms_rows(r);
}
__device__ __forceinline__ float multi_sum4(const float (&v)[4], int lane) {
    float a[2], b[1];
    ms_halve<0x140, 2>(v, a, (lane & 8) != 0); ms_halve<0x141, 1>(a, b, (lane & 4) != 0);
    float r = b[0]; r += dpp_f<0x4E>(r); r += dpp_f<0xB1>(r); return ms_rows(r);
}
__device__ __forceinline__ float silu_f(float x) { return x / (1.f + __expf(-x)); }
__device__ __forceinline__ float sigmoid_f(float x) { return 1.f / (1.f + __expf(-x)); }
__device__ __forceinline__ float softplus_f(float x) { return x > 20.f ? x : log1pf(__expf(x)); }

namespace pg8 {
#define PG8_LAS __attribute__((address_space(3)))
typedef unsigned short bf16_t;
typedef unsigned u32x4 __attribute__((ext_vector_type(4)));
constexpr int BM = 256, BK = 64, HALF = 128, HTB = HALF * BK * 2, STAGE_BYTES = 8 * HTB;

__host__ __device__ __forceinline__ int lds_byte(int r, int c) { const int st = (r >> 4) * 2 + (c >> 5), rr = r & 15, cc = c & 31, ob = rr * 64 + cc * 2; return st * 1024 + (ob ^ (((ob >> 9) & 1) << 5)); }
__host__ __device__ __forceinline__ void stage_rc(int b, int& R, int& C) { const int st = b / 1024, sb = b % 1024, swz = sb ^ (((sb >> 9) & 1) << 5); R = (st >> 1) * 16 + swz / 64; C = (st & 1) * 32 + (swz % 64) / 2; }
__host__ __device__ __forceinline__ int perm32(int rho) { const int n = rho >> 4, i = rho & 15; return 8 * (i >> 2) + 4 * n + (i & 3); }

struct Unit { int pm, pn, e; };
struct Gemm { const bf16_t* A; int K, ldb; };

template <class Epi, class Sched>
__device__ __forceinline__ void gemm_phase(PG8_LAS unsigned char* lds, const Gemm g, const Sched& S, const Epi& E) {
    const int tid = threadIdx.x, wid = __builtin_amdgcn_readfirstlane(tid >> 6), lane = tid & 63, wr = wid >> 2, wc = wid & 3, fr = lane & 15, fq = lane >> 4;
    const int K = g.K, nt = K / BK;
    int R0, C0, R1, C1; stage_rc(tid * 16, R0, C0); stage_rc(tid * 16 + 8192, R1, C1);
    const int Rb0 = (R0 & ~31) + perm32(R0 & 31), Rb1 = (R1 & ~31) + perm32(R1 & 31);
    const unsigned voffB0 = (unsigned)(Rb0 * g.ldb + C0) * 2u, voffB1 = (unsigned)(Rb1 * g.ldb + C1) * 2u;
    const size_t kstep = (size_t)(BK * 2);
    const size_t hstepB = (size_t)HALF * g.ldb * 2;
    const unsigned ldsw = (unsigned)wid * 1024u;
    const int aoff = lds_byte(wr * 64 + fr, fq * 8), boff = lds_byte(wc * 32 + fr, fq * 8);
    const char* Ab = (const char*)g.A;
#define PG8_SA(b, h) (((b) * 2 + (h)) * HTB)
#define PG8_SB(b, h) ((4 + (b) * 2 + (h)) * HTB)
#define PG8_ST2(bufoff, gbase, v0, v1) do { \
        __builtin_amdgcn_global_load_lds((const unsigned*)((const char*)(gbase) + (v0)), (PG8_LAS unsigned*)(lds + (bufoff) + ldsw), 16, 0, 0); \
        __builtin_amdgcn_global_load_lds((const unsigned*)((const char*)(gbase) + (v1)), (PG8_LAS unsigned*)(lds + (bufoff) + ldsw + 8192), 16, 0, 0); } while (0)
#define PG8_STB(bufoff, gbase) PG8_ST2(bufoff, gbase, voffB0, voffB1)
#define PG8_LDA(dst, b, h) do { _Pragma("unroll") for (int m = 0; m < 4; ++m) _Pragma("unroll") for (int k = 0; k < 2; ++k) dst[m][k] = *(const PG8_LAS bf16x8*)(lds + PG8_SA(b, h) + aoff + m * 2048 + k * 1024); } while (0)
#define PG8_LDB(dst, b, h) do { _Pragma("unroll") for (int n = 0; n < 2; ++n) _Pragma("unroll") for (int k = 0; k < 2; ++k) dst[n][k] = *(const PG8_LAS bf16x8*)(lds + PG8_SB(b, h) + boff + n * 2048 + k * 1024); } while (0)
#define PG8_MMA(ai, bj, At, Bt) do { __builtin_amdgcn_s_setprio(1); _Pragma("unroll") for (int m = 0; m < 4; ++m) _Pragma("unroll") for (int n = 0; n < 2; ++n) _Pragma("unroll") for (int k = 0; k < 2; ++k) \
        acc[ai][bj][m][n] = __builtin_amdgcn_mfma_f32_16x16x32_bf16(Bt[n][k], At[m][k], acc[ai][bj][m][n], 0, 0, 0); __builtin_amdgcn_s_setprio(0); } while (0)
#define PG8_WAIT_V(n) asm volatile("s_waitcnt vmcnt(" #n ")" ::: "memory")
#define PG8_WAIT_L(n) asm volatile("s_waitcnt lgkmcnt(" #n ")" ::: "memory")
#define PG8_BAR __builtin_amdgcn_s_barrier()
#define PG8_SCHED __builtin_amdgcn_sched_barrier(0)
    Unit cur, nxt; int ui = 0;
    if (!S.next(0, cur)) return;
    f32x4 acc[2][2][4][2];
#pragma unroll
    for (int a = 0; a < 2; ++a)
#pragma unroll
        for (int b = 0; b < 2; ++b)
#pragma unroll
            for (int m = 0; m < 4; ++m)
#pragma unroll
                for (int n = 0; n < 2; ++n) acc[a][b][m][n] = (f32x4){0.f, 0.f, 0.f, 0.f};
    bf16x8 At[4][2], B0[2][2], B1[2][2];
    unsigned c00, c01, c10, c11;
#define PG8_AOFF(u, d00, d01, d10, d11) do { \
        d00 = S.a_off(u, R0) + (unsigned)C0 * 2u; d01 = S.a_off(u, R1) + (unsigned)C1 * 2u; \
        d10 = S.a_off(u, HALF + R0) + (unsigned)C0 * 2u; d11 = S.a_off(u, HALF + R1) + (unsigned)C1 * 2u; } while (0)
    PG8_AOFF(cur, c00, c01, c10, c11);
    const char* cB = S.b_ptr(cur);
    PG8_STB(PG8_SB(0, 0), cB); PG8_STB(PG8_SB(0, 1), cB + hstepB); PG8_ST2(PG8_SA(0, 0), Ab, c00, c01); PG8_ST2(PG8_SA(0, 1), Ab, c10, c11);
    if (wr == 1) PG8_BAR;
    PG8_WAIT_V(2); PG8_BAR;
    PG8_STB(PG8_SB(1, 0), cB + kstep); PG8_ST2(PG8_SA(1, 0), Ab + kstep, c00, c01); PG8_STB(PG8_SB(1, 1), cB + hstepB + kstep);
    PG8_WAIT_V(6); PG8_BAR;
    for (;;) {
        const bool has_next = S.next(ui + 1, nxt);
        const char* nB = has_next ? S.b_ptr(nxt) : cB;
#pragma unroll 1
        for (int t = 0; t < nt; t += 2) {
            const bool last = (t == nt - 2);
            const char* a1 = Ab + (size_t)(t + 1) * kstep;
            const char* a2 = last ? Ab : Ab + (size_t)(t + 2) * kstep; const char* b2 = last ? nB : cB + (size_t)(t + 2) * kstep;
            const char* a3 = a2 + kstep; const char* b3 = b2 + kstep;
            PG8_LDB(B0, 0, 0); PG8_LDB(B1, 0, 1); PG8_SCHED; PG8_LDA(At, 0, 0); PG8_ST2(PG8_SA(1, 1), a1, c10, c11);
            PG8_WAIT_V(8); PG8_WAIT_L(0); PG8_BAR; PG8_MMA(0, 0, At, B0); PG8_MMA(0, 1, At, B1); PG8_BAR; PG8_SCHED;
            if (last && has_next) { PG8_AOFF(nxt, c00, c01, c10, c11); }
            PG8_LDA(At, 0, 1); PG8_STB(PG8_SB(0, 0), b2); PG8_STB(PG8_SB(0, 1), b2 + hstepB); PG8_ST2(PG8_SA(0, 0), a2, c00, c01);
            PG8_WAIT_V(8); PG8_WAIT_L(0); PG8_BAR; PG8_MMA(1, 0, At, B0); PG8_MMA(1, 1, At, B1); PG8_BAR; PG8_SCHED;
            PG8_LDB(B0, 1, 0); PG8_LDB(B1, 1, 1); PG8_SCHED; PG8_LDA(At, 1, 0); PG8_ST2(PG8_SA(0, 1), a2, c10, c11);
            PG8_WAIT_V(8); PG8_WAIT_L(0); PG8_BAR; PG8_MMA(0, 0, At, B0); PG8_MMA(0, 1, At, B1); PG8_BAR; PG8_SCHED;
            PG8_LDA(At, 1, 1); PG8_STB(PG8_SB(1, 0), b3); PG8_STB(PG8_SB(1, 1), b3 + hstepB); PG8_ST2(PG8_SA(1, 0), a3, c00, c01);
            PG8_WAIT_V(8); PG8_WAIT_L(0); PG8_BAR; PG8_MMA(1, 0, At, B0); PG8_MMA(1, 1, At, B1); PG8_BAR; PG8_SCHED;
        }
        if (wr == 0) PG8_BAR;
        E(acc, cur, wr, wc, fr, fq);
        if (!has_next) break;
#pragma unroll
        for (int a = 0; a < 2; ++a)
#pragma unroll
            for (int b = 0; b < 2; ++b)
#pragma unroll
                for (int m = 0; m < 4; ++m)
#pragma unroll
                    for (int n = 0; n < 2; ++n) acc[a][b][m][n] = (f32x4){0.f, 0.f, 0.f, 0.f};
        cur = nxt; cB = nB; ++ui;
        if (wr == 1) PG8_BAR;
    }
    PG8_WAIT_V(0);
    PG8_BAR;
#undef PG8_SA
#undef PG8_SB
#undef PG8_ST2
#undef PG8_STB
#undef PG8_LDA
#undef PG8_LDB
#undef PG8_MMA
#undef PG8_WAIT_V
#undef PG8_WAIT_L
#undef PG8_BAR
#undef PG8_SCHED
#undef PG8_AOFF
}
}

#define XB_TMO      128
#define XB_XCNT(j)  (256  + 64 * (j))
#define XB_XSUB(j)  (1280 + 64 * (j))
#define XB_XGEN(j)  (2304 + 64 * (j))
#define XB_TOP      3328
#define XB_TOPGEN   3392
#define XCD_BAR_WORDS 3456
#define XB_SPIN_CAP (1u << 22)

__device__ __forceinline__ unsigned xb_ld(unsigned* p)              { return __hip_atomic_load(p, __ATOMIC_RELAXED, __HIP_MEMORY_SCOPE_AGENT); }
__device__ __forceinline__ unsigned xb_add(unsigned* p, unsigned v) { return __hip_atomic_fetch_add(p, v, __ATOMIC_RELAXED, __HIP_MEMORY_SCOPE_AGENT); }
__device__ __forceinline__ unsigned xb_xcc_id() { return (unsigned)__builtin_amdgcn_s_getreg((3 << 11) | 20) & 0xFu; }
#define XB_SPIN(cond, bar) do { unsigned _sp = 0; while (cond) { __builtin_amdgcn_s_sleep(1); \
    if ((++_sp & 255u) == 0u) { if (xb_ld(&(bar)[XB_TMO])) break; if (_sp > XB_SPIN_CAP) { atomicAdd(&(bar)[XB_TMO], 1u); break; } } } } while (0)

struct XcdBarrier { unsigned* bar; unsigned x; volatile LAS unsigned* st; };

__device__ __forceinline__ XcdBarrier xcd_barrier_post(unsigned* bar, volatile LAS unsigned* st) {
    XcdBarrier b; b.bar = bar; b.x = xb_xcc_id(); b.st = st;
    if (threadIdx.x == 0) (void)xb_add(&bar[XB_XCNT(b.x)], 1u);
    return b;
}
__device__ __forceinline__ void xcd_barrier_complete(unsigned* bar, unsigned x, unsigned& nloc, unsigned& nx) {
    const unsigned G = gridDim.x * gridDim.y * gridDim.z;
    unsigned sum, cnt, mine, sp = 0u;
    for (;;) {
        sum = 0u; cnt = 0u; mine = 0u;
#pragma unroll
        for (unsigned j = 0; j < 16; ++j) { const unsigned c = xb_ld(&bar[XB_XCNT(j)]); sum += c; cnt += (c > 0u) ? 1u : 0u; mine = (j == x) ? c : mine; }
        if (sum == G) break;
        __builtin_amdgcn_s_sleep(1);
        if ((++sp & 255u) == 0u) { if (xb_ld(&bar[XB_TMO])) break; if (sp > XB_SPIN_CAP) { atomicAdd(&bar[XB_TMO], 1u); break; } }
    }
    nloc = mine > 0u ? mine : 1u; nx = cnt > 0u ? cnt : 1u;
}
__device__ __forceinline__ void xcd_barrier(const XcdBarrier& b) {
    asm volatile("s_waitcnt vmcnt(0)" ::: "memory");
    __syncthreads();
    if (threadIdx.x == 0) {
        unsigned* bar = b.bar;
        __builtin_amdgcn_s_waitcnt(0);
        unsigned nloc = b.st[0], nx = b.st[1];
        if (nloc == 0u) { xcd_barrier_complete(bar, b.x, nloc, nx); b.st[0] = nloc; b.st[1] = nx; }
        const unsigned old = xb_add(&bar[XB_XSUB(b.x)], 1u);
        const unsigned gen = old / nloc;
        if (old + 1u == (gen + 1u) * nloc) {
            __builtin_amdgcn_fence(__ATOMIC_RELEASE, "agent");
            asm volatile("s_waitcnt vmcnt(0)" ::: "memory");
            const unsigned og = xb_add(&bar[XB_TOP], 1u);
            const unsigned tg = og / nx;
            if (og + 1u == (tg + 1u) * nx) xb_add(&bar[XB_TOPGEN], 1u);
            else XB_SPIN(xb_ld(&bar[XB_TOPGEN]) == tg, bar);
            __builtin_amdgcn_fence(__ATOMIC_ACQUIRE, "agent");
            xb_add(&bar[XB_XGEN(b.x)], 1u);
            asm volatile("s_waitcnt vmcnt(0)" ::: "memory");
        } else {
            XB_SPIN(xb_ld(&bar[XB_XGEN(b.x)]) == gen, bar);
            __builtin_amdgcn_fence(__ATOMIC_ACQUIRE, "agent");
            asm volatile("s_waitcnt vmcnt(0)" ::: "memory");
        }
    }
    __syncthreads();
}

struct Frame {
    LAS unsigned char* lds;
    volatile LAS unsigned* MISC;
    gu32* ctl;
    int tid, lane, wave, vcu, G;
    const float* in[24];
    float* out;
    unsigned char* ws;
};
enum { I_X = 0, I_C, I_ADAW, I_ADAB, I_NMIX, I_NFFN, I_WIN, I_CONVW, I_ALOG, I_DTB, I_ONORM, I_SINKS, I_RELB, I_WOUT, I_POOLW, I_POOLS, I_R1W, I_R1B, I_R2W, I_R2B, I_WG, I_WU, I_WDN, I_FNW };

__device__ __forceinline__ void p0_transpose_item(const float* W, int ldw, int K, bf16* WT, int dst_row0, LAS float* scr, int k0, int n0, int lane) {
    f32x4 w4[8];
#pragma unroll
    for (int i = 0; i < 8; ++i) { const int f = i * 64 + lane, kk = f >> 3, c4 = f & 7; w4[i] = __builtin_nontemporal_load((const f32x4*)(W + (size_t)(k0 + kk) * ldw + n0 + c4 * 4)); }
#pragma unroll
    for (int i = 0; i < 8; ++i) { const int f = i * 64 + lane, kk = f >> 3, c4 = f & 7; LAS float* d = scr + kk * 33 + c4 * 4; d[0] = w4[i].x; d[1] = w4[i].y; d[2] = w4[i].z; d[3] = w4[i].w; }
    LDS_WAIT(); asm volatile("" ::: "memory");
    const int c = lane & 7;
#pragma unroll
    for (int j = 0; j < 4; ++j) { const int n = (lane >> 3) + 8 * j; const LAS float* s = scr + (8 * c) * 33 + n;
        v4u o; o.x = pk2(s[0 * 33], s[1 * 33]); o.y = pk2(s[2 * 33], s[3 * 33]); o.z = pk2(s[4 * 33], s[5 * 33]); o.w = pk2(s[6 * 33], s[7 * 33]);
        __builtin_nontemporal_store(o, (GAS v4u*)(WT + (size_t)(dst_row0 + n) * K + k0 + 8 * c)); }
    LDS_WAIT(); asm volatile("" ::: "memory");
}
constexpr int CQ_NG = NEXP * 512, CQ_NGT = 16 * 512, CQ_N = NEXP * 768;
constexpr int TQ_INPROJ = 11, TQ_GU = 6, TQ_DN = 4;
constexpr int IP_TILES = PIN / 256 - 2;
constexpr int IP_FULL = ((NTOK / 256) * IP_TILES) % 256;
constexpr int CQ_T2 = IP_FULL ? (256 - IP_FULL) * 8 * TQ_INPROJ : 0;
__device__ __forceinline__ void convert_item(Frame& F, int layer, int it, LAS float* scr) {
    if (it < CQ_NG) {
        const int e = it >> 9, r = it & 511, up = r >> 8, q = r & 255, kb = q >> 4, nb = q & 15;
        const float* W = (up ? F.in[I_WU] : F.in[I_WG]) + (size_t)(layer * NEXP + e) * 1024 * 512;
        p0_transpose_item(W, 512, 1024, (bf16*)(F.ws + ((layer && e < 16) ? WS_WGT : WS_WGU)), e * 1024 + (nb >> 2) * 256 + up * 128 + (nb & 3) * 32, scr, kb * 64, nb * 32, F.lane);
    } else {
        const int r0 = it - CQ_NG, e = r0 >> 8, q = r0 & 255, kb = q >> 5, nb = q & 31;
        const float* W = F.in[I_WDN] + (size_t)(layer * NEXP + e) * 512 * 1024;
        p0_transpose_item(W, 1024, 512, (bf16*)(F.ws + WS_WD), e * 1024 + nb * 32, scr, kb * 64, nb * 32, F.lane);
    }
}
__device__ __forceinline__ void convert_range(Frame& F, int layer, int first, int end, int start, int stride) {
    LAS float* scr = (LAS float*)(F.lds + RING_OFF + F.wave * 16384);
    for (int it = first + start; it < end; it += stride) convert_item(F, layer, it, scr);
}
__device__ __forceinline__ void p0_prologue(Frame& F) {
    LAS float* scr = (LAS float*)(F.lds + RING_OFF + F.wave * 16384);
    const int gw = F.vcu * NWAVES + F.wave, NGW = F.G * NWAVES;
    constexpr int IA = 16 * 64, IB = 16 * 24, IO = 16 * 32, IP = 4 * 32, NIT = IA + IB + IO + IP;
    for (int it = gw; it < NIT; it += NGW) {
        int r = it;
        if (r < IA) { p0_transpose_item(F.in[I_WIN], 2832, 1024, (bf16*)(F.ws + WS_WIN), (r % 64) * 32, scr, (r / 64) * 64, (r % 64) * 32, F.lane); continue; } r -= IA;
        if (r < IB) { p0_transpose_item(F.in[I_WIN] + 2064, 2832, 1024, (bf16*)(F.ws + WS_WIN), 2048 + (r % 24) * 32, scr, (r / 24) * 64, (r % 24) * 32, F.lane); continue; } r -= IB;
        if (r < IO) { p0_transpose_item(F.in[I_WOUT], 1024, 1024, (bf16*)(F.ws + WS_WOUT), (r % 32) * 32, scr, (r / 32) * 64, (r % 32) * 32, F.lane); continue; } r -= IO;
        { const int g = r >> 5, q = r & 31; p0_transpose_item(F.in[I_POOLW] + (size_t)g * 65536, 256, 256, (bf16*)(F.ws + WS_POOLW) + (size_t)g * 65536, (q & 7) * 32, scr, (q >> 3) * 64, (q & 7) * 32, F.lane); }
    }
    { float* WBA = (float*)(F.ws + WS_WBA); const int gt = F.vcu * 512 + F.tid;
      if (gt < 16 * 1024) { const int o = gt >> 10, k = gt & 1023; WBA[o * 1024 + k] = F.in[I_WIN][(size_t)k * 2832 + 2048 + o]; } }
    __syncthreads();
    {
        LAS float* red = (LAS float*)(F.lds + RING_OFF);
        const int ks = F.tid >> 4, cj = F.tid & 15;
        for (int u = F.vcu; u < 192; u += F.G) {
            const int l = u / 96, cb = u % 96;
            const float* W = F.in[I_ADAW] + (size_t)l * 1024 * 6144 + cb * 64 + cj * 4;
            f32x4 a0 = {0.f, 0.f, 0.f, 0.f}, a1 = {0.f, 0.f, 0.f, 0.f};
            for (int k = ks * 32; k < ks * 32 + 32; ++k) {
                const f32x4 w = *(const f32x4*)(W + (size_t)k * 6144);
                const float c0 = silu_f(F.in[I_C][k]), c1 = silu_f(F.in[I_C][1024 + k]);
                a0 += w * c0; a1 += w * c1;
            }
            *(LAS f32x4*)(red + (ks * 2 + 0) * 64 + cj * 4) = a0; *(LAS f32x4*)(red + (ks * 2 + 1) * 64 + cj * 4) = a1;
            __syncthreads();
            if (F.tid < 128) { const int b = F.tid >> 6, c = F.tid & 63; float s = 0.f;
                for (int q = 0; q < 32; ++q) s += red[(q * 2 + b) * 64 + c];
                ((float*)(F.ws + WS_MOD))[(size_t)(l * 2 + b) * 6144 + cb * 64 + c] = s + F.in[I_ADAB][l * 6144 + cb * 64 + c]; }
            __syncthreads();
        }
    }
}

struct RowVec { f32x4 v[4]; };
__device__ __forceinline__ RowVec load_row_f32(const float* row, int lane) { RowVec r; const GAS f32x4* p = (const GAS f32x4*)row + lane;
#pragma unroll
    for (int j = 0; j < 4; ++j) r.v[j] = p[64 * j]; return r; }
__device__ __forceinline__ void store_row_f32(float* row, int lane, const RowVec& r) { GAS f32x4* p = (GAS f32x4*)row + lane;
#pragma unroll
    for (int j = 0; j < 4; ++j) p[64 * j] = r.v[j]; }
__device__ __forceinline__ void store_row_bf16(bf16* row, int lane, const RowVec& r) { GAS v2u* p = (GAS v2u*)row + lane;
#pragma unroll
    for (int j = 0; j < 4; ++j) { v2u o; o.x = pk2(r.v[j].x, r.v[j].y); o.y = pk2(r.v[j].z, r.v[j].w); p[64 * j] = o; } }
__device__ __forceinline__ void load_row_bf16(const bf16* row, int lane, v2u (&p)[4]) { const GAS v2u* q = (const GAS v2u*)row + lane;
#pragma unroll
    for (int j = 0; j < 4; ++j) p[j] = q[64 * j]; }
__device__ __forceinline__ RowVec unpack_row_bf16(const v2u (&p)[4]) { RowVec r;
#pragma unroll
    for (int j = 0; j < 4; ++j) { r.v[j].x = bflo(p[j].x); r.v[j].y = bfhi(p[j].x); r.v[j].z = bflo(p[j].y); r.v[j].w = bfhi(p[j].y); } return r; }
__device__ __forceinline__ float row_rstd(const RowVec& r) { float s = 0.f;
#pragma unroll
    for (int j = 0; j < 4; ++j) s += (r.v[j].x * r.v[j].x + r.v[j].y * r.v[j].y) + (r.v[j].z * r.v[j].z + r.v[j].w * r.v[j].w);
    return 1.0f / sqrtf(wave_sum(s) * (1.f / D) + EPS); }
struct ModVec { f32x4 a[4], b[4]; };
__device__ __forceinline__ ModVec load_mod(const float* w, const float* sc, const float* sh, int lane) { ModVec m;
#pragma unroll
    for (int j = 0; j < 4; ++j) { const f32x4 wv = *((const f32x4*)w + lane + 64 * j), s = *((const f32x4*)sc + lane + 64 * j); m.a[j] = wv * (s + 1.0f); m.b[j] = *((const f32x4*)sh + lane + 64 * j); }
    return m; }
__device__ __forceinline__ RowVec apply_mod(const RowVec& x, float rstd, const ModVec& m) { RowVec h;
#pragma unroll
    for (int j = 0; j < 4; ++j) h.v[j] = x.v[j] * rstd * m.a[j] + m.b[j]; return h; }

__device__ __forceinline__ void p1_prenorm0(Frame& F) {
    LAS float* wba = (LAS float*)(F.lds + RING_OFF);
    { const float* WBA = (const float*)(F.ws + WS_WBA); for (int i = F.tid; i < 16 * 256; i += 512) *((LAS f32x4*)wba + i) = *((const f32x4*)WBA + i); }
    __syncthreads();
    const float* mod = (const float*)(F.ws + WS_MOD);
    bf16* H = (bf16*)(F.ws + WS_H); float* BG = (float*)(F.ws + WS_BG);
    const int tok0 = F.vcu * (NTOK / F.G) + F.wave * (NTOK / F.G / NWAVES), ntw = NTOK / F.G / NWAVES;
    const int b = tok0 / SEQ;
    const ModVec m = load_mod(F.in[I_NMIX], mod + (size_t)b * 6144 + 1024, mod + (size_t)b * 6144, F.lane);
    const int hh = F.lane & 7;
    const float nega = -__expf(F.in[I_ALOG][hh]), dtb = F.in[I_DTB][hh];
    RowVec xa = load_row_f32(F.in[I_X] + (size_t)tok0 * D, F.lane), xb = load_row_f32(F.in[I_X] + (size_t)(tok0 + 1) * D, F.lane);
    const LAS f32x4* wl = (const LAS f32x4*)wba + F.lane;
    for (int i = 0; i < ntw; i += 2) {
        const int t = tok0 + i;
        const RowVec x0 = xa, x1 = xb;
        if (i + 2 < ntw) { xa = load_row_f32(F.in[I_X] + (size_t)(t + 2) * D, F.lane); xb = load_row_f32(F.in[I_X] + (size_t)(t + 3) * D, F.lane); }
        const RowVec h0 = apply_mod(x0, row_rstd(x0), m), h1 = apply_mod(x1, row_rstd(x1), m);
        store_row_bf16(H + (size_t)t * D, F.lane, h0); store_row_bf16(H + (size_t)(t + 1) * D, F.lane, h1);
        float p0[16], p1[16]; f32x4 w[2][4];
#pragma unroll
        for (int j = 0; j < 4; ++j) w[0][j] = wl[64 * j];
#pragma unroll
        for (int o = 0; o < 16; ++o) {
            if (o + 1 < 16) {
#pragma unroll
                for (int j = 0; j < 4; ++j) w[(o + 1) & 1][j] = wl[(o + 1) * 256 + 64 * j]; }
            __builtin_amdgcn_sched_barrier(0);
            float s0 = 0.f, s1 = 0.f;
#pragma unroll
            for (int j = 0; j < 4; ++j) { const f32x4 ww = w[o & 1][j];
                s0 += (h0.v[j].x * ww.x + h0.v[j].y * ww.y) + (h0.v[j].z * ww.z + h0.v[j].w * ww.w); s1 += (h1.v[j].x * ww.x + h1.v[j].y * ww.y) + (h1.v[j].z * ww.z + h1.v[j].w * ww.w); }
            p0[o] = s0; p1[o] = s1;
            __builtin_amdgcn_sched_barrier(0); }
        const float mine0 = multi_sum16(p0, F.lane), mine1 = multi_sum16(p1, F.lane);
        if (F.lane < 8) { BG[(size_t)t * 16 + F.lane] = sigmoid_f(mine0); BG[(size_t)(t + 1) * 16 + F.lane] = sigmoid_f(mine1); }
        else if (F.lane < 16) { BG[(size_t)t * 16 + F.lane] = nega * softplus_f(mine0 + dtb); BG[(size_t)(t + 1) * 16 + F.lane] = nega * softplus_f(mine1 + dtb); }
    }
}

struct DenseSched {
    int nM, nN, nwg, G, c, gap_from, gap, L0, Lend; unsigned lda2, acol2; const char* B; size_t btile;
    __device__ __forceinline__ void init(int M, int N, int G_, int c_, int lda, int acolstride, const void* B_, int ldb) { nM = M / 256; nN = N / 256; nwg = nM * nN; G = G_; c = c_; gap_from = 1 << 30; gap = 0; L0 = 0; Lend = nwg; lda2 = (unsigned)lda * 2u; acol2 = (unsigned)acolstride * 2u; B = (const char*)B_; btile = (size_t)256 * ldb * 2; }
    __device__ __forceinline__ bool next(int i, pg8::Unit& u) const {
        const long L = (long)L0 + (long)i * G + c; if (L >= Lend) return false;
        int wgid = (int)L; { const int q = nwg / 8, r = nwg % 8, xcd = wgid % 8, off = wgid / 8; wgid = (xcd < r ? xcd * (q + 1) : r * (q + 1) + (xcd - r) * q) + off; }
        const int nig = 8 * nN, gid = wgid / nig, fm = gid * 8, gsz = (nM - fm) < 8 ? (nM - fm) : 8;
        u.pm = fm + ((wgid % nig) % gsz); u.pn = (wgid % nig) / gsz; u.pn += (u.pn >= gap_from) ? gap : 0; u.e = 0; return true;
    }
    __device__ __forceinline__ unsigned a_off(const pg8::Unit& u, int r) const { return (unsigned)(u.pm * 256 + r) * lda2 + (unsigned)u.pn * acol2; }
    __device__ __forceinline__ const char* b_ptr(const pg8::Unit& u) const { return B + (size_t)u.pn * btile; }
};
struct MoeSched {
    const LAS int* cnt; const LAS int* tbase; const LAS int* tileExp;
    int nunits, chunk, G, c, esplit; const int* RT; const char* B; const char* Blo; size_t bexp, btile; unsigned arow2;
    __device__ __forceinline__ void init(const LAS int* tables, int G_, int c_, const int* RT_, const void* B_, int ldb, int lda) {
        cnt = tables; tbase = tables + 32; tileExp = tables + 80; G = G_; c = c_; RT = RT_; B = (const char*)B_; Blo = B; esplit = 0; bexp = (size_t)1024 * ldb * 2; btile = (size_t)256 * ldb * 2; arow2 = (unsigned)lda * 2u;
        nunits = tbase[32] * 4; chunk = ((nunits + 7) / 8 + 3) & ~3;
    }
    __device__ __forceinline__ bool next(int i, pg8::Unit& u) const {
        const int w = i * (G / 8) + (c >> 3); if (w >= chunk) return false;
        const int L = (c & 7) * chunk + w; if (L >= nunits) return false;
        u.pm = L >> 2; u.pn = L & 3; u.e = tileExp[u.pm]; return true;
    }
    __device__ __forceinline__ unsigned a_off(const pg8::Unit& u, int r) const {
        if (RT) { const int pos = (u.pm - tbase[u.e]) * 256 + r; const int tok = pos < cnt[u.e] ? RT[u.e * NTOK + pos] : 0; return (unsigned)tok * arow2; }
        return (unsigned)(u.pm * 256 + r) * arow2;
    }
    __device__ __forceinline__ const char* b_ptr(const pg8::Unit& u) const { return (u.e < esplit ? Blo : B) + (size_t)u.e * bexp + (size_t)u.pn * btile; }
};
__device__ __forceinline__ void build_moe_tables(Frame& F, int layer) {
    LAS int* T = (LAS int*)(F.lds + SCHED_OFF);
    int tid_ = F.tid; asm volatile("" : "+v"(tid_));
    if (tid_ < 32) T[tid_] = (int)__hip_atomic_load(F.ctl + CW_CNT + 64 * layer + tid_, RLX_AGENT);
    __syncthreads();
    if (F.tid == 0) { int acc = 0; for (int e = 0; e < 32; ++e) { T[32 + e] = acc; const int nt = (T[e] + 255) >> 8; for (int j = 0; j < nt; ++j) T[80 + acc + j] = e; acc += nt; } T[64] = acc; }
    __syncthreads();
}

__device__ __forceinline__ int moe_units_of(int c, int G, int nunits, int chunk) {
    const int sl = c >> 3, x = c & 7, per = G / 8; int U = nunits - x * chunk; U = U < 0 ? 0 : (U > chunk ? chunk : U);
    return sl < U ? (U - sl + per - 1) / per : 0;
}
__device__ __forceinline__ void moe_tail_plan(Frame& F) {
    LAS int* T = (LAS int*)(F.lds + SCHED_OFF);
    if (F.tid == 0) { T[65] = 0; T[66] = 0; }
    __syncthreads();
    if (F.tid < 256) {
        const int nunits = T[64] * 4, chunk = ((nunits + 7) / 8 + 3) & ~3, per = F.G / 8, maxu = (chunk + per - 1) / per, c = (int)blockIdx.x;
        const int sp = F.tid < F.G ? maxu - moe_units_of(F.tid, F.G, nunits, chunk) : 0;
        const int lower = (int)wave_sum(F.tid < c ? (float)sp : 0.f), all = (int)wave_sum((float)sp);
        if (F.lane == 0) { atomicAdd((int*)(T + 65), lower); atomicAdd((int*)(T + 66), all); }
        if (F.tid == c) T[67] = sp;
    }
    __syncthreads();
}

struct EpiStoreBf16 {
    bf16* O; int ldc;
    __device__ __forceinline__ void operator()(const f32x4 (&acc)[2][2][4][2], const pg8::Unit& u, int wr, int wc, int fr, int fq) const {
        const int row0 = u.pm * 256 + wr * 64 + fr, col0 = u.pn * 256 + wc * 32 + 8 * fq;
#pragma unroll
        for (int ai = 0; ai < 2; ++ai)
#pragma unroll
            for (int m = 0; m < 4; ++m) { bf16* rowp = O + (size_t)(row0 + ai * 128 + m * 16) * ldc + col0;
#pragma unroll
                for (int bj = 0; bj < 2; ++bj) { const f32x4 v0 = acc[ai][bj][m][0], v1 = acc[ai][bj][m][1];
                    v4u w; w.x = pk2(v0[0], v0[1]); w.y = pk2(v0[2], v0[3]); w.z = pk2(v1[0], v1[1]); w.w = pk2(v1[2], v1[3]);
                    *(v4u*)(rowp + bj * 128) = w; } }
    }
};
template <bool F32SRC> struct EpiResid {
    const float* X; bf16* O; const float* cf; const float* mul;
    __device__ __forceinline__ void operator()(const f32x4 (&acc)[2][2][4][2], const pg8::Unit& u, int wr, int wc, int fr, int fq) const {
        const int row0 = u.pm * 256 + wr * 64 + fr, col0 = u.pn * 256 + wc * 32 + 8 * fq, b = (u.pm * 256) / SEQ;
        f32x4 c[2][2];
#pragma unroll
        for (int bj = 0; bj < 2; ++bj)
#pragma unroll
            for (int n = 0; n < 2; ++n) { c[bj][n] = *(const f32x4*)(cf + (size_t)b * 6144 + col0 + bj * 128 + 4 * n); if (mul) c[bj][n] *= *(const f32x4*)(mul + col0 + bj * 128 + 4 * n); }
#pragma unroll
        for (int ai = 0; ai < 2; ++ai)
#pragma unroll
            for (int m = 0; m < 4; ++m) { const size_t ro = (size_t)(row0 + ai * 128 + m * 16) * D + col0;
                f32x4 s[2][2];
                if (F32SRC) {
#pragma unroll
                    for (int bj = 0; bj < 2; ++bj) { s[bj][0] = *(const GAS f32x4*)(X + ro + bj * 128); s[bj][1] = *(const GAS f32x4*)(X + ro + bj * 128 + 4); }
                } else {
#pragma unroll
                    for (int bj = 0; bj < 2; ++bj) { const v4u q = *(const GAS v4u*)(O + ro + bj * 128);
                        s[bj][0].x = bflo(q.x); s[bj][0].y = bfhi(q.x); s[bj][0].z = bflo(q.y); s[bj][0].w = bfhi(q.y); s[bj][1].x = bflo(q.z); s[bj][1].y = bfhi(q.z); s[bj][1].z = bflo(q.w); s[bj][1].w = bfhi(q.w); }
                }
#pragma unroll
                for (int bj = 0; bj < 2; ++bj) { const f32x4 v0 = s[bj][0] + c[bj][0] * acc[ai][bj][m][0], v1 = s[bj][1] + c[bj][1] * acc[ai][bj][m][1];
                    v4u w; w.x = pk2(v0[0], v0[1]); w.y = pk2(v0[2], v0[3]); w.z = pk2(v1[0], v1[1]); w.w = pk2(v1[2], v1[3]);
                    *(v4u*)(O + ro + bj * 128) = w; } }
    }
};
struct EpiSwiglu {
    bf16* O;
    __device__ __forceinline__ void operator()(const f32x4 (&acc)[2][2][4][2], const pg8::Unit& u, int wr, int wc, int fr, int fq) const {
        const int row0 = u.pm * 256 + wr * 64 + fr, col0 = u.pn * 128 + wc * 32 + 8 * fq;
#pragma unroll
        for (int ai = 0; ai < 2; ++ai)
#pragma unroll
            for (int m = 0; m < 4; ++m) { bf16* rowp = O + (size_t)(row0 + ai * 128 + m * 16) * DFF + col0;
                float r[8];
#pragma unroll
                for (int n = 0; n < 2; ++n)
#pragma unroll
                    for (int j = 0; j < 4; ++j) r[4 * n + j] = silu_f(acc[ai][0][m][n][j]) * acc[ai][1][m][n][j];
                v4u w; w.x = pk2(r[0], r[1]); w.y = pk2(r[2], r[3]); w.z = pk2(r[4], r[5]); w.w = pk2(r[6], r[7]);
                *(v4u*)rowp = w; }
    }
};

__device__ __forceinline__ void moe_route(Frame& F, int layer) {
    LAS int* hist = (LAS int*)(F.lds + RT_LDS_OFF);
    LAS int* base = hist + 32;
    LAS int* tinfo = hist + 64;
    LAS float* tg = (LAS float*)(hist + 64 + 512);
    if (F.tid < 32) hist[F.tid] = 0;
    LAS f32x4* R2 = (LAS f32x4*)(F.lds + RING_OFF);
    LAS f32x4* R1 = (LAS f32x4*)(F.lds + R1W_OFF);
    { const f32x4* g2p = (const f32x4*)(F.in[I_R2W] + (size_t)layer * 1024 * 32); const f32x4* g1p = (const f32x4*)(F.in[I_R1W] + (size_t)layer * 1024 * 4);
      for (int i = F.tid; i < 8192; i += 512) { const int k = i >> 3, c4 = i & 7, ln = (k & 255) >> 2, q = k & 3, j = k >> 8; R2[((j * 4 + q) * 8 + c4) * 64 + ln] = g2p[i]; }
      for (int k = F.tid; k < 1024; k += 512) { const int ln = (k & 255) >> 2, q = k & 3, j = k >> 8; R1[(j * 4 + q) * 64 + ln] = g1p[k]; } }
    __syncthreads();
    const float* mod = (const float*)(F.ws + WS_MOD) + (size_t)layer * 2 * 6144;
    bf16* H = (bf16*)(F.ws + WS_H);
    const int tokw = F.vcu * 128 + F.wave * 16, b = (F.vcu * 128) / SEQ;
    const ModVec m = load_mod(F.in[I_NFFN] + layer * D, mod + (size_t)b * 6144 + 4 * 1024, mod + (size_t)b * 6144 + 3 * 1024, F.lane);
    const float* r1b = F.in[I_R1B] + layer * 4; const float* r2b = F.in[I_R2B] + layer * 32;
    const bf16* XRB = (const bf16*)(F.ws + WS_XRB);
    v2u xbn[4], xb2[4];
    load_row_bf16(XRB + (size_t)tokw * D, F.lane, xbn); load_row_bf16(XRB + (size_t)(tokw + 1) * D, F.lane, xb2);
    for (int i = 0; i < 16; ++i) {
        const int t = tokw + i;
        const RowVec x = unpack_row_bf16(xbn);
#pragma unroll
        for (int j = 0; j < 4; ++j) xbn[j] = xb2[j];
        if (i + 2 < 16) load_row_bf16(XRB + (size_t)(t + 2) * D, F.lane, xb2);
        RowVec h = apply_mod(x, row_rstd(x), m);
        store_row_bf16(H + (size_t)t * D, F.lane, h);
        f32x4 l1 = {0.f, 0.f, 0.f, 0.f};
#pragma unroll
        for (int j = 0; j < 4; ++j)
#pragma unroll
            for (int q = 0; q < 4; ++q) l1 += R1[(j * 4 + q) * 64 + F.lane] * h.v[j][q];
        float lg[4];
        { const float p4[4] = {l1[0], l1[1], l1[2], l1[3]}; const float r = multi_sum4(p4, F.lane);
#pragma unroll
          for (int g = 0; g < 4; ++g) lg[g] = rl(r, 4 * g) + r1b[g]; }
        int grp = 0; float mx = lg[0];
#pragma unroll
        for (int g = 1; g < 4; ++g) if (lg[g] > mx) { mx = lg[g]; grp = g; }
        float se = 0.f;
#pragma unroll
        for (int g = 0; g < 4; ++g) se += __expf(lg[g] - mx);
        const float ptop = 1.0f / se;
        grp = __builtin_amdgcn_readfirstlane(grp);
        f32x4 a0 = {0.f, 0.f, 0.f, 0.f}, a1 = {0.f, 0.f, 0.f, 0.f};
#pragma unroll
        for (int j = 0; j < 4; ++j)
#pragma unroll
            for (int q = 0; q < 4; ++q) { const LAS f32x4* wp = R2 + ((j * 4 + q) * 8 + grp * 2) * 64 + F.lane;
                a0 += wp[0] * h.v[j][q]; a1 += wp[64] * h.v[j][q]; }
        float l2[8];
        { const float p8[8] = {a0[0], a0[1], a0[2], a0[3], a1[0], a1[1], a1[2], a1[3]}; const float r = multi_sum8(p8, F.lane);
#pragma unroll
          for (int q = 0; q < 8; ++q) l2[q] = rl(r, 2 * q) + r2b[grp * 8 + q]; }
        int i0 = 0; float v0 = l2[0];
#pragma unroll
        for (int q = 1; q < 8; ++q) if (l2[q] > v0) { v0 = l2[q]; i0 = q; }
        int i1 = (i0 == 0) ? 1 : 0; float v1 = l2[i1 == 1 ? 1 : 0];
#pragma unroll
        for (int q = 0; q < 8; ++q) if (q != i0 && l2[q] > v1) { v1 = l2[q]; i1 = q; }
        const float g0 = ptop / (1.0f + __expf(v1 - v0)), g1 = ptop - g0;
        if (F.lane == 0) { const int e0 = grp * 8 + i0, e1 = grp * 8 + i1, li = F.wave * 16 + i;
            tinfo[li * 4 + 0] = e0; tinfo[li * 4 + 1] = e1; tinfo[li * 4 + 2] = atomicAdd((int*)(hist + e0), 1); tinfo[li * 4 + 3] = atomicAdd((int*)(hist + e1), 1);
            tg[li * 2] = g0; tg[li * 2 + 1] = g1;
            { float* GA = (float*)(F.ws + WS_BG); GA[(size_t)t * 2] = g0; GA[(size_t)t * 2 + 1] = g1; }
        }
    }
    __syncthreads();
    if (F.tid < 32) base[F.tid] = (int)__hip_atomic_fetch_add(F.ctl + CW_CNT + 64 * layer + F.tid, (unsigned)hist[F.tid], RLX_AGENT);
    __syncthreads();
    if (F.tid < 128) { const int t = F.vcu * 128 + F.tid; const int e0 = tinfo[F.tid * 4], e1 = tinfo[F.tid * 4 + 1];
        const int p0 = base[e0] + tinfo[F.tid * 4 + 2], p1 = base[e1] + tinfo[F.tid * 4 + 3];
        int* RT = (int*)(F.ws + WS_RT); RT[e0 * NTOK + p0] = t; RT[e1 * NTOK + p1] = t;
        v4u r0; r0.x = e0; r0.y = e1; r0.z = p0; r0.w = p1; v4u r1; r1.x = __builtin_bit_cast(unsigned, tg[F.tid * 2]); r1.y = __builtin_bit_cast(unsigned, tg[F.tid * 2 + 1]); r1.z = 0; r1.w = 0;
        v4u* RO = (v4u*)(F.ws + WS_ROUTE) + (size_t)t * 2; RO[0] = r0; (void)r1; }
    __syncthreads();
}

struct CombRows { v2u xb[4], ya[4], yb[4]; };
struct CombRecs { v4u rec; float ga, gb; };
__device__ __forceinline__ CombRecs comb_load_recs(Frame& F, int tokw) { CombRecs c; const int t = tokw + (F.lane & 15);
    c.rec = *((const v4u*)(F.ws + WS_ROUTE) + (size_t)t * 2); const float* GA = (const float*)(F.ws + WS_BG); c.ga = GA[(size_t)t * 2]; c.gb = GA[(size_t)t * 2 + 1]; return c; }
__device__ __forceinline__ int rl_i(int v, int l) { return __builtin_amdgcn_readlane(v, l); }
__device__ __forceinline__ void comb_issue(Frame& F, const CombRecs& c, int i, int t, CombRows& r) {
    const LAS int* T = (const LAS int*)(F.lds + SCHED_OFF);
    const int e0 = rl_i((int)c.rec.x, i), e1 = rl_i((int)c.rec.y, i), p0 = rl_i((int)c.rec.z, i), p1 = rl_i((int)c.rec.w, i);
    const size_t rowa = (size_t)T[32 + e0] * 256 + p0, rowb = (size_t)T[32 + e1] * 256 + p1;
    const bf16* Y = (const bf16*)(F.ws + WS_Y);
    const GAS v2u* ya = (const GAS v2u*)(Y + rowa * D) + F.lane; const GAS v2u* yb = (const GAS v2u*)(Y + rowb * D) + F.lane;
    load_row_bf16((const bf16*)(F.ws + WS_XRB) + (size_t)t * D, F.lane, r.xb);
#pragma unroll
    for (int j = 0; j < 4; ++j) { r.ya[j] = ya[64 * j]; r.yb[j] = yb[64 * j]; }
}
__device__ __forceinline__ RowVec comb_finish(const CombRecs& c, int i, const CombRows& r, const f32x4 (&g2)[4]) {
    const float ga = rl(c.ga, i), gb = rl(c.gb, i); RowVec x = unpack_row_bf16(r.xb);
#pragma unroll
    for (int j = 0; j < 4; ++j) { const v2u a = r.ya[j], bq = r.yb[j];
        f32x4 s; s.x = ga * bflo(a.x) + gb * bflo(bq.x); s.y = ga * bfhi(a.x) + gb * bfhi(bq.x); s.z = ga * bflo(a.y) + gb * bflo(bq.y); s.w = ga * bfhi(a.y) + gb * bfhi(bq.y);
        x.v[j] += g2[j] * s; }
    return x;
}

__device__ __forceinline__ void attn_phase(Frame& F, const int u_first, const int u_stride) {
    LAS bf16* KS = (LAS bf16*)(F.lds + RING_OFF);
    LAS bf16* VT = (LAS bf16*)(F.lds + RING_OFF + 36864);
    LAS float* BT = (LAS float*)(F.lds + RING_OFF + 36864 + 33280);
    const bf16* PROJ = (const bf16*)(F.ws + WS_PROJ); bf16* OAB = (bf16*)(F.ws + WS_OAB);
    const int lane = F.lane, lc = lane & 31, lh = lane >> 5;
    for (int unit = u_first; unit < 512; unit += u_stride) {
        const int b = unit >> 8, kvh = (unit >> 7) & 1, qb = unit & 127, t0 = qb * 128;
        __syncthreads();
        for (int i = F.tid; i < 4 * 192; i += 512) { const int hq = i / 192, x = i - hq * 192, dist = 159 - x; float v = 0.f;
            if (dist >= 0 && dist < 128) { int bk = dist; if (dist >= 16) { bk = 16 + (int)(logf((float)dist / 16.0f) / 2.0794415416798357f * 16.0f); bk = bk > 31 ? 31 : bk; }
                v = F.in[I_RELB][bk * 8 + kvh * 4 + hq] * 1.4426950408889634f; }
            BT[i] = v; }
#pragma unroll
        for (int cc = 0; cc < 4; ++cc) { const int ch = F.tid + 512 * cc, key = ch >> 3, part = ch & 7, tl = t0 - 128 + key;
            v4u kv = {0u, 0u, 0u, 0u}, vv = {0u, 0u, 0u, 0u};
            if (tl >= 0) { const bf16* rp = PROJ + (size_t)(b * SEQ + tl) * PIN; kv = *(const v4u*)(rp + PC_KB + kvh * 64 + part * 8); vv = *(const v4u*)(rp + PC_VB + kvh * 64 + part * 8); }
            *(LAS v4u*)(KS + key * 72 + part * 8) = kv;
            const unsigned w[4] = {vv.x, vv.y, vv.z, vv.w};
#pragma unroll
            for (int q = 0; q < 4; ++q) { VT[(part * 8 + 2 * q) * 260 + key] = (bf16)(w[q] & 0xffffu); VT[(part * 8 + 2 * q + 1) * 260 + key] = (bf16)(w[q] >> 16); } }
        __syncthreads();
#pragma unroll 1
        for (int tt = 0; tt < 2; ++tt) {
            const int task = F.wave * 2 + tt, hq = task >> 2, qt = task & 3, qh = kvh * 4 + hq;
            const int qi = 32 * qt + lc;
            const bf16* qrow = PROJ + (size_t)(b * SEQ + t0 + qi) * PIN + PC_QB + qh * 64 + 8 * lh;
            bf16x8 qf[4];
#pragma unroll
            for (int s = 0; s < 4; ++s) qf[s] = *(const bf16x8*)(qrow + 16 * s);
            f32x16 sc[5];
#pragma unroll
            for (int kt = 0; kt < 5; ++kt) {
#pragma unroll
                for (int r = 0; r < 16; ++r) sc[kt][r] = 0.f;
                const LAS bf16* kp = KS + (32 * (qt + kt) + lc) * 72 + 8 * lh;
#pragma unroll
                for (int s = 0; s < 4; ++s) { const bf16x8 kf = *(const LAS bf16x8*)(kp + 16 * s); sc[kt] = __builtin_amdgcn_mfma_f32_32x32x16_bf16(kf, qf[s], sc[kt], 0, 0, 0); }
            }
            const float sink2 = F.in[I_SINKS][qh] * 1.4426950408889634f;
            const LAS float* bp = BT + hq * 192 + (4 * lh - lc + 31);
            const int m_lo = lc + 1 - 4 * lh, m_hi = lc - 4 * lh;
            float mx = sink2;
#pragma unroll
            for (int kt = 0; kt < 5; ++kt) {
                const bool dead = (t0 == 0) && (qt + kt < 4);
#pragma unroll
                for (int r = 0; r < 16; ++r) { const int cr = (r & 3) + 8 * (r >> 2);
                    float v = sc[kt][r] * (0.125f * 1.4426950408889634f) + bp[32 * kt + cr];
                    if (kt == 0) v = (cr >= m_lo) ? v : -1e30f;
                    if (kt == 4) v = (cr <= m_hi) ? v : -1e30f;
                    if (dead) v = -1e30f;
                    sc[kt][r] = v; mx = fmaxf(mx, v); } }
            mx = fmaxf(mx, __shfl_xor(mx, 32));
            float den = 0.f;
#pragma unroll
            for (int kt = 0; kt < 5; ++kt)
#pragma unroll
                for (int r = 0; r < 16; ++r) { const float p = __builtin_amdgcn_exp2f(sc[kt][r] - mx); sc[kt][r] = p; den += p; }
            den += __shfl_xor(den, 32);
            den += __builtin_amdgcn_exp2f(sink2 - mx);
            const float inv = 1.0f / den;
            f32x16 oa[2];
#pragma unroll
            for (int dt = 0; dt < 2; ++dt)
#pragma unroll
                for (int r = 0; r < 16; ++r) oa[dt][r] = 0.f;
#pragma unroll
            for (int kt = 0; kt < 5; ++kt)
#pragma unroll
                for (int s2 = 0; s2 < 2; ++s2) {
                    v4u pw; pw.x = pk2(sc[kt][8 * s2 + 0], sc[kt][8 * s2 + 1]); pw.y = pk2(sc[kt][8 * s2 + 2], sc[kt][8 * s2 + 3]); pw.z = pk2(sc[kt][8 * s2 + 4], sc[kt][8 * s2 + 5]); pw.w = pk2(sc[kt][8 * s2 + 6], sc[kt][8 * s2 + 7]);
                    const bf16x8 pf = __builtin_bit_cast(bf16x8, pw);
#pragma unroll
                    for (int dt = 0; dt < 2; ++dt) { const LAS bf16* vp = VT + (32 * dt + lc) * 260 + 32 * (qt + kt) + 16 * s2 + 4 * lh;
                        const v2u va = *(const LAS v2u*)vp, vb = *(const LAS v2u*)(vp + 8);
                        v4u vw; vw.x = va.x; vw.y = va.y; vw.z = vb.x; vw.w = vb.y;
                        oa[dt] = __builtin_amdgcn_mfma_f32_32x32x16_bf16(__builtin_bit_cast(bf16x8, vw), pf, oa[dt], 0, 0, 0); }
                }
            bf16* orow = OAB + (size_t)(b * SEQ + t0 + qi) * D + 512 + qh * 64 + 4 * lh;
#pragma unroll
            for (int dt = 0; dt < 2; ++dt)
#pragma unroll
                for (int rg = 0; rg < 4; ++rg) { v2u o; o.x = pk2(oa[dt][4 * rg] * inv, oa[dt][4 * rg + 1] * inv); o.y = pk2(oa[dt][4 * rg + 2] * inv, oa[dt][4 * rg + 3] * inv);
                    *(v2u*)(orow + 32 * dt + 8 * rg) = o; }
        }
    }
    __syncthreads();
}


constexpr int DN_ST = 72;

__device__ __forceinline__ bf16x8 pack8(const f32x16& x, int s) { v4u p; p.x = pk2(x[8 * s], x[8 * s + 1]); p.y = pk2(x[8 * s + 2], x[8 * s + 3]); p.z = pk2(x[8 * s + 4], x[8 * s + 5]); p.w = pk2(x[8 * s + 6], x[8 * s + 7]); return __builtin_bit_cast(bf16x8, p); }
__device__ __forceinline__ f32x16 dn_tile(const LAS bf16* A, int ra, const LAS bf16* B, int rb, int lc, int lh) {
    f32x16 acc;
#pragma unroll
    for (int r = 0; r < 16; ++r) acc[r] = 0.f;
#pragma unroll
    for (int s = 0; s < 4; ++s) { const bf16x8 a = *(const LAS bf16x8*)(A + (ra + lc) * DN_ST + 16 * s + 8 * lh), b = *(const LAS bf16x8*)(B + (rb + lc) * DN_ST + 16 * s + 8 * lh);
        acc = __builtin_amdgcn_mfma_f32_32x32x16_bf16(a, b, acc, 0, 0, 0); }
    return acc;
}
__device__ __forceinline__ void dn_prep(Frame& F) {
    LAS bf16* Qs = (LAS bf16*)(F.lds + RING_OFF);
    LAS bf16* Ks = Qs + 64 * DN_ST;
    LAS bf16* KBs = Ks + 64 * DN_ST;
    LAS bf16* Vs = KBs + 64 * DN_ST;
    LAS bf16* KDT = Vs + 64 * DN_ST;
    LAS bf16* AQK = KDT + 64 * DN_ST;
    LAS bf16* UT = AQK + 64 * DN_ST;
    LAS bf16* WT = UT + 64 * DN_ST;
    LAS bf16* LNO = WT + 64 * DN_ST;
    LAS float* LD = (LAS float*)(LNO + 64 * DN_ST);
    LAS bf16* TDZ = (LAS bf16*)(LD + 64 * 16);
    LAS float* GB = (LAS float*)(TDZ + 64 * 24);
    const bf16* PROJ = (const bf16*)(F.ws + WS_PROJ); const float* BG = (const float*)(F.ws + WS_BG);
    const int tid = F.tid, lane = F.lane, lc = lane & 31, lh = lane >> 5, wave = F.wave;
    LAS float* CW = GB + 256;
    for (int i = tid; i < 1536; i += 512) *((LAS f32x4*)CW + i) = *((const f32x4*)F.in[I_CONVW] + i);
    LAS v4u* RAW = (LAS v4u*)(F.lds + R1W_OFF);
    constexpr int RAW_CH = 67 * 24;
#define DN_RAW_SRC(i_, b_, h_, n_) ({ const int r_ = (i_) / 24, c_ = (i_) - r_ * 24; const int tl_ = (n_) * 64 - 3 + r_; \
        tl_ >= 0 ? (const v4u*)(PROJ + ((size_t)(b_) * SEQ + tl_) * PIN + (c_ < 8 ? PC_QA : c_ < 16 ? PC_KA : PC_VA) + (h_) * 64 + (c_ & 7) * 8) : (const v4u*)nullptr; })
    { const int u0 = F.vcu, b = u0 >> 11, h = (u0 >> 8) & 7, n = u0 & 255;
      for (int i = tid; i < RAW_CH; i += 512) { const v4u* sp = DN_RAW_SRC(i, b, h, n); v4u z = {0u, 0u, 0u, 0u}; if (sp) z = *sp; RAW[i] = z; }
      if (wave == 0) { const size_t row0 = (size_t)b * SEQ + (size_t)n * 64; float c = BG[(row0 + lane) * 16 + 8 + h];
#pragma unroll
          for (int o = 1; o < 64; o <<= 1) { const float up = __shfl_up(c, o); if (lane >= o) c += up; }
          GB[lane] = c; GB[64 + lane] = BG[(row0 + lane) * 16 + h]; } }
    int par = 0;
    for (int unit = F.vcu; unit < 4096; unit += F.G, par ^= 1) {
        const int b = unit >> 11, h = (unit >> 8) & 7, n = unit & 255;
        LAS float* gcs = GB + par * 128; LAS float* bts = gcs + 64;
        const int un = unit + F.G; const bool more = un < 4096; const int bn = un >> 11, hn = (un >> 8) & 7, nn = un & 255;
        __syncthreads();
        { const int t = tid >> 3, cs = tid & 7;
          float q[8], k[8], v[8];
#pragma unroll
          for (int e = 0; e < 8; ++e) { q[e] = 0.f; k[e] = 0.f; v[e] = 0.f; }
#pragma unroll
          for (int j = 0; j < 4; ++j) { { const LAS v4u* rp = RAW + (t + j) * 24 + cs;
                const v4u wq = rp[0], wk = rp[8], wv = rp[16];
                const LAS float* cw = CW + j * 1536 + h * 64 + cs * 8;
                const unsigned uq[4] = {wq.x, wq.y, wq.z, wq.w}, uk[4] = {wk.x, wk.y, wk.z, wk.w}, uv[4] = {wv.x, wv.y, wv.z, wv.w};
#pragma unroll
                for (int e = 0; e < 4; ++e) { q[2 * e] += cw[2 * e] * bflo(uq[e]); q[2 * e + 1] += cw[2 * e + 1] * bfhi(uq[e]);
                    k[2 * e] += cw[512 + 2 * e] * bflo(uk[e]); k[2 * e + 1] += cw[512 + 2 * e + 1] * bfhi(uk[e]);
                    v[2 * e] += cw[1024 + 2 * e] * bflo(uv[e]); v[2 * e + 1] += cw[1024 + 2 * e + 1] * bfhi(uv[e]); } } }
          float sq = 0.f, sk = 0.f;
#pragma unroll
          for (int e = 0; e < 8; ++e) { q[e] = silu_f(q[e]); k[e] = silu_f(k[e]); v[e] = silu_f(v[e]); sq += q[e] * q[e]; sk += k[e] * k[e]; }
          sq = oct_sum(sq); sk = oct_sum(sk);
          const float rq = 0.125f / sqrtf(sq + EPS), rk = 1.0f / sqrtf(sk + EPS), bt = bts[t], kd = __expf(gcs[63] - gcs[t]);
          v4u oq, ok, ob, ov;
          oq.x = pk2(q[0] * rq, q[1] * rq); oq.y = pk2(q[2] * rq, q[3] * rq); oq.z = pk2(q[4] * rq, q[5] * rq); oq.w = pk2(q[6] * rq, q[7] * rq);
#pragma unroll
          for (int e = 0; e < 8; ++e) k[e] *= rk;
          ok.x = pk2(k[0], k[1]); ok.y = pk2(k[2], k[3]); ok.z = pk2(k[4], k[5]); ok.w = pk2(k[6], k[7]);
          ob.x = pk2(k[0] * bt, k[1] * bt); ob.y = pk2(k[2] * bt, k[3] * bt); ob.z = pk2(k[4] * bt, k[5] * bt); ob.w = pk2(k[6] * bt, k[7] * bt);
          ov.x = pk2(v[0], v[1]); ov.y = pk2(v[2], v[3]); ov.z = pk2(v[4], v[5]); ov.w = pk2(v[6], v[7]);
          *(LAS v4u*)(Qs + t * DN_ST + cs * 8) = oq; *(LAS v4u*)(Ks + t * DN_ST + cs * 8) = ok; *(LAS v4u*)(KBs + t * DN_ST + cs * 8) = ob; *(LAS v4u*)(Vs + t * DN_ST + cs * 8) = ov;
#pragma unroll
          for (int e = 0; e < 8; ++e) KDT[(cs * 8 + e) * DN_ST + t] = (bf16)f2bf(k[e] * kd); }
        __syncthreads();
        v4u pf[7]; float pg = 0.f, pb = 0.f;
        if (wave >= 4 && more) {
#pragma unroll
            for (int k7 = 0; k7 < 7; ++k7) { const int i = (tid - 256) + 256 * k7; pf[k7] = (v4u){0u, 0u, 0u, 0u}; if (i < RAW_CH) { const v4u* sp = DN_RAW_SRC(i, bn, hn, nn); if (sp) pf[k7] = *sp; } }
            if (wave == 4) { const size_t rn = (size_t)bn * SEQ + (size_t)nn * 64; pg = BG[(rn + lane) * 16 + 8 + hn]; pb = BG[(rn + lane) * 16 + hn]; }
        }
        { const int it = (wave >> 1) & 1, jt = wave & 1; const bool qk = wave >= 4;
          f32x16 acc;
          if (it >= jt) acc = dn_tile(qk ? Qs : KBs, 32 * it, Ks, 32 * jt, lc, lh);
          const int j = 32 * jt + lc; const float gj = gcs[j];
#pragma unroll
          for (int r = 0; r < 16; ++r) { const int i = 32 * it + (r & 3) + 8 * (r >> 2) + 4 * lh;
              float val = 0.f;
              if (it >= jt) { if (qk ? (i >= j) : (i > j)) val = acc[r] * __expf(gcs[i] - gj); }
              if (qk) AQK[i * DN_ST + j] = (bf16)f2bf(val);
              else { const bool diag = (i >> 4) == (j >> 4); LNO[i * DN_ST + j] = (bf16)f2bf(diag ? 0.f : -val); if (diag) LD[i * 16 + (j & 15)] = val; } } }
        __syncthreads();
        if (wave == 0) { const int bb = lane >> 4, c = lane & 15; float tcol[16];
#pragma unroll
            for (int i = 0; i < 16; ++i) { float v = (i == c) ? 1.f : 0.f;
#pragma unroll
                for (int j4 = 0; j4 < (i + 3) / 4; ++j4) { const f32x4 a = *(const LAS f32x4*)(LD + (16 * bb + i) * 16 + 4 * j4);
#pragma unroll
                    for (int e = 0; e < 4; ++e) if (4 * j4 + e < i) v -= a[e] * tcol[4 * j4 + e]; }
                tcol[i] = v; TDZ[(16 * bb + i) * 24 + c] = (bf16)f2bf(v); } }
        __syncthreads();
        if (wave < 4) {
            const int ct = wave, cc = 32 * (ct & 1) + lc; const bool isw = ct >= 2;
            f32x16 acc[2];
#pragma unroll
            for (int rt = 0; rt < 2; ++rt)
#pragma unroll
                for (int r = 0; r < 16; ++r) { const int t = 32 * rt + (r & 3) + 8 * (r >> 2) + 4 * lh;
                    acc[rt][r] = isw ? bf2f(Ks[t * DN_ST + cc]) * bts[t] * __expf(gcs[t]) : bf2f(Vs[t * DN_ST + cc]) * bts[t]; }
#define DN_AFRAG(arr, stride, row, kb) ({ const LAS bf16* p_ = (arr) + (row) * (stride) + 16 * (kb) + 4 * lh; const v2u lo_ = *(const LAS v2u*)p_, hi_ = *(const LAS v2u*)(p_ + 8); v4u w_; w_.x = lo_.x; w_.y = lo_.y; w_.z = hi_.x; w_.w = hi_.y; __builtin_bit_cast(bf16x8, w_); })
            f32x16 X[4];
#pragma unroll
            for (int bb = 0; bb < 4; ++bb) { const int rt = bb >> 1, odd = bb & 1;
                bf16x8 ta = DN_AFRAG(TDZ, 24, 32 * rt + lc, 0);
                if ((lc >> 4) != odd) ta = (bf16x8){0, 0, 0, 0, 0, 0, 0, 0};
                f32x16 z;
#pragma unroll
                for (int r = 0; r < 16; ++r) z[r] = 0.f;
                z = __builtin_amdgcn_mfma_f32_32x32x16_bf16(ta, pack8(acc[rt], odd), z, 0, 0, 0);
                X[bb] = z;
                const bf16x8 xb = pack8(z, odd);
                if (bb == 0) { acc[0] = __builtin_amdgcn_mfma_f32_32x32x16_bf16(DN_AFRAG(LNO, DN_ST, lc, 0), xb, acc[0], 0, 0, 0); acc[1] = __builtin_amdgcn_mfma_f32_32x32x16_bf16(DN_AFRAG(LNO, DN_ST, 32 + lc, 0), xb, acc[1], 0, 0, 0); }
                if (bb == 1) { acc[1] = __builtin_amdgcn_mfma_f32_32x32x16_bf16(DN_AFRAG(LNO, DN_ST, 32 + lc, 1), xb, acc[1], 0, 0, 0); }
                if (bb == 2) { acc[1] = __builtin_amdgcn_mfma_f32_32x32x16_bf16(DN_AFRAG(LNO, DN_ST, 32 + lc, 2), xb, acc[1], 0, 0, 0); }
            }
#undef DN_AFRAG
            LAS bf16* dst = (isw ? WT : UT) + cc * DN_ST;
#pragma unroll
            for (int bb = 0; bb < 4; ++bb)
#pragma unroll
                for (int g = 0; g < 2; ++g) { const int r0 = 8 * (bb & 1) + 4 * g; v2u o; o.x = pk2(X[bb][r0], X[bb][r0 + 1]); o.y = pk2(X[bb][r0 + 2], X[bb][r0 + 3]);
                    *(LAS v2u*)(dst + 16 * bb + 8 * g + 4 * lh) = o; }
        } else if (more) {
#pragma unroll
            for (int k7 = 0; k7 < 7; ++k7) { const int i = (tid - 256) + 256 * k7; if (i < RAW_CH) RAW[i] = pf[k7]; }
            if (wave == 4) { float c = pg;
#pragma unroll
                for (int o = 1; o < 64; o <<= 1) { const float up = __shfl_up(c, o); if (lane >= o) c += up; }
                GB[(par ^ 1) * 128 + lane] = c; GB[(par ^ 1) * 128 + 64 + lane] = pb; }
        }
        __syncthreads();
        { bf16* MT = (bf16*)((unsigned char*)F.out + OUT_DN_MT) + (size_t)unit * 4096; bf16* QPT = (bf16*)((unsigned char*)F.out + OUT_DN_QPT) + (size_t)unit * 4096;
          bf16* BM = (bf16*)(F.ws + WS_DN_BM) + (size_t)unit * 4096; bf16* O0T = (bf16*)(F.ws + WS_DN_O0T) + (size_t)unit * 4096;
#pragma unroll 1
          for (int tt = 0; tt < 2; ++tt) { const int task = wave * 2 + tt, p = task >> 2, ta = (task >> 1) & 1, tb = task & 1;
              if (p == 0) {
                  f32x16 acc = dn_tile(WT, 32 * ta, KDT, 32 * tb, lc, lh);
#pragma unroll
                  for (int r = 0; r < 16; ++r) acc[r] = -acc[r];
#pragma unroll
                  for (int s2 = 0; s2 < 2; ++s2) *(bf16x8*)(MT + ((((tb * 2 + ta) * 2 + s2) * 64 + lane) * 8)) = pack8(acc, s2);
              } else if (p == 1) {
                  const f32x16 acc = dn_tile(KDT, 32 * ta, UT, 32 * tb, lc, lh);
#pragma unroll
                  for (int s2 = 0; s2 < 2; ++s2) *(bf16x8*)(BM + ((((tb * 2 + ta) * 2 + s2) * 64 + lane) * 8)) = pack8(acc, s2);
              } else if (p == 2) {
                  f32x16 acc = dn_tile(WT, 32 * ta, AQK, 32 * tb, lc, lh);
                  const int i = 32 * tb + lc; const float eg = __expf(gcs[i]);
#pragma unroll
                  for (int r = 0; r < 16; ++r) { const int a = 32 * ta + (r & 3) + 8 * (r >> 2) + 4 * lh; acc[r] = bf2f(Qs[i * DN_ST + a]) * eg - acc[r]; }
#pragma unroll
                  for (int s2 = 0; s2 < 2; ++s2) *(bf16x8*)(QPT + ((((tb * 2 + ta) * 2 + s2) * 64 + lane) * 8)) = pack8(acc, s2);
              } else {
                  const f32x16 acc = dn_tile(UT, 32 * ta, AQK, 32 * tb, lc, lh);
#pragma unroll
                  for (int s2 = 0; s2 < 2; ++s2) *(bf16x8*)(O0T + ((((tb * 2 + ta) * 2 + s2) * 64 + lane) * 8)) = pack8(acc, s2);
              } }
          if (tid == 0) ((float*)(F.ws + WS_DN_GT))[unit] = __expf(gcs[63]); }
    }
#undef DN_RAW_SRC
    __syncthreads();
}
template <int r>
__device__ __forceinline__ void dn_scan_wave(Frame& F) {
    const int bx = (int)blockIdx.x, w = (bx & 7) * 4 + (bx >> 3), bh = w >> 1, ct = w & 1, lane = F.lane;
    const bf16x8* MT = (const bf16x8*)((const unsigned char*)F.out + OUT_DN_MT); const bf16x8* BM = (const bf16x8*)(F.ws + WS_DN_BM); bf16x8* SS = (bf16x8*)(F.ws + WS_DN_S);
    const float* GT = (const float*)(F.ws + WS_DN_GT);
    LAS bf16x8* MB = (LAS bf16x8*)(F.lds + RING_OFF);
    volatile LAS int* FL = (volatile LAS int*)(F.lds + LDSCTL_OFF + 64);
    f32x16 S;
#pragma unroll
    for (int q = 0; q < 16; ++q) S[q] = 0.f;
    bf16x8 mA[4], bA[2], mB[4], bB[2], mC[4], bC[2], mD[4], bD[2], mE[4], bE[2], mG[4], bG[2]; float gA, gB, gC, gD, gE, gG;
#define DN_SLOAD(m, bm, gt, u) do { const size_t ub = (size_t)(u) * 512; _Pragma("unroll") for (int f = 0; f < 4; ++f) m[f] = MT[ub + (r * 4 + f) * 64 + lane]; \
        _Pragma("unroll") for (int f = 0; f < 2; ++f) bm[f] = BM[ub + ((ct * 2 + r) * 2 + f) * 64 + lane]; gt = GT[u]; } while (0)
#define DN_STEP(cm, cb, cg, unit, n) do { \
        bf16x8 own[2]; own[0] = pack8(S, 0); own[1] = pack8(S, 1); \
        LAS bf16x8* mb = MB + ((n) & 1) * 256; \
        mb[(r * 2 + 0) * 64 + lane] = own[0]; mb[(r * 2 + 1) * 64 + lane] = own[1]; \
        asm volatile("s_waitcnt lgkmcnt(0)" ::: "memory"); \
        if (lane == 0) FL[r] = (n) + 1; \
        SS[(size_t)(unit) * 512 + (ct * 4 + r * 2 + 0) * 64 + lane] = own[0]; SS[(size_t)(unit) * 512 + (ct * 4 + r * 2 + 1) * 64 + lane] = own[1]; \
        f32x16 A; \
        { const v4u b0 = __builtin_bit_cast(v4u, cb[0]), b1 = __builtin_bit_cast(v4u, cb[1]); const unsigned u0[8] = {b0.x, b0.y, b0.z, b0.w, b1.x, b1.y, b1.z, b1.w}; \
          _Pragma("unroll") for (int e = 0; e < 8; ++e) { A[2 * e] = cg * S[2 * e] + bflo(u0[e]); A[2 * e + 1] = cg * S[2 * e + 1] + bfhi(u0[e]); } } \
        while (FL[1 - r] < (n) + 1) { } \
        asm volatile("" ::: "memory"); \
        bf16x8 oth[2]; oth[0] = mb[((1 - r) * 2 + 0) * 64 + lane]; oth[1] = mb[((1 - r) * 2 + 1) * 64 + lane]; \
          \
        _Pragma("unroll") for (int s2 = 0; s2 < 2; ++s2) { A = __builtin_amdgcn_mfma_f32_32x32x16_bf16(cm[r * 2 + s2], own[s2], A, 0, 0, 0); A = __builtin_amdgcn_mfma_f32_32x32x16_bf16(cm[(1 - r) * 2 + s2], oth[s2], A, 0, 0, 0); } \
        S = A; } while (0)
    const int u0 = bh * 256;
    DN_SLOAD(mA, bA, gA, u0); DN_SLOAD(mB, bB, gB, u0 + 1); DN_SLOAD(mC, bC, gC, u0 + 2); DN_SLOAD(mD, bD, gD, u0 + 3); DN_SLOAD(mE, bE, gE, u0 + 4); DN_SLOAD(mG, bG, gG, u0 + 5);
    for (int n = 0; n < 252; n += 6) {
        DN_STEP(mA, bA, gA, u0 + n, n);         DN_SLOAD(mA, bA, gA, u0 + n + 6);
        DN_STEP(mB, bB, gB, u0 + n + 1, n + 1); DN_SLOAD(mB, bB, gB, u0 + n + 7);
        DN_STEP(mC, bC, gC, u0 + n + 2, n + 2); DN_SLOAD(mC, bC, gC, u0 + n + 8);
        DN_STEP(mD, bD, gD, u0 + n + 3, n + 3); DN_SLOAD(mD, bD, gD, u0 + n + 9);
        DN_STEP(mE, bE, gE, u0 + n + 4, n + 4); if (n + 10 < 256) DN_SLOAD(mE, bE, gE, u0 + n + 10);
        DN_STEP(mG, bG, gG, u0 + n + 5, n + 5); if (n + 11 < 256) DN_SLOAD(mG, bG, gG, u0 + n + 11);
    }
    DN_STEP(mA, bA, gA, u0 + 252, 252); DN_STEP(mB, bB, gB, u0 + 253, 253); DN_STEP(mC, bC, gC, u0 + 254, 254); DN_STEP(mD, bD, gD, u0 + 255, 255);
#undef DN_SLOAD
#undef DN_STEP
}
__device__ __forceinline__ void dn_scan(Frame& F) {
    if ((int)blockIdx.x >= 32) return;
    if (F.wave == 0) dn_scan_wave<0>(F); else if (F.wave == 1) dn_scan_wave<1>(F);
}
__device__ __forceinline__ void dn_output(Frame& F) {
    const bf16x8* QPT = (const bf16x8*)((const unsigned char*)F.out + OUT_DN_QPT); const bf16x8* O0T = (const bf16x8*)(F.ws + WS_DN_O0T); const bf16x8* SS = (const bf16x8*)(F.ws + WS_DN_S);
    const bf16* PROJ = (const bf16*)(F.ws + WS_PROJ); bf16* OAB = (bf16*)(F.ws + WS_OAB);
    const int lane = F.lane, lc = lane & 31, lh = lane >> 5; int nbad = 0; (void)nbad;
    for (int task = F.vcu * NWAVES + F.wave; task < 8192; task += F.G * NWAVES) {
        const int unit = task >> 1, it = task & 1, b = unit >> 11, h = (unit >> 8) & 7, n = unit & 255;
        const size_t ub = (size_t)unit * 512;
        f32x16 o[2];
#pragma unroll
        for (int ct = 0; ct < 2; ++ct) {
            const v4u c0 = __builtin_bit_cast(v4u, O0T[ub + ((it * 2 + ct) * 2 + 0) * 64 + lane]), c1 = __builtin_bit_cast(v4u, O0T[ub + ((it * 2 + ct) * 2 + 1) * 64 + lane]);
            const unsigned u[8] = {c0.x, c0.y, c0.z, c0.w, c1.x, c1.y, c1.z, c1.w};
#pragma unroll
            for (int e = 0; e < 8; ++e) { o[ct][2 * e] = bflo(u[e]); o[ct][2 * e + 1] = bfhi(u[e]); }
#pragma unroll
            for (int at = 0; at < 2; ++at)
#pragma unroll
                for (int s2 = 0; s2 < 2; ++s2) o[ct] = __builtin_amdgcn_mfma_f32_32x32x16_bf16(SS[ub + (ct * 4 + at * 2 + s2) * 64 + lane], QPT[ub + ((it * 2 + at) * 2 + s2) * 64 + lane], o[ct], 0, 0, 0);
        }
        float ss = 0.f;
#pragma unroll
        for (int ct = 0; ct < 2; ++ct)
#pragma unroll
            for (int r = 0; r < 16; ++r) ss += o[ct][r] * o[ct][r];
        ss += __shfl_xor(ss, 32);
        const float rs = 1.0f / sqrtf(ss * (1.0f / 64.0f) + EPS);
        const size_t row = (size_t)b * SEQ + (size_t)n * 64 + it * 32 + lc;
#pragma unroll
        for (int ct = 0; ct < 2; ++ct)
#pragma unroll
            for (int rg = 0; rg < 4; ++rg) { const int c0 = 32 * ct + 8 * rg + 4 * lh;
                const v2u zz = *(const v2u*)(PROJ + row * PIN + PC_ZA + h * 64 + c0); const f32x4 ow = *(const f32x4*)(F.in[I_ONORM] + c0);
                const float z0 = bflo(zz.x), z1 = bfhi(zz.x), z2 = bflo(zz.y), z3 = bfhi(zz.y);
                v2u ov; ov.x = pk2(o[ct][4 * rg] * rs * ow[0] * silu_f(z0), o[ct][4 * rg + 1] * rs * ow[1] * silu_f(z1)); ov.y = pk2(o[ct][4 * rg + 2] * rs * ow[2] * silu_f(z2), o[ct][4 * rg + 3] * rs * ow[3] * silu_f(z3));
                *(v2u*)(OAB + row * D + h * 64 + c0) = ov;
            }
    }
}

template <int WIN>
__device__ __forceinline__ void pooled_block(const bf16* H, bf16* P, const int t0, const int tl0, const int col) {
    v4u r[WIN - 1 + 8];
#pragma unroll
    for (int j = 0; j < WIN - 1 + 8; ++j) { const int dt = j - (WIN - 1); r[j] = (v4u){0u, 0u, 0u, 0u}; if (tl0 + dt >= 0) r[j] = *(const v4u*)(H + (size_t)(t0 + dt) * D + col); }
    float s[8];
#pragma unroll
    for (int q = 0; q < 8; ++q) s[q] = 0.f;
#define POOL_ACC(sgn, VV) do { const v4u q_ = (VV); s[0] += sgn bflo(q_.x); s[1] += sgn bfhi(q_.x); s[2] += sgn bflo(q_.y); s[3] += sgn bfhi(q_.y); s[4] += sgn bflo(q_.z); s[5] += sgn bfhi(q_.z); s[6] += sgn bflo(q_.w); s[7] += sgn bfhi(q_.w); } while (0)
#pragma unroll
    for (int j = 0; j < WIN - 1; ++j) POOL_ACC(+, r[j]);
#pragma unroll
    for (int i = 0; i < 8; ++i) { const v4u self = r[WIN - 1 + i]; POOL_ACC(+, self);
        const int n = (tl0 + i + 1) < WIN ? (tl0 + i + 1) : WIN; const float inv = 1.0f / (float)n;
        v4u o; o.x = pk2(s[0] * inv - bflo(self.x), s[1] * inv - bfhi(self.x)); o.y = pk2(s[2] * inv - bflo(self.y), s[3] * inv - bfhi(self.y));
        o.z = pk2(s[4] * inv - bflo(self.z), s[5] * inv - bfhi(self.z)); o.w = pk2(s[6] * inv - bflo(self.w), s[7] * inv - bfhi(self.w));
        *(v4u*)(P + (size_t)(t0 + i) * D + col) = o;
        POOL_ACC(-, r[i]); }
#undef POOL_ACC
}
__device__ __forceinline__ void pooled_phase(Frame& F) {
    const bf16* H = (const bf16*)(F.ws + WS_H); bf16* P = (bf16*)(F.ws + WS_OAB);
    const int gt = F.vcu * 512 + F.tid, NT = F.G * 512;
    for (int it = gt; it < (NTOK / 8) * 128; it += NT) {
        const int c = it & 31, g = __builtin_amdgcn_readfirstlane((it >> 6) & 3), tb = ((it >> 8) << 1) | ((it >> 5) & 1);
        const int t0 = tb * 8, tl0 = t0 & (SEQ - 1), col = g * 256 + c * 8;
        if (g == 0) pooled_block<2>(H, P, t0, tl0, col); else if (g == 1) pooled_block<4>(H, P, t0, tl0, col); else if (g == 2) pooled_block<8>(H, P, t0, tl0, col); else pooled_block<16>(H, P, t0, tl0, col);
    }
}


#ifndef PH_MASK
#define PH_MASK 0xFFFFFF
#endif
#define IN(k) (((PH_MASK >> (k)) & 1) && lo <= (k) && (k) < hi)
#define BOTH(k) (IN(k) && IN((k) + 1))
#if MK_ONE_LAUNCH
#define GRID_BAR() xcd_barrier(bar)
#else
#define GRID_BAR() do { } while (0)
#endif
template <int LAYER>
__device__ __forceinline__ void moe_phases(Frame& F, const XcdBarrier& bar, const int lo, const int hi) {
    constexpr int pb = LAYER == 0 ? 7 : 13;
    bf16* const H = (bf16*)(F.ws + WS_H);
    const float* const MOD = (const float*)(F.ws + WS_MOD);
    if (IN(pb)) {
        moe_route(F, LAYER); if (BOTH(pb)) GRID_BAR(); }
    if (IN(pb + 1)) {
        build_moe_tables(F, LAYER);
        pg8::Gemm g{(const bf16*)H, 1024, 1024}; MoeSched S; S.init((const LAS int*)(F.lds + SCHED_OFF), F.G, (int)blockIdx.x, (const int*)(F.ws + WS_RT), F.ws + WS_WGU, 1024, 1024);
        EpiSwiglu E{(bf16*)(F.ws + WS_ACT)};
        if (LAYER == 1) { S.Blo = (const char*)(F.ws + WS_WGT); S.esplit = 16; }
        moe_tail_plan(F);
        pg8::gemm_phase<EpiSwiglu, MoeSched>(F.lds + RING_OFF, g, S, E);
        {
            const LAS int* T = (const LAS int*)(F.lds + SCHED_OFF); const int sp = T[67];
            const int q0 = LAYER == 0 ? 0 : CQ_NG, q1 = LAYER == 0 ? CQ_NGT : CQ_N;
            if (sp > 0) { __syncthreads(); const int f = q0 + T[65] * 8 * TQ_GU; int e = f + sp * 8 * TQ_GU; e = e < q1 ? e : q1; convert_range(F, 1, f, e, F.wave, 8); }
            if (LAYER == 1) { int t = q0 + T[66] * 8 * TQ_GU;
                if (t < q1) { __syncthreads(); convert_range(F, 1, t, q1, F.vcu * NWAVES + F.wave, F.G * NWAVES); } } }
        if (BOTH(pb + 1)) GRID_BAR();
    }
    if (IN(pb + 2)) {
        build_moe_tables(F, LAYER);
        pg8::Gemm g{(const bf16*)(F.ws + WS_ACT), 512, 512}; MoeSched S; S.init((const LAS int*)(F.lds + SCHED_OFF), F.G, (int)blockIdx.x, nullptr, F.ws + WS_WD, 512, 512);
        EpiStoreBf16 E{(bf16*)(F.ws + WS_Y), D};
        if (LAYER == 0) moe_tail_plan(F);
        pg8::gemm_phase<EpiStoreBf16, MoeSched>(F.lds + RING_OFF, g, S, E);
        if (LAYER == 0) {
            const LAS int* T = (const LAS int*)(F.lds + SCHED_OFF); const int sp = T[67];
            int t8 = T[66] * 8 * TQ_GU; t8 = t8 < CQ_NGT ? t8 : CQ_NGT;
            if (sp > 0) { __syncthreads(); const int f = t8 + T[65] * 8 * TQ_DN; int e = f + sp * 8 * TQ_DN; e = e < CQ_NG ? e : CQ_NG; convert_range(F, 1, f, e, F.wave, 8); } }
        if (BOTH(pb + 2)) GRID_BAR();
    }
    if (IN(pb + 3)) {
        build_moe_tables(F, LAYER);
        if (LAYER == 0) moe_tail_plan(F);
        const int tokw = F.vcu * 128 + F.wave * 16, b = (F.vcu * 128) / SEQ;
        f32x4 g2[4];
#pragma unroll
        for (int j = 0; j < 4; ++j) g2[j] = *((const f32x4*)(MOD + (size_t)(LAYER * 2 + b) * 6144 + 5 * 1024) + F.lane + 64 * j);
        if (LAYER == 0) {
            const ModVec m1 = load_mod(F.in[I_NMIX] + D, MOD + (size_t)(2 + b) * 6144 + 1024, MOD + (size_t)(2 + b) * 6144, F.lane);
            { const CombRecs recs = comb_load_recs(F, tokw); CombRows cur, nxt; comb_issue(F, recs, 0, tokw, cur);
              for (int i = 0; i < 16; ++i) { const int t = tokw + i;
                  if (i + 1 < 16) comb_issue(F, recs, i + 1, t + 1, nxt);
                  const RowVec x = comb_finish(recs, i, cur, g2);
                  store_row_bf16((bf16*)(F.ws + WS_XRB) + (size_t)t * D, F.lane, x); store_row_bf16(H + (size_t)t * D, F.lane, apply_mod(x, row_rstd(x), m1));
                  cur = nxt; } }
            __syncthreads();
            { const LAS int* T = (const LAS int*)(F.lds + SCHED_OFF);
              int t8 = T[66] * 8 * TQ_GU; t8 = t8 < CQ_NGT ? t8 : CQ_NGT; int t9 = t8 + T[66] * 8 * TQ_DN; t9 = t9 < CQ_NG ? t9 : CQ_NG;
              convert_range(F, 1, t9, CQ_NG, F.vcu * NWAVES + F.wave, F.G * NWAVES); }
        } else {
            f32x4 fw[4];
#pragma unroll
            for (int j = 0; j < 4; ++j) fw[j] = *((const f32x4*)F.in[I_FNW] + F.lane + 64 * j);
            { const CombRecs recs = comb_load_recs(F, tokw); CombRows cur, nxt; comb_issue(F, recs, 0, tokw, cur);
              for (int i = 0; i < 16; ++i) { const int t = tokw + i;
                  if (i + 1 < 16) comb_issue(F, recs, i + 1, t + 1, nxt);
                  RowVec x = comb_finish(recs, i, cur, g2); const float rstd = row_rstd(x);
#pragma unroll
                  for (int j = 0; j < 4; ++j) x.v[j] = x.v[j] * rstd * fw[j];
                  store_row_f32(F.out + (size_t)t * D, F.lane, x);
                  cur = nxt; } }
        }
        if (BOTH(pb + 3)) GRID_BAR();
    }
}

constexpr int PH_P0 = 0, PH_P1 = 1, PH_INPROJ = 2, PH_ATT = 3, PH_SCAN = 4, PH_DNOUT = 5, PH_OUTPROJ = 6, PH_MOE0 = 7, PH_POOLED = 11, PH_POOLG = 12, PH_MOE1 = 13;
constexpr int N_PHASES = 17;
struct Args { const float* in[24]; float* out; unsigned char* ws; int ph_lo, ph_hi; };
__global__ void __launch_bounds__(NWAVES * 64, 2) trunk_fwd(Args args) {
    __shared__ __attribute__((aligned(16))) unsigned char lds[LDS_BYTES];
    Frame F;
    F.lds = (LAS unsigned char*)lds;
    F.MISC = (volatile LAS unsigned*)(F.lds + MISC_OFF);
    F.tid = threadIdx.x; F.lane = F.tid & 63; F.wave = __builtin_amdgcn_readfirstlane(F.tid >> 6);
    F.G = gridDim.x; { const int bx = blockIdx.x; F.vcu = (F.G % 8 == 0) ? (bx % 8) * (F.G / 8) + bx / 8 : bx; }
#pragma unroll
    for (int i = 0; i < 24; ++i) F.in[i] = args.in[i];
    F.out = args.out; F.ws = args.ws; F.ctl = (gu32*)(args.ws + WS_CTL);
    for (int u = F.tid; u < (LDS_BYTES - LDSCTL_OFF) / 4; u += NWAVES * 64) ((LAS unsigned*)(F.lds + LDSCTL_OFF))[u] = 0u;
    __syncthreads();
#if MK_ONE_LAUNCH
    XcdBarrier bar = xcd_barrier_post((unsigned*)(F.ctl + CW_BAR), F.MISC + 8);
#else
    XcdBarrier bar; bar.bar = nullptr; bar.x = 0; bar.st = nullptr;
#endif
    const int lo = args.ph_lo, hi = args.ph_hi;
    bf16* const H = (bf16*)(F.ws + WS_H);
    const float* const MOD = (const float*)(F.ws + WS_MOD);

    if (IN(PH_P0)) { p0_prologue(F); if (BOTH(PH_P0)) GRID_BAR(); }
    if (IN(PH_P1)) { p1_prenorm0(F); if (BOTH(PH_P1)) GRID_BAR(); }
    if (IN(PH_INPROJ)) {
        pg8::Gemm g{(const bf16*)H, 1024, 1024}; DenseSched S; S.init(NTOK, IP_TILES * 256, F.G, (int)blockIdx.x, 1024, 0, F.ws + WS_WIN, 1024); S.gap_from = PC_ZA / 256; S.gap = 2;
        EpiStoreBf16 E{(bf16*)(F.ws + WS_PROJ), PIN};
        pg8::gemm_phase<EpiStoreBf16, DenseSched>(F.lds + RING_OFF, g, S, E);
        if (IP_FULL && (int)blockIdx.x >= IP_FULL) {
            __syncthreads(); const int r = (int)blockIdx.x - IP_FULL; convert_range(F, 0, r * 8 * TQ_INPROJ, (r + 1) * 8 * TQ_INPROJ, F.wave, 8); }
        if (BOTH(PH_INPROJ)) GRID_BAR();
    }
    if (IN(PH_ATT)) { dn_prep(F); if (BOTH(PH_ATT)) GRID_BAR(); }
    if (IN(PH_SCAN)) {
        if ((int)blockIdx.x < 32) dn_scan(F);
        else { const int o = (int)blockIdx.x - 32, NO = F.G - 32;
            attn_phase(F, o, NO); __syncthreads();
            { pg8::Gemm g{(const bf16*)H, 1024, 1024}; EpiStoreBf16 E{(bf16*)(F.ws + WS_PROJ), PIN};
              DenseSched S; S.init(NTOK, 512, NO, o, 1024, 0, F.ws + WS_WIN, 1024); S.gap_from = 0; S.gap = PC_ZA / 256; S.Lend = NO;
              pg8::gemm_phase<EpiStoreBf16, DenseSched>(F.lds + RING_OFF, g, S, E);
              if (o >= 64 && o < 64 + (S.nwg - NO)) { __syncthreads(); S.L0 = NO; S.G = S.nwg - NO; S.c = o - 64; S.Lend = S.nwg;
                  pg8::gemm_phase<EpiStoreBf16, DenseSched>(F.lds + RING_OFF, g, S, E); } }
            __syncthreads();
            { const int q = o < 64 ? 6 : o < 96 ? 4 : 9, off = o < 64 ? 48 * o : o < 96 ? 3072 + 32 * (o - 64) : 4096 + 72 * (o - 96);
              convert_range(F, 0, CQ_T2 + off, CQ_T2 + off + 8 * q, F.wave, 8);
              convert_range(F, 0, CQ_T2 + 4096 + 72 * 128, CQ_N, o * NWAVES + F.wave, NO * NWAVES); } }
        if (BOTH(PH_SCAN)) GRID_BAR(); }
    if (IN(PH_DNOUT)) { dn_output(F); if (BOTH(PH_DNOUT)) GRID_BAR(); }
    if (IN(PH_OUTPROJ)) {
        pg8::Gemm g{(const bf16*)(F.ws + WS_OAB), 1024, 1024}; DenseSched S; S.init(NTOK, D, F.G, (int)blockIdx.x, 1024, 0, F.ws + WS_WOUT, 1024);
        EpiResid<true> E{F.in[I_X], (bf16*)(F.ws + WS_XRB), MOD + 2 * 1024, nullptr};
        pg8::gemm_phase<EpiResid<true>, DenseSched>(F.lds + RING_OFF, g, S, E);
        if (BOTH(PH_OUTPROJ)) GRID_BAR();
    }
    moe_phases<0>(F, bar, lo, hi);
    if (IN(PH_POOLED)) { pooled_phase(F); if (BOTH(PH_POOLED)) GRID_BAR(); }
    if (IN(PH_POOLG)) {
        pg8::Gemm g{(const bf16*)(F.ws + WS_OAB), 256, 256}; DenseSched S; S.init(NTOK, D, F.G, (int)blockIdx.x, 1024, 256, F.ws + WS_POOLW, 256);
        EpiResid<false> E{nullptr, (bf16*)(F.ws + WS_XRB), MOD + (size_t)2 * 6144 + 2 * 1024, F.in[I_POOLS]};
        pg8::gemm_phase<EpiResid<false>, DenseSched>(F.lds + RING_OFF, g, S, E);
        if (BOTH(PH_POOLG)) GRID_BAR();
    }
    moe_phases<1>(F, bar, lo, hi);
#undef IN
#undef BOTH
}

extern "C" void kernel_launch(void* const* d_in, const int* in_sizes, int n_in, void* d_out, int out_size, void* d_ws, size_t ws_size, hipStream_t stream) {
    static int grid = 0;
    if (grid == 0) {
        if (n_in != 24 || in_sizes[0] != NTOK * D || out_size != NTOK * D || ws_size < WS_END2) { fprintf(stderr, "kernel_launch: unexpected shapes (n_in %d, in0 %d, out %d, ws %zu); nothing launched\n", n_in, n_in > 0 ? in_sizes[0] : -1, out_size, ws_size); grid = -1; return; }
        int per_cu = 0;
        if (hipOccupancyMaxActiveBlocksPerMultiprocessor(&per_cu, (const void*)trunk_fwd, NWAVES * 64, 0) != hipSuccess || per_cu < 1) fprintf(stderr, "kernel_launch: occupancy query says %d\n", per_cu);
        (void)hipGetLastError();
        grid = 256;
    }
    if (grid < 0) return;
    if (hipMemsetAsync((char*)d_ws + WS_CTL, 0, CTL_ZERO_BYTES, stream) != hipSuccess) { fprintf(stderr, "kernel_launch: memset failed\n"); return; }
    Args a{};
    for (int i = 0; i < 24; ++i) a.in[i] = (const float*)d_in[i];
    a.out = (float*)d_out; a.ws = (unsigned char*)d_ws;
#if MK_ONE_LAUNCH
    a.ph_lo = 0; a.ph_hi = N_PHASES;
    hipLaunchKernelGGL(trunk_fwd, dim3(grid), dim3(NWAVES * 64), 0, stream, a);
#else
    for (int p = 0; p < N_PHASES; ++p) { a.ph_lo = p; a.ph_hi = p + 1; hipLaunchKernelGGL(trunk_fwd, dim3(grid), dim3(NWAVES * 64), 0, stream, a); }
#endif
}
```

```cpp
#include <hip/hip_runtime.h>
#include <cstdio>
#include <cstdint>

#ifndef MK_ONE_LAUNCH
#define MK_ONE_LAUNCH 1
#endif

#define GAS __attribute__((address_space(1)))
#define LAS __attribute__((address_space(3)))
typedef unsigned short bf16;
typedef unsigned v4u __attribute__((ext_vector_type(4)));
typedef unsigned v2u __attribute__((ext_vector_type(2)));
typedef float f32x4 __attribute__((ext_vector_type(4)));
typedef float f32x2 __attribute__((ext_vector_type(2)));
typedef float f32x16 __attribute__((ext_vector_type(16)));
typedef short bf16x8 __attribute__((ext_vector_type(8)));
typedef GAS unsigned gu32;
#define RLX_AGENT __ATOMIC_RELAXED, __HIP_MEMORY_SCOPE_AGENT
#define LDS_WAIT() asm volatile("s_waitcnt lgkmcnt(0)" ::: "memory")
#define VM_WAIT() asm volatile("s_waitcnt vmcnt(0)" ::: "memory")

constexpr int BATCH = 2, SEQ = 16384, D = 1024, NTOK = BATCH * SEQ;
constexpr int PIN = 2816;
constexpr int PC_QA = 0, PC_KA = 512, PC_VA = 1024, PC_ZA = 1536, PC_QB = 2048, PC_KB = 2560, PC_VB = 2688;
constexpr int NEXP = 32, DFF = 512;
constexpr int MAXTILES = NTOK * 2 / 256 + NEXP;
constexpr float EPS = 1e-6f;
constexpr int NWAVES = 8;

constexpr size_t MiB = 1u << 20;
constexpr size_t WS_CTL = 0, CTL_ZERO_BYTES = 1 * MiB;
constexpr size_t WS_MOD = 1 * MiB;
constexpr size_t WS_WBA = 1 * MiB + 128 * 1024;
constexpr size_t WS_ROUTE = 2 * MiB;
constexpr size_t WS_RT = 3 * MiB;
constexpr size_t WS_BG = 7 * MiB;
constexpr size_t WS_WIN = 10 * MiB;
constexpr size_t WS_WOUT = 16 * MiB;
constexpr size_t WS_POOLW = 18 * MiB;
constexpr size_t WS_WGU = 20 * MiB;
constexpr size_t WS_WD = 84 * MiB;
constexpr size_t WS_H = 116 * MiB;
constexpr size_t WS_PROJ = 180 * MiB;
constexpr size_t WS_OAB = 356 * MiB;
constexpr size_t WS_YM = 180 * MiB;
constexpr size_t WS_ACT = 180 * MiB;
constexpr size_t WS_Y = 252 * MiB;
constexpr size_t WS_END = 420 * MiB;
constexpr size_t OUT_DN_MT = 0, OUT_DN_QPT = 32 * MiB;
constexpr size_t WS_DN_BM = 420 * MiB, WS_DN_O0T = 452 * MiB, WS_DN_S = 484 * MiB;
constexpr size_t WS_DN_GT = 9 * MiB;
constexpr size_t WS_XRB = 420 * MiB;
constexpr size_t WS_WGT = 484 * MiB;
constexpr size_t WS_END2 = 516 * MiB;
constexpr int CW_CNT = 64;
constexpr int CW_BAR = 4096;
constexpr int CW_BAD = 200;

constexpr int RING_OFF = 0, RING_BYTES = 131072;
constexpr int LDSCTL_OFF = RING_BYTES, MISC_OFF = LDSCTL_OFF + 320;
constexpr int SCHED_OFF = LDSCTL_OFF + 1024;
constexpr int LDS_BYTES = 163840;
constexpr int R1W_OFF = 135168;
constexpr int RT_LDS_OFF = 151552;

typedef __bf16 bf16x2_t __attribute__((ext_vector_type(2)));
__device__ __forceinline__ unsigned pk2(float lo, float hi) { bf16x2_t v; v.x = (__bf16)lo; v.y = (__bf16)hi; return __builtin_bit_cast(unsigned, v); }
__device__ __forceinline__ unsigned f2bf(float f) { return pk2(f, 0.f) & 0xffffu; }
__device__ __forceinline__ float bf2f(unsigned b) { return __builtin_bit_cast(float, b << 16); }
__device__ __forceinline__ float bflo(unsigned w) { return __builtin_bit_cast(float, w << 16); }
__device__ __forceinline__ float bfhi(unsigned w) { return __builtin_bit_cast(float, w & 0xffff0000u); }
template <int CTRL> __device__ __forceinline__ float dpp_f(float v) { return __builtin_bit_cast(float, __builtin_amdgcn_update_dpp(0, __builtin_bit_cast(int, v), CTRL, 0xf, 0xf, false)); }
__device__ __forceinline__ float quad_sum(float v) { v += dpp_f<0xB1>(v); v += dpp_f<0x4E>(v); return v; }
__device__ __forceinline__ float oct_sum(float v) { v = quad_sum(v); v += dpp_f<0x141>(v); return v; }
__device__ __forceinline__ float wave_sum(float v) {
    v = oct_sum(v); v += dpp_f<0x140>(v);
    const float r0 = __builtin_bit_cast(float, __builtin_amdgcn_readlane(__builtin_bit_cast(int, v), 0)), r1 = __builtin_bit_cast(float, __builtin_amdgcn_readlane(__builtin_bit_cast(int, v), 16));
    const float r2 = __builtin_bit_cast(float, __builtin_amdgcn_readlane(__builtin_bit_cast(int, v), 32)), r3 = __builtin_bit_cast(float, __builtin_amdgcn_readlane(__builtin_bit_cast(int, v), 48));
    return (r0 + r1) + (r2 + r3);
}
__device__ __forceinline__ float rl(float x, int l) { return __builtin_bit_cast(float, __builtin_amdgcn_readlane(__builtin_bit_cast(int, x), l)); }
template <int CTRL, int M> __device__ __forceinline__ void ms_halve(const float (&in)[2 * M], float (&out)[M], bool s) {
#pragma unroll
    for (int k = 0; k < M; ++k) { const float keep = s ? in[k + M] : in[k], send = s ? in[k] : in[k + M]; out[k] = keep + dpp_f<CTRL>(send); }
}
__device__ __forceinline__ float ms_rows(float v) {
    { unsigned a = __builtin_bit_cast(unsigned, v), b = a; asm volatile("s_nop 1\n\tv_permlane16_swap_b32 %0, %1" : "+v"(a), "+v"(b)); v = __builtin_bit_cast(float, a) + __builtin_bit_cast(float, b); }
    { unsigned a = __builtin_bit_cast(unsigned, v), b = a; asm volatile("s_nop 1\n\tv_permlane32_swap_b32 %0, %1" : "+v"(a), "+v"(b)); v = __builtin_bit_cast(float, a) + __builtin_bit_cast(float, b); }
    return v;
}
__device__ __forceinline__ float multi_sum16(const float (&v)[16], int lane) {
    float a[8], b[4], c[2], d[1];
    ms_halve<0x140, 8>(v, a, (lane & 8) != 0); ms_halve<0x141, 4>(a, b, (lane & 4) != 0); ms_halve<0x4E, 2>(b, c, (lane & 2) != 0); ms_halve<0xB1, 1>(c, d, (lane & 1) != 0);
    return ms_rows(d[0]);
}
__device__ __forceinline__ float multi_sum8(const float (&v)[8], int lane) {
    float a[4], b[2], c[1];
    ms_halve<0x140, 4>(v, a, (lane & 8) != 0); ms_halve<0x141, 2>(a, b, (lane & 4) != 0); ms_halve<0x4E, 1>(b, c, (lane & 2) != 0);
    float r = c[0]; r += dpp_f<0xB1>(r); return ms_rows(r);
}
__device__ __forceinline__ float multi_sum4(const float (&v)[4], int lane) {
    float a[2], b[1];
    ms_halve<0x140, 2>(v, a, (lane & 8) != 0); ms_halve<0x141, 1>(a, b, (lane & 4) != 0);
    float r = b[0]; r += dpp_f<0x4E>(r); r += dpp_f<0xB1>(r); return ms_rows(r);
}
__device__ __forceinline__ float silu_f(float x) { return x / (1.f + __expf(-x)); }
__device__ __forceinline__ float sigmoid_f(float x) { return 1.f / (1.f + __expf(-x)); }
__device__ __forceinline__ float softplus_f(float x) { return x > 20.f ? x : log1pf(__expf(x)); }

namespace pg8 {
#define PG8_LAS __attribute__((address_space(3)))
typedef unsigned short bf16_t;
typedef unsigned u32x4 __attribute__((ext_vector_type(4)));
constexpr int BM = 256, BK = 64, HALF = 128, HTB = HALF * BK * 2, STAGE_BYTES = 8 * HTB;

__host__ __device__ __forceinline__ int lds_byte(int r, int c) { const int st = (r >> 4) * 2 + (c >> 5), rr = r & 15, cc = c & 31, ob = rr * 64 + cc * 2; return st * 1024 + (ob ^ (((ob >> 9) & 1) << 5)); }
__host__ __device__ __forceinline__ void stage_rc(int b, int& R, int& C) { const int st = b / 1024, sb = b % 1024, swz = sb ^ (((sb >> 9) & 1) << 5); R = (st >> 1) * 16 + swz / 64; C = (st & 1) * 32 + (swz % 64) / 2; }
__host__ __device__ __forceinline__ int perm32(int rho) { const int n = rho >> 4, i = rho & 15; return 8 * (i >> 2) + 4 * n + (i & 3); }

struct Unit { int pm, pn, e; };
struct Gemm { const bf16_t* A; int K, ldb; };

template <class Epi, class Sched>
__device__ __forceinline__ void gemm_phase(PG8_LAS unsigned char* lds, const Gemm g, const Sched& S, const Epi& E) {
    const int tid = threadIdx.x, wid = __builtin_amdgcn_readfirstlane(tid >> 6), lane = tid & 63, wr = wid >> 2, wc = wid & 3, fr = lane & 15, fq = lane >> 4;
    const int K = g.K, nt = K / BK;
    int R0, C0, R1, C1; stage_rc(tid * 16, R0, C0); stage_rc(tid * 16 + 8192, R1, C1);
    const int Rb0 = (R0 & ~31) + perm32(R0 & 31), Rb1 = (R1 & ~31) + perm32(R1 & 31);
    const unsigned voffB0 = (unsigned)(Rb0 * g.ldb + C0) * 2u, voffB1 = (unsigned)(Rb1 * g.ldb + C1) * 2u;
    const size_t kstep = (size_t)(BK * 2);
    const size_t hstepB = (size_t)HALF * g.ldb * 2;
    const unsigned ldsw = (unsigned)wid * 1024u;
    const int aoff = lds_byte(wr * 64 + fr, fq * 8), boff = lds_byte(wc * 32 + fr, fq * 8);
    const char* Ab = (const char*)g.A;
#define PG8_SA(b, h) (((b) * 2 + (h)) * HTB)
#define PG8_SB(b, h) ((4 + (b) * 2 + (h)) * HTB)
#define PG8_ST2(bufoff, gbase, v0, v1) do { \
        __builtin_amdgcn_global_load_lds((const unsigned*)((const char*)(gbase) + (v0)), (PG8_LAS unsigned*)(lds + (bufoff) + ldsw), 16, 0, 0); \
        __builtin_amdgcn_global_load_lds((const unsigned*)((const char*)(gbase) + (v1)), (PG8_LAS unsigned*)(lds + (bufoff) + ldsw + 8192), 16, 0, 0); } while (0)
#define PG8_STB(bufoff, gbase) PG8_ST2(bufoff, gbase, voffB0, voffB1)
#define PG8_LDA(dst, b, h) do { _Pragma("unroll") for (int m = 0; m < 4; ++m) _Pragma("unroll") for (int k = 0; k < 2; ++k) dst[m][k] = *(const PG8_LAS bf16x8*)(lds + PG8_SA(b, h) + aoff + m * 2048 + k * 1024); } while (0)
#define PG8_LDB(dst, b, h) do { _Pragma("unroll") for (int n = 0; n < 2; ++n) _Pragma("unroll") for (int k = 0; k < 2; ++k) dst[n][k] = *(const PG8_LAS bf16x8*)(lds + PG8_SB(b, h) + boff + n * 2048 + k * 1024); } while (0)
#define PG8_MMA(ai, bj, At, Bt) do { __builtin_amdgcn_s_setprio(1); _Pragma("unroll") for (int m = 0; m < 4; ++m) _Pragma("unroll") for (int n = 0; n < 2; ++n) _Pragma("unroll") for (int k = 0; k < 2; ++k) \
        acc[ai][bj][m][n] = __builtin_amdgcn_mfma_f32_16x16x32_bf16(Bt[n][k], At[m][k], acc[ai][bj][m][n], 0, 0, 0); __builtin_amdgcn_s_setprio(0); } while (0)
#define PG8_WAIT_V(n) asm volatile("s_waitcnt vmcnt(" #n ")" ::: "memory")
#define PG8_WAIT_L(n) asm volatile("s_waitcnt lgkmcnt(" #n ")" ::: "memory")
#define PG8_BAR __builtin_amdgcn_s_barrier()
#define PG8_SCHED __builtin_amdgcn_sched_barrier(0)
    Unit cur, nxt; int ui = 0;
    if (!S.next(0, cur)) return;
    f32x4 acc[2][2][4][2];
#pragma unroll
    for (int a = 0; a < 2; ++a)
#pragma unroll
        for (int b = 0; b < 2; ++b)
#pragma unroll
            for (int m = 0; m < 4; ++m)
#pragma unroll
                for (int n = 0; n < 2; ++n) acc[a][b][m][n] = (f32x4){0.f, 0.f, 0.f, 0.f};
    bf16x8 At[4][2], B0[2][2], B1[2][2];
    unsigned c00, c01, c10, c11;
#define PG8_AOFF(u, d00, d01, d10, d11) do { \
        d00 = S.a_off(u, R0) + (unsigned)C0 * 2u; d01 = S.a_off(u, R1) + (unsigned)C1 * 2u; \
        d10 = S.a_off(u, HALF + R0) + (unsigned)C0 * 2u; d11 = S.a_off(u, HALF + R1) + (unsigned)C1 * 2u; } while (0)
    PG8_AOFF(cur, c00, c01, c10, c11);
    const char* cB = S.b_ptr(cur);
    PG8_STB(PG8_SB(0, 0), cB); PG8_STB(PG8_SB(0, 1), cB + hstepB); PG8_ST2(PG8_SA(0, 0), Ab, c00, c01); PG8_ST2(PG8_SA(0, 1), Ab, c10, c11);
    if (wr == 1) PG8_BAR;
    PG8_WAIT_V(2); PG8_BAR;
    PG8_STB(PG8_SB(1, 0), cB + kstep); PG8_ST2(PG8_SA(1, 0), Ab + kstep, c00, c01); PG8_STB(PG8_SB(1, 1), cB + hstepB + kstep);
    PG8_WAIT_V(6); PG8_BAR;
    for (;;) {
        const bool has_next = S.next(ui + 1, nxt);
        const char* nB = has_next ? S.b_ptr(nxt) : cB;
#pragma unroll 1
        for (int t = 0; t < nt; t += 2) {
            const bool last = (t == nt - 2);
            const char* a1 = Ab + (size_t)(t + 1) * kstep;
            const char* a2 = last ? Ab : Ab + (size_t)(t + 2) * kstep; const char* b2 = last ? nB : cB + (size_t)(t + 2) * kstep;
            const char* a3 = a2 + kstep; const char* b3 = b2 + kstep;
            PG8_LDB(B0, 0, 0); PG8_LDB(B1, 0, 1); PG8_SCHED; PG8_LDA(At, 0, 0); PG8_ST2(PG8_SA(1, 1), a1, c10, c11);
            PG8_WAIT_V(8); PG8_WAIT_L(0); PG8_BAR; PG8_MMA(0, 0, At, B0); PG8_MMA(0, 1, At, B1); PG8_BAR; PG8_SCHED;
            if (last && has_next) { PG8_AOFF(nxt, c00, c01, c10, c11); }
            PG8_LDA(At, 0, 1); PG8_STB(PG8_SB(0, 0), b2); PG8_STB(PG8_SB(0, 1), b2 + hstepB); PG8_ST2(PG8_SA(0, 0), a2, c00, c01);
            PG8_WAIT_V(8); PG8_WAIT_L(0); PG8_BAR; PG8_MMA(1, 0, At, B0); PG8_MMA(1, 1, At, B1); PG8_BAR; PG8_SCHED;
            PG8_LDB(B0, 1, 0); PG8_LDB(B1, 1, 1); PG8_SCHED; PG8_LDA(At, 1, 0); PG8_ST2(PG8_SA(0, 1), a2, c10, c11);
            PG8_WAIT_V(8); PG8_WAIT_L(0); PG8_BAR; PG8_MMA(0, 0, At, B0); PG8_MMA(0, 1, At, B1); PG8_BAR; PG8_SCHED;
            PG8_LDA(At, 1, 1); PG8_STB(PG8_SB(1, 0), b3); PG8_STB(PG8_SB(1, 1), b3 + hstepB); PG8_ST2(PG8_SA(1, 0), a3, c00, c01);
            PG8_WAIT_V(8); PG8_WAIT_L(0); PG8_BAR; PG8_MMA(1, 0, At, B0); PG8_MMA(1, 1, At, B1); PG8_BAR; PG8_SCHED;
        }
        if (wr == 0) PG8_BAR;
        E(acc, cur, wr, wc, fr, fq);
        if (!has_next) break;
#pragma unroll
        for (int a = 0; a < 2; ++a)
#pragma unroll
            for (int b = 0; b < 2; ++b)
#pragma unroll
                for (int m = 0; m < 4; ++m)
#pragma unroll
                    for (int n = 0; n < 2; ++n) acc[a][b][m][n] = (f32x4){0.f, 0.f, 0.f, 0.f};
        cur = nxt; cB = nB; ++ui;
        if (wr == 1) PG8_BAR;
    }
    PG8_WAIT_V(0);
    PG8_BAR;
#undef PG8_SA
#undef PG8_SB
#undef PG8_ST2
#undef PG8_STB
#undef PG8_LDA
#undef PG8_LDB
#undef PG8_MMA
#undef PG8_WAIT_V
#undef PG8_WAIT_L
#undef PG8_BAR
#undef PG8_SCHED
#undef PG8_AOFF
}
}

#define XB_TMO      128
#define XB_XCNT(j)  (256  + 64 * (j))
#define XB_XSUB(j)  (1280 + 64 * (j))
#define XB_XGEN(j)  (2304 + 64 * (j))
#define XB_TOP      3328
#define XB_TOPGEN   3392
#define XCD_BAR_WORDS 3456
#define XB_SPIN_CAP (1u << 22)

__device__ __forceinline__ unsigned xb_ld(unsigned* p)              { return __hip_atomic_load(p, __ATOMIC_RELAXED, __HIP_MEMORY_SCOPE_AGENT); }
__device__ __forceinline__ unsigned xb_add(unsigned* p, unsigned v) { return __hip_atomic_fetch_add(p, v, __ATOMIC_RELAXED, __HIP_MEMORY_SCOPE_AGENT); }
__device__ __forceinline__ unsigned xb_xcc_id() { return (unsigned)__builtin_amdgcn_s_getreg((3 << 11) | 20) & 0xFu; }
#define XB_SPIN(cond, bar) do { unsigned _sp = 0; while (cond) { __builtin_amdgcn_s_sleep(1); \
    if ((++_sp & 255u) == 0u) { if (xb_ld(&(bar)[XB_TMO])) break; if (_sp > XB_SPIN_CAP) { atomicAdd(&(bar)[XB_TMO], 1u); break; } } } } while (0)

struct XcdBarrier { unsigned* bar; unsigned x; volatile LAS unsigned* st; };

__device__ __forceinline__ XcdBarrier xcd_barrier_post(unsigned* bar, volatile LAS unsigned* st) {
    XcdBarrier b; b.bar = bar; b.x = xb_xcc_id(); b.st = st;
    if (threadIdx.x == 0) (void)xb_add(&bar[XB_XCNT(b.x)], 1u);
    return b;
}
__device__ __forceinline__ void xcd_barrier_complete(unsigned* bar, unsigned x, unsigned& nloc, unsigned& nx) {
    const unsigned G = gridDim.x * gridDim.y * gridDim.z;
    unsigned sum, cnt, mine, sp = 0u;
    for (;;) {
        sum = 0u; cnt = 0u; mine = 0u;
#pragma unroll
        for (unsigned j = 0; j < 16; ++j) { const unsigned c = xb_ld(&bar[XB_XCNT(j)]); sum += c; cnt += (c > 0u) ? 1u : 0u; mine = (j == x) ? c : mine; }
        if (sum == G) break;
        __builtin_amdgcn_s_sleep(1);
        if ((++sp & 255u) == 0u) { if (xb_ld(&bar[XB_TMO])) break; if (sp > XB_SPIN_CAP) { atomicAdd(&bar[XB_TMO], 1u); break; } }
    }
    nloc = mine > 0u ? mine : 1u; nx = cnt > 0u ? cnt : 1u;
}
__device__ __forceinline__ void xcd_barrier(const XcdBarrier& b) {
    asm volatile("s_waitcnt vmcnt(0)" ::: "memory");
    __syncthreads();
    if (threadIdx.x == 0) {
        unsigned* bar = b.bar;
        __builtin_amdgcn_s_waitcnt(0);
        unsigned nloc = b.st[0], nx = b.st[1];
        if (nloc == 0u) { xcd_barrier_complete(bar, b.x, nloc, nx); b.st[0] = nloc; b.st[1] = nx; }
        const unsigned old = xb_add(&bar[XB_XSUB(b.x)], 1u);
        const unsigned gen = old / nloc;
        if (old + 1u == (gen + 1u) * nloc) {
            __builtin_amdgcn_fence(__ATOMIC_RELEASE, "agent");
            asm volatile("s_waitcnt vmcnt(0)" ::: "memory");
            const unsigned og = xb_add(&bar[XB_TOP], 1u);
            const unsigned tg = og / nx;
            if (og + 1u == (tg + 1u) * nx) xb_add(&bar[XB_TOPGEN], 1u);
            else XB_SPIN(xb_ld(&bar[XB_TOPGEN]) == tg, bar);
            __builtin_amdgcn_fence(__ATOMIC_ACQUIRE, "agent");
            xb_add(&bar[XB_XGEN(b.x)], 1u);
            asm volatile("s_waitcnt vmcnt(0)" ::: "memory");
        } else {
            XB_SPIN(xb_ld(&bar[XB_XGEN(b.x)]) == gen, bar);
            __builtin_amdgcn_fence(__ATOMIC_ACQUIRE, "agent");
            asm volatile("s_waitcnt vmcnt(0)" ::: "memory");
        }
    }
    __syncthreads();
}

struct Frame {
    LAS unsigned char* lds;
    volatile LAS unsigned* MISC;
    gu32* ctl;
    int tid, lane, wave, vcu, G;
    const float* in[24];
    float* out;
    unsigned char* ws;
};
enum { I_X = 0, I_C, I_ADAW, I_ADAB, I_NMIX, I_NFFN, I_WIN, I_CONVW, I_ALOG, I_DTB, I_ONORM, I_SINKS, I_RELB, I_WOUT, I_POOLW, I_POOLS, I_R1W, I_R1B, I_R2W, I_R2B, I_WG, I_WU, I_WDN, I_FNW };

__device__ __forceinline__ void p0_transpose_item(const float* W, int ldw, int K, bf16* WT, int dst_row0, LAS float* scr, int k0, int n0, int lane) {
    f32x4 w4[8];
#pragma unroll
    for (int i = 0; i < 8; ++i) { const int f = i * 64 + lane, kk = f >> 3, c4 = f & 7; w4[i] = __builtin_nontemporal_load((const f32x4*)(W + (size_t)(k0 + kk) * ldw + n0 + c4 * 4)); }
#pragma unroll
    for (int i = 0; i < 8; ++i) { const int f = i * 64 + lane, kk = f >> 3, c4 = f & 7; LAS float* d = scr + kk * 33 + c4 * 4; d[0] = w4[i].x; d[1] = w4[i].y; d[2] = w4[i].z; d[3] = w4[i].w; }
    LDS_WAIT(); asm volatile("" ::: "memory");
    const int c = lane & 7;
#pragma unroll
    for (int j = 0; j < 4; ++j) { const int n = (lane >> 3) + 8 * j; const LAS float* s = scr + (8 * c) * 33 + n;
        v4u o; o.x = pk2(s[0 * 33], s[1 * 33]); o.y = pk2(s[2 * 33], s[3 * 33]); o.z = pk2(s[4 * 33], s[5 * 33]); o.w = pk2(s[6 * 33], s[7 * 33]);
        __builtin_nontemporal_store(o, (GAS v4u*)(WT + (size_t)(dst_row0 + n) * K + k0 + 8 * c)); }
    LDS_WAIT(); asm volatile("" ::: "memory");
}
constexpr int CQ_NG = NEXP * 512, CQ_NGT = 16 * 512, CQ_N = NEXP * 768;
constexpr int TQ_INPROJ = 11, TQ_GU = 6, TQ_DN = 4;
constexpr int IP_TILES = PIN / 256 - 2;
constexpr int IP_FULL = ((NTOK / 256) * IP_TILES) % 256;
constexpr int CQ_T2 = IP_FULL ? (256 - IP_FULL) * 8 * TQ_INPROJ : 0;
__device__ __forceinline__ void convert_item(Frame& F, int layer, int it, LAS float* scr) {
    if (it < CQ_NG) {
        const int e = it >> 9, r = it & 511, up = r >> 8, q = r & 255, kb = q >> 4, nb = q & 15;
        const float* W = (up ? F.in[I_WU] : F.in[I_WG]) + (size_t)(layer * NEXP + e) * 1024 * 512;
        p0_transpose_item(W, 512, 1024, (bf16*)(F.ws + ((layer && e < 16) ? WS_WGT : WS_WGU)), e * 1024 + (nb >> 2) * 256 + up * 128 + (nb & 3) * 32, scr, kb * 64, nb * 32, F.lane);
    } else {
        const int r0 = it - CQ_NG, e = r0 >> 8, q = r0 & 255, kb = q >> 5, nb = q & 31;
        const float* W = F.in[I_WDN] + (size_t)(layer * NEXP + e) * 512 * 1024;
        p0_transpose_item(W, 1024, 512, (bf16*)(F.ws + WS_WD), e * 1024 + nb * 32, scr, kb * 64, nb * 32, F.lane);
    }
}
__device__ __forceinline__ void convert_range(Frame& F, int layer, int first, int end, int start, int stride) {
    LAS float* scr = (LAS float*)(F.lds + RING_OFF + F.wave * 16384);
    for (int it = first + start; it < end; it += stride) convert_item(F, layer, it, scr);
}
__device__ __forceinline__ void p0_prologue(Frame& F) {
    LAS float* scr = (LAS float*)(F.lds + RING_OFF + F.wave * 16384);
    const int gw = F.vcu * NWAVES + F.wave, NGW = F.G * NWAVES;
    constexpr int IA = 16 * 64, IB = 16 * 24, IO = 16 * 32, IP = 4 * 32, NIT = IA + IB + IO + IP;
    for (int it = gw; it < NIT; it += NGW) {
        int r = it;
        if (r < IA) { p0_transpose_item(F.in[I_WIN], 2832, 1024, (bf16*)(F.ws + WS_WIN), (r % 64) * 32, scr, (r / 64) * 64, (r % 64) * 32, F.lane); continue; } r -= IA;
        if (r < IB) { p0_transpose_item(F.in[I_WIN] + 2064, 2832, 1024, (bf16*)(F.ws + WS_WIN), 2048 + (r % 24) * 32, scr, (r / 24) * 64, (r % 24) * 32, F.lane); continue; } r -= IB;
        if (r < IO) { p0_transpose_item(F.in[I_WOUT], 1024, 1024, (bf16*)(F.ws + WS_WOUT), (r % 32) * 32, scr, (r / 32) * 64, (r % 32) * 32, F.lane); continue; } r -= IO;
        { const int g = r >> 5, q = r & 31; p0_transpose_item(F.in[I_POOLW] + (size_t)g * 65536, 256, 256, (bf16*)(F.ws + WS_POOLW) + (size_t)g * 65536, (q & 7) * 32, scr, (q >> 3) * 64, (q & 7) * 32, F.lane); }
    }
    { float* WBA = (float*)(F.ws + WS_WBA); const int gt = F.vcu * 512 + F.tid;
      if (gt < 16 * 1024) { const int o = gt >> 10, k = gt & 1023; WBA[o * 1024 + k] = F.in[I_WIN][(size_t)k * 2832 + 2048 + o]; } }
    __syncthreads();
    {
        LAS float* red = (LAS float*)(F.lds + RING_OFF);
        const int ks = F.tid >> 4, cj = F.tid & 15;
        for (int u = F.vcu; u < 192; u += F.G) {
            const int l = u / 96, cb = u % 96;
            const float* W = F.in[I_ADAW] + (size_t)l * 1024 * 6144 + cb * 64 + cj * 4;
            f32x4 a0 = {0.f, 0.f, 0.f, 0.f}, a1 = {0.f, 0.f, 0.f, 0.f};
            for (int k = ks * 32; k < ks * 32 + 32; ++k) {
                const f32x4 w = *(const f32x4*)(W + (size_t)k * 6144);
                const float c0 = silu_f(F.in[I_C][k]), c1 = silu_f(F.in[I_C][1024 + k]);
                a0 += w * c0; a1 += w * c1;
            }
            *(LAS f32x4*)(red + (ks * 2 + 0) * 64 + cj * 4) = a0; *(LAS f32x4*)(red + (ks * 2 + 1) * 64 + cj * 4) = a1;
            __syncthreads();
            if (F.tid < 128) { const int b = F.tid >> 6, c = F.tid & 63; float s = 0.f;
                for (int q = 0; q < 32; ++q) s += red[(q * 2 + b) * 64 + c];
                ((float*)(F.ws + WS_MOD))[(size_t)(l * 2 + b) * 6144 + cb * 64 + c] = s + F.in[I_ADAB][l * 6144 + cb * 64 + c]; }
            __syncthreads();
        }
    }
}

struct RowVec { f32x4 v[4]; };
__device__ __forceinline__ RowVec load_row_f32(const float* row, int lane) { RowVec r; const GAS f32x4* p = (const GAS f32x4*)row + lane;
#pragma unroll
    for (int j = 0; j < 4; ++j) r.v[j] = p[64 * j]; return r; }
__device__ __forceinline__ void store_row_f32(float* row, int lane, const RowVec& r) { GAS f32x4* p = (GAS f32x4*)row + lane;
#pragma unroll
    for (int j = 0; j < 4; ++j) p[64 * j] = r.v[j]; }
__device__ __forceinline__ void store_row_bf16(bf16* row, int lane, const RowVec& r) { GAS v2u* p = (GAS v2u*)row + lane;
#pragma unroll
    for (int j = 0; j < 4; ++j) { v2u o; o.x = pk2(r.v[j].x, r.v[j].y); o.y = pk2(r.v[j].z, r.v[j].w); p[64 * j] = o; } }
__device__ __forceinline__ void load_row_bf16(const bf16* row, int lane, v2u (&p)[4]) { const GAS v2u* q = (const GAS v2u*)row + lane;
#pragma unroll
    for (int j = 0; j < 4; ++j) p[j] = q[64 * j]; }
__device__ __forceinline__ RowVec unpack_row_bf16(const v2u (&p)[4]) { RowVec r;
#pragma unroll
    for (int j = 0; j < 4; ++j) { r.v[j].x = bflo(p[j].x); r.v[j].y = bfhi(p[j].x); r.v[j].z = bflo(p[j].y); r.v[j].w = bfhi(p[j].y); } return r; }
__device__ __forceinline__ float row_rstd(const RowVec& r) { float s = 0.f;
#pragma unroll
    for (int j = 0; j < 4; ++j) s += (r.v[j].x * r.v[j].x + r.v[j].y * r.v[j].y) + (r.v[j].z * r.v[j].z + r.v[j].w * r.v[j].w);
    return 1.0f / sqrtf(wave_sum(s) * (1.f / D) + EPS); }
struct ModVec { f32x4 a[4], b[4]; };
__device__ __forceinline__ ModVec load_mod(const float* w, const float* sc, const float* sh, int lane) { ModVec m;
#pragma unroll
    for (int j = 0; j < 4; ++j) { const f32x4 wv = *((const f32x4*)w + lane + 64 * j), s = *((const f32x4*)sc + lane + 64 * j); m.a[j] = wv * (s + 1.0f); m.b[j] = *((const f32x4*)sh + lane + 64 * j); }
    return m; }
__device__ __forceinline__ RowVec apply_mod(const RowVec& x, float rstd, const ModVec& m) { RowVec h;
#pragma unroll
    for (int j = 0; j < 4; ++j) h.v[j] = x.v[j] * rstd * m.a[j] + m.b[j]; return h; }

__device__ __forceinline__ void p1_prenorm0(Frame& F) {
    LAS float* wba = (LAS float*)(F.lds + RING_OFF);
    { const float* WBA = (const float*)(F.ws + WS_WBA); for (int i = F.tid; i < 16 * 256; i += 512) *((LAS f32x4*)wba + i) = *((const f32x4*)WBA + i); }
    __syncthreads();
    const float* mod = (const float*)(F.ws + WS_MOD);
    bf16* H = (bf16*)(F.ws + WS_H); float* BG = (float*)(F.ws + WS_BG);
    const int tok0 = F.vcu * (NTOK / F.G) + F.wave * (NTOK / F.G / NWAVES), ntw = NTOK / F.G / NWAVES;
    const int b = tok0 / SEQ;
    const ModVec m = load_mod(F.in[I_NMIX], mod + (size_t)b * 6144 + 1024, mod + (size_t)b * 6144, F.lane);
    const int hh = F.lane & 7;
    const float nega = -__expf(F.in[I_ALOG][hh]), dtb = F.in[I_DTB][hh];
    RowVec xa = load_row_f32(F.in[I_X] + (size_t)tok0 * D, F.lane), xb = load_row_f32(F.in[I_X] + (size_t)(tok0 + 1) * D, F.lane);
    const LAS f32x4* wl = (const LAS f32x4*)wba + F.lane;
    for (int i = 0; i < ntw; i += 2) {
        const int t = tok0 + i;
        const RowVec x0 = xa, x1 = xb;
        if (i + 2 < ntw) { xa = load_row_f32(F.in[I_X] + (size_t)(t + 2) * D, F.lane); xb = load_row_f32(F.in[I_X] + (size_t)(t + 3) * D, F.lane); }
        const RowVec h0 = apply_mod(x0, row_rstd(x0), m), h1 = apply_mod(x1, row_rstd(x1), m);
        store_row_bf16(H + (size_t)t * D, F.lane, h0); store_row_bf16(H + (size_t)(t + 1) * D, F.lane, h1);
        float p0[16], p1[16]; f32x4 w[2][4];
#pragma unroll
        for (int j = 0; j < 4; ++j) w[0][j] = wl[64 * j];
#pragma unroll
        for (int o = 0; o < 16; ++o) {
            if (o + 1 < 16) {
#pragma unroll
                for (int j = 0; j < 4; ++j) w[(o + 1) & 1][j] = wl[(o + 1) * 256 + 64 * j]; }
            __builtin_amdgcn_sched_barrier(0);
            float s0 = 0.f, s1 = 0.f;
#pragma unroll
            for (int j = 0; j < 4; ++j) { const f32x4 ww = w[o & 1][j];
                s0 += (h0.v[j].x * ww.x + h0.v[j].y * ww.y) + (h0.v[j].z * ww.z + h0.v[j].w * ww.w); s1 += (h1.v[j].x * ww.x + h1.v[j].y * ww.y) + (h1.v[j].z * ww.z + h1.v[j].w * ww.w); }
            p0[o] = s0; p1[o] = s1;
            __builtin_amdgcn_sched_barrier(0); }
        const float mine0 = multi_sum16(p0, F.lane), mine1 = multi_sum16(p1, F.lane);
        if (F.lane < 8) { BG[(size_t)t * 16 + F.lane] = sigmoid_f(mine0); BG[(size_t)(t + 1) * 16 + F.lane] = sigmoid_f(mine1); }
        else if (F.lane < 16) { BG[(size_t)t * 16 + F.lane] = nega * softplus_f(mine0 + dtb); BG[(size_t)(t + 1) * 16 + F.lane] = nega * softplus_f(mine1 + dtb); }
    }
}

struct DenseSched {
    int nM, nN, nwg, G, c, gap_from, gap, L0, Lend; unsigned lda2, acol2; const char* B; size_t btile;
    __device__ __forceinline__ void init(int M, int N, int G_, int c_, int lda, int acolstride, const void* B_, int ldb) { nM = M / 256; nN = N / 256; nwg = nM * nN; G = G_; c = c_; gap_from = 1 << 30; gap = 0; L0 = 0; Lend = nwg; lda2 = (unsigned)lda * 2u; acol2 = (unsigned)acolstride * 2u; B = (const char*)B_; btile = (size_t)256 * ldb * 2; }
    __device__ __forceinline__ bool next(int i, pg8::Unit& u) const {
        const long L = (long)L0 + (long)i * G + c; if (L >= Lend) return false;
        int wgid = (int)L; { const int q = nwg / 8, r = nwg % 8, xcd = wgid % 8, off = wgid / 8; wgid = (xcd < r ? xcd * (q + 1) : r * (q + 1) + (xcd - r) * q) + off; }
        const int nig = 8 * nN, gid = wgid / nig, fm = gid * 8, gsz = (nM - fm) < 8 ? (nM - fm) : 8;
        u.pm = fm + ((wgid % nig) % gsz); u.pn = (wgid % nig) / gsz; u.pn += (u.pn >= gap_from) ? gap : 0; u.e = 0; return true;
    }
    __device__ __forceinline__ unsigned a_off(const pg8::Unit& u, int r) const { return (unsigned)(u.pm * 256 + r) * lda2 + (unsigned)u.pn * acol2; }
    __device__ __forceinline__ const char* b_ptr(const pg8::Unit& u) const { return B + (size_t)u.pn * btile; }
};
struct MoeSched {
    const LAS int* cnt; const LAS int* tbase; const LAS int* tileExp;
    int nunits, chunk, G, c, esplit; const int* RT; const char* B; const char* Blo; size_t bexp, btile; unsigned arow2;
    __device__ __forceinline__ void init(const LAS int* tables, int G_, int c_, const int* RT_, const void* B_, int ldb, int lda) {
        cnt = tables; tbase = tables + 32; tileExp = tables + 80; G = G_; c = c_; RT = RT_; B = (const char*)B_; Blo = B; esplit = 0; bexp = (size_t)1024 * ldb * 2; btile = (size_t)256 * ldb * 2; arow2 = (unsigned)lda * 2u;
        nunits = tbase[32] * 4; chunk = ((nunits + 7) / 8 + 3) & ~3;
    }
    __device__ __forceinline__ bool next(int i, pg8::Unit& u) const {
        const int w = i * (G / 8) + (c >> 3); if (w >= chunk) return false;
        const int L = (c & 7) * chunk + w; if (L >= nunits) return false;
        u.pm = L >> 2; u.pn = L & 3; u.e = tileExp[u.pm]; return true;
    }
    __device__ __forceinline__ unsigned a_off(const pg8::Unit& u, int r) const {
        if (RT) { const int pos = (u.pm - tbase[u.e]) * 256 + r; const int tok = pos < cnt[u.e] ? RT[u.e * NTOK + pos] : 0; return (unsigned)tok * arow2; }
        return (unsigned)(u.pm * 256 + r) * arow2;
    }
    __device__ __forceinline__ const char* b_ptr(const pg8::Unit& u) const { return (u.e < esplit ? Blo : B) + (size_t)u.e * bexp + (size_t)u.pn * btile; }
};
__device__ __forceinline__ void build_moe_tables(Frame& F, int layer) {
    LAS int* T = (LAS int*)(F.lds + SCHED_OFF);
    int tid_ = F.tid; asm volatile("" : "+v"(tid_));
    if (tid_ < 32) T[tid_] = (int)__hip_atomic_load(F.ctl + CW_CNT + 64 * layer + tid_, RLX_AGENT);
    __syncthreads();
    if (F.tid == 0) { int acc = 0; for (int e = 0; e < 32; ++e) { T[32 + e] = acc; const int nt = (T[e] + 255) >> 8; for (int j = 0; j < nt; ++j) T[80 + acc + j] = e; acc += nt; } T[64] = acc; }
    __syncthreads();
}

__device__ __forceinline__ int moe_units_of(int c, int G, int nunits, int chunk) {
    const int sl = c >> 3, x = c & 7, per = G / 8; int U = nunits - x * chunk; U = U < 0 ? 0 : (U > chunk ? chunk : U);
    return sl < U ? (U - sl + per - 1) / per : 0;
}
__device__ __forceinline__ void moe_tail_plan(Frame& F) {
    LAS int* T = (LAS int*)(F.lds + SCHED_OFF);
    if (F.tid == 0) { T[65] = 0; T[66] = 0; }
    __syncthreads();
    if (F.tid < 256) {
        const int nunits = T[64] * 4, chunk = ((nunits + 7) / 8 + 3) & ~3, per = F.G / 8, maxu = (chunk + per - 1) / per, c = (int)blockIdx.x;
        const int sp = F.tid < F.G ? maxu - moe_units_of(F.tid, F.G, nunits, chunk) : 0;
        const int lower = (int)wave_sum(F.tid < c ? (float)sp : 0.f), all = (int)wave_sum((float)sp);
        if (F.lane == 0) { atomicAdd((int*)(T + 65), lower); atomicAdd((int*)(T + 66), all); }
        if (F.tid == c) T[67] = sp;
    }
    __syncthreads();
}

struct EpiStoreBf16 {
    bf16* O; int ldc;
    __device__ __forceinline__ void operator()(const f32x4 (&acc)[2][2][4][2], const pg8::Unit& u, int wr, int wc, int fr, int fq) const {
        const int row0 = u.pm * 256 + wr * 64 + fr, col0 = u.pn * 256 + wc * 32 + 8 * fq;
#pragma unroll
        for (int ai = 0; ai < 2; ++ai)
#pragma unroll
            for (int m = 0; m < 4; ++m) { bf16* rowp = O + (size_t)(row0 + ai * 128 + m * 16) * ldc + col0;
#pragma unroll
                for (int bj = 0; bj < 2; ++bj) { const f32x4 v0 = acc[ai][bj][m][0], v1 = acc[ai][bj][m][1];
                    v4u w; w.x = pk2(v0[0], v0[1]); w.y = pk2(v0[2], v0[3]); w.z = pk2(v1[0], v1[1]); w.w = pk2(v1[2], v1[3]);
                    *(v4u*)(rowp + bj * 128) = w; } }
    }
};
template <bool F32SRC> struct EpiResid {
    const float* X; bf16* O; const float* cf; const float* mul;
    __device__ __forceinline__ void operator()(const f32x4 (&acc)[2][2][4][2], const pg8::Unit& u, int wr, int wc, int fr, int fq) const {
        const int row0 = u.pm * 256 + wr * 64 + fr, col0 = u.pn * 256 + wc * 32 + 8 * fq, b = (u.pm * 256) / SEQ;
        f32x4 c[2][2];
#pragma unroll
        for (int bj = 0; bj < 2; ++bj)
#pragma unroll
            for (int n = 0; n < 2; ++n) { c[bj][n] = *(const f32x4*)(cf + (size_t)b * 6144 + col0 + bj * 128 + 4 * n); if (mul) c[bj][n] *= *(const f32x4*)(mul + col0 + bj * 128 + 4 * n); }
#pragma unroll
        for (int ai = 0; ai < 2; ++ai)
#pragma unroll
            for (int m = 0; m < 4; ++m) { const size_t ro = (size_t)(row0 + ai * 128 + m * 16) * D + col0;
                f32x4 s[2][2];
                if (F32SRC) {
#pragma unroll
                    for (int bj = 0; bj < 2; ++bj) { s[bj][0] = *(const GAS f32x4*)(X + ro + bj * 128); s[bj][1] = *(const GAS f32x4*)(X + ro + bj * 128 + 4); }
                } else {
#pragma unroll
                    for (int bj = 0; bj < 2; ++bj) { const v4u q = *(const GAS v4u*)(O + ro + bj * 128);
                        s[bj][0].x = bflo(q.x); s[bj][0].y = bfhi(q.x); s[bj][0].z = bflo(q.y); s[bj][0].w = bfhi(q.y); s[bj][1].x = bflo(q.z); s[bj][1].y = bfhi(q.z); s[bj][1].z = bflo(q.w); s[bj][1].w = bfhi(q.w); }
                }
#pragma unroll
                for (int bj = 0; bj < 2; ++bj) { const f32x4 v0 = s[bj][0] + c[bj][0] * acc[ai][bj][m][0], v1 = s[bj][1] + c[bj][1] * acc[ai][bj][m][1];
                    v4u w; w.x = pk2(v0[0], v0[1]); w.y = pk2(v0[2], v0[3]); w.z = pk2(v1[0], v1[1]); w.w = pk2(v1[2], v1[3]);
                    *(v4u*)(O + ro + bj * 128) = w; } }
    }
};
struct EpiSwiglu {
    bf16* O;
    __device__ __forceinline__ void operator()(const f32x4 (&acc)[2][2][4][2], const pg8::Unit& u, int wr, int wc, int fr, int fq) const {
        const int row0 = u.pm * 256 + wr * 64 + fr, col0 = u.pn * 128 + wc * 32 + 8 * fq;
#pragma unroll
        for (int ai = 0; ai < 2; ++ai)
#pragma unroll
            for (int m = 0; m < 4; ++m) { bf16* rowp = O + (size_t)(row0 + ai * 128 + m * 16) * DFF + col0;
                float r[8];
#pragma unroll
                for (int n = 0; n < 2; ++n)
#pragma unroll
                    for (int j = 0; j < 4; ++j) r[4 * n + j] = silu_f(acc[ai][0][m][n][j]) * acc[ai][1][m][n][j];
                v4u w; w.x = pk2(r[0], r[1]); w.y = pk2(r[2], r[3]); w.z = pk2(r[4], r[5]); w.w = pk2(r[6], r[7]);
                *(v4u*)rowp = w; }
    }
};

__device__ __forceinline__ void moe_route(Frame& F, int layer) {
    LAS int* hist = (LAS int*)(F.lds + RT_LDS_OFF);
    LAS int* base = hist + 32;
    LAS int* tinfo = hist + 64;
    LAS float* tg = (LAS float*)(hist + 64 + 512);
    if (F.tid < 32) hist[F.tid] = 0;
    LAS f32x4* R2 = (LAS f32x4*)(F.lds + RING_OFF);
    LAS f32x4* R1 = (LAS f32x4*)(F.lds + R1W_OFF);
    { const f32x4* g2p = (const f32x4*)(F.in[I_R2W] + (size_t)layer * 1024 * 32); const f32x4* g1p = (const f32x4*)(F.in[I_R1W] + (size_t)layer * 1024 * 4);
      f32x4 t2[16], t1[2];
#pragma unroll
      for (int u = 0; u < 16; ++u) t2[u] = g2p[F.tid + 512 * u];
#pragma unroll
      for (int u = 0; u < 2; ++u) t1[u] = g1p[F.tid + 512 * u];
#pragma unroll
      for (int u = 0; u < 16; ++u) { const int i = F.tid + 512 * u, k = i >> 3, c4 = i & 7, ln = (k & 255) >> 2, q = k & 3, j = k >> 8; R2[((j * 4 + q) * 8 + c4) * 64 + ln] = t2[u]; }
#pragma unroll
      for (int u = 0; u < 2; ++u) { const int k = F.tid + 512 * u, ln = (k & 255) >> 2, q = k & 3, j = k >> 8; R1[(j * 4 + q) * 64 + ln] = t1[u]; } }
    __syncthreads();
    const float* mod = (const float*)(F.ws + WS_MOD) + (size_t)layer * 2 * 6144;
    bf16* H = (bf16*)(F.ws + WS_H);
    const int tokw = F.vcu * 128 + F.wave * 16, b = (F.vcu * 128) / SEQ;
    const ModVec m = load_mod(F.in[I_NFFN] + layer * D, mod + (size_t)b * 6144 + 4 * 1024, mod + (size_t)b * 6144 + 3 * 1024, F.lane);
    const float* r1b = F.in[I_R1B] + layer * 4; const float* r2b = F.in[I_R2B] + layer * 32;
    const bf16* XRB = (const bf16*)(F.ws + WS_XRB);
    v2u xbn[4], xb2[4];
    load_row_bf16(XRB + (size_t)tokw * D, F.lane, xbn); load_row_bf16(XRB + (size_t)(tokw + 1) * D, F.lane, xb2);
    f32x4 r1w[16];
#pragma unroll
    for (int k = 0; k < 16; ++k) r1w[k] = R1[k * 64 + F.lane];
    for (int i = 0; i < 16; ++i) {
        const int t = tokw + i;
        const RowVec x = unpack_row_bf16(xbn);
#pragma unroll
        for (int j = 0; j < 4; ++j) xbn[j] = xb2[j];
        if (i + 2 < 16) load_row_bf16(XRB + (size_t)(t + 2) * D, F.lane, xb2);
        RowVec h = apply_mod(x, row_rstd(x), m);
        store_row_bf16(H + (size_t)t * D, F.lane, h);
        f32x4 l1 = {0.f, 0.f, 0.f, 0.f};
#pragma unroll
        for (int j = 0; j < 4; ++j)
#pragma unroll
            for (int q = 0; q < 4; ++q) l1 += r1w[j * 4 + q] * h.v[j][q];
        float lg[4];
        { const float p4[4] = {l1[0], l1[1], l1[2], l1[3]}; const float r = multi_sum4(p4, F.lane);
#pragma unroll
          for (int g = 0; g < 4; ++g) lg[g] = rl(r, 4 * g) + r1b[g]; }
        int grp = 0; float mx = lg[0];
#pragma unroll
        for (int g = 1; g < 4; ++g) if (lg[g] > mx) { mx = lg[g]; grp = g; }
        float se = 0.f;
#pragma unroll
        for (int g = 0; g < 4; ++g) se += __expf(lg[g] - mx);
        const float ptop = 1.0f / se;
        grp = __builtin_amdgcn_readfirstlane(grp);
        f32x4 a0 = {0.f, 0.f, 0.f, 0.f}, a1 = {0.f, 0.f, 0.f, 0.f};
        { const LAS f32x4* wg = R2 + (grp * 2) * 64 + F.lane;
#pragma unroll
          for (int hb = 0; hb < 2; ++hb) { f32x4 w2[16];
#pragma unroll
              for (int k = 0; k < 8; ++k) { w2[2 * k] = wg[((hb * 8 + k) * 8) * 64]; w2[2 * k + 1] = wg[((hb * 8 + k) * 8 + 1) * 64]; }
              __builtin_amdgcn_sched_barrier(0);
#pragma unroll
              for (int k = 0; k < 8; ++k) { const float hv = h.v[(hb * 8 + k) >> 2][(hb * 8 + k) & 3]; a0 += w2[2 * k] * hv; a1 += w2[2 * k + 1] * hv; }
              __builtin_amdgcn_sched_barrier(0); } }
        float l2[8];
        { const float p8[8] = {a0[0], a0[1], a0[2], a0[3], a1[0], a1[1], a1[2], a1[3]}; const float r = multi_sum8(p8, F.lane);
#pragma unroll
          for (int q = 0; q < 8; ++q) l2[q] = rl(r, 2 * q) + r2b[grp * 8 + q]; }
        int i0 = 0; float v0 = l2[0];
#pragma unroll
        for (int q = 1; q < 8; ++q) if (l2[q] > v0) { v0 = l2[q]; i0 = q; }
        int i1 = (i0 == 0) ? 1 : 0; float v1 = l2[i1 == 1 ? 1 : 0];
#pragma unroll
        for (int q = 0; q < 8; ++q) if (q != i0 && l2[q] > v1) { v1 = l2[q]; i1 = q; }
        const float g0 = ptop / (1.0f + __expf(v1 - v0)), g1 = ptop - g0;
        if (F.lane == 0) { const int e0 = grp * 8 + i0, e1 = grp * 8 + i1, li = F.wave * 16 + i;
            tinfo[li * 4 + 0] = e0; tinfo[li * 4 + 1] = e1; tinfo[li * 4 + 2] = atomicAdd((int*)(hist + e0), 1); tinfo[li * 4 + 3] = atomicAdd((int*)(hist + e1), 1);
            tg[li * 2] = g0; tg[li * 2 + 1] = g1;
            { float* GA = (float*)(F.ws + WS_BG); GA[(size_t)t * 2] = g0; GA[(size_t)t * 2 + 1] = g1; }
        }
    }
    __syncthreads();
    if (F.tid < 32) base[F.tid] = (int)__hip_atomic_fetch_add(F.ctl + CW_CNT + 64 * layer + F.tid, (unsigned)hist[F.tid], RLX_AGENT);
    __syncthreads();
    if (F.tid < 128) { const int t = F.vcu * 128 + F.tid; const int e0 = tinfo[F.tid * 4], e1 = tinfo[F.tid * 4 + 1];
        const int p0 = base[e0] + tinfo[F.tid * 4 + 2], p1 = base[e1] + tinfo[F.tid * 4 + 3];
        int* RT = (int*)(F.ws + WS_RT); RT[e0 * NTOK + p0] = t; RT[e1 * NTOK + p1] = t;
        v4u r0; r0.x = e0; r0.y = e1; r0.z = p0; r0.w = p1; v4u r1; r1.x = __builtin_bit_cast(unsigned, tg[F.tid * 2]); r1.y = __builtin_bit_cast(unsigned, tg[F.tid * 2 + 1]); r1.z = 0; r1.w = 0;
        v4u* RO = (v4u*)(F.ws + WS_ROUTE) + (size_t)t * 2; RO[0] = r0; (void)r1; }
    __syncthreads();
}

struct CombRows { v2u xb[4], ya[4], yb[4]; };
struct CombRecs { v4u rec; float ga, gb; };
__device__ __forceinline__ CombRecs comb_load_recs(Frame& F, int tokw) { CombRecs c; const int t = tokw + (F.lane & 15);
    c.rec = *((const v4u*)(F.ws + WS_ROUTE) + (size_t)t * 2); const float* GA = (const float*)(F.ws + WS_BG); c.ga = GA[(size_t)t * 2]; c.gb = GA[(size_t)t * 2 + 1]; return c; }
__device__ __forceinline__ int rl_i(int v, int l) { return __builtin_amdgcn_readlane(v, l); }
__device__ __forceinline__ void comb_issue(Frame& F, const CombRecs& c, int i, int t, CombRows& r) {
    const LAS int* T = (const LAS int*)(F.lds + SCHED_OFF);
    const int e0 = rl_i((int)c.rec.x, i), e1 = rl_i((int)c.rec.y, i), p0 = rl_i((int)c.rec.z, i), p1 = rl_i((int)c.rec.w, i);
    const size_t rowa = (size_t)T[32 + e0] * 256 + p0, rowb = (size_t)T[32 + e1] * 256 + p1;
    const bf16* Y = (const bf16*)(F.ws + WS_Y);
    const GAS v2u* ya = (const GAS v2u*)(Y + rowa * D) + F.lane; const GAS v2u* yb = (const GAS v2u*)(Y + rowb * D) + F.lane;
    load_row_bf16((const bf16*)(F.ws + WS_XRB) + (size_t)t * D, F.lane, r.xb);
#pragma unroll
    for (int j = 0; j < 4; ++j) { r.ya[j] = ya[64 * j]; r.yb[j] = yb[64 * j]; }
}
__device__ __forceinline__ RowVec comb_finish(const CombRecs& c, int i, const CombRows& r, const f32x4 (&g2)[4]) {
    const float ga = rl(c.ga, i), gb = rl(c.gb, i); RowVec x = unpack_row_bf16(r.xb);
#pragma unroll
    for (int j = 0; j < 4; ++j) { const v2u a = r.ya[j], bq = r.yb[j];
        f32x4 s; s.x = ga * bflo(a.x) + gb * bflo(bq.x); s.y = ga * bfhi(a.x) + gb * bfhi(bq.x); s.z = ga * bflo(a.y) + gb * bflo(bq.y); s.w = ga * bfhi(a.y) + gb * bfhi(bq.y);
        x.v[j] += g2[j] * s; }
    return x;
}

__device__ __forceinline__ void attn_phase(Frame& F, const int u_first, const int u_stride) {
    LAS bf16* KS = (LAS bf16*)(F.lds + RING_OFF);
    LAS bf16* VT = (LAS bf16*)(F.lds + RING_OFF + 36864);
    LAS float* BT = (LAS float*)(F.lds + RING_OFF + 36864 + 33280);
    const bf16* PROJ = (const bf16*)(F.ws + WS_PROJ); bf16* OAB = (bf16*)(F.ws + WS_OAB);
    const int lane = F.lane, lc = lane & 31, lh = lane >> 5;
    for (int unit = u_first; unit < 512; unit += u_stride) {
        const int b = unit >> 8, kvh = (unit >> 7) & 1, qb = unit & 127, t0 = qb * 128;
        __syncthreads();
        for (int i = F.tid; i < 4 * 192; i += 512) { const int hq = i / 192, x = i - hq * 192, dist = 159 - x; float v = 0.f;
            if (dist >= 0 && dist < 128) { int bk = dist; if (dist >= 16) { bk = 16 + (int)(logf((float)dist / 16.0f) / 2.0794415416798357f * 16.0f); bk = bk > 31 ? 31 : bk; }
                v = F.in[I_RELB][bk * 8 + kvh * 4 + hq] * 1.4426950408889634f; }
            BT[i] = v; }
#pragma unroll
        for (int cc = 0; cc < 4; ++cc) { const int ch = F.tid + 512 * cc, key = ch >> 3, part = ch & 7, tl = t0 - 128 + key;
            v4u kv = {0u, 0u, 0u, 0u}, vv = {0u, 0u, 0u, 0u};
            if (tl >= 0) { const bf16* rp = PROJ + (size_t)(b * SEQ + tl) * PIN; kv = *(const v4u*)(rp + PC_KB + kvh * 64 + part * 8); vv = *(const v4u*)(rp + PC_VB + kvh * 64 + part * 8); }
            *(LAS v4u*)(KS + key * 72 + part * 8) = kv;
            const unsigned w[4] = {vv.x, vv.y, vv.z, vv.w};
#pragma unroll
            for (int q = 0; q < 4; ++q) { VT[(part * 8 + 2 * q) * 260 + key] = (bf16)(w[q] & 0xffffu); VT[(part * 8 + 2 * q + 1) * 260 + key] = (bf16)(w[q] >> 16); } }
        __syncthreads();
#pragma unroll 1
        for (int tt = 0; tt < 2; ++tt) {
            const int task = F.wave * 2 + tt, hq = task >> 2, qt = task & 3, qh = kvh * 4 + hq;
            const int qi = 32 * qt + lc;
            const bf16* qrow = PROJ + (size_t)(b * SEQ + t0 + qi) * PIN + PC_QB + qh * 64 + 8 * lh;
            bf16x8 qf[4];
#pragma unroll
            for (int s = 0; s < 4; ++s) qf[s] = *(const bf16x8*)(qrow + 16 * s);
            f32x16 sc[5];
#pragma unroll
            for (int kt = 0; kt < 5; ++kt) {
#pragma unroll
                for (int r = 0; r < 16; ++r) sc[kt][r] = 0.f;
                const LAS bf16* kp = KS + (32 * (qt + kt) + lc) * 72 + 8 * lh;
#pragma unroll
                for (int s = 0; s < 4; ++s) { const bf16x8 kf = *(const LAS bf16x8*)(kp + 16 * s); sc[kt] = __builtin_amdgcn_mfma_f32_32x32x16_bf16(kf, qf[s], sc[kt], 0, 0, 0); }
            }
            const float sink2 = F.in[I_SINKS][qh] * 1.4426950408889634f;
            const LAS float* bp = BT + hq * 192 + (4 * lh - lc + 31);
            const int m_lo = lc + 1 - 4 * lh, m_hi = lc - 4 * lh;
            float mx = sink2;
#pragma unroll
            for (int kt = 0; kt < 5; ++kt) {
                const bool dead = (t0 == 0) && (qt + kt < 4);
#pragma unroll
                for (int r = 0; r < 16; ++r) { const int cr = (r & 3) + 8 * (r >> 2);
                    float v = sc[kt][r] * (0.125f * 1.4426950408889634f) + bp[32 * kt + cr];
                    if (kt == 0) v = (cr >= m_lo) ? v : -1e30f;
                    if (kt == 4) v = (cr <= m_hi) ? v : -1e30f;
                    if (dead) v = -1e30f;
                    sc[kt][r] = v; mx = fmaxf(mx, v); } }
            mx = fmaxf(mx, __shfl_xor(mx, 32));
            float den = 0.f;
#pragma unroll
            for (int kt = 0; kt < 5; ++kt)
#pragma unroll
                for (int r = 0; r < 16; ++r) { const float p = __builtin_amdgcn_exp2f(sc[kt][r] - mx); sc[kt][r] = p; den += p; }
            den += __shfl_xor(den, 32);
            den += __builtin_amdgcn_exp2f(sink2 - mx);
            const float inv = 1.0f / den;
            f32x16 oa[2];
#pragma unroll
            for (int dt = 0; dt < 2; ++dt)
#pragma unroll
                for (int r = 0; r < 16; ++r) oa[dt][r] = 0.f;
#pragma unroll
            for (int kt = 0; kt < 5; ++kt)
#pragma unroll
                for (int s2 = 0; s2 < 2; ++s2) {
                    v4u pw; pw.x = pk2(sc[kt][8 * s2 + 0], sc[kt][8 * s2 + 1]); pw.y = pk2(sc[kt][8 * s2 + 2], sc[kt][8 * s2 + 3]); pw.z = pk2(sc[kt][8 * s2 + 4], sc[kt][8 * s2 + 5]); pw.w = pk2(sc[kt][8 * s2 + 6], sc[kt][8 * s2 + 7]);
                    const bf16x8 pf = __builtin_bit_cast(bf16x8, pw);
#pragma unroll
                    for (int dt = 0; dt < 2; ++dt) { const LAS bf16* vp = VT + (32 * dt + lc) * 260 + 32 * (qt + kt) + 16 * s2 + 4 * lh;
                        const v2u va = *(const LAS v2u*)vp, vb = *(const LAS v2u*)(vp + 8);
                        v4u vw; vw.x = va.x; vw.y = va.y; vw.z = vb.x; vw.w = vb.y;
                        oa[dt] = __builtin_amdgcn_mfma_f32_32x32x16_bf16(__builtin_bit_cast(bf16x8, vw), pf, oa[dt], 0, 0, 0); }
                }
            bf16* orow = OAB + (size_t)(b * SEQ + t0 + qi) * D + 512 + qh * 64 + 4 * lh;
#pragma unroll
            for (int dt = 0; dt < 2; ++dt)
#pragma unroll
                for (int rg = 0; rg < 4; ++rg) { v2u o; o.x = pk2(oa[dt][4 * rg] * inv, oa[dt][4 * rg + 1] * inv); o.y = pk2(oa[dt][4 * rg + 2] * inv, oa[dt][4 * rg + 3] * inv);
                    *(v2u*)(orow + 32 * dt + 8 * rg) = o; }
        }
    }
    __syncthreads();
}


constexpr int DN_ST = 72;

__device__ __forceinline__ bf16x8 pack8(const f32x16& x, int s) { v4u p; p.x = pk2(x[8 * s], x[8 * s + 1]); p.y = pk2(x[8 * s + 2], x[8 * s + 3]); p.z = pk2(x[8 * s + 4], x[8 * s + 5]); p.w = pk2(x[8 * s + 6], x[8 * s + 7]); return __builtin_bit_cast(bf16x8, p); }
__device__ __forceinline__ f32x16 dn_tile(const LAS bf16* A, int ra, const LAS bf16* B, int rb, int lc, int lh) {
    f32x16 acc;
#pragma unroll
    for (int r = 0; r < 16; ++r) acc[r] = 0.f;
#pragma unroll
    for (int s = 0; s < 4; ++s) { const bf16x8 a = *(const LAS bf16x8*)(A + (ra + lc) * DN_ST + 16 * s + 8 * lh), b = *(const LAS bf16x8*)(B + (rb + lc) * DN_ST + 16 * s + 8 * lh);
        acc = __builtin_amdgcn_mfma_f32_32x32x16_bf16(a, b, acc, 0, 0, 0); }
    return acc;
}
__device__ __forceinline__ void dn_prep(Frame& F) {
    LAS bf16* Qs = (LAS bf16*)(F.lds + RING_OFF);
    LAS bf16* Ks = Qs + 64 * DN_ST;
    LAS bf16* KBs = Ks + 64 * DN_ST;
    LAS bf16* Vs = KBs + 64 * DN_ST;
    LAS bf16* KDT = Vs + 64 * DN_ST;
    LAS bf16* AQK = KDT + 64 * DN_ST;
    LAS bf16* UT = AQK + 64 * DN_ST;
    LAS bf16* WT = UT + 64 * DN_ST;
    LAS bf16* LNO = WT + 64 * DN_ST;
    LAS float* LD = (LAS float*)(LNO + 64 * DN_ST);
    LAS bf16* TDZ = (LAS bf16*)(LD + 64 * 16);
    LAS float* GB = (LAS float*)(TDZ + 64 * 24);
    const bf16* PROJ = (const bf16*)(F.ws + WS_PROJ); const float* BG = (const float*)(F.ws + WS_BG);
    const int tid = F.tid, lane = F.lane, lc = lane & 31, lh = lane >> 5, wave = F.wave;
    LAS float* CW = GB + 256;
    { f32x4 tc[3];
#pragma unroll
      for (int u = 0; u < 3; ++u) tc[u] = *((const f32x4*)F.in[I_CONVW] + tid + 512 * u);
#pragma unroll
      for (int u = 0; u < 3; ++u) *((LAS f32x4*)CW + tid + 512 * u) = tc[u]; }
    LAS v4u* RAW = (LAS v4u*)(F.lds + R1W_OFF);
    constexpr int RAW_CH = 67 * 24;
#define DN_RAW_SRC(i_, b_, h_, n_) ({ const int r_ = (i_) / 24, c_ = (i_) - r_ * 24; const int tl_ = (n_) * 64 - 3 + r_; \
        tl_ >= 0 ? (const v4u*)(PROJ + ((size_t)(b_) * SEQ + tl_) * PIN + (c_ < 8 ? PC_QA : c_ < 16 ? PC_KA : PC_VA) + (h_) * 64 + (c_ & 7) * 8) : (const v4u*)nullptr; })
    { const int u0 = F.vcu, b = u0 >> 11, h = (u0 >> 8) & 7, n = u0 & 255;
      for (int i = tid; i < RAW_CH; i += 512) { const v4u* sp = DN_RAW_SRC(i, b, h, n); v4u z = {0u, 0u, 0u, 0u}; if (sp) z = *sp; RAW[i] = z; }
      if (wave == 0) { const size_t row0 = (size_t)b * SEQ + (size_t)n * 64; float c = BG[(row0 + lane) * 16 + 8 + h];
#pragma unroll
          for (int o = 1; o < 64; o <<= 1) { const float up = __shfl_up(c, o); if (lane >= o) c += up; }
          GB[lane] = c; GB[64 + lane] = BG[(row0 + lane) * 16 + h]; } }
    int par = 0;
    for (int unit = F.vcu; unit < 4096; unit += F.G, par ^= 1) {
        const int b = unit >> 11, h = (unit >> 8) & 7, n = unit & 255;
        LAS float* gcs = GB + par * 128; LAS float* bts = gcs + 64;
        const int un = unit + F.G; const bool more = un < 4096; const int bn = un >> 11, hn = (un >> 8) & 7, nn = un & 255;
        __syncthreads();
        { const int t = tid >> 3, cs = tid & 7;
          float q[8], k[8], v[8];
#pragma unroll
          for (int e = 0; e < 8; ++e) { q[e] = 0.f; k[e] = 0.f; v[e] = 0.f; }
#pragma unroll
          for (int j = 0; j < 4; ++j) { { const LAS v4u* rp = RAW + (t + j) * 24 + cs;
                const v4u wq = rp[0], wk = rp[8], wv = rp[16];
                const LAS float* cw = CW + j * 1536 + h * 64 + cs * 8;
                const unsigned uq[4] = {wq.x, wq.y, wq.z, wq.w}, uk[4] = {wk.x, wk.y, wk.z, wk.w}, uv[4] = {wv.x, wv.y, wv.z, wv.w};
#pragma unroll
                for (int e = 0; e < 4; ++e) { q[2 * e] += cw[2 * e] * bflo(uq[e]); q[2 * e + 1] += cw[2 * e + 1] * bfhi(uq[e]);
                    k[2 * e] += cw[512 + 2 * e] * bflo(uk[e]); k[2 * e + 1] += cw[512 + 2 * e + 1] * bfhi(uk[e]);
                    v[2 * e] += cw[1024 + 2 * e] * bflo(uv[e]); v[2 * e + 1] += cw[1024 + 2 * e + 1] * bfhi(uv[e]); } } }
          float sq = 0.f, sk = 0.f;
#pragma unroll
          for (int e = 0; e < 8; ++e) { q[e] = silu_f(q[e]); k[e] = silu_f(k[e]); v[e] = silu_f(v[e]); sq += q[e] * q[e]; sk += k[e] * k[e]; }
          sq = oct_sum(sq); sk = oct_sum(sk);
          const float rq = 0.125f / sqrtf(sq + EPS), rk = 1.0f / sqrtf(sk + EPS), bt = bts[t], kd = __expf(gcs[63] - gcs[t]);
          v4u oq, ok, ob, ov;
          oq.x = pk2(q[0] * rq, q[1] * rq); oq.y = pk2(q[2] * rq, q[3] * rq); oq.z = pk2(q[4] * rq, q[5] * rq); oq.w = pk2(q[6] * rq, q[7] * rq);
#pragma unroll
          for (int e = 0; e < 8; ++e) k[e] *= rk;
          ok.x = pk2(k[0], k[1]); ok.y = pk2(k[2], k[3]); ok.z = pk2(k[4], k[5]); ok.w = pk2(k[6], k[7]);
          ob.x = pk2(k[0] * bt, k[1] * bt); ob.y = pk2(k[2] * bt, k[3] * bt); ob.z = pk2(k[4] * bt, k[5] * bt); ob.w = pk2(k[6] * bt, k[7] * bt);
          ov.x = pk2(v[0], v[1]); ov.y = pk2(v[2], v[3]); ov.z = pk2(v[4], v[5]); ov.w = pk2(v[6], v[7]);
          *(LAS v4u*)(Qs + t * DN_ST + cs * 8) = oq; *(LAS v4u*)(Ks + t * DN_ST + cs * 8) = ok; *(LAS v4u*)(KBs + t * DN_ST + cs * 8) = ob; *(LAS v4u*)(Vs + t * DN_ST + cs * 8) = ov;
#pragma unroll
          for (int e = 0; e < 8; ++e) KDT[(cs * 8 + e) * DN_ST + t] = (bf16)f2bf(k[e] * kd); }
        __syncthreads();
        v4u pf[7]; float pg = 0.f, pb = 0.f;
        if (wave >= 4 && more) {
#pragma unroll
            for (int k7 = 0; k7 < 7; ++k7) { const int i = (tid - 256) + 256 * k7; pf[k7] = (v4u){0u, 0u, 0u, 0u}; if (i < RAW_CH) { const v4u* sp = DN_RAW_SRC(i, bn, hn, nn); if (sp) pf[k7] = *sp; } }
            if (wave == 4) { const size_t rn = (size_t)bn * SEQ + (size_t)nn * 64; pg = BG[(rn + lane) * 16 + 8 + hn]; pb = BG[(rn + lane) * 16 + hn]; }
        }
        { const int it = (wave >> 1) & 1, jt = wave & 1; const bool qk = wave >= 4;
          f32x16 acc;
          if (it >= jt) acc = dn_tile(qk ? Qs : KBs, 32 * it, Ks, 32 * jt, lc, lh);
          const int j = 32 * jt + lc; const float gj = gcs[j];
#pragma unroll
          for (int r = 0; r < 16; ++r) { const int i = 32 * it + (r & 3) + 8 * (r >> 2) + 4 * lh;
              float val = 0.f;
              if (it >= jt) { if (qk ? (i >= j) : (i > j)) val = acc[r] * __expf(gcs[i] - gj); }
              if (qk) AQK[i * DN_ST + j] = (bf16)f2bf(val);
              else { const bool diag = (i >> 4) == (j >> 4); LNO[i * DN_ST + j] = (bf16)f2bf(diag ? 0.f : -val); if (diag) LD[i * 16 + (j & 15)] = val; } } }
        __syncthreads();
        if (wave == 0) { const int bb = lane >> 4, c = lane & 15; float tcol[16];
#pragma unroll
            for (int i = 0; i < 16; ++i) { float v = (i == c) ? 1.f : 0.f;
#pragma unroll
                for (int j4 = 0; j4 < (i + 3) / 4; ++j4) { const f32x4 a = *(const LAS f32x4*)(LD + (16 * bb + i) * 16 + 4 * j4);
#pragma unroll
                    for (int e = 0; e < 4; ++e) if (4 * j4 + e < i) v -= a[e] * tcol[4 * j4 + e]; }
                tcol[i] = v; TDZ[(16 * bb + i) * 24 + c] = (bf16)f2bf(v); } }
        __syncthreads();
        if (wave < 4) {
            const int ct = wave, cc = 32 * (ct & 1) + lc; const bool isw = ct >= 2;
            f32x16 acc[2];
#pragma unroll
            for (int rt = 0; rt < 2; ++rt)
#pragma unroll
                for (int r = 0; r < 16; ++r) { const int t = 32 * rt + (r & 3) + 8 * (r >> 2) + 4 * lh;
                    acc[rt][r] = isw ? bf2f(Ks[t * DN_ST + cc]) * bts[t] * __expf(gcs[t]) : bf2f(Vs[t * DN_ST + cc]) * bts[t]; }
#define DN_AFRAG(arr, stride, row, kb) ({ const LAS bf16* p_ = (arr) + (row) * (stride) + 16 * (kb) + 4 * lh; const v2u lo_ = *(const LAS v2u*)p_, hi_ = *(const LAS v2u*)(p_ + 8); v4u w_; w_.x = lo_.x; w_.y = lo_.y; w_.z = hi_.x; w_.w = hi_.y; __builtin_bit_cast(bf16x8, w_); })
            f32x16 X[4];
#pragma unroll
            for (int bb = 0; bb < 4; ++bb) { const int rt = bb >> 1, odd = bb & 1;
                bf16x8 ta = DN_AFRAG(TDZ, 24, 32 * rt + lc, 0);
                if ((lc >> 4) != odd) ta = (bf16x8){0, 0, 0, 0, 0, 0, 0, 0};
                f32x16 z;
#pragma unroll
                for (int r = 0; r < 16; ++r) z[r] = 0.f;
                z = __builtin_amdgcn_mfma_f32_32x32x16_bf16(ta, pack8(acc[rt], odd), z, 0, 0, 0);
                X[bb] = z;
                const bf16x8 xb = pack8(z, odd);
                if (bb == 0) { acc[0] = __builtin_amdgcn_mfma_f32_32x32x16_bf16(DN_AFRAG(LNO, DN_ST, lc, 0), xb, acc[0], 0, 0, 0); acc[1] = __builtin_amdgcn_mfma_f32_32x32x16_bf16(DN_AFRAG(LNO, DN_ST, 32 + lc, 0), xb, acc[1], 0, 0, 0); }
                if (bb == 1) { acc[1] = __builtin_amdgcn_mfma_f32_32x32x16_bf16(DN_AFRAG(LNO, DN_ST, 32 + lc, 1), xb, acc[1], 0, 0, 0); }
                if (bb == 2) { acc[1] = __builtin_amdgcn_mfma_f32_32x32x16_bf16(DN_AFRAG(LNO, DN_ST, 32 + lc, 2), xb, acc[1], 0, 0, 0); }
            }
#undef DN_AFRAG
            LAS bf16* dst = (isw ? WT : UT) + cc * DN_ST;
#pragma unroll
            for (int bb = 0; bb < 4; ++bb)
#pragma unroll
                for (int g = 0; g < 2; ++g) { const int r0 = 8 * (bb & 1) + 4 * g; v2u o; o.x = pk2(X[bb][r0], X[bb][r0 + 1]); o.y = pk2(X[bb][r0 + 2], X[bb][r0 + 3]);
                    *(LAS v2u*)(dst + 16 * bb + 8 * g + 4 * lh) = o; }
        } else if (more) {
#pragma unroll
            for (int k7 = 0; k7 < 7; ++k7) { const int i = (tid - 256) + 256 * k7; if (i < RAW_CH) RAW[i] = pf[k7]; }
            if (wave == 4) { float c = pg;
#pragma unroll
                for (int o = 1; o < 64; o <<= 1) { const float up = __shfl_up(c, o); if (lane >= o) c += up; }
                GB[(par ^ 1) * 128 + lane] = c; GB[(par ^ 1) * 128 + 64 + lane] = pb; }
        }
        __syncthreads();
        { bf16* MT = (bf16*)((unsigned char*)F.out + OUT_DN_MT) + (size_t)unit * 4096; bf16* QPT = (bf16*)((unsigned char*)F.out + OUT_DN_QPT) + (size_t)unit * 4096;
          bf16* BM = (bf16*)(F.ws + WS_DN_BM) + (size_t)unit * 4096; bf16* O0T = (bf16*)(F.ws + WS_DN_O0T) + (size_t)unit * 4096;
#pragma unroll 1
          for (int tt = 0; tt < 2; ++tt) { const int task = wave * 2 + tt, p = task >> 2, ta = (task >> 1) & 1, tb = task & 1;
              if (p == 0) {
                  f32x16 acc = dn_tile(WT, 32 * ta, KDT, 32 * tb, lc, lh);
#pragma unroll
                  for (int r = 0; r < 16; ++r) acc[r] = -acc[r];
#pragma unroll
                  for (int s2 = 0; s2 < 2; ++s2) *(bf16x8*)(MT + ((((tb * 2 + ta) * 2 + s2) * 64 + lane) * 8)) = pack8(acc, s2);
              } else if (p == 1) {
                  const f32x16 acc = dn_tile(KDT, 32 * ta, UT, 32 * tb, lc, lh);
#pragma unroll
                  for (int s2 = 0; s2 < 2; ++s2) *(bf16x8*)(BM + ((((tb * 2 + ta) * 2 + s2) * 64 + lane) * 8)) = pack8(acc, s2);
              } else if (p == 2) {
                  f32x16 acc = dn_tile(WT, 32 * ta, AQK, 32 * tb, lc, lh);
                  const int i = 32 * tb + lc; const float eg = __expf(gcs[i]);
#pragma unroll
                  for (int r = 0; r < 16; ++r) { const int a = 32 * ta + (r & 3) + 8 * (r >> 2) + 4 * lh; acc[r] = bf2f(Qs[i * DN_ST + a]) * eg - acc[r]; }
#pragma unroll
                  for (int s2 = 0; s2 < 2; ++s2) *(bf16x8*)(QPT + ((((tb * 2 + ta) * 2 + s2) * 64 + lane) * 8)) = pack8(acc, s2);
              } else {
                  const f32x16 acc = dn_tile(UT, 32 * ta, AQK, 32 * tb, lc, lh);
#pragma unroll
                  for (int s2 = 0; s2 < 2; ++s2) *(bf16x8*)(O0T + ((((tb * 2 + ta) * 2 + s2) * 64 + lane) * 8)) = pack8(acc, s2);
              } }
          if (tid == 0) ((float*)(F.ws + WS_DN_GT))[unit] = __expf(gcs[63]); }
    }
#undef DN_RAW_SRC
    __syncthreads();
}
template <int r>
__device__ __forceinline__ void dn_scan_wave(Frame& F) {
    const int bx = (int)blockIdx.x, w = (bx & 7) * 4 + (bx >> 3), bh = w >> 1, ct = w & 1, lane = F.lane;
    const bf16x8* MT = (const bf16x8*)((const unsigned char*)F.out + OUT_DN_MT); const bf16x8* BM = (const bf16x8*)(F.ws + WS_DN_BM); bf16x8* SS = (bf16x8*)(F.ws + WS_DN_S);
    const float* GT = (const float*)(F.ws + WS_DN_GT);
    LAS bf16x8* MB = (LAS bf16x8*)(F.lds + RING_OFF);
    volatile LAS int* FL = (volatile LAS int*)(F.lds + LDSCTL_OFF + 64);
    f32x16 S;
#pragma unroll
    for (int q = 0; q < 16; ++q) S[q] = 0.f;
    bf16x8 mA[4], bA[2], mB[4], bB[2], mC[4], bC[2], mD[4], bD[2], mE[4], bE[2], mG[4], bG[2]; float gA, gB, gC, gD, gE, gG;
#define DN_SLOAD(m, bm, gt, u) do { const size_t ub = (size_t)(u) * 512; _Pragma("unroll") for (int f = 0; f < 4; ++f) m[f] = MT[ub + (r * 4 + f) * 64 + lane]; \
        _Pragma("unroll") for (int f = 0; f < 2; ++f) bm[f] = BM[ub + ((ct * 2 + r) * 2 + f) * 64 + lane]; gt = GT[u]; } while (0)
#define DN_STEP(cm, cb, cg, unit, n) do { \
        bf16x8 own[2]; own[0] = pack8(S, 0); own[1] = pack8(S, 1); \
        LAS bf16x8* mb = MB + ((n) & 1) * 256; \
        mb[(r * 2 + 0) * 64 + lane] = own[0]; mb[(r * 2 + 1) * 64 + lane] = own[1]; \
        asm volatile("s_waitcnt lgkmcnt(0)" ::: "memory"); \
        if (lane == 0) FL[r] = (n) + 1; \
        SS[(size_t)(unit) * 512 + (ct * 4 + r * 2 + 0) * 64 + lane] = own[0]; SS[(size_t)(unit) * 512 + (ct * 4 + r * 2 + 1) * 64 + lane] = own[1]; \
        f32x16 A; \
        { const v4u b0 = __builtin_bit_cast(v4u, cb[0]), b1 = __builtin_bit_cast(v4u, cb[1]); const unsigned u0[8] = {b0.x, b0.y, b0.z, b0.w, b1.x, b1.y, b1.z, b1.w}; \
          _Pragma("unroll") for (int e = 0; e < 8; ++e) { A[2 * e] = cg * S[2 * e] + bflo(u0[e]); A[2 * e + 1] = cg * S[2 * e + 1] + bfhi(u0[e]); } } \
        while (FL[1 - r] < (n) + 1) { } \
        asm volatile("" ::: "memory"); \
        bf16x8 oth[2]; oth[0] = mb[((1 - r) * 2 + 0) * 64 + lane]; oth[1] = mb[((1 - r) * 2 + 1) * 64 + lane]; \
          \
        _Pragma("unroll") for (int s2 = 0; s2 < 2; ++s2) { A = __builtin_amdgcn_mfma_f32_32x32x16_bf16(cm[r * 2 + s2], own[s2], A, 0, 0, 0); A = __builtin_amdgcn_mfma_f32_32x32x16_bf16(cm[(1 - r) * 2 + s2], oth[s2], A, 0, 0, 0); } \
        S = A; } while (0)
    const int u0 = bh * 256;
    DN_SLOAD(mA, bA, gA, u0); DN_SLOAD(mB, bB, gB, u0 + 1); DN_SLOAD(mC, bC, gC, u0 + 2); DN_SLOAD(mD, bD, gD, u0 + 3); DN_SLOAD(mE, bE, gE, u0 + 4); DN_SLOAD(mG, bG, gG, u0 + 5);
    for (int n = 0; n < 252; n += 6) {
        DN_STEP(mA, bA, gA, u0 + n, n);         DN_SLOAD(mA, bA, gA, u0 + n + 6);
        DN_STEP(mB, bB, gB, u0 + n + 1, n + 1); DN_SLOAD(mB, bB, gB, u0 + n + 7);
        DN_STEP(mC, bC, gC, u0 + n + 2, n + 2); DN_SLOAD(mC, bC, gC, u0 + n + 8);
        DN_STEP(mD, bD, gD, u0 + n + 3, n + 3); DN_SLOAD(mD, bD, gD, u0 + n + 9);
        DN_STEP(mE, bE, gE, u0 + n + 4, n + 4); if (n + 10 < 256) DN_SLOAD(mE, bE, gE, u0 + n + 10);
        DN_STEP(mG, bG, gG, u0 + n + 5, n + 5); if (n + 11 < 256) DN_SLOAD(mG, bG, gG, u0 + n + 11);
    }
    DN_STEP(mA, bA, gA, u0 + 252, 252); DN_STEP(mB, bB, gB, u0 + 253, 253); DN_STEP(mC, bC, gC, u0 + 254, 254); DN_STEP(mD, bD, gD, u0 + 255, 255);
#undef DN_SLOAD
#undef DN_STEP
}
__device__ __forceinline__ void dn_scan(Frame& F) {
    if ((int)blockIdx.x >= 32) return;
    if (F.wave == 0) dn_scan_wave<0>(F); else if (F.wave == 1) dn_scan_wave<1>(F);
}
__device__ __forceinline__ void dn_output(Frame& F) {
    const bf16x8* QPT = (const bf16x8*)((const unsigned char*)F.out + OUT_DN_QPT); const bf16x8* O0T = (const bf16x8*)(F.ws + WS_DN_O0T); const bf16x8* SS = (const bf16x8*)(F.ws + WS_DN_S);
    const bf16* PROJ = (const bf16*)(F.ws + WS_PROJ); bf16* OAB = (bf16*)(F.ws + WS_OAB);
    const int lane = F.lane, lc = lane & 31, lh = lane >> 5; int nbad = 0; (void)nbad;
    for (int task = F.vcu * NWAVES + F.wave; task < 8192; task += F.G * NWAVES) {
        const int unit = task >> 1, it = task & 1, b = unit >> 11, h = (unit >> 8) & 7, n = unit & 255;
        const size_t ub = (size_t)unit * 512;
        f32x16 o[2];
#pragma unroll
        for (int ct = 0; ct < 2; ++ct) {
            const v4u c0 = __builtin_bit_cast(v4u, O0T[ub + ((it * 2 + ct) * 2 + 0) * 64 + lane]), c1 = __builtin_bit_cast(v4u, O0T[ub + ((it * 2 + ct) * 2 + 1) * 64 + lane]);
            const unsigned u[8] = {c0.x, c0.y, c0.z, c0.w, c1.x, c1.y, c1.z, c1.w};
#pragma unroll
            for (int e = 0; e < 8; ++e) { o[ct][2 * e] = bflo(u[e]); o[ct][2 * e + 1] = bfhi(u[e]); }
#pragma unroll
            for (int at = 0; at < 2; ++at)
#pragma unroll
                for (int s2 = 0; s2 < 2; ++s2) o[ct] = __builtin_amdgcn_mfma_f32_32x32x16_bf16(SS[ub + (ct * 4 + at * 2 + s2) * 64 + lane], QPT[ub + ((it * 2 + at) * 2 + s2) * 64 + lane], o[ct], 0, 0, 0);
        }
        float ss = 0.f;
#pragma unroll
        for (int ct = 0; ct < 2; ++ct)
#pragma unroll
            for (int r = 0; r < 16; ++r) ss += o[ct][r] * o[ct][r];
        ss += __shfl_xor(ss, 32);
        const float rs = 1.0f / sqrtf(ss * (1.0f / 64.0f) + EPS);
        const size_t row = (size_t)b * SEQ + (size_t)n * 64 + it * 32 + lc;
#pragma unroll
        for (int ct = 0; ct < 2; ++ct)
#pragma unroll
            for (int rg = 0; rg < 4; ++rg) { const int c0 = 32 * ct + 8 * rg + 4 * lh;
                const v2u zz = *(const v2u*)(PROJ + row * PIN + PC_ZA + h * 64 + c0); const f32x4 ow = *(const f32x4*)(F.in[I_ONORM] + c0);
                const float z0 = bflo(zz.x), z1 = bfhi(zz.x), z2 = bflo(zz.y), z3 = bfhi(zz.y);
                v2u ov; ov.x = pk2(o[ct][4 * rg] * rs * ow[0] * silu_f(z0), o[ct][4 * rg + 1] * rs * ow[1] * silu_f(z1)); ov.y = pk2(o[ct][4 * rg + 2] * rs * ow[2] * silu_f(z2), o[ct][4 * rg + 3] * rs * ow[3] * silu_f(z3));
                *(v2u*)(OAB + row * D + h * 64 + c0) = ov;
            }
    }
}

template <int WIN>
__device__ __forceinline__ void pooled_block(const bf16* H, bf16* P, const int t0, const int tl0, const int col) {
    v4u r[WIN - 1 + 8];
#pragma unroll
    for (int j = 0; j < WIN - 1 + 8; ++j) { const int dt = j - (WIN - 1); r[j] = (v4u){0u, 0u, 0u, 0u}; if (tl0 + dt >= 0) r[j] = *(const v4u*)(H + (size_t)(t0 + dt) * D + col); }
    float s[8];
#pragma unroll
    for (int q = 0; q < 8; ++q) s[q] = 0.f;
#define POOL_ACC(sgn, VV) do { const v4u q_ = (VV); s[0] += sgn bflo(q_.x); s[1] += sgn bfhi(q_.x); s[2] += sgn bflo(q_.y); s[3] += sgn bfhi(q_.y); s[4] += sgn bflo(q_.z); s[5] += sgn bfhi(q_.z); s[6] += sgn bflo(q_.w); s[7] += sgn bfhi(q_.w); } while (0)
#pragma unroll
    for (int j = 0; j < WIN - 1; ++j) POOL_ACC(+, r[j]);
#pragma unroll
    for (int i = 0; i < 8; ++i) { const v4u self = r[WIN - 1 + i]; POOL_ACC(+, self);
        const int n = (tl0 + i + 1) < WIN ? (tl0 + i + 1) : WIN; const float inv = 1.0f / (float)n;
        v4u o; o.x = pk2(s[0] * inv - bflo(self.x), s[1] * inv - bfhi(self.x)); o.y = pk2(s[2] * inv - bflo(self.y), s[3] * inv - bfhi(self.y));
        o.z = pk2(s[4] * inv - bflo(self.z), s[5] * inv - bfhi(self.z)); o.w = pk2(s[6] * inv - bflo(self.w), s[7] * inv - bfhi(self.w));
        *(v4u*)(P + (size_t)(t0 + i) * D + col) = o;
        POOL_ACC(-, r[i]); }
#undef POOL_ACC
}
__device__ __forceinline__ void pooled_phase(Frame& F) {
    const bf16* H = (const bf16*)(F.ws + WS_H); bf16* P = (bf16*)(F.ws + WS_OAB);
    const int gt = F.vcu * 512 + F.tid, NT = F.G * 512;
    for (int it = gt; it < (NTOK / 8) * 128; it += NT) {
        const int c = it & 31, g = __builtin_amdgcn_readfirstlane((it >> 6) & 3), tb = ((it >> 8) << 1) | ((it >> 5) & 1);
        const int t0 = tb * 8, tl0 = t0 & (SEQ - 1), col = g * 256 + c * 8;
        if (g == 0) pooled_block<2>(H, P, t0, tl0, col); else if (g == 1) pooled_block<4>(H, P, t0, tl0, col); else if (g == 2) pooled_block<8>(H, P, t0, tl0, col); else pooled_block<16>(H, P, t0, tl0, col);
    }
}


#ifndef PH_MASK
#define PH_MASK 0xFFFFFF
#endif
#define IN(k) (((PH_MASK >> (k)) & 1) && lo <= (k) && (k) < hi)
#define BOTH(k) (IN(k) && IN((k) + 1))
#if MK_ONE_LAUNCH
#define GRID_BAR() xcd_barrier(bar)
#else
#define GRID_BAR() do { } while (0)
#endif
template <int LAYER>
__device__ __forceinline__ void moe_phases(Frame& F, const XcdBarrier& bar, const int lo, const int hi) {
    constexpr int pb = LAYER == 0 ? 7 : 13;
    bf16* const H = (bf16*)(F.ws + WS_H);
    const float* const MOD = (const float*)(F.ws + WS_MOD);
    if (IN(pb)) {
        moe_route(F, LAYER); if (BOTH(pb)) GRID_BAR(); }
    if (IN(pb + 1)) {
        build_moe_tables(F, LAYER);
        pg8::Gemm g{(const bf16*)H, 1024, 1024}; MoeSched S; S.init((const LAS int*)(F.lds + SCHED_OFF), F.G, (int)blockIdx.x, (const int*)(F.ws + WS_RT), F.ws + WS_WGU, 1024, 1024);
        EpiSwiglu E{(bf16*)(F.ws + WS_ACT)};
        if (LAYER == 1) { S.Blo = (const char*)(F.ws + WS_WGT); S.esplit = 16; }
        moe_tail_plan(F);
        pg8::gemm_phase<EpiSwiglu, MoeSched>(F.lds + RING_OFF, g, S, E);
        {
            const LAS int* T = (const LAS int*)(F.lds + SCHED_OFF); const int sp = T[67];
            const int q0 = LAYER == 0 ? 0 : CQ_NG, q1 = LAYER == 0 ? CQ_NGT : CQ_N;
            if (sp > 0) { __syncthreads(); const int f = q0 + T[65] * 8 * TQ_GU; int e = f + sp * 8 * TQ_GU; e = e < q1 ? e : q1; convert_range(F, 1, f, e, F.wave, 8); }
            if (LAYER == 1) { int t = q0 + T[66] * 8 * TQ_GU;
                if (t < q1) { __syncthreads(); convert_range(F, 1, t, q1, F.vcu * NWAVES + F.wave, F.G * NWAVES); } } }
        if (BOTH(pb + 1)) GRID_BAR();
    }
    if (IN(pb + 2)) {
        build_moe_tables(F, LAYER);
        pg8::Gemm g{(const bf16*)(F.ws + WS_ACT), 512, 512}; MoeSched S; S.init((const LAS int*)(F.lds + SCHED_OFF), F.G, (int)blockIdx.x, nullptr, F.ws + WS_WD, 512, 512);
        EpiStoreBf16 E{(bf16*)(F.ws + WS_Y), D};
        if (LAYER == 0) moe_tail_plan(F);
        pg8::gemm_phase<EpiStoreBf16, MoeSched>(F.lds + RING_OFF, g, S, E);
        if (LAYER == 0) {
            const LAS int* T = (const LAS int*)(F.lds + SCHED_OFF); const int sp = T[67];
            int t8 = T[66] * 8 * TQ_GU; t8 = t8 < CQ_NGT ? t8 : CQ_NGT;
            if (sp > 0) { __syncthreads(); const int f = t8 + T[65] * 8 * TQ_DN; int e = f + sp * 8 * TQ_DN; e = e < CQ_NG ? e : CQ_NG; convert_range(F, 1, f, e, F.wave, 8); } }
        if (BOTH(pb + 2)) GRID_BAR();
    }
    if (IN(pb + 3)) {
        build_moe_tables(F, LAYER);
        if (LAYER == 0) moe_tail_plan(F);
        const int tokw = F.vcu * 128 + F.wave * 16, b = (F.vcu * 128) / SEQ;
        f32x4 g2[4];
#pragma unroll
        for (int j = 0; j < 4; ++j) g2[j] = *((const f32x4*)(MOD + (size_t)(LAYER * 2 + b) * 6144 + 5 * 1024) + F.lane + 64 * j);
        if (LAYER == 0) {
            const ModVec m1 = load_mod(F.in[I_NMIX] + D, MOD + (size_t)(2 + b) * 6144 + 1024, MOD + (size_t)(2 + b) * 6144, F.lane);
            { const CombRecs recs = comb_load_recs(F, tokw); CombRows cur, nxt; comb_issue(F, recs, 0, tokw, cur);
              for (int i = 0; i < 16; ++i) { const int t = tokw + i;
                  if (i + 1 < 16) comb_issue(F, recs, i + 1, t + 1, nxt);
                  const RowVec x = comb_finish(recs, i, cur, g2);
                  store_row_bf16((bf16*)(F.ws + WS_XRB) + (size_t)t * D, F.lane, x); store_row_bf16(H + (size_t)t * D, F.lane, apply_mod(x, row_rstd(x), m1));
                  cur = nxt; } }
            __syncthreads();
            { const LAS int* T = (const LAS int*)(F.lds + SCHED_OFF);
              int t8 = T[66] * 8 * TQ_GU; t8 = t8 < CQ_NGT ? t8 : CQ_NGT; int t9 = t8 + T[66] * 8 * TQ_DN; t9 = t9 < CQ_NG ? t9 : CQ_NG;
              convert_range(F, 1, t9, CQ_NG, F.vcu * NWAVES + F.wave, F.G * NWAVES); }
        } else {
            f32x4 fw[4];
#pragma unroll
            for (int j = 0; j < 4; ++j) fw[j] = *((const f32x4*)F.in[I_FNW] + F.lane + 64 * j);
            { const CombRecs recs = comb_load_recs(F, tokw); CombRows cur, nxt; comb_issue(F, recs, 0, tokw, cur);
              for (int i = 0; i < 16; ++i) { const int t = tokw + i;
                  if (i + 1 < 16) comb_issue(F, recs, i + 1, t + 1, nxt);
                  RowVec x = comb_finish(recs, i, cur, g2); const float rstd = row_rstd(x);
#pragma unroll
                  for (int j = 0; j < 4; ++j) x.v[j] = x.v[j] * rstd * fw[j];
                  store_row_f32(F.out + (size_t)t * D, F.lane, x);
                  cur = nxt; } }
        }
        if (BOTH(pb + 3)) GRID_BAR();
    }
}

constexpr int PH_P0 = 0, PH_P1 = 1, PH_INPROJ = 2, PH_ATT = 3, PH_SCAN = 4, PH_DNOUT = 5, PH_OUTPROJ = 6, PH_MOE0 = 7, PH_POOLED = 11, PH_POOLG = 12, PH_MOE1 = 13;
constexpr int N_PHASES = 17;
struct Args { const float* in[24]; float* out; unsigned char* ws; int ph_lo, ph_hi; };
__global__ void __launch_bounds__(NWAVES * 64, 2) trunk_fwd(Args args) {
    __shared__ __attribute__((aligned(16))) unsigned char lds[LDS_BYTES];
    Frame F;
    F.lds = (LAS unsigned char*)lds;
    F.MISC = (volatile LAS unsigned*)(F.lds + MISC_OFF);
    F.tid = threadIdx.x; F.lane = F.tid & 63; F.wave = __builtin_amdgcn_readfirstlane(F.tid >> 6);
    F.G = gridDim.x; { const int bx = blockIdx.x; F.vcu = (F.G % 8 == 0) ? (bx % 8) * (F.G / 8) + bx / 8 : bx; }
#pragma unroll
    for (int i = 0; i < 24; ++i) F.in[i] = args.in[i];
    F.out = args.out; F.ws = args.ws; F.ctl = (gu32*)(args.ws + WS_CTL);
    for (int u = F.tid; u < (LDS_BYTES - LDSCTL_OFF) / 4; u += NWAVES * 64) ((LAS unsigned*)(F.lds + LDSCTL_OFF))[u] = 0u;
    __syncthreads();
#if MK_ONE_LAUNCH
    XcdBarrier bar = xcd_barrier_post((unsigned*)(F.ctl + CW_BAR), F.MISC + 8);
#else
    XcdBarrier bar; bar.bar = nullptr; bar.x = 0; bar.st = nullptr;
#endif
    const int lo = args.ph_lo, hi = args.ph_hi;

    bf16* const H = (bf16*)(F.ws + WS_H);
    const float* const MOD = (const float*)(F.ws + WS_MOD);

    if (IN(PH_P0)) { p0_prologue(F); if (BOTH(PH_P0)) GRID_BAR(); }
    if (IN(PH_P1)) { p1_prenorm0(F); if (BOTH(PH_P1)) GRID_BAR(); }
    if (IN(PH_INPROJ)) {
        pg8::Gemm g{(const bf16*)H, 1024, 1024}; DenseSched S; S.init(NTOK, IP_TILES * 256, F.G, (int)blockIdx.x, 1024, 0, F.ws + WS_WIN, 1024); S.gap_from = PC_ZA / 256; S.gap = 2;
        EpiStoreBf16 E{(bf16*)(F.ws + WS_PROJ), PIN};
        pg8::gemm_phase<EpiStoreBf16, DenseSched>(F.lds + RING_OFF, g, S, E);
        if (IP_FULL && (int)blockIdx.x >= IP_FULL) {
            __syncthreads(); const int r = (int)blockIdx.x - IP_FULL; convert_range(F, 0, r * 8 * TQ_INPROJ, (r + 1) * 8 * TQ_INPROJ, F.wave, 8); }
        if (BOTH(PH_INPROJ)) GRID_BAR();
    }
    if (IN(PH_ATT)) { dn_prep(F); if (BOTH(PH_ATT)) GRID_BAR(); }
    if (IN(PH_SCAN)) {
        if ((int)blockIdx.x < 32) dn_scan(F);
        else { const int o = (int)blockIdx.x - 32, NO = F.G - 32;
            attn_phase(F, o, NO); __syncthreads();
            { pg8::Gemm g{(const bf16*)H, 1024, 1024}; EpiStoreBf16 E{(bf16*)(F.ws + WS_PROJ), PIN};
              DenseSched S; S.init(NTOK, 512, NO, o, 1024, 0, F.ws + WS_WIN, 1024); S.gap_from = 0; S.gap = PC_ZA / 256; S.Lend = NO;
              pg8::gemm_phase<EpiStoreBf16, DenseSched>(F.lds + RING_OFF, g, S, E);
              if (o >= 64 && o < 64 + (S.nwg - NO)) { __syncthreads(); S.L0 = NO; S.G = S.nwg - NO; S.c = o - 64; S.Lend = S.nwg;
                  pg8::gemm_phase<EpiStoreBf16, DenseSched>(F.lds + RING_OFF, g, S, E); } }
            __syncthreads();
            { const int q = o < 64 ? 6 : o < 96 ? 4 : 9, off = o < 64 ? 48 * o : o < 96 ? 3072 + 32 * (o - 64) : 4096 + 72 * (o - 96);
              convert_range(F, 0, CQ_T2 + off, CQ_T2 + off + 8 * q, F.wave, 8);
              convert_range(F, 0, CQ_T2 + 4096 + 72 * 128, CQ_N, o * NWAVES + F.wave, NO * NWAVES); } }
        if (BOTH(PH_SCAN)) GRID_BAR(); }
    if (IN(PH_DNOUT)) { dn_output(F); if (BOTH(PH_DNOUT)) GRID_BAR(); }
    if (IN(PH_OUTPROJ)) {
        pg8::Gemm g{(const bf16*)(F.ws + WS_OAB), 1024, 1024}; DenseSched S; S.init(NTOK, D, F.G, (int)blockIdx.x, 1024, 0, F.ws + WS_WOUT, 1024);
        EpiResid<true> E{F.in[I_X], (bf16*)(F.ws + WS_XRB), MOD + 2 * 1024, nullptr};
        pg8::gemm_phase<EpiResid<true>, DenseSched>(F.lds + RING_OFF, g, S, E);
        if (BOTH(PH_OUTPROJ)) GRID_BAR();
    }
    moe_phases<0>(F, bar, lo, hi);
    if (IN(PH_POOLED)) { pooled_phase(F); if (BOTH(PH_POOLED)) GRID_BAR(); }
    if (IN(PH_POOLG)) {
        pg8::Gemm g{(const bf16*)(F.ws + WS_OAB), 256, 256}; DenseSched S; S.init(NTOK, D, F.G, (int)blockIdx.x, 1024, 256, F.ws + WS_POOLW, 256);
        EpiResid<false> E{nullptr, (bf16*)(F.ws + WS_XRB), MOD + (size_t)2 * 6144 + 2 * 1024, F.in[I_POOLS]};
        pg8::gemm_phase<EpiResid<false>, DenseSched>(F.lds + RING_OFF, g, S, E);
        if (BOTH(PH_POOLG)) GRID_BAR();
    }
    moe_phases<1>(F, bar, lo, hi);
#undef IN
#undef BOTH
}

extern "C" void kernel_launch(void* const* d_in, const int* in_sizes, int n_in, void* d_out, int out_size, void* d_ws, size_t ws_size, hipStream_t stream) {
    static int grid = 0;
    if (grid == 0) {
        if (n_in != 24 || in_sizes[0] != NTOK * D || out_size != NTOK * D || ws_size < WS_END2) { fprintf(stderr, "kernel_launch: unexpected shapes (n_in %d, in0 %d, out %d, ws %zu); nothing launched\n", n_in, n_in > 0 ? in_sizes[0] : -1, out_size, ws_size); grid = -1; return; }
        int per_cu = 0;
        if (hipOccupancyMaxActiveBlocksPerMultiprocessor(&per_cu, (const void*)trunk_fwd, NWAVES * 64, 0) != hipSuccess || per_cu < 1) fprintf(stderr, "kernel_launch: occupancy query says %d\n", per_cu);
        (void)hipGetLastError();
        grid = 256;
    }
    if (grid < 0) return;
    if (hipMemsetAsync((char*)d_ws + WS_CTL, 0, CTL_ZERO_BYTES, stream) != hipSuccess) { fprintf(stderr, "kernel_launch: memset failed\n"); return; }
    Args a{};
    for (int i = 0; i < 24; ++i) a.in[i] = (const float*)d_in[i];
    a.out = (float*)d_out; a.ws = (unsigned char*)d_ws;
#if MK_ONE_LAUNCH
    a.ph_lo = 0; a.ph_hi = N_PHASES;
    hipLaunchKernelGGL(trunk_fwd, dim3(grid), dim3(NWAVES * 64), 0, stream, a);
#else
    for (int p = 0; p < N_PHASES; ++p) { a.ph_lo = p; a.ph_hi = p + 1; hipLaunchKernelGGL(trunk_fwd, dim3(grid), dim3(NWAVES * 64), 0, stream, a); }
#endif
}
```

```cpp
#include <hip/hip_runtime.h>
#include <cstdio>
#include <cstdint>

#ifndef MK_ONE_LAUNCH
#define MK_ONE_LAUNCH 1
#endif

#define GAS __attribute__((address_space(1)))
#define LAS __attribute__((address_space(3)))
typedef unsigned short bf16;
typedef unsigned v4u __attribute__((ext_vector_type(4)));
typedef unsigned v2u __attribute__((ext_vector_type(2)));
typedef float f32x4 __attribute__((ext_vector_type(4)));
typedef float f32x2 __attribute__((ext_vector_type(2)));
typedef float f32x16 __attribute__((ext_vector_type(16)));
typedef short bf16x8 __attribute__((ext_vector_type(8)));
typedef GAS unsigned gu32;
#define RLX_AGENT __ATOMIC_RELAXED, __HIP_MEMORY_SCOPE_AGENT
#define LDS_WAIT() asm volatile("s_waitcnt lgkmcnt(0)" ::: "memory")
#define VM_WAIT() asm volatile("s_waitcnt vmcnt(0)" ::: "memory")

constexpr int BATCH = 2, SEQ = 16384, D = 1024, NTOK = BATCH * SEQ;
constexpr int PIN = 2816;
constexpr int PC_QA = 0, PC_KA = 512, PC_VA = 1024, PC_ZA = 1536, PC_QB = 2048, PC_KB = 2560, PC_VB = 2688;
constexpr int NEXP = 32, DFF = 512;
constexpr int MAXTILES = NTOK * 2 / 256 + NEXP;
constexpr float EPS = 1e-6f;
constexpr int NWAVES = 8;

constexpr size_t MiB = 1u << 20;
constexpr size_t WS_CTL = 0, CTL_ZERO_BYTES = 1 * MiB;
constexpr size_t WS_MOD = 1 * MiB;
constexpr size_t WS_WBA = 1 * MiB + 128 * 1024;
constexpr size_t WS_ROUTE = 2 * MiB;
constexpr size_t WS_RT = 3 * MiB;
constexpr size_t WS_BG = 7 * MiB;
constexpr size_t WS_WIN = 10 * MiB;
constexpr size_t WS_WOUT = 16 * MiB;
constexpr size_t WS_POOLW = 18 * MiB;
constexpr size_t WS_WGU = 20 * MiB;
constexpr size_t WS_WD = 84 * MiB;
constexpr size_t WS_H = 116 * MiB;
constexpr size_t WS_PROJ = 180 * MiB;
constexpr size_t WS_OAB = 356 * MiB;
constexpr size_t WS_YM = 180 * MiB;
constexpr size_t WS_ACT = 180 * MiB;
constexpr size_t WS_Y = 252 * MiB;
constexpr size_t WS_END = 420 * MiB;
constexpr size_t OUT_DN_MT = 0, OUT_DN_QPT = 32 * MiB;
constexpr size_t WS_DN_BM = 420 * MiB, WS_DN_O0T = 452 * MiB, WS_DN_S = 484 * MiB;
constexpr size_t WS_DN_GT = 9 * MiB;
constexpr size_t WS_XRB = 420 * MiB;
constexpr size_t WS_WGT = 484 * MiB;
constexpr size_t WS_END2 = 516 * MiB;
constexpr int CW_CNT = 64;
constexpr int CW_BAR = 4096;
constexpr int CW_BAD = 200;

constexpr int RING_OFF = 0, RING_BYTES = 131072;
constexpr int LDSCTL_OFF = RING_BYTES, MISC_OFF = LDSCTL_OFF + 320;
constexpr int SCHED_OFF = LDSCTL_OFF + 1024;
constexpr int LDS_BYTES = 163840;
constexpr int R1W_OFF = 135168;
constexpr int RT_LDS_OFF = 151552;

typedef __bf16 bf16x2_t __attribute__((ext_vector_type(2)));
__device__ __forceinline__ unsigned pk2(float lo, float hi) { bf16x2_t v; v.x = (__bf16)lo; v.y = (__bf16)hi; return __builtin_bit_cast(unsigned, v); }
__device__ __forceinline__ unsigned f2bf(float f) { return pk2(f, 0.f) & 0xffffu; }
__device__ __forceinline__ float bf2f(unsigned b) { return __builtin_bit_cast(float, b << 16); }
__device__ __forceinline__ float bflo(unsigned w) { return __builtin_bit_cast(float, w << 16); }
__device__ __forceinline__ float bfhi(unsigned w) { return __builtin_bit_cast(float, w & 0xffff0000u); }
template <int CTRL> __device__ __forceinline__ float dpp_f(float v) { return __builtin_bit_cast(float, __builtin_amdgcn_update_dpp(0, __builtin_bit_cast(int, v), CTRL, 0xf, 0xf, false)); }
__device__ __forceinline__ float quad_sum(float v) { v += dpp_f<0xB1>(v); v += dpp_f<0x4E>(v); return v; }
__device__ __forceinline__ float oct_sum(float v) { v = quad_sum(v); v += dpp_f<0x141>(v); return v; }
__device__ __forceinline__ float wave_sum(float v) {
    v = oct_sum(v); v += dpp_f<0x140>(v);
    const float r0 = __builtin_bit_cast(float, __builtin_amdgcn_readlane(__builtin_bit_cast(int, v), 0)), r1 = __builtin_bit_cast(float, __builtin_amdgcn_readlane(__builtin_bit_cast(int, v), 16));
    const float r2 = __builtin_bit_cast(float, __builtin_amdgcn_readlane(__builtin_bit_cast(int, v), 32)), r3 = __builtin_bit_cast(float, __builtin_amdgcn_readlane(__builtin_bit_cast(int, v), 48));
    return (r0 + r1) + (r2 + r3);
}
__device__ __forceinline__ float rl(float x, int l) { return __builtin_bit_cast(float, __builtin_amdgcn_readlane(__builtin_bit_cast(int, x), l)); }
template <int CTRL, int M> __device__ __forceinline__ void ms_halve(const float (&in)[2 * M], float (&out)[M], bool s) {
#pragma unroll
    for (int k = 0; k < M; ++k) { const float keep = s ? in[k + M] : in[k], send = s ? in[k] : in[k + M]; out[k] = keep + dpp_f<CTRL>(send); }
}
__device__ __forceinline__ float ms_rows(float v) {
    { unsigned a = __builtin_bit_cast(unsigned, v), b = a; asm volatile("s_nop 1\n\tv_permlane16_swap_b32 %0, %1" : "+v"(a), "+v"(b)); v = __builtin_bit_cast(float, a) + __builtin_bit_cast(float, b); }
    { unsigned a = __builtin_bit_cast(unsigned, v), b = a; asm volatile("s_nop 1\n\tv_permlane32_swap_b32 %0, %1" : "+v"(a), "+v"(b)); v = __builtin_bit_cast(float, a) + __builtin_bit_cast(float, b); }
    return v;
}
__device__ __forceinline__ float multi_sum16(const float (&v)[16], int lane) {
    float a[8], b[4], c[2], d[1];
    ms_halve<0x140, 8>(v, a, (lane & 8) != 0); ms_halve<0x141, 4>(a, b, (lane & 4) != 0); ms_halve<0x4E, 2>(b, c, (lane & 2) != 0); ms_halve<0xB1, 1>(c, d, (lane & 1) != 0);
    return ms_rows(d[0]);
}
__device__ __forceinline__ float multi_sum8(const float (&v)[8], int lane) {
    float a[4], b[2], c[1];
    ms_halve<0x140, 4>(v, a, (lane & 8) != 0); ms_halve<0x141, 2>(a, b, (lane & 4) != 0); ms_halve<0x4E, 1>(b, c, (lane & 2) != 0);
    float r = c[0]; r += dpp_f<0xB1>(r); return ms_rows(r);
}
__device__ __forceinline__ float multi_sum4(const float (&v)[4], int lane) {
    float a[2], b[1];
    ms_halve<0x140, 2>(v, a, (lane & 8) != 0); ms_halve<0x141, 1>(a, b, (lane & 4) != 0);
    float r = b[0]; r += dpp_f<0x4E>(r); r += dpp_f<0xB1>(r); return ms_rows(r);
}
__device__ __forceinline__ float silu_f(float x) { return x / (1.f + __expf(-x)); }
__device__ __forceinline__ float sigmoid_f(float x) { return 1.f / (1.f + __expf(-x)); }
__device__ __forceinline__ float softplus_f(float x) { return x > 20.f ? x : log1pf(__expf(x)); }

namespace pg8 {
#define PG8_LAS __attribute__((address_space(3)))
typedef unsigned short bf16_t;
typedef unsigned u32x4 __attribute__((ext_vector_type(4)));
constexpr int BM = 256, BK = 64, HALF = 128, HTB = HALF * BK * 2, STAGE_BYTES = 8 * HTB;

__host__ __device__ __forceinline__ int lds_byte(int r, int c) { const int st = (r >> 4) * 2 + (c >> 5), rr = r & 15, cc = c & 31, ob = rr * 64 + cc * 2; return st * 1024 + (ob ^ (((ob >> 9) & 1) << 5)); }
__host__ __device__ __forceinline__ void stage_rc(int b, int& R, int& C) { const int st = b / 1024, sb = b % 1024, swz = sb ^ (((sb >> 9) & 1) << 5); R = (st >> 1) * 16 + swz / 64; C = (st & 1) * 32 + (swz % 64) / 2; }
__host__ __device__ __forceinline__ int perm32(int rho) { const int n = rho >> 4, i = rho & 15; return 8 * (i >> 2) + 4 * n + (i & 3); }

struct Unit { int pm, pn, e; };
struct Gemm { const bf16_t* A; int K, ldb; };

template <class Epi, class Sched>
__device__ __forceinline__ void gemm_phase(PG8_LAS unsigned char* lds, const Gemm g, const Sched& S, const Epi& E) {
    const int tid = threadIdx.x, wid = __builtin_amdgcn_readfirstlane(tid >> 6), lane = tid & 63, wr = wid >> 2, wc = wid & 3, fr = lane & 15, fq = lane >> 4;
    const int K = g.K, nt = K / BK;
    int R0, C0, R1, C1; stage_rc(tid * 16, R0, C0); stage_rc(tid * 16 + 8192, R1, C1);
    const int Rb0 = (R0 & ~31) + perm32(R0 & 31), Rb1 = (R1 & ~31) + perm32(R1 & 31);
    const unsigned voffB0 = (unsigned)(Rb0 * g.ldb + C0) * 2u, voffB1 = (unsigned)(Rb1 * g.ldb + C1) * 2u;
    const size_t kstep = (size_t)(BK * 2);
    const size_t hstepB = (size_t)HALF * g.ldb * 2;
    const unsigned ldsw = (unsigned)wid * 1024u;
    const int aoff = lds_byte(wr * 64 + fr, fq * 8), boff = lds_byte(wc * 32 + fr, fq * 8);
    const char* Ab = (const char*)g.A;
#define PG8_SA(b, h) (((b) * 2 + (h)) * HTB)
#define PG8_SB(b, h) ((4 + (b) * 2 + (h)) * HTB)
#define PG8_ST2(bufoff, gbase, v0, v1) do { \
        __builtin_amdgcn_global_load_lds((const unsigned*)((const char*)(gbase) + (v0)), (PG8_LAS unsigned*)(lds + (bufoff) + ldsw), 16, 0, 0); \
        __builtin_amdgcn_global_load_lds((const unsigned*)((const char*)(gbase) + (v1)), (PG8_LAS unsigned*)(lds + (bufoff) + ldsw + 8192), 16, 0, 0); } while (0)
#define PG8_STB(bufoff, gbase) PG8_ST2(bufoff, gbase, voffB0, voffB1)
#define PG8_LDA(dst, b, h) do { _Pragma("unroll") for (int m = 0; m < 4; ++m) _Pragma("unroll") for (int k = 0; k < 2; ++k) dst[m][k] = *(const PG8_LAS bf16x8*)(lds + PG8_SA(b, h) + aoff + m * 2048 + k * 1024); } while (0)
#define PG8_LDB(dst, b, h) do { _Pragma("unroll") for (int n = 0; n < 2; ++n) _Pragma("unroll") for (int k = 0; k < 2; ++k) dst[n][k] = *(const PG8_LAS bf16x8*)(lds + PG8_SB(b, h) + boff + n * 2048 + k * 1024); } while (0)
#define PG8_MMA(ai, bj, At, Bt) do { __builtin_amdgcn_s_setprio(1); _Pragma("unroll") for (int m = 0; m < 4; ++m) _Pragma("unroll") for (int n = 0; n < 2; ++n) _Pragma("unroll") for (int k = 0; k < 2; ++k) \
        acc[ai][bj][m][n] = __builtin_amdgcn_mfma_f32_16x16x32_bf16(Bt[n][k], At[m][k], acc[ai][bj][m][n], 0, 0, 0); __builtin_amdgcn_s_setprio(0); } while (0)
#define PG8_WAIT_V(n) asm volatile("s_waitcnt vmcnt(" #n ")" ::: "memory")
#define PG8_WAIT_L(n) asm volatile("s_waitcnt lgkmcnt(" #n ")" ::: "memory")
#define PG8_BAR __builtin_amdgcn_s_barrier()
#define PG8_SCHED __builtin_amdgcn_sched_barrier(0)
    Unit cur, nxt; int ui = 0;
    if (!S.next(0, cur)) return;
    f32x4 acc[2][2][4][2];
#pragma unroll
    for (int a = 0; a < 2; ++a)
#pragma unroll
        for (int b = 0; b < 2; ++b)
#pragma unroll
            for (int m = 0; m < 4; ++m)
#pragma unroll
                for (int n = 0; n < 2; ++n) acc[a][b][m][n] = (f32x4){0.f, 0.f, 0.f, 0.f};
    bf16x8 At[4][2], B0[2][2], B1[2][2];
    unsigned c00, c01, c10, c11;
#define PG8_AOFF(u, d00, d01, d10, d11) do { \
        d00 = S.a_off(u, R0) + (unsigned)C0 * 2u; d01 = S.a_off(u, R1) + (unsigned)C1 * 2u; \
        d10 = S.a_off(u, HALF + R0) + (unsigned)C0 * 2u; d11 = S.a_off(u, HALF + R1) + (unsigned)C1 * 2u; } while (0)
    PG8_AOFF(cur, c00, c01, c10, c11);
    const char* cB = S.b_ptr(cur);
    PG8_STB(PG8_SB(0, 0), cB); PG8_STB(PG8_SB(0, 1), cB + hstepB); PG8_ST2(PG8_SA(0, 0), Ab, c00, c01); PG8_ST2(PG8_SA(0, 1), Ab, c10, c11);
    if (wr == 1) PG8_BAR;
    PG8_WAIT_V(2); PG8_BAR;
    PG8_STB(PG8_SB(1, 0), cB + kstep); PG8_ST2(PG8_SA(1, 0), Ab + kstep, c00, c01); PG8_STB(PG8_SB(1, 1), cB + hstepB + kstep);
    PG8_WAIT_V(6); PG8_BAR;
    for (;;) {
        const bool has_next = S.next(ui + 1, nxt);
        const char* nB = has_next ? S.b_ptr(nxt) : cB;
#pragma unroll 1
        for (int t = 0; t < nt; t += 2) {
            const bool last = (t == nt - 2);
            const char* a1 = Ab + (size_t)(t + 1) * kstep;
            const char* a2 = last ? Ab : Ab + (size_t)(t + 2) * kstep; const char* b2 = last ? nB : cB + (size_t)(t + 2) * kstep;
            const char* a3 = a2 + kstep; const char* b3 = b2 + kstep;
            PG8_LDB(B0, 0, 0); PG8_LDB(B1, 0, 1); PG8_SCHED; PG8_LDA(At, 0, 0); PG8_ST2(PG8_SA(1, 1), a1, c10, c11);
            PG8_WAIT_V(8); PG8_WAIT_L(0); PG8_BAR; PG8_MMA(0, 0, At, B0); PG8_MMA(0, 1, At, B1); PG8_BAR; PG8_SCHED;
            if (last && has_next) { PG8_AOFF(nxt, c00, c01, c10, c11); }
            PG8_LDA(At, 0, 1); PG8_STB(PG8_SB(0, 0), b2); PG8_STB(PG8_SB(0, 1), b2 + hstepB); PG8_ST2(PG8_SA(0, 0), a2, c00, c01);
            PG8_WAIT_V(8); PG8_WAIT_L(0); PG8_BAR; PG8_MMA(1, 0, At, B0); PG8_MMA(1, 1, At, B1); PG8_BAR; PG8_SCHED;
            PG8_LDB(B0, 1, 0); PG8_LDB(B1, 1, 1); PG8_SCHED; PG8_LDA(At, 1, 0); PG8_ST2(PG8_SA(0, 1), a2, c10, c11);
            PG8_WAIT_V(8); PG8_WAIT_L(0); PG8_BAR; PG8_MMA(0, 0, At, B0); PG8_MMA(0, 1, At, B1); PG8_BAR; PG8_SCHED;
            PG8_LDA(At, 1, 1); PG8_STB(PG8_SB(1, 0), b3); PG8_STB(PG8_SB(1, 1), b3 + hstepB); PG8_ST2(PG8_SA(1, 0), a3, c00, c01);
            PG8_WAIT_V(8); PG8_WAIT_L(0); PG8_BAR; PG8_MMA(1, 0, At, B0); PG8_MMA(1, 1, At, B1); PG8_BAR; PG8_SCHED;
        }
        if (wr == 0) PG8_BAR;
        E(acc, cur, wr, wc, fr, fq);
        if (!has_next) break;
#pragma unroll
        for (int a = 0; a < 2; ++a)
#pragma unroll
            for (int b = 0; b < 2; ++b)
#pragma unroll
                for (int m = 0; m < 4; ++m)
#pragma unroll
                    for (int n = 0; n < 2; ++n) acc[a][b][m][n] = (f32x4){0.f, 0.f, 0.f, 0.f};
        cur = nxt; cB = nB; ++ui;
        if (wr == 1) PG8_BAR;
    }
    PG8_WAIT_V(0);
    PG8_BAR;
#undef PG8_SA
#undef PG8_SB
#undef PG8_ST2
#undef PG8_STB
#undef PG8_LDA
#undef PG8_LDB
#undef PG8_MMA
#undef PG8_WAIT_V
#undef PG8_WAIT_L
#undef PG8_BAR
#undef PG8_SCHED
#undef PG8_AOFF
}
}

#define XB_TMO      128
#define XB_XCNT(j)  (256  + 64 * (j))
#define XB_XSUB(j)  (1280 + 64 * (j))
#define XB_XGEN(j)  (2304 + 64 * (j))
#define XB_TOP      3328
#define XB_TOPGEN   3392
#define XCD_BAR_WORDS 3456
#define XB_SPIN_CAP (1u << 22)

__device__ __forceinline__ unsigned xb_ld(unsigned* p)              { return __hip_atomic_load(p, __ATOMIC_RELAXED, __HIP_MEMORY_SCOPE_AGENT); }
__device__ __forceinline__ unsigned xb_add(unsigned* p, unsigned v) { return __hip_atomic_fetch_add(p, v, __ATOMIC_RELAXED, __HIP_MEMORY_SCOPE_AGENT); }
__device__ __forceinline__ unsigned xb_xcc_id() { return (unsigned)__builtin_amdgcn_s_getreg((3 << 11) | 20) & 0xFu; }
#define XB_SPIN(cond, bar) do { unsigned _sp = 0; while (cond) { __builtin_amdgcn_s_sleep(1); \
    if ((++_sp & 255u) == 0u) { if (xb_ld(&(bar)[XB_TMO])) break; if (_sp > XB_SPIN_CAP) { atomicAdd(&(bar)[XB_TMO], 1u); break; } } } } while (0)

struct XcdBarrier { unsigned* bar; unsigned x; volatile LAS unsigned* st; };

__device__ __forceinline__ XcdBarrier xcd_barrier_post(unsigned* bar, volatile LAS unsigned* st) {
    XcdBarrier b; b.bar = bar; b.x = xb_xcc_id(); b.st = st;
    if (threadIdx.x == 0) (void)xb_add(&bar[XB_XCNT(b.x)], 1u);
    return b;
}
__device__ __forceinline__ void xcd_barrier_complete(unsigned* bar, unsigned x, unsigned& nloc, unsigned& nx) {
    const unsigned G = gridDim.x * gridDim.y * gridDim.z;
    unsigned sum, cnt, mine, sp = 0u;
    for (;;) {
        sum = 0u; cnt = 0u; mine = 0u;
#pragma unroll
        for (unsigned j = 0; j < 16; ++j) { const unsigned c = xb_ld(&bar[XB_XCNT(j)]); sum += c; cnt += (c > 0u) ? 1u : 0u; mine = (j == x) ? c : mine; }
        if (sum == G) break;
        __builtin_amdgcn_s_sleep(1);
        if ((++sp & 255u) == 0u) { if (xb_ld(&bar[XB_TMO])) break; if (sp > XB_SPIN_CAP) { atomicAdd(&bar[XB_TMO], 1u); break; } }
    }
    nloc = mine > 0u ? mine : 1u; nx = cnt > 0u ? cnt : 1u;
}
__device__ __forceinline__ void xcd_barrier(const XcdBarrier& b) {
    asm volatile("s_waitcnt vmcnt(0)" ::: "memory");
    __syncthreads();
    if (threadIdx.x == 0) {
        unsigned* bar = b.bar;
        __builtin_amdgcn_s_waitcnt(0);
        unsigned nloc = b.st[0], nx = b.st[1];
        if (nloc == 0u) { xcd_barrier_complete(bar, b.x, nloc, nx); b.st[0] = nloc; b.st[1] = nx; }
        const unsigned old = xb_add(&bar[XB_XSUB(b.x)], 1u);
        const unsigned gen = old / nloc;
        if (old + 1u == (gen + 1u) * nloc) {
            __builtin_amdgcn_fence(__ATOMIC_RELEASE, "agent");
            asm volatile("s_waitcnt vmcnt(0)" ::: "memory");
            const unsigned og = xb_add(&bar[XB_TOP], 1u);
            const unsigned tg = og / nx;
            if (og + 1u == (tg + 1u) * nx) xb_add(&bar[XB_TOPGEN], 1u);
            else XB_SPIN(xb_ld(&bar[XB_TOPGEN]) == tg, bar);
            __builtin_amdgcn_fence(__ATOMIC_ACQUIRE, "agent");
            xb_add(&bar[XB_XGEN(b.x)], 1u);
            asm volatile("s_waitcnt vmcnt(0)" ::: "memory");
        } else {
            XB_SPIN(xb_ld(&bar[XB_XGEN(b.x)]) == gen, bar);
            __builtin_amdgcn_fence(__ATOMIC_ACQUIRE, "agent");
            asm volatile("s_waitcnt vmcnt(0)" ::: "memory");
        }
    }
    __syncthreads();
}

struct Frame {
    LAS unsigned char* lds;
    volatile LAS unsigned* MISC;
    gu32* ctl;
    int tid, lane, wave, vcu, G;
    const float* in[24];
    float* out;
    unsigned char* ws;
};
enum { I_X = 0, I_C, I_ADAW, I_ADAB, I_NMIX, I_NFFN, I_WIN, I_CONVW, I_ALOG, I_DTB, I_ONORM, I_SINKS, I_RELB, I_WOUT, I_POOLW, I_POOLS, I_R1W, I_R1B, I_R2W, I_R2B, I_WG, I_WU, I_WDN, I_FNW };

__device__ __forceinline__ void p0_transpose_item(const float* W, int ldw, int K, bf16* WT, int dst_row0, LAS float* scr, int k0, int n0, int lane) {
    f32x4 w4[8];
#pragma unroll
    for (int i = 0; i < 8; ++i) { const int f = i * 64 + lane, kk = f >> 3, c4 = f & 7; w4[i] = __builtin_nontemporal_load((const f32x4*)(W + (size_t)(k0 + kk) * ldw + n0 + c4 * 4)); }
#pragma unroll
    for (int i = 0; i < 8; ++i) { const int f = i * 64 + lane, kk = f >> 3, c4 = f & 7; LAS float* d = scr + kk * 33 + c4 * 4; d[0] = w4[i].x; d[1] = w4[i].y; d[2] = w4[i].z; d[3] = w4[i].w; }
    LDS_WAIT(); asm volatile("" ::: "memory");
    const int c = lane & 7;
#pragma unroll
    for (int j = 0; j < 4; ++j) { const int n = (lane >> 3) + 8 * j; const LAS float* s = scr + (8 * c) * 33 + n;
        v4u o; o.x = pk2(s[0 * 33], s[1 * 33]); o.y = pk2(s[2 * 33], s[3 * 33]); o.z = pk2(s[4 * 33], s[5 * 33]); o.w = pk2(s[6 * 33], s[7 * 33]);
        __builtin_nontemporal_store(o, (GAS v4u*)(WT + (size_t)(dst_row0 + n) * K + k0 + 8 * c)); }
    LDS_WAIT(); asm volatile("" ::: "memory");
}
constexpr int CQ_NG = NEXP * 512, CQ_NGT = 16 * 512, CQ_N = NEXP * 768;
constexpr int TQ_INPROJ = 11, TQ_GU = 6, TQ_DN = 4;
constexpr int IP_TILES = PIN / 256 - 2;
constexpr int IP_FULL = ((NTOK / 256) * IP_TILES) % 256;
constexpr int CQ_T2 = IP_FULL ? (256 - IP_FULL) * 8 * TQ_INPROJ : 0;
__device__ __forceinline__ void convert_item(Frame& F, int layer, int it, LAS float* scr) {
    if (it < CQ_NG) {
        const int e = it >> 9, r = it & 511, up = r >> 8, q = r & 255, kb = q >> 4, nb = q & 15;
        const float* W = (up ? F.in[I_WU] : F.in[I_WG]) + (size_t)(layer * NEXP + e) * 1024 * 512;
        p0_transpose_item(W, 512, 1024, (bf16*)(F.ws + ((layer && e < 16) ? WS_WGT : WS_WGU)), e * 1024 + (nb >> 2) * 256 + up * 128 + (nb & 3) * 32, scr, kb * 64, nb * 32, F.lane);
    } else {
        const int r0 = it - CQ_NG, e = r0 >> 8, q = r0 & 255, kb = q >> 5, nb = q & 31;
        const float* W = F.in[I_WDN] + (size_t)(layer * NEXP + e) * 512 * 1024;
        p0_transpose_item(W, 1024, 512, (bf16*)(F.ws + WS_WD), e * 1024 + nb * 32, scr, kb * 64, nb * 32, F.lane);
    }
}
__device__ __forceinline__ void convert_range(Frame& F, int layer, int first, int end, int start, int stride) {
    LAS float* scr = (LAS float*)(F.lds + RING_OFF + F.wave * 16384);
    for (int it = first + start; it < end; it += stride) convert_item(F, layer, it, scr);
}
__device__ __forceinline__ void p0_prologue(Frame& F) {
    LAS float* scr = (LAS float*)(F.lds + RING_OFF + F.wave * 16384);
    const int gw = F.vcu * NWAVES + F.wave, NGW = F.G * NWAVES;
    constexpr int IA = 16 * 64, IB = 16 * 24, IO = 16 * 32, IP = 4 * 32, NIT = IA + IB + IO + IP;
    for (int it = gw; it < NIT; it += NGW) {
        int r = it;
        if (r < IA) { p0_transpose_item(F.in[I_WIN], 2832, 1024, (bf16*)(F.ws + WS_WIN), (r % 64) * 32, scr, (r / 64) * 64, (r % 64) * 32, F.lane); continue; } r -= IA;
        if (r < IB) { p0_transpose_item(F.in[I_WIN] + 2064, 2832, 1024, (bf16*)(F.ws + WS_WIN), 2048 + (r % 24) * 32, scr, (r / 24) * 64, (r % 24) * 32, F.lane); continue; } r -= IB;
        if (r < IO) { p0_transpose_item(F.in[I_WOUT], 1024, 1024, (bf16*)(F.ws + WS_WOUT), (r % 32) * 32, scr, (r / 32) * 64, (r % 32) * 32, F.lane); continue; } r -= IO;
        { const int g = r >> 5, q = r & 31; p0_transpose_item(F.in[I_POOLW] + (size_t)g * 65536, 256, 256, (bf16*)(F.ws + WS_POOLW) + (size_t)g * 65536, (q & 7) * 32, scr, (q >> 3) * 64, (q & 7) * 32, F.lane); }
    }
    { float* WBA = (float*)(F.ws + WS_WBA); const int gt = F.vcu * 512 + F.tid;
      if (gt < 16 * 1024) { const int o = gt >> 10, k = gt & 1023; WBA[o * 1024 + k] = F.in[I_WIN][(size_t)k * 2832 + 2048 + o]; } }
    __syncthreads();
    {
        LAS float* red = (LAS float*)(F.lds + RING_OFF);
        const int ks = F.tid >> 4, cj = F.tid & 15;
        for (int u = F.vcu; u < 192; u += F.G) {
            const int l = u / 96, cb = u % 96;
            const float* W = F.in[I_ADAW] + (size_t)l * 1024 * 6144 + cb * 64 + cj * 4;
            f32x4 a0 = {0.f, 0.f, 0.f, 0.f}, a1 = {0.f, 0.f, 0.f, 0.f};
            for (int k = ks * 32; k < ks * 32 + 32; ++k) {
                const f32x4 w = *(const f32x4*)(W + (size_t)k * 6144);
                const float c0 = silu_f(F.in[I_C][k]), c1 = silu_f(F.in[I_C][1024 + k]);
                a0 += w * c0; a1 += w * c1;
            }
            *(LAS f32x4*)(red + (ks * 2 + 0) * 64 + cj * 4) = a0; *(LAS f32x4*)(red + (ks * 2 + 1) * 64 + cj * 4) = a1;
            __syncthreads();
            if (F.tid < 128) { const int b = F.tid >> 6, c = F.tid & 63; float s = 0.f;
                for (int q = 0; q < 32; ++q) s += red[(q * 2 + b) * 64 + c];
                ((float*)(F.ws + WS_MOD))[(size_t)(l * 2 + b) * 6144 + cb * 64 + c] = s + F.in[I_ADAB][l * 6144 + cb * 64 + c]; }
            __syncthreads();
        }
    }
}

struct RowVec { f32x4 v[4]; };
__device__ __forceinline__ RowVec load_row_f32(const float* row, int lane) { RowVec r; const GAS f32x4* p = (const GAS f32x4*)row + lane;
#pragma unroll
    for (int j = 0; j < 4; ++j) r.v[j] = p[64 * j]; return r; }
__device__ __forceinline__ void store_row_f32(float* row, int lane, const RowVec& r) { GAS f32x4* p = (GAS f32x4*)row + lane;
#pragma unroll
    for (int j = 0; j < 4; ++j) p[64 * j] = r.v[j]; }
__device__ __forceinline__ void store_row_bf16(bf16* row, int lane, const RowVec& r) { GAS v2u* p = (GAS v2u*)row + lane;
#pragma unroll
    for (int j = 0; j < 4; ++j) { v2u o; o.x = pk2(r.v[j].x, r.v[j].y); o.y = pk2(r.v[j].z, r.v[j].w); p[64 * j] = o; } }
__device__ __forceinline__ void load_row_bf16(const bf16* row, int lane, v2u (&p)[4]) { const GAS v2u* q = (const GAS v2u*)row + lane;
#pragma unroll
    for (int j = 0; j < 4; ++j) p[j] = q[64 * j]; }
__device__ __forceinline__ RowVec unpack_row_bf16(const v2u (&p)[4]) { RowVec r;
#pragma unroll
    for (int j = 0; j < 4; ++j) { r.v[j].x = bflo(p[j].x); r.v[j].y = bfhi(p[j].x); r.v[j].z = bflo(p[j].y); r.v[j].w = bfhi(p[j].y); } return r; }
__device__ __forceinline__ float row_rstd(const RowVec& r) { float s = 0.f;
#pragma unroll
    for (int j = 0; j < 4; ++j) s += (r.v[j].x * r.v[j].x + r.v[j].y * r.v[j].y) + (r.v[j].z * r.v[j].z + r.v[j].w * r.v[j].w);
    return 1.0f / sqrtf(wave_sum(s) * (1.f / D) + EPS); }
struct ModVec { f32x4 a[4], b[4]; };
__device__ __forceinline__ ModVec load_mod(const float* w, const float* sc, const float* sh, int lane) { ModVec m;
#pragma unroll
    for (int j = 0; j < 4; ++j) { const f32x4 wv = *((const f32x4*)w + lane + 64 * j), s = *((const f32x4*)sc + lane + 64 * j); m.a[j] = wv * (s + 1.0f); m.b[j] = *((const f32x4*)sh + lane + 64 * j); }
    return m; }
__device__ __forceinline__ RowVec apply_mod(const RowVec& x, float rstd, const ModVec& m) { RowVec h;
#pragma unroll
    for (int j = 0; j < 4; ++j) h.v[j] = x.v[j] * rstd * m.a[j] + m.b[j]; return h; }

__device__ __forceinline__ void p1_prenorm0(Frame& F) {
    LAS float* wba = (LAS float*)(F.lds + RING_OFF);
    { const float* WBA = (const float*)(F.ws + WS_WBA); for (int i = F.tid; i < 16 * 256; i += 512) *((LAS f32x4*)wba + i) = *((const f32x4*)WBA + i); }
    __syncthreads();
    const float* mod = (const float*)(F.ws + WS_MOD);
    bf16* H = (bf16*)(F.ws + WS_H); float* BG = (float*)(F.ws + WS_BG);
    const int tok0 = F.vcu * (NTOK / F.G) + F.wave * (NTOK / F.G / NWAVES), ntw = NTOK / F.G / NWAVES;
    const int b = tok0 / SEQ;
    const ModVec m = load_mod(F.in[I_NMIX], mod + (size_t)b * 6144 + 1024, mod + (size_t)b * 6144, F.lane);
    const int hh = F.lane & 7;
    const float nega = -__expf(F.in[I_ALOG][hh]), dtb = F.in[I_DTB][hh];
    RowVec xa = load_row_f32(F.in[I_X] + (size_t)tok0 * D, F.lane), xb = load_row_f32(F.in[I_X] + (size_t)(tok0 + 1) * D, F.lane);
    const LAS f32x4* wl = (const LAS f32x4*)wba + F.lane;
    for (int i = 0; i < ntw; i += 2) {
        const int t = tok0 + i;
        const RowVec x0 = xa, x1 = xb;
        if (i + 2 < ntw) { xa = load_row_f32(F.in[I_X] + (size_t)(t + 2) * D, F.lane); xb = load_row_f32(F.in[I_X] + (size_t)(t + 3) * D, F.lane); }
        const RowVec h0 = apply_mod(x0, row_rstd(x0), m), h1 = apply_mod(x1, row_rstd(x1), m);
        store_row_bf16(H + (size_t)t * D, F.lane, h0); store_row_bf16(H + (size_t)(t + 1) * D, F.lane, h1);
        float p0[16], p1[16]; f32x4 w[2][4];
#pragma unroll
        for (int j = 0; j < 4; ++j) w[0][j] = wl[64 * j];
#pragma unroll
        for (int o = 0; o < 16; ++o) {
            if (o + 1 < 16) {
#pragma unroll
                for (int j = 0; j < 4; ++j) w[(o + 1) & 1][j] = wl[(o + 1) * 256 + 64 * j]; }
            __builtin_amdgcn_sched_barrier(0);
            float s0 = 0.f, s1 = 0.f;
#pragma unroll
            for (int j = 0; j < 4; ++j) { const f32x4 ww = w[o & 1][j];
                s0 += (h0.v[j].x * ww.x + h0.v[j].y * ww.y) + (h0.v[j].z * ww.z + h0.v[j].w * ww.w); s1 += (h1.v[j].x * ww.x + h1.v[j].y * ww.y) + (h1.v[j].z * ww.z + h1.v[j].w * ww.w); }
            p0[o] = s0; p1[o] = s1;
            __builtin_amdgcn_sched_barrier(0); }
        const float mine0 = multi_sum16(p0, F.lane), mine1 = multi_sum16(p1, F.lane);
        if (F.lane < 8) { BG[(size_t)t * 16 + F.lane] = sigmoid_f(mine0); BG[(size_t)(t + 1) * 16 + F.lane] = sigmoid_f(mine1); }
        else if (F.lane < 16) { BG[(size_t)t * 16 + F.lane] = nega * softplus_f(mine0 + dtb); BG[(size_t)(t + 1) * 16 + F.lane] = nega * softplus_f(mine1 + dtb); }
    }
}

struct DenseSched {
    int nM, nN, nwg, G, c, gap_from, gap, L0, Lend; unsigned lda2, acol2; const char* B; size_t btile;
    __device__ __forceinline__ void init(int M, int N, int G_, int c_, int lda, int acolstride, const void* B_, int ldb) { nM = M / 256; nN = N / 256; nwg = nM * nN; G = G_; c = c_; gap_from = 1 << 30; gap = 0; L0 = 0; Lend = nwg; lda2 = (unsigned)lda * 2u; acol2 = (unsigned)acolstride * 2u; B = (const char*)B_; btile = (size_t)256 * ldb * 2; }
    __device__ __forceinline__ bool next(int i, pg8::Unit& u) const {
        const long L = (long)L0 + (long)i * G + c; if (L >= Lend) return false;
        int wgid = (int)L; { const int q = nwg / 8, r = nwg % 8, xcd = wgid % 8, off = wgid / 8; wgid = (xcd < r ? xcd * (q + 1) : r * (q + 1) + (xcd - r) * q) + off; }
        const int nig = 8 * nN, gid = wgid / nig, fm = gid * 8, gsz = (nM - fm) < 8 ? (nM - fm) : 8;
        u.pm = fm + ((wgid % nig) % gsz); u.pn = (wgid % nig) / gsz; u.pn += (u.pn >= gap_from) ? gap : 0; u.e = 0; return true;
    }
    __device__ __forceinline__ unsigned a_off(const pg8::Unit& u, int r) const { return (unsigned)(u.pm * 256 + r) * lda2 + (unsigned)u.pn * acol2; }
    __device__ __forceinline__ const char* b_ptr(const pg8::Unit& u) const { return B + (size_t)u.pn * btile; }
};
struct MoeSched {
    const LAS int* cnt; const LAS int* tbase; const LAS int* tileExp;
    int nunits, chunk, G, c, esplit; const int* RT; const char* B; const char* Blo; size_t bexp, btile; unsigned arow2;
    __device__ __forceinline__ void init(const LAS int* tables, int G_, int c_, const int* RT_, const void* B_, int ldb, int lda) {
        cnt = tables; tbase = tables + 32; tileExp = tables + 80; G = G_; c = c_; RT = RT_; B = (const char*)B_; Blo = B; esplit = 0; bexp = (size_t)1024 * ldb * 2; btile = (size_t)256 * ldb * 2; arow2 = (unsigned)lda * 2u;
        nunits = tbase[32] * 4; chunk = ((nunits + 7) / 8 + 3) & ~3;
    }
    __device__ __forceinline__ bool next(int i, pg8::Unit& u) const {
        const int w = i * (G / 8) + (c >> 3); if (w >= chunk) return false;
        const int L = (c & 7) * chunk + w; if (L >= nunits) return false;
        u.pm = L >> 2; u.pn = L & 3; u.e = tileExp[u.pm]; return true;
    }
    __device__ __forceinline__ unsigned a_off(const pg8::Unit& u, int r) const {
        if (RT) { const int pos = (u.pm - tbase[u.e]) * 256 + r; const int tok = pos < cnt[u.e] ? RT[u.e * NTOK + pos] : 0; return (unsigned)tok * arow2; }
        return (unsigned)(u.pm * 256 + r) * arow2;
    }
    __device__ __forceinline__ const char* b_ptr(const pg8::Unit& u) const { return (u.e < esplit ? Blo : B) + (size_t)u.e * bexp + (size_t)u.pn * btile; }
};
__device__ __forceinline__ void build_moe_tables(Frame& F, int layer) {
    LAS int* T = (LAS int*)(F.lds + SCHED_OFF);
    int tid_ = F.tid; asm volatile("" : "+v"(tid_));
    if (tid_ < 32) T[tid_] = (int)__hip_atomic_load(F.ctl + CW_CNT + 64 * layer + tid_, RLX_AGENT);
    __syncthreads();
    if (F.tid == 0) { int acc = 0; for (int e = 0; e < 32; ++e) { T[32 + e] = acc; const int nt = (T[e] + 255) >> 8; for (int j = 0; j < nt; ++j) T[80 + acc + j] = e; acc += nt; } T[64] = acc; }
    __syncthreads();
}

__device__ __forceinline__ int moe_units_of(int c, int G, int nunits, int chunk) {
    const int sl = c >> 3, x = c & 7, per = G / 8; int U = nunits - x * chunk; U = U < 0 ? 0 : (U > chunk ? chunk : U);
    return sl < U ? (U - sl + per - 1) / per : 0;
}
__device__ __forceinline__ void moe_tail_plan(Frame& F) {
    LAS int* T = (LAS int*)(F.lds + SCHED_OFF);
    if (F.tid == 0) { T[65] = 0; T[66] = 0; }
    __syncthreads();
    if (F.tid < 256) {
        const int nunits = T[64] * 4, chunk = ((nunits + 7) / 8 + 3) & ~3, per = F.G / 8, maxu = (chunk + per - 1) / per, c = (int)blockIdx.x;
        const int sp = F.tid < F.G ? maxu - moe_units_of(F.tid, F.G, nunits, chunk) : 0;
        const int lower = (int)wave_sum(F.tid < c ? (float)sp : 0.f), all = (int)wave_sum((float)sp);
        if (F.lane == 0) { atomicAdd((int*)(T + 65), lower); atomicAdd((int*)(T + 66), all); }
        if (F.tid == c) T[67] = sp;
    }
    __syncthreads();
}

struct EpiStoreBf16 {
    bf16* O; int ldc;
    __device__ __forceinline__ void operator()(const f32x4 (&acc)[2][2][4][2], const pg8::Unit& u, int wr, int wc, int fr, int fq) const {
        const int row0 = u.pm * 256 + wr * 64 + fr, col0 = u.pn * 256 + wc * 32 + 8 * fq;
#pragma unroll
        for (int ai = 0; ai < 2; ++ai)
#pragma unroll
            for (int m = 0; m < 4; ++m) { bf16* rowp = O + (size_t)(row0 + ai * 128 + m * 16) * ldc + col0;
#pragma unroll
                for (int bj = 0; bj < 2; ++bj) { const f32x4 v0 = acc[ai][bj][m][0], v1 = acc[ai][bj][m][1];
                    v4u w; w.x = pk2(v0[0], v0[1]); w.y = pk2(v0[2], v0[3]); w.z = pk2(v1[0], v1[1]); w.w = pk2(v1[2], v1[3]);
                    *(v4u*)(rowp + bj * 128) = w; } }
    }
};
template <bool F32SRC> struct EpiResid {
    const float* X; bf16* O; const float* cf; const float* mul;
    __device__ __forceinline__ void operator()(const f32x4 (&acc)[2][2][4][2], const pg8::Unit& u, int wr, int wc, int fr, int fq) const {
        const int row0 = u.pm * 256 + wr * 64 + fr, col0 = u.pn * 256 + wc * 32 + 8 * fq, b = (u.pm * 256) / SEQ;
        f32x4 c[2][2];
#pragma unroll
        for (int bj = 0; bj < 2; ++bj)
#pragma unroll
            for (int n = 0; n < 2; ++n) { c[bj][n] = *(const f32x4*)(cf + (size_t)b * 6144 + col0 + bj * 128 + 4 * n); if (mul) c[bj][n] *= *(const f32x4*)(mul + col0 + bj * 128 + 4 * n); }
#pragma unroll
        for (int ai = 0; ai < 2; ++ai)
#pragma unroll
            for (int m = 0; m < 4; ++m) { const size_t ro = (size_t)(row0 + ai * 128 + m * 16) * D + col0;
                f32x4 s[2][2];
                if (F32SRC) {
#pragma unroll
                    for (int bj = 0; bj < 2; ++bj) { s[bj][0] = *(const GAS f32x4*)(X + ro + bj * 128); s[bj][1] = *(const GAS f32x4*)(X + ro + bj * 128 + 4); }
                } else {
#pragma unroll
                    for (int bj = 0; bj < 2; ++bj) { const v4u q = *(const GAS v4u*)(O + ro + bj * 128);
                        s[bj][0].x = bflo(q.x); s[bj][0].y = bfhi(q.x); s[bj][0].z = bflo(q.y); s[bj][0].w = bfhi(q.y); s[bj][1].x = bflo(q.z); s[bj][1].y = bfhi(q.z); s[bj][1].z = bflo(q.w); s[bj][1].w = bfhi(q.w); }
                }
#pragma unroll
                for (int bj = 0; bj < 2; ++bj) { const f32x4 v0 = s[bj][0] + c[bj][0] * acc[ai][bj][m][0], v1 = s[bj][1] + c[bj][1] * acc[ai][bj][m][1];
                    v4u w; w.x = pk2(v0[0], v0[1]); w.y = pk2(v0[2], v0[3]); w.z = pk2(v1[0], v1[1]); w.w = pk2(v1[2], v1[3]);
                    *(v4u*)(O + ro + bj * 128) = w; } }
    }
};
struct EpiSwiglu {
    bf16* O;
    __device__ __forceinline__ void operator()(const f32x4 (&acc)[2][2][4][2], const pg8::Unit& u, int wr, int wc, int fr, int fq) const {
        const int row0 = u.pm * 256 + wr * 64 + fr, col0 = u.pn * 128 + wc * 32 + 8 * fq;
#pragma unroll
        for (int ai = 0; ai < 2; ++ai)
#pragma unroll
            for (int m = 0; m < 4; ++m) { bf16* rowp = O + (size_t)(row0 + ai * 128 + m * 16) * DFF + col0;
                float r[8];
#pragma unroll
                for (int n = 0; n < 2; ++n)
#pragma unroll
                    for (int j = 0; j < 4; ++j) r[4 * n + j] = silu_f(acc[ai][0][m][n][j]) * acc[ai][1][m][n][j];
                v4u w; w.x = pk2(r[0], r[1]); w.y = pk2(r[2], r[3]); w.z = pk2(r[4], r[5]); w.w = pk2(r[6], r[7]);
                *(v4u*)rowp = w; }
    }
};

__device__ __forceinline__ void moe_route(Frame& F, int layer) {
    LAS int* hist = (LAS int*)(F.lds + RT_LDS_OFF);
    LAS int* base = hist + 32;
    LAS int* tinfo = hist + 64;
    LAS float* tg = (LAS float*)(hist + 64 + 512);
    if (F.tid < 32) hist[F.tid] = 0;
    LAS f32x4* R2 = (LAS f32x4*)(F.lds + RING_OFF);
    LAS f32x4* R1 = (LAS f32x4*)(F.lds + R1W_OFF);
    { const f32x4* g2p = (const f32x4*)(F.in[I_R2W] + (size_t)layer * 1024 * 32); const f32x4* g1p = (const f32x4*)(F.in[I_R1W] + (size_t)layer * 1024 * 4);
      f32x4 t2[16], t1[2];
#pragma unroll
      for (int u = 0; u < 16; ++u) t2[u] = g2p[F.tid + 512 * u];
#pragma unroll
      for (int u = 0; u < 2; ++u) t1[u] = g1p[F.tid + 512 * u];
#pragma unroll
      for (int u = 0; u < 16; ++u) { const int i = F.tid + 512 * u, k = i >> 3, c4 = i & 7, ln = (k & 255) >> 2, q = k & 3, j = k >> 8; R2[((j * 4 + q) * 8 + c4) * 64 + ln] = t2[u]; }
#pragma unroll
      for (int u = 0; u < 2; ++u) { const int k = F.tid + 512 * u, ln = (k & 255) >> 2, q = k & 3, j = k >> 8; R1[(j * 4 + q) * 64 + ln] = t1[u]; } }
    __syncthreads();
    const float* mod = (const float*)(F.ws + WS_MOD) + (size_t)layer * 2 * 6144;
    bf16* H = (bf16*)(F.ws + WS_H);
    const int tokw = F.vcu * 128 + F.wave * 16, b = (F.vcu * 128) / SEQ;
    const ModVec m = load_mod(F.in[I_NFFN] + layer * D, mod + (size_t)b * 6144 + 4 * 1024, mod + (size_t)b * 6144 + 3 * 1024, F.lane);
    const float b1v = F.lane < 4 ? F.in[I_R1B][layer * 4 + F.lane] : 0.f, b2v = F.lane < 32 ? F.in[I_R2B][layer * 32 + F.lane] : 0.f;
    const bf16* XRB = (const bf16*)(F.ws + WS_XRB);
    v2u xbn[4], xb2[4];
    load_row_bf16(XRB + (size_t)tokw * D, F.lane, xbn); load_row_bf16(XRB + (size_t)(tokw + 1) * D, F.lane, xb2);
    f32x4 r1w[16];
#pragma unroll
    for (int k = 0; k < 16; ++k) r1w[k] = R1[k * 64 + F.lane];
    for (int i = 0; i < 16; ++i) {
        const int t = tokw + i;
        const RowVec x = unpack_row_bf16(xbn);
#pragma unroll
        for (int j = 0; j < 4; ++j) xbn[j] = xb2[j];
        if (i + 2 < 16) load_row_bf16(XRB + (size_t)(t + 2) * D, F.lane, xb2);
        RowVec h = apply_mod(x, row_rstd(x), m);
        store_row_bf16(H + (size_t)t * D, F.lane, h);
        f32x4 l1 = {0.f, 0.f, 0.f, 0.f};
#pragma unroll
        for (int j = 0; j < 4; ++j)
#pragma unroll
            for (int q = 0; q < 4; ++q) l1 += r1w[j * 4 + q] * h.v[j][q];
        float lg[4];
        { const float p4[4] = {l1[0], l1[1], l1[2], l1[3]}; const float r = multi_sum4(p4, F.lane);
#pragma unroll
          for (int g = 0; g < 4; ++g) lg[g] = rl(r, 4 * g) + rl(b1v, g); }
        int grp = 0; float mx = lg[0];
#pragma unroll
        for (int g = 1; g < 4; ++g) if (lg[g] > mx) { mx = lg[g]; grp = g; }
        float se = 0.f;
#pragma unroll
        for (int g = 0; g < 4; ++g) se += __expf(lg[g] - mx);
        const float ptop = 1.0f / se;
        grp = __builtin_amdgcn_readfirstlane(grp);
        f32x4 a0 = {0.f, 0.f, 0.f, 0.f}, a1 = {0.f, 0.f, 0.f, 0.f};
        { const LAS f32x4* wg = R2 + (grp * 2) * 64 + F.lane;
#pragma unroll
          for (int hb = 0; hb < 2; ++hb) { f32x4 w2[16];
#pragma unroll
              for (int k = 0; k < 8; ++k) { w2[2 * k] = wg[((hb * 8 + k) * 8) * 64]; w2[2 * k + 1] = wg[((hb * 8 + k) * 8 + 1) * 64]; }
              __builtin_amdgcn_sched_barrier(0);
#pragma unroll
              for (int k = 0; k < 8; ++k) { const float hv = h.v[(hb * 8 + k) >> 2][(hb * 8 + k) & 3]; a0 += w2[2 * k] * hv; a1 += w2[2 * k + 1] * hv; }
              __builtin_amdgcn_sched_barrier(0); } }
        float l2[8];
        { const float p8[8] = {a0[0], a0[1], a0[2], a0[3], a1[0], a1[1], a1[2], a1[3]}; const float r = multi_sum8(p8, F.lane);
#pragma unroll
          for (int q = 0; q < 8; ++q) l2[q] = rl(r, 2 * q) + rl(b2v, grp * 8 + q); }
        int i0 = 0; float v0 = l2[0];
#pragma unroll
        for (int q = 1; q < 8; ++q) if (l2[q] > v0) { v0 = l2[q]; i0 = q; }
        int i1 = (i0 == 0) ? 1 : 0; float v1 = l2[i1 == 1 ? 1 : 0];
#pragma unroll
        for (int q = 0; q < 8; ++q) if (q != i0 && l2[q] > v1) { v1 = l2[q]; i1 = q; }
        const float g0 = ptop / (1.0f + __expf(v1 - v0)), g1 = ptop - g0;
        if (F.lane == 0) { const int e0 = grp * 8 + i0, e1 = grp * 8 + i1, li = F.wave * 16 + i;
            tinfo[li * 4 + 0] = e0; tinfo[li * 4 + 1] = e1; tinfo[li * 4 + 2] = atomicAdd((int*)(hist + e0), 1); tinfo[li * 4 + 3] = atomicAdd((int*)(hist + e1), 1);
            tg[li * 2] = g0; tg[li * 2 + 1] = g1;
        }
    }
    __syncthreads();
    if (F.tid < 32) base[F.tid] = (int)__hip_atomic_fetch_add(F.ctl + CW_CNT + 64 * layer + F.tid, (unsigned)hist[F.tid], RLX_AGENT);
    __syncthreads();
    if (F.tid < 128) { const int t = F.vcu * 128 + F.tid; const int e0 = tinfo[F.tid * 4], e1 = tinfo[F.tid * 4 + 1];
        const int p0 = base[e0] + tinfo[F.tid * 4 + 2], p1 = base[e1] + tinfo[F.tid * 4 + 3];
        int* RT = (int*)(F.ws + WS_RT); RT[e0 * NTOK + p0] = t; RT[e1 * NTOK + p1] = t;
        v4u r0; r0.x = e0; r0.y = e1; r0.z = p0; r0.w = p1; v4u r1; r1.x = __builtin_bit_cast(unsigned, tg[F.tid * 2]); r1.y = __builtin_bit_cast(unsigned, tg[F.tid * 2 + 1]); r1.z = 0; r1.w = 0;
        v4u* RO = (v4u*)(F.ws + WS_ROUTE) + (size_t)t * 2; RO[0] = r0; (void)r1;
        { float* GA = (float*)(F.ws + WS_BG); GA[(size_t)t * 2] = tg[F.tid * 2]; GA[(size_t)t * 2 + 1] = tg[F.tid * 2 + 1]; } }
    __syncthreads();
}

struct CombRows { v2u xb[4], ya[4], yb[4]; };
struct CombRecs { v4u rec; float ga, gb; };
__device__ __forceinline__ CombRecs comb_load_recs(Frame& F, int tokw) { CombRecs c; const int t = tokw + (F.lane & 15);
    c.rec = *((const v4u*)(F.ws + WS_ROUTE) + (size_t)t * 2); const float* GA = (const float*)(F.ws + WS_BG); c.ga = GA[(size_t)t * 2]; c.gb = GA[(size_t)t * 2 + 1]; return c; }
__device__ __forceinline__ int rl_i(int v, int l) { return __builtin_amdgcn_readlane(v, l); }
__device__ __forceinline__ void comb_issue(Frame& F, const CombRecs& c, int i, int t, CombRows& r) {
    const LAS int* T = (const LAS int*)(F.lds + SCHED_OFF);
    const int e0 = rl_i((int)c.rec.x, i), e1 = rl_i((int)c.rec.y, i), p0 = rl_i((int)c.rec.z, i), p1 = rl_i((int)c.rec.w, i);
    const size_t rowa = (size_t)T[32 + e0] * 256 + p0, rowb = (size_t)T[32 + e1] * 256 + p1;
    const bf16* Y = (const bf16*)(F.ws + WS_Y);
    const GAS v2u* ya = (const GAS v2u*)(Y + rowa * D) + F.lane; const GAS v2u* yb = (const GAS v2u*)(Y + rowb * D) + F.lane;
    load_row_bf16((const bf16*)(F.ws + WS_XRB) + (size_t)t * D, F.lane, r.xb);
#pragma unroll
    for (int j = 0; j < 4; ++j) { r.ya[j] = ya[64 * j]; r.yb[j] = yb[64 * j]; }
}
__device__ __forceinline__ RowVec comb_finish(const CombRecs& c, int i, const CombRows& r, const f32x4 (&g2)[4]) {
    const float ga = rl(c.ga, i), gb = rl(c.gb, i); RowVec x = unpack_row_bf16(r.xb);
#pragma unroll
    for (int j = 0; j < 4; ++j) { const v2u a = r.ya[j], bq = r.yb[j];
        f32x4 s; s.x = ga * bflo(a.x) + gb * bflo(bq.x); s.y = ga * bfhi(a.x) + gb * bfhi(bq.x); s.z = ga * bflo(a.y) + gb * bflo(bq.y); s.w = ga * bfhi(a.y) + gb * bfhi(bq.y);
        x.v[j] += g2[j] * s; }
    return x;
}

__device__ __forceinline__ void attn_phase(Frame& F, const int u_first, const int u_stride) {
    LAS bf16* KS = (LAS bf16*)(F.lds + RING_OFF);
    LAS bf16* VT = (LAS bf16*)(F.lds + RING_OFF + 36864);
    LAS float* BT = (LAS float*)(F.lds + RING_OFF + 36864 + 33280);
    const bf16* PROJ = (const bf16*)(F.ws + WS_PROJ); bf16* OAB = (bf16*)(F.ws + WS_OAB);
    const int lane = F.lane, lc = lane & 31, lh = lane >> 5;
    for (int unit = u_first; unit < 512; unit += u_stride) {
        const int b = unit >> 8, kvh = (unit >> 7) & 1, qb = unit & 127, t0 = qb * 128;
        __syncthreads();
        for (int i = F.tid; i < 4 * 192; i += 512) { const int hq = i / 192, x = i - hq * 192, dist = 159 - x; float v = 0.f;
            if (dist >= 0 && dist < 128) { int bk = dist; if (dist >= 16) { bk = 16 + (int)(logf((float)dist / 16.0f) / 2.0794415416798357f * 16.0f); bk = bk > 31 ? 31 : bk; }
                v = F.in[I_RELB][bk * 8 + kvh * 4 + hq] * 1.4426950408889634f; }
            BT[i] = v; }
#pragma unroll
        for (int cc = 0; cc < 4; ++cc) { const int ch = F.tid + 512 * cc, key = ch >> 3, part = ch & 7, tl = t0 - 128 + key;
            v4u kv = {0u, 0u, 0u, 0u}, vv = {0u, 0u, 0u, 0u};
            if (tl >= 0) { const bf16* rp = PROJ + (size_t)(b * SEQ + tl) * PIN; kv = *(const v4u*)(rp + PC_KB + kvh * 64 + part * 8); vv = *(const v4u*)(rp + PC_VB + kvh * 64 + part * 8); }
            *(LAS v4u*)(KS + key * 72 + part * 8) = kv;
            const unsigned w[4] = {vv.x, vv.y, vv.z, vv.w};
#pragma unroll
            for (int q = 0; q < 4; ++q) { VT[(part * 8 + 2 * q) * 260 + key] = (bf16)(w[q] & 0xffffu); VT[(part * 8 + 2 * q + 1) * 260 + key] = (bf16)(w[q] >> 16); } }
        __syncthreads();
#pragma unroll 1
        for (int tt = 0; tt < 2; ++tt) {
            const int task = F.wave * 2 + tt, hq = task >> 2, qt = task & 3, qh = kvh * 4 + hq;
            const int qi = 32 * qt + lc;
            const bf16* qrow = PROJ + (size_t)(b * SEQ + t0 + qi) * PIN + PC_QB + qh * 64 + 8 * lh;
            bf16x8 qf[4];
#pragma unroll
            for (int s = 0; s < 4; ++s) qf[s] = *(const bf16x8*)(qrow + 16 * s);
            f32x16 sc[5];
#pragma unroll
            for (int kt = 0; kt < 5; ++kt) {
#pragma unroll
                for (int r = 0; r < 16; ++r) sc[kt][r] = 0.f;
                const LAS bf16* kp = KS + (32 * (qt + kt) + lc) * 72 + 8 * lh;
#pragma unroll
                for (int s = 0; s < 4; ++s) { const bf16x8 kf = *(const LAS bf16x8*)(kp + 16 * s); sc[kt] = __builtin_amdgcn_mfma_f32_32x32x16_bf16(kf, qf[s], sc[kt], 0, 0, 0); }
            }
            const float sink2 = F.in[I_SINKS][qh] * 1.4426950408889634f;
            const LAS float* bp = BT + hq * 192 + (4 * lh - lc + 31);
            const int m_lo = lc + 1 - 4 * lh, m_hi = lc - 4 * lh;
            float mx = sink2;
#pragma unroll
            for (int kt = 0; kt < 5; ++kt) {
                const bool dead = (t0 == 0) && (qt + kt < 4);
#pragma unroll
                for (int r = 0; r < 16; ++r) { const int cr = (r & 3) + 8 * (r >> 2);
                    float v = sc[kt][r] * (0.125f * 1.4426950408889634f) + bp[32 * kt + cr];
                    if (kt == 0) v = (cr >= m_lo) ? v : -1e30f;
                    if (kt == 4) v = (cr <= m_hi) ? v : -1e30f;
                    if (dead) v = -1e30f;
                    sc[kt][r] = v; mx = fmaxf(mx, v); } }
            mx = fmaxf(mx, __shfl_xor(mx, 32));
            float den = 0.f;
#pragma unroll
            for (int kt = 0; kt < 5; ++kt)
#pragma unroll
                for (int r = 0; r < 16; ++r) { const float p = __builtin_amdgcn_exp2f(sc[kt][r] - mx); sc[kt][r] = p; den += p; }
            den += __shfl_xor(den, 32);
            den += __builtin_amdgcn_exp2f(sink2 - mx);
            const float inv = 1.0f / den;
            f32x16 oa[2];
#pragma unroll
            for (int dt = 0; dt < 2; ++dt)
#pragma unroll
                for (int r = 0; r < 16; ++r) oa[dt][r] = 0.f;
#pragma unroll
            for (int kt = 0; kt < 5; ++kt)
#pragma unroll
                for (int s2 = 0; s2 < 2; ++s2) {
                    v4u pw; pw.x = pk2(sc[kt][8 * s2 + 0], sc[kt][8 * s2 + 1]); pw.y = pk2(sc[kt][8 * s2 + 2], sc[kt][8 * s2 + 3]); pw.z = pk2(sc[kt][8 * s2 + 4], sc[kt][8 * s2 + 5]); pw.w = pk2(sc[kt][8 * s2 + 6], sc[kt][8 * s2 + 7]);
                    const bf16x8 pf = __builtin_bit_cast(bf16x8, pw);
#pragma unroll
                    for (int dt = 0; dt < 2; ++dt) { const LAS bf16* vp = VT + (32 * dt + lc) * 260 + 32 * (qt + kt) + 16 * s2 + 4 * lh;
                        const v2u va = *(const LAS v2u*)vp, vb = *(const LAS v2u*)(vp + 8);
                        v4u vw; vw.x = va.x; vw.y = va.y; vw.z = vb.x; vw.w = vb.y;
                        oa[dt] = __builtin_amdgcn_mfma_f32_32x32x16_bf16(__builtin_bit_cast(bf16x8, vw), pf, oa[dt], 0, 0, 0); }
                }
            bf16* orow = OAB + (size_t)(b * SEQ + t0 + qi) * D + 512 + qh * 64 + 4 * lh;
#pragma unroll
            for (int dt = 0; dt < 2; ++dt)
#pragma unroll
                for (int rg = 0; rg < 4; ++rg) { v2u o; o.x = pk2(oa[dt][4 * rg] * inv, oa[dt][4 * rg + 1] * inv); o.y = pk2(oa[dt][4 * rg + 2] * inv, oa[dt][4 * rg + 3] * inv);
                    *(v2u*)(orow + 32 * dt + 8 * rg) = o; }
        }
    }
    __syncthreads();
}


constexpr int DN_ST = 72;

__device__ __forceinline__ bf16x8 pack8(const f32x16& x, int s) { v4u p; p.x = pk2(x[8 * s], x[8 * s + 1]); p.y = pk2(x[8 * s + 2], x[8 * s + 3]); p.z = pk2(x[8 * s + 4], x[8 * s + 5]); p.w = pk2(x[8 * s + 6], x[8 * s + 7]); return __builtin_bit_cast(bf16x8, p); }
__device__ __forceinline__ f32x16 dn_tile(const LAS bf16* A, int ra, const LAS bf16* B, int rb, int lc, int lh) {
    f32x16 acc;
#pragma unroll
    for (int r = 0; r < 16; ++r) acc[r] = 0.f;
#pragma unroll
    for (int s = 0; s < 4; ++s) { const bf16x8 a = *(const LAS bf16x8*)(A + (ra + lc) * DN_ST + 16 * s + 8 * lh), b = *(const LAS bf16x8*)(B + (rb + lc) * DN_ST + 16 * s + 8 * lh);
        acc = __builtin_amdgcn_mfma_f32_32x32x16_bf16(a, b, acc, 0, 0, 0); }
    return acc;
}
__device__ __forceinline__ void dn_prep(Frame& F) {
    LAS bf16* Qs = (LAS bf16*)(F.lds + RING_OFF);
    LAS bf16* Ks = Qs + 64 * DN_ST;
    LAS bf16* KBs = Ks + 64 * DN_ST;
    LAS bf16* Vs = KBs + 64 * DN_ST;
    LAS bf16* KDT = Vs + 64 * DN_ST;
    LAS bf16* AQK = KDT + 64 * DN_ST;
    LAS bf16* UT = AQK + 64 * DN_ST;
    LAS bf16* WT = UT + 64 * DN_ST;
    LAS bf16* LNO = WT + 64 * DN_ST;
    LAS float* LD = (LAS float*)(LNO + 64 * DN_ST);
    LAS bf16* TDZ = (LAS bf16*)(LD + 64 * 16);
    LAS float* GB = (LAS float*)(TDZ + 64 * 24);
    const bf16* PROJ = (const bf16*)(F.ws + WS_PROJ); const float* BG = (const float*)(F.ws + WS_BG);
    const int tid = F.tid, lane = F.lane, lc = lane & 31, lh = lane >> 5, wave = F.wave;
    LAS float* CW = GB + 256;
    { f32x4 tc[3];
#pragma unroll
      for (int u = 0; u < 3; ++u) tc[u] = *((const f32x4*)F.in[I_CONVW] + tid + 512 * u);
#pragma unroll
      for (int u = 0; u < 3; ++u) *((LAS f32x4*)CW + tid + 512 * u) = tc[u]; }
    LAS v4u* RAW = (LAS v4u*)(F.lds + R1W_OFF);
    constexpr int RAW_CH = 67 * 24;
#define DN_RAW_SRC(i_, b_, h_, n_) ({ const int r_ = (i_) / 24, c_ = (i_) - r_ * 24; const int tl_ = (n_) * 64 - 3 + r_; \
        tl_ >= 0 ? (const v4u*)(PROJ + ((size_t)(b_) * SEQ + tl_) * PIN + (c_ < 8 ? PC_QA : c_ < 16 ? PC_KA : PC_VA) + (h_) * 64 + (c_ & 7) * 8) : (const v4u*)nullptr; })
    { const int u0 = F.vcu, b = u0 >> 11, h = (u0 >> 8) & 7, n = u0 & 255;
      for (int i = tid; i < RAW_CH; i += 512) { const v4u* sp = DN_RAW_SRC(i, b, h, n); v4u z = {0u, 0u, 0u, 0u}; if (sp) z = *sp; RAW[i] = z; }
      if (wave == 0) { const size_t row0 = (size_t)b * SEQ + (size_t)n * 64; float c = BG[(row0 + lane) * 16 + 8 + h];
#pragma unroll
          for (int o = 1; o < 64; o <<= 1) { const float up = __shfl_up(c, o); if (lane >= o) c += up; }
          GB[lane] = c; GB[64 + lane] = BG[(row0 + lane) * 16 + h]; } }
    int par = 0;
    for (int unit = F.vcu; unit < 4096; unit += F.G, par ^= 1) {
        const int b = unit >> 11, h = (unit >> 8) & 7, n = unit & 255;
        LAS float* gcs = GB + par * 128; LAS float* bts = gcs + 64;
        const int un = unit + F.G; const bool more = un < 4096; const int bn = un >> 11, hn = (un >> 8) & 7, nn = un & 255;
        __syncthreads();
        { const int t = tid >> 3, cs = tid & 7;
          float q[8], k[8], v[8];
#pragma unroll
          for (int e = 0; e < 8; ++e) { q[e] = 0.f; k[e] = 0.f; v[e] = 0.f; }
#pragma unroll
          for (int j = 0; j < 4; ++j) { { const LAS v4u* rp = RAW + (t + j) * 24 + cs;
                const v4u wq = rp[0], wk = rp[8], wv = rp[16];
                const LAS float* cw = CW + j * 1536 + h * 64 + cs * 8;
                const unsigned uq[4] = {wq.x, wq.y, wq.z, wq.w}, uk[4] = {wk.x, wk.y, wk.z, wk.w}, uv[4] = {wv.x, wv.y, wv.z, wv.w};
#pragma unroll
                for (int e = 0; e < 4; ++e) { q[2 * e] += cw[2 * e] * bflo(uq[e]); q[2 * e + 1] += cw[2 * e + 1] * bfhi(uq[e]);
                    k[2 * e] += cw[512 + 2 * e] * bflo(uk[e]); k[2 * e + 1] += cw[512 + 2 * e + 1] * bfhi(uk[e]);
                    v[2 * e] += cw[1024 + 2 * e] * bflo(uv[e]); v[2 * e + 1] += cw[1024 + 2 * e + 1] * bfhi(uv[e]); } } }
          float sq = 0.f, sk = 0.f;
#pragma unroll
          for (int e = 0; e < 8; ++e) { q[e] = silu_f(q[e]); k[e] = silu_f(k[e]); v[e] = silu_f(v[e]); sq += q[e] * q[e]; sk += k[e] * k[e]; }
          sq = oct_sum(sq); sk = oct_sum(sk);
          const float rq = 0.125f / sqrtf(sq + EPS), rk = 1.0f / sqrtf(sk + EPS), bt = bts[t], kd = __expf(gcs[63] - gcs[t]);
          v4u oq, ok, ob, ov;
          oq.x = pk2(q[0] * rq, q[1] * rq); oq.y = pk2(q[2] * rq, q[3] * rq); oq.z = pk2(q[4] * rq, q[5] * rq); oq.w = pk2(q[6] * rq, q[7] * rq);
#pragma unroll
          for (int e = 0; e < 8; ++e) k[e] *= rk;
          ok.x = pk2(k[0], k[1]); ok.y = pk2(k[2], k[3]); ok.z = pk2(k[4], k[5]); ok.w = pk2(k[6], k[7]);
          ob.x = pk2(k[0] * bt, k[1] * bt); ob.y = pk2(k[2] * bt, k[3] * bt); ob.z = pk2(k[4] * bt, k[5] * bt); ob.w = pk2(k[6] * bt, k[7] * bt);
          ov.x = pk2(v[0], v[1]); ov.y = pk2(v[2], v[3]); ov.z = pk2(v[4], v[5]); ov.w = pk2(v[6], v[7]);
          *(LAS v4u*)(Qs + t * DN_ST + cs * 8) = oq; *(LAS v4u*)(Ks + t * DN_ST + cs * 8) = ok; *(LAS v4u*)(KBs + t * DN_ST + cs * 8) = ob; *(LAS v4u*)(Vs + t * DN_ST + cs * 8) = ov;
#pragma unroll
          for (int e = 0; e < 8; ++e) KDT[(cs * 8 + e) * DN_ST + t] = (bf16)f2bf(k[e] * kd); }
        __syncthreads();
        v4u pf[7]; float pg = 0.f, pb = 0.f;
        if (wave >= 4 && more) {
#pragma unroll
            for (int k7 = 0; k7 < 7; ++k7) { const int i = (tid - 256) + 256 * k7; pf[k7] = (v4u){0u, 0u, 0u, 0u}; if (i < RAW_CH) { const v4u* sp = DN_RAW_SRC(i, bn, hn, nn); if (sp) pf[k7] = *sp; } }
            if (wave == 4) { const size_t rn = (size_t)bn * SEQ + (size_t)nn * 64; pg = BG[(rn + lane) * 16 + 8 + hn]; pb = BG[(rn + lane) * 16 + hn]; }
        }
        { const int it = (wave >> 1) & 1, jt = wave & 1; const bool qk = wave >= 4;
          f32x16 acc;
          if (it >= jt) acc = dn_tile(qk ? Qs : KBs, 32 * it, Ks, 32 * jt, lc, lh);
          const int j = 32 * jt + lc; const float gj = gcs[j];
#pragma unroll
          for (int r = 0; r < 16; ++r) { const int i = 32 * it + (r & 3) + 8 * (r >> 2) + 4 * lh;
              float val = 0.f;
              if (it >= jt) { if (qk ? (i >= j) : (i > j)) val = acc[r] * __expf(gcs[i] - gj); }
              if (qk) AQK[i * DN_ST + j] = (bf16)f2bf(val);
              else { const bool diag = (i >> 4) == (j >> 4); LNO[i * DN_ST + j] = (bf16)f2bf(diag ? 0.f : -val); if (diag) LD[i * 16 + (j & 15)] = val; } } }
        __syncthreads();
        if (wave == 0) { const int bb = lane >> 4, c = lane & 15; float tcol[16];
#pragma unroll
            for (int i = 0; i < 16; ++i) { float v = (i == c) ? 1.f : 0.f;
#pragma unroll
                for (int j4 = 0; j4 < (i + 3) / 4; ++j4) { const f32x4 a = *(const LAS f32x4*)(LD + (16 * bb + i) * 16 + 4 * j4);
#pragma unroll
                    for (int e = 0; e < 4; ++e) if (4 * j4 + e < i) v -= a[e] * tcol[4 * j4 + e]; }
                tcol[i] = v; TDZ[(16 * bb + i) * 24 + c] = (bf16)f2bf(v); } }
        __syncthreads();
        if (wave < 4) {
            const int ct = wave, cc = 32 * (ct & 1) + lc; const bool isw = ct >= 2;
            f32x16 acc[2];
#pragma unroll
            for (int rt = 0; rt < 2; ++rt)
#pragma unroll
                for (int r = 0; r < 16; ++r) { const int t = 32 * rt + (r & 3) + 8 * (r >> 2) + 4 * lh;
                    acc[rt][r] = isw ? bf2f(Ks[t * DN_ST + cc]) * bts[t] * __expf(gcs[t]) : bf2f(Vs[t * DN_ST + cc]) * bts[t]; }
#define DN_AFRAG(arr, stride, row, kb) ({ const LAS bf16* p_ = (arr) + (row) * (stride) + 16 * (kb) + 4 * lh; const v2u lo_ = *(const LAS v2u*)p_, hi_ = *(const LAS v2u*)(p_ + 8); v4u w_; w_.x = lo_.x; w_.y = lo_.y; w_.z = hi_.x; w_.w = hi_.y; __builtin_bit_cast(bf16x8, w_); })
            f32x16 X[4];
#pragma unroll
            for (int bb = 0; bb < 4; ++bb) { const int rt = bb >> 1, odd = bb & 1;
                bf16x8 ta = DN_AFRAG(TDZ, 24, 32 * rt + lc, 0);
                if ((lc >> 4) != odd) ta = (bf16x8){0, 0, 0, 0, 0, 0, 0, 0};
                f32x16 z;
#pragma unroll
                for (int r = 0; r < 16; ++r) z[r] = 0.f;
                z = __builtin_amdgcn_mfma_f32_32x32x16_bf16(ta, pack8(acc[rt], odd), z, 0, 0, 0);
                X[bb] = z;
                const bf16x8 xb = pack8(z, odd);
                if (bb == 0) { acc[0] = __builtin_amdgcn_mfma_f32_32x32x16_bf16(DN_AFRAG(LNO, DN_ST, lc, 0), xb, acc[0], 0, 0, 0); acc[1] = __builtin_amdgcn_mfma_f32_32x32x16_bf16(DN_AFRAG(LNO, DN_ST, 32 + lc, 0), xb, acc[1], 0, 0, 0); }
                if (bb == 1) { acc[1] = __builtin_amdgcn_mfma_f32_32x32x16_bf16(DN_AFRAG(LNO, DN_ST, 32 + lc, 1), xb, acc[1], 0, 0, 0); }
                if (bb == 2) { acc[1] = __builtin_amdgcn_mfma_f32_32x32x16_bf16(DN_AFRAG(LNO, DN_ST, 32 + lc, 2), xb, acc[1], 0, 0, 0); }
            }
#undef DN_AFRAG
            LAS bf16* dst = (isw ? WT : UT) + cc * DN_ST;
#pragma unroll
            for (int bb = 0; bb < 4; ++bb)
#pragma unroll
                for (int g = 0; g < 2; ++g) { const int r0 = 8 * (bb & 1) + 4 * g; v2u o; o.x = pk2(X[bb][r0], X[bb][r0 + 1]); o.y = pk2(X[bb][r0 + 2], X[bb][r0 + 3]);
                    *(LAS v2u*)(dst + 16 * bb + 8 * g + 4 * lh) = o; }
        } else if (more) {
#pragma unroll
            for (int k7 = 0; k7 < 7; ++k7) { const int i = (tid - 256) + 256 * k7; if (i < RAW_CH) RAW[i] = pf[k7]; }
            if (wave == 4) { float c = pg;
#pragma unroll
                for (int o = 1; o < 64; o <<= 1) { const float up = __shfl_up(c, o); if (lane >= o) c += up; }
                GB[(par ^ 1) * 128 + lane] = c; GB[(par ^ 1) * 128 + 64 + lane] = pb; }
        }
        __syncthreads();
        { bf16* MT = (bf16*)((unsigned char*)F.out + OUT_DN_MT) + (size_t)unit * 4096; bf16* QPT = (bf16*)((unsigned char*)F.out + OUT_DN_QPT) + (size_t)unit * 4096;
          bf16* BM = (bf16*)(F.ws + WS_DN_BM) + (size_t)unit * 4096; bf16* O0T = (bf16*)(F.ws + WS_DN_O0T) + (size_t)unit * 4096;
#pragma unroll 1
          for (int tt = 0; tt < 2; ++tt) { const int task = wave * 2 + tt, p = task >> 2, ta = (task >> 1) & 1, tb = task & 1;
              if (p == 0) {
                  f32x16 acc = dn_tile(WT, 32 * ta, KDT, 32 * tb, lc, lh);
#pragma unroll
                  for (int r = 0; r < 16; ++r) acc[r] = -acc[r];
#pragma unroll
                  for (int s2 = 0; s2 < 2; ++s2) *(bf16x8*)(MT + ((((tb * 2 + ta) * 2 + s2) * 64 + lane) * 8)) = pack8(acc, s2);
              } else if (p == 1) {
                  const f32x16 acc = dn_tile(KDT, 32 * ta, UT, 32 * tb, lc, lh);
#pragma unroll
                  for (int s2 = 0; s2 < 2; ++s2) *(bf16x8*)(BM + ((((tb * 2 + ta) * 2 + s2) * 64 + lane) * 8)) = pack8(acc, s2);
              } else if (p == 2) {
                  f32x16 acc = dn_tile(WT, 32 * ta, AQK, 32 * tb, lc, lh);
                  const int i = 32 * tb + lc; const float eg = __expf(gcs[i]);
#pragma unroll
                  for (int r = 0; r < 16; ++r) { const int a = 32 * ta + (r & 3) + 8 * (r >> 2) + 4 * lh; acc[r] = bf2f(Qs[i * DN_ST + a]) * eg - acc[r]; }
#pragma unroll
                  for (int s2 = 0; s2 < 2; ++s2) *(bf16x8*)(QPT + ((((tb * 2 + ta) * 2 + s2) * 64 + lane) * 8)) = pack8(acc, s2);
              } else {
                  const f32x16 acc = dn_tile(UT, 32 * ta, AQK, 32 * tb, lc, lh);
#pragma unroll
                  for (int s2 = 0; s2 < 2; ++s2) *(bf16x8*)(O0T + ((((tb * 2 + ta) * 2 + s2) * 64 + lane) * 8)) = pack8(acc, s2);
              } }
          if (tid == 0) ((float*)(F.ws + WS_DN_GT))[unit] = __expf(gcs[63]); }
    }
#undef DN_RAW_SRC
    __syncthreads();
}
template <int r>
__device__ __forceinline__ void dn_scan_wave(Frame& F) {
    const int bx = (int)blockIdx.x, w = (bx & 7) * 4 + (bx >> 3), bh = w >> 1, ct = w & 1, lane = F.lane;
    const bf16x8* MT = (const bf16x8*)((const unsigned char*)F.out + OUT_DN_MT); const bf16x8* BM = (const bf16x8*)(F.ws + WS_DN_BM); bf16x8* SS = (bf16x8*)(F.ws + WS_DN_S);
    const float* GT = (const float*)(F.ws + WS_DN_GT);
    LAS bf16x8* MB = (LAS bf16x8*)(F.lds + RING_OFF);
    volatile LAS int* FL = (volatile LAS int*)(F.lds + LDSCTL_OFF + 64);
    f32x16 S;
#pragma unroll
    for (int q = 0; q < 16; ++q) S[q] = 0.f;
    bf16x8 mA[4], bA[2], mB[4], bB[2], mC[4], bC[2], mD[4], bD[2], mE[4], bE[2], mG[4], bG[2]; float gA, gB, gC, gD, gE, gG;
#define DN_SLOAD(m, bm, gt, u) do { const size_t ub = (size_t)(u) * 512; _Pragma("unroll") for (int f = 0; f < 4; ++f) m[f] = MT[ub + (r * 4 + f) * 64 + lane]; \
        _Pragma("unroll") for (int f = 0; f < 2; ++f) bm[f] = BM[ub + ((ct * 2 + r) * 2 + f) * 64 + lane]; gt = GT[u]; } while (0)
#define DN_STEP(cm, cb, cg, unit, n) do { \
        bf16x8 own[2]; own[0] = pack8(S, 0); own[1] = pack8(S, 1); \
        LAS bf16x8* mb = MB + ((n) & 1) * 256; \
        mb[(r * 2 + 0) * 64 + lane] = own[0]; mb[(r * 2 + 1) * 64 + lane] = own[1]; \
        asm volatile("s_waitcnt lgkmcnt(0)" ::: "memory"); \
        if (lane == 0) FL[r] = (n) + 1; \
        SS[(size_t)(unit) * 512 + (ct * 4 + r * 2 + 0) * 64 + lane] = own[0]; SS[(size_t)(unit) * 512 + (ct * 4 + r * 2 + 1) * 64 + lane] = own[1]; \
        f32x16 A; \
        { const v4u b0 = __builtin_bit_cast(v4u, cb[0]), b1 = __builtin_bit_cast(v4u, cb[1]); const unsigned u0[8] = {b0.x, b0.y, b0.z, b0.w, b1.x, b1.y, b1.z, b1.w}; \
          _Pragma("unroll") for (int e = 0; e < 8; ++e) { A[2 * e] = cg * S[2 * e] + bflo(u0[e]); A[2 * e + 1] = cg * S[2 * e + 1] + bfhi(u0[e]); } } \
        while (FL[1 - r] < (n) + 1) { } \
        asm volatile("" ::: "memory"); \
        bf16x8 oth[2]; oth[0] = mb[((1 - r) * 2 + 0) * 64 + lane]; oth[1] = mb[((1 - r) * 2 + 1) * 64 + lane]; \
          \
        _Pragma("unroll") for (int s2 = 0; s2 < 2; ++s2) { A = __builtin_amdgcn_mfma_f32_32x32x16_bf16(cm[r * 2 + s2], own[s2], A, 0, 0, 0); A = __builtin_amdgcn_mfma_f32_32x32x16_bf16(cm[(1 - r) * 2 + s2], oth[s2], A, 0, 0, 0); } \
        S = A; } while (0)
    const int u0 = bh * 256;
    DN_SLOAD(mA, bA, gA, u0); DN_SLOAD(mB, bB, gB, u0 + 1); DN_SLOAD(mC, bC, gC, u0 + 2); DN_SLOAD(mD, bD, gD, u0 + 3); DN_SLOAD(mE, bE, gE, u0 + 4); DN_SLOAD(mG, bG, gG, u0 + 5);
    for (int n = 0; n < 252; n += 6) {
        DN_STEP(mA, bA, gA, u0 + n, n);         DN_SLOAD(mA, bA, gA, u0 + n + 6);
        DN_STEP(mB, bB, gB, u0 + n + 1, n + 1); DN_SLOAD(mB, bB, gB, u0 + n + 7);
        DN_STEP(mC, bC, gC, u0 + n + 2, n + 2); DN_SLOAD(mC, bC, gC, u0 + n + 8);
        DN_STEP(mD, bD, gD, u0 + n + 3, n + 3); DN_SLOAD(mD, bD, gD, u0 + n + 9);
        DN_STEP(mE, bE, gE, u0 + n + 4, n + 4); if (n + 10 < 256) DN_SLOAD(mE, bE, gE, u0 + n + 10);
        DN_STEP(mG, bG, gG, u0 + n + 5, n + 5); if (n + 11 < 256) DN_SLOAD(mG, bG, gG, u0 + n + 11);
    }
    DN_STEP(mA, bA, gA, u0 + 252, 252); DN_STEP(mB, bB, gB, u0 + 253, 253); DN_STEP(mC, bC, gC, u0 + 254, 254); DN_STEP(mD, bD, gD, u0 + 255, 255);
#undef DN_SLOAD
#undef DN_STEP
}
__device__ __forceinline__ void dn_scan(Frame& F) {
    if ((int)blockIdx.x >= 32) return;
    if (F.wave == 0) dn_scan_wave<0>(F); else if (F.wave == 1) dn_scan_wave<1>(F);
}
__device__ __forceinline__ void dn_output(Frame& F) {
    const bf16x8* QPT = (const bf16x8*)((const unsigned char*)F.out + OUT_DN_QPT); const bf16x8* O0T = (const bf16x8*)(F.ws + WS_DN_O0T); const bf16x8* SS = (const bf16x8*)(F.ws + WS_DN_S);
    const bf16* PROJ = (const bf16*)(F.ws + WS_PROJ); bf16* OAB = (bf16*)(F.ws + WS_OAB);
    const int lane = F.lane, lc = lane & 31, lh = lane >> 5; int nbad = 0; (void)nbad;
    for (int task = F.vcu * NWAVES + F.wave; task < 8192; task += F.G * NWAVES) {
        const int unit = task >> 1, it = task & 1, b = unit >> 11, h = (unit >> 8) & 7, n = unit & 255;
        const size_t ub = (size_t)unit * 512;
        f32x16 o[2];
#pragma unroll
        for (int ct = 0; ct < 2; ++ct) {
            const v4u c0 = __builtin_bit_cast(v4u, O0T[ub + ((it * 2 + ct) * 2 + 0) * 64 + lane]), c1 = __builtin_bit_cast(v4u, O0T[ub + ((it * 2 + ct) * 2 + 1) * 64 + lane]);
            const unsigned u[8] = {c0.x, c0.y, c0.z, c0.w, c1.x, c1.y, c1.z, c1.w};
#pragma unroll
            for (int e = 0; e < 8; ++e) { o[ct][2 * e] = bflo(u[e]); o[ct][2 * e + 1] = bfhi(u[e]); }
#pragma unroll
            for (int at = 0; at < 2; ++at)
#pragma unroll
                for (int s2 = 0; s2 < 2; ++s2) o[ct] = __builtin_amdgcn_mfma_f32_32x32x16_bf16(SS[ub + (ct * 4 + at * 2 + s2) * 64 + lane], QPT[ub + ((it * 2 + at) * 2 + s2) * 64 + lane], o[ct], 0, 0, 0);
        }
        float ss = 0.f;
#pragma unroll
        for (int ct = 0; ct < 2; ++ct)
#pragma unroll
            for (int r = 0; r < 16; ++r) ss += o[ct][r] * o[ct][r];
        ss += __shfl_xor(ss, 32);
        const float rs = 1.0f / sqrtf(ss * (1.0f / 64.0f) + EPS);
        const size_t row = (size_t)b * SEQ + (size_t)n * 64 + it * 32 + lc;
#pragma unroll
        for (int ct = 0; ct < 2; ++ct)
#pragma unroll
            for (int rg = 0; rg < 4; ++rg) { const int c0 = 32 * ct + 8 * rg + 4 * lh;
                const v2u zz = *(const v2u*)(PROJ + row * PIN + PC_ZA + h * 64 + c0); const f32x4 ow = *(const f32x4*)(F.in[I_ONORM] + c0);
                const float z0 = bflo(zz.x), z1 = bfhi(zz.x), z2 = bflo(zz.y), z3 = bfhi(zz.y);
                v2u ov; ov.x = pk2(o[ct][4 * rg] * rs * ow[0] * silu_f(z0), o[ct][4 * rg + 1] * rs * ow[1] * silu_f(z1)); ov.y = pk2(o[ct][4 * rg + 2] * rs * ow[2] * silu_f(z2), o[ct][4 * rg + 3] * rs * ow[3] * silu_f(z3));
                *(v2u*)(OAB + row * D + h * 64 + c0) = ov;
            }
    }
}

template <int WIN>
__device__ __forceinline__ void pooled_block(const bf16* H, bf16* P, const int t0, const int tl0, const int col) {
    v4u r[WIN - 1 + 8];
#pragma unroll
    for (int j = 0; j < WIN - 1 + 8; ++j) { const int dt = j - (WIN - 1); r[j] = (v4u){0u, 0u, 0u, 0u}; if (tl0 + dt >= 0) r[j] = *(const v4u*)(H + (size_t)(t0 + dt) * D + col); }
    float s[8];
#pragma unroll
    for (int q = 0; q < 8; ++q) s[q] = 0.f;
#define POOL_ACC(sgn, VV) do { const v4u q_ = (VV); s[0] += sgn bflo(q_.x); s[1] += sgn bfhi(q_.x); s[2] += sgn bflo(q_.y); s[3] += sgn bfhi(q_.y); s[4] += sgn bflo(q_.z); s[5] += sgn bfhi(q_.z); s[6] += sgn bflo(q_.w); s[7] += sgn bfhi(q_.w); } while (0)
#pragma unroll
    for (int j = 0; j < WIN - 1; ++j) POOL_ACC(+, r[j]);
#pragma unroll
    for (int i = 0; i < 8; ++i) { const v4u self = r[WIN - 1 + i]; POOL_ACC(+, self);
        const int n = (tl0 + i + 1) < WIN ? (tl0 + i + 1) : WIN; const float inv = 1.0f / (float)n;
        v4u o; o.x = pk2(s[0] * inv - bflo(self.x), s[1] * inv - bfhi(self.x)); o.y = pk2(s[2] * inv - bflo(self.y), s[3] * inv - bfhi(self.y));
        o.z = pk2(s[4] * inv - bflo(self.z), s[5] * inv - bfhi(self.z)); o.w = pk2(s[6] * inv - bflo(self.w), s[7] * inv - bfhi(self.w));
        *(v4u*)(P + (size_t)(t0 + i) * D + col) = o;
        POOL_ACC(-, r[i]); }
#undef POOL_ACC
}
__device__ __forceinline__ void pooled_phase(Frame& F) {
    const bf16* H = (const bf16*)(F.ws + WS_H); bf16* P = (bf16*)(F.ws + WS_OAB);
    const int gt = F.vcu * 512 + F.tid, NT = F.G * 512;
    for (int it = gt; it < (NTOK / 8) * 128; it += NT) {
        const int c = it & 31, g = __builtin_amdgcn_readfirstlane((it >> 6) & 3), tb = ((it >> 8) << 1) | ((it >> 5) & 1);
        const int t0 = tb * 8, tl0 = t0 & (SEQ - 1), col = g * 256 + c * 8;
        if (g == 0) pooled_block<2>(H, P, t0, tl0, col); else if (g == 1) pooled_block<4>(H, P, t0, tl0, col); else if (g == 2) pooled_block<8>(H, P, t0, tl0, col); else pooled_block<16>(H, P, t0, tl0, col);
    }
}


#ifndef PH_MASK
#define PH_MASK 0xFFFFFF
#endif
#define IN(k) (((PH_MASK >> (k)) & 1) && lo <= (k) && (k) < hi)
#define BOTH(k) (IN(k) && IN((k) + 1))
#if MK_ONE_LAUNCH
#define GRID_BAR() xcd_barrier(bar)
#else
#define GRID_BAR() do { } while (0)
#endif
template <int LAYER>
__device__ __forceinline__ void moe_phases(Frame& F, const XcdBarrier& bar, const int lo, const int hi) {
    constexpr int pb = LAYER == 0 ? 7 : 13;
    bf16* const H = (bf16*)(F.ws + WS_H);
    const float* const MOD = (const float*)(F.ws + WS_MOD);
    if (IN(pb)) {
        moe_route(F, LAYER); if (BOTH(pb)) GRID_BAR(); }
    if (IN(pb + 1)) {
        build_moe_tables(F, LAYER);
        pg8::Gemm g{(const bf16*)H, 1024, 1024}; MoeSched S; S.init((const LAS int*)(F.lds + SCHED_OFF), F.G, (int)blockIdx.x, (const int*)(F.ws + WS_RT), F.ws + WS_WGU, 1024, 1024);
        EpiSwiglu E{(bf16*)(F.ws + WS_ACT)};
        if (LAYER == 1) { S.Blo = (const char*)(F.ws + WS_WGT); S.esplit = 16; }
        moe_tail_plan(F);
        pg8::gemm_phase<EpiSwiglu, MoeSched>(F.lds + RING_OFF, g, S, E);
        {
            const LAS int* T = (const LAS int*)(F.lds + SCHED_OFF); const int sp = T[67];
            const int q0 = LAYER == 0 ? 0 : CQ_NG, q1 = LAYER == 0 ? CQ_NGT : CQ_N;
            if (sp > 0) { __syncthreads(); const int f = q0 + T[65] * 8 * TQ_GU; int e = f + sp * 8 * TQ_GU; e = e < q1 ? e : q1; convert_range(F, 1, f, e, F.wave, 8); }
            if (LAYER == 1) { int t = q0 + T[66] * 8 * TQ_GU;
                if (t < q1) { __syncthreads(); convert_range(F, 1, t, q1, F.vcu * NWAVES + F.wave, F.G * NWAVES); } } }
        if (BOTH(pb + 1)) GRID_BAR();
    }
    if (IN(pb + 2)) {
        build_moe_tables(F, LAYER);
        pg8::Gemm g{(const bf16*)(F.ws + WS_ACT), 512, 512}; MoeSched S; S.init((const LAS int*)(F.lds + SCHED_OFF), F.G, (int)blockIdx.x, nullptr, F.ws + WS_WD, 512, 512);
        EpiStoreBf16 E{(bf16*)(F.ws + WS_Y), D};
        if (LAYER == 0) moe_tail_plan(F);
        pg8::gemm_phase<EpiStoreBf16, MoeSched>(F.lds + RING_OFF, g, S, E);
        if (LAYER == 0) {
            const LAS int* T = (const LAS int*)(F.lds + SCHED_OFF); const int sp = T[67];
            int t8 = T[66] * 8 * TQ_GU; t8 = t8 < CQ_NGT ? t8 : CQ_NGT;
            if (sp > 0) { __syncthreads(); const int f = t8 + T[65] * 8 * TQ_DN; int e = f + sp * 8 * TQ_DN; e = e < CQ_NG ? e : CQ_NG; convert_range(F, 1, f, e, F.wave, 8); } }
        if (BOTH(pb + 2)) GRID_BAR();
    }
    if (IN(pb + 3)) {
        build_moe_tables(F, LAYER);
        if (LAYER == 0) moe_tail_plan(F);
        const int tokw = F.vcu * 128 + F.wave * 16, b = (F.vcu * 128) / SEQ;
        f32x4 g2[4];
#pragma unroll
        for (int j = 0; j < 4; ++j) g2[j] = *((const f32x4*)(MOD + (size_t)(LAYER * 2 + b) * 6144 + 5 * 1024) + F.lane + 64 * j);
        if (LAYER == 0) {
            const ModVec m1 = load_mod(F.in[I_NMIX] + D, MOD + (size_t)(2 + b) * 6144 + 1024, MOD + (size_t)(2 + b) * 6144, F.lane);
            { const CombRecs recs = comb_load_recs(F, tokw); CombRows cur, nxt; comb_issue(F, recs, 0, tokw, cur);
              for (int i = 0; i < 16; ++i) { const int t = tokw + i;
                  if (i + 1 < 16) comb_issue(F, recs, i + 1, t + 1, nxt);
                  const RowVec x = comb_finish(recs, i, cur, g2);
                  store_row_bf16((bf16*)(F.ws + WS_XRB) + (size_t)t * D, F.lane, x); store_row_bf16(H + (size_t)t * D, F.lane, apply_mod(x, row_rstd(x), m1));
                  cur = nxt; } }
            __syncthreads();
            { const LAS int* T = (const LAS int*)(F.lds + SCHED_OFF);
              int t8 = T[66] * 8 * TQ_GU; t8 = t8 < CQ_NGT ? t8 : CQ_NGT; int t9 = t8 + T[66] * 8 * TQ_DN; t9 = t9 < CQ_NG ? t9 : CQ_NG;
              convert_range(F, 1, t9, CQ_NG, F.vcu * NWAVES + F.wave, F.G * NWAVES); }
        } else {
            f32x4 fw[4];
#pragma unroll
            for (int j = 0; j < 4; ++j) fw[j] = *((const f32x4*)F.in[I_FNW] + F.lane + 64 * j);
            { const CombRecs recs = comb_load_recs(F, tokw); CombRows cur, nxt; comb_issue(F, recs, 0, tokw, cur);
              for (int i = 0; i < 16; ++i) { const int t = tokw + i;
                  if (i + 1 < 16) comb_issue(F, recs, i + 1, t + 1, nxt);
                  RowVec x = comb_finish(recs, i, cur, g2); const float rstd = row_rstd(x);
#pragma unroll
                  for (int j = 0; j < 4; ++j) x.v[j] = x.v[j] * rstd * fw[j];
                  store_row_f32(F.out + (size_t)t * D, F.lane, x);
                  cur = nxt; } }
        }
        if (BOTH(pb + 3)) GRID_BAR();
    }
}

constexpr int PH_P0 = 0, PH_P1 = 1, PH_INPROJ = 2, PH_ATT = 3, PH_SCAN = 4, PH_DNOUT = 5, PH_OUTPROJ = 6, PH_MOE0 = 7, PH_POOLED = 11, PH_POOLG = 12, PH_MOE1 = 13;
constexpr int N_PHASES = 17;
struct Args { const float* in[24]; float* out; unsigned char* ws; int ph_lo, ph_hi; };
__global__ void __launch_bounds__(NWAVES * 64, 2) trunk_fwd(Args args) {
    __shared__ __attribute__((aligned(16))) unsigned char lds[LDS_BYTES];
    Frame F;
    F.lds = (LAS unsigned char*)lds;
    F.MISC = (volatile LAS unsigned*)(F.lds + MISC_OFF);
    F.tid = threadIdx.x; F.lane = F.tid & 63; F.wave = __builtin_amdgcn_readfirstlane(F.tid >> 6);
    F.G = gridDim.x; { const int bx = blockIdx.x; F.vcu = (F.G % 8 == 0) ? (bx % 8) * (F.G / 8) + bx / 8 : bx; }
#pragma unroll
    for (int i = 0; i < 24; ++i) F.in[i] = args.in[i];
    F.out = args.out; F.ws = args.ws; F.ctl = (gu32*)(args.ws + WS_CTL);
    for (int u = F.tid; u < (LDS_BYTES - LDSCTL_OFF) / 4; u += NWAVES * 64) ((LAS unsigned*)(F.lds + LDSCTL_OFF))[u] = 0u;
    __syncthreads();
#if MK_ONE_LAUNCH
    XcdBarrier bar = xcd_barrier_post((unsigned*)(F.ctl + CW_BAR), F.MISC + 8);
#else
    XcdBarrier bar; bar.bar = nullptr; bar.x = 0; bar.st = nullptr;
#endif
    const int lo = args.ph_lo, hi = args.ph_hi;

    bf16* const H = (bf16*)(F.ws + WS_H);
    const float* const MOD = (const float*)(F.ws + WS_MOD);

    if (IN(PH_P0)) { p0_prologue(F); if (BOTH(PH_P0)) GRID_BAR(); }
    if (IN(PH_P1)) { p1_prenorm0(F); if (BOTH(PH_P1)) GRID_BAR(); }
    if (IN(PH_INPROJ)) {
        pg8::Gemm g{(const bf16*)H, 1024, 1024}; DenseSched S; S.init(NTOK, IP_TILES * 256, F.G, (int)blockIdx.x, 1024, 0, F.ws + WS_WIN, 1024); S.gap_from = PC_ZA / 256; S.gap = 2;
        EpiStoreBf16 E{(bf16*)(F.ws + WS_PROJ), PIN};
        pg8::gemm_phase<EpiStoreBf16, DenseSched>(F.lds + RING_OFF, g, S, E);
        if (IP_FULL && (int)blockIdx.x >= IP_FULL) {
            __syncthreads(); const int r = (int)blockIdx.x - IP_FULL; convert_range(F, 0, r * 8 * TQ_INPROJ, (r + 1) * 8 * TQ_INPROJ, F.wave, 8); }
        if (BOTH(PH_INPROJ)) GRID_BAR();
    }
    if (IN(PH_ATT)) { dn_prep(F); if (BOTH(PH_ATT)) GRID_BAR(); }
    if (IN(PH_SCAN)) {
        if ((int)blockIdx.x < 32) dn_scan(F);
        else { const int o = (int)blockIdx.x - 32, NO = F.G - 32;
            attn_phase(F, o, NO); __syncthreads();
            { pg8::Gemm g{(const bf16*)H, 1024, 1024}; EpiStoreBf16 E{(bf16*)(F.ws + WS_PROJ), PIN};
              DenseSched S; S.init(NTOK, 512, NO, o, 1024, 0, F.ws + WS_WIN, 1024); S.gap_from = 0; S.gap = PC_ZA / 256; S.Lend = NO;
              pg8::gemm_phase<EpiStoreBf16, DenseSched>(F.lds + RING_OFF, g, S, E);
              if (o >= 64 && o < 64 + (S.nwg - NO)) { __syncthreads(); S.L0 = NO; S.G = S.nwg - NO; S.c = o - 64; S.Lend = S.nwg;
                  pg8::gemm_phase<EpiStoreBf16, DenseSched>(F.lds + RING_OFF, g, S, E); } }
            __syncthreads();
            { const int q = o < 64 ? 6 : o < 96 ? 4 : 9, off = o < 64 ? 48 * o : o < 96 ? 3072 + 32 * (o - 64) : 4096 + 72 * (o - 96);
              convert_range(F, 0, CQ_T2 + off, CQ_T2 + off + 8 * q, F.wave, 8);
              convert_range(F, 0, CQ_T2 + 4096 + 72 * 128, CQ_N, o * NWAVES + F.wave, NO * NWAVES); } }
        if (BOTH(PH_SCAN)) GRID_BAR(); }
    if (IN(PH_DNOUT)) { dn_output(F); if (BOTH(PH_DNOUT)) GRID_BAR(); }
    if (IN(PH_OUTPROJ)) {
        pg8::Gemm g{(const bf16*)(F.ws + WS_OAB), 1024, 1024}; DenseSched S; S.init(NTOK, D, F.G, (int)blockIdx.x, 1024, 0, F.ws + WS_WOUT, 1024);
        EpiResid<true> E{F.in[I_X], (bf16*)(F.ws + WS_XRB), MOD + 2 * 1024, nullptr};
        pg8::gemm_phase<EpiResid<true>, DenseSched>(F.lds + RING_OFF, g, S, E);
        if (BOTH(PH_OUTPROJ)) GRID_BAR();
    }
    moe_phases<0>(F, bar, lo, hi);
    if (IN(PH_POOLED)) { pooled_phase(F); if (BOTH(PH_POOLED)) GRID_BAR(); }
    if (IN(PH_POOLG)) {
        pg8::Gemm g{(const bf16*)(F.ws + WS_OAB), 256, 256}; DenseSched S; S.init(NTOK, D, F.G, (int)blockIdx.x, 1024, 256, F.ws + WS_POOLW, 256);
        EpiResid<false> E{nullptr, (bf16*)(F.ws + WS_XRB), MOD + (size_t)2 * 6144 + 2 * 1024, F.in[I_POOLS]};
        pg8::gemm_phase<EpiResid<false>, DenseSched>(F.lds + RING_OFF, g, S, E);
        if (BOTH(PH_POOLG)) GRID_BAR();
    }
    moe_phases<1>(F, bar, lo, hi);
#undef IN
#undef BOTH
}

extern "C" void kernel_launch(void* const* d_in, const int* in_sizes, int n_in, void* d_out, int out_size, void* d_ws, size_t ws_size, hipStream_t stream) {
    static int grid = 0;
    if (grid == 0) {
        if (n_in != 24 || in_sizes[0] != NTOK * D || out_size != NTOK * D || ws_size < WS_END2) { fprintf(stderr, "kernel_launch: unexpected shapes (n_in %d, in0 %d, out %d, ws %zu); nothing launched\n", n_in, n_in > 0 ? in_sizes[0] : -1, out_size, ws_size); grid = -1; return; }
        int per_cu = 0;
        if (hipOccupancyMaxActiveBlocksPerMultiprocessor(&per_cu, (const void*)trunk_fwd, NWAVES * 64, 0) != hipSuccess || per_cu < 1) fprintf(stderr, "kernel_launch: occupancy query says %d\n", per_cu);
        (void)hipGetLastError();
        grid = 256;
    }
    if (grid < 0) return;
    if (hipMemsetAsync((char*)d_ws + WS_CTL, 0, CTL_ZERO_BYTES, stream) != hipSuccess) { fprintf(stderr, "kernel_launch: memset failed\n"); return; }
    Args a{};
    for (int i = 0; i < 24; ++i) a.in[i] = (const float*)d_in[i];
    a.out = (float*)d_out; a.ws = (unsigned char*)d_ws;
#if MK_ONE_LAUNCH
    a.ph_lo = 0; a.ph_hi = N_PHASES;
    hipLaunchKernelGGL(trunk_fwd, dim3(grid), dim3(NWAVES * 64), 0, stream, a);
#else
    for (int p = 0; p < N_PHASES; ++p) { a.ph_lo = p; a.ph_hi = p + 1; hipLaunchKernelGGL(trunk_fwd, dim3(grid), dim3(NWAVES * 64), 0, stream, a); }
#endif
}
```

```cpp
#include <hip/hip_runtime.h>
#include <cstdio>
#include <cstdint>

#ifndef MK_ONE_LAUNCH
#define MK_ONE_LAUNCH 1
#endif

#define GAS __attribute__((address_space(1)))
#define LAS __attribute__((address_space(3)))
typedef unsigned short bf16;
typedef unsigned v4u __attribute__((ext_vector_type(4)));
typedef unsigned v2u __attribute__((ext_vector_type(2)));
typedef float f32x4 __attribute__((ext_vector_type(4)));
typedef float f32x2 __attribute__((ext_vector_type(2)));
typedef float f32x16 __attribute__((ext_vector_type(16)));
typedef short bf16x8 __attribute__((ext_vector_type(8)));
typedef GAS unsigned gu32;
#define RLX_AGENT __ATOMIC_RELAXED, __HIP_MEMORY_SCOPE_AGENT
#define LDS_WAIT() asm volatile("s_waitcnt lgkmcnt(0)" ::: "memory")
#define VM_WAIT() asm volatile("s_waitcnt vmcnt(0)" ::: "memory")

constexpr int BATCH = 2, SEQ = 16384, D = 1024, NTOK = BATCH * SEQ;
constexpr int PIN = 2816;
constexpr int PC_QA = 0, PC_KA = 512, PC_VA = 1024, PC_ZA = 1536, PC_QB = 2048, PC_KB = 2560, PC_VB = 2688;
constexpr int NEXP = 32, DFF = 512;
constexpr int MAXTILES = NTOK * 2 / 256 + NEXP;
constexpr float EPS = 1e-6f;
constexpr int NWAVES = 8;

constexpr size_t MiB = 1u << 20;
constexpr size_t WS_CTL = 0, CTL_ZERO_BYTES = 1 * MiB;
constexpr size_t WS_MOD = 1 * MiB;
constexpr size_t WS_WBA = 1 * MiB + 128 * 1024;
constexpr size_t WS_ROUTE = 2 * MiB;
constexpr size_t WS_RT = 3 * MiB;
constexpr size_t WS_BG = 7 * MiB;
constexpr size_t WS_WIN = 10 * MiB;
constexpr size_t WS_WOUT = 16 * MiB;
constexpr size_t WS_POOLW = 18 * MiB;
constexpr size_t WS_WGU = 20 * MiB;
constexpr size_t WS_WD = 84 * MiB;
constexpr size_t WS_H = 116 * MiB;
constexpr size_t WS_PROJ = 180 * MiB;
constexpr size_t WS_OAB = 356 * MiB;
constexpr size_t WS_YM = 180 * MiB;
constexpr size_t WS_ACT = 180 * MiB;
constexpr size_t WS_Y = 252 * MiB;
constexpr size_t WS_END = 420 * MiB;
constexpr size_t OUT_DN_MT = 0, OUT_DN_QPT = 32 * MiB;
constexpr size_t WS_DN_BM = 420 * MiB, WS_DN_O0T = 452 * MiB, WS_DN_S = 484 * MiB;
constexpr size_t WS_DN_GT = 9 * MiB;
constexpr size_t WS_XRB = 420 * MiB;
constexpr size_t WS_WGT = 484 * MiB;
constexpr size_t WS_END2 = 516 * MiB;
constexpr int CW_CNT = 64;
constexpr int CW_BAR = 4096;
constexpr int CW_BAD = 200;

constexpr int RING_OFF = 0, RING_BYTES = 131072;
constexpr int LDSCTL_OFF = RING_BYTES, MISC_OFF = LDSCTL_OFF + 320;
constexpr int SCHED_OFF = LDSCTL_OFF + 1024;
constexpr int LDS_BYTES = 163840;
constexpr int R1W_OFF = 135168;
constexpr int RT_LDS_OFF = 151552;

typedef __bf16 bf16x2_t __attribute__((ext_vector_type(2)));
__device__ __forceinline__ unsigned pk2(float lo, float hi) { bf16x2_t v; v.x = (__bf16)lo; v.y = (__bf16)hi; return __builtin_bit_cast(unsigned, v); }
__device__ __forceinline__ unsigned f2bf(float f) { return pk2(f, 0.f) & 0xffffu; }
__device__ __forceinline__ float bf2f(unsigned b) { return __builtin_bit_cast(float, b << 16); }
__device__ __forceinline__ float bflo(unsigned w) { return __builtin_bit_cast(float, w << 16); }
__device__ __forceinline__ float bfhi(unsigned w) { return __builtin_bit_cast(float, w & 0xffff0000u); }
template <int CTRL> __device__ __forceinline__ float dpp_f(float v) { return __builtin_bit_cast(float, __builtin_amdgcn_update_dpp(0, __builtin_bit_cast(int, v), CTRL, 0xf, 0xf, false)); }
__device__ __forceinline__ float quad_sum(float v) { v += dpp_f<0xB1>(v); v += dpp_f<0x4E>(v); return v; }
__device__ __forceinline__ float oct_sum(float v) { v = quad_sum(v); v += dpp_f<0x141>(v); return v; }
__device__ __forceinline__ float wave_sum(float v) {
    v = oct_sum(v); v += dpp_f<0x140>(v);
    const float r0 = __builtin_bit_cast(float, __builtin_amdgcn_readlane(__builtin_bit_cast(int, v), 0)), r1 = __builtin_bit_cast(float, __builtin_amdgcn_readlane(__builtin_bit_cast(int, v), 16));
    const float r2 = __builtin_bit_cast(float, __builtin_amdgcn_readlane(__builtin_bit_cast(int, v), 32)), r3 = __builtin_bit_cast(float, __builtin_amdgcn_readlane(__builtin_bit_cast(int, v), 48));
    return (r0 + r1) + (r2 + r3);
}
__device__ __forceinline__ float rl(float x, int l) { return __builtin_bit_cast(float, __builtin_amdgcn_readlane(__builtin_bit_cast(int, x), l)); }
template <int CTRL, int M> __device__ __forceinline__ void ms_halve(const float (&in)[2 * M], float (&out)[M], bool s) {
#pragma unroll
    for (int k = 0; k < M; ++k) { const float keep = s ? in[k + M] : in[k], send = s ? in[k] : in[k + M]; out[k] = keep + dpp_f<CTRL>(send); }
}
__device__ __forceinline__ float ms_rows(float v) {
    { unsigned a = __builtin_bit_cast(unsigned, v), b = a; asm volatile("s_nop 1\n\tv_permlane16_swap_b32 %0, %1" : "+v"(a), "+v"(b)); v = __builtin_bit_cast(float, a) + __builtin_bit_cast(float, b); }
    { unsigned a = __builtin_bit_cast(unsigned, v), b = a; asm volatile("s_nop 1\n\tv_permlane32_swap_b32 %0, %1" : "+v"(a), "+v"(b)); v = __builtin_bit_cast(float, a) + __builtin_bit_cast(float, b); }
    return v;
}
__device__ __forceinline__ float multi_sum16(const float (&v)[16], int lane) {
    float a[8], b[4], c[2], d[1];
    ms_halve<0x140, 8>(v, a, (lane & 8) != 0); ms_halve<0x141, 4>(a, b, (lane & 4) != 0); ms_halve<0x4E, 2>(b, c, (lane & 2) != 0); ms_halve<0xB1, 1>(c, d, (lane & 1) != 0);
    return ms_rows(d[0]);
}
__device__ __forceinline__ float multi_sum8(const float (&v)[8], int lane) {
    float a[4], b[2], c[1];
    ms_halve<0x140, 4>(v, a, (lane & 8) != 0); ms_halve<0x141, 2>(a, b, (lane & 4) != 0); ms_halve<0x4E, 1>(b, c, (lane & 2) != 0);
    float r = c[0]; r += dpp_f<0xB1>(r); return ms_rows(r);
}
__device__ __forceinline__ float multi_sum4(const float (&v)[4], int lane) {
    float a[2], b[1];
    ms_halve<0x140, 2>(v, a, (lane & 8) != 0); ms_halve<0x141, 1>(a, b, (lane & 4) != 0);
    float r = b[0]; r += dpp_f<0x4E>(r); r += dpp_f<0xB1>(r); return ms_rows(r);
}
__device__ __forceinline__ float silu_f(float x) { return x / (1.f + __expf(-x)); }
__device__ __forceinline__ float sigmoid_f(float x) { return 1.f / (1.f + __expf(-x)); }
__device__ __forceinline__ float softplus_f(float x) { return x > 20.f ? x : log1pf(__expf(x)); }

namespace pg8 {
#define PG8_LAS __attribute__((address_space(3)))
typedef unsigned short bf16_t;
typedef unsigned u32x4 __attribute__((ext_vector_type(4)));
constexpr int BM = 256, BK = 64, HALF = 128, HTB = HALF * BK * 2, STAGE_BYTES = 8 * HTB;

__host__ __device__ __forceinline__ int lds_byte(int r, int c) { const int st = (r >> 4) * 2 + (c >> 5), rr = r & 15, cc = c & 31, ob = rr * 64 + cc * 2; return st * 1024 + (ob ^ (((ob >> 9) & 1) << 5)); }
__host__ __device__ __forceinline__ void stage_rc(int b, int& R, int& C) { const int st = b / 1024, sb = b % 1024, swz = sb ^ (((sb >> 9) & 1) << 5); R = (st >> 1) * 16 + swz / 64; C = (st & 1) * 32 + (swz % 64) / 2; }
__host__ __device__ __forceinline__ int perm32(int rho) { const int n = rho >> 4, i = rho & 15; return 8 * (i >> 2) + 4 * n + (i & 3); }

struct Unit { int pm, pn, e; };
struct Gemm { const bf16_t* A; int K, ldb; };

template <class Epi, class Sched>
__device__ __forceinline__ void gemm_phase(PG8_LAS unsigned char* lds, const Gemm g, const Sched& S, const Epi& E) {
    const int tid = threadIdx.x, wid = __builtin_amdgcn_readfirstlane(tid >> 6), lane = tid & 63, wr = wid >> 2, wc = wid & 3, fr = lane & 15, fq = lane >> 4;
    const int K = g.K, nt = K / BK;
    int R0, C0, R1, C1; stage_rc(tid * 16, R0, C0); stage_rc(tid * 16 + 8192, R1, C1);
    const int Rb0 = (R0 & ~31) + perm32(R0 & 31), Rb1 = (R1 & ~31) + perm32(R1 & 31);
    const unsigned voffB0 = (unsigned)(Rb0 * g.ldb + C0) * 2u, voffB1 = (unsigned)(Rb1 * g.ldb + C1) * 2u;
    const size_t kstep = (size_t)(BK * 2);
    const size_t hstepB = (size_t)HALF * g.ldb * 2;
    const unsigned ldsw = (unsigned)wid * 1024u;
    const int aoff = lds_byte(wr * 64 + fr, fq * 8), boff = lds_byte(wc * 32 + fr, fq * 8);
    const char* Ab = (const char*)g.A;
#define PG8_SA(b, h) (((b) * 2 + (h)) * HTB)
#define PG8_SB(b, h) ((4 + (b) * 2 + (h)) * HTB)
#define PG8_ST2(bufoff, gbase, v0, v1) do { \
        __builtin_amdgcn_global_load_lds((const unsigned*)((const char*)(gbase) + (v0)), (PG8_LAS unsigned*)(lds + (bufoff) + ldsw), 16, 0, 0); \
        __builtin_amdgcn_global_load_lds((const unsigned*)((const char*)(gbase) + (v1)), (PG8_LAS unsigned*)(lds + (bufoff) + ldsw + 8192), 16, 0, 0); } while (0)
#define PG8_STB(bufoff, gbase) PG8_ST2(bufoff, gbase, voffB0, voffB1)
#define PG8_LDA(dst, b, h) do { _Pragma("unroll") for (int m = 0; m < 4; ++m) _Pragma("unroll") for (int k = 0; k < 2; ++k) dst[m][k] = *(const PG8_LAS bf16x8*)(lds + PG8_SA(b, h) + aoff + m * 2048 + k * 1024); } while (0)
#define PG8_LDB(dst, b, h) do { _Pragma("unroll") for (int n = 0; n < 2; ++n) _Pragma("unroll") for (int k = 0; k < 2; ++k) dst[n][k] = *(const PG8_LAS bf16x8*)(lds + PG8_SB(b, h) + boff + n * 2048 + k * 1024); } while (0)
#define PG8_MMA(ai, bj, At, Bt) do { __builtin_amdgcn_s_setprio(1); _Pragma("unroll") for (int m = 0; m < 4; ++m) _Pragma("unroll") for (int n = 0; n < 2; ++n) _Pragma("unroll") for (int k = 0; k < 2; ++k) \
        acc[ai][bj][m][n] = __builtin_amdgcn_mfma_f32_16x16x32_bf16(Bt[n][k], At[m][k], acc[ai][bj][m][n], 0, 0, 0); __builtin_amdgcn_s_setprio(0); } while (0)
#define PG8_WAIT_V(n) asm volatile("s_waitcnt vmcnt(" #n ")" ::: "memory")
#define PG8_WAIT_L(n) asm volatile("s_waitcnt lgkmcnt(" #n ")" ::: "memory")
#define PG8_BAR __builtin_amdgcn_s_barrier()
#define PG8_SCHED __builtin_amdgcn_sched_barrier(0)
    Unit cur, nxt; int ui = 0;
    if (!S.next(0, cur)) return;
    f32x4 acc[2][2][4][2];
#pragma unroll
    for (int a = 0; a < 2; ++a)
#pragma unroll
        for (int b = 0; b < 2; ++b)
#pragma unroll
            for (int m = 0; m < 4; ++m)
#pragma unroll
                for (int n = 0; n < 2; ++n) acc[a][b][m][n] = (f32x4){0.f, 0.f, 0.f, 0.f};
    bf16x8 At[4][2], B0[2][2], B1[2][2];
    unsigned c00, c01, c10, c11;
#define PG8_AOFF(u, d00, d01, d10, d11) do { \
        d00 = S.a_off(u, R0) + (unsigned)C0 * 2u; d01 = S.a_off(u, R1) + (unsigned)C1 * 2u; \
        d10 = S.a_off(u, HALF + R0) + (unsigned)C0 * 2u; d11 = S.a_off(u, HALF + R1) + (unsigned)C1 * 2u; } while (0)
    PG8_AOFF(cur, c00, c01, c10, c11);
    const char* cB = S.b_ptr(cur);
    PG8_STB(PG8_SB(0, 0), cB); PG8_STB(PG8_SB(0, 1), cB + hstepB); PG8_ST2(PG8_SA(0, 0), Ab, c00, c01); PG8_ST2(PG8_SA(0, 1), Ab, c10, c11);
    if (wr == 1) PG8_BAR;
    PG8_WAIT_V(2); PG8_BAR;
    PG8_STB(PG8_SB(1, 0), cB + kstep); PG8_ST2(PG8_SA(1, 0), Ab + kstep, c00, c01); PG8_STB(PG8_SB(1, 1), cB + hstepB + kstep);
    PG8_WAIT_V(6); PG8_BAR;
    for (;;) {
        const bool has_next = S.next(ui + 1, nxt);
        const char* nB = has_next ? S.b_ptr(nxt) : cB;
#pragma unroll 1
        for (int t = 0; t < nt; t += 2) {
            const bool last = (t == nt - 2);
            const char* a1 = Ab + (size_t)(t + 1) * kstep;
            const char* a2 = last ? Ab : Ab + (size_t)(t + 2) * kstep; const char* b2 = last ? nB : cB + (size_t)(t + 2) * kstep;
            const char* a3 = a2 + kstep; const char* b3 = b2 + kstep;
            PG8_LDB(B0, 0, 0); PG8_LDB(B1, 0, 1); PG8_SCHED; PG8_LDA(At, 0, 0); PG8_ST2(PG8_SA(1, 1), a1, c10, c11);
            PG8_WAIT_V(8); PG8_WAIT_L(0); PG8_BAR; PG8_MMA(0, 0, At, B0); PG8_MMA(0, 1, At, B1); PG8_BAR; PG8_SCHED;
            if (last && has_next) { PG8_AOFF(nxt, c00, c01, c10, c11); }
            PG8_LDA(At, 0, 1); PG8_STB(PG8_SB(0, 0), b2); PG8_STB(PG8_SB(0, 1), b2 + hstepB); PG8_ST2(PG8_SA(0, 0), a2, c00, c01);
            PG8_WAIT_V(8); PG8_WAIT_L(0); PG8_BAR; PG8_MMA(1, 0, At, B0); PG8_MMA(1, 1, At, B1); PG8_BAR; PG8_SCHED;
            PG8_LDB(B0, 1, 0); PG8_LDB(B1, 1, 1); PG8_SCHED; PG8_LDA(At, 1, 0); PG8_ST2(PG8_SA(0, 1), a2, c10, c11);
            PG8_WAIT_V(8); PG8_WAIT_L(0); PG8_BAR; PG8_MMA(0, 0, At, B0); PG8_MMA(0, 1, At, B1); PG8_BAR; PG8_SCHED;
            PG8_LDA(At, 1, 1); PG8_STB(PG8_SB(1, 0), b3); PG8_STB(PG8_SB(1, 1), b3 + hstepB); PG8_ST2(PG8_SA(1, 0), a3, c00, c01);
            PG8_WAIT_V(8); PG8_WAIT_L(0); PG8_BAR; PG8_MMA(1, 0, At, B0); PG8_MMA(1, 1, At, B1); PG8_BAR; PG8_SCHED;
        }
        if (wr == 0) PG8_BAR;
        E(acc, cur, wr, wc, fr, fq);
        if (!has_next) break;
#pragma unroll
        for (int a = 0; a < 2; ++a)
#pragma unroll
            for (int b = 0; b < 2; ++b)
#pragma unroll
                for (int m = 0; m < 4; ++m)
#pragma unroll
                    for (int n = 0; n < 2; ++n) acc[a][b][m][n] = (f32x4){0.f, 0.f, 0.f, 0.f};
        cur = nxt; cB = nB; ++ui;
        if (wr == 1) PG8_BAR;
    }
    PG8_WAIT_V(0);
    PG8_BAR;
#undef PG8_SA
#undef PG8_SB
#undef PG8_ST2
#undef PG8_STB
#undef PG8_LDA
#undef PG8_LDB
#undef PG8_MMA
#undef PG8_WAIT_V
#undef PG8_WAIT_L
#undef PG8_BAR
#undef PG8_SCHED
#undef PG8_AOFF
}
}

#define XB_TMO      128
#define XB_XCNT(j)  (256  + 64 * (j))
#define XB_XSUB(j)  (1280 + 64 * (j))
#define XB_XGEN(j)  (2304 + 64 * (j))
#define XB_TOP      3328
#define XB_TOPGEN   3392
#define XCD_BAR_WORDS 3456
#define XB_SPIN_CAP (1u << 22)

__device__ __forceinline__ unsigned xb_ld(unsigned* p)              { return __hip_atomic_load(p, __ATOMIC_RELAXED, __HIP_MEMORY_SCOPE_AGENT); }
__device__ __forceinline__ unsigned xb_add(unsigned* p, unsigned v) { return __hip_atomic_fetch_add(p, v, __ATOMIC_RELAXED, __HIP_MEMORY_SCOPE_AGENT); }
__device__ __forceinline__ unsigned xb_xcc_id() { return (unsigned)__builtin_amdgcn_s_getreg((3 << 11) | 20) & 0xFu; }
#define XB_SPIN(cond, bar) do { unsigned _sp = 0; while (cond) { __builtin_amdgcn_s_sleep(1); \
    if ((++_sp & 255u) == 0u) { if (xb_ld(&(bar)[XB_TMO])) break; if (_sp > XB_SPIN_CAP) { atomicAdd(&(bar)[XB_TMO], 1u); break; } } } } while (0)

struct XcdBarrier { unsigned* bar; unsigned x; volatile LAS unsigned* st; };

__device__ __forceinline__ XcdBarrier xcd_barrier_post(unsigned* bar, volatile LAS unsigned* st) {
    XcdBarrier b; b.bar = bar; b.x = xb_xcc_id(); b.st = st;
    if (threadIdx.x == 0) (void)xb_add(&bar[XB_XCNT(b.x)], 1u);
    return b;
}
__device__ __forceinline__ void xcd_barrier_complete(unsigned* bar, unsigned x, unsigned& nloc, unsigned& nx) {
    const unsigned G = gridDim.x * gridDim.y * gridDim.z;
    unsigned sum, cnt, mine, sp = 0u;
    for (;;) {
        sum = 0u; cnt = 0u; mine = 0u;
#pragma unroll
        for (unsigned j = 0; j < 16; ++j) { const unsigned c = xb_ld(&bar[XB_XCNT(j)]); sum += c; cnt += (c > 0u) ? 1u : 0u; mine = (j == x) ? c : mine; }
        if (sum == G) break;
        __builtin_amdgcn_s_sleep(1);
        if ((++sp & 255u) == 0u) { if (xb_ld(&bar[XB_TMO])) break; if (sp > XB_SPIN_CAP) { atomicAdd(&bar[XB_TMO], 1u); break; } }
    }
    nloc = mine > 0u ? mine : 1u; nx = cnt > 0u ? cnt : 1u;
}
__device__ __forceinline__ void xcd_barrier(const XcdBarrier& b) {
    asm volatile("s_waitcnt vmcnt(0)" ::: "memory");
    __syncthreads();
    if (threadIdx.x == 0) {
        unsigned* bar = b.bar;
        __builtin_amdgcn_s_waitcnt(0);
        unsigned nloc = b.st[0], nx = b.st[1];
        if (nloc == 0u) { xcd_barrier_complete(bar, b.x, nloc, nx); b.st[0] = nloc; b.st[1] = nx; }
        const unsigned old = xb_add(&bar[XB_XSUB(b.x)], 1u);
        const unsigned gen = old / nloc;
        if (old + 1u == (gen + 1u) * nloc) {
            __builtin_amdgcn_fence(__ATOMIC_RELEASE, "agent");
            asm volatile("s_waitcnt vmcnt(0)" ::: "memory");
            const unsigned og = xb_add(&bar[XB_TOP], 1u);
            const unsigned tg = og / nx;
            if (og + 1u == (tg + 1u) * nx) xb_add(&bar[XB_TOPGEN], 1u);
            else XB_SPIN(xb_ld(&bar[XB_TOPGEN]) == tg, bar);
            __builtin_amdgcn_fence(__ATOMIC_ACQUIRE, "agent");
            xb_add(&bar[XB_XGEN(b.x)], 1u);
            asm volatile("s_waitcnt vmcnt(0)" ::: "memory");
        } else {
            XB_SPIN(xb_ld(&bar[XB_XGEN(b.x)]) == gen, bar);
            __builtin_amdgcn_fence(__ATOMIC_ACQUIRE, "agent");
            asm volatile("s_waitcnt vmcnt(0)" ::: "memory");
        }
    }
    __syncthreads();
}

struct Frame {
    LAS unsigned char* lds;
    volatile LAS unsigned* MISC;
    gu32* ctl;
    int tid, lane, wave, vcu, G;
    const float* in[24];
    float* out;
    unsigned char* ws;
};
enum { I_X = 0, I_C, I_ADAW, I_ADAB, I_NMIX, I_NFFN, I_WIN, I_CONVW, I_ALOG, I_DTB, I_ONORM, I_SINKS, I_RELB, I_WOUT, I_POOLW, I_POOLS, I_R1W, I_R1B, I_R2W, I_R2B, I_WG, I_WU, I_WDN, I_FNW };

__device__ __forceinline__ void p0_transpose_item(const float* W, int ldw, int K, bf16* WT, int dst_row0, LAS float* scr, int k0, int n0, int lane) {
    f32x4 w4[8];
#pragma unroll
    for (int i = 0; i < 8; ++i) { const int f = i * 64 + lane, kk = f >> 3, c4 = f & 7; w4[i] = __builtin_nontemporal_load((const f32x4*)(W + (size_t)(k0 + kk) * ldw + n0 + c4 * 4)); }
#pragma unroll
    for (int i = 0; i < 8; ++i) { const int f = i * 64 + lane, kk = f >> 3, c4 = f & 7; LAS float* d = scr + kk * 33 + c4 * 4; d[0] = w4[i].x; d[1] = w4[i].y; d[2] = w4[i].z; d[3] = w4[i].w; }
    LDS_WAIT(); asm volatile("" ::: "memory");
    const int c = lane & 7;
#pragma unroll
    for (int j = 0; j < 4; ++j) { const int n = (lane >> 3) + 8 * j; const LAS float* s = scr + (8 * c) * 33 + n;
        v4u o; o.x = pk2(s[0 * 33], s[1 * 33]); o.y = pk2(s[2 * 33], s[3 * 33]); o.z = pk2(s[4 * 33], s[5 * 33]); o.w = pk2(s[6 * 33], s[7 * 33]);
        __builtin_nontemporal_store(o, (GAS v4u*)(WT + (size_t)(dst_row0 + n) * K + k0 + 8 * c)); }
    LDS_WAIT(); asm volatile("" ::: "memory");
}
constexpr int CQ_NG = NEXP * 512, CQ_NGT = 16 * 512, CQ_N = NEXP * 768;
constexpr int TQ_INPROJ = 11, TQ_GU = 6, TQ_DN = 4;
constexpr int IP_TILES = PIN / 256 - 2;
constexpr int IP_FULL = ((NTOK / 256) * IP_TILES) % 256;
constexpr int CQ_T2 = IP_FULL ? (256 - IP_FULL) * 8 * TQ_INPROJ : 0;
__device__ __forceinline__ void convert_item(Frame& F, int layer, int it, LAS float* scr) {
    if (it < CQ_NG) {
        const int e = it >> 9, r = it & 511, up = r >> 8, q = r & 255, kb = q >> 4, nb = q & 15;
        const float* W = (up ? F.in[I_WU] : F.in[I_WG]) + (size_t)(layer * NEXP + e) * 1024 * 512;
        p0_transpose_item(W, 512, 1024, (bf16*)(F.ws + ((layer && e < 16) ? WS_WGT : WS_WGU)), e * 1024 + (nb >> 2) * 256 + up * 128 + (nb & 3) * 32, scr, kb * 64, nb * 32, F.lane);
    } else {
        const int r0 = it - CQ_NG, e = r0 >> 8, q = r0 & 255, kb = q >> 5, nb = q & 31;
        const float* W = F.in[I_WDN] + (size_t)(layer * NEXP + e) * 512 * 1024;
        p0_transpose_item(W, 1024, 512, (bf16*)(F.ws + WS_WD), e * 1024 + nb * 32, scr, kb * 64, nb * 32, F.lane);
    }
}
__device__ __forceinline__ void convert_range(Frame& F, int layer, int first, int end, int start, int stride) {
    LAS float* scr = (LAS float*)(F.lds + RING_OFF + F.wave * 16384);
    for (int it = first + start; it < end; it += stride) convert_item(F, layer, it, scr);
}
__device__ __forceinline__ void p0_prologue(Frame& F) {
    LAS float* scr = (LAS float*)(F.lds + RING_OFF + F.wave * 16384);
    const int gw = F.vcu * NWAVES + F.wave, NGW = F.G * NWAVES;
    constexpr int IA = 16 * 64, IB = 16 * 24, IO = 16 * 32, IP = 4 * 32, NIT = IA + IB + IO + IP;
    for (int it = gw; it < NIT; it += NGW) {
        int r = it;
        if (r < IA) { p0_transpose_item(F.in[I_WIN], 2832, 1024, (bf16*)(F.ws + WS_WIN), (r % 64) * 32, scr, (r / 64) * 64, (r % 64) * 32, F.lane); continue; } r -= IA;
        if (r < IB) { p0_transpose_item(F.in[I_WIN] + 2064, 2832, 1024, (bf16*)(F.ws + WS_WIN), 2048 + (r % 24) * 32, scr, (r / 24) * 64, (r % 24) * 32, F.lane); continue; } r -= IB;
        if (r < IO) { p0_transpose_item(F.in[I_WOUT], 1024, 1024, (bf16*)(F.ws + WS_WOUT), (r % 32) * 32, scr, (r / 32) * 64, (r % 32) * 32, F.lane); continue; } r -= IO;
        { const int g = r >> 5, q = r & 31; p0_transpose_item(F.in[I_POOLW] + (size_t)g * 65536, 256, 256, (bf16*)(F.ws + WS_POOLW) + (size_t)g * 65536, (q & 7) * 32, scr, (q >> 3) * 64, (q & 7) * 32, F.lane); }
    }
    { float* WBA = (float*)(F.ws + WS_WBA); const int gt = F.vcu * 512 + F.tid;
      if (gt < 16 * 1024) { const int o = gt >> 10, k = gt & 1023; WBA[o * 1024 + k] = F.in[I_WIN][(size_t)k * 2832 + 2048 + o]; } }
    __syncthreads();
    {
        LAS float* red = (LAS float*)(F.lds + RING_OFF);
        const int ks = F.tid >> 4, cj = F.tid & 15;
        for (int u = F.vcu; u < 192; u += F.G) {
            const int l = u / 96, cb = u % 96;
            const float* W = F.in[I_ADAW] + (size_t)l * 1024 * 6144 + cb * 64 + cj * 4;
            f32x4 a0 = {0.f, 0.f, 0.f, 0.f}, a1 = {0.f, 0.f, 0.f, 0.f};
            for (int k = ks * 32; k < ks * 32 + 32; ++k) {
                const f32x4 w = *(const f32x4*)(W + (size_t)k * 6144);
                const float c0 = silu_f(F.in[I_C][k]), c1 = silu_f(F.in[I_C][1024 + k]);
                a0 += w * c0; a1 += w * c1;
            }
            *(LAS f32x4*)(red + (ks * 2 + 0) * 64 + cj * 4) = a0; *(LAS f32x4*)(red + (ks * 2 + 1) * 64 + cj * 4) = a1;
            __syncthreads();
            if (F.tid < 128) { const int b = F.tid >> 6, c = F.tid & 63; float s = 0.f;
                for (int q = 0; q < 32; ++q) s += red[(q * 2 + b) * 64 + c];
                ((float*)(F.ws + WS_MOD))[(size_t)(l * 2 + b) * 6144 + cb * 64 + c] = s + F.in[I_ADAB][l * 6144 + cb * 64 + c]; }
            __syncthreads();
        }
    }
}

struct RowVec { f32x4 v[4]; };
__device__ __forceinline__ RowVec load_row_f32(const float* row, int lane) { RowVec r; const GAS f32x4* p = (const GAS f32x4*)row + lane;
#pragma unroll
    for (int j = 0; j < 4; ++j) r.v[j] = p[64 * j]; return r; }
__device__ __forceinline__ void store_row_f32(float* row, int lane, const RowVec& r) { GAS f32x4* p = (GAS f32x4*)row + lane;
#pragma unroll
    for (int j = 0; j < 4; ++j) p[64 * j] = r.v[j]; }
__device__ __forceinline__ void store_row_bf16(bf16* row, int lane, const RowVec& r) { GAS v2u* p = (GAS v2u*)row + lane;
#pragma unroll
    for (int j = 0; j < 4; ++j) { v2u o; o.x = pk2(r.v[j].x, r.v[j].y); o.y = pk2(r.v[j].z, r.v[j].w); p[64 * j] = o; } }
__device__ __forceinline__ void load_row_bf16(const bf16* row, int lane, v2u (&p)[4]) { const GAS v2u* q = (const GAS v2u*)row + lane;
#pragma unroll
    for (int j = 0; j < 4; ++j) p[j] = q[64 * j]; }
__device__ __forceinline__ RowVec unpack_row_bf16(const v2u (&p)[4]) { RowVec r;
#pragma unroll
    for (int j = 0; j < 4; ++j) { r.v[j].x = bflo(p[j].x); r.v[j].y = bfhi(p[j].x); r.v[j].z = bflo(p[j].y); r.v[j].w = bfhi(p[j].y); } return r; }
__device__ __forceinline__ float row_rstd(const RowVec& r) { float s = 0.f;
#pragma unroll
    for (int j = 0; j < 4; ++j) s += (r.v[j].x * r.v[j].x + r.v[j].y * r.v[j].y) + (r.v[j].z * r.v[j].z + r.v[j].w * r.v[j].w);
    return 1.0f / sqrtf(wave_sum(s) * (1.f / D) + EPS); }
struct ModVec { f32x4 a[4], b[4]; };
__device__ __forceinline__ ModVec load_mod(const float* w, const float* sc, const float* sh, int lane) { ModVec m;
#pragma unroll
    for (int j = 0; j < 4; ++j) { const f32x4 wv = *((const f32x4*)w + lane + 64 * j), s = *((const f32x4*)sc + lane + 64 * j); m.a[j] = wv * (s + 1.0f); m.b[j] = *((const f32x4*)sh + lane + 64 * j); }
    return m; }
__device__ __forceinline__ RowVec apply_mod(const RowVec& x, float rstd, const ModVec& m) { RowVec h;
#pragma unroll
    for (int j = 0; j < 4; ++j) h.v[j] = x.v[j] * rstd * m.a[j] + m.b[j]; return h; }

__device__ __forceinline__ void p1_prenorm0(Frame& F) {
    LAS float* wba = (LAS float*)(F.lds + RING_OFF);
    { const float* WBA = (const float*)(F.ws + WS_WBA); for (int i = F.tid; i < 16 * 256; i += 512) *((LAS f32x4*)wba + i) = *((const f32x4*)WBA + i); }
    __syncthreads();
    const float* mod = (const float*)(F.ws + WS_MOD);
    bf16* H = (bf16*)(F.ws + WS_H); float* BG = (float*)(F.ws + WS_BG);
    const int tok0 = F.vcu * (NTOK / F.G) + F.wave * (NTOK / F.G / NWAVES), ntw = NTOK / F.G / NWAVES;
    const int b = tok0 / SEQ;
    const ModVec m = load_mod(F.in[I_NMIX], mod + (size_t)b * 6144 + 1024, mod + (size_t)b * 6144, F.lane);
    const int hh = F.lane & 7;
    const float nega = -__expf(F.in[I_ALOG][hh]), dtb = F.in[I_DTB][hh];
    RowVec xa = load_row_f32(F.in[I_X] + (size_t)tok0 * D, F.lane), xb = load_row_f32(F.in[I_X] + (size_t)(tok0 + 1) * D, F.lane);
    const LAS f32x4* wl = (const LAS f32x4*)wba + F.lane;
    for (int i = 0; i < ntw; i += 2) {
        const int t = tok0 + i;
        const RowVec x0 = xa, x1 = xb;
        if (i + 2 < ntw) { xa = load_row_f32(F.in[I_X] + (size_t)(t + 2) * D, F.lane); xb = load_row_f32(F.in[I_X] + (size_t)(t + 3) * D, F.lane); }
        const RowVec h0 = apply_mod(x0, row_rstd(x0), m), h1 = apply_mod(x1, row_rstd(x1), m);
        store_row_bf16(H + (size_t)t * D, F.lane, h0); store_row_bf16(H + (size_t)(t + 1) * D, F.lane, h1);
        float p0[16], p1[16]; f32x4 w[2][4];
#pragma unroll
        for (int j = 0; j < 4; ++j) w[0][j] = wl[64 * j];
#pragma unroll
        for (int o = 0; o < 16; ++o) {
            if (o + 1 < 16) {
#pragma unroll
                for (int j = 0; j < 4; ++j) w[(o + 1) & 1][j] = wl[(o + 1) * 256 + 64 * j]; }
            __builtin_amdgcn_sched_barrier(0);
            float s0 = 0.f, s1 = 0.f;
#pragma unroll
            for (int j = 0; j < 4; ++j) { const f32x4 ww = w[o & 1][j];
                s0 += (h0.v[j].x * ww.x + h0.v[j].y * ww.y) + (h0.v[j].z * ww.z + h0.v[j].w * ww.w); s1 += (h1.v[j].x * ww.x + h1.v[j].y * ww.y) + (h1.v[j].z * ww.z + h1.v[j].w * ww.w); }
            p0[o] = s0; p1[o] = s1;
            __builtin_amdgcn_sched_barrier(0); }
        const float mine0 = multi_sum16(p0, F.lane), mine1 = multi_sum16(p1, F.lane);
        if (F.lane < 8) { BG[(size_t)t * 16 + F.lane] = sigmoid_f(mine0); BG[(size_t)(t + 1) * 16 + F.lane] = sigmoid_f(mine1); }
        else if (F.lane < 16) { BG[(size_t)t * 16 + F.lane] = nega * softplus_f(mine0 + dtb); BG[(size_t)(t + 1) * 16 + F.lane] = nega * softplus_f(mine1 + dtb); }
    }
}

struct DenseSched {
    int nM, nN, nwg, G, c, gap_from, gap, L0, Lend; unsigned lda2, acol2; const char* B; size_t btile;
    __device__ __forceinline__ void init(int M, int N, int G_, int c_, int lda, int acolstride, const void* B_, int ldb) { nM = M / 256; nN = N / 256; nwg = nM * nN; G = G_; c = c_; gap_from = 1 << 30; gap = 0; L0 = 0; Lend = nwg; lda2 = (unsigned)lda * 2u; acol2 = (unsigned)acolstride * 2u; B = (const char*)B_; btile = (size_t)256 * ldb * 2; }
    __device__ __forceinline__ bool next(int i, pg8::Unit& u) const {
        const long L = (long)L0 + (long)i * G + c; if (L >= Lend) return false;
        int wgid = (int)L; { const int q = nwg / 8, r = nwg % 8, xcd = wgid % 8, off = wgid / 8; wgid = (xcd < r ? xcd * (q + 1) : r * (q + 1) + (xcd - r) * q) + off; }
        const int nig = 8 * nN, gid = wgid / nig, fm = gid * 8, gsz = (nM - fm) < 8 ? (nM - fm) : 8;
        u.pm = fm + ((wgid % nig) % gsz); u.pn = (wgid % nig) / gsz; u.pn += (u.pn >= gap_from) ? gap : 0; u.e = 0; return true;
    }
    __device__ __forceinline__ unsigned a_off(const pg8::Unit& u, int r) const { return (unsigned)(u.pm * 256 + r) * lda2 + (unsigned)u.pn * acol2; }
    __device__ __forceinline__ const char* b_ptr(const pg8::Unit& u) const { return B + (size_t)u.pn * btile; }
};
struct MoeSched {
    const LAS int* cnt; const LAS int* tbase; const LAS int* tileExp;
    int nunits, chunk, G, c, esplit; const int* RT; const char* B; const char* Blo; size_t bexp, btile; unsigned arow2;
    __device__ __forceinline__ void init(const LAS int* tables, int G_, int c_, const int* RT_, const void* B_, int ldb, int lda) {
        cnt = tables; tbase = tables + 32; tileExp = tables + 80; G = G_; c = c_; RT = RT_; B = (const char*)B_; Blo = B; esplit = 0; bexp = (size_t)1024 * ldb * 2; btile = (size_t)256 * ldb * 2; arow2 = (unsigned)lda * 2u;
        nunits = tbase[32] * 4; chunk = ((nunits + 7) / 8 + 3) & ~3;
    }
    __device__ __forceinline__ bool next(int i, pg8::Unit& u) const {
        const int w = i * (G / 8) + (c >> 3); if (w >= chunk) return false;
        const int L = (c & 7) * chunk + w; if (L >= nunits) return false;
        u.pm = L >> 2; u.pn = L & 3; u.e = tileExp[u.pm]; return true;
    }
    __device__ __forceinline__ unsigned a_off(const pg8::Unit& u, int r) const {
        if (RT) { const int pos = (u.pm - tbase[u.e]) * 256 + r; const int tok = pos < cnt[u.e] ? RT[u.e * NTOK + pos] : 0; return (unsigned)tok * arow2; }
        return (unsigned)(u.pm * 256 + r) * arow2;
    }
    __device__ __forceinline__ const char* b_ptr(const pg8::Unit& u) const { return (u.e < esplit ? Blo : B) + (size_t)u.e * bexp + (size_t)u.pn * btile; }
};
__device__ __forceinline__ void build_moe_tables(Frame& F, int layer) {
    LAS int* T = (LAS int*)(F.lds + SCHED_OFF);
    int tid_ = F.tid; asm volatile("" : "+v"(tid_));
    if (tid_ < 32) T[tid_] = (int)__hip_atomic_load(F.ctl + CW_CNT + 64 * layer + tid_, RLX_AGENT);
    __syncthreads();
    if (F.tid == 0) { int acc = 0; for (int e = 0; e < 32; ++e) { T[32 + e] = acc; const int nt = (T[e] + 255) >> 8; for (int j = 0; j < nt; ++j) T[80 + acc + j] = e; acc += nt; } T[64] = acc; }
    __syncthreads();
}

__device__ __forceinline__ int moe_units_of(int c, int G, int nunits, int chunk) {
    const int sl = c >> 3, x = c & 7, per = G / 8; int U = nunits - x * chunk; U = U < 0 ? 0 : (U > chunk ? chunk : U);
    return sl < U ? (U - sl + per - 1) / per : 0;
}
__device__ __forceinline__ void moe_tail_plan(Frame& F) {
    LAS int* T = (LAS int*)(F.lds + SCHED_OFF);
    if (F.tid == 0) { T[65] = 0; T[66] = 0; }
    __syncthreads();
    if (F.tid < 256) {
        const int nunits = T[64] * 4, chunk = ((nunits + 7) / 8 + 3) & ~3, per = F.G / 8, maxu = (chunk + per - 1) / per, c = (int)blockIdx.x;
        const int sp = F.tid < F.G ? maxu - moe_units_of(F.tid, F.G, nunits, chunk) : 0;
        const int lower = (int)wave_sum(F.tid < c ? (float)sp : 0.f), all = (int)wave_sum((float)sp);
        if (F.lane == 0) { atomicAdd((int*)(T + 65), lower); atomicAdd((int*)(T + 66), all); }
        if (F.tid == c) T[67] = sp;
    }
    __syncthreads();
}

struct EpiStoreBf16 {
    bf16* O; int ldc;
    __device__ __forceinline__ void operator()(const f32x4 (&acc)[2][2][4][2], const pg8::Unit& u, int wr, int wc, int fr, int fq) const {
        const int row0 = u.pm * 256 + wr * 64 + fr, col0 = u.pn * 256 + wc * 32 + 8 * fq;
#pragma unroll
        for (int ai = 0; ai < 2; ++ai)
#pragma unroll
            for (int m = 0; m < 4; ++m) { bf16* rowp = O + (size_t)(row0 + ai * 128 + m * 16) * ldc + col0;
#pragma unroll
                for (int bj = 0; bj < 2; ++bj) { const f32x4 v0 = acc[ai][bj][m][0], v1 = acc[ai][bj][m][1];
                    v4u w; w.x = pk2(v0[0], v0[1]); w.y = pk2(v0[2], v0[3]); w.z = pk2(v1[0], v1[1]); w.w = pk2(v1[2], v1[3]);
                    *(v4u*)(rowp + bj * 128) = w; } }
    }
};
template <bool F32SRC> struct EpiResid {
    const float* X; bf16* O; const float* cf; const float* mul;
    __device__ __forceinline__ void operator()(const f32x4 (&acc)[2][2][4][2], const pg8::Unit& u, int wr, int wc, int fr, int fq) const {
        const int row0 = u.pm * 256 + wr * 64 + fr, col0 = u.pn * 256 + wc * 32 + 8 * fq, b = (u.pm * 256) / SEQ;
        f32x4 c[2][2];
#pragma unroll
        for (int bj = 0; bj < 2; ++bj)
#pragma unroll
            for (int n = 0; n < 2; ++n) { c[bj][n] = *(const f32x4*)(cf + (size_t)b * 6144 + col0 + bj * 128 + 4 * n); if (mul) c[bj][n] *= *(const f32x4*)(mul + col0 + bj * 128 + 4 * n); }
#pragma unroll
        for (int ai = 0; ai < 2; ++ai)
#pragma unroll
            for (int m = 0; m < 4; ++m) { const size_t ro = (size_t)(row0 + ai * 128 + m * 16) * D + col0;
                f32x4 s[2][2];
                if (F32SRC) {
#pragma unroll
                    for (int bj = 0; bj < 2; ++bj) { s[bj][0] = *(const GAS f32x4*)(X + ro + bj * 128); s[bj][1] = *(const GAS f32x4*)(X + ro + bj * 128 + 4); }
                } else {
#pragma unroll
                    for (int bj = 0; bj < 2; ++bj) { const v4u q = *(const GAS v4u*)(O + ro + bj * 128);
                        s[bj][0].x = bflo(q.x); s[bj][0].y = bfhi(q.x); s[bj][0].z = bflo(q.y); s[bj][0].w = bfhi(q.y); s[bj][1].x = bflo(q.z); s[bj][1].y = bfhi(q.z); s[bj][1].z = bflo(q.w); s[bj][1].w = bfhi(q.w); }
                }
#pragma unroll
                for (int bj = 0; bj < 2; ++bj) { const f32x4 v0 = s[bj][0] + c[bj][0] * acc[ai][bj][m][0], v1 = s[bj][1] + c[bj][1] * acc[ai][bj][m][1];
                    v4u w; w.x = pk2(v0[0], v0[1]); w.y = pk2(v0[2], v0[3]); w.z = pk2(v1[0], v1[1]); w.w = pk2(v1[2], v1[3]);
                    *(v4u*)(O + ro + bj * 128) = w; } }
    }
};
struct EpiSwiglu {
    bf16* O;
    __device__ __forceinline__ void operator()(const f32x4 (&acc)[2][2][4][2], const pg8::Unit& u, int wr, int wc, int fr, int fq) const {
        const int row0 = u.pm * 256 + wr * 64 + fr, col0 = u.pn * 128 + wc * 32 + 8 * fq;
#pragma unroll
        for (int ai = 0; ai < 2; ++ai)
#pragma unroll
            for (int m = 0; m < 4; ++m) { bf16* rowp = O + (size_t)(row0 + ai * 128 + m * 16) * DFF + col0;
                float r[8];
#pragma unroll
                for (int n = 0; n < 2; ++n)
#pragma unroll
                    for (int j = 0; j < 4; ++j) r[4 * n + j] = silu_f(acc[ai][0][m][n][j]) * acc[ai][1][m][n][j];
                v4u w; w.x = pk2(r[0], r[1]); w.y = pk2(r[2], r[3]); w.z = pk2(r[4], r[5]); w.w = pk2(r[6], r[7]);
                *(v4u*)rowp = w; }
    }
};

__device__ __forceinline__ void moe_route(Frame& F, int layer) {
    LAS int* hist = (LAS int*)(F.lds + RT_LDS_OFF);
    LAS int* base = hist + 32;
    LAS int* tinfo = hist + 64;
    LAS float* tg = (LAS float*)(hist + 64 + 512);
    if (F.tid < 32) hist[F.tid] = 0;
    LAS f32x4* R2 = (LAS f32x4*)(F.lds + RING_OFF);
    LAS f32x4* R1 = (LAS f32x4*)(F.lds + R1W_OFF);
    { const f32x4* g2p = (const f32x4*)(F.in[I_R2W] + (size_t)layer * 1024 * 32); const f32x4* g1p = (const f32x4*)(F.in[I_R1W] + (size_t)layer * 1024 * 4);
      f32x4 t2[16], t1[2];
#pragma unroll
      for (int u = 0; u < 16; ++u) t2[u] = g2p[F.tid + 512 * u];
#pragma unroll
      for (int u = 0; u < 2; ++u) t1[u] = g1p[F.tid + 512 * u];
#pragma unroll
      for (int u = 0; u < 16; ++u) { const int i = F.tid + 512 * u, k = i >> 3, c4 = i & 7, ln = (k & 255) >> 2, q = k & 3, j = k >> 8; R2[((j * 4 + q) * 8 + c4) * 64 + ln] = t2[u]; }
#pragma unroll
      for (int u = 0; u < 2; ++u) { const int k = F.tid + 512 * u, ln = (k & 255) >> 2, q = k & 3, j = k >> 8; R1[(j * 4 + q) * 64 + ln] = t1[u]; } }
    __syncthreads();
    const float* mod = (const float*)(F.ws + WS_MOD) + (size_t)layer * 2 * 6144;
    bf16* H = (bf16*)(F.ws + WS_H);
    const int tokw = F.vcu * 128 + F.wave * 16, b = (F.vcu * 128) / SEQ;
    const ModVec m = load_mod(F.in[I_NFFN] + layer * D, mod + (size_t)b * 6144 + 4 * 1024, mod + (size_t)b * 6144 + 3 * 1024, F.lane);
    const float b1v = F.lane < 4 ? F.in[I_R1B][layer * 4 + F.lane] : 0.f, b2v = F.lane < 32 ? F.in[I_R2B][layer * 32 + F.lane] : 0.f;
    const bf16* XRB = (const bf16*)(F.ws + WS_XRB);
    v2u xbn[4], xb2[4];
    load_row_bf16(XRB + (size_t)tokw * D, F.lane, xbn); load_row_bf16(XRB + (size_t)(tokw + 1) * D, F.lane, xb2);
    f32x4 r1w[16];
#pragma unroll
    for (int k = 0; k < 16; ++k) r1w[k] = R1[k * 64 + F.lane];
    for (int i = 0; i < 16; ++i) {
        const int t = tokw + i;
        const RowVec x = unpack_row_bf16(xbn);
#pragma unroll
        for (int j = 0; j < 4; ++j) xbn[j] = xb2[j];
        if (i + 2 < 16) load_row_bf16(XRB + (size_t)(t + 2) * D, F.lane, xb2);
        RowVec h = apply_mod(x, row_rstd(x), m);
        store_row_bf16(H + (size_t)t * D, F.lane, h);
        f32x4 l1 = {0.f, 0.f, 0.f, 0.f};
#pragma unroll
        for (int j = 0; j < 4; ++j)
#pragma unroll
            for (int q = 0; q < 4; ++q) l1 += r1w[j * 4 + q] * h.v[j][q];
        float lg[4];
        { const float p4[4] = {l1[0], l1[1], l1[2], l1[3]}; const float r = multi_sum4(p4, F.lane);
#pragma unroll
          for (int g = 0; g < 4; ++g) lg[g] = rl(r, 4 * g) + rl(b1v, g); }
        int grp = 0; float mx = lg[0];
#pragma unroll
        for (int g = 1; g < 4; ++g) if (lg[g] > mx) { mx = lg[g]; grp = g; }
        float se = 0.f;
#pragma unroll
        for (int g = 0; g < 4; ++g) se += __expf(lg[g] - mx);
        const float ptop = 1.0f / se;
        grp = __builtin_amdgcn_readfirstlane(grp);
        f32x4 a0 = {0.f, 0.f, 0.f, 0.f}, a1 = {0.f, 0.f, 0.f, 0.f};
        { const LAS f32x4* wg = R2 + (grp * 2) * 64 + F.lane;
#pragma unroll
          for (int hb = 0; hb < 2; ++hb) { f32x4 w2[16];
#pragma unroll
              for (int k = 0; k < 8; ++k) { w2[2 * k] = wg[((hb * 8 + k) * 8) * 64]; w2[2 * k + 1] = wg[((hb * 8 + k) * 8 + 1) * 64]; }
              __builtin_amdgcn_sched_barrier(0);
#pragma unroll
              for (int k = 0; k < 8; ++k) { const float hv = h.v[(hb * 8 + k) >> 2][(hb * 8 + k) & 3]; a0 += w2[2 * k] * hv; a1 += w2[2 * k + 1] * hv; }
              __builtin_amdgcn_sched_barrier(0); } }
        float l2[8];
        { const float p8[8] = {a0[0], a0[1], a0[2], a0[3], a1[0], a1[1], a1[2], a1[3]}; const float r = multi_sum8(p8, F.lane);
#pragma unroll
          for (int q = 0; q < 8; ++q) l2[q] = rl(r, 2 * q) + rl(b2v, grp * 8 + q); }
        int i0 = 0; float v0 = l2[0];
#pragma unroll
        for (int q = 1; q < 8; ++q) if (l2[q] > v0) { v0 = l2[q]; i0 = q; }
        int i1 = (i0 == 0) ? 1 : 0; float v1 = l2[i1 == 1 ? 1 : 0];
#pragma unroll
        for (int q = 0; q < 8; ++q) if (q != i0 && l2[q] > v1) { v1 = l2[q]; i1 = q; }
        const float g0 = ptop / (1.0f + __expf(v1 - v0)), g1 = ptop - g0;
        if (F.lane == 0) { const int e0 = grp * 8 + i0, e1 = grp * 8 + i1, li = F.wave * 16 + i;
            tinfo[li * 4 + 0] = e0; tinfo[li * 4 + 1] = e1; tinfo[li * 4 + 2] = atomicAdd((int*)(hist + e0), 1); tinfo[li * 4 + 3] = atomicAdd((int*)(hist + e1), 1);
            tg[li * 2] = g0; tg[li * 2 + 1] = g1;
        }
    }
    __syncthreads();
    if (F.tid < 32) base[F.tid] = (int)__hip_atomic_fetch_add(F.ctl + CW_CNT + 64 * layer + F.tid, (unsigned)hist[F.tid], RLX_AGENT);
    __syncthreads();
    if (F.tid < 128) { const int t = F.vcu * 128 + F.tid; const int e0 = tinfo[F.tid * 4], e1 = tinfo[F.tid * 4 + 1];
        const int p0 = base[e0] + tinfo[F.tid * 4 + 2], p1 = base[e1] + tinfo[F.tid * 4 + 3];
        int* RT = (int*)(F.ws + WS_RT); RT[e0 * NTOK + p0] = t; RT[e1 * NTOK + p1] = t;
        v4u r0; r0.x = e0; r0.y = e1; r0.z = p0; r0.w = p1; v4u r1; r1.x = __builtin_bit_cast(unsigned, tg[F.tid * 2]); r1.y = __builtin_bit_cast(unsigned, tg[F.tid * 2 + 1]); r1.z = 0; r1.w = 0;
        v4u* RO = (v4u*)(F.ws + WS_ROUTE) + (size_t)t * 2; RO[0] = r0; (void)r1;
        { float* GA = (float*)(F.ws + WS_BG); GA[(size_t)t * 2] = tg[F.tid * 2]; GA[(size_t)t * 2 + 1] = tg[F.tid * 2 + 1]; } }
    __syncthreads();
}

struct CombRows { v2u xb[4], ya[4], yb[4]; };
struct CombRecs { v4u rec; float ga, gb; };
__device__ __forceinline__ CombRecs comb_load_recs(Frame& F, int tokw) { CombRecs c; const int t = tokw + (F.lane & 15);
    c.rec = *((const v4u*)(F.ws + WS_ROUTE) + (size_t)t * 2); const float* GA = (const float*)(F.ws + WS_BG); c.ga = GA[(size_t)t * 2]; c.gb = GA[(size_t)t * 2 + 1]; return c; }
__device__ __forceinline__ int rl_i(int v, int l) { return __builtin_amdgcn_readlane(v, l); }
__device__ __forceinline__ void comb_issue(Frame& F, const CombRecs& c, int i, int t, CombRows& r) {
    const LAS int* T = (const LAS int*)(F.lds + SCHED_OFF);
    const int e0 = rl_i((int)c.rec.x, i), e1 = rl_i((int)c.rec.y, i), p0 = rl_i((int)c.rec.z, i), p1 = rl_i((int)c.rec.w, i);
    const size_t rowa = (size_t)T[32 + e0] * 256 + p0, rowb = (size_t)T[32 + e1] * 256 + p1;
    const bf16* Y = (const bf16*)(F.ws + WS_Y);
    const GAS v2u* ya = (const GAS v2u*)(Y + rowa * D) + F.lane; const GAS v2u* yb = (const GAS v2u*)(Y + rowb * D) + F.lane;
    load_row_bf16((const bf16*)(F.ws + WS_XRB) + (size_t)t * D, F.lane, r.xb);
#pragma unroll
    for (int j = 0; j < 4; ++j) { r.ya[j] = ya[64 * j]; r.yb[j] = yb[64 * j]; }
}
__device__ __forceinline__ RowVec comb_finish(const CombRecs& c, int i, const CombRows& r, const f32x4 (&g2)[4]) {
    const float ga = rl(c.ga, i), gb = rl(c.gb, i); RowVec x = unpack_row_bf16(r.xb);
#pragma unroll
    for (int j = 0; j < 4; ++j) { const v2u a = r.ya[j], bq = r.yb[j];
        f32x4 s; s.x = ga * bflo(a.x) + gb * bflo(bq.x); s.y = ga * bfhi(a.x) + gb * bfhi(bq.x); s.z = ga * bflo(a.y) + gb * bflo(bq.y); s.w = ga * bfhi(a.y) + gb * bfhi(bq.y);
        x.v[j] += g2[j] * s; }
    return x;
}

__device__ __forceinline__ void attn_phase(Frame& F, const int u_first, const int u_stride) {
    LAS bf16* KS = (LAS bf16*)(F.lds + RING_OFF);
    LAS bf16* VT = (LAS bf16*)(F.lds + RING_OFF + 36864);
    LAS float* BT = (LAS float*)(F.lds + RING_OFF + 36864 + 33280);
    const bf16* PROJ = (const bf16*)(F.ws + WS_PROJ); bf16* OAB = (bf16*)(F.ws + WS_OAB);
    const int lane = F.lane, lc = lane & 31, lh = lane >> 5;
    for (int unit = u_first; unit < 512; unit += u_stride) {
        const int b = unit >> 8, kvh = (unit >> 7) & 1, qb = unit & 127, t0 = qb * 128;
        __syncthreads();
        for (int i = F.tid; i < 4 * 192; i += 512) { const int hq = i / 192, x = i - hq * 192, dist = 159 - x; float v = 0.f;
            if (dist >= 0 && dist < 128) { int bk = dist; if (dist >= 16) { bk = 16 + (int)(logf((float)dist / 16.0f) / 2.0794415416798357f * 16.0f); bk = bk > 31 ? 31 : bk; }
                v = F.in[I_RELB][bk * 8 + kvh * 4 + hq] * 1.4426950408889634f; }
            BT[i] = v; }
#pragma unroll
        for (int cc = 0; cc < 4; ++cc) { const int ch = F.tid + 512 * cc, key = ch >> 3, part = ch & 7, tl = t0 - 128 + key;
            v4u kv = {0u, 0u, 0u, 0u}, vv = {0u, 0u, 0u, 0u};
            if (tl >= 0) { const bf16* rp = PROJ + (size_t)(b * SEQ + tl) * PIN; kv = *(const v4u*)(rp + PC_KB + kvh * 64 + part * 8); vv = *(const v4u*)(rp + PC_VB + kvh * 64 + part * 8); }
            *(LAS v4u*)(KS + key * 72 + part * 8) = kv;
            const unsigned w[4] = {vv.x, vv.y, vv.z, vv.w};
#pragma unroll
            for (int q = 0; q < 4; ++q) { VT[(part * 8 + 2 * q) * 260 + key] = (bf16)(w[q] & 0xffffu); VT[(part * 8 + 2 * q + 1) * 260 + key] = (bf16)(w[q] >> 16); } }
        __syncthreads();
#pragma unroll 1
        for (int tt = 0; tt < 2; ++tt) {
            const int task = F.wave * 2 + tt, hq = task >> 2, qt = task & 3, qh = kvh * 4 + hq;
            const int qi = 32 * qt + lc;
            const bf16* qrow = PROJ + (size_t)(b * SEQ + t0 + qi) * PIN + PC_QB + qh * 64 + 8 * lh;
            bf16x8 qf[4];
#pragma unroll
            for (int s = 0; s < 4; ++s) qf[s] = *(const bf16x8*)(qrow + 16 * s);
            f32x16 sc[5];
#pragma unroll
            for (int kt = 0; kt < 5; ++kt) {
#pragma unroll
                for (int r = 0; r < 16; ++r) sc[kt][r] = 0.f;
                const LAS bf16* kp = KS + (32 * (qt + kt) + lc) * 72 + 8 * lh;
#pragma unroll
                for (int s = 0; s < 4; ++s) { const bf16x8 kf = *(const LAS bf16x8*)(kp + 16 * s); sc[kt] = __builtin_amdgcn_mfma_f32_32x32x16_bf16(kf, qf[s], sc[kt], 0, 0, 0); }
            }
            const float sink2 = F.in[I_SINKS][qh] * 1.4426950408889634f;
            const LAS float* bp = BT + hq * 192 + (4 * lh - lc + 31);
            const int m_lo = lc + 1 - 4 * lh, m_hi = lc - 4 * lh;
            float mx = sink2;
#pragma unroll
            for (int kt = 0; kt < 5; ++kt) {
                const bool dead = (t0 == 0) && (qt + kt < 4);
#pragma unroll
                for (int r = 0; r < 16; ++r) { const int cr = (r & 3) + 8 * (r >> 2);
                    float v = sc[kt][r] * (0.125f * 1.4426950408889634f) + bp[32 * kt + cr];
                    if (kt == 0) v = (cr >= m_lo) ? v : -1e30f;
                    if (kt == 4) v = (cr <= m_hi) ? v : -1e30f;
                    if (dead) v = -1e30f;
                    sc[kt][r] = v; mx = fmaxf(mx, v); } }
            mx = fmaxf(mx, __shfl_xor(mx, 32));
            float den = 0.f;
#pragma unroll
            for (int kt = 0; kt < 5; ++kt)
#pragma unroll
                for (int r = 0; r < 16; ++r) { const float p = __builtin_amdgcn_exp2f(sc[kt][r] - mx); sc[kt][r] = p; den += p; }
            den += __shfl_xor(den, 32);
            den += __builtin_amdgcn_exp2f(sink2 - mx);
            const float inv = 1.0f / den;
            f32x16 oa[2];
#pragma unroll
            for (int dt = 0; dt < 2; ++dt)
#pragma unroll
                for (int r = 0; r < 16; ++r) oa[dt][r] = 0.f;
#pragma unroll
            for (int kt = 0; kt < 5; ++kt)
#pragma unroll
                for (int s2 = 0; s2 < 2; ++s2) {
                    v4u pw; pw.x = pk2(sc[kt][8 * s2 + 0], sc[kt][8 * s2 + 1]); pw.y = pk2(sc[kt][8 * s2 + 2], sc[kt][8 * s2 + 3]); pw.z = pk2(sc[kt][8 * s2 + 4], sc[kt][8 * s2 + 5]); pw.w = pk2(sc[kt][8 * s2 + 6], sc[kt][8 * s2 + 7]);
                    const bf16x8 pf = __builtin_bit_cast(bf16x8, pw);
#pragma unroll
                    for (int dt = 0; dt < 2; ++dt) { const LAS bf16* vp = VT + (32 * dt + lc) * 260 + 32 * (qt + kt) + 16 * s2 + 4 * lh;
                        const v2u va = *(const LAS v2u*)vp, vb = *(const LAS v2u*)(vp + 8);
                        v4u vw; vw.x = va.x; vw.y = va.y; vw.z = vb.x; vw.w = vb.y;
                        oa[dt] = __builtin_amdgcn_mfma_f32_32x32x16_bf16(__builtin_bit_cast(bf16x8, vw), pf, oa[dt], 0, 0, 0); }
                }
            bf16* orow = OAB + (size_t)(b * SEQ + t0 + qi) * D + 512 + qh * 64 + 4 * lh;
#pragma unroll
            for (int dt = 0; dt < 2; ++dt)
#pragma unroll
                for (int rg = 0; rg < 4; ++rg) { v2u o; o.x = pk2(oa[dt][4 * rg] * inv, oa[dt][4 * rg + 1] * inv); o.y = pk2(oa[dt][4 * rg + 2] * inv, oa[dt][4 * rg + 3] * inv);
                    *(v2u*)(orow + 32 * dt + 8 * rg) = o; }
        }
    }
    __syncthreads();
}


constexpr int DN_ST = 72;

__device__ __forceinline__ bf16x8 pack8(const f32x16& x, int s) { v4u p; p.x = pk2(x[8 * s], x[8 * s + 1]); p.y = pk2(x[8 * s + 2], x[8 * s + 3]); p.z = pk2(x[8 * s + 4], x[8 * s + 5]); p.w = pk2(x[8 * s + 6], x[8 * s + 7]); return __builtin_bit_cast(bf16x8, p); }
__device__ __forceinline__ f32x16 dn_tile(const LAS bf16* A, int ra, const LAS bf16* B, int rb, int lc, int lh) {
    f32x16 acc;
#pragma unroll
    for (int r = 0; r < 16; ++r) acc[r] = 0.f;
#pragma unroll
    for (int s = 0; s < 4; ++s) { const bf16x8 a = *(const LAS bf16x8*)(A + (ra + lc) * DN_ST + 16 * s + 8 * lh), b = *(const LAS bf16x8*)(B + (rb + lc) * DN_ST + 16 * s + 8 * lh);
        acc = __builtin_amdgcn_mfma_f32_32x32x16_bf16(a, b, acc, 0, 0, 0); }
    return acc;
}
__device__ __forceinline__ void dn_prep(Frame& F) {
    LAS bf16* Qs = (LAS bf16*)(F.lds + RING_OFF);
    LAS bf16* Ks = Qs + 64 * DN_ST;
    LAS bf16* KBs = Ks + 64 * DN_ST;
    LAS bf16* Vs = KBs + 64 * DN_ST;
    LAS bf16* KDT = Vs + 64 * DN_ST;
    LAS bf16* AQK = KDT + 64 * DN_ST;
    LAS bf16* UT = AQK + 64 * DN_ST;
    LAS bf16* WT = UT + 64 * DN_ST;
    LAS bf16* LNO = WT + 64 * DN_ST;
    LAS float* LD = (LAS float*)(LNO + 64 * DN_ST);
    LAS bf16* TDZ = (LAS bf16*)(LD + 64 * 16);
    LAS float* GB = (LAS float*)(TDZ + 64 * 24);
    const bf16* PROJ = (const bf16*)(F.ws + WS_PROJ); const float* BG = (const float*)(F.ws + WS_BG);
    const int tid = F.tid, lane = F.lane, lc = lane & 31, lh = lane >> 5, wave = F.wave;
    LAS float* CW = GB + 256;
    { f32x4 tc[3];
#pragma unroll
      for (int u = 0; u < 3; ++u) tc[u] = *((const f32x4*)F.in[I_CONVW] + tid + 512 * u);
#pragma unroll
      for (int u = 0; u < 3; ++u) *((LAS f32x4*)CW + tid + 512 * u) = tc[u]; }
    LAS v4u* RAW = (LAS v4u*)(F.lds + R1W_OFF);
    constexpr int RAW_CH = 67 * 24;
#define DN_RAW_SRC(i_, b_, h_, n_) ({ const int r_ = (i_) / 24, c_ = (i_) - r_ * 24; const int tl_ = (n_) * 64 - 3 + r_; \
        tl_ >= 0 ? (const v4u*)(PROJ + ((size_t)(b_) * SEQ + tl_) * PIN + (c_ < 8 ? PC_QA : c_ < 16 ? PC_KA : PC_VA) + (h_) * 64 + (c_ & 7) * 8) : (const v4u*)nullptr; })
    { const int u0 = F.vcu, b = u0 >> 11, h = (u0 >> 8) & 7, n = u0 & 255;
      for (int i = tid; i < RAW_CH; i += 512) { const v4u* sp = DN_RAW_SRC(i, b, h, n); v4u z = {0u, 0u, 0u, 0u}; if (sp) z = *sp; RAW[i] = z; }
      if (wave == 0) { const size_t row0 = (size_t)b * SEQ + (size_t)n * 64; float c = BG[(row0 + lane) * 16 + 8 + h];
#pragma unroll
          for (int o = 1; o < 64; o <<= 1) { const float up = __shfl_up(c, o); if (lane >= o) c += up; }
          GB[lane] = c; GB[64 + lane] = BG[(row0 + lane) * 16 + h]; } }
    int par = 0;
    for (int unit = F.vcu; unit < 4096; unit += F.G, par ^= 1) {
        const int b = unit >> 11, h = (unit >> 8) & 7, n = unit & 255;
        LAS float* gcs = GB + par * 128; LAS float* bts = gcs + 64;
        const int un = unit + F.G; const bool more = un < 4096; const int bn = un >> 11, hn = (un >> 8) & 7, nn = un & 255;
        __syncthreads();
        { const int t = tid >> 3, cs = tid & 7;
          float q[8], k[8], v[8];
#pragma unroll
          for (int e = 0; e < 8; ++e) { q[e] = 0.f; k[e] = 0.f; v[e] = 0.f; }
#pragma unroll
          for (int j = 0; j < 4; ++j) { { const LAS v4u* rp = RAW + (t + j) * 24 + cs;
                const v4u wq = rp[0], wk = rp[8], wv = rp[16];
                const LAS float* cw = CW + j * 1536 + h * 64 + cs * 8;
                const unsigned uq[4] = {wq.x, wq.y, wq.z, wq.w}, uk[4] = {wk.x, wk.y, wk.z, wk.w}, uv[4] = {wv.x, wv.y, wv.z, wv.w};
#pragma unroll
                for (int e = 0; e < 4; ++e) { q[2 * e] += cw[2 * e] * bflo(uq[e]); q[2 * e + 1] += cw[2 * e + 1] * bfhi(uq[e]);
                    k[2 * e] += cw[512 + 2 * e] * bflo(uk[e]); k[2 * e + 1] += cw[512 + 2 * e + 1] * bfhi(uk[e]);
                    v[2 * e] += cw[1024 + 2 * e] * bflo(uv[e]); v[2 * e + 1] += cw[1024 + 2 * e + 1] * bfhi(uv[e]); } } }
          float sq = 0.f, sk = 0.f;
#pragma unroll
          for (int e = 0; e < 8; ++e) { q[e] = silu_f(q[e]); k[e] = silu_f(k[e]); v[e] = silu_f(v[e]); sq += q[e] * q[e]; sk += k[e] * k[e]; }
          sq = oct_sum(sq); sk = oct_sum(sk);
          const float rq = 0.125f / sqrtf(sq + EPS), rk = 1.0f / sqrtf(sk + EPS), bt = bts[t], kd = __expf(gcs[63] - gcs[t]);
          v4u oq, ok, ob, ov;
          oq.x = pk2(q[0] * rq, q[1] * rq); oq.y = pk2(q[2] * rq, q[3] * rq); oq.z = pk2(q[4] * rq, q[5] * rq); oq.w = pk2(q[6] * rq, q[7] * rq);
#pragma unroll
          for (int e = 0; e < 8; ++e) k[e] *= rk;
          ok.x = pk2(k[0], k[1]); ok.y = pk2(k[2], k[3]); ok.z = pk2(k[4], k[5]); ok.w = pk2(k[6], k[7]);
          ob.x = pk2(k[0] * bt, k[1] * bt); ob.y = pk2(k[2] * bt, k[3] * bt); ob.z = pk2(k[4] * bt, k[5] * bt); ob.w = pk2(k[6] * bt, k[7] * bt);
          ov.x = pk2(v[0], v[1]); ov.y = pk2(v[2], v[3]); ov.z = pk2(v[4], v[5]); ov.w = pk2(v[6], v[7]);
          *(LAS v4u*)(Qs + t * DN_ST + cs * 8) = oq; *(LAS v4u*)(Ks + t * DN_ST + cs * 8) = ok; *(LAS v4u*)(KBs + t * DN_ST + cs * 8) = ob; *(LAS v4u*)(Vs + t * DN_ST + cs * 8) = ov;
#pragma unroll
          for (int e = 0; e < 8; ++e) KDT[(cs * 8 + e) * DN_ST + t] = (bf16)f2bf(k[e] * kd); }
        __syncthreads();
        v4u pf[7]; float pg = 0.f, pb = 0.f;
        if (wave >= 4 && more) {
#pragma unroll
            for (int k7 = 0; k7 < 7; ++k7) { const int i = (tid - 256) + 256 * k7; pf[k7] = (v4u){0u, 0u, 0u, 0u}; if (i < RAW_CH) { const v4u* sp = DN_RAW_SRC(i, bn, hn, nn); if (sp) pf[k7] = *sp; } }
            if (wave == 4) { const size_t rn = (size_t)bn * SEQ + (size_t)nn * 64; pg = BG[(rn + lane) * 16 + 8 + hn]; pb = BG[(rn + lane) * 16 + hn]; }
        }
        { const int it = (wave >> 1) & 1, jt = wave & 1; const bool qk = wave >= 4;
          f32x16 acc;
#pragma unroll
          for (int r = 0; r < 16; ++r) acc[r] = 0.f;
          if (it >= jt) acc = dn_tile(qk ? Qs : KBs, 32 * it, Ks, 32 * jt, lc, lh);
          const int j = 32 * jt + lc; const float gj = gcs[j];
          LAS float* ldspare = LD + 64 * 16 + 0;
          if (qk) {
#pragma unroll
              for (int r = 0; r < 16; ++r) { const int i = 32 * it + (r & 3) + 8 * (r >> 2) + 4 * lh;
                  const float val = (i >= j) ? acc[r] * __expf(gcs[i] - gj) : 0.f; AQK[i * DN_ST + j] = (bf16)f2bf(val); }
          } else {
#pragma unroll
              for (int r = 0; r < 16; ++r) { const int i = 32 * it + (r & 3) + 8 * (r >> 2) + 4 * lh;
                  const float val = (i > j) ? acc[r] * __expf(gcs[i] - gj) : 0.f; const bool diag = (i >> 4) == (j >> 4);
                  LNO[i * DN_ST + j] = (bf16)f2bf(diag ? 0.f : -val);
                  LAS float* dp = diag ? LD + i * 16 + (j & 15) : ldspare + lane; *dp = val; } } }
        __syncthreads();
        if (wave == 0) { const int bb = lane >> 4, c = lane & 15; float tcol[16];
#pragma unroll
            for (int i = 0; i < 16; ++i) { float v = (i == c) ? 1.f : 0.f;
#pragma unroll
                for (int j4 = 0; j4 < (i + 3) / 4; ++j4) { const f32x4 a = *(const LAS f32x4*)(LD + (16 * bb + i) * 16 + 4 * j4);
#pragma unroll
                    for (int e = 0; e < 4; ++e) if (4 * j4 + e < i) v -= a[e] * tcol[4 * j4 + e]; }
                tcol[i] = v; TDZ[(16 * bb + i) * 24 + c] = (bf16)f2bf(v); } }
        __syncthreads();
        if (wave < 4) {
            const int ct = wave, cc = 32 * (ct & 1) + lc; const bool isw = ct >= 2;
            f32x16 acc[2];
#pragma unroll
            for (int rt = 0; rt < 2; ++rt)
#pragma unroll
                for (int r = 0; r < 16; ++r) { const int t = 32 * rt + (r & 3) + 8 * (r >> 2) + 4 * lh;
                    acc[rt][r] = isw ? bf2f(Ks[t * DN_ST + cc]) * bts[t] * __expf(gcs[t]) : bf2f(Vs[t * DN_ST + cc]) * bts[t]; }
#define DN_AFRAG(arr, stride, row, kb) ({ const LAS bf16* p_ = (arr) + (row) * (stride) + 16 * (kb) + 4 * lh; const v2u lo_ = *(const LAS v2u*)p_, hi_ = *(const LAS v2u*)(p_ + 8); v4u w_; w_.x = lo_.x; w_.y = lo_.y; w_.z = hi_.x; w_.w = hi_.y; __builtin_bit_cast(bf16x8, w_); })
            f32x16 X[4];
#pragma unroll
            for (int bb = 0; bb < 4; ++bb) { const int rt = bb >> 1, odd = bb & 1;
                bf16x8 ta = DN_AFRAG(TDZ, 24, 32 * rt + lc, 0);
                if ((lc >> 4) != odd) ta = (bf16x8){0, 0, 0, 0, 0, 0, 0, 0};
                f32x16 z;
#pragma unroll
                for (int r = 0; r < 16; ++r) z[r] = 0.f;
                z = __builtin_amdgcn_mfma_f32_32x32x16_bf16(ta, pack8(acc[rt], odd), z, 0, 0, 0);
                X[bb] = z;
                const bf16x8 xb = pack8(z, odd);
                if (bb == 0) { acc[0] = __builtin_amdgcn_mfma_f32_32x32x16_bf16(DN_AFRAG(LNO, DN_ST, lc, 0), xb, acc[0], 0, 0, 0); acc[1] = __builtin_amdgcn_mfma_f32_32x32x16_bf16(DN_AFRAG(LNO, DN_ST, 32 + lc, 0), xb, acc[1], 0, 0, 0); }
                if (bb == 1) { acc[1] = __builtin_amdgcn_mfma_f32_32x32x16_bf16(DN_AFRAG(LNO, DN_ST, 32 + lc, 1), xb, acc[1], 0, 0, 0); }
                if (bb == 2) { acc[1] = __builtin_amdgcn_mfma_f32_32x32x16_bf16(DN_AFRAG(LNO, DN_ST, 32 + lc, 2), xb, acc[1], 0, 0, 0); }
            }
#undef DN_AFRAG
            LAS bf16* dst = (isw ? WT : UT) + cc * DN_ST;
#pragma unroll
            for (int bb = 0; bb < 4; ++bb)
#pragma unroll
                for (int g = 0; g < 2; ++g) { const int r0 = 8 * (bb & 1) + 4 * g; v2u o; o.x = pk2(X[bb][r0], X[bb][r0 + 1]); o.y = pk2(X[bb][r0 + 2], X[bb][r0 + 3]);
                    *(LAS v2u*)(dst + 16 * bb + 8 * g + 4 * lh) = o; }
        } else if (more) {
#pragma unroll
            for (int k7 = 0; k7 < 7; ++k7) { const int i = (tid - 256) + 256 * k7; if (i < RAW_CH) RAW[i] = pf[k7]; }
            if (wave == 4) { float c = pg;
#pragma unroll
                for (int o = 1; o < 64; o <<= 1) { const float up = __shfl_up(c, o); if (lane >= o) c += up; }
                GB[(par ^ 1) * 128 + lane] = c; GB[(par ^ 1) * 128 + 64 + lane] = pb; }
        }
        __syncthreads();
        { bf16* MT = (bf16*)((unsigned char*)F.out + OUT_DN_MT) + (size_t)unit * 4096; bf16* QPT = (bf16*)((unsigned char*)F.out + OUT_DN_QPT) + (size_t)unit * 4096;
          bf16* BM = (bf16*)(F.ws + WS_DN_BM) + (size_t)unit * 4096; bf16* O0T = (bf16*)(F.ws + WS_DN_O0T) + (size_t)unit * 4096;
#pragma unroll 1
          for (int tt = 0; tt < 2; ++tt) { const int task = wave * 2 + tt, p = task >> 2, ta = (task >> 1) & 1, tb = task & 1;
              if (p == 0) {
                  f32x16 acc = dn_tile(WT, 32 * ta, KDT, 32 * tb, lc, lh);
#pragma unroll
                  for (int r = 0; r < 16; ++r) acc[r] = -acc[r];
#pragma unroll
                  for (int s2 = 0; s2 < 2; ++s2) *(bf16x8*)(MT + ((((tb * 2 + ta) * 2 + s2) * 64 + lane) * 8)) = pack8(acc, s2);
              } else if (p == 1) {
                  const f32x16 acc = dn_tile(KDT, 32 * ta, UT, 32 * tb, lc, lh);
#pragma unroll
                  for (int s2 = 0; s2 < 2; ++s2) *(bf16x8*)(BM + ((((tb * 2 + ta) * 2 + s2) * 64 + lane) * 8)) = pack8(acc, s2);
              } else if (p == 2) {
                  f32x16 acc = dn_tile(WT, 32 * ta, AQK, 32 * tb, lc, lh);
                  const int i = 32 * tb + lc; const float eg = __expf(gcs[i]);
#pragma unroll
                  for (int r = 0; r < 16; ++r) { const int a = 32 * ta + (r & 3) + 8 * (r >> 2) + 4 * lh; acc[r] = bf2f(Qs[i * DN_ST + a]) * eg - acc[r]; }
#pragma unroll
                  for (int s2 = 0; s2 < 2; ++s2) *(bf16x8*)(QPT + ((((tb * 2 + ta) * 2 + s2) * 64 + lane) * 8)) = pack8(acc, s2);
              } else {
                  const f32x16 acc = dn_tile(UT, 32 * ta, AQK, 32 * tb, lc, lh);
#pragma unroll
                  for (int s2 = 0; s2 < 2; ++s2) *(bf16x8*)(O0T + ((((tb * 2 + ta) * 2 + s2) * 64 + lane) * 8)) = pack8(acc, s2);
              } }
          if (tid == 0) ((float*)(F.ws + WS_DN_GT))[unit] = __expf(gcs[63]); }
    }
#undef DN_RAW_SRC
    __syncthreads();
}
template <int r>
__device__ __forceinline__ void dn_scan_wave(Frame& F) {
    const int bx = (int)blockIdx.x, w = (bx & 7) * 4 + (bx >> 3), bh = w >> 1, ct = w & 1, lane = F.lane;
    const bf16x8* MT = (const bf16x8*)((const unsigned char*)F.out + OUT_DN_MT); const bf16x8* BM = (const bf16x8*)(F.ws + WS_DN_BM); bf16x8* SS = (bf16x8*)(F.ws + WS_DN_S);
    const float* GT = (const float*)(F.ws + WS_DN_GT);
    LAS bf16x8* MB = (LAS bf16x8*)(F.lds + RING_OFF);
    volatile LAS int* FL = (volatile LAS int*)(F.lds + LDSCTL_OFF + 64);
    f32x16 S;
#pragma unroll
    for (int q = 0; q < 16; ++q) S[q] = 0.f;
    bf16x8 mA[4], bA[2], mB[4], bB[2], mC[4], bC[2], mD[4], bD[2], mE[4], bE[2], mG[4], bG[2]; float gA, gB, gC, gD, gE, gG;
#define DN_SLOAD(m, bm, gt, u) do { const size_t ub = (size_t)(u) * 512; _Pragma("unroll") for (int f = 0; f < 4; ++f) m[f] = MT[ub + (r * 4 + f) * 64 + lane]; \
        _Pragma("unroll") for (int f = 0; f < 2; ++f) bm[f] = BM[ub + ((ct * 2 + r) * 2 + f) * 64 + lane]; gt = GT[u]; } while (0)
#define DN_STEP(cm, cb, cg, unit, n) do { \
        bf16x8 own[2]; own[0] = pack8(S, 0); own[1] = pack8(S, 1); \
        LAS bf16x8* mb = MB + ((n) & 1) * 256; \
        mb[(r * 2 + 0) * 64 + lane] = own[0]; mb[(r * 2 + 1) * 64 + lane] = own[1]; \
        asm volatile("s_waitcnt lgkmcnt(0)" ::: "memory"); \
        if (lane == 0) FL[r] = (n) + 1; \
        SS[(size_t)(unit) * 512 + (ct * 4 + r * 2 + 0) * 64 + lane] = own[0]; SS[(size_t)(unit) * 512 + (ct * 4 + r * 2 + 1) * 64 + lane] = own[1]; \
        f32x16 A; \
        { const v4u b0 = __builtin_bit_cast(v4u, cb[0]), b1 = __builtin_bit_cast(v4u, cb[1]); const unsigned u0[8] = {b0.x, b0.y, b0.z, b0.w, b1.x, b1.y, b1.z, b1.w}; \
          _Pragma("unroll") for (int e = 0; e < 8; ++e) { A[2 * e] = cg * S[2 * e] + bflo(u0[e]); A[2 * e + 1] = cg * S[2 * e + 1] + bfhi(u0[e]); } } \
        while (FL[1 - r] < (n) + 1) { } \
        asm volatile("" ::: "memory"); \
        bf16x8 oth[2]; oth[0] = mb[((1 - r) * 2 + 0) * 64 + lane]; oth[1] = mb[((1 - r) * 2 + 1) * 64 + lane]; \
          \
        _Pragma("unroll") for (int s2 = 0; s2 < 2; ++s2) { A = __builtin_amdgcn_mfma_f32_32x32x16_bf16(cm[r * 2 + s2], own[s2], A, 0, 0, 0); A = __builtin_amdgcn_mfma_f32_32x32x16_bf16(cm[(1 - r) * 2 + s2], oth[s2], A, 0, 0, 0); } \
        S = A; } while (0)
    const int u0 = bh * 256;
    DN_SLOAD(mA, bA, gA, u0); DN_SLOAD(mB, bB, gB, u0 + 1); DN_SLOAD(mC, bC, gC, u0 + 2); DN_SLOAD(mD, bD, gD, u0 + 3); DN_SLOAD(mE, bE, gE, u0 + 4); DN_SLOAD(mG, bG, gG, u0 + 5);
    for (int n = 0; n < 252; n += 6) {
        DN_STEP(mA, bA, gA, u0 + n, n);         DN_SLOAD(mA, bA, gA, u0 + n + 6);
        DN_STEP(mB, bB, gB, u0 + n + 1, n + 1); DN_SLOAD(mB, bB, gB, u0 + n + 7);
        DN_STEP(mC, bC, gC, u0 + n + 2, n + 2); DN_SLOAD(mC, bC, gC, u0 + n + 8);
        DN_STEP(mD, bD, gD, u0 + n + 3, n + 3); DN_SLOAD(mD, bD, gD, u0 + n + 9);
        DN_STEP(mE, bE, gE, u0 + n + 4, n + 4); if (n + 10 < 256) DN_SLOAD(mE, bE, gE, u0 + n + 10);
        DN_STEP(mG, bG, gG, u0 + n + 5, n + 5); if (n + 11 < 256) DN_SLOAD(mG, bG, gG, u0 + n + 11);
    }
    DN_STEP(mA, bA, gA, u0 + 252, 252); DN_STEP(mB, bB, gB, u0 + 253, 253); DN_STEP(mC, bC, gC, u0 + 254, 254); DN_STEP(mD, bD, gD, u0 + 255, 255);
#undef DN_SLOAD
#undef DN_STEP
}
__device__ __forceinline__ void dn_scan(Frame& F) {
    if ((int)blockIdx.x >= 32) return;
    if (F.wave == 0) dn_scan_wave<0>(F); else if (F.wave == 1) dn_scan_wave<1>(F);
}
__device__ __forceinline__ void dn_output(Frame& F) {
    const bf16x8* QPT = (const bf16x8*)((const unsigned char*)F.out + OUT_DN_QPT); const bf16x8* O0T = (const bf16x8*)(F.ws + WS_DN_O0T); const bf16x8* SS = (const bf16x8*)(F.ws + WS_DN_S);
    const bf16* PROJ = (const bf16*)(F.ws + WS_PROJ); bf16* OAB = (bf16*)(F.ws + WS_OAB);
    const int lane = F.lane, lc = lane & 31, lh = lane >> 5; int nbad = 0; (void)nbad;
    f32x4 oww[2][4];
#pragma unroll
    for (int ct = 0; ct < 2; ++ct)
#pragma unroll
        for (int rg = 0; rg < 4; ++rg) oww[ct][rg] = *(const f32x4*)(F.in[I_ONORM] + 32 * ct + 8 * rg + 4 * lh);
    for (int task = F.vcu * NWAVES + F.wave; task < 8192; task += F.G * NWAVES) {
        const int unit = task >> 1, it = task & 1, b = unit >> 11, h = (unit >> 8) & 7, n = unit & 255;
        const size_t ub = (size_t)unit * 512;
        f32x16 o[2];
#pragma unroll
        for (int ct = 0; ct < 2; ++ct) {
            const v4u c0 = __builtin_bit_cast(v4u, O0T[ub + ((it * 2 + ct) * 2 + 0) * 64 + lane]), c1 = __builtin_bit_cast(v4u, O0T[ub + ((it * 2 + ct) * 2 + 1) * 64 + lane]);
            const unsigned u[8] = {c0.x, c0.y, c0.z, c0.w, c1.x, c1.y, c1.z, c1.w};
#pragma unroll
            for (int e = 0; e < 8; ++e) { o[ct][2 * e] = bflo(u[e]); o[ct][2 * e + 1] = bfhi(u[e]); }
#pragma unroll
            for (int at = 0; at < 2; ++at)
#pragma unroll
                for (int s2 = 0; s2 < 2; ++s2) o[ct] = __builtin_amdgcn_mfma_f32_32x32x16_bf16(SS[ub + (ct * 4 + at * 2 + s2) * 64 + lane], QPT[ub + ((it * 2 + at) * 2 + s2) * 64 + lane], o[ct], 0, 0, 0);
        }
        float ss = 0.f;
#pragma unroll
        for (int ct = 0; ct < 2; ++ct)
#pragma unroll
            for (int r = 0; r < 16; ++r) ss += o[ct][r] * o[ct][r];
        ss += __shfl_xor(ss, 32);
        const float rs = 1.0f / sqrtf(ss * (1.0f / 64.0f) + EPS);
        const size_t row = (size_t)b * SEQ + (size_t)n * 64 + it * 32 + lc;
#pragma unroll
        for (int ct = 0; ct < 2; ++ct)
#pragma unroll
            for (int rg = 0; rg < 4; ++rg) { const int c0 = 32 * ct + 8 * rg + 4 * lh;
                const v2u zz = *(const v2u*)(PROJ + row * PIN + PC_ZA + h * 64 + c0); const f32x4 ow = oww[ct][rg];
                const float z0 = bflo(zz.x), z1 = bfhi(zz.x), z2 = bflo(zz.y), z3 = bfhi(zz.y);
                v2u ov; ov.x = pk2(o[ct][4 * rg] * rs * ow[0] * silu_f(z0), o[ct][4 * rg + 1] * rs * ow[1] * silu_f(z1)); ov.y = pk2(o[ct][4 * rg + 2] * rs * ow[2] * silu_f(z2), o[ct][4 * rg + 3] * rs * ow[3] * silu_f(z3));
                *(v2u*)(OAB + row * D + h * 64 + c0) = ov;
            }
    }
}

template <int WIN>
__device__ __forceinline__ void pooled_block(const bf16* H, bf16* P, const int t0, const int tl0, const int col) {
    v4u r[WIN - 1 + 8];
#pragma unroll
    for (int j = 0; j < WIN - 1 + 8; ++j) { const int dt = j - (WIN - 1); r[j] = (v4u){0u, 0u, 0u, 0u}; if (tl0 + dt >= 0) r[j] = *(const v4u*)(H + (size_t)(t0 + dt) * D + col); }
    float s[8];
#pragma unroll
    for (int q = 0; q < 8; ++q) s[q] = 0.f;
#define POOL_ACC(sgn, VV) do { const v4u q_ = (VV); s[0] += sgn bflo(q_.x); s[1] += sgn bfhi(q_.x); s[2] += sgn bflo(q_.y); s[3] += sgn bfhi(q_.y); s[4] += sgn bflo(q_.z); s[5] += sgn bfhi(q_.z); s[6] += sgn bflo(q_.w); s[7] += sgn bfhi(q_.w); } while (0)
#pragma unroll
    for (int j = 0; j < WIN - 1; ++j) POOL_ACC(+, r[j]);
#pragma unroll
    for (int i = 0; i < 8; ++i) { const v4u self = r[WIN - 1 + i]; POOL_ACC(+, self);
        const int n = (tl0 + i + 1) < WIN ? (tl0 + i + 1) : WIN; const float inv = 1.0f / (float)n;
        v4u o; o.x = pk2(s[0] * inv - bflo(self.x), s[1] * inv - bfhi(self.x)); o.y = pk2(s[2] * inv - bflo(self.y), s[3] * inv - bfhi(self.y));
        o.z = pk2(s[4] * inv - bflo(self.z), s[5] * inv - bfhi(self.z)); o.w = pk2(s[6] * inv - bflo(self.w), s[7] * inv - bfhi(self.w));
        *(v4u*)(P + (size_t)(t0 + i) * D + col) = o;
        POOL_ACC(-, r[i]); }
#undef POOL_ACC
}
__device__ __forceinline__ void pooled_phase(Frame& F) {
    const bf16* H = (const bf16*)(F.ws + WS_H); bf16* P = (bf16*)(F.ws + WS_OAB);
    const int gt = F.vcu * 512 + F.tid, NT = F.G * 512;
    for (int it = gt; it < (NTOK / 8) * 128; it += NT) {
        const int c = it & 31, g = __builtin_amdgcn_readfirstlane((it >> 6) & 3), tb = ((it >> 8) << 1) | ((it >> 5) & 1);
        const int t0 = tb * 8, tl0 = t0 & (SEQ - 1), col = g * 256 + c * 8;
        if (g == 0) pooled_block<2>(H, P, t0, tl0, col); else if (g == 1) pooled_block<4>(H, P, t0, tl0, col); else if (g == 2) pooled_block<8>(H, P, t0, tl0, col); else pooled_block<16>(H, P, t0, tl0, col);
    }
}


#ifndef PH_MASK
#define PH_MASK 0xFFFFFF
#endif
#define IN(k) (((PH_MASK >> (k)) & 1) && lo <= (k) && (k) < hi)
#define BOTH(k) (IN(k) && IN((k) + 1))
#if MK_ONE_LAUNCH
#define GRID_BAR() xcd_barrier(bar)
#else
#define GRID_BAR() do { } while (0)
#endif
template <int LAYER>
__device__ __forceinline__ void moe_phases(Frame& F, const XcdBarrier& bar, const int lo, const int hi) {
    constexpr int pb = LAYER == 0 ? 7 : 13;
    bf16* const H = (bf16*)(F.ws + WS_H);
    const float* const MOD = (const float*)(F.ws + WS_MOD);
    if (IN(pb)) {
        moe_route(F, LAYER); if (BOTH(pb)) GRID_BAR(); }
    if (IN(pb + 1)) {
        build_moe_tables(F, LAYER);
        pg8::Gemm g{(const bf16*)H, 1024, 1024}; MoeSched S; S.init((const LAS int*)(F.lds + SCHED_OFF), F.G, (int)blockIdx.x, (const int*)(F.ws + WS_RT), F.ws + WS_WGU, 1024, 1024);
        EpiSwiglu E{(bf16*)(F.ws + WS_ACT)};
        if (LAYER == 1) { S.Blo = (const char*)(F.ws + WS_WGT); S.esplit = 16; }
        moe_tail_plan(F);
        pg8::gemm_phase<EpiSwiglu, MoeSched>(F.lds + RING_OFF, g, S, E);
        {
            const LAS int* T = (const LAS int*)(F.lds + SCHED_OFF); const int sp = T[67];
            const int q0 = LAYER == 0 ? 0 : CQ_NG, q1 = LAYER == 0 ? CQ_NGT : CQ_N;
            if (sp > 0) { __syncthreads(); const int f = q0 + T[65] * 8 * TQ_GU; int e = f + sp * 8 * TQ_GU; e = e < q1 ? e : q1; convert_range(F, 1, f, e, F.wave, 8); }
            if (LAYER == 1) { int t = q0 + T[66] * 8 * TQ_GU;
                if (t < q1) { __syncthreads(); convert_range(F, 1, t, q1, F.vcu * NWAVES + F.wave, F.G * NWAVES); } } }
        if (BOTH(pb + 1)) GRID_BAR();
    }
    if (IN(pb + 2)) {
        build_moe_tables(F, LAYER);
        pg8::Gemm g{(const bf16*)(F.ws + WS_ACT), 512, 512}; MoeSched S; S.init((const LAS int*)(F.lds + SCHED_OFF), F.G, (int)blockIdx.x, nullptr, F.ws + WS_WD, 512, 512);
        EpiStoreBf16 E{(bf16*)(F.ws + WS_Y), D};
        if (LAYER == 0) moe_tail_plan(F);
        pg8::gemm_phase<EpiStoreBf16, MoeSched>(F.lds + RING_OFF, g, S, E);
        if (LAYER == 0) {
            const LAS int* T = (const LAS int*)(F.lds + SCHED_OFF); const int sp = T[67];
            int t8 = T[66] * 8 * TQ_GU; t8 = t8 < CQ_NGT ? t8 : CQ_NGT;
            if (sp > 0) { __syncthreads(); const int f = t8 + T[65] * 8 * TQ_DN; int e = f + sp * 8 * TQ_DN; e = e < CQ_NG ? e : CQ_NG; convert_range(F, 1, f, e, F.wave, 8); } }
        if (BOTH(pb + 2)) GRID_BAR();
    }
    if (IN(pb + 3)) {
        build_moe_tables(F, LAYER);
        if (LAYER == 0) moe_tail_plan(F);
        const int tokw = F.vcu * 128 + F.wave * 16, b = (F.vcu * 128) / SEQ;
        f32x4 g2[4];
#pragma unroll
        for (int j = 0; j < 4; ++j) g2[j] = *((const f32x4*)(MOD + (size_t)(LAYER * 2 + b) * 6144 + 5 * 1024) + F.lane + 64 * j);
        if (LAYER == 0) {
            const ModVec m1 = load_mod(F.in[I_NMIX] + D, MOD + (size_t)(2 + b) * 6144 + 1024, MOD + (size_t)(2 + b) * 6144, F.lane);
            { const CombRecs recs = comb_load_recs(F, tokw); CombRows A, B; comb_issue(F, recs, 0, tokw, A);
#pragma unroll 1
              for (int i = 0; i < 16; i += 2) { const int t = tokw + i;
                  comb_issue(F, recs, i + 1, t + 1, B);
                  { const RowVec x = comb_finish(recs, i, A, g2);
                    store_row_bf16((bf16*)(F.ws + WS_XRB) + (size_t)t * D, F.lane, x); store_row_bf16(H + (size_t)t * D, F.lane, apply_mod(x, row_rstd(x), m1)); }
                  if (i + 2 < 16) comb_issue(F, recs, i + 2, t + 2, A);
                  { const RowVec x = comb_finish(recs, i + 1, B, g2);
                    store_row_bf16((bf16*)(F.ws + WS_XRB) + (size_t)(t + 1) * D, F.lane, x); store_row_bf16(H + (size_t)(t + 1) * D, F.lane, apply_mod(x, row_rstd(x), m1)); } } }
            __syncthreads();
            { const LAS int* T = (const LAS int*)(F.lds + SCHED_OFF);
              int t8 = T[66] * 8 * TQ_GU; t8 = t8 < CQ_NGT ? t8 : CQ_NGT; int t9 = t8 + T[66] * 8 * TQ_DN; t9 = t9 < CQ_NG ? t9 : CQ_NG;
              convert_range(F, 1, t9, CQ_NG, F.vcu * NWAVES + F.wave, F.G * NWAVES); }
        } else {
            f32x4 fw[4];
#pragma unroll
            for (int j = 0; j < 4; ++j) fw[j] = *((const f32x4*)F.in[I_FNW] + F.lane + 64 * j);
            { const CombRecs recs = comb_load_recs(F, tokw); CombRows A, B; comb_issue(F, recs, 0, tokw, A);
#pragma unroll 1
              for (int i = 0; i < 16; i += 2) { const int t = tokw + i;
                  comb_issue(F, recs, i + 1, t + 1, B);
                  { RowVec x = comb_finish(recs, i, A, g2); const float rstd = row_rstd(x);
#pragma unroll
                    for (int j = 0; j < 4; ++j) x.v[j] = x.v[j] * rstd * fw[j];
                    store_row_f32(F.out + (size_t)t * D, F.lane, x); }
                  if (i + 2 < 16) comb_issue(F, recs, i + 2, t + 2, A);
                  { RowVec x = comb_finish(recs, i + 1, B, g2); const float rstd = row_rstd(x);
#pragma unroll
                    for (int j = 0; j < 4; ++j) x.v[j] = x.v[j] * rstd * fw[j];
                    store_row_f32(F.out + (size_t)(t + 1) * D, F.lane, x); } } }
        }
        if (BOTH(pb + 3)) GRID_BAR();
    }
}

constexpr int PH_P0 = 0, PH_P1 = 1, PH_INPROJ = 2, PH_ATT = 3, PH_SCAN = 4, PH_DNOUT = 5, PH_OUTPROJ = 6, PH_MOE0 = 7, PH_POOLED = 11, PH_POOLG = 12, PH_MOE1 = 13;
constexpr int N_PHASES = 17;
struct Args { const float* in[24]; float* out; unsigned char* ws; int ph_lo, ph_hi; };
__global__ void __launch_bounds__(NWAVES * 64, 2) trunk_fwd(Args args) {
    __shared__ __attribute__((aligned(16))) unsigned char lds[LDS_BYTES];
    Frame F;
    F.lds = (LAS unsigned char*)lds;
    F.MISC = (volatile LAS unsigned*)(F.lds + MISC_OFF);
    F.tid = threadIdx.x; F.lane = F.tid & 63; F.wave = __builtin_amdgcn_readfirstlane(F.tid >> 6);
    F.G = gridDim.x; { const int bx = blockIdx.x; F.vcu = (F.G % 8 == 0) ? (bx % 8) * (F.G / 8) + bx / 8 : bx; }
#pragma unroll
    for (int i = 0; i < 24; ++i) F.in[i] = args.in[i];
    F.out = args.out; F.ws = args.ws; F.ctl = (gu32*)(args.ws + WS_CTL);
    for (int u = F.tid; u < (LDS_BYTES - LDSCTL_OFF) / 4; u += NWAVES * 64) ((LAS unsigned*)(F.lds + LDSCTL_OFF))[u] = 0u;
    __syncthreads();
#if MK_ONE_LAUNCH
    XcdBarrier bar = xcd_barrier_post((unsigned*)(F.ctl + CW_BAR), F.MISC + 8);
#else
    XcdBarrier bar; bar.bar = nullptr; bar.x = 0; bar.st = nullptr;
#endif
    const int lo = args.ph_lo, hi = args.ph_hi;

    bf16* const H = (bf16*)(F.ws + WS_H);
    const float* const MOD = (const float*)(F.ws + WS_MOD);

    if (IN(PH_P0)) { p0_prologue(F); if (BOTH(PH_P0)) GRID_BAR(); }
    if (IN(PH_P1)) { p1_prenorm0(F); if (BOTH(PH_P1)) GRID_BAR(); }
    if (IN(PH_INPROJ)) {
        pg8::Gemm g{(const bf16*)H, 1024, 1024}; DenseSched S; S.init(NTOK, IP_TILES * 256, F.G, (int)blockIdx.x, 1024, 0, F.ws + WS_WIN, 1024); S.gap_from = PC_ZA / 256; S.gap = 2;
        EpiStoreBf16 E{(bf16*)(F.ws + WS_PROJ), PIN};
        pg8::gemm_phase<EpiStoreBf16, DenseSched>(F.lds + RING_OFF, g, S, E);
        if (IP_FULL && (int)blockIdx.x >= IP_FULL) {
            __syncthreads(); const int r = (int)blockIdx.x - IP_FULL; convert_range(F, 0, r * 8 * TQ_INPROJ, (r + 1) * 8 * TQ_INPROJ, F.wave, 8); }
        if (BOTH(PH_INPROJ)) GRID_BAR();
    }
    if (IN(PH_ATT)) { dn_prep(F); if (BOTH(PH_ATT)) GRID_BAR(); }
    if (IN(PH_SCAN)) {
        if ((int)blockIdx.x < 32) dn_scan(F);
        else { const int o = (int)blockIdx.x - 32, NO = F.G - 32;
            attn_phase(F, o, NO); __syncthreads();
            { pg8::Gemm g{(const bf16*)H, 1024, 1024}; EpiStoreBf16 E{(bf16*)(F.ws + WS_PROJ), PIN};
              DenseSched S; S.init(NTOK, 512, NO, o, 1024, 0, F.ws + WS_WIN, 1024); S.gap_from = 0; S.gap = PC_ZA / 256; S.Lend = NO;
              pg8::gemm_phase<EpiStoreBf16, DenseSched>(F.lds + RING_OFF, g, S, E);
              if (o >= 64 && o < 64 + (S.nwg - NO)) { __syncthreads(); S.L0 = NO; S.G = S.nwg - NO; S.c = o - 64; S.Lend = S.nwg;
                  pg8::gemm_phase<EpiStoreBf16, DenseSched>(F.lds + RING_OFF, g, S, E); } }
            __syncthreads();
            { const int q = o < 64 ? 6 : o < 96 ? 4 : 9, off = o < 64 ? 48 * o : o < 96 ? 3072 + 32 * (o - 64) : 4096 + 72 * (o - 96);
              convert_range(F, 0, CQ_T2 + off, CQ_T2 + off + 8 * q, F.wave, 8);
              convert_range(F, 0, CQ_T2 + 4096 + 72 * 128, CQ_N, o * NWAVES + F.wave, NO * NWAVES); } }
        if (BOTH(PH_SCAN)) GRID_BAR(); }
    if (IN(PH_DNOUT)) { dn_output(F); if (BOTH(PH_DNOUT)) GRID_BAR(); }
    if (IN(PH_OUTPROJ)) {
        pg8::Gemm g{(const bf16*)(F.ws + WS_OAB), 1024, 1024}; DenseSched S; S.init(NTOK, D, F.G, (int)blockIdx.x, 1024, 0, F.ws + WS_WOUT, 1024);
        EpiResid<true> E{F.in[I_X], (bf16*)(F.ws + WS_XRB), MOD + 2 * 1024, nullptr};
        pg8::gemm_phase<EpiResid<true>, DenseSched>(F.lds + RING_OFF, g, S, E);
        if (BOTH(PH_OUTPROJ)) GRID_BAR();
    }
    moe_phases<0>(F, bar, lo, hi);
    if (IN(PH_POOLED)) { pooled_phase(F); if (BOTH(PH_POOLED)) GRID_BAR(); }
    if (IN(PH_POOLG)) {
        pg8::Gemm g{(const bf16*)(F.ws + WS_OAB), 256, 256}; DenseSched S; S.init(NTOK, D, F.G, (int)blockIdx.x, 1024, 256, F.ws + WS_POOLW, 256);
        EpiResid<false> E{nullptr, (bf16*)(F.ws + WS_XRB), MOD + (size_t)2 * 6144 + 2 * 1024, F.in[I_POOLS]};
        pg8::gemm_phase<EpiResid<false>, DenseSched>(F.lds + RING_OFF, g, S, E);
        if (BOTH(PH_POOLG)) GRID_BAR();
    }
    moe_phases<1>(F, bar, lo, hi);
#undef IN
#undef BOTH
}

extern "C" void kernel_launch(void* const* d_in, const int* in_sizes, int n_in, void* d_out, int out_size, void* d_ws, size_t ws_size, hipStream_t stream) {
    static int grid = 0;
    if (grid == 0) {
        if (n_in != 24 || in_sizes[0] != NTOK * D || out_size != NTOK * D || ws_size < WS_END2) { fprintf(stderr, "kernel_launch: unexpected shapes (n_in %d, in0 %d, out %d, ws %zu); nothing launched\n", n_in, n_in > 0 ? in_sizes[0] : -1, out_size, ws_size); grid = -1; return; }
        int per_cu = 0;
        if (hipOccupancyMaxActiveBlocksPerMultiprocessor(&per_cu, (const void*)trunk_fwd, NWAVES * 64, 0) != hipSuccess || per_cu < 1) fprintf(stderr, "kernel_launch: occupancy query says %d\n", per_cu);
        (void)hipGetLastError();
        grid = 256;
    }
    if (grid < 0) return;
    if (hipMemsetAsync((char*)d_ws + WS_CTL, 0, CTL_ZERO_BYTES, stream) != hipSuccess) { fprintf(stderr, "kernel_launch: memset failed\n"); return; }
    Args a{};
    for (int i = 0; i < 24; ++i) a.in[i] = (const float*)d_in[i];
    a.out = (float*)d_out; a.ws = (unsigned char*)d_ws;
#if MK_ONE_LAUNCH
    a.ph_lo = 0; a.ph_hi = N_PHASES;
    hipLaunchKernelGGL(trunk_fwd, dim3(grid), dim3(NWAVES * 64), 0, stream, a);
#else
    for (int p = 0; p < N_PHASES; ++p) { a.ph_lo = p; a.ph_hi = p + 1; hipLaunchKernelGGL(trunk_fwd, dim3(grid), dim3(NWAVES * 64), 0, stream, a); }
#endif
}
```

```cpp
#include <hip/hip_runtime.h>
#include <cstdio>
#include <cstdint>

#ifndef MK_ONE_LAUNCH
#define MK_ONE_LAUNCH 1
#endif

#define GAS __attribute__((address_space(1)))
#define LAS __attribute__((address_space(3)))
typedef unsigned short bf16;
typedef unsigned v4u __attribute__((ext_vector_type(4)));
typedef unsigned v2u __attribute__((ext_vector_type(2)));
typedef float f32x4 __attribute__((ext_vector_type(4)));
typedef float f32x2 __attribute__((ext_vector_type(2)));
typedef float f32x16 __attribute__((ext_vector_type(16)));
typedef short bf16x8 __attribute__((ext_vector_type(8)));
typedef GAS unsigned gu32;
#define RLX_AGENT __ATOMIC_RELAXED, __HIP_MEMORY_SCOPE_AGENT
#define LDS_WAIT() asm volatile("s_waitcnt lgkmcnt(0)" ::: "memory")
#define LDS_BAR() do { asm volatile("s_waitcnt lgkmcnt(0)" ::: "memory"); __builtin_amdgcn_s_barrier(); asm volatile("" ::: "memory"); } while (0)
#define VM_WAIT() asm volatile("s_waitcnt vmcnt(0)" ::: "memory")

constexpr int BATCH = 2, SEQ = 16384, D = 1024, NTOK = BATCH * SEQ;
constexpr int PIN = 2816;
constexpr int PC_QA = 0, PC_KA = 512, PC_VA = 1024, PC_ZA = 1536, PC_QB = 2048, PC_KB = 2560, PC_VB = 2688;
constexpr int NEXP = 32, DFF = 512;
constexpr int MAXTILES = NTOK * 2 / 256 + NEXP;
constexpr float EPS = 1e-6f;
constexpr int NWAVES = 8;

constexpr size_t MiB = 1u << 20;
constexpr size_t WS_CTL = 0, CTL_ZERO_BYTES = 1 * MiB;
constexpr size_t WS_MOD = 1 * MiB;
constexpr size_t WS_WBA = 1 * MiB + 128 * 1024;
constexpr size_t WS_ROUTE = 2 * MiB;
constexpr size_t WS_RT = 3 * MiB;
constexpr size_t WS_BG = 7 * MiB;
constexpr size_t WS_WIN = 10 * MiB;
constexpr size_t WS_WOUT = 16 * MiB;
constexpr size_t WS_POOLW = 18 * MiB;
constexpr size_t WS_WGU = 20 * MiB;
constexpr size_t WS_WD = 84 * MiB;
constexpr size_t WS_H = 116 * MiB;
constexpr size_t WS_PROJ = 180 * MiB;
constexpr size_t WS_OAB = 356 * MiB;
constexpr size_t WS_YM = 180 * MiB;
constexpr size_t WS_ACT = 180 * MiB;
constexpr size_t WS_Y = 252 * MiB;
constexpr size_t WS_END = 420 * MiB;
constexpr size_t OUT_DN_MT = 0, OUT_DN_QPT = 32 * MiB;
constexpr size_t WS_DN_BM = 420 * MiB, WS_DN_O0T = 452 * MiB, WS_DN_S = 484 * MiB;
constexpr size_t WS_DN_GT = 9 * MiB;
constexpr size_t WS_XRB = 420 * MiB;
constexpr size_t WS_WGT = 484 * MiB;
constexpr size_t WS_END2 = 516 * MiB;
constexpr int CW_CNT = 64;
constexpr int CW_BAR = 4096;
constexpr int CW_BAD = 200;

constexpr int RING_OFF = 0, RING_BYTES = 131072;
constexpr int LDSCTL_OFF = RING_BYTES, MISC_OFF = LDSCTL_OFF + 320;
constexpr int SCHED_OFF = LDSCTL_OFF + 1024;
constexpr int LDS_BYTES = 163840;
constexpr int R1W_OFF = 135168;
constexpr int RT_LDS_OFF = 151552;

typedef __bf16 bf16x2_t __attribute__((ext_vector_type(2)));
__device__ __forceinline__ unsigned pk2(float lo, float hi) { bf16x2_t v; v.x = (__bf16)lo; v.y = (__bf16)hi; return __builtin_bit_cast(unsigned, v); }
__device__ __forceinline__ unsigned f2bf(float f) { return pk2(f, 0.f) & 0xffffu; }
__device__ __forceinline__ float bf2f(unsigned b) { return __builtin_bit_cast(float, b << 16); }
__device__ __forceinline__ float bflo(unsigned w) { return __builtin_bit_cast(float, w << 16); }
__device__ __forceinline__ float bfhi(unsigned w) { return __builtin_bit_cast(float, w & 0xffff0000u); }
template <int CTRL> __device__ __forceinline__ float dpp_f(float v) { return __builtin_bit_cast(float, __builtin_amdgcn_update_dpp(0, __builtin_bit_cast(int, v), CTRL, 0xf, 0xf, false)); }
__device__ __forceinline__ float quad_sum(float v) { v += dpp_f<0xB1>(v); v += dpp_f<0x4E>(v); return v; }
__device__ __forceinline__ float oct_sum(float v) { v = quad_sum(v); v += dpp_f<0x141>(v); return v; }
__device__ __forceinline__ float wave_sum(float v) {
    v = oct_sum(v); v += dpp_f<0x140>(v);
    const float r0 = __builtin_bit_cast(float, __builtin_amdgcn_readlane(__builtin_bit_cast(int, v), 0)), r1 = __builtin_bit_cast(float, __builtin_amdgcn_readlane(__builtin_bit_cast(int, v), 16));
    const float r2 = __builtin_bit_cast(float, __builtin_amdgcn_readlane(__builtin_bit_cast(int, v), 32)), r3 = __builtin_bit_cast(float, __builtin_amdgcn_readlane(__builtin_bit_cast(int, v), 48));
    return (r0 + r1) + (r2 + r3);
}
__device__ __forceinline__ float rl(float x, int l) { return __builtin_bit_cast(float, __builtin_amdgcn_readlane(__builtin_bit_cast(int, x), l)); }
template <int CTRL, int M> __device__ __forceinline__ void ms_halve(const float (&in)[2 * M], float (&out)[M], bool s) {
#pragma unroll
    for (int k = 0; k < M; ++k) { const float keep = s ? in[k + M] : in[k], send = s ? in[k] : in[k + M]; out[k] = keep + dpp_f<CTRL>(send); }
}
__device__ __forceinline__ float ms_rows(float v) {
    { unsigned a = __builtin_bit_cast(unsigned, v), b = a; asm volatile("s_nop 1\n\tv_permlane16_swap_b32 %0, %1" : "+v"(a), "+v"(b)); v = __builtin_bit_cast(float, a) + __builtin_bit_cast(float, b); }
    { unsigned a = __builtin_bit_cast(unsigned, v), b = a; asm volatile("s_nop 1\n\tv_permlane32_swap_b32 %0, %1" : "+v"(a), "+v"(b)); v = __builtin_bit_cast(float, a) + __builtin_bit_cast(float, b); }
    return v;
}
__device__ __forceinline__ float multi_sum16(const float (&v)[16], int lane) {
    float a[8], b[4], c[2], d[1];
    ms_halve<0x140, 8>(v, a, (lane & 8) != 0); ms_halve<0x141, 4>(a, b, (lane & 4) != 0); ms_halve<0x4E, 2>(b, c, (lane & 2) != 0); ms_halve<0xB1, 1>(c, d, (lane & 1) != 0);
    return ms_rows(d[0]);
}
__device__ __forceinline__ float multi_sum8(const float (&v)[8], int lane) {
    float a[4], b[2], c[1];
    ms_halve<0x140, 4>(v, a, (lane & 8) != 0); ms_halve<0x141, 2>(a, b, (lane & 4) != 0); ms_halve<0x4E, 1>(b, c, (lane & 2) != 0);
    float r = c[0]; r += dpp_f<0xB1>(r); return ms_rows(r);
}
__device__ __forceinline__ float multi_sum4(const float (&v)[4], int lane) {
    float a[2], b[1];
    ms_halve<0x140, 2>(v, a, (lane & 8) != 0); ms_halve<0x141, 1>(a, b, (lane & 4) != 0);
    float r = b[0]; r += dpp_f<0x4E>(r); r += dpp_f<0xB1>(r); return ms_rows(r);
}
__device__ __forceinline__ float silu_f(float x) { return x / (1.f + __expf(-x)); }
__device__ __forceinline__ float sigmoid_f(float x) { return 1.f / (1.f + __expf(-x)); }
__device__ __forceinline__ float softplus_f(float x) { return x > 20.f ? x : log1pf(__expf(x)); }

namespace pg8 {
#define PG8_LAS __attribute__((address_space(3)))
typedef unsigned short bf16_t;
typedef unsigned u32x4 __attribute__((ext_vector_type(4)));
constexpr int BM = 256, BK = 64, HALF = 128, HTB = HALF * BK * 2, STAGE_BYTES = 8 * HTB;

__host__ __device__ __forceinline__ int lds_byte(int r, int c) { const int st = (r >> 4) * 2 + (c >> 5), rr = r & 15, cc = c & 31, ob = rr * 64 + cc * 2; return st * 1024 + (ob ^ (((ob >> 9) & 1) << 5)); }
__host__ __device__ __forceinline__ void stage_rc(int b, int& R, int& C) { const int st = b / 1024, sb = b % 1024, swz = sb ^ (((sb >> 9) & 1) << 5); R = (st >> 1) * 16 + swz / 64; C = (st & 1) * 32 + (swz % 64) / 2; }
__host__ __device__ __forceinline__ int perm32(int rho) { const int n = rho >> 4, i = rho & 15; return 8 * (i >> 2) + 4 * n + (i & 3); }

struct Unit { int pm, pn, e; };
struct Gemm { const bf16_t* A; int K, ldb; };

template <class Epi, class Sched>
__device__ __forceinline__ void gemm_phase(PG8_LAS unsigned char* lds, const Gemm g, const Sched& S, const Epi& E) {
    const int tid = threadIdx.x, wid = __builtin_amdgcn_readfirstlane(tid >> 6), lane = tid & 63, wr = wid >> 2, wc = wid & 3, fr = lane & 15, fq = lane >> 4;
    const int K = g.K, nt = K / BK;
    int R0, C0, R1, C1; stage_rc(tid * 16, R0, C0); stage_rc(tid * 16 + 8192, R1, C1);
    const int Rb0 = (R0 & ~31) + perm32(R0 & 31), Rb1 = (R1 & ~31) + perm32(R1 & 31);
    const unsigned voffB0 = (unsigned)(Rb0 * g.ldb + C0) * 2u, voffB1 = (unsigned)(Rb1 * g.ldb + C1) * 2u;
    const size_t kstep = (size_t)(BK * 2);
    const size_t hstepB = (size_t)HALF * g.ldb * 2;
    const unsigned ldsw = (unsigned)wid * 1024u;
    const int aoff = lds_byte(wr * 64 + fr, fq * 8), boff = lds_byte(wc * 32 + fr, fq * 8);
    const char* Ab = (const char*)g.A;
#define PG8_SA(b, h) (((b) * 2 + (h)) * HTB)
#define PG8_SB(b, h) ((4 + (b) * 2 + (h)) * HTB)
#define PG8_ST2(bufoff, gbase, v0, v1) do { \
        __builtin_amdgcn_global_load_lds((const unsigned*)((const char*)(gbase) + (v0)), (PG8_LAS unsigned*)(lds + (bufoff) + ldsw), 16, 0, 0); \
        __builtin_amdgcn_global_load_lds((const unsigned*)((const char*)(gbase) + (v1)), (PG8_LAS unsigned*)(lds + (bufoff) + ldsw + 8192), 16, 0, 0); } while (0)
#define PG8_STB(bufoff, gbase) PG8_ST2(bufoff, gbase, voffB0, voffB1)
#define PG8_LDA(dst, b, h) do { _Pragma("unroll") for (int m = 0; m < 4; ++m) _Pragma("unroll") for (int k = 0; k < 2; ++k) dst[m][k] = *(const PG8_LAS bf16x8*)(lds + PG8_SA(b, h) + aoff + m * 2048 + k * 1024); } while (0)
#define PG8_LDB(dst, b, h) do { _Pragma("unroll") for (int n = 0; n < 2; ++n) _Pragma("unroll") for (int k = 0; k < 2; ++k) dst[n][k] = *(const PG8_LAS bf16x8*)(lds + PG8_SB(b, h) + boff + n * 2048 + k * 1024); } while (0)
#define PG8_MMA(ai, bj, At, Bt) do { __builtin_amdgcn_s_setprio(1); _Pragma("unroll") for (int m = 0; m < 4; ++m) _Pragma("unroll") for (int n = 0; n < 2; ++n) _Pragma("unroll") for (int k = 0; k < 2; ++k) \
        acc[ai][bj][m][n] = __builtin_amdgcn_mfma_f32_16x16x32_bf16(Bt[n][k], At[m][k], acc[ai][bj][m][n], 0, 0, 0); __builtin_amdgcn_s_setprio(0); } while (0)
#define PG8_WAIT_V(n) asm volatile("s_waitcnt vmcnt(" #n ")" ::: "memory")
#define PG8_WAIT_L(n) asm volatile("s_waitcnt lgkmcnt(" #n ")" ::: "memory")
#define PG8_BAR __builtin_amdgcn_s_barrier()
#define PG8_SCHED __builtin_amdgcn_sched_barrier(0)
    Unit cur, nxt; int ui = 0;
    if (!S.next(0, cur)) return;
    f32x4 acc[2][2][4][2];
#pragma unroll
    for (int a = 0; a < 2; ++a)
#pragma unroll
        for (int b = 0; b < 2; ++b)
#pragma unroll
            for (int m = 0; m < 4; ++m)
#pragma unroll
                for (int n = 0; n < 2; ++n) acc[a][b][m][n] = (f32x4){0.f, 0.f, 0.f, 0.f};
    bf16x8 At[4][2], B0[2][2], B1[2][2];
    unsigned c00, c01, c10, c11;
#define PG8_AOFF(u, d00, d01, d10, d11) do { \
        d00 = S.a_off(u, R0) + (unsigned)C0 * 2u; d01 = S.a_off(u, R1) + (unsigned)C1 * 2u; \
        d10 = S.a_off(u, HALF + R0) + (unsigned)C0 * 2u; d11 = S.a_off(u, HALF + R1) + (unsigned)C1 * 2u; } while (0)
    PG8_AOFF(cur, c00, c01, c10, c11);
    const char* cB = S.b_ptr(cur);
    PG8_STB(PG8_SB(0, 0), cB); PG8_STB(PG8_SB(0, 1), cB + hstepB); PG8_ST2(PG8_SA(0, 0), Ab, c00, c01); PG8_ST2(PG8_SA(0, 1), Ab, c10, c11);
    if (wr == 1) PG8_BAR;
    PG8_WAIT_V(2); PG8_BAR;
    PG8_STB(PG8_SB(1, 0), cB + kstep); PG8_ST2(PG8_SA(1, 0), Ab + kstep, c00, c01); PG8_STB(PG8_SB(1, 1), cB + hstepB + kstep);
    PG8_WAIT_V(6); PG8_BAR;
    for (;;) {
        const bool has_next = S.next(ui + 1, nxt);
        const char* nB = has_next ? S.b_ptr(nxt) : cB;
        unsigned n00 = 0, n01 = 0, n10 = 0, n11 = 0;
        if (has_next) { PG8_AOFF(nxt, n00, n01, n10, n11); }
#pragma unroll 1
        for (int t = 0; t < nt; t += 2) {
            const bool last = (t == nt - 2);
            const char* a1 = Ab + (size_t)(t + 1) * kstep;
            const char* a2 = last ? Ab : Ab + (size_t)(t + 2) * kstep; const char* b2 = last ? nB : cB + (size_t)(t + 2) * kstep;
            const char* a3 = a2 + kstep; const char* b3 = b2 + kstep;
            PG8_LDB(B0, 0, 0); PG8_LDB(B1, 0, 1); PG8_SCHED; PG8_LDA(At, 0, 0); PG8_ST2(PG8_SA(1, 1), a1, c10, c11);
            PG8_WAIT_V(8); PG8_WAIT_L(0); PG8_BAR; PG8_MMA(0, 0, At, B0); PG8_MMA(0, 1, At, B1); PG8_BAR; PG8_SCHED;
            if (last && has_next) { c00 = n00; c01 = n01; c10 = n10; c11 = n11; }
            PG8_LDA(At, 0, 1); PG8_STB(PG8_SB(0, 0), b2); PG8_STB(PG8_SB(0, 1), b2 + hstepB); PG8_ST2(PG8_SA(0, 0), a2, c00, c01);
            PG8_WAIT_V(8); PG8_WAIT_L(0); PG8_BAR; PG8_MMA(1, 0, At, B0); PG8_MMA(1, 1, At, B1); PG8_BAR; PG8_SCHED;
            PG8_LDB(B0, 1, 0); PG8_LDB(B1, 1, 1); PG8_SCHED; PG8_LDA(At, 1, 0); PG8_ST2(PG8_SA(0, 1), a2, c10, c11);
            PG8_WAIT_V(8); PG8_WAIT_L(0); PG8_BAR; PG8_MMA(0, 0, At, B0); PG8_MMA(0, 1, At, B1); PG8_BAR; PG8_SCHED;
            PG8_LDA(At, 1, 1); PG8_STB(PG8_SB(1, 0), b3); PG8_STB(PG8_SB(1, 1), b3 + hstepB); PG8_ST2(PG8_SA(1, 0), a3, c00, c01);
            PG8_WAIT_V(8); PG8_WAIT_L(0); PG8_BAR; PG8_MMA(1, 0, At, B0); PG8_MMA(1, 1, At, B1); PG8_BAR; PG8_SCHED;
        }
        if (wr == 0) PG8_BAR;
        E(acc, cur, wr, wc, fr, fq);
        if (!has_next) break;
#pragma unroll
        for (int a = 0; a < 2; ++a)
#pragma unroll
            for (int b = 0; b < 2; ++b)
#pragma unroll
                for (int m = 0; m < 4; ++m)
#pragma unroll
                    for (int n = 0; n < 2; ++n) acc[a][b][m][n] = (f32x4){0.f, 0.f, 0.f, 0.f};
        cur = nxt; cB = nB; ++ui;
        if (wr == 1) PG8_BAR;
    }
    PG8_WAIT_V(0);
    PG8_BAR;
#undef PG8_SA
#undef PG8_SB
#undef PG8_ST2
#undef PG8_STB
#undef PG8_LDA
#undef PG8_LDB
#undef PG8_MMA
#undef PG8_WAIT_V
#undef PG8_WAIT_L
#undef PG8_BAR
#undef PG8_SCHED
#undef PG8_AOFF
}
}

#define XB_TMO      128
#define XB_XCNT(j)  (256  + 64 * (j))
#define XB_XSUB(j)  (1280 + 64 * (j))
#define XB_XGEN(j)  (2304 + 64 * (j))
#define XB_TOP      3328
#define XB_TOPGEN   3392
#define XCD_BAR_WORDS 3456
#define XB_SPIN_CAP (1u << 22)

__device__ __forceinline__ unsigned xb_ld(unsigned* p)              { return __hip_atomic_load(p, __ATOMIC_RELAXED, __HIP_MEMORY_SCOPE_AGENT); }
__device__ __forceinline__ unsigned xb_add(unsigned* p, unsigned v) { return __hip_atomic_fetch_add(p, v, __ATOMIC_RELAXED, __HIP_MEMORY_SCOPE_AGENT); }
__device__ __forceinline__ unsigned xb_xcc_id() { return (unsigned)__builtin_amdgcn_s_getreg((3 << 11) | 20) & 0xFu; }
#define XB_SPIN(cond, bar) do { unsigned _sp = 0; while (cond) { __builtin_amdgcn_s_sleep(1); \
    if ((++_sp & 255u) == 0u) { if (xb_ld(&(bar)[XB_TMO])) break; if (_sp > XB_SPIN_CAP) { atomicAdd(&(bar)[XB_TMO], 1u); break; } } } } while (0)

struct XcdBarrier { unsigned* bar; unsigned x; volatile LAS unsigned* st; };

__device__ __forceinline__ XcdBarrier xcd_barrier_post(unsigned* bar, volatile LAS unsigned* st) {
    XcdBarrier b; b.bar = bar; b.x = xb_xcc_id(); b.st = st;
    if (threadIdx.x == 0) (void)xb_add(&bar[XB_XCNT(b.x)], 1u);
    return b;
}
__device__ __forceinline__ void xcd_barrier_complete(unsigned* bar, unsigned x, unsigned& nloc, unsigned& nx) {
    const unsigned G = gridDim.x * gridDim.y * gridDim.z;
    unsigned sum, cnt, mine, sp = 0u;
    for (;;) {
        sum = 0u; cnt = 0u; mine = 0u;
#pragma unroll
        for (unsigned j = 0; j < 16; ++j) { const unsigned c = xb_ld(&bar[XB_XCNT(j)]); sum += c; cnt += (c > 0u) ? 1u : 0u; mine = (j == x) ? c : mine; }
        if (sum == G) break;
        __builtin_amdgcn_s_sleep(1);
        if ((++sp & 255u) == 0u) { if (xb_ld(&bar[XB_TMO])) break; if (sp > XB_SPIN_CAP) { atomicAdd(&bar[XB_TMO], 1u); break; } }
    }
    nloc = mine > 0u ? mine : 1u; nx = cnt > 0u ? cnt : 1u;
}
__device__ __forceinline__ void xcd_barrier(const XcdBarrier& b) {
    asm volatile("s_waitcnt vmcnt(0)" ::: "memory");
    __syncthreads();
    if (threadIdx.x == 0) {
        unsigned* bar = b.bar;
        __builtin_amdgcn_s_waitcnt(0);
        unsigned nloc = b.st[0], nx = b.st[1];
        if (nloc == 0u) { xcd_barrier_complete(bar, b.x, nloc, nx); b.st[0] = nloc; b.st[1] = nx; }
        const unsigned old = xb_add(&bar[XB_XSUB(b.x)], 1u);
        const unsigned gen = old / nloc;
        if (old + 1u == (gen + 1u) * nloc) {
            __builtin_amdgcn_fence(__ATOMIC_RELEASE, "agent");
            asm volatile("s_waitcnt vmcnt(0)" ::: "memory");
            const unsigned og = xb_add(&bar[XB_TOP], 1u);
            const unsigned tg = og / nx;
            if (og + 1u == (tg + 1u) * nx) xb_add(&bar[XB_TOPGEN], 1u);
            else XB_SPIN(xb_ld(&bar[XB_TOPGEN]) == tg, bar);
            __builtin_amdgcn_fence(__ATOMIC_ACQUIRE, "agent");
            xb_add(&bar[XB_XGEN(b.x)], 1u);
            asm volatile("s_waitcnt vmcnt(0)" ::: "memory");
        } else {
            XB_SPIN(xb_ld(&bar[XB_XGEN(b.x)]) == gen, bar);
            __builtin_amdgcn_fence(__ATOMIC_ACQUIRE, "agent");
            asm volatile("s_waitcnt vmcnt(0)" ::: "memory");
        }
    }
    __syncthreads();
}

struct Frame {
    LAS unsigned char* lds;
    volatile LAS unsigned* MISC;
    gu32* ctl;
    int tid, lane, wave, vcu, G;
    const float* in[24];
    float* out;
    unsigned char* ws;
};
enum { I_X = 0, I_C, I_ADAW, I_ADAB, I_NMIX, I_NFFN, I_WIN, I_CONVW, I_ALOG, I_DTB, I_ONORM, I_SINKS, I_RELB, I_WOUT, I_POOLW, I_POOLS, I_R1W, I_R1B, I_R2W, I_R2B, I_WG, I_WU, I_WDN, I_FNW };

__device__ __forceinline__ void p0_transpose_item(const float* W, int ldw, int K, bf16* WT, int dst_row0, LAS float* scr, int k0, int n0, int lane) {
    f32x4 w4[8];
#pragma unroll
    for (int i = 0; i < 8; ++i) { const int f = i * 64 + lane, kk = f >> 3, c4 = f & 7; w4[i] = __builtin_nontemporal_load((const f32x4*)(W + (size_t)(k0 + kk) * ldw + n0 + c4 * 4)); }
#pragma unroll
    for (int i = 0; i < 8; ++i) { const int f = i * 64 + lane, kk = f >> 3, c4 = f & 7; LAS float* d = scr + kk * 33 + c4 * 4; d[0] = w4[i].x; d[1] = w4[i].y; d[2] = w4[i].z; d[3] = w4[i].w; }
    LDS_WAIT(); asm volatile("" ::: "memory");
    const int c = lane & 7;
#pragma unroll
    for (int j = 0; j < 4; ++j) { const int n = (lane >> 3) + 8 * j; const LAS float* s = scr + (8 * c) * 33 + n;
        v4u o; o.x = pk2(s[0 * 33], s[1 * 33]); o.y = pk2(s[2 * 33], s[3 * 33]); o.z = pk2(s[4 * 33], s[5 * 33]); o.w = pk2(s[6 * 33], s[7 * 33]);
        __builtin_nontemporal_store(o, (GAS v4u*)(WT + (size_t)(dst_row0 + n) * K + k0 + 8 * c)); }
    LDS_WAIT(); asm volatile("" ::: "memory");
}
constexpr int CQ_NG = NEXP * 512, CQ_NGT = 16 * 512, CQ_N = NEXP * 768;
constexpr int TQ_INPROJ = 11, TQ_GU = 6, TQ_DN = 4;
constexpr int IP_TILES = PIN / 256 - 2;
constexpr int IP_FULL = ((NTOK / 256) * IP_TILES) % 256;
constexpr int CQ_T2 = IP_FULL ? (256 - IP_FULL) * 8 * TQ_INPROJ : 0;
__device__ __forceinline__ void convert_item(Frame& F, int layer, int it, LAS float* scr) {
    if (it < CQ_NG) {
        const int e = it >> 9, r = it & 511, up = r >> 8, q = r & 255, kb = q >> 4, nb = q & 15;
        const float* W = (up ? F.in[I_WU] : F.in[I_WG]) + (size_t)(layer * NEXP + e) * 1024 * 512;
        p0_transpose_item(W, 512, 1024, (bf16*)(F.ws + ((layer && e < 16) ? WS_WGT : WS_WGU)), e * 1024 + (nb >> 2) * 256 + up * 128 + (nb & 3) * 32, scr, kb * 64, nb * 32, F.lane);
    } else {
        const int r0 = it - CQ_NG, e = r0 >> 8, q = r0 & 255, kb = q >> 5, nb = q & 31;
        const float* W = F.in[I_WDN] + (size_t)(layer * NEXP + e) * 512 * 1024;
        p0_transpose_item(W, 1024, 512, (bf16*)(F.ws + WS_WD), e * 1024 + nb * 32, scr, kb * 64, nb * 32, F.lane);
    }
}
__device__ __forceinline__ void convert_range(Frame& F, int layer, int first, int end, int start, int stride) {
    LAS float* scr = (LAS float*)(F.lds + RING_OFF + F.wave * 16384);
    for (int it = first + start; it < end; it += stride) convert_item(F, layer, it, scr);
}
__device__ __forceinline__ void p0_prologue(Frame& F) {
    LAS float* scr = (LAS float*)(F.lds + RING_OFF + F.wave * 16384);
    const int gw = F.vcu * NWAVES + F.wave, NGW = F.G * NWAVES;
    constexpr int IA = 16 * 64, IB = 16 * 24, IO = 16 * 32, IP = 4 * 32, NIT = IA + IB + IO + IP;
    for (int it = gw; it < NIT; it += NGW) {
        int r = it;
        if (r < IA) { p0_transpose_item(F.in[I_WIN], 2832, 1024, (bf16*)(F.ws + WS_WIN), (r % 64) * 32, scr, (r / 64) * 64, (r % 64) * 32, F.lane); continue; } r -= IA;
        if (r < IB) { p0_transpose_item(F.in[I_WIN] + 2064, 2832, 1024, (bf16*)(F.ws + WS_WIN), 2048 + (r % 24) * 32, scr, (r / 24) * 64, (r % 24) * 32, F.lane); continue; } r -= IB;
        if (r < IO) { p0_transpose_item(F.in[I_WOUT], 1024, 1024, (bf16*)(F.ws + WS_WOUT), (r % 32) * 32, scr, (r / 32) * 64, (r % 32) * 32, F.lane); continue; } r -= IO;
        { const int g = r >> 5, q = r & 31; p0_transpose_item(F.in[I_POOLW] + (size_t)g * 65536, 256, 256, (bf16*)(F.ws + WS_POOLW) + (size_t)g * 65536, (q & 7) * 32, scr, (q >> 3) * 64, (q & 7) * 32, F.lane); }
    }
    { float* WBA = (float*)(F.ws + WS_WBA); const int gt = F.vcu * 512 + F.tid;
      if (gt < 16 * 1024) { const int o = gt >> 10, k = gt & 1023; WBA[o * 1024 + k] = F.in[I_WIN][(size_t)k * 2832 + 2048 + o]; } }
    __syncthreads();
    {
        LAS float* red = (LAS float*)(F.lds + RING_OFF);
        const int ks = F.tid >> 4, cj = F.tid & 15;
        for (int u = F.vcu; u < 192; u += F.G) {
            const int l = u / 96, cb = u % 96;
            const float* W = F.in[I_ADAW] + (size_t)l * 1024 * 6144 + cb * 64 + cj * 4;
            f32x4 a0 = {0.f, 0.f, 0.f, 0.f}, a1 = {0.f, 0.f, 0.f, 0.f};
            for (int k = ks * 32; k < ks * 32 + 32; ++k) {
                const f32x4 w = *(const f32x4*)(W + (size_t)k * 6144);
                const float c0 = silu_f(F.in[I_C][k]), c1 = silu_f(F.in[I_C][1024 + k]);
                a0 += w * c0; a1 += w * c1;
            }
            *(LAS f32x4*)(red + (ks * 2 + 0) * 64 + cj * 4) = a0; *(LAS f32x4*)(red + (ks * 2 + 1) * 64 + cj * 4) = a1;
            __syncthreads();
            if (F.tid < 128) { const int b = F.tid >> 6, c = F.tid & 63; float s = 0.f;
                for (int q = 0; q < 32; ++q) s += red[(q * 2 + b) * 64 + c];
                ((float*)(F.ws + WS_MOD))[(size_t)(l * 2 + b) * 6144 + cb * 64 + c] = s + F.in[I_ADAB][l * 6144 + cb * 64 + c]; }
            __syncthreads();
        }
    }
}

typedef float f32x2v __attribute__((ext_vector_type(2)));
struct RowVec { f32x4 v[4]; };
__device__ __forceinline__ RowVec load_row_f32(const float* row, int lane) { RowVec r; const GAS f32x4* p = (const GAS f32x4*)row + lane;
#pragma unroll
    for (int j = 0; j < 4; ++j) r.v[j] = p[64 * j]; return r; }
__device__ __forceinline__ void store_row_f32(float* row, int lane, const RowVec& r) { GAS f32x4* p = (GAS f32x4*)row + lane;
#pragma unroll
    for (int j = 0; j < 4; ++j) p[64 * j] = r.v[j]; }
__device__ __forceinline__ void store_row_bf16(bf16* row, int lane, const RowVec& r) { GAS v2u* p = (GAS v2u*)row + lane;
#pragma unroll
    for (int j = 0; j < 4; ++j) { v2u o; o.x = pk2(r.v[j].x, r.v[j].y); o.y = pk2(r.v[j].z, r.v[j].w); p[64 * j] = o; } }
__device__ __forceinline__ void load_row_bf16(const bf16* row, int lane, v2u (&p)[4]) { const GAS v2u* q = (const GAS v2u*)row + lane;
#pragma unroll
    for (int j = 0; j < 4; ++j) p[j] = q[64 * j]; }
__device__ __forceinline__ RowVec unpack_row_bf16(const v2u (&p)[4]) { RowVec r;
#pragma unroll
    for (int j = 0; j < 4; ++j) { r.v[j].x = bflo(p[j].x); r.v[j].y = bfhi(p[j].x); r.v[j].z = bflo(p[j].y); r.v[j].w = bfhi(p[j].y); } return r; }
__device__ __forceinline__ float row_rstd(const RowVec& r) { float s = 0.f;
#pragma unroll
    for (int j = 0; j < 4; ++j) s += (r.v[j].x * r.v[j].x + r.v[j].y * r.v[j].y) + (r.v[j].z * r.v[j].z + r.v[j].w * r.v[j].w);
    return 1.0f / sqrtf(wave_sum(s) * (1.f / D) + EPS); }
struct ModVec { f32x4 a[4], b[4]; };
__device__ __forceinline__ ModVec load_mod(const float* w, const float* sc, const float* sh, int lane) { ModVec m;
#pragma unroll
    for (int j = 0; j < 4; ++j) { const f32x4 wv = *((const f32x4*)w + lane + 64 * j), s = *((const f32x4*)sc + lane + 64 * j); m.a[j] = wv * (s + 1.0f); m.b[j] = *((const f32x4*)sh + lane + 64 * j); }
    return m; }
__device__ __forceinline__ RowVec apply_mod(const RowVec& x, float rstd, const ModVec& m) { RowVec h;
#pragma unroll
    for (int j = 0; j < 4; ++j) h.v[j] = x.v[j] * rstd * m.a[j] + m.b[j]; return h; }

__device__ __forceinline__ void p1_prenorm0(Frame& F) {
    LAS float* wba = (LAS float*)(F.lds + RING_OFF);
    { const float* WBA = (const float*)(F.ws + WS_WBA); for (int i = F.tid; i < 16 * 256; i += 512) *((LAS f32x4*)wba + i) = *((const f32x4*)WBA + i); }
    __syncthreads();
    const float* mod = (const float*)(F.ws + WS_MOD);
    bf16* H = (bf16*)(F.ws + WS_H); float* BG = (float*)(F.ws + WS_BG);
    const int tok0 = F.vcu * (NTOK / F.G) + F.wave * (NTOK / F.G / NWAVES), ntw = NTOK / F.G / NWAVES;
    const int b = tok0 / SEQ;
    const ModVec m = load_mod(F.in[I_NMIX], mod + (size_t)b * 6144 + 1024, mod + (size_t)b * 6144, F.lane);
    const int hh = F.lane & 7;
    const float nega = -__expf(F.in[I_ALOG][hh]), dtb = F.in[I_DTB][hh];
    RowVec xa = load_row_f32(F.in[I_X] + (size_t)tok0 * D, F.lane), xb = load_row_f32(F.in[I_X] + (size_t)(tok0 + 1) * D, F.lane);
    const LAS f32x4* wl = (const LAS f32x4*)wba + F.lane;
    LAS float* bgs = (LAS float*)(F.lds + RING_OFF + 65536 + F.wave * 1024);
    for (int i = 0; i < ntw; i += 2) {
        const int t = tok0 + i;
        const RowVec x0 = xa, x1 = xb;
        const RowVec h0 = apply_mod(x0, row_rstd(x0), m), h1 = apply_mod(x1, row_rstd(x1), m);
        __builtin_amdgcn_sched_barrier(0);
        { const int tn = (i + 2 < ntw) ? t + 2 : t;
          xa = load_row_f32(F.in[I_X] + (size_t)tn * D, F.lane); xb = load_row_f32(F.in[I_X] + (size_t)(tn + 1) * D, F.lane); }
        __builtin_amdgcn_sched_barrier(0);
        store_row_bf16(H + (size_t)t * D, F.lane, h0); store_row_bf16(H + (size_t)(t + 1) * D, F.lane, h1);
        float p0[16], p1[16]; f32x4 w[2][4];
#pragma unroll
        for (int j = 0; j < 4; ++j) w[0][j] = wl[64 * j];
#pragma unroll
        for (int o = 0; o < 16; ++o) {
            if (o + 1 < 16) {
#pragma unroll
                for (int j = 0; j < 4; ++j) w[(o + 1) & 1][j] = wl[(o + 1) * 256 + 64 * j]; }
            __builtin_amdgcn_sched_barrier(0);
            f32x2v s0 = {0.f, 0.f}, s1 = {0.f, 0.f};
#pragma unroll
            for (int j = 0; j < 4; ++j) { const f32x4 ww = w[o & 1][j];
                s0 += h0.v[j].xy * ww.xy; s0 += h0.v[j].zw * ww.zw; s1 += h1.v[j].xy * ww.xy; s1 += h1.v[j].zw * ww.zw; }
            p0[o] = s0.x + s0.y; p1[o] = s1.x + s1.y;
            __builtin_amdgcn_sched_barrier(0); }
        const float mine0 = multi_sum16(p0, F.lane), mine1 = multi_sum16(p1, F.lane);
        if (F.lane < 16) { const float r0 = F.lane < 8 ? sigmoid_f(mine0) : nega * softplus_f(mine0 + dtb), r1 = F.lane < 8 ? sigmoid_f(mine1) : nega * softplus_f(mine1 + dtb);
            bgs[i * 16 + F.lane] = r0; bgs[(i + 1) * 16 + F.lane] = r1; }
    }
    *((f32x4*)(BG + (size_t)tok0 * 16) + F.lane) = *((const LAS f32x4*)bgs + F.lane);
}

struct DenseSched {
    int nM, nN, nwg, G, c, gap_from, gap, L0, Lend; unsigned lda2, acol2; const char* B; size_t btile;
    __device__ __forceinline__ void init(int M, int N, int G_, int c_, int lda, int acolstride, const void* B_, int ldb) { nM = M / 256; nN = N / 256; nwg = nM * nN; G = G_; c = c_; gap_from = 1 << 30; gap = 0; L0 = 0; Lend = nwg; lda2 = (unsigned)lda * 2u; acol2 = (unsigned)acolstride * 2u; B = (const char*)B_; btile = (size_t)256 * ldb * 2; }
    __device__ __forceinline__ bool next(int i, pg8::Unit& u) const {
        const long L = (long)L0 + (long)i * G + c; if (L >= Lend) return false;
        int wgid = (int)L; { const int q = nwg / 8, r = nwg % 8, xcd = wgid % 8, off = wgid / 8; wgid = (xcd < r ? xcd * (q + 1) : r * (q + 1) + (xcd - r) * q) + off; }
        const int nig = 8 * nN, gid = wgid / nig, fm = gid * 8, gsz = (nM - fm) < 8 ? (nM - fm) : 8;
        u.pm = fm + ((wgid % nig) % gsz); u.pn = (wgid % nig) / gsz; u.pn += (u.pn >= gap_from) ? gap : 0; u.e = 0; return true;
    }
    __device__ __forceinline__ unsigned a_off(const pg8::Unit& u, int r) const { return (unsigned)(u.pm * 256 + r) * lda2 + (unsigned)u.pn * acol2; }
    __device__ __forceinline__ const char* b_ptr(const pg8::Unit& u) const { return B + (size_t)u.pn * btile; }
};
struct MoeSched {
    const LAS int* cnt; const LAS int* tbase; const LAS int* tileExp;
    int nunits, chunk, G, c, esplit; const int* RT; const char* B; const char* Blo; size_t bexp, btile; unsigned arow2;
    __device__ __forceinline__ void init(const LAS int* tables, int G_, int c_, const int* RT_, const void* B_, int ldb, int lda) {
        cnt = tables; tbase = tables + 32; tileExp = tables + 80; G = G_; c = c_; RT = RT_; B = (const char*)B_; Blo = B; esplit = 0; bexp = (size_t)1024 * ldb * 2; btile = (size_t)256 * ldb * 2; arow2 = (unsigned)lda * 2u;
        nunits = tbase[32] * 4; chunk = ((nunits + 7) / 8 + 3) & ~3;
    }
    __device__ __forceinline__ bool next(int i, pg8::Unit& u) const {
        const int w = i * (G / 8) + (c >> 3); if (w >= chunk) return false;
        const int L = (c & 7) * chunk + w; if (L >= nunits) return false;
        u.pm = L >> 2; u.pn = L & 3; u.e = tileExp[u.pm]; return true;
    }
    __device__ __forceinline__ unsigned a_off(const pg8::Unit& u, int r) const {
        if (RT) { const int pos = (u.pm - tbase[u.e]) * 256 + r, c_ = cnt[u.e]; const int pc = pos < c_ ? pos : 0;
            int tok = RT[u.e * NTOK + pc]; tok = pos < c_ ? tok : 0; return (unsigned)tok * arow2; }
        return (unsigned)(u.pm * 256 + r) * arow2;
    }
    __device__ __forceinline__ const char* b_ptr(const pg8::Unit& u) const { return (u.e < esplit ? Blo : B) + (size_t)u.e * bexp + (size_t)u.pn * btile; }
};
__device__ __forceinline__ void build_moe_tables(Frame& F, int layer) {
    LAS int* T = (LAS int*)(F.lds + SCHED_OFF);
    int tid_ = F.tid; asm volatile("" : "+v"(tid_));
    __syncthreads();
    if (tid_ < 64) {
        const int c = tid_ < 32 ? (int)__hip_atomic_load(F.ctl + CW_CNT + 64 * layer + (tid_ & 31), RLX_AGENT) : 0;
        const int nt = (c + 255) >> 8; int incl = nt;
#pragma unroll
        for (int o = 1; o < 32; o <<= 1) { const int up = __shfl_up(incl, o); if (tid_ >= o) incl += up; }
        const int base = incl - nt;
        if (tid_ < 32) { T[tid_] = c; T[32 + tid_] = base; for (int j = 0; j < nt; ++j) T[80 + base + j] = tid_; }
        if (tid_ == 31) T[64] = incl;
    }
    __syncthreads();
}

__device__ __forceinline__ int moe_units_of(int c, int G, int nunits, int chunk) {
    const int sl = c >> 3, x = c & 7, per = G / 8; int U = nunits - x * chunk; U = U < 0 ? 0 : (U > chunk ? chunk : U);
    return sl < U ? (U - sl + per - 1) / per : 0;
}
__device__ __forceinline__ void moe_tail_plan(Frame& F) {
    LAS int* T = (LAS int*)(F.lds + SCHED_OFF);
    if (F.tid == 0) { T[65] = 0; T[66] = 0; }
    __syncthreads();
    if (F.tid < 256) {
        const int nunits = T[64] * 4, chunk = ((nunits + 7) / 8 + 3) & ~3, per = F.G / 8, maxu = (chunk + per - 1) / per, c = (int)blockIdx.x;
        const int sp = F.tid < F.G ? maxu - moe_units_of(F.tid, F.G, nunits, chunk) : 0;
        const int lower = (int)wave_sum(F.tid < c ? (float)sp : 0.f), all = (int)wave_sum((float)sp);
        if (F.lane == 0) { atomicAdd((int*)(T + 65), lower); atomicAdd((int*)(T + 66), all); }
        if (F.tid == c) T[67] = sp;
    }
    __syncthreads();
}

struct EpiStoreBf16 {
    bf16* O; int ldc;
    __device__ __forceinline__ void operator()(const f32x4 (&acc)[2][2][4][2], const pg8::Unit& u, int wr, int wc, int fr, int fq) const {
        const int row0 = u.pm * 256 + wr * 64 + fr, col0 = u.pn * 256 + wc * 32 + 8 * fq;
#pragma unroll
        for (int ai = 0; ai < 2; ++ai)
#pragma unroll
            for (int m = 0; m < 4; ++m) { bf16* rowp = O + (size_t)(row0 + ai * 128 + m * 16) * ldc + col0;
#pragma unroll
                for (int bj = 0; bj < 2; ++bj) { const f32x4 v0 = acc[ai][bj][m][0], v1 = acc[ai][bj][m][1];
                    v4u w; w.x = pk2(v0[0], v0[1]); w.y = pk2(v0[2], v0[3]); w.z = pk2(v1[0], v1[1]); w.w = pk2(v1[2], v1[3]);
                    *(v4u*)(rowp + bj * 128) = w; } }
    }
};
template <bool F32SRC> struct EpiResid {
    const float* X; bf16* O; const float* cf; const float* mul;
    __device__ __forceinline__ void operator()(const f32x4 (&acc)[2][2][4][2], const pg8::Unit& u, int wr, int wc, int fr, int fq) const {
        const int row0 = u.pm * 256 + wr * 64 + fr, col0 = u.pn * 256 + wc * 32 + 8 * fq, b = (u.pm * 256) / SEQ;
        f32x4 c[2][2];
#pragma unroll
        for (int bj = 0; bj < 2; ++bj)
#pragma unroll
            for (int n = 0; n < 2; ++n) { c[bj][n] = *(const f32x4*)(cf + (size_t)b * 6144 + col0 + bj * 128 + 4 * n); if (!F32SRC) c[bj][n] *= *(const f32x4*)(mul + col0 + bj * 128 + 4 * n); }
#pragma unroll
        for (int ai = 0; ai < 2; ++ai)
#pragma unroll
            for (int m = 0; m < 4; ++m) { const size_t ro = (size_t)(row0 + ai * 128 + m * 16) * D + col0;
                f32x4 s[2][2];
                if (F32SRC) {
#pragma unroll
                    for (int bj = 0; bj < 2; ++bj) { s[bj][0] = *(const GAS f32x4*)(X + ro + bj * 128); s[bj][1] = *(const GAS f32x4*)(X + ro + bj * 128 + 4); }
                } else {
#pragma unroll
                    for (int bj = 0; bj < 2; ++bj) { const v4u q = *(const GAS v4u*)(O + ro + bj * 128);
                        s[bj][0].x = bflo(q.x); s[bj][0].y = bfhi(q.x); s[bj][0].z = bflo(q.y); s[bj][0].w = bfhi(q.y); s[bj][1].x = bflo(q.z); s[bj][1].y = bfhi(q.z); s[bj][1].z = bflo(q.w); s[bj][1].w = bfhi(q.w); }
                }
#pragma unroll
                for (int bj = 0; bj < 2; ++bj) { const f32x4 v0 = s[bj][0] + c[bj][0] * acc[ai][bj][m][0], v1 = s[bj][1] + c[bj][1] * acc[ai][bj][m][1];
                    v4u w; w.x = pk2(v0[0], v0[1]); w.y = pk2(v0[2], v0[3]); w.z = pk2(v1[0], v1[1]); w.w = pk2(v1[2], v1[3]);
                    *(v4u*)(O + ro + bj * 128) = w; } }
    }
};
struct EpiSwiglu {
    bf16* O;
    __device__ __forceinline__ void operator()(const f32x4 (&acc)[2][2][4][2], const pg8::Unit& u, int wr, int wc, int fr, int fq) const {
        const int row0 = u.pm * 256 + wr * 64 + fr, col0 = u.pn * 128 + wc * 32 + 8 * fq;
#pragma unroll
        for (int ai = 0; ai < 2; ++ai)
#pragma unroll
            for (int m = 0; m < 4; ++m) { bf16* rowp = O + (size_t)(row0 + ai * 128 + m * 16) * DFF + col0;
                float r[8];
#pragma unroll
                for (int n = 0; n < 2; ++n)
#pragma unroll
                    for (int j = 0; j < 4; ++j) r[4 * n + j] = silu_f(acc[ai][0][m][n][j]) * acc[ai][1][m][n][j];
                v4u w; w.x = pk2(r[0], r[1]); w.y = pk2(r[2], r[3]); w.z = pk2(r[4], r[5]); w.w = pk2(r[6], r[7]);
                *(v4u*)rowp = w; }
    }
};

__device__ __forceinline__ void moe_route(Frame& F, int layer) {
    LAS int* hist = (LAS int*)(F.lds + RT_LDS_OFF);
    LAS int* base = hist + 32;
    LAS int* tinfo = hist + 64;
    LAS float* tg = (LAS float*)(hist + 64 + 512);
    if (F.tid < 32) hist[F.tid] = 0;
    LAS f32x4* R2 = (LAS f32x4*)(F.lds + RING_OFF);
    LAS f32x4* R1 = (LAS f32x4*)(F.lds + R1W_OFF);
    { const f32x4* g2p = (const f32x4*)(F.in[I_R2W] + (size_t)layer * 1024 * 32); const f32x4* g1p = (const f32x4*)(F.in[I_R1W] + (size_t)layer * 1024 * 4);
      f32x4 t2[16], t1[2];
#pragma unroll
      for (int u = 0; u < 16; ++u) t2[u] = g2p[F.tid + 512 * u];
#pragma unroll
      for (int u = 0; u < 2; ++u) t1[u] = g1p[F.tid + 512 * u];
#pragma unroll
      for (int u = 0; u < 16; ++u) { const int i = F.tid + 512 * u, k = i >> 3, c4 = i & 7, ln = (k & 255) >> 2, q = k & 3, j = k >> 8; R2[((j * 4 + q) * 8 + c4) * 64 + (ln ^ (c4 + 8 * (q & 1)))] = t2[u]; }
#pragma unroll
      for (int u = 0; u < 2; ++u) { const int k = F.tid + 512 * u, ln = (k & 255) >> 2, q = k & 3, j = k >> 8; R1[(j * 4 + q) * 64 + ln] = t1[u]; } }
    __syncthreads();
    const float* mod = (const float*)(F.ws + WS_MOD) + (size_t)layer * 2 * 6144;
    bf16* H = (bf16*)(F.ws + WS_H);
    const int tokw = F.vcu * 128 + F.wave * 16, b = (F.vcu * 128) / SEQ;
    const ModVec m = load_mod(F.in[I_NFFN] + layer * D, mod + (size_t)b * 6144 + 4 * 1024, mod + (size_t)b * 6144 + 3 * 1024, F.lane);
    const float b1v = F.lane < 4 ? F.in[I_R1B][layer * 4 + F.lane] : 0.f;
    const bool l4 = (F.lane & 3) == 0 && F.lane < 16, l2q = (F.lane & 1) == 0 && F.lane < 16;
    const float b1q = l4 ? F.in[I_R1B][layer * 4 + (F.lane >> 2)] : 0.f;
    float b2q[4];
#pragma unroll
    for (int g = 0; g < 4; ++g) b2q[g] = l2q ? F.in[I_R2B][layer * 32 + g * 8 + (F.lane >> 1)] : 0.f;
    LAS float* LGS = (LAS float*)(hist + 1024); LAS float* LES = (LAS float*)(hist + 1536); LAS int* GRPS = hist + 2560;
    const bf16* XRB = (const bf16*)(F.ws + WS_XRB);
    v2u xbn[4], xb2[4];
    load_row_bf16(XRB + (size_t)tokw * D, F.lane, xbn); load_row_bf16(XRB + (size_t)(tokw + 1) * D, F.lane, xb2);
    f32x4 r1w[16];
#pragma unroll
    for (int k = 0; k < 16; ++k) r1w[k] = R1[k * 64 + F.lane];
    for (int i = 0; i < 16; ++i) {
        const int t = tokw + i;
        const RowVec x = unpack_row_bf16(xbn);
#pragma unroll
        for (int j = 0; j < 4; ++j) xbn[j] = xb2[j];
        if (i + 2 < 16) load_row_bf16(XRB + (size_t)(t + 2) * D, F.lane, xb2);
        RowVec h = apply_mod(x, row_rstd(x), m);
        store_row_bf16(H + (size_t)t * D, F.lane, h);
        f32x4 l1 = {0.f, 0.f, 0.f, 0.f};
#pragma unroll
        for (int j = 0; j < 4; ++j)
#pragma unroll
            for (int q = 0; q < 4; ++q) l1 += r1w[j * 4 + q] * h.v[j][q];
        float lg[4];
        const float p4[4] = {l1[0], l1[1], l1[2], l1[3]}; const float r4 = multi_sum4(p4, F.lane);
#pragma unroll
        for (int g = 0; g < 4; ++g) lg[g] = rl(r4, 4 * g) + rl(b1v, g);
        const int li = F.wave * 16 + i;
        int grp = 0; float mx = lg[0];
#pragma unroll
        for (int g = 1; g < 4; ++g) if (lg[g] > mx) { mx = lg[g]; grp = g; }
        grp = __builtin_amdgcn_readfirstlane(grp);
        if (l4) LGS[li * 4 + (F.lane >> 2)] = r4 + b1q;
        if (F.lane == 0) GRPS[li] = grp;
        f32x4 a0 = {0.f, 0.f, 0.f, 0.f}, a1 = {0.f, 0.f, 0.f, 0.f};
        { const int c0 = grp * 2;
          const LAS f32x4* wg00 = R2 + c0 * 64 + (F.lane ^ c0), * wg01 = R2 + c0 * 64 + (F.lane ^ (c0 + 8)), * wg10 = R2 + (c0 + 1) * 64 + (F.lane ^ (c0 + 1)), * wg11 = R2 + (c0 + 1) * 64 + (F.lane ^ (c0 + 9));
#pragma unroll
          for (int hb = 0; hb < 2; ++hb) { f32x4 w2[16];
#pragma unroll
              for (int k = 0; k < 8; ++k) { const int jq = hb * 8 + k; w2[2 * k] = ((jq & 1) ? wg01 : wg00)[(jq * 8) * 64]; w2[2 * k + 1] = ((jq & 1) ? wg11 : wg10)[(jq * 8) * 64]; }
              __builtin_amdgcn_sched_barrier(0);
#pragma unroll
              for (int k = 0; k < 8; ++k) { const float hv = h.v[(hb * 8 + k) >> 2][(hb * 8 + k) & 3]; a0 += w2[2 * k] * hv; a1 += w2[2 * k + 1] * hv; }
              __builtin_amdgcn_sched_barrier(0); } }
        { const float p8[8] = {a0[0], a0[1], a0[2], a0[3], a1[0], a1[1], a1[2], a1[3]}; const float r8 = multi_sum8(p8, F.lane);
          const float bs = grp == 0 ? b2q[0] : grp == 1 ? b2q[1] : grp == 2 ? b2q[2] : b2q[3];
          if (l2q) LES[li * 8 + (F.lane >> 1)] = r8 + bs; }
    }
    if (F.lane < 16) { const int li = F.wave * 16 + F.lane; const int grp = GRPS[li];
        const f32x4 lgv = *(const LAS f32x4*)(LGS + li * 4); const float lg[4] = {lgv[0], lgv[1], lgv[2], lgv[3]};
        float mx = lg[0];
#pragma unroll
        for (int g = 1; g < 4; ++g) mx = lg[g] > mx ? lg[g] : mx;
        float se = 0.f;
#pragma unroll
        for (int g = 0; g < 4; ++g) se += __expf(lg[g] - mx);
        const float ptop = 1.0f / se;
        const f32x4 ea = *(const LAS f32x4*)(LES + li * 8), eb = *(const LAS f32x4*)(LES + li * 8 + 4); const float l2[8] = {ea[0], ea[1], ea[2], ea[3], eb[0], eb[1], eb[2], eb[3]};
        int i0 = 0; float v0 = l2[0];
#pragma unroll
        for (int q = 1; q < 8; ++q) if (l2[q] > v0) { v0 = l2[q]; i0 = q; }
        int i1 = (i0 == 0) ? 1 : 0; float v1 = (i0 == 0) ? l2[1] : l2[0];
#pragma unroll
        for (int q = 0; q < 8; ++q) if (q != i0 && l2[q] > v1) { v1 = l2[q]; i1 = q; }
        const float g0 = ptop / (1.0f + __expf(v1 - v0)), g1 = ptop - g0;
        const int e0 = grp * 8 + i0, e1 = grp * 8 + i1;
        tinfo[li * 4 + 0] = e0; tinfo[li * 4 + 1] = e1; tinfo[li * 4 + 2] = atomicAdd((int*)(hist + e0), 1); tinfo[li * 4 + 3] = atomicAdd((int*)(hist + e1), 1);
        tg[li * 2] = g0; tg[li * 2 + 1] = g1;
    }
    __syncthreads();
    if (F.tid < 32) base[F.tid] = (int)__hip_atomic_fetch_add(F.ctl + CW_CNT + 64 * layer + F.tid, (unsigned)hist[F.tid], RLX_AGENT);
    __syncthreads();
    if (F.tid < 128) { const int t = F.vcu * 128 + F.tid; const int e0 = tinfo[F.tid * 4], e1 = tinfo[F.tid * 4 + 1];
        const int p0 = base[e0] + tinfo[F.tid * 4 + 2], p1 = base[e1] + tinfo[F.tid * 4 + 3];
        int* RT = (int*)(F.ws + WS_RT); RT[e0 * NTOK + p0] = t; RT[e1 * NTOK + p1] = t;
        v4u r0; r0.x = e0; r0.y = e1; r0.z = p0; r0.w = p1; v4u r1; r1.x = __builtin_bit_cast(unsigned, tg[F.tid * 2]); r1.y = __builtin_bit_cast(unsigned, tg[F.tid * 2 + 1]); r1.z = 0; r1.w = 0;
        v4u* RO = (v4u*)(F.ws + WS_ROUTE) + (size_t)t * 2; RO[0] = r0; (void)r1;
        { float* GA = (float*)(F.ws + WS_BG); GA[(size_t)t * 2] = tg[F.tid * 2]; GA[(size_t)t * 2 + 1] = tg[F.tid * 2 + 1]; } }
    __syncthreads();
}

struct CombRows { v2u xb[4], ya[4], yb[4]; };
struct CombRecs { v4u rec; float ga, gb; };
__device__ __forceinline__ CombRecs comb_load_recs(Frame& F, int tokw) { CombRecs c; const int t = tokw + (F.lane & 15);
    c.rec = *((const v4u*)(F.ws + WS_ROUTE) + (size_t)t * 2); const float* GA = (const float*)(F.ws + WS_BG); c.ga = GA[(size_t)t * 2]; c.gb = GA[(size_t)t * 2 + 1]; return c; }
__device__ __forceinline__ int rl_i(int v, int l) { return __builtin_amdgcn_readlane(v, l); }
__device__ __forceinline__ void comb_issue(Frame& F, const CombRecs& c, int i, int t, CombRows& r) {
    const LAS int* T = (const LAS int*)(F.lds + SCHED_OFF);
    const int e0 = rl_i((int)c.rec.x, i), e1 = rl_i((int)c.rec.y, i), p0 = rl_i((int)c.rec.z, i), p1 = rl_i((int)c.rec.w, i);
    const size_t rowa = (size_t)T[32 + e0] * 256 + p0, rowb = (size_t)T[32 + e1] * 256 + p1;
    const bf16* Y = (const bf16*)(F.ws + WS_Y);
    const GAS v2u* ya = (const GAS v2u*)(Y + rowa * D) + F.lane; const GAS v2u* yb = (const GAS v2u*)(Y + rowb * D) + F.lane;
    load_row_bf16((const bf16*)(F.ws + WS_XRB) + (size_t)t * D, F.lane, r.xb);
#pragma unroll
    for (int j = 0; j < 4; ++j) { r.ya[j] = ya[64 * j]; r.yb[j] = yb[64 * j]; }
}
__device__ __forceinline__ RowVec comb_finish(const CombRecs& c, int i, const CombRows& r, const f32x4 (&g2)[4]) {
    const float ga = rl(c.ga, i), gb = rl(c.gb, i); RowVec x = unpack_row_bf16(r.xb);
#pragma unroll
    for (int j = 0; j < 4; ++j) { const v2u a = r.ya[j], bq = r.yb[j];
        f32x4 s; s.x = ga * bflo(a.x) + gb * bflo(bq.x); s.y = ga * bfhi(a.x) + gb * bfhi(bq.x); s.z = ga * bflo(a.y) + gb * bflo(bq.y); s.w = ga * bfhi(a.y) + gb * bfhi(bq.y);
        x.v[j] += g2[j] * s; }
    return x;
}

__device__ __forceinline__ void attn_phase(Frame& F, const int u_first, const int u_stride) {
    LAS bf16* KS = (LAS bf16*)(F.lds + RING_OFF);
    LAS bf16* VT = (LAS bf16*)(F.lds + RING_OFF + 36864);
    LAS float* BT = (LAS float*)(F.lds + RING_OFF + 36864 + 33280);
    const bf16* PROJ = (const bf16*)(F.ws + WS_PROJ); bf16* OAB = (bf16*)(F.ws + WS_OAB);
    const int lane = F.lane, lc = lane & 31, lh = lane >> 5;
    for (int unit = u_first; unit < 512; unit += u_stride) {
        const int b = unit >> 8, kvh = (unit >> 7) & 1, qb = unit & 127, t0 = qb * 128;
        __syncthreads();
        for (int i = F.tid; i < 4 * 192; i += 512) { const int hq = i / 192, x = i - hq * 192, dist = 159 - x; float v = 0.f;
            if (dist >= 0 && dist < 128) { int bk = dist; if (dist >= 16) { bk = 16 + (int)(logf((float)dist / 16.0f) / 2.0794415416798357f * 16.0f); bk = bk > 31 ? 31 : bk; }
                v = F.in[I_RELB][bk * 8 + kvh * 4 + hq] * 1.4426950408889634f; }
            BT[i] = v; }
#pragma unroll
        for (int cc = 0; cc < 4; ++cc) { const int ch = F.tid + 512 * cc, key = ch >> 3, part = ch & 7, tl = t0 - 128 + key;
            v4u kv = {0u, 0u, 0u, 0u}, vv = {0u, 0u, 0u, 0u};
            if (tl >= 0) { const bf16* rp = PROJ + (size_t)(b * SEQ + tl) * PIN; kv = *(const v4u*)(rp + PC_KB + kvh * 64 + part * 8); vv = *(const v4u*)(rp + PC_VB + kvh * 64 + part * 8); }
            *(LAS v4u*)(KS + key * 72 + part * 8) = kv;
            const unsigned w[4] = {vv.x, vv.y, vv.z, vv.w};
#pragma unroll
            for (int q = 0; q < 4; ++q) { VT[(part * 8 + 2 * q) * 260 + key] = (bf16)(w[q] & 0xffffu); VT[(part * 8 + 2 * q + 1) * 260 + key] = (bf16)(w[q] >> 16); } }
        __syncthreads();
#pragma unroll 1
        for (int tt = 0; tt < 2; ++tt) {
            const int task = F.wave * 2 + tt, hq = task >> 2, qt = task & 3, qh = kvh * 4 + hq;
            const int qi = 32 * qt + lc;
            const bf16* qrow = PROJ + (size_t)(b * SEQ + t0 + qi) * PIN + PC_QB + qh * 64 + 8 * lh;
            bf16x8 qf[4];
#pragma unroll
            for (int s = 0; s < 4; ++s) qf[s] = *(const bf16x8*)(qrow + 16 * s);
            f32x16 sc[5];
#pragma unroll
            for (int kt = 0; kt < 5; ++kt) {
#pragma unroll
                for (int r = 0; r < 16; ++r) sc[kt][r] = 0.f;
                const LAS bf16* kp = KS + (32 * (qt + kt) + lc) * 72 + 8 * lh;
#pragma unroll
                for (int s = 0; s < 4; ++s) { const bf16x8 kf = *(const LAS bf16x8*)(kp + 16 * s); sc[kt] = __builtin_amdgcn_mfma_f32_32x32x16_bf16(kf, qf[s], sc[kt], 0, 0, 0); }
            }
            const float sink2 = F.in[I_SINKS][qh] * 1.4426950408889634f;
            const LAS float* bp = BT + hq * 192 + (4 * lh - lc + 31);
            const int m_lo = lc + 1 - 4 * lh, m_hi = lc - 4 * lh;
            float mx = sink2;
#pragma unroll
            for (int kt = 0; kt < 5; ++kt) {
                const bool dead = (t0 == 0) && (qt + kt < 4);
#pragma unroll
                for (int r = 0; r < 16; ++r) { const int cr = (r & 3) + 8 * (r >> 2);
                    float v = sc[kt][r] * (0.125f * 1.4426950408889634f) + bp[32 * kt + cr];
                    if (kt == 0) v = (cr >= m_lo) ? v : -1e30f;
                    if (kt == 4) v = (cr <= m_hi) ? v : -1e30f;
                    if (dead) v = -1e30f;
                    sc[kt][r] = v; mx = fmaxf(mx, v); } }
            mx = fmaxf(mx, __shfl_xor(mx, 32));
            float den = 0.f;
#pragma unroll
            for (int kt = 0; kt < 5; ++kt)
#pragma unroll
                for (int r = 0; r < 16; ++r) { const float p = __builtin_amdgcn_exp2f(sc[kt][r] - mx); sc[kt][r] = p; den += p; }
            den += __shfl_xor(den, 32);
            den += __builtin_amdgcn_exp2f(sink2 - mx);
            const float inv = 1.0f / den;
            f32x16 oa[2];
#pragma unroll
            for (int dt = 0; dt < 2; ++dt)
#pragma unroll
                for (int r = 0; r < 16; ++r) oa[dt][r] = 0.f;
#pragma unroll
            for (int kt = 0; kt < 5; ++kt)
#pragma unroll
                for (int s2 = 0; s2 < 2; ++s2) {
                    v4u pw; pw.x = pk2(sc[kt][8 * s2 + 0], sc[kt][8 * s2 + 1]); pw.y = pk2(sc[kt][8 * s2 + 2], sc[kt][8 * s2 + 3]); pw.z = pk2(sc[kt][8 * s2 + 4], sc[kt][8 * s2 + 5]); pw.w = pk2(sc[kt][8 * s2 + 6], sc[kt][8 * s2 + 7]);
                    const bf16x8 pf = __builtin_bit_cast(bf16x8, pw);
#pragma unroll
                    for (int dt = 0; dt < 2; ++dt) { const LAS bf16* vp = VT + (32 * dt + lc) * 260 + 32 * (qt + kt) + 16 * s2 + 4 * lh;
                        const v2u va = *(const LAS v2u*)vp, vb = *(const LAS v2u*)(vp + 8);
                        v4u vw; vw.x = va.x; vw.y = va.y; vw.z = vb.x; vw.w = vb.y;
                        oa[dt] = __builtin_amdgcn_mfma_f32_32x32x16_bf16(__builtin_bit_cast(bf16x8, vw), pf, oa[dt], 0, 0, 0); }
                }
            bf16* orow = OAB + (size_t)(b * SEQ + t0 + qi) * D + 512 + qh * 64 + 4 * lh;
#pragma unroll
            for (int dt = 0; dt < 2; ++dt)
#pragma unroll
                for (int rg = 0; rg < 4; ++rg) { v2u o; o.x = pk2(oa[dt][4 * rg] * inv, oa[dt][4 * rg + 1] * inv); o.y = pk2(oa[dt][4 * rg + 2] * inv, oa[dt][4 * rg + 3] * inv);
                    *(v2u*)(orow + 32 * dt + 8 * rg) = o; }
        }
    }
    __syncthreads();
}


constexpr int DN_ST = 72;

__device__ __forceinline__ bf16x8 pack8(const f32x16& x, int s) { v4u p; p.x = pk2(x[8 * s], x[8 * s + 1]); p.y = pk2(x[8 * s + 2], x[8 * s + 3]); p.z = pk2(x[8 * s + 4], x[8 * s + 5]); p.w = pk2(x[8 * s + 6], x[8 * s + 7]); return __builtin_bit_cast(bf16x8, p); }
__device__ __forceinline__ f32x16 dn_tile(const LAS bf16* A, int ra, const LAS bf16* B, int rb, int lc, int lh) {
    f32x16 acc;
#pragma unroll
    for (int r = 0; r < 16; ++r) acc[r] = 0.f;
#pragma unroll
    for (int s = 0; s < 4; ++s) { const bf16x8 a = *(const LAS bf16x8*)(A + (ra + lc) * DN_ST + 16 * s + 8 * lh), b = *(const LAS bf16x8*)(B + (rb + lc) * DN_ST + 16 * s + 8 * lh);
        acc = __builtin_amdgcn_mfma_f32_32x32x16_bf16(a, b, acc, 0, 0, 0); }
    return acc;
}
__device__ __forceinline__ void dn_prep(Frame& F) {
    LAS bf16* Qs = (LAS bf16*)(F.lds + RING_OFF);
    LAS bf16* Ks = Qs + 64 * DN_ST;
    LAS bf16* KBs = Ks + 64 * DN_ST;
    LAS bf16* Vs = KBs + 64 * DN_ST;
    LAS bf16* KDT = Vs + 64 * DN_ST;
    LAS bf16* AQK = KDT + 64 * DN_ST;
    LAS bf16* UT = AQK + 64 * DN_ST;
    LAS bf16* WT = UT + 64 * DN_ST;
    LAS bf16* LNO = WT + 64 * DN_ST;
    LAS float* LD = (LAS float*)(LNO + 64 * DN_ST);
    LAS bf16* TDZ = (LAS bf16*)(LD + 64 * 16);
    LAS float* GB = (LAS float*)(TDZ + 64 * 24);
    const bf16* PROJ = (const bf16*)(F.ws + WS_PROJ); const float* BG = (const float*)(F.ws + WS_BG);
    const int tid = F.tid, lane = F.lane, lc = lane & 31, lh = lane >> 5, wave = F.wave;
    LAS float* CW = GB + 256;
    { f32x4 tc[3];
#pragma unroll
      for (int u = 0; u < 3; ++u) tc[u] = *((const f32x4*)F.in[I_CONVW] + tid + 512 * u);
#pragma unroll
      for (int u = 0; u < 3; ++u) *((LAS f32x4*)CW + tid + 512 * u) = tc[u]; }
    LAS v4u* RAW = (LAS v4u*)(F.lds + R1W_OFF);
    constexpr int RAW_CH = 67 * 24;
#define DN_RAW_SRC(i_, b_, h_, n_) ({ const int r_ = (i_) / 24, c_ = (i_) - r_ * 24; const int tl_ = (n_) * 64 - 3 + r_; \
        tl_ >= 0 ? (const v4u*)(PROJ + ((size_t)(b_) * SEQ + tl_) * PIN + (c_ < 8 ? PC_QA : c_ < 16 ? PC_KA : PC_VA) + (h_) * 64 + (c_ & 7) * 8) : (const v4u*)nullptr; })
    { const int u0 = F.vcu, b = u0 >> 11, h = (u0 >> 8) & 7, n = u0 & 255;
      for (int i = tid; i < RAW_CH; i += 512) { const v4u* sp = DN_RAW_SRC(i, b, h, n); v4u z = {0u, 0u, 0u, 0u}; if (sp) z = *sp; RAW[i] = z; }
      if (wave == 0) { const size_t row0 = (size_t)b * SEQ + (size_t)n * 64; float c = BG[(row0 + lane) * 16 + 8 + h];
#pragma unroll
          for (int o = 1; o < 64; o <<= 1) { const float up = __shfl_up(c, o); if (lane >= o) c += up; }
          GB[lane] = c; GB[64 + lane] = BG[(row0 + lane) * 16 + h]; } }
    int par = 0;
    for (int unit = F.vcu; unit < 4096; unit += F.G, par ^= 1) {
        const int b = unit >> 11, h = (unit >> 8) & 7, n = unit & 255;
        LAS float* gcs = GB + par * 128; LAS float* bts = gcs + 64;
        const int un = unit + F.G; const bool more = un < 4096; const int bn = un >> 11, hn = (un >> 8) & 7, nn = un & 255;
        LDS_BAR();
        { const int t = tid >> 3, cs = tid & 7;
          float q[8], k[8], v[8];
#pragma unroll
          for (int e = 0; e < 8; ++e) { q[e] = 0.f; k[e] = 0.f; v[e] = 0.f; }
#pragma unroll
          for (int j = 0; j < 4; ++j) { { const LAS v4u* rp = RAW + (t + j) * 24 + cs;
                const v4u wq = rp[0], wk = rp[8], wv = rp[16];
                const LAS float* cw = CW + j * 1536 + h * 64 + cs * 8;
                const unsigned uq[4] = {wq.x, wq.y, wq.z, wq.w}, uk[4] = {wk.x, wk.y, wk.z, wk.w}, uv[4] = {wv.x, wv.y, wv.z, wv.w};
#pragma unroll
                for (int e = 0; e < 4; ++e) { q[2 * e] += cw[2 * e] * bflo(uq[e]); q[2 * e + 1] += cw[2 * e + 1] * bfhi(uq[e]);
                    k[2 * e] += cw[512 + 2 * e] * bflo(uk[e]); k[2 * e + 1] += cw[512 + 2 * e + 1] * bfhi(uk[e]);
                    v[2 * e] += cw[1024 + 2 * e] * bflo(uv[e]); v[2 * e + 1] += cw[1024 + 2 * e + 1] * bfhi(uv[e]); } } }
          float sq = 0.f, sk = 0.f;
#pragma unroll
          for (int e = 0; e < 8; ++e) { q[e] = silu_f(q[e]); k[e] = silu_f(k[e]); v[e] = silu_f(v[e]); sq += q[e] * q[e]; sk += k[e] * k[e]; }
          sq = oct_sum(sq); sk = oct_sum(sk);
          const float rq = 0.125f / sqrtf(sq + EPS), rk = 1.0f / sqrtf(sk + EPS), bt = bts[t], kd = __expf(gcs[63] - gcs[t]);
          v4u oq, ok, ob, ov;
          oq.x = pk2(q[0] * rq, q[1] * rq); oq.y = pk2(q[2] * rq, q[3] * rq); oq.z = pk2(q[4] * rq, q[5] * rq); oq.w = pk2(q[6] * rq, q[7] * rq);
#pragma unroll
          for (int e = 0; e < 8; ++e) k[e] *= rk;
          ok.x = pk2(k[0], k[1]); ok.y = pk2(k[2], k[3]); ok.z = pk2(k[4], k[5]); ok.w = pk2(k[6], k[7]);
          ob.x = pk2(k[0] * bt, k[1] * bt); ob.y = pk2(k[2] * bt, k[3] * bt); ob.z = pk2(k[4] * bt, k[5] * bt); ob.w = pk2(k[6] * bt, k[7] * bt);
          ov.x = pk2(v[0], v[1]); ov.y = pk2(v[2], v[3]); ov.z = pk2(v[4], v[5]); ov.w = pk2(v[6], v[7]);
          *(LAS v4u*)(Qs + t * DN_ST + cs * 8) = oq; *(LAS v4u*)(Ks + t * DN_ST + cs * 8) = ok; *(LAS v4u*)(KBs + t * DN_ST + cs * 8) = ob; *(LAS v4u*)(Vs + t * DN_ST + cs * 8) = ov;
#pragma unroll
          for (int e = 0; e < 8; ++e) KDT[(cs * 8 + e) * DN_ST + t] = (bf16)f2bf(k[e] * kd); }
        LDS_BAR();
        v4u pf[7]; float pg = 0.f, pb = 0.f;
        if (wave >= 4 && more) {
#pragma unroll
            for (int k7 = 0; k7 < 7; ++k7) { const int i = (tid - 256) + 256 * k7; pf[k7] = (v4u){0u, 0u, 0u, 0u}; if (i < RAW_CH) { const v4u* sp = DN_RAW_SRC(i, bn, hn, nn); if (sp) pf[k7] = *sp; } }
            if (wave == 4) { const size_t rn = (size_t)bn * SEQ + (size_t)nn * 64; pg = BG[(rn + lane) * 16 + 8 + hn]; pb = BG[(rn + lane) * 16 + hn]; }
        }
        { const int it = (wave >> 1) & 1, jt = wave & 1; const bool qk = wave >= 4;
          f32x16 acc;
#pragma unroll
          for (int r = 0; r < 16; ++r) acc[r] = 0.f;
          if (it >= jt) acc = dn_tile(qk ? Qs : KBs, 32 * it, Ks, 32 * jt, lc, lh);
          const int j = 32 * jt + lc; const float gj = gcs[j];
          LAS float* ldspare = LD + 64 * 16 + 0;
          f32x4 gi4[4];
#pragma unroll
          for (int q = 0; q < 4; ++q) gi4[q] = *(const LAS f32x4*)(gcs + 32 * it + 8 * q + 4 * lh);
          __builtin_amdgcn_sched_barrier(0);
          if (qk) {
#pragma unroll
              for (int r = 0; r < 16; ++r) { const int i = 32 * it + (r & 3) + 8 * (r >> 2) + 4 * lh;
                  const float val = (i >= j) ? acc[r] * __expf(gi4[r >> 2][r & 3] - gj) : 0.f; AQK[i * DN_ST + j] = (bf16)f2bf(val); }
          } else {
#pragma unroll
              for (int r = 0; r < 16; ++r) { const int i = 32 * it + (r & 3) + 8 * (r >> 2) + 4 * lh;
                  const float val = (i > j) ? acc[r] * __expf(gi4[r >> 2][r & 3] - gj) : 0.f; const bool diag = (i >> 4) == (j >> 4);
                  LNO[i * DN_ST + j] = (bf16)f2bf(diag ? 0.f : -val);
                  LAS float* dp = diag ? LD + i * 16 + (j & 15) : ldspare + lane; *dp = val; } } }
        LDS_BAR();
        if (wave == 0) { const int bb = lane >> 4, c = lane & 15; float tcol[16];
#pragma unroll
            for (int i = 0; i < 16; ++i) { float v = (i == c) ? 1.f : 0.f;
#pragma unroll
                for (int j4 = 0; j4 < (i + 3) / 4; ++j4) { const f32x4 a = *(const LAS f32x4*)(LD + (16 * bb + i) * 16 + 4 * j4);
#pragma unroll
                    for (int e = 0; e < 4; ++e) if (4 * j4 + e < i) v -= a[e] * tcol[4 * j4 + e]; }
                tcol[i] = v; TDZ[(16 * bb + i) * 24 + c] = (bf16)f2bf(v); } }
        LDS_BAR();
        if (wave < 4) {
            const int ct = wave, cc = 32 * (ct & 1) + lc; const bool isw = ct >= 2;
            f32x16 acc[2];
            {
              const LAS bf16* src = (isw ? Ks : Vs) + cc; f32x4 b4[2][4], g4[2][4]; unsigned e[2][16];
#pragma unroll
              for (int rt = 0; rt < 2; ++rt)
#pragma unroll
                  for (int q = 0; q < 4; ++q) { b4[rt][q] = *(const LAS f32x4*)(bts + 32 * rt + 8 * q + 4 * lh); g4[rt][q] = *(const LAS f32x4*)(gcs + 32 * rt + 8 * q + 4 * lh); }
#pragma unroll
              for (int rt = 0; rt < 2; ++rt)
#pragma unroll
                  for (int r = 0; r < 16; ++r) { const int t = 32 * rt + (r & 3) + 8 * (r >> 2) + 4 * lh; e[rt][r] = src[t * DN_ST]; }
              __builtin_amdgcn_sched_barrier(0);
#pragma unroll
              for (int rt = 0; rt < 2; ++rt)
#pragma unroll
                  for (int r = 0; r < 16; ++r) { const float f = b4[rt][r >> 2][r & 3] * (isw ? __expf(g4[rt][r >> 2][r & 3]) : 1.0f); acc[rt][r] = bf2f(e[rt][r]) * f; } }
#define DN_AFRAG(arr, stride, row, kb) ({ const LAS bf16* p_ = (arr) + (row) * (stride) + 16 * (kb) + 4 * lh; const v2u lo_ = *(const LAS v2u*)p_, hi_ = *(const LAS v2u*)(p_ + 8); v4u w_; w_.x = lo_.x; w_.y = lo_.y; w_.z = hi_.x; w_.w = hi_.y; __builtin_bit_cast(bf16x8, w_); })
            f32x16 X[4];
#pragma unroll
            for (int bb = 0; bb < 4; ++bb) { const int rt = bb >> 1, odd = bb & 1;
                bf16x8 ta = DN_AFRAG(TDZ, 24, 32 * rt + lc, 0);
                if ((lc >> 4) != odd) ta = (bf16x8){0, 0, 0, 0, 0, 0, 0, 0};
                f32x16 z;
#pragma unroll
                for (int r = 0; r < 16; ++r) z[r] = 0.f;
                z = __builtin_amdgcn_mfma_f32_32x32x16_bf16(ta, pack8(acc[rt], odd), z, 0, 0, 0);
                X[bb] = z;
                const bf16x8 xb = pack8(z, odd);
                if (bb == 0) { acc[0] = __builtin_amdgcn_mfma_f32_32x32x16_bf16(DN_AFRAG(LNO, DN_ST, lc, 0), xb, acc[0], 0, 0, 0); acc[1] = __builtin_amdgcn_mfma_f32_32x32x16_bf16(DN_AFRAG(LNO, DN_ST, 32 + lc, 0), xb, acc[1], 0, 0, 0); }
                if (bb == 1) { acc[1] = __builtin_amdgcn_mfma_f32_32x32x16_bf16(DN_AFRAG(LNO, DN_ST, 32 + lc, 1), xb, acc[1], 0, 0, 0); }
                if (bb == 2) { acc[1] = __builtin_amdgcn_mfma_f32_32x32x16_bf16(DN_AFRAG(LNO, DN_ST, 32 + lc, 2), xb, acc[1], 0, 0, 0); }
            }
#undef DN_AFRAG
            LAS bf16* dst = (isw ? WT : UT) + cc * DN_ST;
#pragma unroll
            for (int bb = 0; bb < 4; ++bb)
#pragma unroll
                for (int g = 0; g < 2; ++g) { const int r0 = 8 * (bb & 1) + 4 * g; v2u o; o.x = pk2(X[bb][r0], X[bb][r0 + 1]); o.y = pk2(X[bb][r0 + 2], X[bb][r0 + 3]);
                    *(LAS v2u*)(dst + 16 * bb + 8 * g + 4 * lh) = o; }
        } else if (more) {
#pragma unroll
            for (int k7 = 0; k7 < 7; ++k7) { const int i = (tid - 256) + 256 * k7; if (i < RAW_CH) RAW[i] = pf[k7]; }
            if (wave == 4) { float c = pg;
#pragma unroll
                for (int o = 1; o < 64; o <<= 1) { const float up = __shfl_up(c, o); if (lane >= o) c += up; }
                GB[(par ^ 1) * 128 + lane] = c; GB[(par ^ 1) * 128 + 64 + lane] = pb; }
        }
        LDS_BAR();
        { bf16* MT = (bf16*)((unsigned char*)F.out + OUT_DN_MT) + (size_t)unit * 4096; bf16* QPT = (bf16*)((unsigned char*)F.out + OUT_DN_QPT) + (size_t)unit * 4096;
          bf16* BM = (bf16*)(F.ws + WS_DN_BM) + (size_t)unit * 4096; bf16* O0T = (bf16*)(F.ws + WS_DN_O0T) + (size_t)unit * 4096;
#pragma unroll 1
          for (int tt = 0; tt < 2; ++tt) { const int task = wave * 2 + tt, p = task >> 2, ta = (task >> 1) & 1, tb = task & 1;
              if (p == 0) {
                  f32x16 acc = dn_tile(WT, 32 * ta, KDT, 32 * tb, lc, lh);
#pragma unroll
                  for (int r = 0; r < 16; ++r) acc[r] = -acc[r];
#pragma unroll
                  for (int s2 = 0; s2 < 2; ++s2) *(bf16x8*)(MT + ((((tb * 2 + ta) * 2 + s2) * 64 + lane) * 8)) = pack8(acc, s2);
              } else if (p == 1) {
                  const f32x16 acc = dn_tile(KDT, 32 * ta, UT, 32 * tb, lc, lh);
#pragma unroll
                  for (int s2 = 0; s2 < 2; ++s2) *(bf16x8*)(BM + ((((tb * 2 + ta) * 2 + s2) * 64 + lane) * 8)) = pack8(acc, s2);
              } else if (p == 2) {
                  f32x16 acc = dn_tile(WT, 32 * ta, AQK, 32 * tb, lc, lh);
                  const int i = 32 * tb + lc; const float eg = __expf(gcs[i]);
#pragma unroll
                  for (int r = 0; r < 16; ++r) { const int a = 32 * ta + (r & 3) + 8 * (r >> 2) + 4 * lh; acc[r] = bf2f(Qs[i * DN_ST + a]) * eg - acc[r]; }
#pragma unroll
                  for (int s2 = 0; s2 < 2; ++s2) *(bf16x8*)(QPT + ((((tb * 2 + ta) * 2 + s2) * 64 + lane) * 8)) = pack8(acc, s2);
              } else {
                  const f32x16 acc = dn_tile(UT, 32 * ta, AQK, 32 * tb, lc, lh);
#pragma unroll
                  for (int s2 = 0; s2 < 2; ++s2) *(bf16x8*)(O0T + ((((tb * 2 + ta) * 2 + s2) * 64 + lane) * 8)) = pack8(acc, s2);
              } }
          if (tid == 0) ((float*)(F.ws + WS_DN_GT))[unit] = __expf(gcs[63]); }
    }
#undef DN_RAW_SRC
    __syncthreads();
}
template <int r>
__device__ __forceinline__ void dn_scan_wave(Frame& F) {
    const int bx = (int)blockIdx.x, w = (bx & 7) * 4 + (bx >> 3), bh = w >> 1, ct = w & 1, lane = F.lane;
    const bf16x8* MT = (const bf16x8*)((const unsigned char*)F.out + OUT_DN_MT); const bf16x8* BM = (const bf16x8*)(F.ws + WS_DN_BM); bf16x8* SS = (bf16x8*)(F.ws + WS_DN_S);
    const float* GT = (const float*)(F.ws + WS_DN_GT);
    LAS bf16x8* MB = (LAS bf16x8*)(F.lds + RING_OFF);
    volatile LAS int* FL = (volatile LAS int*)(F.lds + LDSCTL_OFF + 64);
    f32x16 S;
#pragma unroll
    for (int q = 0; q < 16; ++q) S[q] = 0.f;
    v4u mA[4], bA[2], mB[4], bB[2], mC[4], bC[2], mD[4], bD[2], mE[4], bE[2], mG[4], bG[2]; float gA, gB, gC, gD, gE, gG;
#define DN_SLOAD(m, bm, gt, u) do { const size_t ub = (size_t)(u) * 512; const bf16x8* pm_ = MT + ub + (r * 4) * 64 + lane; const bf16x8* pb_ = BM + ub + ((ct * 2 + r) * 2) * 64 + lane; const float* pg_ = GT + (u); \
        asm volatile("global_load_dwordx4 %0, %1, off" : "=v"(m[0]) : "v"(pm_) : "memory"); asm volatile("global_load_dwordx4 %0, %1, off offset:1024" : "=v"(m[1]) : "v"(pm_) : "memory"); \
        asm volatile("global_load_dwordx4 %0, %1, off offset:2048" : "=v"(m[2]) : "v"(pm_) : "memory"); asm volatile("global_load_dwordx4 %0, %1, off offset:3072" : "=v"(m[3]) : "v"(pm_) : "memory"); \
        asm volatile("global_load_dwordx4 %0, %1, off" : "=v"(bm[0]) : "v"(pb_) : "memory"); asm volatile("global_load_dwordx4 %0, %1, off offset:1024" : "=v"(bm[1]) : "v"(pb_) : "memory"); \
        asm volatile("global_load_dword %0, %1, off" : "=v"(gt) : "v"(pg_) : "memory"); } while (0)
#define DN_WAIT(m, bm, gt, CNT) asm volatile("s_waitcnt vmcnt(" #CNT ")" : "+v"(m[0]), "+v"(m[1]), "+v"(m[2]), "+v"(m[3]), "+v"(bm[0]), "+v"(bm[1]), "+v"(gt) :: "memory")
#define DN_STEP(cm, cb, cg, unit, n, CNT) do { \
        bf16x8 own[2]; own[0] = pack8(S, 0); own[1] = pack8(S, 1); \
        LAS bf16x8* mb = MB + ((n) & 1) * 256; \
        mb[(r * 2 + 0) * 64 + lane] = own[0]; mb[(r * 2 + 1) * 64 + lane] = own[1]; \
        asm volatile("s_waitcnt lgkmcnt(0)" ::: "memory"); \
        if (lane == 0) FL[r] = (n) + 1; \
        DN_WAIT(cm, cb, cg, CNT); \
        SS[(size_t)(unit) * 512 + (ct * 4 + r * 2 + 0) * 64 + lane] = own[0]; SS[(size_t)(unit) * 512 + (ct * 4 + r * 2 + 1) * 64 + lane] = own[1]; \
        f32x16 A; \
        { const v4u b0 = cb[0], b1 = cb[1]; const unsigned u0[8] = {b0.x, b0.y, b0.z, b0.w, b1.x, b1.y, b1.z, b1.w}; \
          _Pragma("unroll") for (int e = 0; e < 8; ++e) { A[2 * e] = cg * S[2 * e] + bflo(u0[e]); A[2 * e + 1] = cg * S[2 * e + 1] + bfhi(u0[e]); } } \
        while (FL[1 - r] < (n) + 1) { } \
        asm volatile("" ::: "memory"); \
        bf16x8 oth[2]; oth[0] = mb[((1 - r) * 2 + 0) * 64 + lane]; oth[1] = mb[((1 - r) * 2 + 1) * 64 + lane]; \
          \
        _Pragma("unroll") for (int s2 = 0; s2 < 2; ++s2) { A = __builtin_amdgcn_mfma_f32_32x32x16_bf16(__builtin_bit_cast(bf16x8, cm[r * 2 + s2]), own[s2], A, 0, 0, 0); A = __builtin_amdgcn_mfma_f32_32x32x16_bf16(__builtin_bit_cast(bf16x8, cm[(1 - r) * 2 + s2]), oth[s2], A, 0, 0, 0); } \
        S = A; } while (0)
    const int u0 = bh * 256;
    DN_SLOAD(mA, bA, gA, u0); DN_SLOAD(mB, bB, gB, u0 + 1); DN_SLOAD(mC, bC, gC, u0 + 2); DN_SLOAD(mD, bD, gD, u0 + 3); DN_SLOAD(mE, bE, gE, u0 + 4); DN_SLOAD(mG, bG, gG, u0 + 5);
    DN_WAIT(mA, bA, gA, 0); DN_WAIT(mB, bB, gB, 0); DN_WAIT(mC, bC, gC, 0); DN_WAIT(mD, bD, gD, 0); DN_WAIT(mE, bE, gE, 0); DN_WAIT(mG, bG, gG, 0);
#pragma unroll 1
    for (int n = 0; n < 246; n += 6) {
        DN_STEP(mA, bA, gA, u0 + n, n, 45);         DN_SLOAD(mA, bA, gA, u0 + n + 6);
        DN_STEP(mB, bB, gB, u0 + n + 1, n + 1, 45); DN_SLOAD(mB, bB, gB, u0 + n + 7);
        DN_STEP(mC, bC, gC, u0 + n + 2, n + 2, 45); DN_SLOAD(mC, bC, gC, u0 + n + 8);
        DN_STEP(mD, bD, gD, u0 + n + 3, n + 3, 45); DN_SLOAD(mD, bD, gD, u0 + n + 9);
        DN_STEP(mE, bE, gE, u0 + n + 4, n + 4, 45); DN_SLOAD(mE, bE, gE, u0 + n + 10);
        DN_STEP(mG, bG, gG, u0 + n + 5, n + 5, 45); DN_SLOAD(mG, bG, gG, u0 + n + 11);
    }
    DN_STEP(mA, bA, gA, u0 + 246, 246, 0); DN_SLOAD(mA, bA, gA, u0 + 252); DN_STEP(mB, bB, gB, u0 + 247, 247, 0); DN_SLOAD(mB, bB, gB, u0 + 253);
    DN_STEP(mC, bC, gC, u0 + 248, 248, 0); DN_SLOAD(mC, bC, gC, u0 + 254); DN_STEP(mD, bD, gD, u0 + 249, 249, 0); DN_SLOAD(mD, bD, gD, u0 + 255);
    DN_STEP(mE, bE, gE, u0 + 250, 250, 0); DN_STEP(mG, bG, gG, u0 + 251, 251, 0);
    DN_STEP(mA, bA, gA, u0 + 252, 252, 0); DN_STEP(mB, bB, gB, u0 + 253, 253, 0); DN_STEP(mC, bC, gC, u0 + 254, 254, 0); DN_STEP(mD, bD, gD, u0 + 255, 255, 0);
#undef DN_WAIT
#undef DN_SLOAD
#undef DN_STEP
}
__device__ __forceinline__ void dn_scan(Frame& F) {
    if ((int)blockIdx.x >= 32) return;
    if (F.wave == 0) dn_scan_wave<0>(F); else if (F.wave == 1) dn_scan_wave<1>(F);
}
__device__ __forceinline__ void dn_output(Frame& F) {
    const bf16x8* QPT = (const bf16x8*)((const unsigned char*)F.out + OUT_DN_QPT); const bf16x8* O0T = (const bf16x8*)(F.ws + WS_DN_O0T); const bf16x8* SS = (const bf16x8*)(F.ws + WS_DN_S);
    const bf16* PROJ = (const bf16*)(F.ws + WS_PROJ); bf16* OAB = (bf16*)(F.ws + WS_OAB);
    const int lane = F.lane, lc = lane & 31, lh = lane >> 5; int nbad = 0; (void)nbad;
    f32x4 oww[2][4];
#pragma unroll
    for (int ct = 0; ct < 2; ++ct)
#pragma unroll
        for (int rg = 0; rg < 4; ++rg) oww[ct][rg] = *(const f32x4*)(F.in[I_ONORM] + 32 * ct + 8 * rg + 4 * lh);
    for (int task = F.vcu * NWAVES + F.wave; task < 8192; task += F.G * NWAVES) {
        const int unit = task >> 1, it = task & 1, b = unit >> 11, h = (unit >> 8) & 7, n = unit & 255;
        const size_t ub = (size_t)unit * 512;
        bf16x8 cO[4], cS[8], cQ[4]; v2u zq[2][4];
        const size_t row = (size_t)b * SEQ + (size_t)n * 64 + it * 32 + lc;
#pragma unroll
        for (int f = 0; f < 4; ++f) { cO[f] = O0T[ub + (it * 4 + f) * 64 + lane]; cQ[f] = QPT[ub + (it * 4 + f) * 64 + lane]; }
#pragma unroll
        for (int f = 0; f < 8; ++f) cS[f] = SS[ub + f * 64 + lane];
#pragma unroll
        for (int ct = 0; ct < 2; ++ct)
#pragma unroll
            for (int rg = 0; rg < 4; ++rg) zq[ct][rg] = *(const v2u*)(PROJ + row * PIN + PC_ZA + h * 64 + 32 * ct + 8 * rg + 4 * lh);
        __builtin_amdgcn_sched_barrier(0);
        f32x16 o[2];
#pragma unroll
        for (int ct = 0; ct < 2; ++ct) {
            const v4u c0 = __builtin_bit_cast(v4u, cO[ct * 2 + 0]), c1 = __builtin_bit_cast(v4u, cO[ct * 2 + 1]);
            const unsigned u[8] = {c0.x, c0.y, c0.z, c0.w, c1.x, c1.y, c1.z, c1.w};
#pragma unroll
            for (int e = 0; e < 8; ++e) { o[ct][2 * e] = bflo(u[e]); o[ct][2 * e + 1] = bfhi(u[e]); }
#pragma unroll
            for (int at = 0; at < 2; ++at)
#pragma unroll
                for (int s2 = 0; s2 < 2; ++s2) o[ct] = __builtin_amdgcn_mfma_f32_32x32x16_bf16(cS[ct * 4 + at * 2 + s2], cQ[at * 2 + s2], o[ct], 0, 0, 0);
        }
        float ss = 0.f;
#pragma unroll
        for (int ct = 0; ct < 2; ++ct)
#pragma unroll
            for (int r = 0; r < 16; ++r) ss += o[ct][r] * o[ct][r];
        ss += __shfl_xor(ss, 32);
        const float rs = 1.0f / sqrtf(ss * (1.0f / 64.0f) + EPS);
#pragma unroll
        for (int ct = 0; ct < 2; ++ct)
#pragma unroll
            for (int rg = 0; rg < 4; ++rg) { const int c0 = 32 * ct + 8 * rg + 4 * lh;
                const v2u zz = zq[ct][rg]; const f32x4 ow = oww[ct][rg];
                const float z0 = bflo(zz.x), z1 = bfhi(zz.x), z2 = bflo(zz.y), z3 = bfhi(zz.y);
                v2u ov; ov.x = pk2(o[ct][4 * rg] * rs * ow[0] * silu_f(z0), o[ct][4 * rg + 1] * rs * ow[1] * silu_f(z1)); ov.y = pk2(o[ct][4 * rg + 2] * rs * ow[2] * silu_f(z2), o[ct][4 * rg + 3] * rs * ow[3] * silu_f(z3));
                *(v2u*)(OAB + row * D + h * 64 + c0) = ov;
            }
    }
}

template <int WIN>
__device__ __forceinline__ void pooled_block(const bf16* H, bf16* P, const int t0, const int tl0, const int col) {
    v4u r[WIN - 1 + 8];
#pragma unroll
    for (int j = 0; j < WIN - 1 + 8; ++j) { const int dt = j - (WIN - 1); r[j] = (v4u){0u, 0u, 0u, 0u}; if (tl0 + dt >= 0) r[j] = *(const v4u*)(H + (size_t)(t0 + dt) * D + col); }
    float s[8];
#pragma unroll
    for (int q = 0; q < 8; ++q) s[q] = 0.f;
#define POOL_ACC(sgn, VV) do { const v4u q_ = (VV); s[0] += sgn bflo(q_.x); s[1] += sgn bfhi(q_.x); s[2] += sgn bflo(q_.y); s[3] += sgn bfhi(q_.y); s[4] += sgn bflo(q_.z); s[5] += sgn bfhi(q_.z); s[6] += sgn bflo(q_.w); s[7] += sgn bfhi(q_.w); } while (0)
#pragma unroll
    for (int j = 0; j < WIN - 1; ++j) POOL_ACC(+, r[j]);
#pragma unroll
    for (int i = 0; i < 8; ++i) { const v4u self = r[WIN - 1 + i]; POOL_ACC(+, self);
        const int n = (tl0 + i + 1) < WIN ? (tl0 + i + 1) : WIN; const float inv = 1.0f / (float)n;
        v4u o; o.x = pk2(s[0] * inv - bflo(self.x), s[1] * inv - bfhi(self.x)); o.y = pk2(s[2] * inv - bflo(self.y), s[3] * inv - bfhi(self.y));
        o.z = pk2(s[4] * inv - bflo(self.z), s[5] * inv - bfhi(self.z)); o.w = pk2(s[6] * inv - bflo(self.w), s[7] * inv - bfhi(self.w));
        *(v4u*)(P + (size_t)(t0 + i) * D + col) = o;
        POOL_ACC(-, r[i]); }
#undef POOL_ACC
}
struct PoolSched {
    const char* B; int nun;
    __device__ __forceinline__ bool next(int i, pg8::Unit& u) const { if (i >= nun) return false; u.pm = (int)blockIdx.x >> 1; u.pn = 2 * ((int)blockIdx.x & 1) + i; u.e = 0; return true; }
    __device__ __forceinline__ unsigned a_off(const pg8::Unit& u, int r) const { return (unsigned)(u.pm * 256 + r) * 2048u + (unsigned)u.pn * 512u; }
    __device__ __forceinline__ const char* b_ptr(const pg8::Unit& u) const { return B + (size_t)u.pn * (256 * 256 * 2); }
};
__device__ __forceinline__ void pooled_phase(Frame& F) {
    const bf16* H = (const bf16*)(F.ws + WS_H); bf16* P = (bf16*)(F.ws + WS_OAB);
    for (int it = F.tid; it < 2048; it += 512) {
        const int c = it & 31, g = 2 * ((int)blockIdx.x & 1) + __builtin_amdgcn_readfirstlane((it >> 6) & 1), tb = ((it >> 7) << 1) | ((it >> 5) & 1);
        const int t0 = ((int)blockIdx.x >> 1) * 256 + tb * 8, tl0 = t0 & (SEQ - 1), col = g * 256 + c * 8;
        if (g == 0) pooled_block<2>(H, P, t0, tl0, col); else if (g == 1) pooled_block<4>(H, P, t0, tl0, col); else if (g == 2) pooled_block<8>(H, P, t0, tl0, col); else pooled_block<16>(H, P, t0, tl0, col);
    }
}


#ifndef PH_MASK
#define PH_MASK 0xFFFFFF
#endif
#define IN(k) (((PH_MASK >> (k)) & 1) && lo <= (k) && (k) < hi)
#define BOTH(k) (IN(k) && IN((k) + 1))
#if MK_ONE_LAUNCH
#define GRID_BAR() xcd_barrier(bar)
#else
#define GRID_BAR() do { } while (0)
#endif
template <int LAYER>
__device__ __forceinline__ void moe_phases(Frame& F, const XcdBarrier& bar, const int lo, const int hi) {
    constexpr int pb = LAYER == 0 ? 7 : 13;
    bf16* const H = (bf16*)(F.ws + WS_H);
    const float* const MOD = (const float*)(F.ws + WS_MOD);
    if (IN(pb)) {
        moe_route(F, LAYER); if (BOTH(pb)) GRID_BAR(); }
    if (IN(pb + 1)) {
        build_moe_tables(F, LAYER);
        pg8::Gemm g{(const bf16*)H, 1024, 1024}; MoeSched S; S.init((const LAS int*)(F.lds + SCHED_OFF), F.G, (int)blockIdx.x, (const int*)(F.ws + WS_RT), F.ws + WS_WGU, 1024, 1024);
        EpiSwiglu E{(bf16*)(F.ws + WS_ACT)};
        if (LAYER == 1) { S.Blo = (const char*)(F.ws + WS_WGT); S.esplit = 16; }
        moe_tail_plan(F);
        pg8::gemm_phase<EpiSwiglu, MoeSched>(F.lds + RING_OFF, g, S, E);
        {
            const LAS int* T = (const LAS int*)(F.lds + SCHED_OFF); const int sp = T[67];
            const int q0 = LAYER == 0 ? 0 : CQ_NG, q1 = LAYER == 0 ? CQ_NGT : CQ_N;
            if (sp > 0) { __syncthreads(); const int f = q0 + T[65] * 8 * TQ_GU; int e = f + sp * 8 * TQ_GU; e = e < q1 ? e : q1; convert_range(F, 1, f, e, F.wave, 8); }
            if (LAYER == 1) { int t = q0 + T[66] * 8 * TQ_GU;
                if (t < q1) { __syncthreads(); convert_range(F, 1, t, q1, F.vcu * NWAVES + F.wave, F.G * NWAVES); } } }
        if (BOTH(pb + 1)) GRID_BAR();
    }
    if (IN(pb + 2)) {
        if (lo == pb + 2) build_moe_tables(F, LAYER);
        pg8::Gemm g{(const bf16*)(F.ws + WS_ACT), 512, 512}; MoeSched S; S.init((const LAS int*)(F.lds + SCHED_OFF), F.G, (int)blockIdx.x, nullptr, F.ws + WS_WD, 512, 512);
        EpiStoreBf16 E{(bf16*)(F.ws + WS_Y), D};
        if (LAYER == 0 && lo == pb + 2) moe_tail_plan(F);
        pg8::gemm_phase<EpiStoreBf16, MoeSched>(F.lds + RING_OFF, g, S, E);
        if (LAYER == 0) {
            const LAS int* T = (const LAS int*)(F.lds + SCHED_OFF); const int sp = T[67];
            int t8 = T[66] * 8 * TQ_GU; t8 = t8 < CQ_NGT ? t8 : CQ_NGT;
            if (sp > 0) { __syncthreads(); const int f = t8 + T[65] * 8 * TQ_DN; int e = f + sp * 8 * TQ_DN; e = e < CQ_NG ? e : CQ_NG; convert_range(F, 1, f, e, F.wave, 8); } }
        if (BOTH(pb + 2)) GRID_BAR();
    }
    if (IN(pb + 3)) {
        if (lo == pb + 3) build_moe_tables(F, LAYER);
        if (LAYER == 0 && lo == pb + 3) moe_tail_plan(F);
        const int tokw = F.vcu * 128 + F.wave * 16, b = (F.vcu * 128) / SEQ;
        f32x4 g2[4];
#pragma unroll
        for (int j = 0; j < 4; ++j) g2[j] = *((const f32x4*)(MOD + (size_t)(LAYER * 2 + b) * 6144 + 5 * 1024) + F.lane + 64 * j);
        if (LAYER == 0) {
            const ModVec m1 = load_mod(F.in[I_NMIX] + D, MOD + (size_t)(2 + b) * 6144 + 1024, MOD + (size_t)(2 + b) * 6144, F.lane);
            { const CombRecs recs = comb_load_recs(F, tokw); CombRows A, B; comb_issue(F, recs, 0, tokw, A);
#pragma unroll 1
              for (int i = 0; i < 16; i += 2) { const int t = tokw + i;
                  comb_issue(F, recs, i + 1, t + 1, B);
                  { const RowVec x = comb_finish(recs, i, A, g2);
                    store_row_bf16((bf16*)(F.ws + WS_XRB) + (size_t)t * D, F.lane, x); store_row_bf16(H + (size_t)t * D, F.lane, apply_mod(x, row_rstd(x), m1)); }
                  if (i + 2 < 16) comb_issue(F, recs, i + 2, t + 2, A);
                  { const RowVec x = comb_finish(recs, i + 1, B, g2);
                    store_row_bf16((bf16*)(F.ws + WS_XRB) + (size_t)(t + 1) * D, F.lane, x); store_row_bf16(H + (size_t)(t + 1) * D, F.lane, apply_mod(x, row_rstd(x), m1)); } } }
            __syncthreads();
            { const LAS int* T = (const LAS int*)(F.lds + SCHED_OFF);
              int t8 = T[66] * 8 * TQ_GU; t8 = t8 < CQ_NGT ? t8 : CQ_NGT; int t9 = t8 + T[66] * 8 * TQ_DN; t9 = t9 < CQ_NG ? t9 : CQ_NG;
              convert_range(F, 1, t9, CQ_NG, F.vcu * NWAVES + F.wave, F.G * NWAVES); }
        } else {
            f32x4 fw[4];
#pragma unroll
            for (int j = 0; j < 4; ++j) fw[j] = *((const f32x4*)F.in[I_FNW] + F.lane + 64 * j);
            { const CombRecs recs = comb_load_recs(F, tokw); CombRows A, B; comb_issue(F, recs, 0, tokw, A);
#pragma unroll 1
              for (int i = 0; i < 16; i += 2) { const int t = tokw + i;
                  comb_issue(F, recs, i + 1, t + 1, B);
                  { RowVec x = comb_finish(recs, i, A, g2); const float rstd = row_rstd(x);
#pragma unroll
                    for (int j = 0; j < 4; ++j) x.v[j] = x.v[j] * rstd * fw[j];
                    store_row_f32(F.out + (size_t)t * D, F.lane, x); }
                  if (i + 2 < 16) comb_issue(F, recs, i + 2, t + 2, A);
                  { RowVec x = comb_finish(recs, i + 1, B, g2); const float rstd = row_rstd(x);
#pragma unroll
                    for (int j = 0; j < 4; ++j) x.v[j] = x.v[j] * rstd * fw[j];
                    store_row_f32(F.out + (size_t)(t + 1) * D, F.lane, x); } } }
        }
        if (BOTH(pb + 3)) GRID_BAR();
    }
}

constexpr int PH_P0 = 0, PH_P1 = 1, PH_INPROJ = 2, PH_ATT = 3, PH_SCAN = 4, PH_DNOUT = 5, PH_OUTPROJ = 6, PH_MOE0 = 7, PH_POOLED = 11, PH_POOLG = 12, PH_MOE1 = 13;
constexpr int N_PHASES = 17;
struct Args { const float* in[24]; float* out; unsigned char* ws; int ph_lo, ph_hi; };
__global__ void __launch_bounds__(NWAVES * 64, 2) trunk_fwd(Args args) {
    __shared__ __attribute__((aligned(16))) unsigned char lds[LDS_BYTES];
    Frame F;
    F.lds = (LAS unsigned char*)lds;
    F.MISC = (volatile LAS unsigned*)(F.lds + MISC_OFF);
    F.tid = threadIdx.x; F.lane = F.tid & 63; F.wave = __builtin_amdgcn_readfirstlane(F.tid >> 6);
    F.G = gridDim.x; { const int bx = blockIdx.x; F.vcu = (F.G % 8 == 0) ? (bx % 8) * (F.G / 8) + bx / 8 : bx; }
#pragma unroll
    for (int i = 0; i < 24; ++i) F.in[i] = args.in[i];
    F.out = args.out; F.ws = args.ws; F.ctl = (gu32*)(args.ws + WS_CTL);
    for (int u = F.tid; u < (LDS_BYTES - LDSCTL_OFF) / 4; u += NWAVES * 64) ((LAS unsigned*)(F.lds + LDSCTL_OFF))[u] = 0u;
    __syncthreads();
#if MK_ONE_LAUNCH
    XcdBarrier bar = xcd_barrier_post((unsigned*)(F.ctl + CW_BAR), F.MISC + 8);
#else
    XcdBarrier bar; bar.bar = nullptr; bar.x = 0; bar.st = nullptr;
#endif
    const int lo = args.ph_lo, hi = args.ph_hi;

    bf16* const H = (bf16*)(F.ws + WS_H);
    const float* const MOD = (const float*)(F.ws + WS_MOD);

    if (IN(PH_P0)) { p0_prologue(F); if (BOTH(PH_P0)) GRID_BAR(); }
    if (IN(PH_P1)) { p1_prenorm0(F); if (BOTH(PH_P1)) GRID_BAR(); }
    if (IN(PH_INPROJ)) {
        pg8::Gemm g{(const bf16*)H, 1024, 1024}; DenseSched S; S.init(NTOK, IP_TILES * 256, F.G, (int)blockIdx.x, 1024, 0, F.ws + WS_WIN, 1024); S.gap_from = PC_ZA / 256; S.gap = 2;
        EpiStoreBf16 E{(bf16*)(F.ws + WS_PROJ), PIN};
        pg8::gemm_phase<EpiStoreBf16, DenseSched>(F.lds + RING_OFF, g, S, E);
        if (IP_FULL && (int)blockIdx.x >= IP_FULL) {
            __syncthreads(); const int r = (int)blockIdx.x - IP_FULL; convert_range(F, 0, r * 8 * TQ_INPROJ, (r + 1) * 8 * TQ_INPROJ, F.wave, 8); }
        if (BOTH(PH_INPROJ)) GRID_BAR();
    }
    if (IN(PH_ATT)) { dn_prep(F); if (BOTH(PH_ATT)) GRID_BAR(); }
    if (IN(PH_SCAN)) {
        if ((int)blockIdx.x < 32) dn_scan(F);
        else { const int o = (int)blockIdx.x - 32, NO = F.G - 32;
            attn_phase(F, o, NO); __syncthreads();
            { pg8::Gemm g{(const bf16*)H, 1024, 1024}; EpiStoreBf16 E{(bf16*)(F.ws + WS_PROJ), PIN};
              DenseSched S; S.init(NTOK, 512, NO, o, 1024, 0, F.ws + WS_WIN, 1024); S.gap_from = 0; S.gap = PC_ZA / 256; S.Lend = NO;
              pg8::gemm_phase<EpiStoreBf16, DenseSched>(F.lds + RING_OFF, g, S, E);
              if (o >= 64 && o < 64 + (S.nwg - NO)) { __syncthreads(); S.L0 = NO; S.G = S.nwg - NO; S.c = o - 64; S.Lend = S.nwg;
                  pg8::gemm_phase<EpiStoreBf16, DenseSched>(F.lds + RING_OFF, g, S, E); } }
            __syncthreads();
            { const int q = o < 64 ? 6 : o < 96 ? 4 : 9, off = o < 64 ? 48 * o : o < 96 ? 3072 + 32 * (o - 64) : 4096 + 72 * (o - 96);
              convert_range(F, 0, CQ_T2 + off, CQ_T2 + off + 8 * q, F.wave, 8);
              convert_range(F, 0, CQ_T2 + 4096 + 72 * 128, CQ_N, o * NWAVES + F.wave, NO * NWAVES); } }
        if (BOTH(PH_SCAN)) GRID_BAR(); }
    if (IN(PH_DNOUT)) { dn_output(F); if (BOTH(PH_DNOUT)) GRID_BAR(); }
    if (IN(PH_OUTPROJ)) {
        pg8::Gemm g{(const bf16*)(F.ws + WS_OAB), 1024, 1024}; DenseSched S; S.init(NTOK, D, F.G, (int)blockIdx.x, 1024, 0, F.ws + WS_WOUT, 1024);
        EpiResid<true> E{F.in[I_X], (bf16*)(F.ws + WS_XRB), MOD + 2 * 1024, nullptr};
        pg8::gemm_phase<EpiResid<true>, DenseSched>(F.lds + RING_OFF, g, S, E);
        if (BOTH(PH_OUTPROJ)) GRID_BAR();
    }
    moe_phases<0>(F, bar, lo, hi);
    if (IN(PH_POOLED)) { pooled_phase(F); __syncthreads(); }
    if (IN(PH_POOLG)) {
        pg8::Gemm g{(const bf16*)(F.ws + WS_OAB), 256, 256}; PoolSched S{(const char*)(F.ws + WS_POOLW), F.G >> 7};
        EpiResid<false> E{nullptr, (bf16*)(F.ws + WS_XRB), MOD + (size_t)2 * 6144 + 2 * 1024, F.in[I_POOLS]};
        pg8::gemm_phase<EpiResid<false>, PoolSched>(F.lds + RING_OFF, g, S, E);
        if (BOTH(PH_POOLG)) GRID_BAR();
    }
    moe_phases<1>(F, bar, lo, hi);
#undef IN
#undef BOTH
}

extern "C" void kernel_launch(void* const* d_in, const int* in_sizes, int n_in, void* d_out, int out_size, void* d_ws, size_t ws_size, hipStream_t stream) {
    static int grid = 0;
    if (grid == 0) {
        if (n_in != 24 || in_sizes[0] != NTOK * D || out_size != NTOK * D || ws_size < WS_END2) { fprintf(stderr, "kernel_launch: unexpected shapes (n_in %d, in0 %d, out %d, ws %zu); nothing launched\n", n_in, n_in > 0 ? in_sizes[0] : -1, out_size, ws_size); grid = -1; return; }
        int per_cu = 0;
        if (hipOccupancyMaxActiveBlocksPerMultiprocessor(&per_cu, (const void*)trunk_fwd, NWAVES * 64, 0) != hipSuccess || per_cu < 1) fprintf(stderr, "kernel_launch: occupancy query says %d\n", per_cu);
        (void)hipGetLastError();
        grid = 256;
    }
    if (grid < 0) return;
    if (hipMemsetAsync((char*)d_ws + WS_CTL, 0, CTL_ZERO_BYTES, stream) != hipSuccess) { fprintf(stderr, "kernel_launch: memset failed\n"); return; }
    Args a{};
    for (int i = 0; i < 24; ++i) a.in[i] = (const float*)d_in[i];
    a.out = (float*)d_out; a.ws = (unsigned char*)d_ws;
#if MK_ONE_LAUNCH
    a.ph_lo = 0; a.ph_hi = N_PHASES;
    hipLaunchKernelGGL(trunk_fwd, dim3(grid), dim3(NWAVES * 64), 0, stream, a);
#else
    for (int p = 0; p < N_PHASES; ++p) { a.ph_lo = p; a.ph_hi = p + 1; hipLaunchKernelGGL(trunk_fwd, dim3(grid), dim3(NWAVES * 64), 0, stream, a); }
#endif
}
```
